# Optimizing an MI355X kernel written in HIP

```python
import jax, jax.numpy as jnp
from jax import lax
import numpy as np

D_MODEL = 1024
BATCH = 8
SEQ = 2048
DEPTH = 4
DEC_BATCH = 32
DEC_SEQ = 4
PAST_LEN = 16384
PAGE_SIZE = 128

N_MIXERS = 3
N_A_LAYERS = (DEPTH + 2) // 3
N_B_LAYERS = (DEPTH + 1) // 3
N_C_LAYERS = DEPTH // 3

D_FF = (-(-8 * D_MODEL // (3 * 256))) * 256

A_CHUNK = 128
A_WIDTH = D_MODEL
A_GROUPS = 8
A_GROUP_DIM = A_WIDTH // A_GROUPS
LN_EPS = 1e-5

MLA_HEADS = 8
MLA_Q_LORA = 384
MLA_KV_LORA = 256
MLA_NOPE = 128
MLA_ROPE = 64
MLA_V = 128
MLA_LAT = MLA_KV_LORA + MLA_ROPE
MLA_SCALE = (MLA_NOPE + MLA_ROPE) ** -0.5
ROPE_THETA = 10000.0
Q_BLOCK = 128

LRU_WIDTH = 1280
LRU_BLOCKS = 10
LRU_BLOCK_DIM = LRU_WIDTH // LRU_BLOCKS
CONV_WIDTH = 4
LRU_C = 8.0

RMS_EPS = 1e-6

kernel_name = 'hybrid_gmlp_mla_rglru_step'


def rmsnorm(x, g):
    xf = x.astype(jnp.float32)
    y = xf * lax.rsqrt(jnp.mean(xf * xf, axis=-1, keepdims=True) + RMS_EPS)
    return (y * g.astype(jnp.float32)).astype(x.dtype)


def layernorm(x, g, b):
    xf = x.astype(jnp.float32)
    mu = jnp.mean(xf, axis=-1, keepdims=True)
    xc = xf - mu
    y = xc * lax.rsqrt(jnp.mean(xc * xc, axis=-1, keepdims=True) + LN_EPS)
    return (y * g.astype(jnp.float32) + b.astype(jnp.float32)).astype(x.dtype)


def swiglu(x, w_gate, w_up, w_down):
    return (jax.nn.silu(x @ w_gate) * (x @ w_up)) @ w_down


def chunk_mlp(x, w_in, ln_g, ln_b, w_s, b_s, w_out):
    bsz, seqlen, _ = x.shape
    z = jax.nn.gelu(x @ w_in)
    u, v = jnp.split(z, 2, axis=-1)
    v = layernorm(v, ln_g, ln_b)
    n_chunks = -(-seqlen // A_CHUNK)
    pad = n_chunks * A_CHUNK - seqlen
    vp = jnp.pad(v, ((0, 0), (0, pad), (0, 0))).reshape(bsz, n_chunks, A_CHUNK, A_GROUPS, A_GROUP_DIM)
    mask = jnp.tril(jnp.ones((A_CHUNK, A_CHUNK), dtype=bool))
    w = jnp.where(mask[None], w_s, 0)
    mixed = jnp.einsum('gts,bcsgd->bctgd', w, vp) + b_s.T[None, None, :, :, None]
    mixed = mixed.reshape(bsz, n_chunks * A_CHUNK, A_WIDTH)[:, :seqlen]
    return (u * mixed) @ w_out, v


def rope_angles(pos):
    inv = 1.0 / (ROPE_THETA ** (jnp.arange(0, MLA_ROPE, 2, dtype=jnp.float32) / MLA_ROPE))
    ang = pos.astype(jnp.float32)[:, None] * inv[None, :]
    return jnp.cos(ang), jnp.sin(ang)


def apply_rope(x, cos, sin):
    xf = x.astype(jnp.float32)
    x1, x2 = jnp.split(xf, 2, axis=-1)
    return jnp.concatenate([x1 * cos - x2 * sin, x1 * sin + x2 * cos], axis=-1).astype(x.dtype)


def mla_project(x, cos, sin, w_dq, q_norm, w_uq, w_dkv, kv_norm, w_uk):
    bsz, seqlen, _ = x.shape
    cq = rmsnorm(x @ w_dq, q_norm)
    q = (cq @ w_uq).reshape(bsz, seqlen, MLA_HEADS, MLA_NOPE + MLA_ROPE)
    q_nope, q_pe = q[..., :MLA_NOPE], q[..., MLA_NOPE:]
    kv = x @ w_dkv
    c_kv = rmsnorm(kv[..., :MLA_KV_LORA], kv_norm)
    k_pe = apply_rope(kv[..., MLA_KV_LORA:], cos, sin)
    q_pe = apply_rope(q_pe, cos[:, None, :], sin[:, None, :])
    q_lat = jnp.einsum('blhn,chn->blhc', q_nope, w_uk)
    q_full = jnp.concatenate([q_lat, q_pe], axis=-1)
    kv_row = jnp.concatenate([c_kv, k_pe], axis=-1)
    return q_full, kv_row


def mla_attend(q, q_pos, keys, k_pos):
    s = jnp.einsum('bqhc,bkc->bhqk', q, keys, preferred_element_type=jnp.float32) * MLA_SCALE
    mask = k_pos[None, :] <= q_pos[:, None]
    s = jnp.where(mask, s, -jnp.inf)
    p = jax.nn.softmax(s, axis=-1).astype(keys.dtype)
    return jnp.einsum('bhqk,bkc->bqhc', p, keys[..., :MLA_KV_LORA])


def mla_prompt_attention(q, kv, pos):
    bsz, seqlen, _, _ = q.shape
    nb = seqlen // Q_BLOCK
    qb = q.reshape(bsz, nb, Q_BLOCK, MLA_HEADS, MLA_LAT).transpose(1, 0, 2, 3, 4)
    qpos = pos.reshape(nb, Q_BLOCK)
    o = lax.map(lambda a: mla_attend(a[0], a[1], kv, pos), (qb, qpos))
    return o.transpose(1, 0, 2, 3, 4).reshape(bsz, seqlen, MLA_HEADS, MLA_KV_LORA)


def mla_output(o, w_uv, w_out):
    bsz, seqlen = o.shape[0], o.shape[1]
    ov = jnp.einsum('blhc,chv->blhv', o, w_uv).reshape(bsz, seqlen, MLA_HEADS * MLA_V)
    return ov @ w_out


def causal_conv(x, buf, w, b):
    seqlen = x.shape[1]
    xx = jnp.concatenate([buf.astype(x.dtype), x], axis=1)
    out = b + sum(w[k] * xx[:, k:k + seqlen] for k in range(CONV_WIDTH))
    return out, xx[:, -(CONV_WIDTH - 1):]


def block_diag(x, w, b):
    bsz, seqlen, _ = x.shape
    xb = x.reshape(bsz, seqlen, LRU_BLOCKS, LRU_BLOCK_DIM)
    return jnp.einsum('blni,nij->blnj', xb, w).reshape(bsz, seqlen, LRU_WIDTH) + b


def rglru(x, h0, w_a, b_a, w_i, b_i, lam):
    r = jax.nn.sigmoid(block_diag(x, w_a, b_a).astype(jnp.float32))
    gi = jax.nn.sigmoid(block_diag(x, w_i, b_i).astype(jnp.float32))
    log_a = -LRU_C * r * jax.nn.softplus(-lam.astype(jnp.float32))
    a = jnp.exp(log_a)
    bterm = jnp.sqrt(-jnp.expm1(2.0 * log_a)) * gi * x.astype(jnp.float32)
    bterm = bterm.at[:, 0].add(a[:, 0] * h0.astype(jnp.float32))

    def combine(left, right):
        a1, b1 = left
        a2, b2 = right
        return a1 * a2, a2 * b1 + b2

    _, h = lax.associative_scan(combine, (a, bterm), axis=1)
    return h.astype(x.dtype), h[:, -1].astype(x.dtype)


def recurrent_block(x, h0, conv_buf, w_x, w_gate, conv_w, conv_b, w_a, b_a, w_i, b_i, lam, w_out):
    gate = jax.nn.gelu(x @ w_gate)
    xc, new_buf = causal_conv(x @ w_x, conv_buf, conv_w, conv_b)
    h, h_last = rglru(xc, h0, w_a, b_a, w_i, b_i, lam)
    return (gate * h) @ w_out, h_last, new_buf


def setup_inputs(seed: int = 0) -> dict:
    key = jax.random.key(seed)
    ks = iter(jax.random.split(key, 64))

    def nrm(shape, fan_in=1):
        return jax.random.normal(next(ks), shape, jnp.float32) * (fan_in ** -0.5)

    def gain(shape):
        return 1.0 + 0.02 * jax.random.normal(next(ks), shape, jnp.float32)

    def small(shape):
        return 0.01 * jax.random.normal(next(ks), shape, jnp.float32)

    n_pages = PAST_LEN // PAGE_SIZE
    n_used = DEC_BATCH * n_pages
    n_pool = n_used + n_used // 4

    x_prompt = nrm((BATCH, SEQ, D_MODEL))
    x_sample = nrm((DEC_BATCH, DEC_SEQ, D_MODEL))
    cache_mla = nrm((N_B_LAYERS, n_pool, PAGE_SIZE, MLA_LAT))
    state_lru_h = 0.5 * nrm((N_C_LAYERS, DEC_BATCH, LRU_WIDTH))
    state_lru_conv = nrm((N_C_LAYERS, DEC_BATCH, CONV_WIDTH - 1, LRU_WIDTH))
    page_table = jax.random.permutation(next(ks), n_pool)[:n_used].reshape(DEC_BATCH, n_pages).astype(jnp.int32)

    a0 = jax.random.uniform(next(ks), (N_C_LAYERS, LRU_WIDTH), jnp.float32, 0.9, 0.999)
    a_base = a0 ** (1.0 / LRU_C)
    c_lambda = jnp.log(a_base) - jnp.log1p(-a_base)

    return {
        'x_prompt': x_prompt,
        'x_sample': x_sample,
        'cache_mla': cache_mla,
        'state_lru_h': state_lru_h,
        'state_lru_conv': state_lru_conv,
        'page_table': page_table,
        'norm_mix': gain((DEPTH, D_MODEL)),
        'norm_ffn': gain((DEPTH, D_MODEL)),
        'norm_out': gain((D_MODEL,)),
        'a_w_in': nrm((N_A_LAYERS, D_MODEL, 2 * A_WIDTH), D_MODEL),
        'a_ln_g': gain((N_A_LAYERS, A_WIDTH)),
        'a_ln_b': small((N_A_LAYERS, A_WIDTH)),
        'a_w_s': nrm((N_A_LAYERS, A_GROUPS, A_CHUNK, A_CHUNK), A_CHUNK),
        'a_b_s': gain((N_A_LAYERS, A_GROUPS, A_CHUNK)),
        'a_w_out': nrm((N_A_LAYERS, A_WIDTH, D_MODEL), A_WIDTH),
        'b_w_dq': nrm((N_B_LAYERS, D_MODEL, MLA_Q_LORA), D_MODEL),
        'b_q_norm': gain((N_B_LAYERS, MLA_Q_LORA)),
        'b_w_uq': nrm((N_B_LAYERS, MLA_Q_LORA, MLA_HEADS * (MLA_NOPE + MLA_ROPE)), MLA_Q_LORA),
        'b_w_dkv': nrm((N_B_LAYERS, D_MODEL, MLA_LAT), D_MODEL),
        'b_kv_norm': gain((N_B_LAYERS, MLA_KV_LORA)),
        'b_w_uk': nrm((N_B_LAYERS, MLA_KV_LORA, MLA_HEADS, MLA_NOPE), MLA_KV_LORA),
        'b_w_uv': nrm((N_B_LAYERS, MLA_KV_LORA, MLA_HEADS, MLA_V), MLA_KV_LORA),
        'b_w_out': nrm((N_B_LAYERS, MLA_HEADS * MLA_V, D_MODEL), MLA_HEADS * MLA_V),
        'c_w_x': nrm((N_C_LAYERS, D_MODEL, LRU_WIDTH), D_MODEL),
        'c_w_gate': nrm((N_C_LAYERS, D_MODEL, LRU_WIDTH), D_MODEL),
        'c_conv_w': nrm((N_C_LAYERS, CONV_WIDTH, LRU_WIDTH), CONV_WIDTH),
        'c_conv_b': small((N_C_LAYERS, LRU_WIDTH)),
        'c_w_a': nrm((N_C_LAYERS, LRU_BLOCKS, LRU_BLOCK_DIM, LRU_BLOCK_DIM), LRU_BLOCK_DIM),
        'c_b_a': small((N_C_LAYERS, LRU_WIDTH)),
        'c_w_i': nrm((N_C_LAYERS, LRU_BLOCKS, LRU_BLOCK_DIM, LRU_BLOCK_DIM), LRU_BLOCK_DIM),
        'c_b_i': small((N_C_LAYERS, LRU_WIDTH)),
        'c_lambda': c_lambda,
        'c_w_out': nrm((N_C_LAYERS, LRU_WIDTH, D_MODEL), LRU_WIDTH),
        'f_w_gate': nrm((DEPTH, D_MODEL, D_FF), D_MODEL),
        'f_w_up': nrm((DEPTH, D_MODEL, D_FF), D_MODEL),
        'f_w_down': nrm((DEPTH, D_FF, D_MODEL), D_FF),
    }


def reference(x_prompt, x_sample, cache_mla, state_lru_h, state_lru_conv, page_table,
              norm_mix, norm_ffn, norm_out,
              a_w_in, a_ln_g, a_ln_b, a_w_s, a_b_s, a_w_out,
              b_w_dq, b_q_norm, b_w_uq, b_w_dkv, b_kv_norm, b_w_uk, b_w_uv, b_w_out,
              c_w_x, c_w_gate, c_conv_w, c_conv_b, c_w_a, c_b_a, c_w_i, c_b_i, c_lambda, c_w_out,
              f_w_gate, f_w_up, f_w_down):
    past_len = page_table.shape[1] * PAGE_SIZE
    n_pr, len_p = x_prompt.shape[0], x_prompt.shape[1]
    n_dec, len_s = x_sample.shape[0], x_sample.shape[1]
    pos_p = jnp.arange(len_p, dtype=jnp.int32)
    pos_s = past_len + jnp.arange(len_s, dtype=jnp.int32)
    k_pos_s = jnp.arange(past_len + len_s, dtype=jnp.int32)
    cos_p, sin_p = rope_angles(pos_p)
    cos_s, sin_s = rope_angles(pos_s)

    hp, hs = x_prompt, x_sample
    chunk_v_s, mla_p, mla_s = [], [], []
    lru_h_p, lru_h_s, lru_c_p, lru_c_s = [], [], [], []
    for layer in range(DEPTH):
        kind, j = layer % N_MIXERS, layer // N_MIXERS
        zp = rmsnorm(hp, norm_mix[layer])
        zs = rmsnorm(hs, norm_mix[layer])
        if kind == 0:
            a_args = (a_w_in[j], a_ln_g[j], a_ln_b[j], a_w_s[j], a_b_s[j], a_w_out[j])
            yp, _ = chunk_mlp(zp, *a_args)
            ys, v_s = chunk_mlp(zs, *a_args)
            chunk_v_s.append(v_s)
        elif kind == 1:
            b_args = (b_w_dq[j], b_q_norm[j], b_w_uq[j], b_w_dkv[j], b_kv_norm[j], b_w_uk[j])
            q_p, kv_p = mla_project(zp, cos_p, sin_p, *b_args)
            o_p = mla_prompt_attention(q_p, kv_p, pos_p)
            q_s, kv_s = mla_project(zs, cos_s, sin_s, *b_args)
            past = cache_mla[j][page_table].reshape(n_dec, past_len, MLA_LAT)
            keys = jnp.concatenate([past, kv_s.astype(past.dtype)], axis=1)
            o_s = mla_attend(q_s, pos_s, keys, k_pos_s)
            yp = mla_output(o_p, b_w_uv[j], b_w_out[j])
            ys = mla_output(o_s, b_w_uv[j], b_w_out[j])
            mla_p.append(kv_p)
            mla_s.append(kv_s)
        else:
            c_args = (c_w_x[j], c_w_gate[j], c_conv_w[j], c_conv_b[j], c_w_a[j], c_b_a[j],
                      c_w_i[j], c_b_i[j], c_lambda[j], c_w_out[j])
            h0_p = jnp.zeros((n_pr, LRU_WIDTH), x_prompt.dtype)
            buf0_p = jnp.zeros((n_pr, CONV_WIDTH - 1, LRU_WIDTH), x_prompt.dtype)
            yp, hl_p, cb_p = recurrent_block(zp, h0_p, buf0_p, *c_args)
            ys, hl_s, cb_s = recurrent_block(zs, state_lru_h[j], state_lru_conv[j], *c_args)
            lru_h_p.append(hl_p)
            lru_h_s.append(hl_s)
            lru_c_p.append(cb_p)
            lru_c_s.append(cb_s)
        hp = hp + yp
        hs = hs + ys
        hp = hp + swiglu(rmsnorm(hp, norm_ffn[layer]), f_w_gate[layer], f_w_up[layer], f_w_down[layer])
        hs = hs + swiglu(rmsnorm(hs, norm_ffn[layer]), f_w_gate[layer], f_w_up[layer], f_w_down[layer])

    y_prompt = rmsnorm(hp, norm_out)
    y_sample = rmsnorm(hs, norm_out)
    return (y_prompt, y_sample, jnp.stack(chunk_v_s), jnp.stack(mla_p), jnp.stack(mla_s),
            jnp.stack(lru_h_p), jnp.stack(lru_h_s), jnp.stack(lru_c_p), jnp.stack(lru_c_s))
```

```cpp
#include <hip/hip_runtime.h>
#include <math.h>
namespace orc {
constexpr int D = 1024, SEQ = 2048, NB_P = 8, NB_S = 32, LS = 4, PAST = 16384, PAGE = 128, NPAGES = 128;
constexpr int DFF = 2816, AW = 1024, AG = 8, AGD = 128, ACH = 128;
constexpr int QL = 384, KVL = 256, NOPE = 128, ROPE = 64, VD = 128, LAT = 320, NH = 8;
constexpr int LW = 1280, LNB = 10, LBD = 128, CW = 4;
constexpr float RMS_EPS = 1e-6f, LN_EPS = 1e-5f, LRU_C = 8.0f;
constexpr float MLA_SCALE = 0.07216878364870322f;

__device__ __forceinline__ float blk_sum(float v, float* red) {
    for (int o = 32; o >= 1; o >>= 1) v += __shfl_xor(v, o);
    const int w = threadIdx.x >> 6, nw = blockDim.x >> 6;
    __syncthreads();
    if ((threadIdx.x & 63) == 0) red[w] = v;
    __syncthreads();
    float s = 0.f; for (int i = 0; i < nw; ++i) s += red[i];
    return s;
}
__device__ __forceinline__ float blk_max(float v, float* red) {
    for (int o = 32; o >= 1; o >>= 1) v = fmaxf(v, __shfl_xor(v, o));
    const int w = threadIdx.x >> 6, nw = blockDim.x >> 6;
    __syncthreads();
    if ((threadIdx.x & 63) == 0) red[w] = v;
    __syncthreads();
    float s = red[0]; for (int i = 1; i < nw; ++i) s = fmaxf(s, red[i]);
    return s;
}
__device__ __forceinline__ float gelu_tanh(float x) { const float c = 0.7978845608028654f; return 0.5f * x * (1.f + tanhf(c * (x + 0.044715f * x * x * x))); }
__device__ __forceinline__ float sigmoidf(float x) { return 1.f / (1.f + expf(-x)); }

__global__ void k_rmsnorm(const float* x, int ldx, const float* g, float* y, int ldy, int Dn) {
    __shared__ float red[8];
    const float* xr = x + (size_t)blockIdx.x * ldx; float* yr = y + (size_t)blockIdx.x * ldy;
    float s = 0.f; for (int c = threadIdx.x; c < Dn; c += blockDim.x) { const float v = xr[c]; s += v * v; }
    s = blk_sum(s, red);
    const float rs = rsqrtf(s / (float)Dn + RMS_EPS);
    for (int c = threadIdx.x; c < Dn; c += blockDim.x) yr[c] = xr[c] * rs * g[c];
}
__global__ void k_layernorm(const float* x, int ldx, const float* g, const float* b, float* y, int ldy, int Dn) {
    __shared__ float red[8];
    const float* xr = x + (size_t)blockIdx.x * ldx; float* yr = y + (size_t)blockIdx.x * ldy;
    float s = 0.f; for (int c = threadIdx.x; c < Dn; c += blockDim.x) s += xr[c];
    s = blk_sum(s, red); const float mu = s / (float)Dn;
    float q = 0.f; for (int c = threadIdx.x; c < Dn; c += blockDim.x) { const float d = xr[c] - mu; q += d * d; }
    q = blk_sum(q, red); const float rs = rsqrtf(q / (float)Dn + LN_EPS);
    for (int c = threadIdx.x; c < Dn; c += blockDim.x) yr[c] = (xr[c] - mu) * rs * g[c] + b[c];
}
__global__ void __launch_bounds__(256) k_gemm(const float* A, int lda, const float* W, int ldw, float* C, int ldc, const float* R, int ldr, int K) {
    __shared__ float As[16][68]; __shared__ float Ws[16][64];
    const int tid = threadIdx.x, tx = tid & 15, ty = tid >> 4, m0 = blockIdx.y * 64, n0 = blockIdx.x * 64;
    float acc[4][4]; for (int i = 0; i < 4; ++i) for (int j = 0; j < 4; ++j) acc[i][j] = 0.f;
    for (int k0 = 0; k0 < K; k0 += 16) {
        { const int r = tid >> 2, kc = (tid & 3) * 4; const float4 v = *(const float4*)(A + (size_t)(m0 + r) * lda + k0 + kc);
          As[kc + 0][r] = v.x; As[kc + 1][r] = v.y; As[kc + 2][r] = v.z; As[kc + 3][r] = v.w; }
        { const int kr = tid >> 4, nc = (tid & 15) * 4; const float4 v = *(const float4*)(W + (size_t)(k0 + kr) * ldw + n0 + nc);
          Ws[kr][nc + 0] = v.x; Ws[kr][nc + 1] = v.y; Ws[kr][nc + 2] = v.z; Ws[kr][nc + 3] = v.w; }
        __syncthreads();
#pragma unroll
        for (int k = 0; k < 16; ++k) {
            float a[4], b[4];
#pragma unroll
            for (int i = 0; i < 4; ++i) a[i] = As[k][ty * 4 + i];
#pragma unroll
            for (int j = 0; j < 4; ++j) b[j] = Ws[k][tx * 4 + j];
#pragma unroll
            for (int i = 0; i < 4; ++i)
#pragma unroll
                for (int j = 0; j < 4; ++j) acc[i][j] += a[i] * b[j];
        }
        __syncthreads();
    }
#pragma unroll
    for (int i = 0; i < 4; ++i) { const int m = m0 + ty * 4 + i;
#pragma unroll
        for (int j = 0; j < 4; ++j) { const int n = n0 + tx * 4 + j; C[(size_t)m * ldc + n] = (R ? R[(size_t)m * ldr + n] : 0.f) + acc[i][j]; } }
}
__global__ void k_gelu(float* x, size_t n) { for (size_t i = (size_t)blockIdx.x * blockDim.x + threadIdx.x; i < n; i += (size_t)gridDim.x * blockDim.x) x[i] = gelu_tanh(x[i]); }
__global__ void k_copy(const float* s, float* d, size_t n) { for (size_t i = (size_t)blockIdx.x * blockDim.x + threadIdx.x; i < n; i += (size_t)gridDim.x * blockDim.x) d[i] = s[i]; }
__global__ void k_spatial(const float* zz  , const float* vn  , const float* w_s, const float* b_s, float* um, int L) {
    const int m = blockIdx.x, b = m / L, l = m % L, t = l % ACH, base = b * L + (l - t);
    for (int c = threadIdx.x; c < AW; c += blockDim.x) {
        const int g = c / AGD; const float* wr = w_s + ((size_t)g * ACH + t) * ACH; float acc = 0.f;
        for (int s = 0; s <= t; ++s) acc += wr[s] * vn[(size_t)(base + s) * AW + c];
        um[(size_t)m * AW + c] = zz[(size_t)m * (2 * AW) + c] * (acc + b_s[g * ACH + t]);
    }
}
__device__ __forceinline__ float rope_inv(int i) { return 1.0f / powf(10000.0f, (float)(2 * i) / 64.0f); }
__global__ void k_kvrow(const float* kv, const float* kv_norm, float* kvrow, int L, int pos0) {
    __shared__ float red[8];
    const int m = blockIdx.x, l = m % L; const float* xr = kv + (size_t)m * LAT; float* yr = kvrow + (size_t)m * LAT;
    const float v = xr[threadIdx.x]; float s = blk_sum(v * v, red);
    const float rs = rsqrtf(s / 256.f + RMS_EPS);
    yr[threadIdx.x] = v * rs * kv_norm[threadIdx.x];
    if (threadIdx.x < 32) { const int i = threadIdx.x; const float ang = (float)(pos0 + l) * rope_inv(i); const float c = cosf(ang), sn = sinf(ang);
        const float x1 = xr[256 + i], x2 = xr[256 + 32 + i]; yr[256 + i] = x1 * c - x2 * sn; yr[256 + 32 + i] = x1 * sn + x2 * c; }
}
__global__ void k_qfull(const float* q, const float* w_uk, float* qf, int L, int pos0) {
    __shared__ float qs[192];
    const int m = blockIdx.x, h = blockIdx.y, l = m % L;
    if (threadIdx.x < 192) qs[threadIdx.x] = q[(size_t)m * 1536 + h * 192 + threadIdx.x];
    __syncthreads();
    const int c = threadIdx.x; const float* w = w_uk + (size_t)c * (NH * NOPE) + h * NOPE; float acc = 0.f;
    for (int n = 0; n < NOPE; ++n) acc += qs[n] * w[n];
    float* o = qf + ((size_t)m * NH + h) * LAT; o[c] = acc;
    if (threadIdx.x < 32) { const int i = threadIdx.x; const float ang = (float)(pos0 + l) * rope_inv(i); const float cs = cosf(ang), sn = sinf(ang);
        const float x1 = qs[128 + i], x2 = qs[128 + 32 + i]; o[256 + i] = x1 * cs - x2 * sn; o[256 + 32 + i] = x1 * sn + x2 * cs; }
}
__global__ void __launch_bounds__(256) k_attn(const float* qf, const float* kvrow, const float* cache  , const int* page_table, float* o, int L) {
    __shared__ float qs[LAT]; __shared__ float sc[1024]; __shared__ float red[8];
    const int m = blockIdx.x, h = blockIdx.y, b = m / L, t = m % L, tid = threadIdx.x;
    for (int i = tid; i < LAT; i += 256) qs[i] = qf[((size_t)m * NH + h) * LAT + i];
    __syncthreads();
    const int npast = cache ? PAST : 0, nk = npast + t + 1;
    float mx = -INFINITY, lsum = 0.f, acc = 0.f;
    for (int k0 = 0; k0 < nk; k0 += 1024) {
        const int n = min(1024, nk - k0);
        float cm = -INFINITY;
        for (int kk = tid; kk < n; kk += 256) { const int k = k0 + kk;
            const float* kp = (k < npast) ? cache + ((size_t)page_table[b * NPAGES + k / PAGE] * PAGE + (k % PAGE)) * LAT : kvrow + (size_t)(b * L + (k - npast)) * LAT;
            float s = 0.f; for (int d = 0; d < LAT; ++d) s += qs[d] * kp[d];
            s *= MLA_SCALE; sc[kk] = s; cm = fmaxf(cm, s); }
        cm = blk_max(cm, red);
        const float mn = fmaxf(mx, cm), alpha = (mx == -INFINITY) ? 0.f : expf(mx - mn);
        acc *= alpha; lsum *= alpha;
        for (int kk = 0; kk < n; ++kk) { const int k = k0 + kk; const float p = expf(sc[kk] - mn);
            const float* kp = (k < npast) ? cache + ((size_t)page_table[b * NPAGES + k / PAGE] * PAGE + (k % PAGE)) * LAT : kvrow + (size_t)(b * L + (k - npast)) * LAT;
            acc += p * kp[tid]; lsum += p; }
        mx = mn;
        __syncthreads();
    }
    o[((size_t)m * NH + h) * KVL + tid] = acc / lsum;
}
__global__ void k_ov(const float* o, const float* w_uv, float* ov) {
    __shared__ float os[KVL];
    const int m = blockIdx.x, h = blockIdx.y;
    for (int i = threadIdx.x; i < KVL; i += blockDim.x) os[i] = o[((size_t)m * NH + h) * KVL + i];
    __syncthreads();
    const int v = threadIdx.x; float acc = 0.f;
    for (int c = 0; c < KVL; ++c) acc += os[c] * w_uv[(size_t)c * (NH * VD) + h * VD + v];
    ov[(size_t)m * (NH * VD) + h * VD + v] = acc;
}
__global__ void k_conv(const float* xw, const float* buf, const float* cw, const float* cb, float* xc, float* newbuf, int L) {
    const int m = blockIdx.x, b = m / L, t = m % L;
    for (int c = threadIdx.x; c < LW; c += blockDim.x) {
        float acc = cb[c];
        for (int k = 0; k < CW; ++k) { const int r = t + k; const float v = (r < 3) ? (buf ? buf[((size_t)b * 3 + r) * LW + c] : 0.f) : xw[(size_t)(b * L + r - 3) * LW + c]; acc += cw[k * LW + c] * v; }
        xc[(size_t)m * LW + c] = acc;
        if (t >= L - 3) { const int j = t - (L - 3);   newbuf[((size_t)b * 3 + j) * LW + c] = xw[(size_t)m * LW + c]; }
    }
}
__global__ void k_rglru_ab(const float* xc, const float* w_a, const float* b_a, const float* w_i, const float* b_i, const float* lam, float* a_out, float* b_out) {
    __shared__ float xs[LW];
    const int m = blockIdx.x;
    for (int c = threadIdx.x; c < LW; c += blockDim.x) xs[c] = xc[(size_t)m * LW + c];
    __syncthreads();
    for (int c = threadIdx.x; c < LW; c += blockDim.x) {
        const int n = c / LBD, j = c % LBD; float sa = b_a[c], si = b_i[c];
        const float* wa = w_a + (size_t)n * LBD * LBD + j; const float* wi = w_i + (size_t)n * LBD * LBD + j;
        for (int i = 0; i < LBD; ++i) { const float x = xs[n * LBD + i]; sa += x * wa[(size_t)i * LBD]; si += x * wi[(size_t)i * LBD]; }
        const float r = sigmoidf(sa), gi = sigmoidf(si);
        const float nl = -lam[c]; const float sp = (nl > 20.f) ? nl : log1pf(expf(nl));
        const float log_a = -LRU_C * r * sp; const float a = expf(log_a);
        const float bt = sqrtf(-expm1f(2.f * log_a)) * gi * xs[c];
        a_out[(size_t)m * LW + c] = a; b_out[(size_t)m * LW + c] = bt;
    }
}
__global__ void k_scan(const float* a, const float* bt, const float* h0, const float* gate, float* gh, float* hlast, int L, int nb) {
    const int idx = blockIdx.x * blockDim.x + threadIdx.x; if (idx >= nb * LW) return;
    const int b = idx / LW, c = idx % LW; float h = h0 ? h0[(size_t)b * LW + c] : 0.f;
    for (int t = 0; t < L; ++t) { const size_t o = (size_t)(b * L + t) * LW + c; h = a[o] * h + bt[o]; gh[o] = gate[o] * h; }
    hlast[(size_t)b * LW + c] = h;
}
__global__ void k_silu_mul(const float* g, const float* u, float* o, size_t n) { for (size_t i = (size_t)blockIdx.x * blockDim.x + threadIdx.x; i < n; i += (size_t)gridDim.x * blockDim.x) { const float x = g[i]; o[i] = x / (1.f + expf(-x)) * u[i]; } }

struct Bump { char* p; size_t off; float* f(size_t n) { float* r = (float*)(p + off); off += ((n * 4 + 255) / 256) * 256; return r; } };

struct SetOut { float *y, *chunk_v, *mla, *lru_h, *lru_conv; };
inline void run_set(void* const* d_in, Bump& ws, hipStream_t st, const float* x, int nb, int L, int pos0, bool sample, SetOut out, float** keep_h  ) {
    const int M = nb * L;
    auto in = [&](int i) { return (const float*)d_in[i]; };
    float* h = ws.f((size_t)M * D); float* z = ws.f((size_t)M * D);
    float* big = ws.f((size_t)M * 2 * DFF);
    float* t1 = ws.f((size_t)M * 2560); float* t2 = ws.f((size_t)M * 2560); float* t3 = ws.f((size_t)M * 2560); float* t4 = ws.f((size_t)M * 2560);
    auto gemm = [&](const float* A, int lda, const float* W, int ldw, float* C, int ldc, const float* R, int ldr, int N, int K) {
        hipLaunchKernelGGL(k_gemm, dim3(N / 64, M / 64), dim3(256), 0, st, A, lda, W, ldw, C, ldc, R, ldr, K); };
    hipLaunchKernelGGL(k_copy, dim3(1024), dim3(256), 0, st, x, h, (size_t)M * D);
    for (int layer = 0; layer < 4; ++layer) {
        const int kind = layer % 3, j = layer / 3;
        hipLaunchKernelGGL(k_rmsnorm, dim3(M), dim3(256), 0, st, (const float*)h, D, in(6) + layer * D, z, D, D);
        if (kind == 0) {
            float* zz = big;
            gemm(z, D, in(9) + (size_t)j * D * 2 * AW, 2 * AW, zz, 2 * AW, nullptr, 0, 2 * AW, D);
            hipLaunchKernelGGL(k_gelu, dim3(2048), dim3(256), 0, st, zz, (size_t)M * 2 * AW);
            float* vn = sample ? out.chunk_v + (size_t)j * M * AW : t1;
            hipLaunchKernelGGL(k_layernorm, dim3(M), dim3(256), 0, st, (const float*)(zz + AW), 2 * AW, in(10) + j * AW, in(11) + j * AW, vn, AW, AW);
            float* um = t2;
            hipLaunchKernelGGL(k_spatial, dim3(M), dim3(256), 0, st, (const float*)zz, (const float*)vn, in(12) + (size_t)j * AG * ACH * ACH, in(13) + (size_t)j * AG * ACH, um, L);
            gemm(um, AW, in(14) + (size_t)j * AW * D, D, h, D, h, D, D, AW);
        } else if (kind == 1) {
            float* cqr = t1; float* cq = t2; float* q = t3; float* kv = t4;
            gemm(z, D, in(15) + (size_t)j * D * QL, QL, cqr, QL, nullptr, 0, QL, D);
            hipLaunchKernelGGL(k_rmsnorm, dim3(M), dim3(256), 0, st, (const float*)cqr, QL, in(16) + j * QL, cq, QL, QL);
            gemm(cq, QL, in(17) + (size_t)j * QL * 1536, 1536, q, 1536, nullptr, 0, 1536, QL);
            gemm(z, D, in(18) + (size_t)j * D * LAT, LAT, kv, LAT, nullptr, 0, LAT, D);
            float* kvrow = out.mla + (size_t)j * M * LAT;
            hipLaunchKernelGGL(k_kvrow, dim3(M), dim3(256), 0, st, (const float*)kv, in(19) + j * KVL, kvrow, L, pos0);
            float* qf = big;
            hipLaunchKernelGGL(k_qfull, dim3(M, NH), dim3(256), 0, st, (const float*)q, in(20) + (size_t)j * KVL * NH * NOPE, qf, L, pos0);
            float* o = t1;
            hipLaunchKernelGGL(k_attn, dim3(M, NH), dim3(256), 0, st, (const float*)qf, (const float*)kvrow, sample ? in(2) + (size_t)j * 5120 * PAGE * LAT : (const float*)nullptr, (const int*)d_in[5], o, L);
            float* ov = t2;
            hipLaunchKernelGGL(k_ov, dim3(M, NH), dim3(128), 0, st, (const float*)o, in(21) + (size_t)j * KVL * NH * VD, ov);
            gemm(ov, NH * VD, in(22) + (size_t)j * NH * VD * D, D, h, D, h, D, D, NH * VD);
        } else {
            float* gate = t1; float* xw = t2; float* xc = t3; float* aa = t4; float* bb = big; float* gh = big + (size_t)M * LW;
            gemm(z, D, in(24) + (size_t)j * D * LW, LW, gate, LW, nullptr, 0, LW, D);
            hipLaunchKernelGGL(k_gelu, dim3(2048), dim3(256), 0, st, gate, (size_t)M * LW);
            gemm(z, D, in(23) + (size_t)j * D * LW, LW, xw, LW, nullptr, 0, LW, D);
            hipLaunchKernelGGL(k_conv, dim3(M), dim3(256), 0, st, (const float*)xw, sample ? in(4) + (size_t)j * NB_S * 3 * LW : (const float*)nullptr, in(25) + (size_t)j * CW * LW, in(26) + j * LW, xc, out.lru_conv + (size_t)j * nb * 3 * LW, L);
            hipLaunchKernelGGL(k_rglru_ab, dim3(M), dim3(256), 0, st, (const float*)xc, in(27) + (size_t)j * LNB * LBD * LBD, in(28) + j * LW, in(29) + (size_t)j * LNB * LBD * LBD, in(30) + j * LW, in(31) + j * LW, aa, bb);
            hipLaunchKernelGGL(k_scan, dim3((nb * LW + 255) / 256), dim3(256), 0, st, (const float*)aa, (const float*)bb, sample ? in(3) + (size_t)j * NB_S * LW : (const float*)nullptr, (const float*)gate, gh, out.lru_h + (size_t)j * nb * LW, L, nb);
            gemm(gh, LW, in(32) + (size_t)j * LW * D, D, h, D, h, D, D, LW);
        }
        hipLaunchKernelGGL(k_rmsnorm, dim3(M), dim3(256), 0, st, (const float*)h, D, in(7) + layer * D, z, D, D);
        float* g = big; float* u = big + (size_t)M * DFF;
        gemm(z, D, in(33) + (size_t)layer * D * DFF, DFF, g, DFF, nullptr, 0, DFF, D);
        gemm(z, D, in(34) + (size_t)layer * D * DFF, DFF, u, DFF, nullptr, 0, DFF, D);
        hipLaunchKernelGGL(k_silu_mul, dim3(2048), dim3(256), 0, st, (const float*)g, (const float*)u, g, (size_t)M * DFF);
        gemm(g, DFF, in(35) + (size_t)layer * DFF * D, D, h, D, h, D, D, DFF);
        if (keep_h) hipLaunchKernelGGL(k_copy, dim3(1024), dim3(256), 0, st, (const float*)h, keep_h[layer], (size_t)M * D);
    }
    hipLaunchKernelGGL(k_rmsnorm, dim3(M), dim3(256), 0, st, (const float*)h, D, in(8), out.y, D, D);
}
constexpr size_t O_YP = 0, O_YS = 16777216, O_CV = 16908288, O_MP = 17170432, O_MS = 22413312, O_HP = 22454272, O_HS = 22464512, O_CP = 22505472, O_CS = 22536192, O_END = 22659072;
inline void run(void* const* d_in, float* out, char* ws_base, size_t ws_off, hipStream_t st) {
    Bump ws{ws_base, ws_off};
    SetOut op{out + O_YP, nullptr, out + O_MP, out + O_HP, out + O_CP};
    SetOut os{out + O_YS, out + O_CV, out + O_MS, out + O_HS, out + O_CS};
    const size_t mark = ws.off;
    run_set(d_in, ws, st, (const float*)d_in[0], NB_P, SEQ, 0, false, op, nullptr);
    ws.off = mark;
    run_set(d_in, ws, st, (const float*)d_in[1], NB_S, LS, PAST, true, os, nullptr);
}
}
extern "C" void kernel_launch(void* const* d_in, const int* in_sizes, int n_in, void* d_out, int out_size, void* d_ws, size_t ws_size, hipStream_t stream) {
    orc::run(d_in, (float*)d_out, (char*)d_ws, 0, stream);
}
```

```cpp
#include <hip/hip_runtime.h>
#include <math.h>
#define LAS __attribute__((address_space(3)))
#define GAS __attribute__((address_space(1)))
namespace pg8 {
#define PG8_LAS __attribute__((address_space(3)))
typedef unsigned short bf16_t;
typedef short bf16x8 __attribute__((ext_vector_type(8)));
typedef float f32x4 __attribute__((ext_vector_type(4)));
typedef unsigned u32x4 __attribute__((ext_vector_type(4)));
constexpr int BM = 256, BK = 64, HALF = 128, HTB = HALF * BK * 2  , STAGE_BYTES = 8 * HTB, NXCD = 8, WGM = 8;
__host__ __device__ __forceinline__ int lds_byte(int r, int c) { const int st = (r >> 4) * 2 + (c >> 5), rr = r & 15, cc = c & 31, ob = rr * 64 + cc * 2; return st * 1024 + (ob ^ (((ob >> 9) & 1) << 5)); }
__host__ __device__ __forceinline__ void stage_rc(int b, int& R, int& C) { const int st = b / 1024, sb = b % 1024, swz = sb ^ (((sb >> 9) & 1) << 5); R = (st >> 1) * 16 + swz / 64; C = (st & 1) * 32 + (swz % 64) / 2; }
__host__ __device__ __forceinline__ int perm32(int rho) { const int n = rho >> 4, i = rho & 15; return 8 * (i >> 2) + 4 * n + (i & 3); }
struct Unit { int pm, pn; };
struct Gemm { const bf16_t* A; const bf16_t* Bt; int lda, ldb, K; };
struct StaticOrder {
    int nM, nN, nwg, G, c;
    __host__ __device__ void init(int M, int N, int G_, int c_) { nM = M / BM; nN = N / BM; nwg = nM * nN; G = G_; c = c_; }
    __host__ __device__ bool next(int i, Unit& u) const {
        const long L = (long)i * G + c; if (L >= nwg) return false;
        int wgid = (int)L; { const int q = nwg / NXCD, r = nwg % NXCD, xcd = wgid % NXCD, off = wgid / NXCD; wgid = (xcd < r ? xcd * (q + 1) : r * (q + 1) + (xcd - r) * q) + off; }
        const int nig = WGM * nN, gid = wgid / nig, fm = gid * WGM, gsz = (nM - fm) < WGM ? (nM - fm) : WGM;
        u.pm = fm + ((wgid % nig) % gsz); u.pn = (wgid % nig) / gsz; return true;
    }
    __device__ __forceinline__ void a_ready(const Unit&) const {}
    __device__ __forceinline__ void done(const Unit&) const {}
};
__device__ __forceinline__ unsigned cvt_pk_bf16(float lo, float hi) { unsigned r; asm volatile("v_cvt_pk_bf16_f32 %0, %1, %2" : "=v"(r) : "v"(lo), "v"(hi)); return r; }
template <class Epi, class Sched, bool ALIGN_EPI = false, bool SP2 = false>
__device__ __forceinline__ void gemm_phase(PG8_LAS unsigned char* lds, const Gemm g, const Sched& S, const Epi& E, const int tid) {
    const int wid = __builtin_amdgcn_readfirstlane(tid >> 6), lane = tid & 63, wr = wid >> 2, wc = wid & 3, fr = lane & 15, fq = lane >> 4;
    const int K = g.K, nt = K / BK, lda = g.lda, ldb = g.ldb;
    unsigned voffA[2], voffB[2];
#pragma unroll
    for (int i = 0; i < 2; ++i) { int R, C; stage_rc(tid * 16 + i * 8192, R, C); const int Rb = Epi::PERM ? ((R & ~31) + perm32(R & 31)) : R;
        voffA[i] = (unsigned)(R * lda + C) * 2u; voffB[i] = (unsigned)(Rb * ldb + C) * 2u; }
    const size_t kstep = (size_t)(BK * 2);
    const size_t hstepA = (size_t)HALF * lda * 2, hstepB = (size_t)HALF * ldb * 2;
    const size_t tstepA = 2 * hstepA, tstepB = 2 * hstepB;
    const unsigned ldsw = (unsigned)wid * 1024u;
    const int aoff = lds_byte(wr * 64 + fr, fq * 8), boff = lds_byte(wc * 32 + fr, fq * 8);
#define PG8_SA(b, h) (((b) * 2 + (h)) * HTB)
#define PG8_SB(b, h) ((4 + (b) * 2 + (h)) * HTB)
#define PG8_STAGE(bufoff, gbase, voff) do { _Pragma("unroll") for (int _i = 0; _i < 2; ++_i) \
        __builtin_amdgcn_global_load_lds((const unsigned*)((const char*)(gbase) + (voff)[_i]), (PG8_LAS unsigned*)(lds + (bufoff) + ldsw + _i * 8192), 16, 0, 0); } while (0)
#define PG8_LDA(dst, b, h) do { _Pragma("unroll") for (int m = 0; m < 4; ++m) _Pragma("unroll") for (int k = 0; k < 2; ++k) dst[m][k] = *(const PG8_LAS bf16x8*)(lds + PG8_SA(b, h) + aoff + m * 2048 + k * 1024); } while (0)
#define PG8_LDB(dst, b, h) do { _Pragma("unroll") for (int n = 0; n < 2; ++n) _Pragma("unroll") for (int k = 0; k < 2; ++k) dst[n][k] = *(const PG8_LAS bf16x8*)(lds + PG8_SB(b, h) + boff + n * 2048 + k * 1024); } while (0)
#define PG8_MMA(ai, bj, At, Bt) do { __builtin_amdgcn_s_setprio(1); _Pragma("unroll") for (int m = 0; m < 4; ++m) _Pragma("unroll") for (int n = 0; n < 2; ++n) _Pragma("unroll") for (int k = 0; k < 2; ++k) \
        acc[ai][bj][m][n] = __builtin_amdgcn_mfma_f32_16x16x32_bf16(Bt[n][k], At[m][k], acc[ai][bj][m][n], 0, 0, 0); __builtin_amdgcn_s_setprio(0); } while (0)
#define PG8_WAIT_V(n) asm volatile("s_waitcnt vmcnt(" #n ")" ::: "memory")
#define PG8_WAIT_L(n) asm volatile("s_waitcnt lgkmcnt(" #n ")" ::: "memory")
#define PG8_BAR __builtin_amdgcn_s_barrier()
#define PG8_SCHED __builtin_amdgcn_sched_barrier(0)
    Unit cur, nxt; int ui = 0;
    if (!S.next(0, cur)) return;
    f32x4 acc[2][2][4][2];
#pragma unroll
    for (int a = 0; a < 2; ++a)
#pragma unroll
        for (int b = 0; b < 2; ++b)
#pragma unroll
            for (int m = 0; m < 4; ++m)
#pragma unroll
                for (int n = 0; n < 2; ++n) acc[a][b][m][n] = (f32x4){0.f, 0.f, 0.f, 0.f};
    bf16x8 At[4][2], B0[2][2], B1[2][2];
    const char* cA = (const char*)g.A + (size_t)cur.pm * tstepA; const char* cB = (const char*)g.Bt + (size_t)cur.pn * tstepB;
    S.a_ready(cur);
    if constexpr (SP2) {
        PG8_STAGE(PG8_SB(0, 0), cB, voffB); PG8_STAGE(PG8_SB(0, 1), cB + hstepB, voffB); PG8_STAGE(PG8_SA(0, 0), cA, voffA); PG8_STAGE(PG8_SA(0, 1), cA + hstepA, voffA);
        if (wr == 1) PG8_BAR;
        PG8_WAIT_V(2); PG8_BAR;
        PG8_STAGE(PG8_SB(1, 0), cB + kstep, voffB); PG8_STAGE(PG8_SA(1, 0), cA + kstep, voffA); PG8_STAGE(PG8_SB(1, 1), cB + hstepB + kstep, voffB);
        PG8_WAIT_V(6); PG8_BAR;
    } else {
        PG8_STAGE(PG8_SB(0, 0), cB, voffB); PG8_STAGE(PG8_SA(0, 0), cA, voffA); PG8_STAGE(PG8_SB(0, 1), cB + hstepB, voffB); PG8_STAGE(PG8_SA(0, 1), cA + hstepA, voffA);
        if (wr == 1) PG8_BAR;
        PG8_WAIT_V(4); PG8_BAR;
        PG8_STAGE(PG8_SB(1, 0), cB + kstep, voffB); PG8_STAGE(PG8_SA(1, 0), cA + kstep, voffA); PG8_STAGE(PG8_SB(1, 1), cB + hstepB + kstep, voffB);
        PG8_WAIT_V(6); PG8_BAR;
    }
    for (;;) {
        const bool has_next = S.next(ui + 1, nxt);
        const char* nA = has_next ? (const char*)g.A + (size_t)nxt.pm * tstepA : cA; const char* nB = has_next ? (const char*)g.Bt + (size_t)nxt.pn * tstepB : cB;
        for (int t = 0; t < nt; t += 2) {
            const bool last = (t == nt - 2);
            const char* a1 = cA + (size_t)(t + 1) * kstep;
            const char* a2 = last ? nA : cA + (size_t)(t + 2) * kstep; const char* b2 = last ? nB : cB + (size_t)(t + 2) * kstep;
            const char* a3 = a2 + kstep; const char* b3 = b2 + kstep;
            if (last && has_next) S.a_ready(nxt);
            if constexpr (SP2) {
            PG8_LDB(B0, 0, 0); PG8_LDB(B1, 0, 1); PG8_SCHED; PG8_LDA(At, 0, 0); PG8_STAGE(PG8_SA(1, 1), a1 + hstepA, voffA);
            PG8_WAIT_V(8); PG8_WAIT_L(0); PG8_BAR; PG8_MMA(0, 0, At, B0); PG8_MMA(0, 1, At, B1); PG8_BAR; PG8_SCHED;
            PG8_LDA(At, 0, 1); PG8_STAGE(PG8_SB(0, 0), b2, voffB); PG8_STAGE(PG8_SB(0, 1), b2 + hstepB, voffB); PG8_STAGE(PG8_SA(0, 0), a2, voffA);
            PG8_WAIT_V(8); PG8_WAIT_L(0); PG8_BAR; PG8_MMA(1, 0, At, B0); PG8_MMA(1, 1, At, B1); PG8_BAR; PG8_SCHED;
            PG8_LDB(B0, 1, 0); PG8_LDB(B1, 1, 1); PG8_SCHED; PG8_LDA(At, 1, 0); PG8_STAGE(PG8_SA(0, 1), a2 + hstepA, voffA);
            PG8_WAIT_V(8); PG8_WAIT_L(0); PG8_BAR; PG8_MMA(0, 0, At, B0); PG8_MMA(0, 1, At, B1); PG8_BAR; PG8_SCHED;
            PG8_LDA(At, 1, 1); PG8_STAGE(PG8_SB(1, 0), b3, voffB); PG8_STAGE(PG8_SB(1, 1), b3 + hstepB, voffB); PG8_STAGE(PG8_SA(1, 0), a3, voffA);
            PG8_WAIT_V(8); PG8_WAIT_L(0); PG8_BAR; PG8_MMA(1, 0, At, B0); PG8_MMA(1, 1, At, B1); PG8_BAR; PG8_SCHED;
            } else {
            PG8_LDB(B0, 0, 0); PG8_SCHED; PG8_LDA(At, 0, 0); PG8_STAGE(PG8_SA(1, 1), a1 + hstepA, voffA);
            PG8_WAIT_L(8); PG8_BAR; PG8_WAIT_L(0); PG8_MMA(0, 0, At, B0); PG8_BAR; PG8_SCHED;
            PG8_LDB(B1, 0, 1); PG8_STAGE(PG8_SB(0, 0), b2, voffB);
            PG8_BAR; PG8_WAIT_L(0); PG8_MMA(0, 1, At, B1); PG8_BAR;
            PG8_LDA(At, 0, 1); PG8_STAGE(PG8_SA(0, 0), a2, voffA);
            PG8_BAR; PG8_WAIT_L(0); PG8_MMA(1, 0, At, B0); PG8_BAR; PG8_SCHED;
            PG8_STAGE(PG8_SB(0, 1), b2 + hstepB, voffB);
            PG8_WAIT_V(6); PG8_BAR; PG8_MMA(1, 1, At, B1); PG8_BAR;
            PG8_LDB(B0, 1, 0); PG8_SCHED; PG8_LDA(At, 1, 0); PG8_STAGE(PG8_SA(0, 1), a2 + hstepA, voffA);
            PG8_WAIT_L(8); PG8_BAR; PG8_WAIT_L(0); PG8_MMA(0, 0, At, B0); PG8_BAR; PG8_SCHED;
            PG8_LDB(B1, 1, 1); PG8_STAGE(PG8_SB(1, 0), b3, voffB);
            PG8_BAR; PG8_WAIT_L(0); PG8_MMA(0, 1, At, B1); PG8_BAR;
            PG8_LDA(At, 1, 1); PG8_STAGE(PG8_SA(1, 0), a3, voffA);
            PG8_BAR; PG8_WAIT_L(0); PG8_MMA(1, 0, At, B0); PG8_BAR; PG8_SCHED;
            PG8_STAGE(PG8_SB(1, 1), b3 + hstepB, voffB);
            PG8_WAIT_V(6); PG8_BAR; PG8_MMA(1, 1, At, B1); PG8_BAR;
            }
        }
        if constexpr (ALIGN_EPI) { if (wr == 0) PG8_BAR; }
        if constexpr (!Epi::AFTER_DRAIN) { E(acc, cur, wr, wc, fr, fq); S.done(cur); }
        if (!has_next) break;
#pragma unroll
        for (int a = 0; a < 2; ++a)
#pragma unroll
            for (int b = 0; b < 2; ++b)
#pragma unroll
                for (int m = 0; m < 4; ++m)
#pragma unroll
                    for (int n = 0; n < 2; ++n) acc[a][b][m][n] = (f32x4){0.f, 0.f, 0.f, 0.f};
        cur = nxt; cA = nA; cB = nB; ++ui;
        if constexpr (ALIGN_EPI) { if (wr == 1) PG8_BAR; }
    }
    PG8_WAIT_V(0);
    if constexpr (!ALIGN_EPI) { if (wr == 0) PG8_BAR; }
    PG8_BAR;
    if constexpr (Epi::AFTER_DRAIN) { E.fused(acc, cur, wr, wc, fr, fq, lds, wid, lane); S.done(cur); }
#undef PG8_SA
#undef PG8_SB
#undef PG8_STAGE
#undef PG8_LDA
#undef PG8_LDB
#undef PG8_MMA
#undef PG8_WAIT_V
#undef PG8_WAIT_L
#undef PG8_BAR
#undef PG8_SCHED
}

}

namespace mk {
using pg8::f32x4; using pg8::bf16x8; using pg8::u32x4; using pg8::cvt_pk_bf16;
typedef unsigned short bf16;
typedef unsigned u32x2 __attribute__((ext_vector_type(2)));
typedef short s16x4 __attribute__((ext_vector_type(4)));
typedef float f32x2 __attribute__((ext_vector_type(2)));
typedef GAS unsigned gu32;
#define RLX_AGENT __ATOMIC_RELAXED, __HIP_MEMORY_SCOPE_AGENT
#define XB_TMO      128
#define XB_XCNT(j)  (256  + 64 * (j))
#define XB_XSUB(j)  (1280 + 64 * (j))
#define XB_XGEN(j)  (2304 + 64 * (j))
#define XB_TOP      3328
#define XB_TOPGEN   3392
#define XCD_BAR_WORDS 3456
#define XB_SPIN_CAP (1u << 18)

__device__ __forceinline__ unsigned xb_ld(unsigned* p)              { return __hip_atomic_load(p, __ATOMIC_RELAXED, __HIP_MEMORY_SCOPE_AGENT); }
__device__ __forceinline__ unsigned xb_add(unsigned* p, unsigned v) { return __hip_atomic_fetch_add(p, v, __ATOMIC_RELAXED, __HIP_MEMORY_SCOPE_AGENT); }
__device__ __forceinline__ unsigned xb_xcc_id() { return (unsigned)__builtin_amdgcn_s_getreg((3 << 11) | 20) & 0xFu; }
#define XB_SPIN(cond, bar) do { unsigned _sp = 0; while (cond) { __builtin_amdgcn_s_sleep(1); \
    if ((++_sp & 255u) == 0u) { if (xb_ld(&(bar)[XB_TMO])) break; if (_sp > XB_SPIN_CAP) { atomicAdd(&(bar)[XB_TMO], 1u); break; } } } } while (0)

struct XcdBarrier {
    unsigned* bar; unsigned x;
    volatile LAS unsigned* st;
};

__device__ __forceinline__ XcdBarrier xcd_barrier_post(unsigned* bar, volatile LAS unsigned* st) {
    XcdBarrier b; b.bar = bar; b.x = xb_xcc_id(); b.st = st;
    if (threadIdx.x == 0) (void)xb_add(&bar[XB_XCNT(b.x)], 1u);
    return b;
}
__device__ __forceinline__ void xcd_barrier_complete(unsigned* bar, unsigned x, unsigned& nloc, unsigned& nx) {
    const unsigned G = gridDim.x * gridDim.y * gridDim.z;
    unsigned sum, cnt, mine, sp = 0u;
    for (;;) {
        sum = 0u; cnt = 0u; mine = 0u;
#pragma unroll
        for (unsigned j = 0; j < 16; ++j) { const unsigned c = xb_ld(&bar[XB_XCNT(j)]); sum += c; cnt += (c > 0u) ? 1u : 0u; mine = (j == x) ? c : mine; }
        if (sum == G) break;
        __builtin_amdgcn_s_sleep(1);
        if ((++sp & 255u) == 0u) { if (xb_ld(&bar[XB_TMO])) break; if (sp > XB_SPIN_CAP) { atomicAdd(&bar[XB_TMO], 1u); break; } }
    }
    nloc = mine > 0u ? mine : 1u; nx = cnt > 0u ? cnt : 1u;
}

__device__ __forceinline__ void xcd_barrier(const XcdBarrier& b) {
    asm volatile("s_waitcnt vmcnt(0)" ::: "memory");
    __syncthreads();
    if (threadIdx.x == 0) {
        unsigned* bar = b.bar;
        __builtin_amdgcn_s_waitcnt(0);
        unsigned nloc = b.st[0], nx = b.st[1];
        if (nloc == 0u) { xcd_barrier_complete(bar, b.x, nloc, nx); b.st[0] = nloc; b.st[1] = nx; }
        const unsigned old = xb_add(&bar[XB_XSUB(b.x)], 1u);
        const unsigned gen = old / nloc;
        if (old + 1u == (gen + 1u) * nloc) {
            __builtin_amdgcn_fence(__ATOMIC_RELEASE, "agent");
            asm volatile("s_waitcnt vmcnt(0)" ::: "memory");
            const unsigned og = xb_add(&bar[XB_TOP], 1u);
            const unsigned tg = og / nx;
            if (og + 1u == (tg + 1u) * nx) xb_add(&bar[XB_TOPGEN], 1u);
            else XB_SPIN(xb_ld(&bar[XB_TOPGEN]) == tg, bar);
            __builtin_amdgcn_fence(__ATOMIC_ACQUIRE, "agent");
            xb_add(&bar[XB_XGEN(b.x)], 1u);
            asm volatile("s_waitcnt vmcnt(0)" ::: "memory");
        } else {
            XB_SPIN(xb_ld(&bar[XB_XGEN(b.x)]) == gen, bar);
            __builtin_amdgcn_fence(__ATOMIC_ACQUIRE, "agent");
            asm volatile("s_waitcnt vmcnt(0)" ::: "memory");
        }
    }
    __syncthreads();
}


constexpr int MP = 16384, MS = 128, MT = MP + MS, MR = 16640;
constexpr int D = 1024, DFF = 2816, NWAVES = 8;
constexpr float RMS_EPS = 1e-6f, LN_EPS = 1e-5f;
constexpr float MLA_SCALE = 0.07216878364870322f;
constexpr size_t MiB = 1u << 20;
constexpr size_t WS_CTL = 0, CTL_BYTES = 3 * MiB;
constexpr int CW_BAR = 4096;
constexpr size_t ST_OFF = 65536, ST_STRIDE = (size_t)MR * 8;
constexpr int ST_SSQ0 = 0  , ST_LNS0 = 9, ST_LNQ0 = 10  , ST_KV = 13, ST_Q = 14, NSTAT = 15;
static_assert(ST_OFF + NSTAT * ST_STRIDE <= CTL_BYTES, "stats inside CTL");
constexpr size_t WS_WGU = 3 * MiB, WGU_BYTES = 11 * MiB, WS_WD = 47 * MiB, WD_BYTES = 5767168, WS_WIN = 69 * MiB, WS_WOUT = 77 * MiB, WS_WS = 81 * MiB,
                 WS_WDQKV = 82 * MiB, WS_WQ = 84 * MiB, WS_WOV = 86 * MiB, WS_WGX = 90 * MiB, WS_WAT = 95 * MiB, WS_WIT = 95 * MiB + 512 * 1024, WS_WCO = 96 * MiB, WS_ROPE = 99 * MiB;
constexpr size_t WS_H = 100 * MiB, WS_HB = 165 * MiB, WS_U = 198 * MiB, WS_GV = 231 * MiB, WS_UM = 264 * MiB, WS_ACT = 297 * MiB, WS_RAW = 387 * MiB, WS_CQB = 436 * MiB,
                 WS_QF = 449 * MiB, WS_KVB = 531 * MiB, WS_OB = 542 * MiB, WS_PART = 607 * MiB, WS_PML = 623 * MiB, WS_GATE = 624 * MiB, WS_XW = 665 * MiB, WS_AA = 747 * MiB, WS_BB = 829 * MiB,
                 WS_AGG = 911 * MiB, WS_GH = 914 * MiB, WS_MK_END = 956 * MiB;
constexpr int RING_BYTES = 131072, MISC_OFF = RING_BYTES, LDS_BYTES = 147456;
constexpr size_t O_YP = 0, O_YS = 16777216, O_CV = 16908288, O_MP = 17170432, O_MS = 22413312, O_HP = 22454272, O_HS = 22464512, O_CP = 22505472, O_CS = 22536192, O_END = 22659072;

__device__ __forceinline__ float fast_sigmoid_l2(float t) { return __builtin_amdgcn_rcpf(1.0f + __builtin_amdgcn_exp2f(-t)); }
__device__ __forceinline__ float gelu_tanh_f(float x) { return x * fast_sigmoid_l2(2.302208198f * (x + 0.044715f * x * x * x)); }
__device__ __forceinline__ float silu_f(float x) { return x * fast_sigmoid_l2(1.4426950409f * x); }
__device__ __forceinline__ unsigned f2bf(float f) { unsigned u = __builtin_bit_cast(unsigned, f); return (u + 0x7fffu + ((u >> 16) & 1u)) >> 16; }
__device__ __forceinline__ unsigned pk2(float lo, float hi) { return f2bf(lo) | (f2bf(hi) << 16); }
__device__ __forceinline__ float bf2f(unsigned short b) { return __builtin_bit_cast(float, (unsigned)b << 16); }
__device__ __forceinline__ float bflo(unsigned w) { return __builtin_bit_cast(float, w << 16); }
__device__ __forceinline__ float bfhi(unsigned w) { return __builtin_bit_cast(float, w & 0xffff0000u); }
constexpr float ST_SCALE = 16777216.0f, ST_INV = 1.0f / 16777216.0f;
__device__ __forceinline__ void stat_add(long long* p, float v) { atomicAdd((unsigned long long*)p, (unsigned long long)(long long)__float2ll_rn(v * ST_SCALE)); }
__device__ __forceinline__ void stat_set(long long* p, float v) { *p = (long long)__float2ll_rn(v * ST_SCALE); }
__device__ __forceinline__ float stat_get(const long long* p) { return (float)(*p) * ST_INV; }
#define LDS_WAIT() asm volatile("s_waitcnt lgkmcnt(0)" ::: "memory")
#define VM_WAIT() asm volatile("s_waitcnt vmcnt(0)" ::: "memory")

struct InTab { const float* const __attribute__((address_space(4)))* t; __device__ __forceinline__ const float* operator[](int i) const { return t[i]; } };
struct P {
    InTab in; float* out; unsigned char* ws;
    LAS unsigned char* lds; int tid, lane, wave, G, bid;
    __device__ __forceinline__ long long* stat(int a) const { return (long long*)(ws + ST_OFF + (size_t)a * ST_STRIDE); }
    template <class T> __device__ __forceinline__ T* w(size_t off) const { return (T*)(ws + off); }
};
}
namespace mk {
struct TrJob { const float* src; int ldsrc, K, N; bf16* dst; int lddst; const float* gain; int kind, off; };
__device__ __forceinline__ int tr_rowmap(int kind, int off, int n) { return kind == 1 ? ((n >> 7) * 256 + (n & 127) + off) : (off + n); }
__device__ __forceinline__ void tr_item(const TrJob& j, LAS float* scr, int item, int lane) {
    const int nblk = j.N / 32, kb = item / nblk, nb = item % nblk, k0 = 64 * kb, n0 = 32 * nb;
#pragma unroll 8
    for (int i = 0; i < 32; ++i) { const int kk = 2 * i + (lane >> 5); float v = j.src[(size_t)(k0 + kk) * j.ldsrc + n0 + (lane & 31)]; if (j.gain) v *= j.gain[k0 + kk]; scr[kk * 33 + (lane & 31)] = v; }
    LDS_WAIT(); asm volatile("" ::: "memory");
    const int c = lane & 7;
#pragma unroll
    for (int jj = 0; jj < 4; ++jj) { const int n = (lane >> 3) + 8 * jj; const LAS float* s = scr + (8 * c) * 33 + n;
        u32x4 o; o.x = pk2(s[0], s[33]); o.y = pk2(s[66], s[99]); o.z = pk2(s[132], s[165]); o.w = pk2(s[198], s[231]);
        *(u32x4*)(j.dst + (size_t)tr_rowmap(j.kind, j.off, n0 + n) * j.lddst + k0 + 8 * c) = o; }
    LDS_WAIT(); asm volatile("" ::: "memory");
}
constexpr int NJOBS = 24;
__device__ __forceinline__ TrJob get_job(const P& p, int jid) {
    TrJob j; j.gain = nullptr; j.kind = 0; j.off = 0; j.src = nullptr; j.dst = nullptr; j.ldsrc = 0; j.K = 0; j.N = 0; j.lddst = 0;
    if (jid < 12) { const int l = jid / 3, t = jid % 3;
        if (t < 2) { j.src = p.in[33 + t] + (size_t)l * D * DFF; j.ldsrc = DFF; j.K = D; j.N = DFF; j.dst = p.w<bf16>(WS_WGU + l * WGU_BYTES); j.lddst = D; j.gain = p.in[7] + l * D; j.kind = 1; j.off = 128 * t; }
        else { j.src = p.in[35] + (size_t)l * DFF * D; j.ldsrc = D; j.K = DFF; j.N = D; j.dst = p.w<bf16>(WS_WD + l * WD_BYTES); j.lddst = DFF; }
    } else if (jid < 16) { const int a = (jid - 12) >> 1;
        if (((jid - 12) & 1) == 0) { j.src = p.in[9] + (size_t)a * D * 2048; j.ldsrc = 2048; j.K = D; j.N = 2048; j.dst = p.w<bf16>(WS_WIN + a * 4 * MiB); j.lddst = D; j.gain = p.in[6] + (3 * a) * D; }
        else { j.src = p.in[14] + (size_t)a * D * D; j.ldsrc = D; j.K = D; j.N = D; j.dst = p.w<bf16>(WS_WOUT + a * 2 * MiB); j.lddst = D; }
    } else if (jid == 16) { j.src = p.in[15]; j.ldsrc = 384; j.K = D; j.N = 384; j.dst = p.w<bf16>(WS_WDQKV); j.lddst = D; j.gain = p.in[6] + D; j.off = 256; }
    else if (jid == 17) { j.src = p.in[18]; j.ldsrc = 320; j.K = D; j.N = 256; j.dst = p.w<bf16>(WS_WDQKV); j.lddst = D; j.gain = p.in[6] + D; j.off = 0; }
    else if (jid == 18) { j.src = p.in[18] + 256; j.ldsrc = 320; j.K = D; j.N = 64; j.dst = p.w<bf16>(WS_WDQKV); j.lddst = D; j.gain = p.in[6] + D; j.off = 640; }
    else if (jid == 19) { j.src = p.in[24]; j.ldsrc = 1280; j.K = D; j.N = 1280; j.dst = p.w<bf16>(WS_WGX); j.lddst = D; j.gain = p.in[6] + 2 * D; j.off = 0; }
    else if (jid == 20) { j.src = p.in[23]; j.ldsrc = 1280; j.K = D; j.N = 1280; j.dst = p.w<bf16>(WS_WGX); j.lddst = D; j.gain = p.in[6] + 2 * D; j.off = 1280; }
    else if (jid == 21) { j.src = p.in[32]; j.ldsrc = D; j.K = 1280; j.N = D; j.dst = p.w<bf16>(WS_WCO); j.lddst = 1280; }
    else if (jid == 22) { j.src = p.in[27]; j.ldsrc = 128; j.K = 128; j.N = 128; j.dst = p.w<bf16>(WS_WAT); j.lddst = 128; j.kind = 2; }
    else { j.src = p.in[29]; j.ldsrc = 128; j.K = 128; j.N = 128; j.dst = p.w<bf16>(WS_WIT); j.lddst = 128; j.kind = 2; }
    return j;
}
__device__ __forceinline__ int job_items(const TrJob& j) { return j.kind == 2 ? 80 : (j.K / 64) * (j.N / 32); }

__device__ __forceinline__ void p0_prologue(const P& p) {
    LAS float* scr = (LAS float*)(p.lds + p.wave * 16384);
    const int gw = p.bid * NWAVES + p.wave, NGW = p.G * NWAVES, lane = p.lane;
    const int gt = p.bid * (NWAVES * 64) + p.tid, NGT = p.G * NWAVES * 64;
    {
        int base = 0;
        for (int jid = 0; jid < NJOBS; ++jid) {
            TrJob j = get_job(p, jid); const int nit = job_items(j);
            int first = (gw - base % NGW + NGW) % NGW;
            for (int it = first; it < nit; it += NGW) {
                if (j.kind == 2) { TrJob b = j; const int blk = it >> 3; b.src = j.src + (size_t)blk * 16384; b.dst = j.dst + (size_t)blk * 16384; b.kind = 0; tr_item(b, scr, it & 7, lane); }
                else tr_item(j, scr, it, lane);
            }
            base += nit;
        }
    }
    { u32x4* z = (u32x4*)(p.w<bf16>(WS_WDQKV) + (size_t)704 * D); for (int i = gt; i < 64 * D / 8; i += NGT) z[i] = (u32x4){0u, 0u, 0u, 0u}; }
    for (int i = gt; i < 2 * 8 * 128 * 16; i += NGT) {
        const int s0 = (i & 15) * 8, t = (i >> 4) & 127, jg = i >> 11; const float* src = p.in[12] + (size_t)jg * 16384;
        unsigned w[4], ws_[4];
#pragma unroll
        for (int e = 0; e < 4; ++e) { float v[2], vs[2];
#pragma unroll
            for (int h = 0; h < 2; ++h) { const int s = s0 + 2 * e + h; v[h] = (s <= t) ? src[t * 128 + s] : 0.f; vs[h] = ((s >> 2) == (t >> 2) && (s & 3) <= (t & 3)) ? src[(t & 3) * 128 + (s & 3)] : 0.f; }
            w[e] = pk2(v[0], v[1]); ws_[e] = pk2(vs[0], vs[1]); }
        const int j = jg >> 3, g = jg & 7;
        *(u32x4*)(p.w<bf16>(WS_WS + (size_t)j * 262144) + ((size_t)g * 128 + t) * 128 + s0) = (u32x4){w[0], w[1], w[2], w[3]};
        *(u32x4*)(p.w<bf16>(WS_WS + 524288 + (size_t)j * 262144) + ((size_t)g * 128 + t) * 128 + s0) = (u32x4){ws_[0], ws_[1], ws_[2], ws_[3]};
    }
    for (int i = gt; i < 2052 * 32; i += NGT) { const int tp = i >> 5, fi = i & 31, pos = tp < 2048 ? tp : 16384 + (tp - 2048);
        const float inv = 1.0f / powf(10000.0f, (float)(2 * fi) / 64.0f); const float ang = (float)pos * inv;
        p.w<f32x2>(WS_ROPE)[i] = (f32x2){cosf(ang), sinf(ang)}; }
    { float* H = p.w<float>(WS_H); bf16* HB = p.w<bf16>(WS_HB); long long* ssq = p.stat(ST_SSQ0);
      for (int m = gw; m < MR; m += NGW) {
        f32x4 v[4]; float s = 0.f;
#pragma unroll
        for (int jj = 0; jj < 4; ++jj) { const int c = 4 * lane + 256 * jj;
            if (m < MP) v[jj] = *(const f32x4*)(p.in[0] + (size_t)m * D + c); else if (m < MT) v[jj] = *(const f32x4*)(p.in[1] + (size_t)(m - MP) * D + c); else v[jj] = (f32x4){0.f, 0.f, 0.f, 0.f};
            s += (v[jj].x * v[jj].x + v[jj].y * v[jj].y) + (v[jj].z * v[jj].z + v[jj].w * v[jj].w); }
#pragma unroll
        for (int o = 1; o < 64; o <<= 1) s += __shfl_xor(s, o);
#pragma unroll
        for (int jj = 0; jj < 4; ++jj) { const int c = 4 * lane + 256 * jj; *(f32x4*)(H + (size_t)m * D + c) = v[jj];
            *(u32x2*)(HB + (size_t)m * D + c) = (u32x2){pk2(v[jj].x, v[jj].y), pk2(v[jj].z, v[jj].w)}; }
        if (lane == 0) stat_set(ssq + m, s);
      } }
    { const float* wuq = p.in[17]; const float* wuk = p.in[20]; const float* qn = p.in[16]; bf16* Wq = p.w<bf16>(WS_WQ);
      for (int it = gw; it < 2560; it += NGW) {
        if (it < 2048) { const int h = it >> 8, c = it & 255; const float* a = wuk + (size_t)c * 1024 + h * 128;
            float acc[6];
#pragma unroll
            for (int kk = 0; kk < 6; ++kk) acc[kk] = 0.f;
            for (int n = 0; n < 128; n += 4) { const f32x4 av = *(const f32x4*)(a + n);
#pragma unroll
                for (int kk = 0; kk < 6; ++kk) { const f32x4 bv = *(const f32x4*)(wuq + (size_t)(lane + 64 * kk) * 1536 + h * 192 + n); acc[kk] += (av.x * bv.x + av.y * bv.y) + (av.z * bv.z + av.w * bv.w); } }
#pragma unroll
            for (int kk = 0; kk < 6; ++kk) { const int k = lane + 64 * kk; Wq[(size_t)(320 * h + c) * 384 + k] = (bf16)f2bf(acc[kk] * qn[k]); }
        } else { const int r = it - 2048, h = r >> 6, ie = r & 63, i = ie >> 1, e = ie & 1;
#pragma unroll
            for (int kk = 0; kk < 6; ++kk) { const int k = lane + 64 * kk; Wq[(size_t)(320 * h + 256 + ie) * 384 + k] = (bf16)f2bf(wuq[(size_t)k * 1536 + h * 192 + 128 + 32 * e + i] * qn[k]); }
        } } }
    { const float* wuv = p.in[21]; const float* wo = p.in[22]; bf16* Wov = p.w<bf16>(WS_WOV);
      for (int it = gw; it < 2048; it += NGW) { const int h = it >> 8, cg = (it >> 2) & 63, nb = it & 3, c0 = cg * 4, n = nb * 256 + lane * 4;
        f32x4 acc[4];
#pragma unroll
        for (int cc = 0; cc < 4; ++cc) acc[cc] = (f32x4){0.f, 0.f, 0.f, 0.f};
        for (int v = 0; v < 128; ++v) { const f32x4 b = *(const f32x4*)(wo + (size_t)(h * 128 + v) * D + n);
#pragma unroll
            for (int cc = 0; cc < 4; ++cc) { const float a = wuv[(size_t)(c0 + cc) * 1024 + h * 128 + v]; acc[cc] += b * a; } }
#pragma unroll
        for (int jn = 0; jn < 4; ++jn) *(u32x2*)(Wov + (size_t)(n + jn) * 2048 + h * 256 + c0) = (u32x2){pk2(acc[0][jn], acc[1][jn]), pk2(acc[2][jn], acc[3][jn])};
      } }
}
}
namespace mk {
typedef const f32x4 (&AccRef)[2][2][4][2];
__device__ __forceinline__ float quad_red(float v) { v += __shfl_xor(v, 16); v += __shfl_xor(v, 32); return v; }
__device__ __forceinline__ u32x4 pack8(const f32x4 a, const f32x4 b) { u32x4 w; w.x = cvt_pk_bf16(a[0], a[1]); w.y = cvt_pk_bf16(a[2], a[3]); w.z = cvt_pk_bf16(b[0], b[1]); w.w = cvt_pk_bf16(b[2], b[3]); return w; }
__device__ __forceinline__ float sumsq8(const f32x4 a, const f32x4 b) { return ((a[0] * a[0] + a[1] * a[1]) + (a[2] * a[2] + a[3] * a[3])) + ((b[0] * b[0] + b[1] * b[1]) + (b[2] * b[2] + b[3] * b[3])); }
__device__ __forceinline__ float sum8(const f32x4 a, const f32x4 b) { return ((a[0] + a[1]) + (a[2] + a[3])) + ((b[0] + b[1]) + (b[2] + b[3])); }

struct EpiA1 {
    static constexpr bool PERM = true, AFTER_DRAIN = false;
    bf16* U; bf16* GV; const long long* ssq; long long* lns; long long* lnq;
    __device__ __forceinline__ void operator()(AccRef acc, const pg8::Unit& u, int wr, int wc, int fr, int fq) const {
        const bool isv = u.pn >= 4; bf16* dst = isv ? GV : U; const int cb0 = (u.pn & 3) * 256 + wc * 32 + 8 * fq;
#pragma unroll
        for (int ai = 0; ai < 2; ++ai)
#pragma unroll
            for (int m = 0; m < 4; ++m) { const int r = u.pm * 256 + ai * 128 + wr * 64 + m * 16 + fr; const float rs = rsqrtf(stat_get(ssq + r) * (1.0f / 1024.0f) + RMS_EPS);
                float s1 = 0.f, s2 = 0.f;
#pragma unroll
                for (int bj = 0; bj < 2; ++bj) { f32x4 a = acc[ai][bj][m][0] * rs, b = acc[ai][bj][m][1] * rs;
#pragma unroll
                    for (int e = 0; e < 4; ++e) { a[e] = gelu_tanh_f(a[e]); b[e] = gelu_tanh_f(b[e]); }
                    s1 += sum8(a, b); s2 += sumsq8(a, b);
                    *(u32x4*)(dst + (size_t)r * 1024 + cb0 + bj * 128) = pack8(a, b); }
                if (isv) { s1 = quad_red(s1); s2 = quad_red(s2); if (fq == 0) { stat_add(lns + r, s1); stat_add(lnq + r, s2); } }
            }
    }
};
struct EpiRes {
    static constexpr bool PERM = true, AFTER_DRAIN = false;
    float* H; bf16* HB; long long* ssq_out;
    __device__ __forceinline__ void operator()(AccRef acc, const pg8::Unit& u, int wr, int wc, int fr, int fq) const {
        const int cb0 = u.pn * 256 + wc * 32 + 8 * fq;
#pragma unroll
        for (int ai = 0; ai < 2; ++ai)
#pragma unroll
            for (int m = 0; m < 4; ++m) { const int r = u.pm * 256 + ai * 128 + wr * 64 + m * 16 + fr; float q = 0.f;
#pragma unroll
                for (int bj = 0; bj < 2; ++bj) { float* hp = H + (size_t)r * 1024 + cb0 + bj * 128;
                    f32x4 a = *(const f32x4*)hp + acc[ai][bj][m][0], b = *(const f32x4*)(hp + 4) + acc[ai][bj][m][1];
                    *(f32x4*)hp = a; *(f32x4*)(hp + 4) = b; q += sumsq8(a, b);
                    *(u32x4*)(HB + (size_t)r * 1024 + cb0 + bj * 128) = pack8(a, b); }
                q = quad_red(q); if (fq == 0) stat_add(ssq_out + r, q);
            }
    }
};
struct EpiF1 {
    static constexpr bool PERM = true, AFTER_DRAIN = false;
    bf16* ACT; const long long* ssq;
    __device__ __forceinline__ void operator()(AccRef acc, const pg8::Unit& u, int wr, int wc, int fr, int fq) const {
        const int cb0 = u.pn * 128 + wc * 32 + 8 * fq;
#pragma unroll
        for (int ai = 0; ai < 2; ++ai)
#pragma unroll
            for (int m = 0; m < 4; ++m) { const int r = u.pm * 256 + ai * 128 + wr * 64 + m * 16 + fr; const float rs = rsqrtf(stat_get(ssq + r) * (1.0f / 1024.0f) + RMS_EPS);
                f32x4 a, b;
#pragma unroll
                for (int e = 0; e < 4; ++e) { a[e] = silu_f(acc[ai][0][m][0][e] * rs) * (acc[ai][1][m][0][e] * rs); b[e] = silu_f(acc[ai][0][m][1][e] * rs) * (acc[ai][1][m][1][e] * rs); }
                *(u32x4*)(ACT + (size_t)r * DFF + cb0) = pack8(a, b);
            }
    }
};
struct EpiB1 {
    static constexpr bool PERM = true, AFTER_DRAIN = false;
    float* RAW; bf16* CQB; const long long* ssq; long long* ssq_kv; long long* ssq_q;
    __device__ __forceinline__ void operator()(AccRef acc, const pg8::Unit& u, int wr, int wc, int fr, int fq) const {
#pragma unroll
        for (int ai = 0; ai < 2; ++ai)
#pragma unroll
            for (int m = 0; m < 4; ++m) { const int r = u.pm * 256 + ai * 128 + wr * 64 + m * 16 + fr; const float rs = rsqrtf(stat_get(ssq + r) * (1.0f / 1024.0f) + RMS_EPS);
                float qkv = 0.f, qq = 0.f;
#pragma unroll
                for (int bj = 0; bj < 2; ++bj) { const int c = u.pn * 256 + bj * 128 + wc * 32 + 8 * fq; const f32x4 a = acc[ai][bj][m][0] * rs, b = acc[ai][bj][m][1] * rs;
                    if (c < 256) { *(f32x4*)(RAW + (size_t)r * 768 + c) = a; *(f32x4*)(RAW + (size_t)r * 768 + c + 4) = b; qkv += sumsq8(a, b); }
                    else if (c < 640) { *(u32x4*)(CQB + (size_t)r * 384 + (c - 256)) = pack8(a, b); qq += sumsq8(a, b); }
                    else if (c < 704) { *(f32x4*)(RAW + (size_t)r * 768 + c) = a; *(f32x4*)(RAW + (size_t)r * 768 + c + 4) = b; } }
                qkv = quad_red(qkv); qq = quad_red(qq);
                if (fq == 0) { if (u.pn == 0) stat_add(ssq_kv + r, qkv); else stat_add(ssq_q + r, qq); }
            }
    }
};
struct EpiB2 {
    static constexpr bool PERM = true, AFTER_DRAIN = false;
    bf16* QF; const long long* ssq_q; const f32x2* rope;
    __device__ __forceinline__ void operator()(AccRef acc, const pg8::Unit& u, int wr, int wc, int fr, int fq) const {
#pragma unroll
        for (int ai = 0; ai < 2; ++ai)
#pragma unroll
            for (int m = 0; m < 4; ++m) { const int r = u.pm * 256 + ai * 128 + wr * 64 + m * 16 + fr; const float rs = rsqrtf(stat_get(ssq_q + r) * (1.0f / 384.0f) + RMS_EPS) * MLA_SCALE;
                const int tp = r < MP ? (r & 2047) : 2048 + ((r - MP) & 3);
#pragma unroll
                for (int bj = 0; bj < 2; ++bj) { const int c = u.pn * 256 + bj * 128 + wc * 32 + 8 * fq, h = c / 320, w = c - h * 320; const f32x4 a = acc[ai][bj][m][0] * rs, b = acc[ai][bj][m][1] * rs;
                    if (w < 256) *(u32x4*)(QF + (size_t)r * 2560 + c) = pack8(a, b);
                    else { const int i0 = (w - 256) >> 1;
                        const f32x4 cs01 = *(const f32x4*)(rope + (size_t)tp * 32 + i0), cs23 = *(const f32x4*)(rope + (size_t)tp * 32 + i0 + 2);
                        f32x4 o1, o2;
                        o1[0] = a[0] * cs01[0] - a[1] * cs01[1]; o2[0] = a[0] * cs01[1] + a[1] * cs01[0];
                        o1[1] = a[2] * cs01[2] - a[3] * cs01[3]; o2[1] = a[2] * cs01[3] + a[3] * cs01[2];
                        o1[2] = b[0] * cs23[0] - b[1] * cs23[1]; o2[2] = b[0] * cs23[1] + b[1] * cs23[0];
                        o1[3] = b[2] * cs23[2] - b[3] * cs23[3]; o2[3] = b[2] * cs23[3] + b[3] * cs23[2];
                        bf16* qh = QF + (size_t)r * 2560 + h * 320 + 256;
                        *(u32x2*)(qh + i0) = (u32x2){cvt_pk_bf16(o1[0], o1[1]), cvt_pk_bf16(o1[2], o1[3])};
                        *(u32x2*)(qh + 32 + i0) = (u32x2){cvt_pk_bf16(o2[0], o2[1]), cvt_pk_bf16(o2[2], o2[3])}; } }
            }
    }
};
struct EpiC1 {
    static constexpr bool PERM = true, AFTER_DRAIN = false;
    bf16* GATE; float* XW; const long long* ssq;
    __device__ __forceinline__ void operator()(AccRef acc, const pg8::Unit& u, int wr, int wc, int fr, int fq) const {
        const bool isx = u.pn >= 5; const int cb0 = (isx ? u.pn - 5 : u.pn) * 256 + wc * 32 + 8 * fq;
#pragma unroll
        for (int ai = 0; ai < 2; ++ai)
#pragma unroll
            for (int m = 0; m < 4; ++m) { const int r = u.pm * 256 + ai * 128 + wr * 64 + m * 16 + fr; const float rs = rsqrtf(stat_get(ssq + r) * (1.0f / 1024.0f) + RMS_EPS);
#pragma unroll
                for (int bj = 0; bj < 2; ++bj) { f32x4 a = acc[ai][bj][m][0] * rs, b = acc[ai][bj][m][1] * rs; const int c = cb0 + bj * 128;
                    if (isx) { *(f32x4*)(XW + (size_t)r * 1280 + c) = a; *(f32x4*)(XW + (size_t)r * 1280 + c + 4) = b; }
                    else {
#pragma unroll
                        for (int e = 0; e < 4; ++e) { a[e] = gelu_tanh_f(a[e]); b[e] = gelu_tanh_f(b[e]); }
                        *(u32x4*)(GATE + (size_t)r * 1280 + c) = pack8(a, b); } }
            }
    }
};
}
namespace mk {
__device__ __forceinline__ s16x4 tr16(const LAS unsigned char* a) { return __builtin_amdgcn_ds_read_tr16_b64_v4i16((LAS s16x4*)a); }
__device__ __forceinline__ bf16x8 cat8(const s16x4 a, const s16x4 b) { return (bf16x8){a[0], a[1], a[2], a[3], b[0], b[1], b[2], b[3]}; }
__device__ __forceinline__ bf16x8 as_bf16x8(const u32x4 w) { return __builtin_bit_cast(bf16x8, w); }
#define MFMA16(A, B, C) __builtin_amdgcn_mfma_f32_16x16x32_bf16((A), (B), (C), 0, 0, 0)
constexpr int TP = 272;
constexpr int KP = 656;
constexpr float LOG2E = 1.4426950408889634f;

__device__ __forceinline__ void a2_spatial(const P& p, int j, float* out_cv  ) {
    const bf16* U = p.w<bf16>(WS_U); const bf16* GV = p.w<bf16>(WS_GV); bf16* UM = p.w<bf16>(WS_UM);
    const long long* lns = p.stat(ST_LNS0 + 2 * j); const long long* lnq = p.stat(ST_LNQ0 + 2 * j);
    const float* ln_g = p.in[10] + j * 1024; const float* ln_b = p.in[11] + j * 1024; const float* b_s = p.in[13] + j * 1024;
    LAS unsigned char* Wt = p.lds; LAS unsigned char* Vt = p.lds + 128 * TP;
    const int tid = p.tid, lane = p.lane, w = p.wave, l15 = lane & 15, g4 = lane >> 4, q4 = (lane & 15) >> 2, pp = lane & 3;
    for (int u = p.bid; u < 129 * 8; u += p.G) {
        const int c = u >> 3, g = u & 7, row0 = c * 128; const bool smp = (c == 128);
        const bf16* Wsrc = p.w<bf16>(WS_WS + (smp ? 524288 : 0) + (size_t)j * 262144) + (size_t)g * 16384;
#pragma unroll
        for (int q = 0; q < 4; ++q) { const int ch = tid + 512 * q, row = ch >> 4, c16 = ch & 15;
            *(LAS u32x4*)(Wt + row * TP + c16 * 16) = *(const u32x4*)(Wsrc + row * 128 + c16 * 8); }
#pragma unroll
        for (int q = 0; q < 4; ++q) { const int ch = tid + 512 * q, s = ch >> 4, c16 = ch & 15, r = row0 + s, d0 = g * 128 + c16 * 8;
            const u32x4 raw = *(const u32x4*)(GV + (size_t)r * 1024 + d0);
            const float mean = stat_get(lns + r) * (1.0f / 1024.0f), var = stat_get(lnq + r) * (1.0f / 1024.0f) - mean * mean, rstd = rsqrtf(var + LN_EPS);
            const f32x4 g0 = *(const f32x4*)(ln_g + d0), g1 = *(const f32x4*)(ln_g + d0 + 4), b0 = *(const f32x4*)(ln_b + d0), b1 = *(const f32x4*)(ln_b + d0 + 4);
            f32x4 v0, v1;
            v0[0] = bflo(raw.x); v0[1] = bfhi(raw.x); v0[2] = bflo(raw.y); v0[3] = bfhi(raw.y); v1[0] = bflo(raw.z); v1[1] = bfhi(raw.z); v1[2] = bflo(raw.w); v1[3] = bfhi(raw.w);
            v0 = (v0 - mean) * rstd * g0 + b0; v1 = (v1 - mean) * rstd * g1 + b1;
            if (smp && out_cv) { float* o = out_cv + (size_t)(r - MP) * 1024 + d0; *(f32x4*)o = v0; *(f32x4*)(o + 4) = v1; }
            *(LAS u32x4*)(Vt + s * TP + c16 * 16) = pack8(v0, v1); }
        __syncthreads();
        f32x4 acc[8];
#pragma unroll
        for (int tt = 0; tt < 8; ++tt) acc[tt] = (f32x4){0.f, 0.f, 0.f, 0.f};
#pragma unroll
        for (int kk = 0; kk < 4; ++kk) {
            const bf16x8 X = cat8(tr16(Vt + (32 * kk + 8 * g4 + q4) * TP + (16 * w + 4 * pp) * 2), tr16(Vt + (32 * kk + 8 * g4 + 4 + q4) * TP + (16 * w + 4 * pp) * 2));
#pragma unroll
            for (int tt = 0; tt < 8; ++tt) if (32 * kk <= 16 * tt + 15) {
                const bf16x8 Y = *(const LAS bf16x8*)(Wt + (16 * tt + l15) * TP + (32 * kk + 8 * g4) * 2);
                acc[tt] = MFMA16(X, Y, acc[tt]); }
        }
#pragma unroll
        for (int tt = 0; tt < 8; ++tt) { const int t = 16 * tt + l15, r = row0 + t, col = g * 128 + 16 * w + 4 * g4;
            const float bias = b_s[g * 128 + (smp ? (t & 3) : t)];
            const u32x2 uu = *(const u32x2*)(U + (size_t)r * 1024 + col);
            const float o0 = bflo(uu.x) * (acc[tt][0] + bias), o1 = bfhi(uu.x) * (acc[tt][1] + bias), o2 = bflo(uu.y) * (acc[tt][2] + bias), o3 = bfhi(uu.y) * (acc[tt][3] + bias);
            *(u32x2*)(UM + (size_t)r * 1024 + col) = (u32x2){cvt_pk_bf16(o0, o1), cvt_pk_bf16(o2, o3)}; }
        __syncthreads();
    }
}

__device__ __forceinline__ void b2_kvfinal(const P& p, float* out_mp, float* out_ms) {
    const float* RAW = p.w<float>(WS_RAW); bf16* KVB = p.w<bf16>(WS_KVB); const long long* ssq_kv = p.stat(ST_KV); const float* kvn = p.in[19]; const f32x2* rope = p.w<f32x2>(WS_ROPE);
    const int gw = p.bid * NWAVES + p.wave, NGW = p.G * NWAVES, lane = p.lane;
    for (int m = gw; m < MT; m += NGW) {
        float* o = m < MP ? (out_mp ? out_mp + (size_t)m * 320 : nullptr) : (out_ms ? out_ms + (size_t)(m - MP) * 320 : nullptr);
        const float rs = rsqrtf(stat_get(ssq_kv + m) * (1.0f / 256.0f) + RMS_EPS);
        const f32x4 v = *(const f32x4*)(RAW + (size_t)m * 768 + 4 * lane) * rs * *(const f32x4*)(kvn + 4 * lane);
        if (o) *(f32x4*)(o + 4 * lane) = v;
        *(u32x2*)(KVB + (size_t)m * 320 + 4 * lane) = (u32x2){cvt_pk_bf16(v[0], v[1]), cvt_pk_bf16(v[2], v[3])};
        if (lane < 32) { const int tp = m < MP ? (m & 2047) : 2048 + ((m - MP) & 3); const f32x2 cs = rope[(size_t)tp * 32 + lane];
            const float x1 = RAW[(size_t)m * 768 + 640 + lane], x2 = RAW[(size_t)m * 768 + 672 + lane];
            const float o1 = x1 * cs.x - x2 * cs.y, o2 = x1 * cs.y + x2 * cs.x;
            if (o) { o[256 + lane] = o1; o[288 + lane] = o2; }
            KVB[(size_t)m * 320 + 256 + lane] = (bf16)f2bf(o1); KVB[(size_t)m * 320 + 288 + lane] = (bf16)f2bf(o2); }
    }
}

__device__ __forceinline__ void b3_attn_prompt(const P& p) {
    const bf16* QF = p.w<bf16>(WS_QF); const bf16* KVB = p.w<bf16>(WS_KVB); bf16* OB = p.w<bf16>(WS_OB);
    const int tid = p.tid, lane = p.lane, h = p.wave, l15 = lane & 15, g4 = lane >> 4, q4 = (lane & 15) >> 2, pp = lane & 3;
    constexpr int TILE_B = 64 * KP;
    for (int pi = p.bid; pi < 512; pi += p.G) {
        const int b = pi >> 6, x = pi & 63;
        for (int half = 0; half < 2; ++half) {
            const int qt = half ? 127 - x : x, t0 = 16 * qt, nkt = (t0 + 15) / 64 + 1;
            const size_t rowq = (size_t)b * 2048 + t0 + l15;
            bf16x8 Q[10];
#pragma unroll
            for (int s = 0; s < 10; ++s) Q[s] = as_bf16x8(*(const u32x4*)(QF + rowq * 2560 + h * 320 + 32 * s + 8 * g4));
            f32x4 O[16];
#pragma unroll
            for (int vt = 0; vt < 16; ++vt) O[vt] = (f32x4){0.f, 0.f, 0.f, 0.f};
            float mrun = -1e30f, lrun = 0.f;
            u32x4 st[5];
            { const bf16* src = KVB + ((size_t)b * 2048) * 320;
#pragma unroll
              for (int q = 0; q < 5; ++q) { const int ch = tid + 512 * q, row = ch / 40, c16 = ch % 40; st[q] = *(const u32x4*)(src + (size_t)row * 320 + c16 * 8); }
              __syncthreads();
#pragma unroll
              for (int q = 0; q < 5; ++q) { const int ch = tid + 512 * q, row = ch / 40, c16 = ch % 40; *(LAS u32x4*)(p.lds + row * KP + c16 * 16) = st[q]; }
              __syncthreads(); }
            for (int kt = 0; kt < nkt; ++kt) {
                LAS unsigned char* buf = p.lds + (kt & 1) * TILE_B;
                if (kt + 1 < nkt) { const bf16* src = KVB + ((size_t)b * 2048 + 64 * (kt + 1)) * 320;
#pragma unroll
                    for (int q = 0; q < 5; ++q) { const int ch = tid + 512 * q, row = ch / 40, c16 = ch % 40; st[q] = *(const u32x4*)(src + (size_t)row * 320 + c16 * 8); } }
                f32x4 S[4];
#pragma unroll
                for (int k4 = 0; k4 < 4; ++k4) { S[k4] = (f32x4){0.f, 0.f, 0.f, 0.f};
#pragma unroll
                    for (int s = 0; s < 10; ++s) { const bf16x8 Kf = *(const LAS bf16x8*)(buf + (16 * k4 + l15) * KP + (32 * s + 8 * g4) * 2); S[k4] = MFMA16(Kf, Q[s], S[k4]); } }
                float mx = -1e30f;
#pragma unroll
                for (int k4 = 0; k4 < 4; ++k4)
#pragma unroll
                    for (int e = 0; e < 4; ++e) { float v = S[k4][e] * LOG2E; if (kt == nkt - 1 && 64 * kt + 16 * k4 + 4 * g4 + e > t0 + l15) v = -1e30f; S[k4][e] = v; mx = fmaxf(mx, v); }
                mx = fmaxf(mx, __shfl_xor(mx, 16)); mx = fmaxf(mx, __shfl_xor(mx, 32));
                const float mnew = fmaxf(mrun, mx), alpha = __builtin_amdgcn_exp2f(mrun - mnew); mrun = mnew;
                float ps = 0.f;
#pragma unroll
                for (int k4 = 0; k4 < 4; ++k4)
#pragma unroll
                    for (int e = 0; e < 4; ++e) { const float pv = __builtin_amdgcn_exp2f(S[k4][e] - mnew); S[k4][e] = pv; ps += pv; }
                lrun = lrun * alpha + ps;
#pragma unroll
                for (int vt = 0; vt < 16; ++vt) O[vt] *= alpha;
                bf16x8 Pf[2];
#pragma unroll
                for (int ks = 0; ks < 2; ++ks) Pf[ks] = as_bf16x8((u32x4){cvt_pk_bf16(S[2 * ks][0], S[2 * ks][1]), cvt_pk_bf16(S[2 * ks][2], S[2 * ks][3]), cvt_pk_bf16(S[2 * ks + 1][0], S[2 * ks + 1][1]), cvt_pk_bf16(S[2 * ks + 1][2], S[2 * ks + 1][3])});
#pragma unroll
                for (int vt = 0; vt < 16; ++vt)
#pragma unroll
                    for (int ks = 0; ks < 2; ++ks) {
                        const bf16x8 Vf = cat8(tr16(buf + (32 * ks + 4 * g4 + q4) * KP + (16 * vt + 4 * pp) * 2), tr16(buf + (32 * ks + 16 + 4 * g4 + q4) * KP + (16 * vt + 4 * pp) * 2));
                        O[vt] = MFMA16(Vf, Pf[ks], O[vt]); }
                if (kt + 1 < nkt) { LAS unsigned char* nb = p.lds + ((kt + 1) & 1) * TILE_B;
#pragma unroll
                    for (int q = 0; q < 5; ++q) { const int ch = tid + 512 * q, row = ch / 40, c16 = ch % 40; *(LAS u32x4*)(nb + row * KP + c16 * 16) = st[q]; } }
                __syncthreads();
            }
            const float linv = 1.0f / quad_red(lrun);
#pragma unroll
            for (int vt = 0; vt < 16; ++vt) { const f32x4 o = O[vt] * linv;
                *(u32x2*)(OB + rowq * 2048 + h * 256 + 16 * vt + 4 * g4) = (u32x2){cvt_pk_bf16(o[0], o[1]), cvt_pk_bf16(o[2], o[3])}; }
        }
    }
}

__device__ __forceinline__ void b3_attn_sample(const P& p) {
    const bf16* QF = p.w<bf16>(WS_QF); float* PART = p.w<float>(WS_PART); float* PML = p.w<float>(WS_PML);
    const float* cache = p.in[2]; const int* ptab = (const int*)p.in[5];
    const int tid = p.tid, lane = p.lane, w = p.wave, qt = w & 1, dvq = w >> 1, l15 = lane & 15, g4 = lane >> 4, q4 = (lane & 15) >> 2, pp = lane & 3;
    constexpr int TILE_B = 64 * KP;
    for (int u = p.bid; u < 256; u += p.G) {
        const int b = u >> 3, sp = u & 7;
        const int hq = 4 * qt + (l15 >> 2), iq = l15 & 3; const size_t rowq = (size_t)MP + 4 * b + iq;
        bf16x8 Q[10];
#pragma unroll
        for (int s = 0; s < 10; ++s) Q[s] = as_bf16x8(*(const u32x4*)(QF + rowq * 2560 + hq * 320 + 32 * s + 8 * g4));
        f32x4 O[4];
#pragma unroll
        for (int v = 0; v < 4; ++v) O[v] = (f32x4){0.f, 0.f, 0.f, 0.f};
        float mrun = -1e30f, lrun = 0.f;
        f32x4 st[10];
        auto tile_src = [&](int ti) -> const float* { const int pg = 16 * sp + (ti >> 1); return cache + ((size_t)ptab[b * 128 + pg] * 128 + 64 * (ti & 1)) * 320; };
        { const float* src = tile_src(0);
#pragma unroll
          for (int q = 0; q < 10; ++q) st[q] = __builtin_nontemporal_load((const f32x4*)(src + (size_t)(tid + 512 * q) * 4));
          __syncthreads();
#pragma unroll
          for (int q = 0; q < 10; ++q) { const int ch = tid + 512 * q, row = ch / 80, c4 = ch % 80; *(LAS u32x2*)(p.lds + row * KP + c4 * 8) = (u32x2){cvt_pk_bf16(st[q][0], st[q][1]), cvt_pk_bf16(st[q][2], st[q][3])}; }
          __syncthreads(); }
        for (int ti = 0; ti < 32; ++ti) {
            LAS unsigned char* buf = p.lds + (ti & 1) * TILE_B;
            if (ti + 1 < 32) { const float* src = tile_src(ti + 1);
#pragma unroll
                for (int q = 0; q < 10; ++q) st[q] = __builtin_nontemporal_load((const f32x4*)(src + (size_t)(tid + 512 * q) * 4)); }
            f32x4 S[4];
#pragma unroll
            for (int k4 = 0; k4 < 4; ++k4) { S[k4] = (f32x4){0.f, 0.f, 0.f, 0.f};
#pragma unroll
                for (int s = 0; s < 10; ++s) { const bf16x8 Kf = *(const LAS bf16x8*)(buf + (16 * k4 + l15) * KP + (32 * s + 8 * g4) * 2); S[k4] = MFMA16(Kf, Q[s], S[k4]); } }
            float mx = -1e30f;
#pragma unroll
            for (int k4 = 0; k4 < 4; ++k4)
#pragma unroll
                for (int e = 0; e < 4; ++e) { const float v = S[k4][e] * LOG2E; S[k4][e] = v; mx = fmaxf(mx, v); }
            mx = fmaxf(mx, __shfl_xor(mx, 16)); mx = fmaxf(mx, __shfl_xor(mx, 32));
            const float mnew = fmaxf(mrun, mx), alpha = __builtin_amdgcn_exp2f(mrun - mnew); mrun = mnew;
            float ps = 0.f;
#pragma unroll
            for (int k4 = 0; k4 < 4; ++k4)
#pragma unroll
                for (int e = 0; e < 4; ++e) { const float pv = __builtin_amdgcn_exp2f(S[k4][e] - mnew); S[k4][e] = pv; ps += pv; }
            lrun = lrun * alpha + ps;
#pragma unroll
            for (int v = 0; v < 4; ++v) O[v] *= alpha;
            bf16x8 Pf[2];
#pragma unroll
            for (int ks = 0; ks < 2; ++ks) Pf[ks] = as_bf16x8((u32x4){cvt_pk_bf16(S[2 * ks][0], S[2 * ks][1]), cvt_pk_bf16(S[2 * ks][2], S[2 * ks][3]), cvt_pk_bf16(S[2 * ks + 1][0], S[2 * ks + 1][1]), cvt_pk_bf16(S[2 * ks + 1][2], S[2 * ks + 1][3])});
#pragma unroll
            for (int v = 0; v < 4; ++v) { const int vt = 4 * dvq + v;
#pragma unroll
                for (int ks = 0; ks < 2; ++ks) {
                    const bf16x8 Vf = cat8(tr16(buf + (32 * ks + 4 * g4 + q4) * KP + (16 * vt + 4 * pp) * 2), tr16(buf + (32 * ks + 16 + 4 * g4 + q4) * KP + (16 * vt + 4 * pp) * 2));
                    O[v] = MFMA16(Vf, Pf[ks], O[v]); } }
            if (ti + 1 < 32) { LAS unsigned char* nb = p.lds + ((ti + 1) & 1) * TILE_B;
#pragma unroll
                for (int q = 0; q < 10; ++q) { const int ch = tid + 512 * q, row = ch / 80, c4 = ch % 80; *(LAS u32x2*)(nb + row * KP + c4 * 8) = (u32x2){cvt_pk_bf16(st[q][0], st[q][1]), cvt_pk_bf16(st[q][2], st[q][3])}; } }
            __syncthreads();
        }
        const float lsum = quad_red(lrun); const int qrow = 16 * qt + l15; const size_t pb = ((size_t)(b * 8 + sp) * 32 + qrow);
#pragma unroll
        for (int v = 0; v < 4; ++v) *(f32x4*)(PART + pb * 256 + 16 * (4 * dvq + v) + 4 * g4) = O[v];
        if (dvq == 0 && g4 == 0) { PML[pb * 2] = mrun; PML[pb * 2 + 1] = lsum; }
    }
}
__device__ __forceinline__ void b3_combine(const P& p) {
    const bf16* QF = p.w<bf16>(WS_QF); const bf16* KVB = p.w<bf16>(WS_KVB); bf16* OB = p.w<bf16>(WS_OB); const float* PART = p.w<float>(WS_PART); const float* PML = p.w<float>(WS_PML);
    const int dv = p.tid & 255, sub = p.tid >> 8;
    for (int it = 2 * p.bid + sub; it < 1024; it += 2 * p.G) {
        const int b = it >> 5, i = (it >> 3) & 3, h = it & 7, qt = h >> 2, ql = ((h & 3) << 2) | i, qrow = 16 * qt + ql; const size_t row = (size_t)MP + 4 * b + i;
        float sn[4];
#pragma unroll
        for (int kk = 0; kk < 4; ++kk) { float s = 0.f;
            if (kk <= i) { const unsigned* qp = (const unsigned*)(QF + row * 2560 + h * 320); const unsigned* kp = (const unsigned*)(KVB + ((size_t)MP + 4 * b + kk) * 320);
                for (int d = 0; d < 160; ++d) { const unsigned a = qp[d], c = kp[d]; s += bflo(a) * bflo(c) + bfhi(a) * bfhi(c); } }
            sn[kk] = (kk <= i) ? s * LOG2E : -1e30f; }
        float M = fmaxf(fmaxf(sn[0], sn[1]), fmaxf(sn[2], sn[3])); float ms[8], ls[8];
#pragma unroll
        for (int sp = 0; sp < 8; ++sp) { const size_t pb = ((size_t)(b * 8 + sp) * 32 + qrow); ms[sp] = PML[pb * 2]; ls[sp] = PML[pb * 2 + 1]; M = fmaxf(M, ms[sp]); }
        float L = 0.f, Oa = 0.f;
#pragma unroll
        for (int sp = 0; sp < 8; ++sp) { const size_t pb = ((size_t)(b * 8 + sp) * 32 + qrow); const float wgt = __builtin_amdgcn_exp2f(ms[sp] - M); L += ls[sp] * wgt; Oa += PART[pb * 256 + dv] * wgt; }
#pragma unroll
        for (int kk = 0; kk < 4; ++kk) { const float pk = __builtin_amdgcn_exp2f(sn[kk] - M); L += pk; Oa += pk * bf2f(KVB[((size_t)MP + 4 * b + kk) * 320 + dv]); }
        OB[row * 2048 + h * 256 + dv] = (bf16)f2bf(Oa / L);
    }
}

__device__ __forceinline__ f32x4 conv4(const float* XW, const float* cbuf  , const float* cw, const float* cb, int m, int c) {
    f32x4 acc = *(const f32x4*)(cb + c);
#pragma unroll
    for (int k = 0; k < 4; ++k) { f32x4 v = (f32x4){0.f, 0.f, 0.f, 0.f};
        if (m < MP) { const int t = m & 2047, r = t + k - 3; if (r >= 0) v = *(const f32x4*)(XW + (size_t)(m + k - 3) * 1280 + c); }
        else { const int b = (m - MP) >> 2, t = (m - MP) & 3, r = t + k - 3; if (r >= 0) v = *(const f32x4*)(XW + (size_t)(m + k - 3) * 1280 + c); else v = *(const f32x4*)(cbuf + ((size_t)b * 3 + (3 + r)) * 1280 + c); }
        acc += *(const f32x4*)(cw + k * 1280 + c) * v; }
    return acc;
}
__device__ __forceinline__ void c2_rglru(const P& p, int j, float* out_cp, float* out_cs) {
    const float* XW = p.w<float>(WS_XW); float* AA = p.w<float>(WS_AA); float* BB = p.w<float>(WS_BB);
    const float* cbuf = p.in[4] + (size_t)j * 32 * 3 * 1280; const float* cw = p.in[25] + (size_t)j * 4 * 1280; const float* cb = p.in[26] + j * 1280;
    const float* b_a = p.in[28] + j * 1280; const float* b_i = p.in[30] + j * 1280; const float* lam = p.in[31] + j * 1280;
    const bf16* WaT = p.w<bf16>(WS_WAT); const bf16* WiT = p.w<bf16>(WS_WIT);
    LAS unsigned char* Xt = p.lds; LAS unsigned char* At = p.lds + 128 * TP; LAS unsigned char* It = p.lds + 256 * TP;
    const int tid = p.tid, lane = p.lane, w = p.wave, l15 = lane & 15, g4 = lane >> 4;
    { const int gt = p.bid * 512 + tid, NGT = p.G * 512;
      for (int i = gt; i < (8 + 32) * 3 * 320; i += NGT) { const int c = (i % 320) * 4, rr = i / 320, jj = rr % 3, bb = rr / 3;
          if (bb < 8) { if (out_cp) *(f32x4*)(out_cp + ((size_t)bb * 3 + jj) * 1280 + c) = *(const f32x4*)(XW + ((size_t)bb * 2048 + 2045 + jj) * 1280 + c); }
          else { const int b = bb - 8; if (out_cs) *(f32x4*)(out_cs + ((size_t)b * 3 + jj) * 1280 + c) = *(const f32x4*)(XW + ((size_t)MP + 4 * b + 1 + jj) * 1280 + c); } } }
    for (int u = p.bid; u < 129 * 10; u += p.G) {
        const int T = u / 10, n = u % 10, row0 = T * 128;
#pragma unroll
        for (int q = 0; q < 4; ++q) { const int ch = tid + 512 * q, row = ch >> 4, c16 = ch & 15;
            *(LAS u32x4*)(At + row * TP + c16 * 16) = *(const u32x4*)(WaT + (size_t)n * 16384 + row * 128 + c16 * 8);
            *(LAS u32x4*)(It + row * TP + c16 * 16) = *(const u32x4*)(WiT + (size_t)n * 16384 + row * 128 + c16 * 8);
            const f32x4 v0 = conv4(XW, cbuf, cw, cb, row0 + row, n * 128 + c16 * 8), v1 = conv4(XW, cbuf, cw, cb, row0 + row, n * 128 + c16 * 8 + 4);
            *(LAS u32x4*)(Xt + row * TP + c16 * 16) = pack8(v0, v1); }
        __syncthreads();
        f32x4 ca[8], ci[8];
#pragma unroll
        for (int tt = 0; tt < 8; ++tt) { ca[tt] = (f32x4){0.f, 0.f, 0.f, 0.f}; ci[tt] = (f32x4){0.f, 0.f, 0.f, 0.f}; }
#pragma unroll
        for (int kk = 0; kk < 4; ++kk) {
            const bf16x8 Xa = *(const LAS bf16x8*)(At + (16 * w + l15) * TP + (32 * kk + 8 * g4) * 2), Xi = *(const LAS bf16x8*)(It + (16 * w + l15) * TP + (32 * kk + 8 * g4) * 2);
#pragma unroll
            for (int tt = 0; tt < 8; ++tt) { const bf16x8 Y = *(const LAS bf16x8*)(Xt + (16 * tt + l15) * TP + (32 * kk + 8 * g4) * 2);
                ca[tt] = MFMA16(Xa, Y, ca[tt]); ci[tt] = MFMA16(Xi, Y, ci[tt]); }
        }
        const int ch = n * 128 + 16 * w + 4 * g4;
        const f32x4 ba = *(const f32x4*)(b_a + ch), bi = *(const f32x4*)(b_i + ch), lm = *(const f32x4*)(lam + ch);
        f32x4 sp;
#pragma unroll
        for (int e = 0; e < 4; ++e) { const float nl = -lm[e]; sp[e] = (nl > 20.f) ? nl : log1pf(expf(nl)); }
#pragma unroll
        for (int tt = 0; tt < 8; ++tt) { const int m = row0 + 16 * tt + l15; const f32x4 xc = conv4(XW, cbuf, cw, cb, m, ch);
            f32x4 av, bv;
#pragma unroll
            for (int e = 0; e < 4; ++e) { const float r = 1.0f / (1.0f + expf(-(ca[tt][e] + ba[e]))), gi = 1.0f / (1.0f + expf(-(ci[tt][e] + bi[e])));
                const float la = -8.0f * r * sp[e]; av[e] = expf(la); bv[e] = sqrtf(-expm1f(2.0f * la)) * gi * xc[e]; }
            *(f32x4*)(AA + (size_t)m * 1280 + ch) = av; *(f32x4*)(BB + (size_t)m * 1280 + ch) = bv; }
        __syncthreads();
    }
}
__device__ __forceinline__ void c3_segagg(const P& p) {
    const float* AA = p.w<float>(WS_AA); const float* BB = p.w<float>(WS_BB); float* AGG = p.w<float>(WS_AGG);
    const int gt = p.bid * 512 + p.tid, NGT = p.G * 512;
    for (int i = gt; i < 8 * 32 * 1280; i += NGT) { const int ch = i % 1280, bs = i / 1280; const size_t m0 = (size_t)bs * 64;
        float P_ = 1.f, H_ = 0.f;
#pragma unroll 8
        for (int t = 0; t < 64; ++t) { const float a = AA[(m0 + t) * 1280 + ch], bt = BB[(m0 + t) * 1280 + ch]; H_ = a * H_ + bt; P_ *= a; }
        AGG[((size_t)bs * 2) * 1280 + ch] = P_; AGG[((size_t)bs * 2 + 1) * 1280 + ch] = H_; }
}
__device__ __forceinline__ void c5_scan(const P& p, int j, float* out_hp, float* out_hs) {
    const float* AA = p.w<float>(WS_AA); const float* BB = p.w<float>(WS_BB); const float* AGG = p.w<float>(WS_AGG); const bf16* GATE = p.w<bf16>(WS_GATE); bf16* GH = p.w<bf16>(WS_GH);
    const float* h0s = p.in[3] + (size_t)j * 32 * 1280;
    const int gt = p.bid * 512 + p.tid, NGT = p.G * 512;
    for (int i = gt; i < 8 * 32 * 1280 + 32 * 1280; i += NGT) {
        if (i < 8 * 32 * 1280) { const int ch = i % 1280, bs = i / 1280, seg = bs & 31, b = bs >> 5; const size_t m0 = (size_t)bs * 64;
            float h = 0.f;
            for (int s = 0; s < seg; ++s) { const size_t o = ((size_t)(b * 32 + s) * 2) * 1280 + ch; h = AGG[o] * h + AGG[o + 1280]; }
#pragma unroll 8
            for (int t = 0; t < 64; ++t) { const size_t o = (m0 + t) * 1280 + ch; h = AA[o] * h + BB[o]; GH[o] = (bf16)f2bf(bf2f(GATE[o]) * h); }
            if (seg == 31 && out_hp) out_hp[(size_t)b * 1280 + ch] = h;
        } else { const int k = i - 8 * 32 * 1280, ch = k % 1280, b = k / 1280; float h = h0s[(size_t)b * 1280 + ch];
#pragma unroll
            for (int t = 0; t < 4; ++t) { const size_t o = ((size_t)MP + 4 * b + t) * 1280 + ch; h = AA[o] * h + BB[o]; GH[o] = (bf16)f2bf(bf2f(GATE[o]) * h); }
            if (out_hs) out_hs[(size_t)b * 1280 + ch] = h; }
    }
}
__device__ __forceinline__ void final_norm(const P& p, float* out_yp, float* out_ys) {
    const float* H = p.w<float>(WS_H); const long long* ssq = p.stat(ST_SSQ0 + 8); const float* g = p.in[8];
    const int gw = p.bid * NWAVES + p.wave, NGW = p.G * NWAVES, lane = p.lane;
    for (int m = gw; m < MT; m += NGW) { float* o = m < MP ? out_yp + (size_t)m * 1024 : out_ys + (size_t)(m - MP) * 1024; const float rs = rsqrtf(stat_get(ssq + m) * (1.0f / 1024.0f) + RMS_EPS);
#pragma unroll
        for (int jj = 0; jj < 4; ++jj) { const int c = 4 * lane + 256 * jj; *(f32x4*)(o + c) = *(const f32x4*)(H + (size_t)m * 1024 + c) * rs * *(const f32x4*)(g + c); } }
}
}
namespace mk {
struct Args { const float* in[36]; float* out; unsigned char* ws; int ph_lo, ph_hi, li, pad; };
constexpr int NPHASE = 34;

#define MK_GEMM(EpiT, E, Aptr, LDA, Bptr, LDB, KD, NC) do { pg8::Gemm g_{(const pg8::bf16_t*)(Aptr), (const pg8::bf16_t*)(Bptr), (LDA), (LDB), (KD)}; pg8::StaticOrder S_; S_.init(MR, (NC), p.G, p.bid); \
        pg8::gemm_phase<EpiT, pg8::StaticOrder, true, true>(p.lds, g_, S_, E, p.tid); } while (0)

#define IN_(k) (lo <= (k) && (k) < hi)
#define PH_BEGIN() P p = p0; { unsigned char* w_ = p0.ws; float* o_ = p0.out; int t_ = p0.tid, g_ = p0.G, b_ = p0.bid; unsigned l_ = (unsigned)(size_t)p0.lds; asm volatile("" : "+s"(w_), "+s"(o_), "+v"(t_), "+s"(g_), "+s"(b_), "+s"(l_)); p.ws = w_; p.out = o_; p.tid = t_; p.lane = t_ & 63; p.wave = __builtin_amdgcn_readfirstlane(t_ >> 6); p.G = g_; p.bid = b_; p.lds = (LAS unsigned char*)(size_t)l_; } float* const out = p.out; (void)out
#define ENDPH(k) do { if ((k) + 1 < hi) xcd_barrier(bar); } while (0)
template <int LAYER> __device__ __forceinline__ void run_layer(const P& p0, const XcdBarrier& bar, const int lo, const int hi) {
        constexpr int layer = LAYER, kind = layer % 3, j = layer / 3, pb = 1 + 8 * layer;
        constexpr size_t resA = kind == 0 ? WS_UM : kind == 1 ? WS_OB : WS_GH, resB = kind == 0 ? WS_WOUT + (size_t)j * 2 * MiB : kind == 1 ? WS_WOV : WS_WCO; constexpr int resK = kind == 0 ? 1024 : kind == 1 ? 2048 : 1280;
        if constexpr (kind == 0) {
            if (IN_(pb)) { PH_BEGIN(); EpiA1 E{p.w<bf16>(WS_U), p.w<bf16>(WS_GV), p.stat(ST_SSQ0 + 2 * layer), p.stat(ST_LNS0 + 2 * j), p.stat(ST_LNQ0 + 2 * j)};
                MK_GEMM(EpiA1, E, p.w<bf16>(WS_HB), 1024, p.w<bf16>(WS_WIN + (size_t)j * 4 * MiB), 1024, 1024, 2048); ENDPH(pb); }
            if (IN_(pb + 1)) { PH_BEGIN(); a2_spatial(p, j, out + O_CV + (size_t)j * 131072); ENDPH(pb + 1); }
        } else if constexpr (kind == 1) {
            if (IN_(pb)) { PH_BEGIN(); EpiB1 E{p.w<float>(WS_RAW), p.w<bf16>(WS_CQB), p.stat(ST_SSQ0 + 2 * layer), p.stat(ST_KV), p.stat(ST_Q)};
                MK_GEMM(EpiB1, E, p.w<bf16>(WS_HB), 1024, p.w<bf16>(WS_WDQKV), 1024, 1024, 768); ENDPH(pb); }
            if (IN_(pb + 1)) { PH_BEGIN(); b2_kvfinal(p, out + O_MP, out + O_MS);
                EpiB2 E{p.w<bf16>(WS_QF), p.stat(ST_Q), p.w<f32x2>(WS_ROPE)};
                MK_GEMM(EpiB2, E, p.w<bf16>(WS_CQB), 384, p.w<bf16>(WS_WQ), 384, 384, 2560); ENDPH(pb + 1); }
            if (IN_(pb + 2)) { PH_BEGIN(); b3_attn_prompt(p); b3_attn_sample(p); ENDPH(pb + 2); }
            if (IN_(pb + 3)) { PH_BEGIN(); b3_combine(p); ENDPH(pb + 3); }
        } else {
            if (IN_(pb)) { PH_BEGIN(); EpiC1 E{p.w<bf16>(WS_GATE), p.w<float>(WS_XW), p.stat(ST_SSQ0 + 2 * layer)};
                MK_GEMM(EpiC1, E, p.w<bf16>(WS_HB), 1024, p.w<bf16>(WS_WGX), 1024, 1024, 2560); ENDPH(pb); }
            if (IN_(pb + 1)) { PH_BEGIN(); c2_rglru(p, j, out + O_CP, out + O_CS); ENDPH(pb + 1); }
            if (IN_(pb + 2)) { PH_BEGIN(); c3_segagg(p); ENDPH(pb + 2); }
            if (IN_(pb + 3)) { PH_BEGIN(); c5_scan(p, j, out + O_HP, out + O_HS); ENDPH(pb + 3); }
        }
        if (IN_(pb + 5)) { PH_BEGIN(); EpiRes E{p.w<float>(WS_H), p.w<bf16>(WS_HB), p.stat(ST_SSQ0 + 2 * layer + 1)}; MK_GEMM(EpiRes, E, p.w<bf16>(resA), resK, p.w<bf16>(resB), resK, resK, 1024); ENDPH(pb + 5); }
        if (IN_(pb + 6)) { PH_BEGIN(); EpiF1 E{p.w<bf16>(WS_ACT), p.stat(ST_SSQ0 + 2 * layer + 1)}; MK_GEMM(EpiF1, E, p.w<bf16>(WS_HB), 1024, p.w<bf16>(WS_WGU + (size_t)layer * WGU_BYTES), 1024, 1024, 5632); ENDPH(pb + 6); }
        if (IN_(pb + 7)) { PH_BEGIN(); EpiRes E{p.w<float>(WS_H), p.w<bf16>(WS_HB), p.stat(ST_SSQ0 + 2 * layer + 2)}; MK_GEMM(EpiRes, E, p.w<bf16>(WS_ACT), DFF, p.w<bf16>(WS_WD + (size_t)layer * WD_BYTES), DFF, DFF, 1024); ENDPH(pb + 7); }
}
__global__ void __launch_bounds__(NWAVES * 64, 2) mk_fwd(Args a) {
    extern __shared__ __attribute__((aligned(16))) unsigned char lds_raw[];
    const int tid_ = threadIdx.x;
    const P p0{InTab{(const float* const __attribute__((address_space(4)))*)__builtin_amdgcn_kernarg_segment_ptr()}, a.out, a.ws, (LAS unsigned char*)lds_raw, tid_, tid_ & 63, __builtin_amdgcn_readfirstlane(tid_ >> 6), (int)gridDim.x, (int)blockIdx.x};
    volatile LAS unsigned* MISC = (volatile LAS unsigned*)(p0.lds + MISC_OFF);
    if (p0.tid < 64) MISC[p0.tid] = 0u;
    __syncthreads();
    XcdBarrier bar = xcd_barrier_post((unsigned*)(a.ws + WS_CTL) + CW_BAR + a.li * XCD_BAR_WORDS, MISC + 8);
    const int lo = a.ph_lo, hi = a.ph_hi;
    if (IN_(0)) { PH_BEGIN(); p0_prologue(p);
        { const int gt = p.bid * 512 + p.tid, NGT = p.G * 512; const u32x4 z = (u32x4){0u, 0u, 0u, 0u};
          for (int i = gt; i < 128 * 128; i += NGT) p.w<u32x4>(WS_UM + (size_t)MT * 2048)[i] = z;
          for (int i = gt; i < 128 * 256; i += NGT) p.w<u32x4>(WS_OB + (size_t)MT * 4096)[i] = z;
          for (int i = gt; i < 128 * 160; i += NGT) p.w<u32x4>(WS_GH + (size_t)MT * 2560)[i] = z; }
        ENDPH(0); }
    run_layer<0>(p0, bar, lo, hi); run_layer<1>(p0, bar, lo, hi); run_layer<2>(p0, bar, lo, hi); run_layer<3>(p0, bar, lo, hi);
    if (IN_(33)) { PH_BEGIN(); final_norm(p, out + O_YP, out + O_YS); }
#undef IN_
#undef ENDPH
}

inline void fill_args(Args& a, void* const* d_in, float* out, void* d_ws) { for (int i = 0; i < 36; ++i) a.in[i] = (const float*)d_in[i]; a.out = out; a.ws = (unsigned char*)d_ws; a.pad = 0; }
inline int setup_grid() {
    static int grid = 0;
    if (!grid) { int dev = 0, cus = 0; hipGetDevice(&dev); hipDeviceGetAttribute(&cus, hipDeviceAttributeMultiprocessorCount, dev);
        hipFuncSetAttribute((const void*)mk_fwd, hipFuncAttributeMaxDynamicSharedMemorySize, LDS_BYTES);
        int per_cu = 0; hipOccupancyMaxActiveBlocksPerMultiprocessor(&per_cu, (const void*)mk_fwd, NWAVES * 64, LDS_BYTES); (void)hipGetLastError();
        grid = cus > 0 ? cus : 256; }
    return grid;
}
inline void launch_range(void* const* d_in, float* out, void* d_ws, hipStream_t st, int lo, int hi, int li) {
    Args a{}; fill_args(a, d_in, out, d_ws); a.ph_lo = lo; a.ph_hi = hi; a.li = li;
    hipLaunchKernelGGL(mk_fwd, dim3(setup_grid()), dim3(NWAVES * 64), LDS_BYTES, st, a);
}
}

extern "C" void kernel_launch(void* const* d_in, const int* in_sizes, int n_in, void* d_out, int out_size, void* d_ws, size_t ws_size, hipStream_t stream) {
    hipMemsetAsync(d_ws, 0, mk::CTL_BYTES, stream);
    mk::launch_range(d_in, (float*)d_out, d_ws, stream, 0, mk::NPHASE, 0);
}
```

```cpp
#include <hip/hip_runtime.h>
#include <math.h>
#define LAS __attribute__((address_space(3)))
#define GAS __attribute__((address_space(1)))
namespace pg8 {
#define PG8_LAS __attribute__((address_space(3)))
typedef unsigned short bf16_t;
typedef short bf16x8 __attribute__((ext_vector_type(8)));
typedef float f32x4 __attribute__((ext_vector_type(4)));
typedef unsigned u32x4 __attribute__((ext_vector_type(4)));
constexpr int BM = 256, BK = 64, HALF = 128, HTB = HALF * BK * 2  , STAGE_BYTES = 8 * HTB, NXCD = 8, WGM = 8;
__host__ __device__ __forceinline__ int lds_byte(int r, int c) { const int st = (r >> 4) * 2 + (c >> 5), rr = r & 15, cc = c & 31, ob = rr * 64 + cc * 2; return st * 1024 + (ob ^ (((ob >> 9) & 1) << 5)); }
__host__ __device__ __forceinline__ void stage_rc(int b, int& R, int& C) { const int st = b / 1024, sb = b % 1024, swz = sb ^ (((sb >> 9) & 1) << 5); R = (st >> 1) * 16 + swz / 64; C = (st & 1) * 32 + (swz % 64) / 2; }
__host__ __device__ __forceinline__ int perm32(int rho) { const int n = rho >> 4, i = rho & 15; return 8 * (i >> 2) + 4 * n + (i & 3); }
struct Unit { int pm, pn; };
struct Gemm { const bf16_t* A; const bf16_t* Bt; int lda, ldb, K; };
struct StaticOrder {
    int nM, nN, nwg, G, c;
    __host__ __device__ void init(int M, int N, int G_, int c_) { nM = M / BM; nN = N / BM; nwg = nM * nN; G = G_; c = c_; }
    __host__ __device__ bool next(int i, Unit& u) const {
        const long L = (long)i * G + c; if (L >= nwg) return false;
        int wgid = (int)L; { const int q = nwg / NXCD, r = nwg % NXCD, xcd = wgid % NXCD, off = wgid / NXCD; wgid = (xcd < r ? xcd * (q + 1) : r * (q + 1) + (xcd - r) * q) + off; }
        const int nig = WGM * nN, gid = wgid / nig, fm = gid * WGM, gsz = (nM - fm) < WGM ? (nM - fm) : WGM;
        u.pm = fm + ((wgid % nig) % gsz); u.pn = (wgid % nig) / gsz; return true;
    }
    __device__ __forceinline__ void a_ready(const Unit&) const {}
    __device__ __forceinline__ void done(const Unit&) const {}
};
__device__ __forceinline__ unsigned cvt_pk_bf16(float lo, float hi) { unsigned r; asm volatile("v_cvt_pk_bf16_f32 %0, %1, %2" : "=v"(r) : "v"(lo), "v"(hi)); return r; }
template <class Epi, class Sched, bool ALIGN_EPI = false, bool SP2 = false>
__device__ __forceinline__ void gemm_phase(PG8_LAS unsigned char* lds, const Gemm g, const Sched& S, const Epi& E, const int tid) {
    const int wid = __builtin_amdgcn_readfirstlane(tid >> 6), lane = tid & 63, wr = wid >> 2, wc = wid & 3, fr = lane & 15, fq = lane >> 4;
    const int K = g.K, nt = K / BK, lda = g.lda, ldb = g.ldb;
    unsigned voffA[2], voffB[2];
#pragma unroll
    for (int i = 0; i < 2; ++i) { int R, C; stage_rc(tid * 16 + i * 8192, R, C); const int Rb = Epi::PERM ? ((R & ~31) + perm32(R & 31)) : R;
        voffA[i] = (unsigned)(R * lda + C) * 2u; voffB[i] = (unsigned)(Rb * ldb + C) * 2u; }
    const size_t kstep = (size_t)(BK * 2);
    const size_t hstepA = (size_t)HALF * lda * 2, hstepB = (size_t)HALF * ldb * 2;
    const size_t tstepA = 2 * hstepA, tstepB = 2 * hstepB;
    const unsigned ldsw = (unsigned)wid * 1024u;
    const int aoff = lds_byte(wr * 64 + fr, fq * 8), boff = lds_byte(wc * 32 + fr, fq * 8);
#define PG8_SA(b, h) (((b) * 2 + (h)) * HTB)
#define PG8_SB(b, h) ((4 + (b) * 2 + (h)) * HTB)
#define PG8_STAGE(bufoff, gbase, voff) do { _Pragma("unroll") for (int _i = 0; _i < 2; ++_i) \
        __builtin_amdgcn_global_load_lds((const unsigned*)((const char*)(gbase) + (voff)[_i]), (PG8_LAS unsigned*)(lds + (bufoff) + ldsw + _i * 8192), 16, 0, 0); } while (0)
#define PG8_LDA(dst, b, h) do { _Pragma("unroll") for (int m = 0; m < 4; ++m) _Pragma("unroll") for (int k = 0; k < 2; ++k) dst[m][k] = *(const PG8_LAS bf16x8*)(lds + PG8_SA(b, h) + aoff + m * 2048 + k * 1024); } while (0)
#define PG8_LDB(dst, b, h) do { _Pragma("unroll") for (int n = 0; n < 2; ++n) _Pragma("unroll") for (int k = 0; k < 2; ++k) dst[n][k] = *(const PG8_LAS bf16x8*)(lds + PG8_SB(b, h) + boff + n * 2048 + k * 1024); } while (0)
#define PG8_MMA(ai, bj, At, Bt) do { __builtin_amdgcn_s_setprio(1); _Pragma("unroll") for (int m = 0; m < 4; ++m) _Pragma("unroll") for (int n = 0; n < 2; ++n) _Pragma("unroll") for (int k = 0; k < 2; ++k) \
        acc[ai][bj][m][n] = __builtin_amdgcn_mfma_f32_16x16x32_bf16(Bt[n][k], At[m][k], acc[ai][bj][m][n], 0, 0, 0); __builtin_amdgcn_s_setprio(0); } while (0)
#define PG8_WAIT_V(n) asm volatile("s_waitcnt vmcnt(" #n ")" ::: "memory")
#define PG8_WAIT_L(n) asm volatile("s_waitcnt lgkmcnt(" #n ")" ::: "memory")
#define PG8_BAR __builtin_amdgcn_s_barrier()
#define PG8_SCHED __builtin_amdgcn_sched_barrier(0)
    Unit cur, nxt; int ui = 0;
    if (!S.next(0, cur)) return;
    f32x4 acc[2][2][4][2];
#pragma unroll
    for (int a = 0; a < 2; ++a)
#pragma unroll
        for (int b = 0; b < 2; ++b)
#pragma unroll
            for (int m = 0; m < 4; ++m)
#pragma unroll
                for (int n = 0; n < 2; ++n) acc[a][b][m][n] = (f32x4){0.f, 0.f, 0.f, 0.f};
    bf16x8 At[4][2], B0[2][2], B1[2][2];
    const char* cA = (const char*)g.A + (size_t)cur.pm * tstepA; const char* cB = (const char*)g.Bt + (size_t)cur.pn * tstepB;
    S.a_ready(cur);
    if constexpr (SP2) {
        PG8_STAGE(PG8_SB(0, 0), cB, voffB); PG8_STAGE(PG8_SB(0, 1), cB + hstepB, voffB); PG8_STAGE(PG8_SA(0, 0), cA, voffA); PG8_STAGE(PG8_SA(0, 1), cA + hstepA, voffA);
        if (wr == 1) PG8_BAR;
        PG8_WAIT_V(2); PG8_BAR;
        PG8_STAGE(PG8_SB(1, 0), cB + kstep, voffB); PG8_STAGE(PG8_SA(1, 0), cA + kstep, voffA); PG8_STAGE(PG8_SB(1, 1), cB + hstepB + kstep, voffB);
        PG8_WAIT_V(6); PG8_BAR;
    } else {
        PG8_STAGE(PG8_SB(0, 0), cB, voffB); PG8_STAGE(PG8_SA(0, 0), cA, voffA); PG8_STAGE(PG8_SB(0, 1), cB + hstepB, voffB); PG8_STAGE(PG8_SA(0, 1), cA + hstepA, voffA);
        if (wr == 1) PG8_BAR;
        PG8_WAIT_V(4); PG8_BAR;
        PG8_STAGE(PG8_SB(1, 0), cB + kstep, voffB); PG8_STAGE(PG8_SA(1, 0), cA + kstep, voffA); PG8_STAGE(PG8_SB(1, 1), cB + hstepB + kstep, voffB);
        PG8_WAIT_V(6); PG8_BAR;
    }
    for (;;) {
        const bool has_next = S.next(ui + 1, nxt);
        const char* nA = has_next ? (const char*)g.A + (size_t)nxt.pm * tstepA : cA; const char* nB = has_next ? (const char*)g.Bt + (size_t)nxt.pn * tstepB : cB;
        for (int t = 0; t < nt; t += 2) {
            const bool last = (t == nt - 2);
            const char* a1 = cA + (size_t)(t + 1) * kstep;
            const char* a2 = last ? nA : cA + (size_t)(t + 2) * kstep; const char* b2 = last ? nB : cB + (size_t)(t + 2) * kstep;
            const char* a3 = a2 + kstep; const char* b3 = b2 + kstep;
            if (last && has_next) S.a_ready(nxt);
            if constexpr (SP2) {
            PG8_LDB(B0, 0, 0); PG8_LDB(B1, 0, 1); PG8_SCHED; PG8_LDA(At, 0, 0); PG8_STAGE(PG8_SA(1, 1), a1 + hstepA, voffA);
            PG8_WAIT_V(8); PG8_WAIT_L(0); PG8_BAR; PG8_MMA(0, 0, At, B0); PG8_MMA(0, 1, At, B1); PG8_BAR; PG8_SCHED;
            PG8_LDA(At, 0, 1); PG8_STAGE(PG8_SB(0, 0), b2, voffB); PG8_STAGE(PG8_SB(0, 1), b2 + hstepB, voffB); PG8_STAGE(PG8_SA(0, 0), a2, voffA);
            PG8_WAIT_V(8); PG8_WAIT_L(0); PG8_BAR; PG8_MMA(1, 0, At, B0); PG8_MMA(1, 1, At, B1); PG8_BAR; PG8_SCHED;
            PG8_LDB(B0, 1, 0); PG8_LDB(B1, 1, 1); PG8_SCHED; PG8_LDA(At, 1, 0); PG8_STAGE(PG8_SA(0, 1), a2 + hstepA, voffA);
            PG8_WAIT_V(8); PG8_WAIT_L(0); PG8_BAR; PG8_MMA(0, 0, At, B0); PG8_MMA(0, 1, At, B1); PG8_BAR; PG8_SCHED;
            PG8_LDA(At, 1, 1); PG8_STAGE(PG8_SB(1, 0), b3, voffB); PG8_STAGE(PG8_SB(1, 1), b3 + hstepB, voffB); PG8_STAGE(PG8_SA(1, 0), a3, voffA);
            PG8_WAIT_V(8); PG8_WAIT_L(0); PG8_BAR; PG8_MMA(1, 0, At, B0); PG8_MMA(1, 1, At, B1); PG8_BAR; PG8_SCHED;
            } else {
            PG8_LDB(B0, 0, 0); PG8_SCHED; PG8_LDA(At, 0, 0); PG8_STAGE(PG8_SA(1, 1), a1 + hstepA, voffA);
            PG8_WAIT_L(8); PG8_BAR; PG8_WAIT_L(0); PG8_MMA(0, 0, At, B0); PG8_BAR; PG8_SCHED;
            PG8_LDB(B1, 0, 1); PG8_STAGE(PG8_SB(0, 0), b2, voffB);
            PG8_BAR; PG8_WAIT_L(0); PG8_MMA(0, 1, At, B1); PG8_BAR;
            PG8_LDA(At, 0, 1); PG8_STAGE(PG8_SA(0, 0), a2, voffA);
            PG8_BAR; PG8_WAIT_L(0); PG8_MMA(1, 0, At, B0); PG8_BAR; PG8_SCHED;
            PG8_STAGE(PG8_SB(0, 1), b2 + hstepB, voffB);
            PG8_WAIT_V(6); PG8_BAR; PG8_MMA(1, 1, At, B1); PG8_BAR;
            PG8_LDB(B0, 1, 0); PG8_SCHED; PG8_LDA(At, 1, 0); PG8_STAGE(PG8_SA(0, 1), a2 + hstepA, voffA);
            PG8_WAIT_L(8); PG8_BAR; PG8_WAIT_L(0); PG8_MMA(0, 0, At, B0); PG8_BAR; PG8_SCHED;
            PG8_LDB(B1, 1, 1); PG8_STAGE(PG8_SB(1, 0), b3, voffB);
            PG8_BAR; PG8_WAIT_L(0); PG8_MMA(0, 1, At, B1); PG8_BAR;
            PG8_LDA(At, 1, 1); PG8_STAGE(PG8_SA(1, 0), a3, voffA);
            PG8_BAR; PG8_WAIT_L(0); PG8_MMA(1, 0, At, B0); PG8_BAR; PG8_SCHED;
            PG8_STAGE(PG8_SB(1, 1), b3 + hstepB, voffB);
            PG8_WAIT_V(6); PG8_BAR; PG8_MMA(1, 1, At, B1); PG8_BAR;
            }
        }
        if constexpr (ALIGN_EPI) { if (wr == 0) PG8_BAR; }
        if constexpr (!Epi::AFTER_DRAIN) { E(acc, cur, wr, wc, fr, fq); S.done(cur); }
        if (!has_next) break;
#pragma unroll
        for (int a = 0; a < 2; ++a)
#pragma unroll
            for (int b = 0; b < 2; ++b)
#pragma unroll
                for (int m = 0; m < 4; ++m)
#pragma unroll
                    for (int n = 0; n < 2; ++n) acc[a][b][m][n] = (f32x4){0.f, 0.f, 0.f, 0.f};
        cur = nxt; cA = nA; cB = nB; ++ui;
        if constexpr (ALIGN_EPI) { if (wr == 1) PG8_BAR; }
    }
    PG8_WAIT_V(0);
    if constexpr (!ALIGN_EPI) { if (wr == 0) PG8_BAR; }
    PG8_BAR;
    if constexpr (Epi::AFTER_DRAIN) { E.fused(acc, cur, wr, wc, fr, fq, lds, wid, lane); S.done(cur); }
#undef PG8_SA
#undef PG8_SB
#undef PG8_STAGE
#undef PG8_LDA
#undef PG8_LDB
#undef PG8_MMA
#undef PG8_WAIT_V
#undef PG8_WAIT_L
#undef PG8_BAR
#undef PG8_SCHED
}

}

namespace mk {
using pg8::f32x4; using pg8::bf16x8; using pg8::u32x4; using pg8::cvt_pk_bf16;
typedef unsigned short bf16;
typedef unsigned u32x2 __attribute__((ext_vector_type(2)));
typedef short s16x4 __attribute__((ext_vector_type(4)));
typedef float f32x2 __attribute__((ext_vector_type(2)));
typedef GAS unsigned gu32;
#define RLX_AGENT __ATOMIC_RELAXED, __HIP_MEMORY_SCOPE_AGENT
#define XB_TMO      128
#define XB_XCNT(j)  (256  + 64 * (j))
#define XB_XSUB(j)  (1280 + 64 * (j))
#define XB_XGEN(j)  (2304 + 64 * (j))
#define XB_TOP      3328
#define XB_TOPGEN   3392
#define XCD_BAR_WORDS 3456
#define XB_SPIN_CAP (1u << 18)

__device__ __forceinline__ unsigned xb_ld(unsigned* p)              { return __hip_atomic_load(p, __ATOMIC_RELAXED, __HIP_MEMORY_SCOPE_AGENT); }
__device__ __forceinline__ unsigned xb_add(unsigned* p, unsigned v) { return __hip_atomic_fetch_add(p, v, __ATOMIC_RELAXED, __HIP_MEMORY_SCOPE_AGENT); }
__device__ __forceinline__ unsigned xb_xcc_id() { return (unsigned)__builtin_amdgcn_s_getreg((3 << 11) | 20) & 0xFu; }
#define XB_SPIN(cond, bar) do { unsigned _sp = 0; while (cond) { __builtin_amdgcn_s_sleep(1); \
    if ((++_sp & 255u) == 0u) { if (xb_ld(&(bar)[XB_TMO])) break; if (_sp > XB_SPIN_CAP) { atomicAdd(&(bar)[XB_TMO], 1u); break; } } } } while (0)

struct XcdBarrier {
    unsigned* bar; unsigned x;
    volatile LAS unsigned* st;
};

__device__ __forceinline__ XcdBarrier xcd_barrier_post(unsigned* bar, volatile LAS unsigned* st) {
    XcdBarrier b; b.bar = bar; b.x = xb_xcc_id(); b.st = st;
    if (threadIdx.x == 0) (void)xb_add(&bar[XB_XCNT(b.x)], 1u);
    return b;
}
__device__ __forceinline__ void xcd_barrier_complete(unsigned* bar, unsigned x, unsigned& nloc, unsigned& nx) {
    const unsigned G = gridDim.x * gridDim.y * gridDim.z;
    unsigned sum, cnt, mine, sp = 0u;
    for (;;) {
        sum = 0u; cnt = 0u; mine = 0u;
#pragma unroll
        for (unsigned j = 0; j < 16; ++j) { const unsigned c = xb_ld(&bar[XB_XCNT(j)]); sum += c; cnt += (c > 0u) ? 1u : 0u; mine = (j == x) ? c : mine; }
        if (sum == G) break;
        __builtin_amdgcn_s_sleep(1);
        if ((++sp & 255u) == 0u) { if (xb_ld(&bar[XB_TMO])) break; if (sp > XB_SPIN_CAP) { atomicAdd(&bar[XB_TMO], 1u); break; } }
    }
    nloc = mine > 0u ? mine : 1u; nx = cnt > 0u ? cnt : 1u;
}

__device__ __forceinline__ void xcd_barrier(const XcdBarrier& b) {
    asm volatile("s_waitcnt vmcnt(0)" ::: "memory");
    __syncthreads();
    if (threadIdx.x == 0) {
        unsigned* bar = b.bar;
        __builtin_amdgcn_s_waitcnt(0);
        unsigned nloc = b.st[0], nx = b.st[1];
        if (nloc == 0u) { xcd_barrier_complete(bar, b.x, nloc, nx); b.st[0] = nloc; b.st[1] = nx; }
        const unsigned old = xb_add(&bar[XB_XSUB(b.x)], 1u);
        const unsigned gen = old / nloc;
        if (old + 1u == (gen + 1u) * nloc) {
            __builtin_amdgcn_fence(__ATOMIC_RELEASE, "agent");
            asm volatile("s_waitcnt vmcnt(0)" ::: "memory");
            const unsigned og = xb_add(&bar[XB_TOP], 1u);
            const unsigned tg = og / nx;
            if (og + 1u == (tg + 1u) * nx) xb_add(&bar[XB_TOPGEN], 1u);
            else XB_SPIN(xb_ld(&bar[XB_TOPGEN]) == tg, bar);
            __builtin_amdgcn_fence(__ATOMIC_ACQUIRE, "agent");
            xb_add(&bar[XB_XGEN(b.x)], 1u);
            asm volatile("s_waitcnt vmcnt(0)" ::: "memory");
        } else {
            XB_SPIN(xb_ld(&bar[XB_XGEN(b.x)]) == gen, bar);
            __builtin_amdgcn_fence(__ATOMIC_ACQUIRE, "agent");
            asm volatile("s_waitcnt vmcnt(0)" ::: "memory");
        }
    }
    __syncthreads();
}


constexpr int MP = 16384, MS = 128, MT = MP + MS, MR = 16640;
constexpr int D = 1024, DFF = 2816, NWAVES = 8;
constexpr float RMS_EPS = 1e-6f, LN_EPS = 1e-5f;
constexpr float MLA_SCALE = 0.07216878364870322f;
constexpr size_t MiB = 1u << 20;
constexpr size_t WS_CTL = 0, CTL_BYTES = 3 * MiB;
constexpr int CW_BAR = 4096;
constexpr size_t ST_OFF = 65536, ST_STRIDE = (size_t)MR * 8;
constexpr int ST_SSQ0 = 0  , ST_LNS0 = 9, ST_LNQ0 = 10  , ST_KV = 13, ST_Q = 14, NSTAT = 15;
static_assert(ST_OFF + NSTAT * ST_STRIDE <= CTL_BYTES, "stats inside CTL");
constexpr size_t WS_WGU = 3 * MiB, WGU_BYTES = 11 * MiB, WS_WD = 47 * MiB, WD_BYTES = 5767168, WS_WIN = 69 * MiB, WS_WOUT = 77 * MiB, WS_WS = 81 * MiB,
                 WS_WDQKV = 82 * MiB, WS_WQ = 84 * MiB, WS_WOV = 86 * MiB, WS_WGX = 90 * MiB, WS_WAT = 95 * MiB, WS_WIT = 95 * MiB + 512 * 1024, WS_WCO = 96 * MiB, WS_ROPE = 99 * MiB;
constexpr size_t WS_H = 100 * MiB, WS_HB = 165 * MiB, WS_U = 198 * MiB, WS_GV = 231 * MiB, WS_UM = 264 * MiB, WS_ACT = 297 * MiB, WS_RAW = 387 * MiB, WS_CQB = 436 * MiB,
                 WS_QF = 449 * MiB, WS_KVB = 531 * MiB, WS_OB = 542 * MiB, WS_PART = 607 * MiB, WS_PML = 623 * MiB, WS_GATE = 624 * MiB, WS_XW = 665 * MiB, WS_AA = 747 * MiB, WS_BB = 829 * MiB,
                 WS_AGG = 911 * MiB, WS_GH = 914 * MiB, WS_PROF = 955 * MiB, WS_MK_END = 956 * MiB;
constexpr int RING_BYTES = 131072, MISC_OFF = RING_BYTES, LDS_BYTES = 147456;
constexpr size_t O_YP = 0, O_YS = 16777216, O_CV = 16908288, O_MP = 17170432, O_MS = 22413312, O_HP = 22454272, O_HS = 22464512, O_CP = 22505472, O_CS = 22536192, O_END = 22659072;

__device__ __forceinline__ float fast_sigmoid_l2(float t) { return __builtin_amdgcn_rcpf(1.0f + __builtin_amdgcn_exp2f(-t)); }
__device__ __forceinline__ float gelu_tanh_f(float x) { return x * fast_sigmoid_l2(2.302208198f * (x + 0.044715f * x * x * x)); }
__device__ __forceinline__ float silu_f(float x) { return x * fast_sigmoid_l2(1.4426950409f * x); }
__device__ __forceinline__ unsigned f2bf(float f) { unsigned u = __builtin_bit_cast(unsigned, f); return (u + 0x7fffu + ((u >> 16) & 1u)) >> 16; }
__device__ __forceinline__ unsigned pk2(float lo, float hi) { return f2bf(lo) | (f2bf(hi) << 16); }
__device__ __forceinline__ float bf2f(unsigned short b) { return __builtin_bit_cast(float, (unsigned)b << 16); }
__device__ __forceinline__ float bflo(unsigned w) { return __builtin_bit_cast(float, w << 16); }
__device__ __forceinline__ float bfhi(unsigned w) { return __builtin_bit_cast(float, w & 0xffff0000u); }
constexpr float ST_SCALE = 16777216.0f, ST_INV = 1.0f / 16777216.0f;
__device__ __forceinline__ void stat_add(long long* p, float v) { atomicAdd((unsigned long long*)p, (unsigned long long)(long long)__float2ll_rn(v * ST_SCALE)); }
__device__ __forceinline__ void stat_set(long long* p, float v) { *p = (long long)__float2ll_rn(v * ST_SCALE); }
__device__ __forceinline__ float stat_get(const long long* p) { return (float)(*p) * ST_INV; }
#define LDS_WAIT() asm volatile("s_waitcnt lgkmcnt(0)" ::: "memory")
#define VM_WAIT() asm volatile("s_waitcnt vmcnt(0)" ::: "memory")

struct InTab { const float* const __attribute__((address_space(4)))* t; __device__ __forceinline__ const float* operator[](int i) const { return t[i]; } };
struct P {
    InTab in; float* out; unsigned char* ws;
    LAS unsigned char* lds; int tid, lane, wave, G, bid;
    __device__ __forceinline__ long long* stat(int a) const { return (long long*)(ws + ST_OFF + (size_t)a * ST_STRIDE); }
    template <class T> __device__ __forceinline__ T* w(size_t off) const { return (T*)(ws + off); }
};
}
namespace mk {
struct TrJob { const float* src; int ldsrc, K, N; bf16* dst; int lddst; const float* gain; int kind, off; };
__device__ __forceinline__ int tr_rowmap(int kind, int off, int n) { return kind == 1 ? ((n >> 7) * 256 + (n & 127) + off) : (off + n); }
__device__ __forceinline__ void tr_item(const TrJob& j, LAS float* scr, int item, int lane) {
    const int nblk = j.N / 32, kb = item / nblk, nb = item % nblk, k0 = 64 * kb, n0 = 32 * nb;
    const float* src = j.src + (size_t)(k0 + (lane >> 5)) * j.ldsrc + n0 + (lane & 31); const size_t rstep = (size_t)2 * j.ldsrc;
    float v[32];
#pragma unroll
    for (int i = 0; i < 32; ++i) v[i] = src[i * rstep];
    if (j.gain) { const float* gp = j.gain + k0 + (lane >> 5); float g[32];
#pragma unroll
        for (int i = 0; i < 32; ++i) g[i] = gp[2 * i];
#pragma unroll
        for (int i = 0; i < 32; ++i) v[i] *= g[i]; }
#pragma unroll
    for (int i = 0; i < 32; ++i) scr[(2 * i + (lane >> 5)) * 33 + (lane & 31)] = v[i];
    LDS_WAIT(); asm volatile("" ::: "memory");
    const int c = lane & 7;
#pragma unroll
    for (int jj = 0; jj < 4; ++jj) { const int n = (lane >> 3) + 8 * jj; const LAS float* s = scr + (8 * c) * 33 + n;
        u32x4 o; o.x = pk2(s[0], s[33]); o.y = pk2(s[66], s[99]); o.z = pk2(s[132], s[165]); o.w = pk2(s[198], s[231]);
        *(u32x4*)(j.dst + (size_t)tr_rowmap(j.kind, j.off, n0 + n) * j.lddst + k0 + 8 * c) = o; }
    LDS_WAIT(); asm volatile("" ::: "memory");
}
constexpr int NJOBS = 24;
__device__ __forceinline__ TrJob get_job(const P& p, int jid) {
    TrJob j; j.gain = nullptr; j.kind = 0; j.off = 0; j.src = nullptr; j.dst = nullptr; j.ldsrc = 0; j.K = 0; j.N = 0; j.lddst = 0;
    if (jid < 12) { const int l = jid / 3, t = jid % 3;
        if (t < 2) { j.src = p.in[33 + t] + (size_t)l * D * DFF; j.ldsrc = DFF; j.K = D; j.N = DFF; j.dst = p.w<bf16>(WS_WGU + l * WGU_BYTES); j.lddst = D; j.gain = p.in[7] + l * D; j.kind = 1; j.off = 128 * t; }
        else { j.src = p.in[35] + (size_t)l * DFF * D; j.ldsrc = D; j.K = DFF; j.N = D; j.dst = p.w<bf16>(WS_WD + l * WD_BYTES); j.lddst = DFF; }
    } else if (jid < 16) { const int a = (jid - 12) >> 1;
        if (((jid - 12) & 1) == 0) { j.src = p.in[9] + (size_t)a * D * 2048; j.ldsrc = 2048; j.K = D; j.N = 2048; j.dst = p.w<bf16>(WS_WIN + a * 4 * MiB); j.lddst = D; j.gain = p.in[6] + (3 * a) * D; }
        else { j.src = p.in[14] + (size_t)a * D * D; j.ldsrc = D; j.K = D; j.N = D; j.dst = p.w<bf16>(WS_WOUT + a * 2 * MiB); j.lddst = D; }
    } else if (jid == 16) { j.src = p.in[15]; j.ldsrc = 384; j.K = D; j.N = 384; j.dst = p.w<bf16>(WS_WDQKV); j.lddst = D; j.gain = p.in[6] + D; j.off = 256; }
    else if (jid == 17) { j.src = p.in[18]; j.ldsrc = 320; j.K = D; j.N = 256; j.dst = p.w<bf16>(WS_WDQKV); j.lddst = D; j.gain = p.in[6] + D; j.off = 0; }
    else if (jid == 18) { j.src = p.in[18] + 256; j.ldsrc = 320; j.K = D; j.N = 64; j.dst = p.w<bf16>(WS_WDQKV); j.lddst = D; j.gain = p.in[6] + D; j.off = 640; }
    else if (jid == 19) { j.src = p.in[24]; j.ldsrc = 1280; j.K = D; j.N = 1280; j.dst = p.w<bf16>(WS_WGX); j.lddst = D; j.gain = p.in[6] + 2 * D; j.off = 0; }
    else if (jid == 20) { j.src = p.in[23]; j.ldsrc = 1280; j.K = D; j.N = 1280; j.dst = p.w<bf16>(WS_WGX); j.lddst = D; j.gain = p.in[6] + 2 * D; j.off = 1280; }
    else if (jid == 21) { j.src = p.in[32]; j.ldsrc = D; j.K = 1280; j.N = D; j.dst = p.w<bf16>(WS_WCO); j.lddst = 1280; }
    else if (jid == 22) { j.src = p.in[27]; j.ldsrc = 128; j.K = 128; j.N = 128; j.dst = p.w<bf16>(WS_WAT); j.lddst = 128; j.kind = 2; }
    else { j.src = p.in[29]; j.ldsrc = 128; j.K = 128; j.N = 128; j.dst = p.w<bf16>(WS_WIT); j.lddst = 128; j.kind = 2; }
    return j;
}
__device__ __forceinline__ int job_items(const TrJob& j) { return j.kind == 2 ? 80 : (j.K / 64) * (j.N / 32); }

__device__ __forceinline__ void p0_prologue(const P& p, const int mask) {
    LAS float* scr = (LAS float*)(p.lds + p.wave * 16384);
    const int gw = p.bid * NWAVES + p.wave, NGW = p.G * NWAVES, lane = p.lane;
    const int gt = p.bid * (NWAVES * 64) + p.tid, NGT = p.G * NWAVES * 64;
    if (mask & 1) {
    {
        int base = 0;
        for (int jid = 0; jid < NJOBS; ++jid) {
            TrJob j = get_job(p, jid); const int nit = job_items(j);
            int first = (gw - base % NGW + NGW) % NGW;
            for (int it = first; it < nit; it += NGW) {
                if (j.kind == 2) { TrJob b = j; const int blk = it >> 3; b.src = j.src + (size_t)blk * 16384; b.dst = j.dst + (size_t)blk * 16384; b.kind = 0; tr_item(b, scr, it & 7, lane); }
                else tr_item(j, scr, it, lane);
            }
            base += nit;
        }
    }
    }
    if (mask & 2) {
    { u32x4* z = (u32x4*)(p.w<bf16>(WS_WDQKV) + (size_t)704 * D); for (int i = gt; i < 64 * D / 8; i += NGT) z[i] = (u32x4){0u, 0u, 0u, 0u}; }
    }
    if (mask & 4) {
    for (int i = gt; i < 2 * 8 * 128 * 16; i += NGT) {
        const int s0 = (i & 15) * 8, t = (i >> 4) & 127, jg = i >> 11; const float* src = p.in[12] + (size_t)jg * 16384;
        unsigned w[4], ws_[4];
#pragma unroll
        for (int e = 0; e < 4; ++e) { float v[2], vs[2];
#pragma unroll
            for (int h = 0; h < 2; ++h) { const int s = s0 + 2 * e + h; v[h] = (s <= t) ? src[t * 128 + s] : 0.f; vs[h] = ((s >> 2) == (t >> 2) && (s & 3) <= (t & 3)) ? src[(t & 3) * 128 + (s & 3)] : 0.f; }
            w[e] = pk2(v[0], v[1]); ws_[e] = pk2(vs[0], vs[1]); }
        const int j = jg >> 3, g = jg & 7;
        *(u32x4*)(p.w<bf16>(WS_WS + (size_t)j * 262144) + ((size_t)g * 128 + t) * 128 + s0) = (u32x4){w[0], w[1], w[2], w[3]};
        *(u32x4*)(p.w<bf16>(WS_WS + 524288 + (size_t)j * 262144) + ((size_t)g * 128 + t) * 128 + s0) = (u32x4){ws_[0], ws_[1], ws_[2], ws_[3]};
    }
    }
    if (mask & 8) {
    for (int i = gt; i < 2052 * 32; i += NGT) { const int tp = i >> 5, fi = i & 31, pos = tp < 2048 ? tp : 16384 + (tp - 2048);
        const float inv = 1.0f / powf(10000.0f, (float)(2 * fi) / 64.0f); const float ang = (float)pos * inv;
        p.w<f32x2>(WS_ROPE)[i] = (f32x2){cosf(ang), sinf(ang)}; }
    }
    if (mask & 16) {
    { float* H = p.w<float>(WS_H); bf16* HB = p.w<bf16>(WS_HB); long long* ssq = p.stat(ST_SSQ0);
      for (int m = gw; m < MR; m += NGW) {
        f32x4 v[4]; float s = 0.f;
#pragma unroll
        for (int jj = 0; jj < 4; ++jj) { const int c = 4 * lane + 256 * jj;
            if (m < MP) v[jj] = *(const f32x4*)(p.in[0] + (size_t)m * D + c); else if (m < MT) v[jj] = *(const f32x4*)(p.in[1] + (size_t)(m - MP) * D + c); else v[jj] = (f32x4){0.f, 0.f, 0.f, 0.f};
            s += (v[jj].x * v[jj].x + v[jj].y * v[jj].y) + (v[jj].z * v[jj].z + v[jj].w * v[jj].w); }
#pragma unroll
        for (int o = 1; o < 64; o <<= 1) s += __shfl_xor(s, o);
#pragma unroll
        for (int jj = 0; jj < 4; ++jj) { const int c = 4 * lane + 256 * jj; *(f32x4*)(H + (size_t)m * D + c) = v[jj];
            *(u32x2*)(HB + (size_t)m * D + c) = (u32x2){pk2(v[jj].x, v[jj].y), pk2(v[jj].z, v[jj].w)}; }
        if (lane == 0) stat_set(ssq + m, s);
      } }
    }
    if (mask & 32) {
    { const float* wuq = p.in[17]; const float* wuk = p.in[20]; const float* qn = p.in[16]; bf16* Wq = p.w<bf16>(WS_WQ);
      LAS float* Qs = (LAS float*)p.lds;
      for (int it = p.bid; it < 192; it += p.G) {
        const int h = it / 24, kb = (it >> 2) % 6, cq = it & 3, k0 = 64 * kb;
        __syncthreads();
#pragma unroll
        for (int q = 0; q < 4; ++q) { const int idx = p.tid + 512 * q, row = idx >> 5, c4 = idx & 31; *(LAS f32x4*)(Qs + row * 132 + c4 * 4) = *(const f32x4*)(wuq + (size_t)(k0 + row) * 1536 + h * 192 + c4 * 4); }
        __syncthreads();
        const int c0 = cq * 64 + p.wave * 8; float acc[8];
#pragma unroll
        for (int cc = 0; cc < 8; ++cc) acc[cc] = 0.f;
        for (int n4 = 0; n4 < 32; ++n4) { const f32x4 bv = *(const LAS f32x4*)(Qs + lane * 132 + n4 * 4);
#pragma unroll
            for (int cc = 0; cc < 8; ++cc) { const f32x4 av = *(const f32x4*)(wuk + (size_t)(c0 + cc) * 1024 + h * 128 + n4 * 4); acc[cc] += (av.x * bv.x + av.y * bv.y) + (av.z * bv.z + av.w * bv.w); } }
        const float g = qn[k0 + lane];
#pragma unroll
        for (int cc = 0; cc < 8; ++cc) Wq[(size_t)(320 * h + c0 + cc) * 384 + k0 + lane] = (bf16)f2bf(acc[cc] * g);
      }
      for (int r = gw; r < 512; r += NGW) { const int h = r >> 6, ie = r & 63, i = ie >> 1, e = ie & 1;
#pragma unroll
        for (int kk = 0; kk < 6; ++kk) { const int k = lane + 64 * kk; Wq[(size_t)(320 * h + 256 + ie) * 384 + k] = (bf16)f2bf(wuq[(size_t)k * 1536 + h * 192 + 128 + 32 * e + i] * qn[k]); } } }
    }
    if (mask & 64) {
    { const float* wuv = p.in[21]; const float* wo = p.in[22]; bf16* Wov = p.w<bf16>(WS_WOV);
      for (int it = gw; it < 2048; it += NGW) { const int h = it >> 8, cg = (it >> 2) & 63, nb = it & 3, c0 = cg * 4, n = nb * 256 + lane * 4;
        f32x4 acc[4];
#pragma unroll
        for (int cc = 0; cc < 4; ++cc) acc[cc] = (f32x4){0.f, 0.f, 0.f, 0.f};
        for (int v = 0; v < 128; ++v) { const f32x4 b = *(const f32x4*)(wo + (size_t)(h * 128 + v) * D + n);
#pragma unroll
            for (int cc = 0; cc < 4; ++cc) { const float a = wuv[(size_t)(c0 + cc) * 1024 + h * 128 + v]; acc[cc] += b * a; } }
#pragma unroll
        for (int jn = 0; jn < 4; ++jn) *(u32x2*)(Wov + (size_t)(n + jn) * 2048 + h * 256 + c0) = (u32x2){pk2(acc[0][jn], acc[1][jn]), pk2(acc[2][jn], acc[3][jn])};
      } }
    }
}
}
namespace mk {
typedef const f32x4 (&AccRef)[2][2][4][2];
__device__ __forceinline__ float quad_red(float v) { v += __shfl_xor(v, 16); v += __shfl_xor(v, 32); return v; }
__device__ __forceinline__ u32x4 pack8(const f32x4 a, const f32x4 b) { u32x4 w; w.x = cvt_pk_bf16(a[0], a[1]); w.y = cvt_pk_bf16(a[2], a[3]); w.z = cvt_pk_bf16(b[0], b[1]); w.w = cvt_pk_bf16(b[2], b[3]); return w; }
__device__ __forceinline__ float sumsq8(const f32x4 a, const f32x4 b) { return ((a[0] * a[0] + a[1] * a[1]) + (a[2] * a[2] + a[3] * a[3])) + ((b[0] * b[0] + b[1] * b[1]) + (b[2] * b[2] + b[3] * b[3])); }
__device__ __forceinline__ float sum8(const f32x4 a, const f32x4 b) { return ((a[0] + a[1]) + (a[2] + a[3])) + ((b[0] + b[1]) + (b[2] + b[3])); }
#define MK_EPI_CALL() \
    __device__ __forceinline__ void operator()(AccRef acc, const pg8::Unit& u, int wr, int wc, int fr, int fq) const { \
        _Pragma("unroll") for (int ai = 0; ai < 2; ++ai) _Pragma("unroll") for (int m = 0; m < 4; ++m) \
            rg(u.pm * 256 + ai * 128 + wr * 64 + m * 16 + fr, u.pn, wc, fq, acc[ai][0][m][0], acc[ai][0][m][1], acc[ai][1][m][0], acc[ai][1][m][1]); }

struct EpiA1 {
    static constexpr bool PERM = true, AFTER_DRAIN = false;
    bf16* U; bf16* GV; const long long* ssq; long long* lns; long long* lnq;
    __device__ __forceinline__ void rg(int r, int pn, int wc, int fq, f32x4 a0, f32x4 b0, f32x4 a1, f32x4 b1) const {
        const bool isv = pn >= 4; bf16* dst = (isv ? GV : U) + (size_t)r * 1024 + (pn & 3) * 256 + wc * 32 + 8 * fq; const float rs = rsqrtf(stat_get(ssq + r) * (1.0f / 1024.0f) + RMS_EPS);
        a0 *= rs; b0 *= rs; a1 *= rs; b1 *= rs;
#pragma unroll
        for (int e = 0; e < 4; ++e) { a0[e] = gelu_tanh_f(a0[e]); b0[e] = gelu_tanh_f(b0[e]); a1[e] = gelu_tanh_f(a1[e]); b1[e] = gelu_tanh_f(b1[e]); }
        *(u32x4*)dst = pack8(a0, b0); *(u32x4*)(dst + 128) = pack8(a1, b1);
        if (isv) { const float s1 = quad_red(sum8(a0, b0) + sum8(a1, b1)), s2 = quad_red(sumsq8(a0, b0) + sumsq8(a1, b1)); if (fq == 0) { stat_add(lns + r, s1); stat_add(lnq + r, s2); } }
    }
    MK_EPI_CALL()
};
struct EpiRes {
    static constexpr bool PERM = true, AFTER_DRAIN = false;
    float* H; bf16* HB; long long* ssq_out;
    __device__ __forceinline__ void rg(int r, int pn, int wc, int fq, f32x4 a0, f32x4 b0, f32x4 a1, f32x4 b1) const {
        const size_t o = (size_t)r * 1024 + pn * 256 + wc * 32 + 8 * fq; float* hp = H + o;
        a0 += *(const f32x4*)hp; b0 += *(const f32x4*)(hp + 4); a1 += *(const f32x4*)(hp + 128); b1 += *(const f32x4*)(hp + 132);
        *(f32x4*)hp = a0; *(f32x4*)(hp + 4) = b0; *(f32x4*)(hp + 128) = a1; *(f32x4*)(hp + 132) = b1;
        *(u32x4*)(HB + o) = pack8(a0, b0); *(u32x4*)(HB + o + 128) = pack8(a1, b1);
        const float q = quad_red(sumsq8(a0, b0) + sumsq8(a1, b1)); if (fq == 0) stat_add(ssq_out + r, q);
    }
    MK_EPI_CALL()
};
struct EpiF1 {
    static constexpr bool PERM = true, AFTER_DRAIN = false;
    bf16* ACT; const long long* ssq;
    __device__ __forceinline__ void rg(int r, int pn, int wc, int fq, f32x4 a0, f32x4 b0, f32x4 a1, f32x4 b1) const {
        const float rs = rsqrtf(stat_get(ssq + r) * (1.0f / 1024.0f) + RMS_EPS); f32x4 a, b;
#pragma unroll
        for (int e = 0; e < 4; ++e) { a[e] = silu_f(a0[e] * rs) * (a1[e] * rs); b[e] = silu_f(b0[e] * rs) * (b1[e] * rs); }
        *(u32x4*)(ACT + (size_t)r * DFF + pn * 128 + wc * 32 + 8 * fq) = pack8(a, b);
    }
    MK_EPI_CALL()
};
struct EpiB1 {
    static constexpr bool PERM = true, AFTER_DRAIN = false;
    float* RAW; bf16* CQB; const long long* ssq; long long* ssq_kv; long long* ssq_q;
    __device__ __forceinline__ void half(int r, int c, f32x4 a, f32x4 b, float& qkv, float& qq) const {
        if (c < 256) { *(f32x4*)(RAW + (size_t)r * 768 + c) = a; *(f32x4*)(RAW + (size_t)r * 768 + c + 4) = b; qkv += sumsq8(a, b); }
        else if (c < 640) { *(u32x4*)(CQB + (size_t)r * 384 + (c - 256)) = pack8(a, b); qq += sumsq8(a, b); }
        else if (c < 704) { *(f32x4*)(RAW + (size_t)r * 768 + c) = a; *(f32x4*)(RAW + (size_t)r * 768 + c + 4) = b; } }
    __device__ __forceinline__ void rg(int r, int pn, int wc, int fq, f32x4 a0, f32x4 b0, f32x4 a1, f32x4 b1) const {
        const float rs = rsqrtf(stat_get(ssq + r) * (1.0f / 1024.0f) + RMS_EPS); const int c = pn * 256 + wc * 32 + 8 * fq; float qkv = 0.f, qq = 0.f;
        half(r, c, a0 * rs, b0 * rs, qkv, qq); half(r, c + 128, a1 * rs, b1 * rs, qkv, qq);
        qkv = quad_red(qkv); qq = quad_red(qq);
        if (fq == 0) { if (pn == 0) stat_add(ssq_kv + r, qkv); else stat_add(ssq_q + r, qq); }
    }
    MK_EPI_CALL()
};
struct EpiB2 {
    static constexpr bool PERM = true, AFTER_DRAIN = false;
    bf16* QF; const long long* ssq_q; const f32x2* rope;
    __device__ __forceinline__ void half(int r, int c, int tp, const f32x4 a, const f32x4 b) const {
        const int h = c / 320, w = c - h * 320;
        if (w < 256) *(u32x4*)(QF + (size_t)r * 2560 + c) = pack8(a, b);
        else { const int i0 = (w - 256) >> 1;
            const f32x4 cs01 = *(const f32x4*)(rope + (size_t)tp * 32 + i0), cs23 = *(const f32x4*)(rope + (size_t)tp * 32 + i0 + 2);
            bf16* qh = QF + (size_t)r * 2560 + h * 320 + 256;
            *(u32x2*)(qh + i0) = (u32x2){cvt_pk_bf16(a[0] * cs01[0] - a[1] * cs01[1], a[2] * cs01[2] - a[3] * cs01[3]), cvt_pk_bf16(b[0] * cs23[0] - b[1] * cs23[1], b[2] * cs23[2] - b[3] * cs23[3])};
            *(u32x2*)(qh + 32 + i0) = (u32x2){cvt_pk_bf16(a[0] * cs01[1] + a[1] * cs01[0], a[2] * cs01[3] + a[3] * cs01[2]), cvt_pk_bf16(b[0] * cs23[1] + b[1] * cs23[0], b[2] * cs23[3] + b[3] * cs23[2])}; } }
    __device__ __forceinline__ void rg(int r, int pn, int wc, int fq, f32x4 a0, f32x4 b0, f32x4 a1, f32x4 b1) const {
        const float rs = rsqrtf(stat_get(ssq_q + r) * (1.0f / 384.0f) + RMS_EPS) * MLA_SCALE; const int tp = r < MP ? (r & 2047) : 2048 + ((r - MP) & 3), c = pn * 256 + wc * 32 + 8 * fq;
        half(r, c, tp, a0 * rs, b0 * rs); half(r, c + 128, tp, a1 * rs, b1 * rs);
    }
    MK_EPI_CALL()
};
struct EpiC1 {
    static constexpr bool PERM = true, AFTER_DRAIN = false;
    bf16* GATE; float* XW; const long long* ssq;
    __device__ __forceinline__ void rg(int r, int pn, int wc, int fq, f32x4 a0, f32x4 b0, f32x4 a1, f32x4 b1) const {
        const bool isx = pn >= 5; const int c = (isx ? pn - 5 : pn) * 256 + wc * 32 + 8 * fq; const float rs = rsqrtf(stat_get(ssq + r) * (1.0f / 1024.0f) + RMS_EPS);
        a0 *= rs; b0 *= rs; a1 *= rs; b1 *= rs;
        if (isx) { float* x = XW + (size_t)r * 1280 + c; *(f32x4*)x = a0; *(f32x4*)(x + 4) = b0; *(f32x4*)(x + 128) = a1; *(f32x4*)(x + 132) = b1; }
        else {
#pragma unroll
            for (int e = 0; e < 4; ++e) { a0[e] = gelu_tanh_f(a0[e]); b0[e] = gelu_tanh_f(b0[e]); a1[e] = gelu_tanh_f(a1[e]); b1[e] = gelu_tanh_f(b1[e]); }
            bf16* g = GATE + (size_t)r * 1280 + c; *(u32x4*)g = pack8(a0, b0); *(u32x4*)(g + 128) = pack8(a1, b1); }
    }
    MK_EPI_CALL()
};

template <class Epi>
__device__ __forceinline__ void mini_gemm(const P& p, const bf16* A, int lda, const bf16* Bt, int ldb, int K, int N, const Epi& E, int first_wg) {
    constexpr int BP = 272, SLOT = 64 * BP;
    const int tid = p.tid, lane = p.lane, w = p.wave, l15 = lane & 15, g4 = lane >> 4, nmu = (N >> 8) * 4, nch = K >> 7;
    const bf16* arow = A + (size_t)(MP + 16 * w + l15) * lda + 8 * g4;
    for (int mu = (p.bid - first_wg + p.G) % p.G; mu < nmu; mu += p.G) {
        const int pn = mu >> 2, wcq = mu & 3;
        const bf16* bsrc[2]; int boff[2];
#pragma unroll
        for (int q = 0; q < 2; ++q) { const int c = tid + 512 * q, rs = c >> 4, c16 = c & 15, bjn = rs >> 4, i = rs & 15;
            const int wrow = pn * 256 + (bjn >> 1) * 128 + wcq * 32 + 8 * (i >> 2) + 4 * (bjn & 1) + (i & 3);
            bsrc[q] = Bt + (size_t)wrow * ldb + c16 * 8; boff[q] = rs * BP + c16 * 16; }
        f32x4 acc[4];
#pragma unroll
        for (int t = 0; t < 4; ++t) acc[t] = (f32x4){0.f, 0.f, 0.f, 0.f};
        u32x4 b0[2], a0[4], b1[2], a1[4], b2[2], a2[4];
#define MG_LOAD(BS, AS, CH) do { _Pragma("unroll") for (int q = 0; q < 2; ++q) BS[q] = *(const u32x4*)(bsrc[q] + (size_t)(CH) * 128); \
                                 _Pragma("unroll") for (int s = 0; s < 4; ++s) AS[s] = *(const u32x4*)(arow + (size_t)(CH) * 128 + 32 * s); } while (0)
#define MG_STEP(BS, AS, CH) do { LAS unsigned char* slot = p.lds + ((CH) & 1) * SLOT; \
            _Pragma("unroll") for (int q = 0; q < 2; ++q) *(LAS u32x4*)(slot + boff[q]) = BS[q]; \
            bf16x8 af[4]; _Pragma("unroll") for (int s = 0; s < 4; ++s) af[s] = __builtin_bit_cast(bf16x8, AS[s]); \
            __syncthreads(); \
            if ((CH) + 3 < nch) MG_LOAD(BS, AS, (CH) + 3); \
            _Pragma("unroll") for (int s = 0; s < 4; ++s) _Pragma("unroll") for (int t = 0; t < 4; ++t) { \
                const bf16x8 bf = *(const LAS bf16x8*)(slot + (t * 16 + l15) * BP + (32 * s + 8 * g4) * 2); \
                acc[t] = __builtin_amdgcn_mfma_f32_16x16x32_bf16(bf, af[s], acc[t], 0, 0, 0); } } while (0)
        MG_LOAD(b0, a0, 0); if (1 < nch) MG_LOAD(b1, a1, 1); if (2 < nch) MG_LOAD(b2, a2, 2);
        __syncthreads();
        for (int ch = 0; ch < nch; ch += 3) {
            MG_STEP(b0, a0, ch);
            if (ch + 1 < nch) MG_STEP(b1, a1, ch + 1);
            if (ch + 2 < nch) MG_STEP(b2, a2, ch + 2);
        }
#undef MG_LOAD
#undef MG_STEP
        E.rg(MP + 16 * w + l15, pn, wcq, g4, acc[0], acc[1], acc[2], acc[3]);
    }
}
}
namespace mk {
__device__ __forceinline__ s16x4 tr16(const LAS unsigned char* a) { return __builtin_amdgcn_ds_read_tr16_b64_v4i16((LAS s16x4*)a); }
__device__ __forceinline__ bf16x8 cat8(const s16x4 a, const s16x4 b) { return (bf16x8){a[0], a[1], a[2], a[3], b[0], b[1], b[2], b[3]}; }
__device__ __forceinline__ bf16x8 as_bf16x8(const u32x4 w) { return __builtin_bit_cast(bf16x8, w); }
#define MFMA16(A, B, C) __builtin_amdgcn_mfma_f32_16x16x32_bf16((A), (B), (C), 0, 0, 0)
constexpr int TP = 272;
constexpr int KP = 656;
constexpr float LOG2E = 1.4426950408889634f;

__device__ __forceinline__ void a2_spatial(const P& p, int j, float* out_cv  ) {
    const bf16* U = p.w<bf16>(WS_U); const bf16* GV = p.w<bf16>(WS_GV); bf16* UM = p.w<bf16>(WS_UM);
    const long long* lns = p.stat(ST_LNS0 + 2 * j); const long long* lnq = p.stat(ST_LNQ0 + 2 * j);
    const float* ln_g = p.in[10] + j * 1024; const float* ln_b = p.in[11] + j * 1024; const float* b_s = p.in[13] + j * 1024;
    LAS unsigned char* Wt = p.lds; LAS unsigned char* Vt = p.lds + 128 * TP;
    const int tid = p.tid, lane = p.lane, w = p.wave, l15 = lane & 15, g4 = lane >> 4, q4 = (lane & 15) >> 2, pp = lane & 3;
    for (int u = p.bid; u < 129 * 8; u += p.G) {
        const int c = u >> 3, g = u & 7, row0 = c * 128; const bool smp = (c == 128);
        const bf16* Wsrc = p.w<bf16>(WS_WS + (smp ? 524288 : 0) + (size_t)j * 262144) + (size_t)g * 16384;
#pragma unroll
        for (int q = 0; q < 4; ++q) { const int ch = tid + 512 * q, row = ch >> 4, c16 = ch & 15;
            *(LAS u32x4*)(Wt + row * TP + c16 * 16) = *(const u32x4*)(Wsrc + row * 128 + c16 * 8); }
#pragma unroll
        for (int q = 0; q < 4; ++q) { const int ch = tid + 512 * q, s = ch >> 4, c16 = ch & 15, r = row0 + s, d0 = g * 128 + c16 * 8;
            const u32x4 raw = *(const u32x4*)(GV + (size_t)r * 1024 + d0);
            const float mean = stat_get(lns + r) * (1.0f / 1024.0f), var = stat_get(lnq + r) * (1.0f / 1024.0f) - mean * mean, rstd = rsqrtf(var + LN_EPS);
            const f32x4 g0 = *(const f32x4*)(ln_g + d0), g1 = *(const f32x4*)(ln_g + d0 + 4), b0 = *(const f32x4*)(ln_b + d0), b1 = *(const f32x4*)(ln_b + d0 + 4);
            f32x4 v0, v1;
            v0[0] = bflo(raw.x); v0[1] = bfhi(raw.x); v0[2] = bflo(raw.y); v0[3] = bfhi(raw.y); v1[0] = bflo(raw.z); v1[1] = bfhi(raw.z); v1[2] = bflo(raw.w); v1[3] = bfhi(raw.w);
            v0 = (v0 - mean) * rstd * g0 + b0; v1 = (v1 - mean) * rstd * g1 + b1;
            if (smp && out_cv) { float* o = out_cv + (size_t)(r - MP) * 1024 + d0; *(f32x4*)o = v0; *(f32x4*)(o + 4) = v1; }
            *(LAS u32x4*)(Vt + s * TP + c16 * 16) = pack8(v0, v1); }
        __syncthreads();
        f32x4 acc[8];
#pragma unroll
        for (int tt = 0; tt < 8; ++tt) acc[tt] = (f32x4){0.f, 0.f, 0.f, 0.f};
#pragma unroll
        for (int kk = 0; kk < 4; ++kk) {
            const bf16x8 X = cat8(tr16(Vt + (32 * kk + 8 * g4 + q4) * TP + (16 * w + 4 * pp) * 2), tr16(Vt + (32 * kk + 8 * g4 + 4 + q4) * TP + (16 * w + 4 * pp) * 2));
#pragma unroll
            for (int tt = 0; tt < 8; ++tt) if (32 * kk <= 16 * tt + 15) {
                const bf16x8 Y = *(const LAS bf16x8*)(Wt + (16 * tt + l15) * TP + (32 * kk + 8 * g4) * 2);
                acc[tt] = MFMA16(X, Y, acc[tt]); }
        }
#pragma unroll
        for (int tt = 0; tt < 8; ++tt) { const int t = 16 * tt + l15, r = row0 + t, col = g * 128 + 16 * w + 4 * g4;
            const float bias = b_s[g * 128 + (smp ? (t & 3) : t)];
            const u32x2 uu = *(const u32x2*)(U + (size_t)r * 1024 + col);
            const float o0 = bflo(uu.x) * (acc[tt][0] + bias), o1 = bfhi(uu.x) * (acc[tt][1] + bias), o2 = bflo(uu.y) * (acc[tt][2] + bias), o3 = bfhi(uu.y) * (acc[tt][3] + bias);
            *(u32x2*)(UM + (size_t)r * 1024 + col) = (u32x2){cvt_pk_bf16(o0, o1), cvt_pk_bf16(o2, o3)}; }
        __syncthreads();
    }
}

__device__ __forceinline__ void b2_kvfinal(const P& p, float* out_mp, float* out_ms) {
    const float* RAW = p.w<float>(WS_RAW); bf16* KVB = p.w<bf16>(WS_KVB); const long long* ssq_kv = p.stat(ST_KV); const float* kvn = p.in[19]; const f32x2* rope = p.w<f32x2>(WS_ROPE);
    const int gw = p.bid * NWAVES + p.wave, NGW = p.G * NWAVES, lane = p.lane;
    for (int m = gw; m < MT; m += NGW) {
        float* o = m < MP ? (out_mp ? out_mp + (size_t)m * 320 : nullptr) : (out_ms ? out_ms + (size_t)(m - MP) * 320 : nullptr);
        const float rs = rsqrtf(stat_get(ssq_kv + m) * (1.0f / 256.0f) + RMS_EPS);
        const f32x4 v = *(const f32x4*)(RAW + (size_t)m * 768 + 4 * lane) * rs * *(const f32x4*)(kvn + 4 * lane);
        if (o) *(f32x4*)(o + 4 * lane) = v;
        *(u32x2*)(KVB + (size_t)m * 320 + 4 * lane) = (u32x2){cvt_pk_bf16(v[0], v[1]), cvt_pk_bf16(v[2], v[3])};
        if (lane < 32) { const int tp = m < MP ? (m & 2047) : 2048 + ((m - MP) & 3); const f32x2 cs = rope[(size_t)tp * 32 + lane];
            const float x1 = RAW[(size_t)m * 768 + 640 + lane], x2 = RAW[(size_t)m * 768 + 672 + lane];
            const float o1 = x1 * cs.x - x2 * cs.y, o2 = x1 * cs.y + x2 * cs.x;
            if (o) { o[256 + lane] = o1; o[288 + lane] = o2; }
            KVB[(size_t)m * 320 + 256 + lane] = (bf16)f2bf(o1); KVB[(size_t)m * 320 + 288 + lane] = (bf16)f2bf(o2); }
    }
}

__device__ __forceinline__ void b3_attn_prompt(const P& p) {
    const bf16* QF = p.w<bf16>(WS_QF); const bf16* KVB = p.w<bf16>(WS_KVB); bf16* OB = p.w<bf16>(WS_OB);
    const int tid = p.tid, lane = p.lane, h = p.wave, l15 = lane & 15, g4 = lane >> 4, q4 = (lane & 15) >> 2, pp = lane & 3;
    constexpr int TILE_B = 64 * KP;
    for (int pi = p.bid; pi < 512; pi += p.G) {
        const int b = pi >> 6, x = pi & 63;
        for (int half = 0; half < 2; ++half) {
            const int qt = half ? 127 - x : x, t0 = 16 * qt, nkt = (t0 + 15) / 64 + 1;
            const size_t rowq = (size_t)b * 2048 + t0 + l15;
            bf16x8 Q[10];
#pragma unroll
            for (int s = 0; s < 10; ++s) Q[s] = as_bf16x8(*(const u32x4*)(QF + rowq * 2560 + h * 320 + 32 * s + 8 * g4));
            f32x4 O[16];
#pragma unroll
            for (int vt = 0; vt < 16; ++vt) O[vt] = (f32x4){0.f, 0.f, 0.f, 0.f};
            float mrun = -1e30f, lrun = 0.f;
            u32x4 st[5];
            { const bf16* src = KVB + ((size_t)b * 2048) * 320;
#pragma unroll
              for (int q = 0; q < 5; ++q) { const int ch = tid + 512 * q, row = ch / 40, c16 = ch % 40; st[q] = *(const u32x4*)(src + (size_t)row * 320 + c16 * 8); }
              __syncthreads();
#pragma unroll
              for (int q = 0; q < 5; ++q) { const int ch = tid + 512 * q, row = ch / 40, c16 = ch % 40; *(LAS u32x4*)(p.lds + row * KP + c16 * 16) = st[q]; }
              __syncthreads(); }
            for (int kt = 0; kt < nkt; ++kt) {
                LAS unsigned char* buf = p.lds + (kt & 1) * TILE_B;
                if (kt + 1 < nkt) { const bf16* src = KVB + ((size_t)b * 2048 + 64 * (kt + 1)) * 320;
#pragma unroll
                    for (int q = 0; q < 5; ++q) { const int ch = tid + 512 * q, row = ch / 40, c16 = ch % 40; st[q] = *(const u32x4*)(src + (size_t)row * 320 + c16 * 8); } }
                f32x4 S[4];
#pragma unroll
                for (int k4 = 0; k4 < 4; ++k4) { S[k4] = (f32x4){0.f, 0.f, 0.f, 0.f};
#pragma unroll
                    for (int s = 0; s < 10; ++s) { const bf16x8 Kf = *(const LAS bf16x8*)(buf + (16 * k4 + l15) * KP + (32 * s + 8 * g4) * 2); S[k4] = MFMA16(Kf, Q[s], S[k4]); } }
                float mx = -1e30f;
#pragma unroll
                for (int k4 = 0; k4 < 4; ++k4)
#pragma unroll
                    for (int e = 0; e < 4; ++e) { float v = S[k4][e] * LOG2E; if (kt == nkt - 1 && 64 * kt + 16 * k4 + 4 * g4 + e > t0 + l15) v = -1e30f; S[k4][e] = v; mx = fmaxf(mx, v); }
                mx = fmaxf(mx, __shfl_xor(mx, 16)); mx = fmaxf(mx, __shfl_xor(mx, 32));
                const float mnew = fmaxf(mrun, mx), alpha = __builtin_amdgcn_exp2f(mrun - mnew); mrun = mnew;
                float ps = 0.f;
#pragma unroll
                for (int k4 = 0; k4 < 4; ++k4)
#pragma unroll
                    for (int e = 0; e < 4; ++e) { const float pv = __builtin_amdgcn_exp2f(S[k4][e] - mnew); S[k4][e] = pv; ps += pv; }
                lrun = lrun * alpha + ps;
#pragma unroll
                for (int vt = 0; vt < 16; ++vt) O[vt] *= alpha;
                bf16x8 Pf[2];
#pragma unroll
                for (int ks = 0; ks < 2; ++ks) Pf[ks] = as_bf16x8((u32x4){cvt_pk_bf16(S[2 * ks][0], S[2 * ks][1]), cvt_pk_bf16(S[2 * ks][2], S[2 * ks][3]), cvt_pk_bf16(S[2 * ks + 1][0], S[2 * ks + 1][1]), cvt_pk_bf16(S[2 * ks + 1][2], S[2 * ks + 1][3])});
#pragma unroll
                for (int vt = 0; vt < 16; ++vt)
#pragma unroll
                    for (int ks = 0; ks < 2; ++ks) {
                        const bf16x8 Vf = cat8(tr16(buf + (32 * ks + 4 * g4 + q4) * KP + (16 * vt + 4 * pp) * 2), tr16(buf + (32 * ks + 16 + 4 * g4 + q4) * KP + (16 * vt + 4 * pp) * 2));
                        O[vt] = MFMA16(Vf, Pf[ks], O[vt]); }
                if (kt + 1 < nkt) { LAS unsigned char* nb = p.lds + ((kt + 1) & 1) * TILE_B;
#pragma unroll
                    for (int q = 0; q < 5; ++q) { const int ch = tid + 512 * q, row = ch / 40, c16 = ch % 40; *(LAS u32x4*)(nb + row * KP + c16 * 16) = st[q]; } }
                __syncthreads();
            }
            const float linv = 1.0f / quad_red(lrun);
#pragma unroll
            for (int vt = 0; vt < 16; ++vt) { const f32x4 o = O[vt] * linv;
                *(u32x2*)(OB + rowq * 2048 + h * 256 + 16 * vt + 4 * g4) = (u32x2){cvt_pk_bf16(o[0], o[1]), cvt_pk_bf16(o[2], o[3])}; }
        }
    }
}

__device__ __forceinline__ void b3_attn_sample(const P& p) {
    const bf16* QF = p.w<bf16>(WS_QF); float* PART = p.w<float>(WS_PART); float* PML = p.w<float>(WS_PML);
    const float* cache = p.in[2]; const int* ptab = (const int*)p.in[5];
    const int tid = p.tid, lane = p.lane, w = p.wave, qt = w & 1, dvq = w >> 1, l15 = lane & 15, g4 = lane >> 4, q4 = (lane & 15) >> 2, pp = lane & 3;
    constexpr int TILE_B = 64 * KP;
    for (int u = p.bid; u < 256; u += p.G) {
        const int b = u >> 3, sp = u & 7;
        const int hq = 4 * qt + (l15 >> 2), iq = l15 & 3; const size_t rowq = (size_t)MP + 4 * b + iq;
        bf16x8 Q[10];
#pragma unroll
        for (int s = 0; s < 10; ++s) Q[s] = as_bf16x8(*(const u32x4*)(QF + rowq * 2560 + hq * 320 + 32 * s + 8 * g4));
        f32x4 O[4];
#pragma unroll
        for (int v = 0; v < 4; ++v) O[v] = (f32x4){0.f, 0.f, 0.f, 0.f};
        float mrun = -1e30f, lrun = 0.f;
        f32x4 st[10];
        auto tile_src = [&](int ti) -> const float* { const int pg = 16 * sp + (ti >> 1); return cache + ((size_t)ptab[b * 128 + pg] * 128 + 64 * (ti & 1)) * 320; };
        { const float* src = tile_src(0);
#pragma unroll
          for (int q = 0; q < 10; ++q) st[q] = __builtin_nontemporal_load((const f32x4*)(src + (size_t)(tid + 512 * q) * 4));
          __syncthreads();
#pragma unroll
          for (int q = 0; q < 10; ++q) { const int ch = tid + 512 * q, row = ch / 80, c4 = ch % 80; *(LAS u32x2*)(p.lds + row * KP + c4 * 8) = (u32x2){cvt_pk_bf16(st[q][0], st[q][1]), cvt_pk_bf16(st[q][2], st[q][3])}; }
          __syncthreads(); }
        for (int ti = 0; ti < 32; ++ti) {
            LAS unsigned char* buf = p.lds + (ti & 1) * TILE_B;
            if (ti + 1 < 32) { const float* src = tile_src(ti + 1);
#pragma unroll
                for (int q = 0; q < 10; ++q) st[q] = __builtin_nontemporal_load((const f32x4*)(src + (size_t)(tid + 512 * q) * 4)); }
            f32x4 S[4];
#pragma unroll
            for (int k4 = 0; k4 < 4; ++k4) { S[k4] = (f32x4){0.f, 0.f, 0.f, 0.f};
#pragma unroll
                for (int s = 0; s < 10; ++s) { const bf16x8 Kf = *(const LAS bf16x8*)(buf + (16 * k4 + l15) * KP + (32 * s + 8 * g4) * 2); S[k4] = MFMA16(Kf, Q[s], S[k4]); } }
            float mx = -1e30f;
#pragma unroll
            for (int k4 = 0; k4 < 4; ++k4)
#pragma unroll
                for (int e = 0; e < 4; ++e) { const float v = S[k4][e] * LOG2E; S[k4][e] = v; mx = fmaxf(mx, v); }
            mx = fmaxf(mx, __shfl_xor(mx, 16)); mx = fmaxf(mx, __shfl_xor(mx, 32));
            const float mnew = fmaxf(mrun, mx), alpha = __builtin_amdgcn_exp2f(mrun - mnew); mrun = mnew;
            float ps = 0.f;
#pragma unroll
            for (int k4 = 0; k4 < 4; ++k4)
#pragma unroll
                for (int e = 0; e < 4; ++e) { const float pv = __builtin_amdgcn_exp2f(S[k4][e] - mnew); S[k4][e] = pv; ps += pv; }
            lrun = lrun * alpha + ps;
#pragma unroll
            for (int v = 0; v < 4; ++v) O[v] *= alpha;
            bf16x8 Pf[2];
#pragma unroll
            for (int ks = 0; ks < 2; ++ks) Pf[ks] = as_bf16x8((u32x4){cvt_pk_bf16(S[2 * ks][0], S[2 * ks][1]), cvt_pk_bf16(S[2 * ks][2], S[2 * ks][3]), cvt_pk_bf16(S[2 * ks + 1][0], S[2 * ks + 1][1]), cvt_pk_bf16(S[2 * ks + 1][2], S[2 * ks + 1][3])});
#pragma unroll
            for (int v = 0; v < 4; ++v) { const int vt = 4 * dvq + v;
#pragma unroll
                for (int ks = 0; ks < 2; ++ks) {
                    const bf16x8 Vf = cat8(tr16(buf + (32 * ks + 4 * g4 + q4) * KP + (16 * vt + 4 * pp) * 2), tr16(buf + (32 * ks + 16 + 4 * g4 + q4) * KP + (16 * vt + 4 * pp) * 2));
                    O[v] = MFMA16(Vf, Pf[ks], O[v]); } }
            if (ti + 1 < 32) { LAS unsigned char* nb = p.lds + ((ti + 1) & 1) * TILE_B;
#pragma unroll
                for (int q = 0; q < 10; ++q) { const int ch = tid + 512 * q, row = ch / 80, c4 = ch % 80; *(LAS u32x2*)(nb + row * KP + c4 * 8) = (u32x2){cvt_pk_bf16(st[q][0], st[q][1]), cvt_pk_bf16(st[q][2], st[q][3])}; } }
            __syncthreads();
        }
        const float lsum = quad_red(lrun); const int qrow = 16 * qt + l15; const size_t pb = ((size_t)(b * 8 + sp) * 32 + qrow);
#pragma unroll
        for (int v = 0; v < 4; ++v) *(f32x4*)(PART + pb * 256 + 16 * (4 * dvq + v) + 4 * g4) = O[v];
        if (dvq == 0 && g4 == 0) { PML[pb * 2] = mrun; PML[pb * 2 + 1] = lsum; }
    }
}
__device__ __forceinline__ void b3_combine(const P& p) {
    const bf16* QF = p.w<bf16>(WS_QF); const bf16* KVB = p.w<bf16>(WS_KVB); bf16* OB = p.w<bf16>(WS_OB); const float* PART = p.w<float>(WS_PART); const float* PML = p.w<float>(WS_PML);
    const int dv = p.tid & 255, sub = p.tid >> 8;
    for (int it = 2 * p.bid + sub; it < 1024; it += 2 * p.G) {
        const int b = it >> 5, i = (it >> 3) & 3, h = it & 7, qt = h >> 2, ql = ((h & 3) << 2) | i, qrow = 16 * qt + ql; const size_t row = (size_t)MP + 4 * b + i;
        float sn[4];
#pragma unroll
        for (int kk = 0; kk < 4; ++kk) { float s = 0.f;
            if (kk <= i) { const unsigned* qp = (const unsigned*)(QF + row * 2560 + h * 320); const unsigned* kp = (const unsigned*)(KVB + ((size_t)MP + 4 * b + kk) * 320);
                for (int d = 0; d < 160; ++d) { const unsigned a = qp[d], c = kp[d]; s += bflo(a) * bflo(c) + bfhi(a) * bfhi(c); } }
            sn[kk] = (kk <= i) ? s * LOG2E : -1e30f; }
        float M = fmaxf(fmaxf(sn[0], sn[1]), fmaxf(sn[2], sn[3])); float ms[8], ls[8];
#pragma unroll
        for (int sp = 0; sp < 8; ++sp) { const size_t pb = ((size_t)(b * 8 + sp) * 32 + qrow); ms[sp] = PML[pb * 2]; ls[sp] = PML[pb * 2 + 1]; M = fmaxf(M, ms[sp]); }
        float L = 0.f, Oa = 0.f;
#pragma unroll
        for (int sp = 0; sp < 8; ++sp) { const size_t pb = ((size_t)(b * 8 + sp) * 32 + qrow); const float wgt = __builtin_amdgcn_exp2f(ms[sp] - M); L += ls[sp] * wgt; Oa += PART[pb * 256 + dv] * wgt; }
#pragma unroll
        for (int kk = 0; kk < 4; ++kk) { const float pk = __builtin_amdgcn_exp2f(sn[kk] - M); L += pk; Oa += pk * bf2f(KVB[((size_t)MP + 4 * b + kk) * 320 + dv]); }
        OB[row * 2048 + h * 256 + dv] = (bf16)f2bf(Oa / L);
    }
}

template <bool SMP>
__device__ __forceinline__ f32x4 conv4(const float* XW, const float* cbuf  , const float* cw, const float* cb, int m, int c) {
    f32x4 acc = *(const f32x4*)(cb + c);
    f32x4 v[4], wv[4];
#pragma unroll
    for (int k = 0; k < 4; ++k) { wv[k] = *(const f32x4*)(cw + k * 1280 + c);
        if (!SMP) { const int t = m & 2047, r = t + k - 3; v[k] = *(const f32x4*)(XW + (size_t)(m + (r >= 0 ? k - 3 : -t)) * 1280 + c); if (r < 0) wv[k] = (f32x4){0.f, 0.f, 0.f, 0.f}; }
        else { const int b = (m - MP) >> 2, t = (m - MP) & 3, r = t + k - 3; const float* ptr = (r >= 0) ? XW + (size_t)(m + k - 3) * 1280 + c : cbuf + ((size_t)b * 3 + (3 + r)) * 1280 + c; v[k] = *(const f32x4*)ptr; } }
#pragma unroll
    for (int k = 0; k < 4; ++k) acc += wv[k] * v[k];
    return acc;
}
__device__ __forceinline__ void c2_rglru(const P& p, int j, float* out_cp, float* out_cs, float* out_hs) {
    const float* XW = p.w<float>(WS_XW); bf16* LH = p.w<bf16>(WS_AA); bf16* CPB = p.w<bf16>(WS_BB); float* AGG = p.w<float>(WS_AGG);
    const float* cbuf = p.in[4] + (size_t)j * 32 * 3 * 1280; const float* cw = p.in[25] + (size_t)j * 4 * 1280; const float* cb = p.in[26] + j * 1280;
    const float* b_a = p.in[28] + j * 1280; const float* b_i = p.in[30] + j * 1280; const float* lam = p.in[31] + j * 1280; const float* h0s = p.in[3] + (size_t)j * 32 * 1280;
    const bf16* WaT = p.w<bf16>(WS_WAT); const bf16* WiT = p.w<bf16>(WS_WIT);
    LAS unsigned char* Xt = p.lds; LAS unsigned char* At = p.lds + 128 * TP; LAS unsigned char* It = p.lds + 256 * TP;
    LAS float* LA = (LAS float*)p.lds;
    LAS unsigned char* LB = p.lds + 128 * 528;
    LAS float* QT = (LAS float*)(p.lds + 128 * 528 + 128 * TP);
    const int tid = p.tid, lane = p.lane, w = p.wave, l15 = lane & 15, g4 = lane >> 4;
    { const int gt = p.bid * 512 + tid, NGT = p.G * 512;
      for (int i = gt; i < (8 + 32) * 3 * 320; i += NGT) { const int c = (i % 320) * 4, rr = i / 320, jj = rr % 3, bb = rr / 3;
          if (bb < 8) { if (out_cp) *(f32x4*)(out_cp + ((size_t)bb * 3 + jj) * 1280 + c) = *(const f32x4*)(XW + ((size_t)bb * 2048 + 2045 + jj) * 1280 + c); }
          else { const int b = bb - 8; if (out_cs) *(f32x4*)(out_cs + ((size_t)b * 3 + jj) * 1280 + c) = *(const f32x4*)(XW + ((size_t)MP + 4 * b + 1 + jj) * 1280 + c); } } }
    for (int u = p.bid; u < 129 * 10; u += p.G) {
        const int T = u / 10, n = u % 10, row0 = T * 128;
#pragma unroll
        for (int q = 0; q < 4; ++q) { const int ch = tid + 512 * q, row = ch >> 4, c16 = ch & 15;
            *(LAS u32x4*)(At + row * TP + c16 * 16) = *(const u32x4*)(WaT + (size_t)n * 16384 + row * 128 + c16 * 8);
            *(LAS u32x4*)(It + row * TP + c16 * 16) = *(const u32x4*)(WiT + (size_t)n * 16384 + row * 128 + c16 * 8);
            f32x4 v0, v1;
            if (T < 128) { v0 = conv4<false>(XW, cbuf, cw, cb, row0 + row, n * 128 + c16 * 8); v1 = conv4<false>(XW, cbuf, cw, cb, row0 + row, n * 128 + c16 * 8 + 4); }
            else { v0 = conv4<true>(XW, cbuf, cw, cb, row0 + row, n * 128 + c16 * 8); v1 = conv4<true>(XW, cbuf, cw, cb, row0 + row, n * 128 + c16 * 8 + 4); }
            *(LAS u32x4*)(Xt + row * TP + c16 * 16) = pack8(v0, v1); }
        __syncthreads();
        f32x4 ca[8], ci[8];
#pragma unroll
        for (int tt = 0; tt < 8; ++tt) { ca[tt] = (f32x4){0.f, 0.f, 0.f, 0.f}; ci[tt] = (f32x4){0.f, 0.f, 0.f, 0.f}; }
#pragma unroll
        for (int kk = 0; kk < 4; ++kk) {
            const bf16x8 Xa = *(const LAS bf16x8*)(At + (16 * w + l15) * TP + (32 * kk + 8 * g4) * 2), Xi = *(const LAS bf16x8*)(It + (16 * w + l15) * TP + (32 * kk + 8 * g4) * 2);
#pragma unroll
            for (int tt = 0; tt < 8; ++tt) { const bf16x8 Y = *(const LAS bf16x8*)(Xt + (16 * tt + l15) * TP + (32 * kk + 8 * g4) * 2);
                ca[tt] = MFMA16(Xa, Y, ca[tt]); ci[tt] = MFMA16(Xi, Y, ci[tt]); }
        }
        const int chn = n * 128 + 16 * w + 4 * g4;
        { const f32x4 ba = *(const f32x4*)(b_a + chn), bi = *(const f32x4*)(b_i + chn), lm = *(const f32x4*)(lam + chn);
          f32x4 sp;
#pragma unroll
          for (int e = 0; e < 4; ++e) { const float nl = -lm[e]; sp[e] = (nl > 20.f) ? nl : log1pf(expf(nl)); }
#pragma unroll
          for (int tt = 0; tt < 8; ++tt) { const u32x2 xb = *(const LAS u32x2*)(Xt + (16 * tt + l15) * TP + (16 * w + 4 * g4) * 2);
              const f32x4 xc = (f32x4){bflo(xb.x), bfhi(xb.x), bflo(xb.y), bfhi(xb.y)};
#pragma unroll
              for (int e = 0; e < 4; ++e) { const float r = fast_sigmoid_l2(LOG2E * (ca[tt][e] + ba[e])), gi = fast_sigmoid_l2(LOG2E * (ci[tt][e] + bi[e]));
                  const float la = -8.0f * r * sp[e], x2 = 2.0f * la;
                  const float ser = -x2 * (1.0f + x2 * (0.5f + x2 * (0.16666667f + x2 * (0.041666668f + x2 * (0.0083333338f + x2 * 0.0013888889f)))));
                  const float big = 1.0f - __builtin_amdgcn_exp2f(x2 * LOG2E);
                  ca[tt][e] = __builtin_amdgcn_exp2f(la * LOG2E); ci[tt][e] = sqrtf(x2 > -0.25f ? ser : big) * gi * xc[e]; } } }
        __syncthreads();
#pragma unroll
        for (int tt = 0; tt < 8; ++tt) { const int tok = 16 * tt + l15;
            *(LAS f32x4*)(LA + tok * 132 + 16 * w + 4 * g4) = ca[tt];
            *(LAS u32x2*)(LB + tok * TP + (16 * w + 4 * g4) * 2) = (u32x2){cvt_pk_bf16(ci[tt][0], ci[tt][1]), cvt_pk_bf16(ci[tt][2], ci[tt][3])}; }
        __syncthreads();
        const int ch = tid & 127, q = tid >> 7, chg = n * 128 + ch;
        if (T < 128) {
            float P_ = 1.f, H_ = 0.f;
#pragma unroll 8
            for (int t = 32 * q; t < 32 * q + 32; ++t) { const float a = LA[t * 132 + ch], b = bf2f(*(const LAS bf16*)(LB + t * TP + ch * 2)); H_ = a * H_ + b; P_ *= a; }
            QT[(q * 128 + ch) * 2] = P_; QT[(q * 128 + ch) * 2 + 1] = H_;
            __syncthreads();
            float h = 0.f, pc = 1.f;
#pragma unroll
            for (int qq = 0; qq < 3; ++qq) if (qq < q) { const float Pq = QT[(qq * 128 + ch) * 2], Hq = QT[(qq * 128 + ch) * 2 + 1]; h = Pq * h + Hq; pc *= Pq; }
#pragma unroll 8
            for (int t = 32 * q; t < 32 * q + 32; ++t) { const float a = LA[t * 132 + ch], b = bf2f(*(const LAS bf16*)(LB + t * TP + ch * 2)); h = a * h + b; pc *= a;
                const size_t o = (size_t)(row0 + t) * 1280 + chg; LH[o] = (bf16)f2bf(h); CPB[o] = (bf16)f2bf(pc); }
            if (q == 3) { AGG[((size_t)T * 2) * 1280 + chg] = pc; AGG[((size_t)T * 2 + 1) * 1280 + chg] = h; }
        } else {
            for (int bb = 8 * q; bb < 8 * q + 8; ++bb) { float h = h0s[(size_t)bb * 1280 + chg];
#pragma unroll
                for (int i = 0; i < 4; ++i) { const int t = 4 * bb + i; const float a = LA[t * 132 + ch], b = bf2f(*(const LAS bf16*)(LB + t * TP + ch * 2)); h = a * h + b;
                    const size_t o = (size_t)(row0 + t) * 1280 + chg; LH[o] = (bf16)f2bf(h); CPB[o] = (bf16)0; }
                if (out_hs) out_hs[(size_t)bb * 1280 + chg] = h; }
        }
        __syncthreads();
    }
}
__device__ __forceinline__ void c5_fixup(const P& p, float* out_hp) {
    const bf16* LH = p.w<bf16>(WS_AA); const bf16* CPB = p.w<bf16>(WS_BB); const float* AGG = p.w<float>(WS_AGG); const bf16* GATE = p.w<bf16>(WS_GATE); bf16* GH = p.w<bf16>(WS_GH);
    LAS float* cr = (LAS float*)p.lds;
    const int tid = p.tid;
    for (int it = p.bid; it < 258; it += p.G) {
        const int T = it >> 1, hf = it & 1, row0 = T * 128 + 64 * hf, T0 = T & ~15;
        for (int ch = tid; ch < 1280; ch += 512) { float c = 0.f;
            if (T < 128) {
#pragma unroll
                for (int d = 0; d < 15; ++d) if (T0 + d < T) c = AGG[((size_t)(T0 + d) * 2) * 1280 + ch] * c + AGG[((size_t)(T0 + d) * 2 + 1) * 1280 + ch];
                if ((T & 15) == 15 && hf == 1 && out_hp) out_hp[(size_t)(T >> 4) * 1280 + ch] = AGG[((size_t)T * 2) * 1280 + ch] * c + AGG[((size_t)T * 2 + 1) * 1280 + ch]; }
            cr[ch] = c; }
        __syncthreads();
#pragma unroll 4
        for (int i = 0; i < 20; ++i) { const int cidx = tid + 512 * i, tok = cidx / 160, c8 = (cidx % 160) * 8; const size_t o = (size_t)(row0 + tok) * 1280 + c8;
            const u32x4 lh = *(const u32x4*)(LH + o), cp = *(const u32x4*)(CPB + o), gt = *(const u32x4*)(GATE + o);
            const f32x4 c0 = *(const LAS f32x4*)(cr + c8), c1 = *(const LAS f32x4*)(cr + c8 + 4);
            f32x4 r0, r1;
            r0[0] = bflo(gt.x) * (bflo(lh.x) + bflo(cp.x) * c0[0]); r0[1] = bfhi(gt.x) * (bfhi(lh.x) + bfhi(cp.x) * c0[1]);
            r0[2] = bflo(gt.y) * (bflo(lh.y) + bflo(cp.y) * c0[2]); r0[3] = bfhi(gt.y) * (bfhi(lh.y) + bfhi(cp.y) * c0[3]);
            r1[0] = bflo(gt.z) * (bflo(lh.z) + bflo(cp.z) * c1[0]); r1[1] = bfhi(gt.z) * (bfhi(lh.z) + bfhi(cp.z) * c1[1]);
            r1[2] = bflo(gt.w) * (bflo(lh.w) + bflo(cp.w) * c1[2]); r1[3] = bfhi(gt.w) * (bfhi(lh.w) + bfhi(cp.w) * c1[3]);
            *(u32x4*)(GH + o) = pack8(r0, r1); }
        __syncthreads();
    }
}
__device__ __forceinline__ void final_norm(const P& p, float* out_yp, float* out_ys) {
    const float* H = p.w<float>(WS_H); const long long* ssq = p.stat(ST_SSQ0 + 8); const float* g = p.in[8];
    const int gw = p.bid * NWAVES + p.wave, NGW = p.G * NWAVES, lane = p.lane;
    for (int m = gw; m < MT; m += NGW) { float* o = m < MP ? out_yp + (size_t)m * 1024 : out_ys + (size_t)(m - MP) * 1024; const float rs = rsqrtf(stat_get(ssq + m) * (1.0f / 1024.0f) + RMS_EPS);
#pragma unroll
        for (int jj = 0; jj < 4; ++jj) { const int c = 4 * lane + 256 * jj; *(f32x4*)(o + c) = *(const f32x4*)(H + (size_t)m * 1024 + c) * rs * *(const f32x4*)(g + c); } }
}
}
namespace mk {
struct Args { const float* in[36]; float* out; unsigned char* ws; int ph_lo, ph_hi, li, mask; };
constexpr int NPHASE = 34;

#define MK_GEMM(EpiT, E, Aptr, LDA, Bptr, LDB, KD, NC) do { pg8::Gemm g_{(const pg8::bf16_t*)(Aptr), (const pg8::bf16_t*)(Bptr), (LDA), (LDB), (KD)}; pg8::StaticOrder S_; S_.init(MP, (NC), p.G, p.bid); \
        pg8::gemm_phase<EpiT, pg8::StaticOrder, true, true>(p.lds, g_, S_, E, p.tid); \
        mini_gemm<EpiT>(p, (const bf16*)(Aptr), (LDA), (const bf16*)(Bptr), (LDB), (KD), (NC), E, (64 * ((NC) / 256)) % p.G); } while (0)

#ifndef MK_REP_SEL
#define MK_REP_SEL(k) 0
#define MK_REP_N 1
#endif
#define REPF(k) for (int rep_ = 0; rep_ < (MK_REP_SEL(k) ? MK_REP_N : 1); ++rep_)
#define IN_(k) (lo <= (k) && (k) < hi)
#define PH_BEGIN() P p = p0; { int z_ = 0, t_ = p0.tid, g_ = p0.G, b_ = p0.bid; unsigned l_ = (unsigned)(size_t)p0.lds; asm volatile("" : "+s"(z_), "+v"(t_), "+s"(g_), "+s"(b_), "+s"(l_)); p.ws = p0.ws + z_; p.out = p0.out + z_; p.tid = t_; p.lane = t_ & 63; p.wave = __builtin_amdgcn_readfirstlane(t_ >> 6); p.G = g_; p.bid = b_; p.lds = (LAS unsigned char*)(size_t)l_; } float* const out = p.out; (void)out
#ifdef MK_PROF
#define STAMP(k) do { if (p0.bid == 0 && p0.tid == 0) ((unsigned long long*)(p0.ws + WS_PROF))[(k)] = (unsigned long long)wall_clock64(); } while (0)
#else
#define STAMP(k) do { } while (0)
#endif
#define ENDPH(k) do { if ((k) + 1 < hi) xcd_barrier(bar); STAMP((k) + 1); } while (0)
template <int LAYER> __device__ __forceinline__ void run_layer(const P& p0, const XcdBarrier& bar, const int lo, const int hi, const int mask) {
        constexpr int layer = LAYER, kind = layer % 3, j = layer / 3, pb = 1 + 8 * layer;
        constexpr size_t resA = kind == 0 ? WS_UM : kind == 1 ? WS_OB : WS_GH, resB = kind == 0 ? WS_WOUT + (size_t)j * 2 * MiB : kind == 1 ? WS_WOV : WS_WCO; constexpr int resK = kind == 0 ? 1024 : kind == 1 ? 2048 : 1280;
        if constexpr (kind == 0) {
            if (IN_(pb)) REPF(pb) { PH_BEGIN(); EpiA1 E{p.w<bf16>(WS_U), p.w<bf16>(WS_GV), p.stat(ST_SSQ0 + 2 * layer), p.stat(ST_LNS0 + 2 * j), p.stat(ST_LNQ0 + 2 * j)};
                MK_GEMM(EpiA1, E, p.w<bf16>(WS_HB), 1024, p.w<bf16>(WS_WIN + (size_t)j * 4 * MiB), 1024, 1024, 2048); ENDPH(pb); }
            if (IN_(pb + 1)) REPF(pb + 1) { PH_BEGIN(); a2_spatial(p, j, out + O_CV + (size_t)j * 131072); ENDPH(pb + 1); }
        } else if constexpr (kind == 1) {
            if (IN_(pb)) REPF(pb) { PH_BEGIN(); EpiB1 E{p.w<float>(WS_RAW), p.w<bf16>(WS_CQB), p.stat(ST_SSQ0 + 2 * layer), p.stat(ST_KV), p.stat(ST_Q)};
                MK_GEMM(EpiB1, E, p.w<bf16>(WS_HB), 1024, p.w<bf16>(WS_WDQKV), 1024, 1024, 768); ENDPH(pb); }
            if (IN_(pb + 1)) REPF(pb + 1) { PH_BEGIN(); b2_kvfinal(p, out + O_MP, out + O_MS);
                EpiB2 E{p.w<bf16>(WS_QF), p.stat(ST_Q), p.w<f32x2>(WS_ROPE)};
                MK_GEMM(EpiB2, E, p.w<bf16>(WS_CQB), 384, p.w<bf16>(WS_WQ), 384, 384, 2560); ENDPH(pb + 1); }
            if (IN_(pb + 2)) REPF(pb + 2) { PH_BEGIN(); if (mask & 256) b3_attn_prompt(p); if (mask & 512) b3_attn_sample(p); ENDPH(pb + 2); }
            if (IN_(pb + 3)) REPF(pb + 3) { PH_BEGIN(); b3_combine(p); ENDPH(pb + 3); }
        } else {
            if (IN_(pb)) REPF(pb) { PH_BEGIN(); EpiC1 E{p.w<bf16>(WS_GATE), p.w<float>(WS_XW), p.stat(ST_SSQ0 + 2 * layer)};
                MK_GEMM(EpiC1, E, p.w<bf16>(WS_HB), 1024, p.w<bf16>(WS_WGX), 1024, 1024, 2560); ENDPH(pb); }
            if (IN_(pb + 1)) REPF(pb + 1) { PH_BEGIN(); c2_rglru(p, j, out + O_CP, out + O_CS, out + O_HS); ENDPH(pb + 1); }
            if (IN_(pb + 3)) REPF(pb + 3) { PH_BEGIN(); c5_fixup(p, out + O_HP); ENDPH(pb + 3); }
        }
        if (IN_(pb + 5)) REPF(pb + 5) { PH_BEGIN(); EpiRes E{p.w<float>(WS_H), p.w<bf16>(WS_HB), p.stat(ST_SSQ0 + 2 * layer + 1)}; MK_GEMM(EpiRes, E, p.w<bf16>(resA), resK, p.w<bf16>(resB), resK, resK, 1024); ENDPH(pb + 5); }
        if (IN_(pb + 6)) REPF(pb + 6) { PH_BEGIN(); EpiF1 E{p.w<bf16>(WS_ACT), p.stat(ST_SSQ0 + 2 * layer + 1)}; MK_GEMM(EpiF1, E, p.w<bf16>(WS_HB), 1024, p.w<bf16>(WS_WGU + (size_t)layer * WGU_BYTES), 1024, 1024, 5632); ENDPH(pb + 6); }
        if (IN_(pb + 7)) REPF(pb + 7) { PH_BEGIN(); EpiRes E{p.w<float>(WS_H), p.w<bf16>(WS_HB), p.stat(ST_SSQ0 + 2 * layer + 2)}; MK_GEMM(EpiRes, E, p.w<bf16>(WS_ACT), DFF, p.w<bf16>(WS_WD + (size_t)layer * WD_BYTES), DFF, DFF, 1024); ENDPH(pb + 7); }
}
__global__ void __launch_bounds__(NWAVES * 64, 2) mk_fwd(Args a) {
    extern __shared__ __attribute__((aligned(16))) unsigned char lds_raw[];
    const int tid_ = threadIdx.x;
    const P p0{InTab{(const float* const __attribute__((address_space(4)))*)__builtin_amdgcn_kernarg_segment_ptr()}, a.out, a.ws, (LAS unsigned char*)lds_raw, tid_, tid_ & 63, __builtin_amdgcn_readfirstlane(tid_ >> 6), (int)gridDim.x, (int)blockIdx.x};
    volatile LAS unsigned* MISC = (volatile LAS unsigned*)(p0.lds + MISC_OFF);
    if (p0.tid < 64) MISC[p0.tid] = 0u;
    __syncthreads();
    XcdBarrier bar = xcd_barrier_post((unsigned*)(a.ws + WS_CTL) + CW_BAR + a.li * XCD_BAR_WORDS, MISC + 8);
    const int lo = a.ph_lo, hi = a.ph_hi, mask = a.mask;
    STAMP(0);
    if (IN_(0)) REPF(0) { PH_BEGIN(); p0_prologue(p, mask); if (mask & 128)
        { const int gt = p.bid * 512 + p.tid, NGT = p.G * 512; const u32x4 z = (u32x4){0u, 0u, 0u, 0u};
          for (int i = gt; i < 128 * 128; i += NGT) p.w<u32x4>(WS_UM + (size_t)MT * 2048)[i] = z;
          for (int i = gt; i < 128 * 256; i += NGT) p.w<u32x4>(WS_OB + (size_t)MT * 4096)[i] = z;
          for (int i = gt; i < 128 * 160; i += NGT) p.w<u32x4>(WS_GH + (size_t)MT * 2560)[i] = z; }
        ENDPH(0); }
    run_layer<0>(p0, bar, lo, hi, mask); run_layer<1>(p0, bar, lo, hi, mask); run_layer<2>(p0, bar, lo, hi, mask); run_layer<3>(p0, bar, lo, hi, mask);
    if (IN_(33)) REPF(33) { PH_BEGIN(); final_norm(p, out + O_YP, out + O_YS); VM_WAIT(); STAMP(34); }
#undef IN_
#undef ENDPH
}

inline void fill_args(Args& a, void* const* d_in, float* out, void* d_ws) { for (int i = 0; i < 36; ++i) a.in[i] = (const float*)d_in[i]; a.out = out; a.ws = (unsigned char*)d_ws; a.mask = -1; }
inline int setup_grid() {
    static int grid = 0;
    if (!grid) { int dev = 0, cus = 0; hipGetDevice(&dev); hipDeviceGetAttribute(&cus, hipDeviceAttributeMultiprocessorCount, dev);
        hipFuncSetAttribute((const void*)mk_fwd, hipFuncAttributeMaxDynamicSharedMemorySize, LDS_BYTES);
        int per_cu = 0; hipOccupancyMaxActiveBlocksPerMultiprocessor(&per_cu, (const void*)mk_fwd, NWAVES * 64, LDS_BYTES); (void)hipGetLastError();
        grid = cus > 0 ? cus : 256; }
    return grid;
}
inline void launch_range(void* const* d_in, float* out, void* d_ws, hipStream_t st, int lo, int hi, int li, int mask = -1) {
    Args a{}; fill_args(a, d_in, out, d_ws); a.ph_lo = lo; a.ph_hi = hi; a.li = li; a.mask = mask;
    hipLaunchKernelGGL(mk_fwd, dim3(setup_grid()), dim3(NWAVES * 64), LDS_BYTES, st, a);
}
}

extern "C" void kernel_launch(void* const* d_in, const int* in_sizes, int n_in, void* d_out, int out_size, void* d_ws, size_t ws_size, hipStream_t stream) {
    hipMemsetAsync(d_ws, 0, mk::CTL_BYTES, stream);
    mk::launch_range(d_in, (float*)d_out, d_ws, stream, 0, mk::NPHASE, 0);
}
```

```cpp
#include <hip/hip_runtime.h>
#include <math.h>
#define LAS __attribute__((address_space(3)))
#define GAS __attribute__((address_space(1)))
namespace pg8 {
#define PG8_LAS __attribute__((address_space(3)))
typedef unsigned short bf16_t;
typedef short bf16x8 __attribute__((ext_vector_type(8)));
typedef float f32x4 __attribute__((ext_vector_type(4)));
typedef unsigned u32x4 __attribute__((ext_vector_type(4)));
constexpr int BM = 256, BK = 64, HALF = 128, HTB = HALF * BK * 2  , STAGE_BYTES = 8 * HTB, NXCD = 8, WGM = 8;
__host__ __device__ __forceinline__ int lds_byte(int r, int c) { const int st = (r >> 4) * 2 + (c >> 5), rr = r & 15, cc = c & 31, ob = rr * 64 + cc * 2; return st * 1024 + (ob ^ (((ob >> 9) & 1) << 5)); }
__host__ __device__ __forceinline__ void stage_rc(int b, int& R, int& C) { const int st = b / 1024, sb = b % 1024, swz = sb ^ (((sb >> 9) & 1) << 5); R = (st >> 1) * 16 + swz / 64; C = (st & 1) * 32 + (swz % 64) / 2; }
__host__ __device__ __forceinline__ int perm32(int rho) { const int n = rho >> 4, i = rho & 15; return 8 * (i >> 2) + 4 * n + (i & 3); }
struct Unit { int pm, pn; };
struct Gemm { const bf16_t* A; const bf16_t* Bt; int lda, ldb, K; };
struct StaticOrder {
    int nM, nN, nwg, G, c;
    __host__ __device__ void init(int M, int N, int G_, int c_) { nM = M / BM; nN = N / BM; nwg = nM * nN; G = G_; c = c_; }
    __host__ __device__ bool next(int i, Unit& u) const {
        const long L = (long)i * G + c; if (L >= nwg) return false;
        int wgid = (int)L; { const int q = nwg / NXCD, r = nwg % NXCD, xcd = wgid % NXCD, off = wgid / NXCD; wgid = (xcd < r ? xcd * (q + 1) : r * (q + 1) + (xcd - r) * q) + off; }
        const int nig = WGM * nN, gid = wgid / nig, fm = gid * WGM, gsz = (nM - fm) < WGM ? (nM - fm) : WGM;
        u.pm = fm + ((wgid % nig) % gsz); u.pn = (wgid % nig) / gsz; return true;
    }
    __device__ __forceinline__ void a_ready(const Unit&) const {}
    __device__ __forceinline__ void done(const Unit&) const {}
};
__device__ __forceinline__ unsigned cvt_pk_bf16(float lo, float hi) { unsigned r; asm volatile("v_cvt_pk_bf16_f32 %0, %1, %2" : "=v"(r) : "v"(lo), "v"(hi)); return r; }
template <class Epi, class Sched, bool ALIGN_EPI = false, bool SP2 = false>
__device__ __forceinline__ void gemm_phase(PG8_LAS unsigned char* lds, const Gemm g, const Sched& S, const Epi& E, const int tid) {
    const int wid = __builtin_amdgcn_readfirstlane(tid >> 6), lane = tid & 63, wr = wid >> 2, wc = wid & 3, fr = lane & 15, fq = lane >> 4;
    const int K = g.K, nt = K / BK, lda = g.lda, ldb = g.ldb;
    unsigned voffA[2], voffB[2];
#pragma unroll
    for (int i = 0; i < 2; ++i) { int R, C; stage_rc(tid * 16 + i * 8192, R, C); const int Rb = Epi::PERM ? ((R & ~31) + perm32(R & 31)) : R;
        voffA[i] = (unsigned)(R * lda + C) * 2u; voffB[i] = (unsigned)(Rb * ldb + C) * 2u; }
    const size_t kstep = (size_t)(BK * 2);
    const size_t hstepA = (size_t)HALF * lda * 2, hstepB = (size_t)HALF * ldb * 2;
    const size_t tstepA = 2 * hstepA, tstepB = 2 * hstepB;
    const unsigned ldsw = (unsigned)wid * 1024u;
    const int aoff = lds_byte(wr * 64 + fr, fq * 8), boff = lds_byte(wc * 32 + fr, fq * 8);
#define PG8_SA(b, h) (((b) * 2 + (h)) * HTB)
#define PG8_SB(b, h) ((4 + (b) * 2 + (h)) * HTB)
#define PG8_STAGE(bufoff, gbase, voff) do { _Pragma("unroll") for (int _i = 0; _i < 2; ++_i) \
        __builtin_amdgcn_global_load_lds((const unsigned*)((const char*)(gbase) + (voff)[_i]), (PG8_LAS unsigned*)(lds + (bufoff) + ldsw + _i * 8192), 16, 0, 0); } while (0)
#define PG8_LDA(dst, b, h) do { _Pragma("unroll") for (int m = 0; m < 4; ++m) _Pragma("unroll") for (int k = 0; k < 2; ++k) dst[m][k] = *(const PG8_LAS bf16x8*)(lds + PG8_SA(b, h) + aoff + m * 2048 + k * 1024); } while (0)
#define PG8_LDB(dst, b, h) do { _Pragma("unroll") for (int n = 0; n < 2; ++n) _Pragma("unroll") for (int k = 0; k < 2; ++k) dst[n][k] = *(const PG8_LAS bf16x8*)(lds + PG8_SB(b, h) + boff + n * 2048 + k * 1024); } while (0)
#define PG8_MMA(ai, bj, At, Bt) do { __builtin_amdgcn_s_setprio(1); _Pragma("unroll") for (int m = 0; m < 4; ++m) _Pragma("unroll") for (int n = 0; n < 2; ++n) _Pragma("unroll") for (int k = 0; k < 2; ++k) \
        acc[ai][bj][m][n] = __builtin_amdgcn_mfma_f32_16x16x32_bf16(Bt[n][k], At[m][k], acc[ai][bj][m][n], 0, 0, 0); __builtin_amdgcn_s_setprio(0); } while (0)
#define PG8_WAIT_V(n) asm volatile("s_waitcnt vmcnt(" #n ")" ::: "memory")
#define PG8_WAIT_L(n) asm volatile("s_waitcnt lgkmcnt(" #n ")" ::: "memory")
#define PG8_BAR __builtin_amdgcn_s_barrier()
#define PG8_SCHED __builtin_amdgcn_sched_barrier(0)
    Unit cur, nxt; int ui = 0;
    if (!S.next(0, cur)) return;
    f32x4 acc[2][2][4][2];
#pragma unroll
    for (int a = 0; a < 2; ++a)
#pragma unroll
        for (int b = 0; b < 2; ++b)
#pragma unroll
            for (int m = 0; m < 4; ++m)
#pragma unroll
                for (int n = 0; n < 2; ++n) acc[a][b][m][n] = (f32x4){0.f, 0.f, 0.f, 0.f};
    bf16x8 At[4][2], B0[2][2], B1[2][2];
    const char* cA = (const char*)g.A + (size_t)cur.pm * tstepA; const char* cB = (const char*)g.Bt + (size_t)cur.pn * tstepB;
    S.a_ready(cur);
    if constexpr (SP2) {
        PG8_STAGE(PG8_SB(0, 0), cB, voffB); PG8_STAGE(PG8_SB(0, 1), cB + hstepB, voffB); PG8_STAGE(PG8_SA(0, 0), cA, voffA); PG8_STAGE(PG8_SA(0, 1), cA + hstepA, voffA);
        if (wr == 1) PG8_BAR;
        PG8_WAIT_V(2); PG8_BAR;
        PG8_STAGE(PG8_SB(1, 0), cB + kstep, voffB); PG8_STAGE(PG8_SA(1, 0), cA + kstep, voffA); PG8_STAGE(PG8_SB(1, 1), cB + hstepB + kstep, voffB);
        PG8_WAIT_V(6); PG8_BAR;
    } else {
        PG8_STAGE(PG8_SB(0, 0), cB, voffB); PG8_STAGE(PG8_SA(0, 0), cA, voffA); PG8_STAGE(PG8_SB(0, 1), cB + hstepB, voffB); PG8_STAGE(PG8_SA(0, 1), cA + hstepA, voffA);
        if (wr == 1) PG8_BAR;
        PG8_WAIT_V(4); PG8_BAR;
        PG8_STAGE(PG8_SB(1, 0), cB + kstep, voffB); PG8_STAGE(PG8_SA(1, 0), cA + kstep, voffA); PG8_STAGE(PG8_SB(1, 1), cB + hstepB + kstep, voffB);
        PG8_WAIT_V(6); PG8_BAR;
    }
    for (;;) {
        const bool has_next = S.next(ui + 1, nxt);
        const char* nA = has_next ? (const char*)g.A + (size_t)nxt.pm * tstepA : cA; const char* nB = has_next ? (const char*)g.Bt + (size_t)nxt.pn * tstepB : cB;
        for (int t = 0; t < nt; t += 2) {
            const bool last = (t == nt - 2);
            const char* a1 = cA + (size_t)(t + 1) * kstep;
            const char* a2 = last ? nA : cA + (size_t)(t + 2) * kstep; const char* b2 = last ? nB : cB + (size_t)(t + 2) * kstep;
            const char* a3 = a2 + kstep; const char* b3 = b2 + kstep;
            if (last && has_next) S.a_ready(nxt);
            if constexpr (SP2) {
            PG8_LDB(B0, 0, 0); PG8_LDB(B1, 0, 1); PG8_SCHED; PG8_LDA(At, 0, 0); PG8_STAGE(PG8_SA(1, 1), a1 + hstepA, voffA);
            PG8_WAIT_V(8); PG8_WAIT_L(0); PG8_BAR; PG8_MMA(0, 0, At, B0); PG8_MMA(0, 1, At, B1); PG8_BAR; PG8_SCHED;
            PG8_LDA(At, 0, 1); PG8_STAGE(PG8_SB(0, 0), b2, voffB); PG8_STAGE(PG8_SB(0, 1), b2 + hstepB, voffB); PG8_STAGE(PG8_SA(0, 0), a2, voffA);
            PG8_WAIT_V(8); PG8_WAIT_L(0); PG8_BAR; PG8_MMA(1, 0, At, B0); PG8_MMA(1, 1, At, B1); PG8_BAR; PG8_SCHED;
            PG8_LDB(B0, 1, 0); PG8_LDB(B1, 1, 1); PG8_SCHED; PG8_LDA(At, 1, 0); PG8_STAGE(PG8_SA(0, 1), a2 + hstepA, voffA);
            PG8_WAIT_V(8); PG8_WAIT_L(0); PG8_BAR; PG8_MMA(0, 0, At, B0); PG8_MMA(0, 1, At, B1); PG8_BAR; PG8_SCHED;
            PG8_LDA(At, 1, 1); PG8_STAGE(PG8_SB(1, 0), b3, voffB); PG8_STAGE(PG8_SB(1, 1), b3 + hstepB, voffB); PG8_STAGE(PG8_SA(1, 0), a3, voffA);
            PG8_WAIT_V(8); PG8_WAIT_L(0); PG8_BAR; PG8_MMA(1, 0, At, B0); PG8_MMA(1, 1, At, B1); PG8_BAR; PG8_SCHED;
            } else {
            PG8_LDB(B0, 0, 0); PG8_SCHED; PG8_LDA(At, 0, 0); PG8_STAGE(PG8_SA(1, 1), a1 + hstepA, voffA);
            PG8_WAIT_L(8); PG8_BAR; PG8_WAIT_L(0); PG8_MMA(0, 0, At, B0); PG8_BAR; PG8_SCHED;
            PG8_LDB(B1, 0, 1); PG8_STAGE(PG8_SB(0, 0), b2, voffB);
            PG8_BAR; PG8_WAIT_L(0); PG8_MMA(0, 1, At, B1); PG8_BAR;
            PG8_LDA(At, 0, 1); PG8_STAGE(PG8_SA(0, 0), a2, voffA);
            PG8_BAR; PG8_WAIT_L(0); PG8_MMA(1, 0, At, B0); PG8_BAR; PG8_SCHED;
            PG8_STAGE(PG8_SB(0, 1), b2 + hstepB, voffB);
            PG8_WAIT_V(6); PG8_BAR; PG8_MMA(1, 1, At, B1); PG8_BAR;
            PG8_LDB(B0, 1, 0); PG8_SCHED; PG8_LDA(At, 1, 0); PG8_STAGE(PG8_SA(0, 1), a2 + hstepA, voffA);
            PG8_WAIT_L(8); PG8_BAR; PG8_WAIT_L(0); PG8_MMA(0, 0, At, B0); PG8_BAR; PG8_SCHED;
            PG8_LDB(B1, 1, 1); PG8_STAGE(PG8_SB(1, 0), b3, voffB);
            PG8_BAR; PG8_WAIT_L(0); PG8_MMA(0, 1, At, B1); PG8_BAR;
            PG8_LDA(At, 1, 1); PG8_STAGE(PG8_SA(1, 0), a3, voffA);
            PG8_BAR; PG8_WAIT_L(0); PG8_MMA(1, 0, At, B0); PG8_BAR; PG8_SCHED;
            PG8_STAGE(PG8_SB(1, 1), b3 + hstepB, voffB);
            PG8_WAIT_V(6); PG8_BAR; PG8_MMA(1, 1, At, B1); PG8_BAR;
            }
        }
        if constexpr (ALIGN_EPI) { if (wr == 0) PG8_BAR; }
        if constexpr (!Epi::AFTER_DRAIN) { E(acc, cur, wr, wc, fr, fq); S.done(cur); }
        if (!has_next) break;
#pragma unroll
        for (int a = 0; a < 2; ++a)
#pragma unroll
            for (int b = 0; b < 2; ++b)
#pragma unroll
                for (int m = 0; m < 4; ++m)
#pragma unroll
                    for (int n = 0; n < 2; ++n) acc[a][b][m][n] = (f32x4){0.f, 0.f, 0.f, 0.f};
        cur = nxt; cA = nA; cB = nB; ++ui;
        if constexpr (ALIGN_EPI) { if (wr == 1) PG8_BAR; }
    }
    PG8_WAIT_V(0);
    if constexpr (!ALIGN_EPI) { if (wr == 0) PG8_BAR; }
    PG8_BAR;
    if constexpr (Epi::AFTER_DRAIN) { E.fused(acc, cur, wr, wc, fr, fq, lds, wid, lane); S.done(cur); }
#undef PG8_SA
#undef PG8_SB
#undef PG8_STAGE
#undef PG8_LDA
#undef PG8_LDB
#undef PG8_MMA
#undef PG8_WAIT_V
#undef PG8_WAIT_L
#undef PG8_BAR
#undef PG8_SCHED
}

}

namespace mk {
using pg8::f32x4; using pg8::bf16x8; using pg8::u32x4; using pg8::cvt_pk_bf16;
typedef unsigned short bf16;
typedef unsigned u32x2 __attribute__((ext_vector_type(2)));
typedef short s16x4 __attribute__((ext_vector_type(4)));
typedef float f32x2 __attribute__((ext_vector_type(2)));
typedef GAS unsigned gu32;
#define RLX_AGENT __ATOMIC_RELAXED, __HIP_MEMORY_SCOPE_AGENT
#define XB_TMO      128
#define XB_XCNT(j)  (256  + 64 * (j))
#define XB_XSUB(j)  (1280 + 64 * (j))
#define XB_XGEN(j)  (2304 + 64 * (j))
#define XB_TOP      3328
#define XB_TOPGEN   3392
#define XCD_BAR_WORDS 3456
#define XB_SPIN_CAP (1u << 18)

__device__ __forceinline__ unsigned xb_ld(unsigned* p)              { return __hip_atomic_load(p, __ATOMIC_RELAXED, __HIP_MEMORY_SCOPE_AGENT); }
__device__ __forceinline__ unsigned xb_add(unsigned* p, unsigned v) { return __hip_atomic_fetch_add(p, v, __ATOMIC_RELAXED, __HIP_MEMORY_SCOPE_AGENT); }
__device__ __forceinline__ unsigned xb_xcc_id() { return (unsigned)__builtin_amdgcn_s_getreg((3 << 11) | 20) & 0xFu; }
#define XB_SPIN(cond, bar) do { unsigned _sp = 0; while (cond) { __builtin_amdgcn_s_sleep(1); \
    if ((++_sp & 255u) == 0u) { if (xb_ld(&(bar)[XB_TMO])) break; if (_sp > XB_SPIN_CAP) { atomicAdd(&(bar)[XB_TMO], 1u); break; } } } } while (0)

struct XcdBarrier {
    unsigned* bar; unsigned x;
    volatile LAS unsigned* st;
};

__device__ __forceinline__ XcdBarrier xcd_barrier_post(unsigned* bar, volatile LAS unsigned* st) {
    XcdBarrier b; b.bar = bar; b.x = xb_xcc_id(); b.st = st;
    if (threadIdx.x == 0) (void)xb_add(&bar[XB_XCNT(b.x)], 1u);
    return b;
}
__device__ __forceinline__ void xcd_barrier_complete(unsigned* bar, unsigned x, unsigned& nloc, unsigned& nx) {
    const unsigned G = gridDim.x * gridDim.y * gridDim.z;
    unsigned sum, cnt, mine, sp = 0u;
    for (;;) {
        sum = 0u; cnt = 0u; mine = 0u;
#pragma unroll
        for (unsigned j = 0; j < 16; ++j) { const unsigned c = xb_ld(&bar[XB_XCNT(j)]); sum += c; cnt += (c > 0u) ? 1u : 0u; mine = (j == x) ? c : mine; }
        if (sum == G) break;
        __builtin_amdgcn_s_sleep(1);
        if ((++sp & 255u) == 0u) { if (xb_ld(&bar[XB_TMO])) break; if (sp > XB_SPIN_CAP) { atomicAdd(&bar[XB_TMO], 1u); break; } }
    }
    nloc = mine > 0u ? mine : 1u; nx = cnt > 0u ? cnt : 1u;
}

__device__ __forceinline__ void xcd_barrier(const XcdBarrier& b) {
    asm volatile("s_waitcnt vmcnt(0)" ::: "memory");
    __syncthreads();
    if (threadIdx.x == 0) {
        unsigned* bar = b.bar;
        __builtin_amdgcn_s_waitcnt(0);
        unsigned nloc = b.st[0], nx = b.st[1];
        if (nloc == 0u) { xcd_barrier_complete(bar, b.x, nloc, nx); b.st[0] = nloc; b.st[1] = nx; }
        const unsigned old = xb_add(&bar[XB_XSUB(b.x)], 1u);
        const unsigned gen = old / nloc;
        if (old + 1u == (gen + 1u) * nloc) {
            __builtin_amdgcn_fence(__ATOMIC_RELEASE, "agent");
            asm volatile("s_waitcnt vmcnt(0)" ::: "memory");
            const unsigned og = xb_add(&bar[XB_TOP], 1u);
            const unsigned tg = og / nx;
            if (og + 1u == (tg + 1u) * nx) xb_add(&bar[XB_TOPGEN], 1u);
            else XB_SPIN(xb_ld(&bar[XB_TOPGEN]) == tg, bar);
            __builtin_amdgcn_fence(__ATOMIC_ACQUIRE, "agent");
            xb_add(&bar[XB_XGEN(b.x)], 1u);
            asm volatile("s_waitcnt vmcnt(0)" ::: "memory");
        } else {
            XB_SPIN(xb_ld(&bar[XB_XGEN(b.x)]) == gen, bar);
            __builtin_amdgcn_fence(__ATOMIC_ACQUIRE, "agent");
            asm volatile("s_waitcnt vmcnt(0)" ::: "memory");
        }
    }
    __syncthreads();
}


constexpr int MP = 16384, MS = 128, MT = MP + MS, MR = 16640;
constexpr int D = 1024, DFF = 2816, NWAVES = 8;
constexpr float RMS_EPS = 1e-6f, LN_EPS = 1e-5f;
constexpr float MLA_SCALE = 0.07216878364870322f;
constexpr size_t MiB = 1u << 20;
constexpr size_t WS_CTL = 0, CTL_BYTES = 3 * MiB;
constexpr int CW_BAR = 4096;
constexpr size_t ST_OFF = 65536, ST_STRIDE = (size_t)MR * 8;
constexpr int ST_SSQ0 = 0  , ST_LNS0 = 9, ST_LNQ0 = 10  , ST_KV = 13, ST_Q = 14, NSTAT = 15;
static_assert(ST_OFF + NSTAT * ST_STRIDE <= CTL_BYTES, "stats inside CTL");
constexpr size_t WS_WGU = 3 * MiB, WGU_BYTES = 11 * MiB, WS_WD = 47 * MiB, WD_BYTES = 5767168, WS_WIN = 69 * MiB, WS_WOUT = 77 * MiB, WS_WS = 81 * MiB,
                 WS_WDQKV = 82 * MiB, WS_WQ = 84 * MiB, WS_WOV = 86 * MiB, WS_WGX = 90 * MiB, WS_WAT = 95 * MiB, WS_WIT = 95 * MiB + 512 * 1024, WS_WCO = 96 * MiB, WS_ROPE = 99 * MiB;
constexpr size_t WS_H = 100 * MiB, WS_HB = 165 * MiB, WS_U = 198 * MiB, WS_GV = 231 * MiB, WS_UM = 264 * MiB, WS_ACT = 297 * MiB, WS_RAW = 387 * MiB, WS_CQB = 436 * MiB,
                 WS_QF = 449 * MiB, WS_KVB = 531 * MiB, WS_OB = 542 * MiB, WS_PART = 607 * MiB, WS_PML = 623 * MiB, WS_GATE = 624 * MiB, WS_XW = 665 * MiB, WS_AA = 747 * MiB, WS_BB = 829 * MiB,
                 WS_AGG = 911 * MiB, WS_GH = 914 * MiB, WS_PROF = 955 * MiB, WS_MK_END = 956 * MiB;
constexpr int RING_BYTES = 131072, LDS_BYTES = 147456, MISC_OFF = LDS_BYTES - 256;
constexpr size_t O_YP = 0, O_YS = 16777216, O_CV = 16908288, O_MP = 17170432, O_MS = 22413312, O_HP = 22454272, O_HS = 22464512, O_CP = 22505472, O_CS = 22536192, O_END = 22659072;

__device__ __forceinline__ float fast_sigmoid_l2(float t) { return __builtin_amdgcn_rcpf(1.0f + __builtin_amdgcn_exp2f(-t)); }
__device__ __forceinline__ float gelu_tanh_f(float x) { return x * fast_sigmoid_l2(2.302208198f * (x + 0.044715f * x * x * x)); }
__device__ __forceinline__ float silu_f(float x) { return x * fast_sigmoid_l2(1.4426950409f * x); }
__device__ __forceinline__ unsigned f2bf(float f) { unsigned u = __builtin_bit_cast(unsigned, f); return (u + 0x7fffu + ((u >> 16) & 1u)) >> 16; }
__device__ __forceinline__ unsigned pk2(float lo, float hi) { return f2bf(lo) | (f2bf(hi) << 16); }
__device__ __forceinline__ float bf2f(unsigned short b) { return __builtin_bit_cast(float, (unsigned)b << 16); }
__device__ __forceinline__ float bflo(unsigned w) { return __builtin_bit_cast(float, w << 16); }
__device__ __forceinline__ float bfhi(unsigned w) { return __builtin_bit_cast(float, w & 0xffff0000u); }
constexpr float ST_SCALE = 16777216.0f, ST_INV = 1.0f / 16777216.0f;
__device__ __forceinline__ void stat_add(long long* p, float v) { atomicAdd((unsigned long long*)p, (unsigned long long)(long long)__float2ll_rn(v * ST_SCALE)); }
__device__ __forceinline__ void stat_set(long long* p, float v) { *p = (long long)__float2ll_rn(v * ST_SCALE); }
__device__ __forceinline__ float stat_get(const long long* p) { return (float)(*p) * ST_INV; }
#define LDS_WAIT() asm volatile("s_waitcnt lgkmcnt(0)" ::: "memory")
#define VM_WAIT() asm volatile("s_waitcnt vmcnt(0)" ::: "memory")

struct InTab { const float* const __attribute__((address_space(4)))* t; __device__ __forceinline__ const float* operator[](int i) const { return t[i]; } };
struct P {
    InTab in; float* out; unsigned char* ws;
    LAS unsigned char* lds; int tid, lane, wave, G, bid;
    __device__ __forceinline__ long long* stat(int a) const { return (long long*)(ws + ST_OFF + (size_t)a * ST_STRIDE); }
    template <class T> __device__ __forceinline__ T* w(size_t off) const { return (T*)(ws + off); }
};
}
namespace mk {
struct TrJob { const float* src; int ldsrc, K, N; bf16* dst; int lddst; const float* gain; int kind, off; };
__device__ __forceinline__ int tr_rowmap(int kind, int off, int n) { return kind == 1 ? ((n >> 7) * 256 + (n & 127) + off) : (off + n); }
__device__ __forceinline__ void tr_item(const TrJob& j, LAS float* scr, int item, int lane) {
    const int nblk = j.N / 32, kb = item / nblk, nb = item % nblk, k0 = 64 * kb, n0 = 32 * nb;
    const float* src = j.src + (size_t)(k0 + (lane >> 5)) * j.ldsrc + n0 + (lane & 31); const size_t rstep = (size_t)2 * j.ldsrc;
    float v[32];
#pragma unroll
    for (int i = 0; i < 32; ++i) v[i] = src[i * rstep];
    if (j.gain) { const float* gp = j.gain + k0 + (lane >> 5); float g[32];
#pragma unroll
        for (int i = 0; i < 32; ++i) g[i] = gp[2 * i];
#pragma unroll
        for (int i = 0; i < 32; ++i) v[i] *= g[i]; }
#pragma unroll
    for (int i = 0; i < 32; ++i) scr[(2 * i + (lane >> 5)) * 33 + (lane & 31)] = v[i];
    LDS_WAIT(); asm volatile("" ::: "memory");
    const int c = lane & 7;
#pragma unroll
    for (int jj = 0; jj < 4; ++jj) { const int n = (lane >> 3) + 8 * jj; const LAS float* s = scr + (8 * c) * 33 + n;
        u32x4 o; o.x = pk2(s[0], s[33]); o.y = pk2(s[66], s[99]); o.z = pk2(s[132], s[165]); o.w = pk2(s[198], s[231]);
        *(u32x4*)(j.dst + (size_t)tr_rowmap(j.kind, j.off, n0 + n) * j.lddst + k0 + 8 * c) = o; }
    LDS_WAIT(); asm volatile("" ::: "memory");
}
constexpr int NJOBS = 24;
__device__ __forceinline__ TrJob get_job(const P& p, int jid) {
    TrJob j; j.gain = nullptr; j.kind = 0; j.off = 0; j.src = nullptr; j.dst = nullptr; j.ldsrc = 0; j.K = 0; j.N = 0; j.lddst = 0;
    if (jid < 12) { const int l = jid / 3, t = jid % 3;
        if (t < 2) { j.src = p.in[33 + t] + (size_t)l * D * DFF; j.ldsrc = DFF; j.K = D; j.N = DFF; j.dst = p.w<bf16>(WS_WGU + l * WGU_BYTES); j.lddst = D; j.gain = p.in[7] + l * D; j.kind = 1; j.off = 128 * t; }
        else { j.src = p.in[35] + (size_t)l * DFF * D; j.ldsrc = D; j.K = DFF; j.N = D; j.dst = p.w<bf16>(WS_WD + l * WD_BYTES); j.lddst = DFF; }
    } else if (jid < 16) { const int a = (jid - 12) >> 1;
        if (((jid - 12) & 1) == 0) { j.src = p.in[9] + (size_t)a * D * 2048; j.ldsrc = 2048; j.K = D; j.N = 2048; j.dst = p.w<bf16>(WS_WIN + a * 4 * MiB); j.lddst = D; j.gain = p.in[6] + (3 * a) * D; }
        else { j.src = p.in[14] + (size_t)a * D * D; j.ldsrc = D; j.K = D; j.N = D; j.dst = p.w<bf16>(WS_WOUT + a * 2 * MiB); j.lddst = D; }
    } else if (jid == 16) { j.src = p.in[15]; j.ldsrc = 384; j.K = D; j.N = 384; j.dst = p.w<bf16>(WS_WDQKV); j.lddst = D; j.gain = p.in[6] + D; j.off = 256; }
    else if (jid == 17) { j.src = p.in[18]; j.ldsrc = 320; j.K = D; j.N = 256; j.dst = p.w<bf16>(WS_WDQKV); j.lddst = D; j.gain = p.in[6] + D; j.off = 0; }
    else if (jid == 18) { j.src = p.in[18] + 256; j.ldsrc = 320; j.K = D; j.N = 64; j.dst = p.w<bf16>(WS_WDQKV); j.lddst = D; j.gain = p.in[6] + D; j.off = 640; }
    else if (jid == 19) { j.src = p.in[24]; j.ldsrc = 1280; j.K = D; j.N = 1280; j.dst = p.w<bf16>(WS_WGX); j.lddst = D; j.gain = p.in[6] + 2 * D; j.off = 0; }
    else if (jid == 20) { j.src = p.in[23]; j.ldsrc = 1280; j.K = D; j.N = 1280; j.dst = p.w<bf16>(WS_WGX); j.lddst = D; j.gain = p.in[6] + 2 * D; j.off = 1280; }
    else if (jid == 21) { j.src = p.in[32]; j.ldsrc = D; j.K = 1280; j.N = D; j.dst = p.w<bf16>(WS_WCO); j.lddst = 1280; }
    else if (jid == 22) { j.src = p.in[27]; j.ldsrc = 128; j.K = 128; j.N = 128; j.dst = p.w<bf16>(WS_WAT); j.lddst = 128; j.kind = 2; }
    else { j.src = p.in[29]; j.ldsrc = 128; j.K = 128; j.N = 128; j.dst = p.w<bf16>(WS_WIT); j.lddst = 128; j.kind = 2; }
    return j;
}
__device__ __forceinline__ int job_items(const TrJob& j) { return j.kind == 2 ? 80 : (j.K / 64) * (j.N / 32); }

__device__ __forceinline__ void p0_prologue(const P& p, const int mask) {
    LAS float* scr = (LAS float*)(p.lds + p.wave * 16384);
    const int gw = p.bid * NWAVES + p.wave, NGW = p.G * NWAVES, lane = p.lane;
    const int gt = p.bid * (NWAVES * 64) + p.tid, NGT = p.G * NWAVES * 64;
    if (mask & 1) {
    {
        int base = 0;
        for (int jid = 0; jid < NJOBS; ++jid) {
            TrJob j = get_job(p, jid); const int nit = job_items(j);
            int first = (gw - base % NGW + NGW) % NGW;
            for (int it = first; it < nit; it += NGW) {
                if (j.kind == 2) { TrJob b = j; const int blk = it >> 3; b.src = j.src + (size_t)blk * 16384; b.dst = j.dst + (size_t)blk * 16384; b.kind = 0; tr_item(b, scr, it & 7, lane); }
                else tr_item(j, scr, it, lane);
            }
            base += nit;
        }
    }
    }
    if (mask & 2) {
    { u32x4* z = (u32x4*)(p.w<bf16>(WS_WDQKV) + (size_t)704 * D); for (int i = gt; i < 64 * D / 8; i += NGT) z[i] = (u32x4){0u, 0u, 0u, 0u}; }
    }
    if (mask & 4) {
    for (int i = gt; i < 2 * 8 * 128 * 16; i += NGT) {
        const int s0 = (i & 15) * 8, t = (i >> 4) & 127, jg = i >> 11; const float* src = p.in[12] + (size_t)jg * 16384;
        unsigned w[4], ws_[4];
#pragma unroll
        for (int e = 0; e < 4; ++e) { float v[2], vs[2];
#pragma unroll
            for (int h = 0; h < 2; ++h) { const int s = s0 + 2 * e + h; v[h] = (s <= t) ? src[t * 128 + s] : 0.f; vs[h] = ((s >> 2) == (t >> 2) && (s & 3) <= (t & 3)) ? src[(t & 3) * 128 + (s & 3)] : 0.f; }
            w[e] = pk2(v[0], v[1]); ws_[e] = pk2(vs[0], vs[1]); }
        const int j = jg >> 3, g = jg & 7;
        *(u32x4*)(p.w<bf16>(WS_WS + (size_t)j * 262144) + ((size_t)g * 128 + t) * 128 + s0) = (u32x4){w[0], w[1], w[2], w[3]};
        *(u32x4*)(p.w<bf16>(WS_WS + 524288 + (size_t)j * 262144) + ((size_t)g * 128 + t) * 128 + s0) = (u32x4){ws_[0], ws_[1], ws_[2], ws_[3]};
    }
    }
    if (mask & 8) {
    for (int i = gt; i < 2052 * 32; i += NGT) { const int tp = i >> 5, fi = i & 31, pos = tp < 2048 ? tp : 16384 + (tp - 2048);
        const float inv = 1.0f / powf(10000.0f, (float)(2 * fi) / 64.0f); const float ang = (float)pos * inv;
        p.w<f32x2>(WS_ROPE)[i] = (f32x2){cosf(ang), sinf(ang)}; }
    }
    if (mask & 16) {
    { float* H = p.w<float>(WS_H); bf16* HB = p.w<bf16>(WS_HB); long long* ssq = p.stat(ST_SSQ0);
      for (int m = gw; m < MR; m += NGW) {
        f32x4 v[4]; float s = 0.f;
#pragma unroll
        for (int jj = 0; jj < 4; ++jj) { const int c = 4 * lane + 256 * jj;
            if (m < MP) v[jj] = *(const f32x4*)(p.in[0] + (size_t)m * D + c); else if (m < MT) v[jj] = *(const f32x4*)(p.in[1] + (size_t)(m - MP) * D + c); else v[jj] = (f32x4){0.f, 0.f, 0.f, 0.f};
            s += (v[jj].x * v[jj].x + v[jj].y * v[jj].y) + (v[jj].z * v[jj].z + v[jj].w * v[jj].w); }
#pragma unroll
        for (int o = 1; o < 64; o <<= 1) s += __shfl_xor(s, o);
#pragma unroll
        for (int jj = 0; jj < 4; ++jj) { const int c = 4 * lane + 256 * jj; *(f32x4*)(H + (size_t)m * D + c) = v[jj];
            *(u32x2*)(HB + (size_t)m * D + c) = (u32x2){pk2(v[jj].x, v[jj].y), pk2(v[jj].z, v[jj].w)}; }
        if (lane == 0) stat_set(ssq + m, s);
      } }
    }
    if (mask & 32) {
    { const float* wuq = p.in[17]; const float* wuk = p.in[20]; const float* qn = p.in[16]; bf16* Wq = p.w<bf16>(WS_WQ);
      LAS float* Qs = (LAS float*)p.lds;
      for (int it = p.bid; it < 192; it += p.G) {
        const int h = it / 24, kb = (it >> 2) % 6, cq = it & 3, k0 = 64 * kb;
        __syncthreads();
#pragma unroll
        for (int q = 0; q < 4; ++q) { const int idx = p.tid + 512 * q, row = idx >> 5, c4 = idx & 31; *(LAS f32x4*)(Qs + row * 132 + c4 * 4) = *(const f32x4*)(wuq + (size_t)(k0 + row) * 1536 + h * 192 + c4 * 4); }
        __syncthreads();
        const int c0 = cq * 64 + p.wave * 8; float acc[8];
#pragma unroll
        for (int cc = 0; cc < 8; ++cc) acc[cc] = 0.f;
        for (int n4 = 0; n4 < 32; ++n4) { const f32x4 bv = *(const LAS f32x4*)(Qs + lane * 132 + n4 * 4);
#pragma unroll
            for (int cc = 0; cc < 8; ++cc) { const f32x4 av = *(const f32x4*)(wuk + (size_t)(c0 + cc) * 1024 + h * 128 + n4 * 4); acc[cc] += (av.x * bv.x + av.y * bv.y) + (av.z * bv.z + av.w * bv.w); } }
        const float g = qn[k0 + lane];
#pragma unroll
        for (int cc = 0; cc < 8; ++cc) Wq[(size_t)(320 * h + c0 + cc) * 384 + k0 + lane] = (bf16)f2bf(acc[cc] * g);
      }
      for (int r = gw; r < 512; r += NGW) { const int h = r >> 6, ie = r & 63, i = ie >> 1, e = ie & 1;
#pragma unroll
        for (int kk = 0; kk < 6; ++kk) { const int k = lane + 64 * kk; Wq[(size_t)(320 * h + 256 + ie) * 384 + k] = (bf16)f2bf(wuq[(size_t)k * 1536 + h * 192 + 128 + 32 * e + i] * qn[k]); } } }
    }
    if (mask & 64) {
    { const float* wuv = p.in[21]; const float* wo = p.in[22]; bf16* Wov = p.w<bf16>(WS_WOV);
      for (int it = gw; it < 2048; it += NGW) { const int h = it >> 8, cg = (it >> 2) & 63, nb = it & 3, c0 = cg * 4, n = nb * 256 + lane * 4;
        f32x4 acc[4];
#pragma unroll
        for (int cc = 0; cc < 4; ++cc) acc[cc] = (f32x4){0.f, 0.f, 0.f, 0.f};
        for (int v = 0; v < 128; ++v) { const f32x4 b = *(const f32x4*)(wo + (size_t)(h * 128 + v) * D + n);
#pragma unroll
            for (int cc = 0; cc < 4; ++cc) { const float a = wuv[(size_t)(c0 + cc) * 1024 + h * 128 + v]; acc[cc] += b * a; } }
#pragma unroll
        for (int jn = 0; jn < 4; ++jn) *(u32x2*)(Wov + (size_t)(n + jn) * 2048 + h * 256 + c0) = (u32x2){pk2(acc[0][jn], acc[1][jn]), pk2(acc[2][jn], acc[3][jn])};
      } }
    }
}
}
namespace mk {
#ifdef MK_DRYPROBE
#define MK_DRY(E) ((E).dry)
#define MK_DRYFIELD int dry;
#else
#define MK_DRY(E) 0
#define MK_DRYFIELD
#endif
typedef const f32x4 (&AccRef)[2][2][4][2];
__device__ __forceinline__ float quad_red(float v) { v += __shfl_xor(v, 16); v += __shfl_xor(v, 32); return v; }
__device__ __forceinline__ u32x4 pack8(const f32x4 a, const f32x4 b) { u32x4 w; w.x = cvt_pk_bf16(a[0], a[1]); w.y = cvt_pk_bf16(a[2], a[3]); w.z = cvt_pk_bf16(b[0], b[1]); w.w = cvt_pk_bf16(b[2], b[3]); return w; }
__device__ __forceinline__ float sumsq8(const f32x4 a, const f32x4 b) { return ((a[0] * a[0] + a[1] * a[1]) + (a[2] * a[2] + a[3] * a[3])) + ((b[0] * b[0] + b[1] * b[1]) + (b[2] * b[2] + b[3] * b[3])); }
__device__ __forceinline__ float sum8(const f32x4 a, const f32x4 b) { return ((a[0] + a[1]) + (a[2] + a[3])) + ((b[0] + b[1]) + (b[2] + b[3])); }
#define MK_EPI_CALL() \
    __device__ __forceinline__ void operator()(AccRef acc, const pg8::Unit& u, int wr, int wc, int fr, int fq) const { \
        _Pragma("unroll") for (int ai = 0; ai < 2; ++ai) _Pragma("unroll") for (int m = 0; m < 4; ++m) \
            rg(u.pm * 256 + ai * 128 + wr * 64 + m * 16 + fr, u.pn, wc, fq, acc[ai][0][m][0], acc[ai][0][m][1], acc[ai][1][m][0], acc[ai][1][m][1]); }
#define MK_EPI_CALL_DENSE() \
    __device__ __forceinline__ void operator()(AccRef acc, const pg8::Unit& u, int wr, int wc, int fr, int fq) const { \
        _Pragma("unroll") for (int ai = 0; ai < 2; ++ai) { float s1 = 0.f, s2 = 0.f; \
            _Pragma("unroll") for (int m = 0; m < 4; ++m) { float t1, t2; \
                rgs(u.pm * 256 + ai * 128 + wr * 64 + m * 16 + fr, u.pn, wc, fq, acc[ai][0][m][0], acc[ai][0][m][1], acc[ai][1][m][0], acc[ai][1][m][1], t1, t2); \
                s1 = (fq == m) ? t1 : s1; s2 = (fq == m) ? t2 : s2; } \
            stats(u.pm * 256 + ai * 128 + wr * 64 + fq * 16 + fr, u.pn, s1, s2); } } \
    __device__ __forceinline__ void rg(int r, int pn, int wc, int fq, f32x4 a0, f32x4 b0, f32x4 a1, f32x4 b1) const { float t1, t2; rgs(r, pn, wc, fq, a0, b0, a1, b1, t1, t2); if (fq == 0) stats(r, pn, t1, t2); }

struct EpiA1 {
    static constexpr bool PERM = true, AFTER_DRAIN = false;
    bf16* U; bf16* GV; const long long* ssq; long long* lns; long long* lnq; MK_DRYFIELD
    __device__ __forceinline__ void rgs(int r, int pn, int wc, int fq, f32x4 a0, f32x4 b0, f32x4 a1, f32x4 b1, float& s1, float& s2) const {
        const bool isv = pn >= 4; bf16* dst = (isv ? GV : U) + (size_t)r * 1024 + (pn & 3) * 256 + wc * 32 + 8 * fq; const float rs = rsqrtf(stat_get(ssq + r) * (1.0f / 1024.0f) + RMS_EPS);
        a0 *= rs; b0 *= rs; a1 *= rs; b1 *= rs;
#pragma unroll
        for (int e = 0; e < 4; ++e) { a0[e] = gelu_tanh_f(a0[e]); b0[e] = gelu_tanh_f(b0[e]); a1[e] = gelu_tanh_f(a1[e]); b1[e] = gelu_tanh_f(b1[e]); }
        *(u32x4*)dst = pack8(a0, b0); *(u32x4*)(dst + 128) = pack8(a1, b1);
        s1 = 0.f; s2 = 0.f;
        if (isv) { s1 = quad_red(sum8(a0, b0) + sum8(a1, b1)); s2 = quad_red(sumsq8(a0, b0) + sumsq8(a1, b1)); }
    }
    __device__ __forceinline__ void stats(int r, int pn, float s1, float s2) const { if (pn >= 4 && !MK_DRY(*this)) { stat_add(lns + r, s1); stat_add(lnq + r, s2); } }
    MK_EPI_CALL_DENSE()
};
struct EpiRes {
    static constexpr bool PERM = true, AFTER_DRAIN = false;
    float* H; bf16* HB; long long* ssq_out; MK_DRYFIELD
    __device__ __forceinline__ void rgs(int r, int pn, int wc, int fq, f32x4 a0, f32x4 b0, f32x4 a1, f32x4 b1, float& s1, float& s2) const {
        const size_t o = (size_t)r * 1024 + pn * 256 + wc * 32 + 8 * fq; float* hp = H + o;
        a0 += *(const f32x4*)hp; b0 += *(const f32x4*)(hp + 4); a1 += *(const f32x4*)(hp + 128); b1 += *(const f32x4*)(hp + 132);
        s1 = quad_red(sumsq8(a0, b0) + sumsq8(a1, b1)); s2 = 0.f;
        if (MK_DRY(*this)) { if (s1 == 12345.678f) *(f32x4*)hp = a0; return; }
        *(f32x4*)hp = a0; *(f32x4*)(hp + 4) = b0; *(f32x4*)(hp + 128) = a1; *(f32x4*)(hp + 132) = b1;
        *(u32x4*)(HB + o) = pack8(a0, b0); *(u32x4*)(HB + o + 128) = pack8(a1, b1);
    }
    __device__ __forceinline__ void stats(int r, int pn, float s1, float s2) const { if (!MK_DRY(*this)) stat_add(ssq_out + r, s1); }
    MK_EPI_CALL_DENSE()
};
struct EpiF1 {
    static constexpr bool PERM = true, AFTER_DRAIN = false;
    bf16* ACT; const long long* ssq;
    __device__ __forceinline__ void rg(int r, int pn, int wc, int fq, f32x4 a0, f32x4 b0, f32x4 a1, f32x4 b1) const {
        const float rs = rsqrtf(stat_get(ssq + r) * (1.0f / 1024.0f) + RMS_EPS); f32x4 a, b;
#pragma unroll
        for (int e = 0; e < 4; ++e) { a[e] = silu_f(a0[e] * rs) * (a1[e] * rs); b[e] = silu_f(b0[e] * rs) * (b1[e] * rs); }
        *(u32x4*)(ACT + (size_t)r * DFF + pn * 128 + wc * 32 + 8 * fq) = pack8(a, b);
    }
    MK_EPI_CALL()
};
struct EpiB1 {
    static constexpr bool PERM = true, AFTER_DRAIN = false;
    float* RAW; bf16* CQB; const long long* ssq; long long* ssq_kv; long long* ssq_q; MK_DRYFIELD
    __device__ __forceinline__ void half(int r, int c, f32x4 a, f32x4 b, float& qkv, float& qq) const {
        if (c < 256) { *(f32x4*)(RAW + (size_t)r * 768 + c) = a; *(f32x4*)(RAW + (size_t)r * 768 + c + 4) = b; qkv += sumsq8(a, b); }
        else if (c < 640) { *(u32x4*)(CQB + (size_t)r * 384 + (c - 256)) = pack8(a, b); qq += sumsq8(a, b); }
        else if (c < 704) { *(f32x4*)(RAW + (size_t)r * 768 + c) = a; *(f32x4*)(RAW + (size_t)r * 768 + c + 4) = b; } }
    __device__ __forceinline__ void rgs(int r, int pn, int wc, int fq, f32x4 a0, f32x4 b0, f32x4 a1, f32x4 b1, float& s1, float& s2) const {
        const float rs = rsqrtf(stat_get(ssq + r) * (1.0f / 1024.0f) + RMS_EPS); const int c = pn * 256 + wc * 32 + 8 * fq; float qkv = 0.f, qq = 0.f;
        half(r, c, a0 * rs, b0 * rs, qkv, qq); half(r, c + 128, a1 * rs, b1 * rs, qkv, qq);
        s1 = quad_red(qkv); s2 = quad_red(qq);
    }
    __device__ __forceinline__ void stats(int r, int pn, float s1, float s2) const { if (!MK_DRY(*this)) { if (pn == 0) stat_add(ssq_kv + r, s1); else stat_add(ssq_q + r, s2); } }
    MK_EPI_CALL_DENSE()
};
struct EpiB2 {
    static constexpr bool PERM = true, AFTER_DRAIN = false;
    bf16* QF; const long long* ssq_q; const f32x2* rope;
    __device__ __forceinline__ void half(int r, int c, int tp, const f32x4 a, const f32x4 b) const {
        const int h = c / 320, w = c - h * 320;
        if (w < 256) *(u32x4*)(QF + (size_t)r * 2560 + c) = pack8(a, b);
        else { const int i0 = (w - 256) >> 1;
            const f32x4 cs01 = *(const f32x4*)(rope + (size_t)tp * 32 + i0), cs23 = *(const f32x4*)(rope + (size_t)tp * 32 + i0 + 2);
            bf16* qh = QF + (size_t)r * 2560 + h * 320 + 256;
            *(u32x2*)(qh + i0) = (u32x2){cvt_pk_bf16(a[0] * cs01[0] - a[1] * cs01[1], a[2] * cs01[2] - a[3] * cs01[3]), cvt_pk_bf16(b[0] * cs23[0] - b[1] * cs23[1], b[2] * cs23[2] - b[3] * cs23[3])};
            *(u32x2*)(qh + 32 + i0) = (u32x2){cvt_pk_bf16(a[0] * cs01[1] + a[1] * cs01[0], a[2] * cs01[3] + a[3] * cs01[2]), cvt_pk_bf16(b[0] * cs23[1] + b[1] * cs23[0], b[2] * cs23[3] + b[3] * cs23[2])}; } }
    __device__ __forceinline__ void rg(int r, int pn, int wc, int fq, f32x4 a0, f32x4 b0, f32x4 a1, f32x4 b1) const {
        const float rs = rsqrtf(stat_get(ssq_q + r) * (1.0f / 384.0f) + RMS_EPS) * MLA_SCALE; const int tp = r < MP ? (r & 2047) : 2048 + ((r - MP) & 3), c = pn * 256 + wc * 32 + 8 * fq;
        half(r, c, tp, a0 * rs, b0 * rs); half(r, c + 128, tp, a1 * rs, b1 * rs);
    }
    MK_EPI_CALL()
};
struct EpiC1 {
    static constexpr bool PERM = true, AFTER_DRAIN = false;
    bf16* GATE; float* XW; const long long* ssq;
    __device__ __forceinline__ void rg(int r, int pn, int wc, int fq, f32x4 a0, f32x4 b0, f32x4 a1, f32x4 b1) const {
        const bool isx = pn >= 5; const int c = (isx ? pn - 5 : pn) * 256 + wc * 32 + 8 * fq; const float rs = rsqrtf(stat_get(ssq + r) * (1.0f / 1024.0f) + RMS_EPS);
        a0 *= rs; b0 *= rs; a1 *= rs; b1 *= rs;
        if (isx) { float* x = XW + (size_t)r * 1280 + c; *(f32x4*)x = a0; *(f32x4*)(x + 4) = b0; *(f32x4*)(x + 128) = a1; *(f32x4*)(x + 132) = b1; }
        else {
#pragma unroll
            for (int e = 0; e < 4; ++e) { a0[e] = gelu_tanh_f(a0[e]); b0[e] = gelu_tanh_f(b0[e]); a1[e] = gelu_tanh_f(a1[e]); b1[e] = gelu_tanh_f(b1[e]); }
            bf16* g = GATE + (size_t)r * 1280 + c; *(u32x4*)g = pack8(a0, b0); *(u32x4*)(g + 128) = pack8(a1, b1); }
    }
    MK_EPI_CALL()
};

template <class Epi>
__device__ __forceinline__ void mini_gemm(const P& p, const bf16* A, int lda, const bf16* Bt, int ldb, int K, int N, const Epi& E, int first_wg) {
    constexpr int BP = 272, SLOT = 64 * BP;
    const int tid = p.tid, lane = p.lane, w = p.wave, kq = w & 3, rgp = w >> 2, l15 = lane & 15, g4 = lane >> 4, nmu = (N >> 8) * 16, nch = K >> 7, nst = (nch + 3) >> 2;
    const int t128 = (rgp << 6) | lane;
    for (int mu = (p.bid - first_wg + p.G) % p.G; mu < nmu; mu += p.G) {
        const int pn = mu >> 4, wcq = (mu >> 2) & 3, rq = mu & 3, row = MP + 32 * rq + 16 * rgp + l15;
        const bf16* arow = A + (size_t)row * lda + 8 * g4;
        const int r0 = t128 >> 4, c16 = t128 & 15;
        const bf16* bbase = Bt + (size_t)(pn * 256 + wcq * 32 + 8 * (r0 >> 2) + (r0 & 3)) * ldb + c16 * 8; const int bo0 = r0 * BP + c16 * 16;
#define MG_BSRC(q) (bbase + (size_t)(128 * ((q) >> 2) + 4 * (((q) >> 1) & 1) + 16 * ((q) & 1)) * ldb)
#define MG_BOFF(q) (bo0 + 8 * (q) * BP)
        f32x4 acc[4];
#pragma unroll
        for (int t = 0; t < 4; ++t) acc[t] = (f32x4){0.f, 0.f, 0.f, 0.f};
        u32x4 b0[8], a0[4], b1[8], a1[4], b2[8], a2[4];
#define MG_LOAD(BS, AS, ST) do { const int ch_ = 4 * (ST) + kq; if (ch_ < nch) { \
            _Pragma("unroll") for (int q = 0; q < 8; ++q) BS[q] = *(const u32x4*)(MG_BSRC(q) + (size_t)ch_ * 128); \
            _Pragma("unroll") for (int s = 0; s < 4; ++s) AS[s] = *(const u32x4*)(arow + (size_t)ch_ * 128 + 32 * s); } } while (0)
#define MG_STEP(BS, AS, ST) do { LAS unsigned char* slot = p.lds + (kq * 2 + ((ST) & 1)) * SLOT; const bool ok_ = 4 * (ST) + kq < nch; \
            if (ok_) { _Pragma("unroll") for (int q = 0; q < 8; ++q) *(LAS u32x4*)(slot + MG_BOFF(q)) = BS[q]; } \
            bf16x8 af[4]; _Pragma("unroll") for (int s = 0; s < 4; ++s) af[s] = __builtin_bit_cast(bf16x8, AS[s]); \
            __syncthreads(); \
            if ((ST) + 3 < nst) MG_LOAD(BS, AS, (ST) + 3); \
            if (ok_) { _Pragma("unroll") for (int s = 0; s < 4; ++s) _Pragma("unroll") for (int t = 0; t < 4; ++t) { \
                const bf16x8 bf = *(const LAS bf16x8*)(slot + (t * 16 + l15) * BP + (32 * s + 8 * g4) * 2); \
                acc[t] = __builtin_amdgcn_mfma_f32_16x16x32_bf16(bf, af[s], acc[t], 0, 0, 0); } } } while (0)
        MG_LOAD(b0, a0, 0); if (1 < nst) MG_LOAD(b1, a1, 1); if (2 < nst) MG_LOAD(b2, a2, 2);
        __syncthreads();
        for (int st = 0; st < nst; st += 3) {
            MG_STEP(b0, a0, st);
            if (st + 1 < nst) MG_STEP(b1, a1, st + 1);
            if (st + 2 < nst) MG_STEP(b2, a2, st + 2);
        }
#undef MG_LOAD
#undef MG_STEP
#undef MG_BSRC
#undef MG_BOFF
        __syncthreads();
        LAS f32x4* red = (LAS f32x4*)p.lds;
        if (kq > 0) {
#pragma unroll
            for (int t = 0; t < 4; ++t) red[((rgp * 3 + (kq - 1)) * 4 + t) * 64 + lane] = acc[t]; }
        __syncthreads();
        if (kq == 0) {
#pragma unroll
            for (int k2 = 0; k2 < 3; ++k2)
#pragma unroll
                for (int t = 0; t < 4; ++t) acc[t] += red[((rgp * 3 + k2) * 4 + t) * 64 + lane];
            E.rg(row, pn, wcq, g4, acc[0], acc[1], acc[2], acc[3]); }
    }
}
}
namespace mk {
__device__ __forceinline__ s16x4 tr16(const LAS unsigned char* a) { return __builtin_amdgcn_ds_read_tr16_b64_v4i16((LAS s16x4*)a); }
__device__ __forceinline__ bf16x8 cat8(const s16x4 a, const s16x4 b) { return (bf16x8){a[0], a[1], a[2], a[3], b[0], b[1], b[2], b[3]}; }
__device__ __forceinline__ bf16x8 as_bf16x8(const u32x4 w) { return __builtin_bit_cast(bf16x8, w); }
#define MFMA16(A, B, C) __builtin_amdgcn_mfma_f32_16x16x32_bf16((A), (B), (C), 0, 0, 0)
constexpr int TP = 272;
constexpr int KP = 656;
constexpr float LOG2E = 1.4426950408889634f;

__device__ __forceinline__ void a2_spatial(const P& p, int j, float* out_cv  ) {
    const bf16* U = p.w<bf16>(WS_U); const bf16* GV = p.w<bf16>(WS_GV); bf16* UM = p.w<bf16>(WS_UM);
    const long long* lns = p.stat(ST_LNS0 + 2 * j); const long long* lnq = p.stat(ST_LNQ0 + 2 * j);
    const float* ln_g = p.in[10] + j * 1024; const float* ln_b = p.in[11] + j * 1024; const float* b_s = p.in[13] + j * 1024;
    LAS unsigned char* Wt = p.lds; LAS unsigned char* Vt = p.lds + 128 * TP;
    const int tid = p.tid, lane = p.lane, w = p.wave, l15 = lane & 15, g4 = lane >> 4, q4 = (lane & 15) >> 2, pp = lane & 3;
    for (int u = p.bid; u < 129 * 8; u += p.G) {
        const int c = u >> 3, g = u & 7, row0 = c * 128; const bool smp = (c == 128);
        const bf16* Wsrc = p.w<bf16>(WS_WS + (smp ? 524288 : 0) + (size_t)j * 262144) + (size_t)g * 16384;
#pragma unroll
        for (int q = 0; q < 4; ++q) { const int ch = tid + 512 * q, row = ch >> 4, c16 = ch & 15;
            *(LAS u32x4*)(Wt + row * TP + c16 * 16) = *(const u32x4*)(Wsrc + row * 128 + c16 * 8); }
#pragma unroll
        for (int q = 0; q < 4; ++q) { const int ch = tid + 512 * q, s = ch >> 4, c16 = ch & 15, r = row0 + s, d0 = g * 128 + c16 * 8;
            const u32x4 raw = *(const u32x4*)(GV + (size_t)r * 1024 + d0);
            const float mean = stat_get(lns + r) * (1.0f / 1024.0f), var = stat_get(lnq + r) * (1.0f / 1024.0f) - mean * mean, rstd = rsqrtf(var + LN_EPS);
            const f32x4 g0 = *(const f32x4*)(ln_g + d0), g1 = *(const f32x4*)(ln_g + d0 + 4), b0 = *(const f32x4*)(ln_b + d0), b1 = *(const f32x4*)(ln_b + d0 + 4);
            f32x4 v0, v1;
            v0[0] = bflo(raw.x); v0[1] = bfhi(raw.x); v0[2] = bflo(raw.y); v0[3] = bfhi(raw.y); v1[0] = bflo(raw.z); v1[1] = bfhi(raw.z); v1[2] = bflo(raw.w); v1[3] = bfhi(raw.w);
            v0 = (v0 - mean) * rstd * g0 + b0; v1 = (v1 - mean) * rstd * g1 + b1;
            if (smp && out_cv) { float* o = out_cv + (size_t)(r - MP) * 1024 + d0; *(f32x4*)o = v0; *(f32x4*)(o + 4) = v1; }
            *(LAS u32x4*)(Vt + s * TP + c16 * 16) = pack8(v0, v1); }
        __syncthreads();
        f32x4 acc[8];
#pragma unroll
        for (int tt = 0; tt < 8; ++tt) acc[tt] = (f32x4){0.f, 0.f, 0.f, 0.f};
#pragma unroll
        for (int kk = 0; kk < 4; ++kk) {
            const bf16x8 X = cat8(tr16(Vt + (32 * kk + 8 * g4 + q4) * TP + (16 * w + 4 * pp) * 2), tr16(Vt + (32 * kk + 8 * g4 + 4 + q4) * TP + (16 * w + 4 * pp) * 2));
#pragma unroll
            for (int tt = 0; tt < 8; ++tt) if (32 * kk <= 16 * tt + 15) {
                const bf16x8 Y = *(const LAS bf16x8*)(Wt + (16 * tt + l15) * TP + (32 * kk + 8 * g4) * 2);
                acc[tt] = MFMA16(X, Y, acc[tt]); }
        }
#pragma unroll
        for (int tt = 0; tt < 8; ++tt) { const int t = 16 * tt + l15, r = row0 + t, col = g * 128 + 16 * w + 4 * g4;
            const float bias = b_s[g * 128 + (smp ? (t & 3) : t)];
            const u32x2 uu = *(const u32x2*)(U + (size_t)r * 1024 + col);
            const float o0 = bflo(uu.x) * (acc[tt][0] + bias), o1 = bfhi(uu.x) * (acc[tt][1] + bias), o2 = bflo(uu.y) * (acc[tt][2] + bias), o3 = bfhi(uu.y) * (acc[tt][3] + bias);
            *(u32x2*)(UM + (size_t)r * 1024 + col) = (u32x2){cvt_pk_bf16(o0, o1), cvt_pk_bf16(o2, o3)}; }
        __syncthreads();
    }
}

__device__ __forceinline__ void b2_kvfinal(const P& p, float* out_mp, float* out_ms) {
    const float* RAW = p.w<float>(WS_RAW); bf16* KVB = p.w<bf16>(WS_KVB); const long long* ssq_kv = p.stat(ST_KV); const float* kvn = p.in[19]; const f32x2* rope = p.w<f32x2>(WS_ROPE);
    const int gw = p.bid * NWAVES + p.wave, NGW = p.G * NWAVES, lane = p.lane;
    for (int m = gw; m < MT; m += NGW) {
        float* o = m < MP ? (out_mp ? out_mp + (size_t)m * 320 : nullptr) : (out_ms ? out_ms + (size_t)(m - MP) * 320 : nullptr);
        const float rs = rsqrtf(stat_get(ssq_kv + m) * (1.0f / 256.0f) + RMS_EPS);
        const f32x4 v = *(const f32x4*)(RAW + (size_t)m * 768 + 4 * lane) * rs * *(const f32x4*)(kvn + 4 * lane);
        if (o) *(f32x4*)(o + 4 * lane) = v;
        *(u32x2*)(KVB + (size_t)m * 320 + 4 * lane) = (u32x2){cvt_pk_bf16(v[0], v[1]), cvt_pk_bf16(v[2], v[3])};
        if (lane < 32) { const int tp = m < MP ? (m & 2047) : 2048 + ((m - MP) & 3); const f32x2 cs = rope[(size_t)tp * 32 + lane];
            const float x1 = RAW[(size_t)m * 768 + 640 + lane], x2 = RAW[(size_t)m * 768 + 672 + lane];
            const float o1 = x1 * cs.x - x2 * cs.y, o2 = x1 * cs.y + x2 * cs.x;
            if (o) { o[256 + lane] = o1; o[288 + lane] = o2; }
            KVB[(size_t)m * 320 + 256 + lane] = (bf16)f2bf(o1); KVB[(size_t)m * 320 + 288 + lane] = (bf16)f2bf(o2); }
    }
}

__device__ __forceinline__ void b3_attn_prompt(const P& p) {
    const bf16* QF = p.w<bf16>(WS_QF); const bf16* KVB = p.w<bf16>(WS_KVB); bf16* OB = p.w<bf16>(WS_OB);
    const int lane = p.lane, h = p.wave, l15 = lane & 15, g4 = lane >> 4, q4 = (lane & 15) >> 2, pp = lane & 3;
    constexpr int TILE_B = 64 * 640;
    int soff[5];
#pragma unroll
    for (int i = 0; i < 5; ++i) { const int P_ = (h + 8 * i) * 64 + lane, row = P_ / 40, cph = P_ - 40 * row; soff[i] = row * 320 + ((cph ^ (row & 6)) << 3); }
    int kaddr[10];
#pragma unroll
    for (int s_ = 0; s_ < 10; ++s_) kaddr[s_] = l15 * 640 + (((4 * s_ + g4) ^ (l15 & 6)) << 4);
    int taddr[4];
    { const int rl = 4 * g4 + q4, m_ = (rl & 6) >> 1;
#pragma unroll
      for (int v3 = 0; v3 < 4; ++v3) taddr[v3] = rl * 640 + (((v3 ^ m_) << 1 | (pp >> 1)) << 4) + 8 * (pp & 1); }
#define AT_DMA(BUF, SRC) do { _Pragma("unroll") for (int i = 0; i < 5; ++i) \
        __builtin_amdgcn_global_load_lds((const unsigned*)((SRC) + soff[i]), (LAS unsigned*)((BUF) + (h + 8 * i) * 1024), 16, 0, 0); } while (0)
    for (int pi = p.bid; pi < 512; pi += p.G) {
        const int b = pi >> 6, x = pi & 63;
        for (int half = 0; half < 2; ++half) {
            const int qt = half ? 127 - x : x, t0 = 16 * qt, nkt = (t0 + 15) / 64 + 1;
            const size_t rowq = (size_t)b * 2048 + t0 + l15; const bf16* kvb = KVB + (size_t)b * 2048 * 320;
            AT_DMA(p.lds, kvb);
            bf16x8 Q[10];
#pragma unroll
            for (int s = 0; s < 10; ++s) Q[s] = as_bf16x8(*(const u32x4*)(QF + rowq * 2560 + h * 320 + 32 * s + 8 * g4));
            f32x4 O[16];
#pragma unroll
            for (int vt = 0; vt < 16; ++vt) O[vt] = (f32x4){0.f, 0.f, 0.f, 0.f};
            float mrun = -1e30f, lrun = 0.f;
            asm volatile("s_waitcnt vmcnt(0)" ::: "memory"); __syncthreads();
            for (int kt = 0; kt < nkt; ++kt) {
                LAS unsigned char* buf = p.lds + (kt & 1) * TILE_B;
                if (kt + 1 < nkt) AT_DMA(p.lds + ((kt + 1) & 1) * TILE_B, kvb + (size_t)64 * (kt + 1) * 320);
                f32x4 S[4];
#pragma unroll
                for (int k4 = 0; k4 < 4; ++k4) S[k4] = (f32x4){0.f, 0.f, 0.f, 0.f};
                { bf16x8 Kc[4], Kn[4];
#pragma unroll
                  for (int k4 = 0; k4 < 4; ++k4) Kc[k4] = *(const LAS bf16x8*)(buf + kaddr[0] + k4 * 10240);
#pragma unroll
                  for (int s = 0; s < 10; ++s) {
                      if (s < 9) {
#pragma unroll
                          for (int k4 = 0; k4 < 4; ++k4) Kn[k4] = *(const LAS bf16x8*)(buf + kaddr[s + 1] + k4 * 10240); }
#pragma unroll
                      for (int k4 = 0; k4 < 4; ++k4) S[k4] = MFMA16(Kc[k4], Q[s], S[k4]);
#pragma unroll
                      for (int k4 = 0; k4 < 4; ++k4) Kc[k4] = Kn[k4]; } }
                float mx = -1e30f;
#pragma unroll
                for (int k4 = 0; k4 < 4; ++k4)
#pragma unroll
                    for (int e = 0; e < 4; ++e) { float v = S[k4][e] * LOG2E; if (kt == nkt - 1 && 64 * kt + 16 * k4 + 4 * g4 + e > t0 + l15) v = -1e30f; S[k4][e] = v; mx = fmaxf(mx, v); }
                mx = fmaxf(mx, __shfl_xor(mx, 16)); mx = fmaxf(mx, __shfl_xor(mx, 32));
                const float mnew = fmaxf(mrun, mx), alpha = __builtin_amdgcn_exp2f(mrun - mnew); mrun = mnew;
                float ps = 0.f;
#pragma unroll
                for (int k4 = 0; k4 < 4; ++k4)
#pragma unroll
                    for (int e = 0; e < 4; ++e) { const float pv = __builtin_amdgcn_exp2f(S[k4][e] - mnew); S[k4][e] = pv; ps += pv; }
                lrun = lrun * alpha + ps;
#pragma unroll
                for (int vt = 0; vt < 16; ++vt) O[vt] *= alpha;
                bf16x8 Pf[2];
#pragma unroll
                for (int ks = 0; ks < 2; ++ks) Pf[ks] = as_bf16x8((u32x4){cvt_pk_bf16(S[2 * ks][0], S[2 * ks][1]), cvt_pk_bf16(S[2 * ks][2], S[2 * ks][3]), cvt_pk_bf16(S[2 * ks + 1][0], S[2 * ks + 1][1]), cvt_pk_bf16(S[2 * ks + 1][2], S[2 * ks + 1][3])});
#define AT_V(VT, KS, T) tr16(buf + taddr[(VT) & 3] + ((VT) >> 2) * 128 + (32 * (KS) + 16 * (T)) * 640)
                { s16x4 Vc[4], Vn[4];
                  Vc[0] = AT_V(0, 0, 0); Vc[1] = AT_V(0, 0, 1); Vc[2] = AT_V(0, 1, 0); Vc[3] = AT_V(0, 1, 1);
#pragma unroll
                  for (int vt = 0; vt < 16; ++vt) {
                      if (vt < 15) { Vn[0] = AT_V(vt + 1, 0, 0); Vn[1] = AT_V(vt + 1, 0, 1); Vn[2] = AT_V(vt + 1, 1, 0); Vn[3] = AT_V(vt + 1, 1, 1); }
                      O[vt] = MFMA16(cat8(Vc[0], Vc[1]), Pf[0], O[vt]); O[vt] = MFMA16(cat8(Vc[2], Vc[3]), Pf[1], O[vt]);
#pragma unroll
                      for (int i = 0; i < 4; ++i) Vc[i] = Vn[i]; } }
#undef AT_V
                asm volatile("s_waitcnt vmcnt(0)" ::: "memory"); __syncthreads();
            }
            const float linv = 1.0f / quad_red(lrun);
#pragma unroll
            for (int vt = 0; vt < 16; ++vt) { const f32x4 o = O[vt] * linv;
                *(u32x2*)(OB + rowq * 2048 + h * 256 + 16 * vt + 4 * g4) = (u32x2){cvt_pk_bf16(o[0], o[1]), cvt_pk_bf16(o[2], o[3])}; }
        }
    }
#undef AT_DMA
}

__device__ __forceinline__ void b3_attn_sample(const P& p) {
    const bf16* QF = p.w<bf16>(WS_QF); float* PART = p.w<float>(WS_PART); float* PML = p.w<float>(WS_PML);
    const float* cache = p.in[2]; const int* ptab = (const int*)p.in[5];
    const int tid = p.tid, lane = p.lane, w = p.wave, qt = w & 1, dvq = w >> 1, l15 = lane & 15, g4 = lane >> 4, q4 = (lane & 15) >> 2, pp = lane & 3;
    constexpr int TILE_B = 64 * KP;
    for (int u = p.bid; u < 256; u += p.G) {
        const int b = u >> 3, sp = u & 7;
        const int hq = 4 * qt + (l15 >> 2), iq = l15 & 3; const size_t rowq = (size_t)MP + 4 * b + iq;
        bf16x8 Q[10];
#pragma unroll
        for (int s = 0; s < 10; ++s) Q[s] = as_bf16x8(*(const u32x4*)(QF + rowq * 2560 + hq * 320 + 32 * s + 8 * g4));
        f32x4 O[4];
#pragma unroll
        for (int v = 0; v < 4; ++v) O[v] = (f32x4){0.f, 0.f, 0.f, 0.f};
        float mrun = -1e30f, lrun = 0.f;
        f32x4 st[10];
        auto tile_src = [&](int ti) -> const float* { const int pg = 16 * sp + (ti >> 1); return cache + ((size_t)ptab[b * 128 + pg] * 128 + 64 * (ti & 1)) * 320; };
        { const float* src = tile_src(0);
#pragma unroll
          for (int q = 0; q < 10; ++q) st[q] = __builtin_nontemporal_load((const f32x4*)(src + (size_t)(tid + 512 * q) * 4));
          __syncthreads();
#pragma unroll
          for (int q = 0; q < 10; ++q) { const int ch = tid + 512 * q, row = ch / 80, c4 = ch % 80; *(LAS u32x2*)(p.lds + row * KP + c4 * 8) = (u32x2){cvt_pk_bf16(st[q][0], st[q][1]), cvt_pk_bf16(st[q][2], st[q][3])}; }
          __syncthreads(); }
        for (int ti = 0; ti < 32; ++ti) {
            LAS unsigned char* buf = p.lds + (ti & 1) * TILE_B;
            if (ti + 1 < 32) { const float* src = tile_src(ti + 1);
#pragma unroll
                for (int q = 0; q < 10; ++q) st[q] = __builtin_nontemporal_load((const f32x4*)(src + (size_t)(tid + 512 * q) * 4)); }
            f32x4 S[4];
#pragma unroll
            for (int k4 = 0; k4 < 4; ++k4) { S[k4] = (f32x4){0.f, 0.f, 0.f, 0.f};
#pragma unroll
                for (int s = 0; s < 10; ++s) { const bf16x8 Kf = *(const LAS bf16x8*)(buf + (16 * k4 + l15) * KP + (32 * s + 8 * g4) * 2); S[k4] = MFMA16(Kf, Q[s], S[k4]); } }
            float mx = -1e30f;
#pragma unroll
            for (int k4 = 0; k4 < 4; ++k4)
#pragma unroll
                for (int e = 0; e < 4; ++e) { const float v = S[k4][e] * LOG2E; S[k4][e] = v; mx = fmaxf(mx, v); }
            mx = fmaxf(mx, __shfl_xor(mx, 16)); mx = fmaxf(mx, __shfl_xor(mx, 32));
            const float mnew = fmaxf(mrun, mx), alpha = __builtin_amdgcn_exp2f(mrun - mnew); mrun = mnew;
            float ps = 0.f;
#pragma unroll
            for (int k4 = 0; k4 < 4; ++k4)
#pragma unroll
                for (int e = 0; e < 4; ++e) { const float pv = __builtin_amdgcn_exp2f(S[k4][e] - mnew); S[k4][e] = pv; ps += pv; }
            lrun = lrun * alpha + ps;
#pragma unroll
            for (int v = 0; v < 4; ++v) O[v] *= alpha;
            bf16x8 Pf[2];
#pragma unroll
            for (int ks = 0; ks < 2; ++ks) Pf[ks] = as_bf16x8((u32x4){cvt_pk_bf16(S[2 * ks][0], S[2 * ks][1]), cvt_pk_bf16(S[2 * ks][2], S[2 * ks][3]), cvt_pk_bf16(S[2 * ks + 1][0], S[2 * ks + 1][1]), cvt_pk_bf16(S[2 * ks + 1][2], S[2 * ks + 1][3])});
#pragma unroll
            for (int v = 0; v < 4; ++v) { const int vt = 4 * dvq + v;
#pragma unroll
                for (int ks = 0; ks < 2; ++ks) {
                    const bf16x8 Vf = cat8(tr16(buf + (32 * ks + 4 * g4 + q4) * KP + (16 * vt + 4 * pp) * 2), tr16(buf + (32 * ks + 16 + 4 * g4 + q4) * KP + (16 * vt + 4 * pp) * 2));
                    O[v] = MFMA16(Vf, Pf[ks], O[v]); } }
            if (ti + 1 < 32) { LAS unsigned char* nb = p.lds + ((ti + 1) & 1) * TILE_B;
#pragma unroll
                for (int q = 0; q < 10; ++q) { const int ch = tid + 512 * q, row = ch / 80, c4 = ch % 80; *(LAS u32x2*)(nb + row * KP + c4 * 8) = (u32x2){cvt_pk_bf16(st[q][0], st[q][1]), cvt_pk_bf16(st[q][2], st[q][3])}; } }
            __syncthreads();
        }
        const float lsum = quad_red(lrun); const int qrow = 16 * qt + l15; const size_t pb = ((size_t)(b * 8 + sp) * 32 + qrow);
#pragma unroll
        for (int v = 0; v < 4; ++v) *(f32x4*)(PART + pb * 256 + 16 * (4 * dvq + v) + 4 * g4) = O[v];
        if (dvq == 0 && g4 == 0) { PML[pb * 2] = mrun; PML[pb * 2 + 1] = lsum; }
    }
}
__device__ __forceinline__ void b3_combine(const P& p) {
    const bf16* QF = p.w<bf16>(WS_QF); const bf16* KVB = p.w<bf16>(WS_KVB); bf16* OB = p.w<bf16>(WS_OB); const float* PART = p.w<float>(WS_PART); const float* PML = p.w<float>(WS_PML);
    const int dv = p.tid & 255, sub = p.tid >> 8;
    for (int it = 2 * p.bid + sub; it < 1024; it += 2 * p.G) {
        const int b = it >> 5, i = (it >> 3) & 3, h = it & 7, qt = h >> 2, ql = ((h & 3) << 2) | i, qrow = 16 * qt + ql; const size_t row = (size_t)MP + 4 * b + i;
        float sn[4];
#pragma unroll
        for (int kk = 0; kk < 4; ++kk) { float s = 0.f;
            if (kk <= i) { const unsigned* qp = (const unsigned*)(QF + row * 2560 + h * 320); const unsigned* kp = (const unsigned*)(KVB + ((size_t)MP + 4 * b + kk) * 320);
                for (int d = 0; d < 160; ++d) { const unsigned a = qp[d], c = kp[d]; s += bflo(a) * bflo(c) + bfhi(a) * bfhi(c); } }
            sn[kk] = (kk <= i) ? s * LOG2E : -1e30f; }
        float M = fmaxf(fmaxf(sn[0], sn[1]), fmaxf(sn[2], sn[3])); float ms[8], ls[8];
#pragma unroll
        for (int sp = 0; sp < 8; ++sp) { const size_t pb = ((size_t)(b * 8 + sp) * 32 + qrow); ms[sp] = PML[pb * 2]; ls[sp] = PML[pb * 2 + 1]; M = fmaxf(M, ms[sp]); }
        float L = 0.f, Oa = 0.f;
#pragma unroll
        for (int sp = 0; sp < 8; ++sp) { const size_t pb = ((size_t)(b * 8 + sp) * 32 + qrow); const float wgt = __builtin_amdgcn_exp2f(ms[sp] - M); L += ls[sp] * wgt; Oa += PART[pb * 256 + dv] * wgt; }
#pragma unroll
        for (int kk = 0; kk < 4; ++kk) { const float pk = __builtin_amdgcn_exp2f(sn[kk] - M); L += pk; Oa += pk * bf2f(KVB[((size_t)MP + 4 * b + kk) * 320 + dv]); }
        OB[row * 2048 + h * 256 + dv] = (bf16)f2bf(Oa / L);
    }
}

template <bool SMP>
__device__ __forceinline__ f32x4 conv4(const float* XW, const float* cbuf  , const float* cw, const float* cb, int m, int c) {
    f32x4 acc = *(const f32x4*)(cb + c);
    f32x4 v[4], wv[4];
#pragma unroll
    for (int k = 0; k < 4; ++k) { wv[k] = *(const f32x4*)(cw + k * 1280 + c);
        if (!SMP) { const int t = m & 2047, r = t + k - 3; v[k] = *(const f32x4*)(XW + (size_t)(m + (r >= 0 ? k - 3 : -t)) * 1280 + c); if (r < 0) wv[k] = (f32x4){0.f, 0.f, 0.f, 0.f}; }
        else { const int b = (m - MP) >> 2, t = (m - MP) & 3, r = t + k - 3; const float* ptr = (r >= 0) ? XW + (size_t)(m + k - 3) * 1280 + c : cbuf + ((size_t)b * 3 + (3 + r)) * 1280 + c; v[k] = *(const f32x4*)ptr; } }
#pragma unroll
    for (int k = 0; k < 4; ++k) acc += wv[k] * v[k];
    return acc;
}
__device__ __forceinline__ void c2_rglru(const P& p, int j, float* out_cp, float* out_cs, float* out_hs, const int mask) {
    const float* XW = p.w<float>(WS_XW); bf16* LH = p.w<bf16>(WS_AA); bf16* CPB = p.w<bf16>(WS_BB); float* AGG = p.w<float>(WS_AGG);
    const float* cbuf = p.in[4] + (size_t)j * 32 * 3 * 1280; const float* cw = p.in[25] + (size_t)j * 4 * 1280; const float* cb = p.in[26] + j * 1280;
    const float* b_a = p.in[28] + j * 1280; const float* b_i = p.in[30] + j * 1280; const float* lam = p.in[31] + j * 1280; const float* h0s = p.in[3] + (size_t)j * 32 * 1280;
    const bf16* WaT = p.w<bf16>(WS_WAT); const bf16* WiT = p.w<bf16>(WS_WIT);
    LAS unsigned char* Xt = p.lds; LAS unsigned char* At = p.lds + 128 * TP; LAS unsigned char* It = p.lds + 256 * TP;
    LAS float* LA = (LAS float*)p.lds;
    LAS unsigned char* LB = p.lds + 128 * 528;
    LAS float* QT = (LAS float*)(p.lds + 128 * 528 + 128 * TP);
    const int tid = p.tid, lane = p.lane, w = p.wave, l15 = lane & 15, g4 = lane >> 4;
    { const int gt = p.bid * 512 + tid, NGT = p.G * 512;
      for (int i = gt; i < (8 + 32) * 3 * 320; i += NGT) { const int c = (i % 320) * 4, rr = i / 320, jj = rr % 3, bb = rr / 3;
          if (bb < 8) { if (out_cp) *(f32x4*)(out_cp + ((size_t)bb * 3 + jj) * 1280 + c) = *(const f32x4*)(XW + ((size_t)bb * 2048 + 2045 + jj) * 1280 + c); }
          else { const int b = bb - 8; if (out_cs) *(f32x4*)(out_cs + ((size_t)b * 3 + jj) * 1280 + c) = *(const f32x4*)(XW + ((size_t)MP + 4 * b + 1 + jj) * 1280 + c); } } }
    for (int u = p.bid; u < 129 * 10; u += p.G) {
        const int T = u / 10, n = u % 10, row0 = T * 128;
        if (mask & 4096) {
            const int c16 = tid & 15, cch = n * 128 + c16 * 8;
            f32x4 wv[4][2], bv[2];
#pragma unroll
            for (int k = 0; k < 4; ++k) { wv[k][0] = *(const f32x4*)(cw + k * 1280 + cch); wv[k][1] = *(const f32x4*)(cw + k * 1280 + cch + 4); }
            bv[0] = *(const f32x4*)(cb + cch); bv[1] = *(const f32x4*)(cb + cch + 4);
            u32x4 wa[4], wi[4];
#pragma unroll
            for (int q = 0; q < 4; ++q) { const int row = (tid >> 4) + 32 * q; wa[q] = *(const u32x4*)(WaT + (size_t)n * 16384 + row * 128 + c16 * 8); wi[q] = *(const u32x4*)(WiT + (size_t)n * 16384 + row * 128 + c16 * 8); }
#pragma unroll
            for (int qh = 0; qh < 2; ++qh) {
                f32x4 xv[2][4][2];
#pragma unroll
                for (int qq = 0; qq < 2; ++qq) { const int m = row0 + (tid >> 4) + 32 * (2 * qh + qq);
#pragma unroll
                    for (int k = 0; k < 4; ++k) { const float* ptr;
                        if (T < 128) { const int t = m & 2047, r = t + k - 3; ptr = XW + (size_t)(m + (r >= 0 ? k - 3 : -t)) * 1280 + cch; }
                        else { const int b = (m - MP) >> 2, t = (m - MP) & 3, r = t + k - 3; ptr = (r >= 0) ? XW + (size_t)(m + k - 3) * 1280 + cch : cbuf + ((size_t)b * 3 + (3 + r)) * 1280 + cch; }
                        xv[qq][k][0] = *(const f32x4*)ptr; xv[qq][k][1] = *(const f32x4*)(ptr + 4); } }
#pragma unroll
                for (int qq = 0; qq < 2; ++qq) { const int row = (tid >> 4) + 32 * (2 * qh + qq), m = row0 + row; f32x4 v0 = bv[0], v1 = bv[1];
#pragma unroll
                    for (int k = 0; k < 4; ++k) { const bool live = (T >= 128) || (((m & 2047) + k - 3) >= 0); const f32x4 z = (f32x4){0.f, 0.f, 0.f, 0.f};
                        v0 += (live ? wv[k][0] : z) * xv[qq][k][0]; v1 += (live ? wv[k][1] : z) * xv[qq][k][1]; }
                    *(LAS u32x4*)(Xt + row * TP + c16 * 16) = pack8(v0, v1); } }
#pragma unroll
            for (int q = 0; q < 4; ++q) { const int row = (tid >> 4) + 32 * q; *(LAS u32x4*)(At + row * TP + c16 * 16) = wa[q]; *(LAS u32x4*)(It + row * TP + c16 * 16) = wi[q]; }
        }
        __syncthreads();
        f32x4 ca[8], ci[8];
#pragma unroll
        for (int tt = 0; tt < 8; ++tt) { ca[tt] = (f32x4){0.f, 0.f, 0.f, 0.f}; ci[tt] = (f32x4){0.f, 0.f, 0.f, 0.f}; }
        if (mask & 8192) {
#pragma unroll
        for (int kk = 0; kk < 4; ++kk) {
            const bf16x8 Xa = *(const LAS bf16x8*)(At + (16 * w + l15) * TP + (32 * kk + 8 * g4) * 2), Xi = *(const LAS bf16x8*)(It + (16 * w + l15) * TP + (32 * kk + 8 * g4) * 2);
#pragma unroll
            for (int tt = 0; tt < 8; ++tt) { const bf16x8 Y = *(const LAS bf16x8*)(Xt + (16 * tt + l15) * TP + (32 * kk + 8 * g4) * 2);
                ca[tt] = MFMA16(Xa, Y, ca[tt]); ci[tt] = MFMA16(Xi, Y, ci[tt]); }
        }
        const int chn = n * 128 + 16 * w + 4 * g4;
        { const f32x4 ba = *(const f32x4*)(b_a + chn), bi = *(const f32x4*)(b_i + chn), lm = *(const f32x4*)(lam + chn);
          f32x4 sp;
#pragma unroll
          for (int e = 0; e < 4; ++e) { const float nl = -lm[e]; sp[e] = -8.0f * LOG2E * ((nl > 20.f) ? nl : log1pf(expf(nl))); }
#pragma unroll
          for (int tt = 0; tt < 8; ++tt) { const u32x2 xb = *(const LAS u32x2*)(Xt + (16 * tt + l15) * TP + (16 * w + 4 * g4) * 2);
              const f32x4 xc = (f32x4){bflo(xb.x), bfhi(xb.x), bflo(xb.y), bfhi(xb.y)};
#pragma unroll
              for (int e = 0; e < 4; ++e) { const float r = fast_sigmoid_l2(LOG2E * (ca[tt][e] + ba[e])), gi = fast_sigmoid_l2(LOG2E * (ci[tt][e] + bi[e]));
                  const float a = __builtin_amdgcn_exp2f(r * sp[e]);
                  ca[tt][e] = a; ci[tt][e] = __builtin_amdgcn_sqrtf(fmaxf(__builtin_fmaf(-a, a, 1.0f), 0.f)) * gi * xc[e]; } } }
        }
        __syncthreads();
#pragma unroll
        for (int tt = 0; tt < 8; ++tt) { const int tok = 16 * tt + l15;
            *(LAS f32x4*)(LA + tok * 132 + 16 * w + 4 * g4) = ca[tt];
            *(LAS u32x2*)(LB + tok * TP + (16 * w + 4 * g4) * 2) = (u32x2){cvt_pk_bf16(ci[tt][0], ci[tt][1]), cvt_pk_bf16(ci[tt][2], ci[tt][3])}; }
        __syncthreads();
        const int ch = tid & 127, q = tid >> 7, chg = n * 128 + ch;
        if (mask & 16384) {
        if (T < 128) {
            float P_ = 1.f, H_ = 0.f;
#pragma unroll 8
            for (int t = 32 * q; t < 32 * q + 32; ++t) { const float a = LA[t * 132 + ch], b = bf2f(*(const LAS bf16*)(LB + t * TP + ch * 2)); H_ = a * H_ + b; P_ *= a; }
            QT[(q * 128 + ch) * 2] = P_; QT[(q * 128 + ch) * 2 + 1] = H_;
            __syncthreads();
            float h = 0.f, pc = 1.f;
#pragma unroll
            for (int qq = 0; qq < 3; ++qq) if (qq < q) { const float Pq = QT[(qq * 128 + ch) * 2], Hq = QT[(qq * 128 + ch) * 2 + 1]; h = Pq * h + Hq; pc *= Pq; }
#pragma unroll 8
            for (int t = 32 * q; t < 32 * q + 32; ++t) { const float a = LA[t * 132 + ch], b = bf2f(*(const LAS bf16*)(LB + t * TP + ch * 2)); h = a * h + b; pc *= a;
                LA[t * 132 + ch] = pc; *(LAS bf16*)(LB + t * TP + ch * 2) = (bf16)f2bf(h); }
            if (q == 3) { AGG[((size_t)T * 2) * 1280 + chg] = pc; AGG[((size_t)T * 2 + 1) * 1280 + chg] = h; }
        } else {
            for (int bb = 8 * q; bb < 8 * q + 8; ++bb) { float h = h0s[(size_t)bb * 1280 + chg];
#pragma unroll
                for (int i = 0; i < 4; ++i) { const int t = 4 * bb + i; const float a = LA[t * 132 + ch], b = bf2f(*(const LAS bf16*)(LB + t * TP + ch * 2)); h = a * h + b;
                    LA[t * 132 + ch] = 0.f; *(LAS bf16*)(LB + t * TP + ch * 2) = (bf16)f2bf(h); }
                if (out_hs) out_hs[(size_t)bb * 1280 + chg] = h; }
        }
        }
        __syncthreads();
        if (mask & 32768)
#pragma unroll
        for (int i = 0; i < 4; ++i) { const int cidx = tid + 512 * i, tok = cidx >> 4, c8 = (cidx & 15) * 8; const size_t o = (size_t)(row0 + tok) * 1280 + n * 128 + c8;
            *(u32x4*)(LH + o) = *(const LAS u32x4*)(LB + tok * TP + c8 * 2);
            *(u32x4*)(CPB + o) = pack8(*(const LAS f32x4*)(LA + tok * 132 + c8), *(const LAS f32x4*)(LA + tok * 132 + c8 + 4)); }
        __syncthreads();
    }
}
__device__ __forceinline__ void c5_fixup(const P& p, float* out_hp) {
    const bf16* LH = p.w<bf16>(WS_AA); const bf16* CPB = p.w<bf16>(WS_BB); const float* AGG = p.w<float>(WS_AGG); const bf16* GATE = p.w<bf16>(WS_GATE); bf16* GH = p.w<bf16>(WS_GH);
    LAS float* cr = (LAS float*)p.lds;
    const int tid = p.tid;
    for (int it = p.bid; it < 258; it += p.G) {
        const int T = it >> 1, hf = it & 1, row0 = T * 128 + 64 * hf, T0 = T & ~15;
        for (int ch = tid; ch < 1280; ch += 512) { float c = 0.f;
            if (T < 128) {
#pragma unroll
                for (int d = 0; d < 15; ++d) if (T0 + d < T) c = AGG[((size_t)(T0 + d) * 2) * 1280 + ch] * c + AGG[((size_t)(T0 + d) * 2 + 1) * 1280 + ch];
                if ((T & 15) == 15 && hf == 1 && out_hp) out_hp[(size_t)(T >> 4) * 1280 + ch] = AGG[((size_t)T * 2) * 1280 + ch] * c + AGG[((size_t)T * 2 + 1) * 1280 + ch]; }
            cr[ch] = c; }
        __syncthreads();
#pragma unroll 4
        for (int i = 0; i < 20; ++i) { const int cidx = tid + 512 * i, tok = cidx / 160, c8 = (cidx % 160) * 8; const size_t o = (size_t)(row0 + tok) * 1280 + c8;
            const u32x4 lh = *(const u32x4*)(LH + o), cp = *(const u32x4*)(CPB + o), gt = *(const u32x4*)(GATE + o);
            const f32x4 c0 = *(const LAS f32x4*)(cr + c8), c1 = *(const LAS f32x4*)(cr + c8 + 4);
            f32x4 r0, r1;
            r0[0] = bflo(gt.x) * (bflo(lh.x) + bflo(cp.x) * c0[0]); r0[1] = bfhi(gt.x) * (bfhi(lh.x) + bfhi(cp.x) * c0[1]);
            r0[2] = bflo(gt.y) * (bflo(lh.y) + bflo(cp.y) * c0[2]); r0[3] = bfhi(gt.y) * (bfhi(lh.y) + bfhi(cp.y) * c0[3]);
            r1[0] = bflo(gt.z) * (bflo(lh.z) + bflo(cp.z) * c1[0]); r1[1] = bfhi(gt.z) * (bfhi(lh.z) + bfhi(cp.z) * c1[1]);
            r1[2] = bflo(gt.w) * (bflo(lh.w) + bflo(cp.w) * c1[2]); r1[3] = bfhi(gt.w) * (bfhi(lh.w) + bfhi(cp.w) * c1[3]);
            *(u32x4*)(GH + o) = pack8(r0, r1); }
        __syncthreads();
    }
}
__device__ __forceinline__ void final_norm(const P& p, float* out_yp, float* out_ys) {
    const float* H = p.w<float>(WS_H); const long long* ssq = p.stat(ST_SSQ0 + 8); const float* g = p.in[8];
    const int gw = p.bid * NWAVES + p.wave, NGW = p.G * NWAVES, lane = p.lane;
    for (int m = gw; m < MT; m += NGW) { float* o = m < MP ? out_yp + (size_t)m * 1024 : out_ys + (size_t)(m - MP) * 1024; const float rs = rsqrtf(stat_get(ssq + m) * (1.0f / 1024.0f) + RMS_EPS);
#pragma unroll
        for (int jj = 0; jj < 4; ++jj) { const int c = 4 * lane + 256 * jj; *(f32x4*)(o + c) = *(const f32x4*)(H + (size_t)m * 1024 + c) * rs * *(const f32x4*)(g + c); } }
}
}
namespace mk {
struct Args { const float* in[36]; float* out; unsigned char* ws; int ph_lo, ph_hi, li, mask; };
constexpr int NPHASE = 34;

#define MK_GEMM(EpiT, E, Aptr, LDA, Bptr, LDB, KD, NC) do { pg8::Gemm g_{(const pg8::bf16_t*)(Aptr), (const pg8::bf16_t*)(Bptr), (LDA), (LDB), (KD)}; pg8::StaticOrder S_; S_.init(MP, (NC), p.G, p.bid); \
        pg8::gemm_phase<EpiT, pg8::StaticOrder, true, true>(p.lds, g_, S_, E, p.tid); \
          \
        P q_ = p; { int t2_ = p0.tid; asm volatile("" : "+v"(t2_)); q_.tid = t2_; q_.lane = t2_ & 63; q_.wave = __builtin_amdgcn_readfirstlane(t2_ >> 6); } \
        mini_gemm<EpiT>(q_, (const bf16*)(Aptr), (LDA), (const bf16*)(Bptr), (LDB), (KD), (NC), E, (64 * ((NC) / 256)) % p.G); } while (0)

#ifdef MK_DRYPROBE
#define MK_DRYARG , ((mask >> 10) & 1)
#else
#define MK_DRYARG
#endif
#ifndef MK_REP_SEL
#define MK_REP_SEL(k) 0
#define MK_REP_N 1
#endif
#define REPF(k) for (int rep_ = 0; rep_ < (MK_REP_SEL(k) ? MK_REP_N : 1); ++rep_)
#define IN_(k) (lo <= (k) && (k) < hi)
#define PH_BEGIN() P p = p0; { int z_ = 0, t_ = p0.tid, g_ = p0.G, b_ = p0.bid; unsigned l_ = (unsigned)(size_t)p0.lds; asm volatile("" : "+s"(z_), "+v"(t_), "+s"(g_), "+s"(b_), "+s"(l_)); p.ws = p0.ws + z_; p.out = p0.out + z_; p.tid = t_; p.lane = t_ & 63; p.wave = __builtin_amdgcn_readfirstlane(t_ >> 6); p.G = g_; p.bid = b_; p.lds = (LAS unsigned char*)(size_t)l_; } float* const out = p.out; (void)out
#ifdef MK_PROF
#define STAMP(k) do { if (p0.bid == 0 && p0.tid == 0) ((unsigned long long*)(p0.ws + WS_PROF))[(k)] = (unsigned long long)wall_clock64(); } while (0)
#else
#define STAMP(k) do { } while (0)
#endif
#define ENDPH(k) do { if ((k) + 1 < hi) xcd_barrier(bar); STAMP((k) + 1); } while (0)
template <int LAYER> __device__ __forceinline__ void run_layer(const P& p0, const XcdBarrier& bar, const int lo, const int hi, const int mask) {
        constexpr int layer = LAYER, kind = layer % 3, j = layer / 3, pb = 1 + 8 * layer;
        constexpr size_t resA = kind == 0 ? WS_UM : kind == 1 ? WS_OB : WS_GH, resB = kind == 0 ? WS_WOUT + (size_t)j * 2 * MiB : kind == 1 ? WS_WOV : WS_WCO; constexpr int resK = kind == 0 ? 1024 : kind == 1 ? 2048 : 1280;
        if constexpr (kind == 0) {
            if (IN_(pb)) REPF(pb) { PH_BEGIN(); EpiA1 E{p.w<bf16>(WS_U), p.w<bf16>(WS_GV), p.stat(ST_SSQ0 + 2 * layer), p.stat(ST_LNS0 + 2 * j), p.stat(ST_LNQ0 + 2 * j) MK_DRYARG};
                MK_GEMM(EpiA1, E, p.w<bf16>(WS_HB), 1024, p.w<bf16>(WS_WIN + (size_t)j * 4 * MiB), 1024, 1024, 2048); ENDPH(pb); }
            if (IN_(pb + 1)) REPF(pb + 1) { PH_BEGIN(); a2_spatial(p, j, out + O_CV + (size_t)j * 131072); ENDPH(pb + 1); }
        } else if constexpr (kind == 1) {
            if (IN_(pb)) REPF(pb) { PH_BEGIN(); EpiB1 E{p.w<float>(WS_RAW), p.w<bf16>(WS_CQB), p.stat(ST_SSQ0 + 2 * layer), p.stat(ST_KV), p.stat(ST_Q) MK_DRYARG};
                MK_GEMM(EpiB1, E, p.w<bf16>(WS_HB), 1024, p.w<bf16>(WS_WDQKV), 1024, 1024, 768); ENDPH(pb); }
            if (IN_(pb + 1)) REPF(pb + 1) { PH_BEGIN(); b2_kvfinal(p, out + O_MP, out + O_MS);
                EpiB2 E{p.w<bf16>(WS_QF), p.stat(ST_Q), p.w<f32x2>(WS_ROPE)};
                MK_GEMM(EpiB2, E, p.w<bf16>(WS_CQB), 384, p.w<bf16>(WS_WQ), 384, 384, 2560); ENDPH(pb + 1); }
            if (IN_(pb + 2)) REPF(pb + 2) { PH_BEGIN(); if (mask & 256) b3_attn_prompt(p); if (mask & 512) b3_attn_sample(p); ENDPH(pb + 2); }
            if (IN_(pb + 3)) REPF(pb + 3) { PH_BEGIN(); b3_combine(p); ENDPH(pb + 3); }
        } else {
            if (IN_(pb)) REPF(pb) { PH_BEGIN(); EpiC1 E{p.w<bf16>(WS_GATE), p.w<float>(WS_XW), p.stat(ST_SSQ0 + 2 * layer)};
                MK_GEMM(EpiC1, E, p.w<bf16>(WS_HB), 1024, p.w<bf16>(WS_WGX), 1024, 1024, 2560); ENDPH(pb); }
            if (IN_(pb + 1)) REPF(pb + 1) { PH_BEGIN(); c2_rglru(p, j, out + O_CP, out + O_CS, out + O_HS, mask); ENDPH(pb + 1); }
            if (IN_(pb + 3)) REPF(pb + 3) { PH_BEGIN(); c5_fixup(p, out + O_HP); ENDPH(pb + 3); }
        }
        if (IN_(pb + 5)) REPF(pb + 5) { PH_BEGIN(); EpiRes E{p.w<float>(WS_H), p.w<bf16>(WS_HB), p.stat(ST_SSQ0 + 2 * layer + 1) MK_DRYARG}; MK_GEMM(EpiRes, E, p.w<bf16>(resA), resK, p.w<bf16>(resB), resK, resK, 1024); ENDPH(pb + 5); }
        if (IN_(pb + 6)) REPF(pb + 6) { PH_BEGIN(); EpiF1 E{p.w<bf16>(WS_ACT), p.stat(ST_SSQ0 + 2 * layer + 1)}; MK_GEMM(EpiF1, E, p.w<bf16>(WS_HB), 1024, p.w<bf16>(WS_WGU + (size_t)layer * WGU_BYTES), 1024, 1024, 5632); ENDPH(pb + 6); }
        if (IN_(pb + 7)) REPF(pb + 7) { PH_BEGIN(); EpiRes E{p.w<float>(WS_H), p.w<bf16>(WS_HB), p.stat(ST_SSQ0 + 2 * layer + 2) MK_DRYARG}; MK_GEMM(EpiRes, E, p.w<bf16>(WS_ACT), DFF, p.w<bf16>(WS_WD + (size_t)layer * WD_BYTES), DFF, DFF, 1024); ENDPH(pb + 7); }
}
__global__ void __launch_bounds__(NWAVES * 64, 2) mk_fwd(Args a) {
    extern __shared__ __attribute__((aligned(16))) unsigned char lds_raw[];
    const int tid_ = threadIdx.x;
    const P p0{InTab{(const float* const __attribute__((address_space(4)))*)__builtin_amdgcn_kernarg_segment_ptr()}, a.out, a.ws, (LAS unsigned char*)lds_raw, tid_, tid_ & 63, __builtin_amdgcn_readfirstlane(tid_ >> 6), (int)gridDim.x, (int)blockIdx.x};
    volatile LAS unsigned* MISC = (volatile LAS unsigned*)(p0.lds + MISC_OFF);
    if (p0.tid < 64) MISC[p0.tid] = 0u;
    __syncthreads();
    XcdBarrier bar = xcd_barrier_post((unsigned*)(a.ws + WS_CTL) + CW_BAR + a.li * XCD_BAR_WORDS, MISC + 8);
    const int lo = a.ph_lo, hi = a.ph_hi, mask = a.mask;
    STAMP(0);
    if (IN_(0)) REPF(0) { PH_BEGIN(); p0_prologue(p, mask); if (mask & 128)
        { const int gt = p.bid * 512 + p.tid, NGT = p.G * 512; const u32x4 z = (u32x4){0u, 0u, 0u, 0u};
          for (int i = gt; i < 128 * 128; i += NGT) p.w<u32x4>(WS_UM + (size_t)MT * 2048)[i] = z;
          for (int i = gt; i < 128 * 256; i += NGT) p.w<u32x4>(WS_OB + (size_t)MT * 4096)[i] = z;
          for (int i = gt; i < 128 * 160; i += NGT) p.w<u32x4>(WS_GH + (size_t)MT * 2560)[i] = z; }
        ENDPH(0); }
    run_layer<0>(p0, bar, lo, hi, mask); run_layer<1>(p0, bar, lo, hi, mask); run_layer<2>(p0, bar, lo, hi, mask); run_layer<3>(p0, bar, lo, hi, mask);
    if (IN_(33)) REPF(33) { PH_BEGIN(); final_norm(p, out + O_YP, out + O_YS); VM_WAIT(); STAMP(34); }
#undef IN_
#undef ENDPH
}

inline void fill_args(Args& a, void* const* d_in, float* out, void* d_ws) { for (int i = 0; i < 36; ++i) a.in[i] = (const float*)d_in[i]; a.out = out; a.ws = (unsigned char*)d_ws; a.mask = -1; }
inline int setup_grid() {
    static int grid = 0;
    if (!grid) { int dev = 0, cus = 0; hipGetDevice(&dev); hipDeviceGetAttribute(&cus, hipDeviceAttributeMultiprocessorCount, dev);
        hipFuncSetAttribute((const void*)mk_fwd, hipFuncAttributeMaxDynamicSharedMemorySize, LDS_BYTES);
        int per_cu = 0; hipOccupancyMaxActiveBlocksPerMultiprocessor(&per_cu, (const void*)mk_fwd, NWAVES * 64, LDS_BYTES); (void)hipGetLastError();
        grid = cus > 0 ? cus : 256; }
    return grid;
}
inline void launch_range(void* const* d_in, float* out, void* d_ws, hipStream_t st, int lo, int hi, int li, int mask = -1) {
    Args a{}; fill_args(a, d_in, out, d_ws); a.ph_lo = lo; a.ph_hi = hi; a.li = li; a.mask = mask;
    hipLaunchKernelGGL(mk_fwd, dim3(setup_grid()), dim3(NWAVES * 64), LDS_BYTES, st, a);
}
}

extern "C" void kernel_launch(void* const* d_in, const int* in_sizes, int n_in, void* d_out, int out_size, void* d_ws, size_t ws_size, hipStream_t stream) {
    hipMemsetAsync(d_ws, 0, mk::CTL_BYTES, stream);
    mk::launch_range(d_in, (float*)d_out, d_ws, stream, 0, mk::NPHASE, 0);
}
```

```cpp
#include <hip/hip_runtime.h>
#include <math.h>
#define LAS __attribute__((address_space(3)))
#define GAS __attribute__((address_space(1)))
namespace pg8 {
#define PG8_LAS __attribute__((address_space(3)))
typedef unsigned short bf16_t;
typedef short bf16x8 __attribute__((ext_vector_type(8)));
typedef float f32x4 __attribute__((ext_vector_type(4)));
typedef unsigned u32x4 __attribute__((ext_vector_type(4)));
constexpr int BM = 256, BK = 64, HALF = 128, HTB = HALF * BK * 2  , STAGE_BYTES = 8 * HTB, NXCD = 8, WGM = 8;
__host__ __device__ __forceinline__ int lds_byte(int r, int c) { const int st = (r >> 4) * 2 + (c >> 5), rr = r & 15, cc = c & 31, ob = rr * 64 + cc * 2; return st * 1024 + (ob ^ (((ob >> 9) & 1) << 5)); }
__host__ __device__ __forceinline__ void stage_rc(int b, int& R, int& C) { const int st = b / 1024, sb = b % 1024, swz = sb ^ (((sb >> 9) & 1) << 5); R = (st >> 1) * 16 + swz / 64; C = (st & 1) * 32 + (swz % 64) / 2; }
__host__ __device__ __forceinline__ int perm32(int rho) { const int n = rho >> 4, i = rho & 15; return 8 * (i >> 2) + 4 * n + (i & 3); }
struct Unit { int pm, pn; };
struct Gemm { const bf16_t* A; const bf16_t* Bt; int lda, ldb, K; };
struct StaticOrder {
    int nM, nN, nwg, G, c;
    __host__ __device__ void init(int M, int N, int G_, int c_) { nM = M / BM; nN = N / BM; nwg = nM * nN; G = G_; c = c_; }
    __host__ __device__ bool next(int i, Unit& u) const {
        const long L = (long)i * G + c; if (L >= nwg) return false;
        int wgid = (int)L; { const int q = nwg / NXCD, r = nwg % NXCD, xcd = wgid % NXCD, off = wgid / NXCD; wgid = (xcd < r ? xcd * (q + 1) : r * (q + 1) + (xcd - r) * q) + off; }
        const int nig = WGM * nN, gid = wgid / nig, fm = gid * WGM, gsz = (nM - fm) < WGM ? (nM - fm) : WGM;
        u.pm = fm + ((wgid % nig) % gsz); u.pn = (wgid % nig) / gsz; return true;
    }
    __device__ __forceinline__ void a_ready(const Unit&) const {}
    __device__ __forceinline__ void done(const Unit&) const {}
};
__device__ __forceinline__ unsigned cvt_pk_bf16(float lo, float hi) { unsigned r; asm volatile("v_cvt_pk_bf16_f32 %0, %1, %2" : "=v"(r) : "v"(lo), "v"(hi)); return r; }
template <class Epi, class Sched, bool ALIGN_EPI = false, bool SP2 = false>
__device__ __forceinline__ void gemm_phase(PG8_LAS unsigned char* lds, const Gemm g, const Sched& S, const Epi& E, const int tid) {
    const int wid = __builtin_amdgcn_readfirstlane(tid >> 6), lane = tid & 63, wr = wid >> 2, wc = wid & 3, fr = lane & 15, fq = lane >> 4;
    const int K = g.K, nt = K / BK, lda = g.lda, ldb = g.ldb;
    unsigned voffA[2], voffB[2];
#pragma unroll
    for (int i = 0; i < 2; ++i) { int R, C; stage_rc(tid * 16 + i * 8192, R, C); const int Rb = Epi::PERM ? ((R & ~31) + perm32(R & 31)) : R;
        voffA[i] = (unsigned)(R * lda + C) * 2u; voffB[i] = (unsigned)(Rb * ldb + C) * 2u; }
    const size_t kstep = (size_t)(BK * 2);
    const size_t hstepA = (size_t)HALF * lda * 2, hstepB = (size_t)HALF * ldb * 2;
    const size_t tstepA = 2 * hstepA, tstepB = 2 * hstepB;
    const unsigned ldsw = (unsigned)wid * 1024u;
    const int aoff = lds_byte(wr * 64 + fr, fq * 8), boff = lds_byte(wc * 32 + fr, fq * 8);
#define PG8_SA(b, h) (((b) * 2 + (h)) * HTB)
#define PG8_SB(b, h) ((4 + (b) * 2 + (h)) * HTB)
#define PG8_STAGE(bufoff, gbase, voff) do { _Pragma("unroll") for (int _i = 0; _i < 2; ++_i) \
        __builtin_amdgcn_global_load_lds((const unsigned*)((const char*)(gbase) + (voff)[_i]), (PG8_LAS unsigned*)(lds + (bufoff) + ldsw + _i * 8192), 16, 0, 0); } while (0)
#define PG8_LDA(dst, b, h) do { _Pragma("unroll") for (int m = 0; m < 4; ++m) _Pragma("unroll") for (int k = 0; k < 2; ++k) dst[m][k] = *(const PG8_LAS bf16x8*)(lds + PG8_SA(b, h) + aoff + m * 2048 + k * 1024); } while (0)
#define PG8_LDB(dst, b, h) do { _Pragma("unroll") for (int n = 0; n < 2; ++n) _Pragma("unroll") for (int k = 0; k < 2; ++k) dst[n][k] = *(const PG8_LAS bf16x8*)(lds + PG8_SB(b, h) + boff + n * 2048 + k * 1024); } while (0)
#define PG8_MMA(ai, bj, At, Bt) do { __builtin_amdgcn_s_setprio(1); _Pragma("unroll") for (int m = 0; m < 4; ++m) _Pragma("unroll") for (int n = 0; n < 2; ++n) _Pragma("unroll") for (int k = 0; k < 2; ++k) \
        acc[ai][bj][m][n] = __builtin_amdgcn_mfma_f32_16x16x32_bf16(Bt[n][k], At[m][k], acc[ai][bj][m][n], 0, 0, 0); __builtin_amdgcn_s_setprio(0); } while (0)
#define PG8_WAIT_V(n) asm volatile("s_waitcnt vmcnt(" #n ")" ::: "memory")
#define PG8_WAIT_L(n) asm volatile("s_waitcnt lgkmcnt(" #n ")" ::: "memory")
#define PG8_BAR __builtin_amdgcn_s_barrier()
#define PG8_SCHED __builtin_amdgcn_sched_barrier(0)
    Unit cur, nxt; int ui = 0;
    if (!S.next(0, cur)) return;
    f32x4 acc[2][2][4][2];
#pragma unroll
    for (int a = 0; a < 2; ++a)
#pragma unroll
        for (int b = 0; b < 2; ++b)
#pragma unroll
            for (int m = 0; m < 4; ++m)
#pragma unroll
                for (int n = 0; n < 2; ++n) acc[a][b][m][n] = (f32x4){0.f, 0.f, 0.f, 0.f};
    bf16x8 At[4][2], B0[2][2], B1[2][2];
    const char* cA = (const char*)g.A + (size_t)cur.pm * tstepA; const char* cB = (const char*)g.Bt + (size_t)cur.pn * tstepB;
    S.a_ready(cur);
    if constexpr (SP2) {
        PG8_STAGE(PG8_SB(0, 0), cB, voffB); PG8_STAGE(PG8_SB(0, 1), cB + hstepB, voffB); PG8_STAGE(PG8_SA(0, 0), cA, voffA); PG8_STAGE(PG8_SA(0, 1), cA + hstepA, voffA);
        if (wr == 1) PG8_BAR;
        PG8_WAIT_V(2); PG8_BAR;
        PG8_STAGE(PG8_SB(1, 0), cB + kstep, voffB); PG8_STAGE(PG8_SA(1, 0), cA + kstep, voffA); PG8_STAGE(PG8_SB(1, 1), cB + hstepB + kstep, voffB);
        PG8_WAIT_V(6); PG8_BAR;
    } else {
        PG8_STAGE(PG8_SB(0, 0), cB, voffB); PG8_STAGE(PG8_SA(0, 0), cA, voffA); PG8_STAGE(PG8_SB(0, 1), cB + hstepB, voffB); PG8_STAGE(PG8_SA(0, 1), cA + hstepA, voffA);
        if (wr == 1) PG8_BAR;
        PG8_WAIT_V(4); PG8_BAR;
        PG8_STAGE(PG8_SB(1, 0), cB + kstep, voffB); PG8_STAGE(PG8_SA(1, 0), cA + kstep, voffA); PG8_STAGE(PG8_SB(1, 1), cB + hstepB + kstep, voffB);
        PG8_WAIT_V(6); PG8_BAR;
    }
    for (;;) {
        const bool has_next = S.next(ui + 1, nxt);
        const char* nA = has_next ? (const char*)g.A + (size_t)nxt.pm * tstepA : cA; const char* nB = has_next ? (const char*)g.Bt + (size_t)nxt.pn * tstepB : cB;
        for (int t = 0; t < nt; t += 2) {
            const bool last = (t == nt - 2);
            const char* a1 = cA + (size_t)(t + 1) * kstep;
            const char* a2 = last ? nA : cA + (size_t)(t + 2) * kstep; const char* b2 = last ? nB : cB + (size_t)(t + 2) * kstep;
            const char* a3 = a2 + kstep; const char* b3 = b2 + kstep;
            if (last && has_next) S.a_ready(nxt);
            if constexpr (SP2) {
            PG8_LDB(B0, 0, 0); PG8_LDB(B1, 0, 1); PG8_SCHED; PG8_LDA(At, 0, 0); PG8_STAGE(PG8_SA(1, 1), a1 + hstepA, voffA);
            PG8_WAIT_V(8); PG8_WAIT_L(0); PG8_BAR; PG8_MMA(0, 0, At, B0); PG8_MMA(0, 1, At, B1); PG8_BAR; PG8_SCHED;
            PG8_LDA(At, 0, 1); PG8_STAGE(PG8_SB(0, 0), b2, voffB); PG8_STAGE(PG8_SB(0, 1), b2 + hstepB, voffB); PG8_STAGE(PG8_SA(0, 0), a2, voffA);
            PG8_WAIT_V(8); PG8_WAIT_L(0); PG8_BAR; PG8_MMA(1, 0, At, B0); PG8_MMA(1, 1, At, B1); PG8_BAR; PG8_SCHED;
            PG8_LDB(B0, 1, 0); PG8_LDB(B1, 1, 1); PG8_SCHED; PG8_LDA(At, 1, 0); PG8_STAGE(PG8_SA(0, 1), a2 + hstepA, voffA);
            PG8_WAIT_V(8); PG8_WAIT_L(0); PG8_BAR; PG8_MMA(0, 0, At, B0); PG8_MMA(0, 1, At, B1); PG8_BAR; PG8_SCHED;
            PG8_LDA(At, 1, 1); PG8_STAGE(PG8_SB(1, 0), b3, voffB); PG8_STAGE(PG8_SB(1, 1), b3 + hstepB, voffB); PG8_STAGE(PG8_SA(1, 0), a3, voffA);
            PG8_WAIT_V(8); PG8_WAIT_L(0); PG8_BAR; PG8_MMA(1, 0, At, B0); PG8_MMA(1, 1, At, B1); PG8_BAR; PG8_SCHED;
            } else {
            PG8_LDB(B0, 0, 0); PG8_SCHED; PG8_LDA(At, 0, 0); PG8_STAGE(PG8_SA(1, 1), a1 + hstepA, voffA);
            PG8_WAIT_L(8); PG8_BAR; PG8_WAIT_L(0); PG8_MMA(0, 0, At, B0); PG8_BAR; PG8_SCHED;
            PG8_LDB(B1, 0, 1); PG8_STAGE(PG8_SB(0, 0), b2, voffB);
            PG8_BAR; PG8_WAIT_L(0); PG8_MMA(0, 1, At, B1); PG8_BAR;
            PG8_LDA(At, 0, 1); PG8_STAGE(PG8_SA(0, 0), a2, voffA);
            PG8_BAR; PG8_WAIT_L(0); PG8_MMA(1, 0, At, B0); PG8_BAR; PG8_SCHED;
            PG8_STAGE(PG8_SB(0, 1), b2 + hstepB, voffB);
            PG8_WAIT_V(6); PG8_BAR; PG8_MMA(1, 1, At, B1); PG8_BAR;
            PG8_LDB(B0, 1, 0); PG8_SCHED; PG8_LDA(At, 1, 0); PG8_STAGE(PG8_SA(0, 1), a2 + hstepA, voffA);
            PG8_WAIT_L(8); PG8_BAR; PG8_WAIT_L(0); PG8_MMA(0, 0, At, B0); PG8_BAR; PG8_SCHED;
            PG8_LDB(B1, 1, 1); PG8_STAGE(PG8_SB(1, 0), b3, voffB);
            PG8_BAR; PG8_WAIT_L(0); PG8_MMA(0, 1, At, B1); PG8_BAR;
            PG8_LDA(At, 1, 1); PG8_STAGE(PG8_SA(1, 0), a3, voffA);
            PG8_BAR; PG8_WAIT_L(0); PG8_MMA(1, 0, At, B0); PG8_BAR; PG8_SCHED;
            PG8_STAGE(PG8_SB(1, 1), b3 + hstepB, voffB);
            PG8_WAIT_V(6); PG8_BAR; PG8_MMA(1, 1, At, B1); PG8_BAR;
            }
        }
        if constexpr (ALIGN_EPI) { if (wr == 0) PG8_BAR; }
        if constexpr (!Epi::AFTER_DRAIN) { E(acc, cur, wr, wc, fr, fq); S.done(cur); }
        if (!has_next) break;
#pragma unroll
        for (int a = 0; a < 2; ++a)
#pragma unroll
            for (int b = 0; b < 2; ++b)
#pragma unroll
                for (int m = 0; m < 4; ++m)
#pragma unroll
                    for (int n = 0; n < 2; ++n) acc[a][b][m][n] = (f32x4){0.f, 0.f, 0.f, 0.f};
        cur = nxt; cA = nA; cB = nB; ++ui;
        if constexpr (ALIGN_EPI) { if (wr == 1) PG8_BAR; }
    }
    PG8_WAIT_V(0);
    if constexpr (!ALIGN_EPI) { if (wr == 0) PG8_BAR; }
    PG8_BAR;
    if constexpr (Epi::AFTER_DRAIN) { E.fused(acc, cur, wr, wc, fr, fq, lds, wid, lane); S.done(cur); }
#undef PG8_SA
#undef PG8_SB
#undef PG8_STAGE
#undef PG8_LDA
#undef PG8_LDB
#undef PG8_MMA
#undef PG8_WAIT_V
#undef PG8_WAIT_L
#undef PG8_BAR
#undef PG8_SCHED
}

}

namespace mk {
using pg8::f32x4; using pg8::bf16x8; using pg8::u32x4; using pg8::cvt_pk_bf16;
typedef unsigned short bf16;
typedef unsigned u32x2 __attribute__((ext_vector_type(2)));
typedef short s16x4 __attribute__((ext_vector_type(4)));
typedef float f32x2 __attribute__((ext_vector_type(2)));
typedef GAS unsigned gu32;
#define RLX_AGENT __ATOMIC_RELAXED, __HIP_MEMORY_SCOPE_AGENT
#define XB_TMO      128
#define XB_XCNT(j)  (256  + 64 * (j))
#define XB_XSUB(j)  (1280 + 64 * (j))
#define XB_XGEN(j)  (2304 + 64 * (j))
#define XB_TOP      3328
#define XB_TOPGEN   3392
#define XCD_BAR_WORDS 3456
#define XB_SPIN_CAP (1u << 18)

__device__ __forceinline__ unsigned xb_ld(unsigned* p)              { return __hip_atomic_load(p, __ATOMIC_RELAXED, __HIP_MEMORY_SCOPE_AGENT); }
__device__ __forceinline__ unsigned xb_add(unsigned* p, unsigned v) { return __hip_atomic_fetch_add(p, v, __ATOMIC_RELAXED, __HIP_MEMORY_SCOPE_AGENT); }
__device__ __forceinline__ unsigned xb_xcc_id() { return (unsigned)__builtin_amdgcn_s_getreg((3 << 11) | 20) & 0xFu; }
#define XB_SPIN(cond, bar) do { unsigned _sp = 0; while (cond) { __builtin_amdgcn_s_sleep(1); \
    if ((++_sp & 255u) == 0u) { if (xb_ld(&(bar)[XB_TMO])) break; if (_sp > XB_SPIN_CAP) { atomicAdd(&(bar)[XB_TMO], 1u); break; } } } } while (0)

struct XcdBarrier {
    unsigned* bar; unsigned x;
    volatile LAS unsigned* st;
};

__device__ __forceinline__ XcdBarrier xcd_barrier_post(unsigned* bar, volatile LAS unsigned* st) {
    XcdBarrier b; b.bar = bar; b.x = xb_xcc_id(); b.st = st;
    if (threadIdx.x == 0) (void)xb_add(&bar[XB_XCNT(b.x)], 1u);
    return b;
}
__device__ __forceinline__ void xcd_barrier_complete(unsigned* bar, unsigned x, unsigned& nloc, unsigned& nx) {
    const unsigned G = gridDim.x * gridDim.y * gridDim.z;
    unsigned sum, cnt, mine, sp = 0u;
    for (;;) {
        sum = 0u; cnt = 0u; mine = 0u;
#pragma unroll
        for (unsigned j = 0; j < 16; ++j) { const unsigned c = xb_ld(&bar[XB_XCNT(j)]); sum += c; cnt += (c > 0u) ? 1u : 0u; mine = (j == x) ? c : mine; }
        if (sum == G) break;
        __builtin_amdgcn_s_sleep(1);
        if ((++sp & 255u) == 0u) { if (xb_ld(&bar[XB_TMO])) break; if (sp > XB_SPIN_CAP) { atomicAdd(&bar[XB_TMO], 1u); break; } }
    }
    nloc = mine > 0u ? mine : 1u; nx = cnt > 0u ? cnt : 1u;
}

__device__ __forceinline__ void xcd_barrier(const XcdBarrier& b) {
    asm volatile("s_waitcnt vmcnt(0)" ::: "memory");
    __syncthreads();
    if (threadIdx.x == 0) {
        unsigned* bar = b.bar;
        __builtin_amdgcn_s_waitcnt(0);
        unsigned nloc = b.st[0], nx = b.st[1];
        if (nloc == 0u) { xcd_barrier_complete(bar, b.x, nloc, nx); b.st[0] = nloc; b.st[1] = nx; }
        const unsigned old = xb_add(&bar[XB_XSUB(b.x)], 1u);
        const unsigned gen = old / nloc;
        if (old + 1u == (gen + 1u) * nloc) {
            __builtin_amdgcn_fence(__ATOMIC_RELEASE, "agent");
            asm volatile("s_waitcnt vmcnt(0)" ::: "memory");
            const unsigned og = xb_add(&bar[XB_TOP], 1u);
            const unsigned tg = og / nx;
            if (og + 1u == (tg + 1u) * nx) xb_add(&bar[XB_TOPGEN], 1u);
            else XB_SPIN(xb_ld(&bar[XB_TOPGEN]) == tg, bar);
            __builtin_amdgcn_fence(__ATOMIC_ACQUIRE, "agent");
            xb_add(&bar[XB_XGEN(b.x)], 1u);
            asm volatile("s_waitcnt vmcnt(0)" ::: "memory");
        } else {
            XB_SPIN(xb_ld(&bar[XB_XGEN(b.x)]) == gen, bar);
            __builtin_amdgcn_fence(__ATOMIC_ACQUIRE, "agent");
            asm volatile("s_waitcnt vmcnt(0)" ::: "memory");
        }
    }
    __syncthreads();
}


constexpr int MP = 16384, MS = 128, MT = MP + MS, MR = 16640;
constexpr int D = 1024, DFF = 2816, NWAVES = 8;
constexpr float RMS_EPS = 1e-6f, LN_EPS = 1e-5f;
constexpr float MLA_SCALE = 0.07216878364870322f;
constexpr size_t MiB = 1u << 20;
constexpr size_t WS_CTL = 0, CTL_BYTES = 3 * MiB;
constexpr int CW_BAR = 4096;
constexpr size_t ST_OFF = 65536, ST_STRIDE = (size_t)MR * 8;
constexpr int ST_SSQ0 = 0  , ST_LNS0 = 9, ST_LNQ0 = 10  , ST_KV = 13, ST_Q = 14, NSTAT = 15;
static_assert(ST_OFF + NSTAT * ST_STRIDE <= CTL_BYTES, "stats inside CTL");
constexpr size_t WS_WGU = 3 * MiB, WGU_BYTES = 11 * MiB, WS_WD = 47 * MiB, WD_BYTES = 5767168, WS_WIN = 69 * MiB, WS_WOUT = 77 * MiB, WS_WS = 81 * MiB,
                 WS_WDQKV = 82 * MiB, WS_WQ = 84 * MiB, WS_WOV = 86 * MiB, WS_WGX = 90 * MiB, WS_WAT = 95 * MiB, WS_WIT = 95 * MiB + 512 * 1024, WS_WCO = 96 * MiB, WS_ROPE = 99 * MiB;
constexpr size_t WS_H = 100 * MiB, WS_HB = 165 * MiB, WS_U = 198 * MiB, WS_GV = 231 * MiB, WS_UM = 264 * MiB, WS_ACT = 297 * MiB, WS_RAW = 387 * MiB, WS_CQB = 436 * MiB,
                 WS_QF = 449 * MiB, WS_KVB = 531 * MiB, WS_OB = 542 * MiB, WS_PART = 607 * MiB, WS_PML = 623 * MiB, WS_GATE = 624 * MiB, WS_XW = 665 * MiB, WS_AA = 747 * MiB, WS_BB = 829 * MiB,
                 WS_AGG = 911 * MiB, WS_GH = 914 * MiB, WS_PROF = 955 * MiB, WS_MK_END = 956 * MiB;
constexpr int RING_BYTES = 131072, LDS_BYTES = 147456, MISC_OFF = LDS_BYTES - 256;
constexpr size_t O_YP = 0, O_YS = 16777216, O_CV = 16908288, O_MP = 17170432, O_MS = 22413312, O_HP = 22454272, O_HS = 22464512, O_CP = 22505472, O_CS = 22536192, O_END = 22659072;

__device__ __forceinline__ float fast_sigmoid_l2(float t) { return __builtin_amdgcn_rcpf(1.0f + __builtin_amdgcn_exp2f(-t)); }
__device__ __forceinline__ float gelu_tanh_f(float x) { return x * fast_sigmoid_l2(2.302208198f * (x + 0.044715f * x * x * x)); }
__device__ __forceinline__ float silu_f(float x) { return x * fast_sigmoid_l2(1.4426950409f * x); }
__device__ __forceinline__ unsigned f2bf(float f) { unsigned u = __builtin_bit_cast(unsigned, f); return (u + 0x7fffu + ((u >> 16) & 1u)) >> 16; }
__device__ __forceinline__ unsigned pk2(float lo, float hi) { return f2bf(lo) | (f2bf(hi) << 16); }
__device__ __forceinline__ float bf2f(unsigned short b) { return __builtin_bit_cast(float, (unsigned)b << 16); }
__device__ __forceinline__ float bflo(unsigned w) { return __builtin_bit_cast(float, w << 16); }
__device__ __forceinline__ float bfhi(unsigned w) { return __builtin_bit_cast(float, w & 0xffff0000u); }
constexpr float ST_SCALE = 16777216.0f, ST_INV = 1.0f / 16777216.0f;
__device__ __forceinline__ void stat_add(long long* p, float v) { atomicAdd((unsigned long long*)p, (unsigned long long)(long long)__float2ll_rn(v * ST_SCALE)); }
__device__ __forceinline__ void stat_set(long long* p, float v) { *p = (long long)__float2ll_rn(v * ST_SCALE); }
__device__ __forceinline__ float stat_get(const long long* p) { return (float)(*p) * ST_INV; }
#define LDS_WAIT() asm volatile("s_waitcnt lgkmcnt(0)" ::: "memory")
#define VM_WAIT() asm volatile("s_waitcnt vmcnt(0)" ::: "memory")

struct InTab { const float* const __attribute__((address_space(4)))* t; __device__ __forceinline__ const float* operator[](int i) const { return t[i]; } };
struct P {
    InTab in; float* out; unsigned char* ws;
    LAS unsigned char* lds; int tid, lane, wave, G, bid;
    __device__ __forceinline__ long long* stat(int a) const { return (long long*)(ws + ST_OFF + (size_t)a * ST_STRIDE); }
    template <class T> __device__ __forceinline__ T* w(size_t off) const { return (T*)(ws + off); }
};
}
namespace mk {
struct TrJob { const float* src; int ldsrc, K, N; bf16* dst; int lddst; const float* gain; int kind, off; };
__device__ __forceinline__ int tr_rowmap(int kind, int off, int n) { return kind == 1 ? ((n >> 7) * 256 + (n & 127) + off) : (off + n); }
__device__ __forceinline__ void tr_item(const TrJob& j, LAS float* scr, int item, int lane) {
    const int nblk = j.N / 32, kb = item / nblk, nb = item % nblk, k0 = 64 * kb, n0 = 32 * nb;
    const float* src = j.src + (size_t)(k0 + (lane >> 5)) * j.ldsrc + n0 + (lane & 31); const size_t rstep = (size_t)2 * j.ldsrc;
    float v[32];
#pragma unroll
    for (int i = 0; i < 32; ++i) v[i] = src[i * rstep];
    if (j.gain) { const float* gp = j.gain + k0 + (lane >> 5); float g[32];
#pragma unroll
        for (int i = 0; i < 32; ++i) g[i] = gp[2 * i];
#pragma unroll
        for (int i = 0; i < 32; ++i) v[i] *= g[i]; }
#pragma unroll
    for (int i = 0; i < 32; ++i) scr[(2 * i + (lane >> 5)) * 33 + (lane & 31)] = v[i];
    LDS_WAIT(); asm volatile("" ::: "memory");
    const int c = lane & 7;
#pragma unroll
    for (int jj = 0; jj < 4; ++jj) { const int n = (lane >> 3) + 8 * jj; const LAS float* s = scr + (8 * c) * 33 + n;
        u32x4 o; o.x = pk2(s[0], s[33]); o.y = pk2(s[66], s[99]); o.z = pk2(s[132], s[165]); o.w = pk2(s[198], s[231]);
        *(u32x4*)(j.dst + (size_t)tr_rowmap(j.kind, j.off, n0 + n) * j.lddst + k0 + 8 * c) = o; }
    LDS_WAIT(); asm volatile("" ::: "memory");
}
constexpr int NJOBS = 24;
__device__ __forceinline__ TrJob get_job(const P& p, int jid) {
    TrJob j; j.gain = nullptr; j.kind = 0; j.off = 0; j.src = nullptr; j.dst = nullptr; j.ldsrc = 0; j.K = 0; j.N = 0; j.lddst = 0;
    if (jid < 12) { const int l = jid / 3, t = jid % 3;
        if (t < 2) { j.src = p.in[33 + t] + (size_t)l * D * DFF; j.ldsrc = DFF; j.K = D; j.N = DFF; j.dst = p.w<bf16>(WS_WGU + l * WGU_BYTES); j.lddst = D; j.gain = p.in[7] + l * D; j.kind = 1; j.off = 128 * t; }
        else { j.src = p.in[35] + (size_t)l * DFF * D; j.ldsrc = D; j.K = DFF; j.N = D; j.dst = p.w<bf16>(WS_WD + l * WD_BYTES); j.lddst = DFF; }
    } else if (jid < 16) { const int a = (jid - 12) >> 1;
        if (((jid - 12) & 1) == 0) { j.src = p.in[9] + (size_t)a * D * 2048; j.ldsrc = 2048; j.K = D; j.N = 2048; j.dst = p.w<bf16>(WS_WIN + a * 4 * MiB); j.lddst = D; j.gain = p.in[6] + (3 * a) * D; }
        else { j.src = p.in[14] + (size_t)a * D * D; j.ldsrc = D; j.K = D; j.N = D; j.dst = p.w<bf16>(WS_WOUT + a * 2 * MiB); j.lddst = D; }
    } else if (jid == 16) { j.src = p.in[15]; j.ldsrc = 384; j.K = D; j.N = 384; j.dst = p.w<bf16>(WS_WDQKV); j.lddst = D; j.gain = p.in[6] + D; j.off = 256; }
    else if (jid == 17) { j.src = p.in[18]; j.ldsrc = 320; j.K = D; j.N = 256; j.dst = p.w<bf16>(WS_WDQKV); j.lddst = D; j.gain = p.in[6] + D; j.off = 0; }
    else if (jid == 18) { j.src = p.in[18] + 256; j.ldsrc = 320; j.K = D; j.N = 64; j.dst = p.w<bf16>(WS_WDQKV); j.lddst = D; j.gain = p.in[6] + D; j.off = 640; }
    else if (jid == 19) { j.src = p.in[24]; j.ldsrc = 1280; j.K = D; j.N = 1280; j.dst = p.w<bf16>(WS_WGX); j.lddst = D; j.gain = p.in[6] + 2 * D; j.off = 0; }
    else if (jid == 20) { j.src = p.in[23]; j.ldsrc = 1280; j.K = D; j.N = 1280; j.dst = p.w<bf16>(WS_WGX); j.lddst = D; j.gain = p.in[6] + 2 * D; j.off = 1280; }
    else if (jid == 21) { j.src = p.in[32]; j.ldsrc = D; j.K = 1280; j.N = D; j.dst = p.w<bf16>(WS_WCO); j.lddst = 1280; }
    else if (jid == 22) { j.src = p.in[27]; j.ldsrc = 128; j.K = 128; j.N = 128; j.dst = p.w<bf16>(WS_WAT); j.lddst = 128; j.kind = 2; }
    else { j.src = p.in[29]; j.ldsrc = 128; j.K = 128; j.N = 128; j.dst = p.w<bf16>(WS_WIT); j.lddst = 128; j.kind = 2; }
    return j;
}
__device__ __forceinline__ int job_items(const TrJob& j) { return j.kind == 2 ? 80 : (j.K / 64) * (j.N / 32); }

__device__ __forceinline__ void p0_prologue(const P& p, const int mask) {
    LAS float* scr = (LAS float*)(p.lds + p.wave * 16384);
    const int gw = p.bid * NWAVES + p.wave, NGW = p.G * NWAVES, lane = p.lane;
    const int gt = p.bid * (NWAVES * 64) + p.tid, NGT = p.G * NWAVES * 64;
    if (mask & 1) {
    {
        int base = 0;
        for (int jid = 0; jid < NJOBS; ++jid) {
            TrJob j = get_job(p, jid); const int nit = job_items(j);
            int first = (gw - base % NGW + NGW) % NGW;
            for (int it = first; it < nit; it += NGW) {
                if (j.kind == 2) { TrJob b = j; const int blk = it >> 3; b.src = j.src + (size_t)blk * 16384; b.dst = j.dst + (size_t)blk * 16384; b.kind = 0; tr_item(b, scr, it & 7, lane); }
                else tr_item(j, scr, it, lane);
            }
            base += nit;
        }
    }
    }
    if (mask & 2) {
    { u32x4* z = (u32x4*)(p.w<bf16>(WS_WDQKV) + (size_t)704 * D); for (int i = gt; i < 64 * D / 8; i += NGT) z[i] = (u32x4){0u, 0u, 0u, 0u}; }
    }
    if (mask & 4) {
    for (int i = gt; i < 2 * 8 * 128 * 16; i += NGT) {
        const int s0 = (i & 15) * 8, t = (i >> 4) & 127, jg = i >> 11; const float* src = p.in[12] + (size_t)jg * 16384;
        unsigned w[4], ws_[4];
#pragma unroll
        for (int e = 0; e < 4; ++e) { float v[2], vs[2];
#pragma unroll
            for (int h = 0; h < 2; ++h) { const int s = s0 + 2 * e + h; v[h] = (s <= t) ? src[t * 128 + s] : 0.f; vs[h] = ((s >> 2) == (t >> 2) && (s & 3) <= (t & 3)) ? src[(t & 3) * 128 + (s & 3)] : 0.f; }
            w[e] = pk2(v[0], v[1]); ws_[e] = pk2(vs[0], vs[1]); }
        const int j = jg >> 3, g = jg & 7;
        *(u32x4*)(p.w<bf16>(WS_WS + (size_t)j * 262144) + ((size_t)g * 128 + t) * 128 + s0) = (u32x4){w[0], w[1], w[2], w[3]};
        *(u32x4*)(p.w<bf16>(WS_WS + 524288 + (size_t)j * 262144) + ((size_t)g * 128 + t) * 128 + s0) = (u32x4){ws_[0], ws_[1], ws_[2], ws_[3]};
    }
    }
    if (mask & 8) {
    for (int i = gt; i < 2052 * 32; i += NGT) { const int tp = i >> 5, fi = i & 31, pos = tp < 2048 ? tp : 16384 + (tp - 2048);
        const float inv = 1.0f / powf(10000.0f, (float)(2 * fi) / 64.0f); const float ang = (float)pos * inv;
        p.w<f32x2>(WS_ROPE)[i] = (f32x2){cosf(ang), sinf(ang)}; }
    }
    if (mask & 16) {
    { bf16* HB = p.w<bf16>(WS_HB); long long* ssq = p.stat(ST_SSQ0);
      for (int m = gw; m < MR; m += NGW) {
        f32x4 v[4]; float s = 0.f;
#pragma unroll
        for (int jj = 0; jj < 4; ++jj) { const int c = 4 * lane + 256 * jj;
            if (m < MP) v[jj] = *(const f32x4*)(p.in[0] + (size_t)m * D + c); else if (m < MT) v[jj] = *(const f32x4*)(p.in[1] + (size_t)(m - MP) * D + c); else v[jj] = (f32x4){0.f, 0.f, 0.f, 0.f};
            s += (v[jj].x * v[jj].x + v[jj].y * v[jj].y) + (v[jj].z * v[jj].z + v[jj].w * v[jj].w); }
#pragma unroll
        for (int o = 1; o < 64; o <<= 1) s += __shfl_xor(s, o);
#pragma unroll
        for (int jj = 0; jj < 4; ++jj) { const int c = 4 * lane + 256 * jj;
            *(u32x2*)(HB + (size_t)m * D + c) = (u32x2){pk2(v[jj].x, v[jj].y), pk2(v[jj].z, v[jj].w)}; }
        if (lane == 0) stat_set(ssq + m, s);
      } }
    }
    if (mask & 32) {
    { const float* wuq = p.in[17]; const float* wuk = p.in[20]; const float* qn = p.in[16]; bf16* Wq = p.w<bf16>(WS_WQ);
      LAS float* Qs = (LAS float*)p.lds;
      for (int it = p.bid; it < 192; it += p.G) {
        const int h = it / 24, kb = (it >> 2) % 6, cq = it & 3, k0 = 64 * kb;
        __syncthreads();
#pragma unroll
        for (int q = 0; q < 4; ++q) { const int idx = p.tid + 512 * q, row = idx >> 5, c4 = idx & 31; *(LAS f32x4*)(Qs + row * 132 + c4 * 4) = *(const f32x4*)(wuq + (size_t)(k0 + row) * 1536 + h * 192 + c4 * 4); }
        __syncthreads();
        const int c0 = cq * 64 + p.wave * 8; float acc[8];
#pragma unroll
        for (int cc = 0; cc < 8; ++cc) acc[cc] = 0.f;
        for (int n4 = 0; n4 < 32; ++n4) { const f32x4 bv = *(const LAS f32x4*)(Qs + lane * 132 + n4 * 4);
#pragma unroll
            for (int cc = 0; cc < 8; ++cc) { const f32x4 av = *(const f32x4*)(wuk + (size_t)(c0 + cc) * 1024 + h * 128 + n4 * 4); acc[cc] += (av.x * bv.x + av.y * bv.y) + (av.z * bv.z + av.w * bv.w); } }
        const float g = qn[k0 + lane];
#pragma unroll
        for (int cc = 0; cc < 8; ++cc) Wq[(size_t)(320 * h + c0 + cc) * 384 + k0 + lane] = (bf16)f2bf(acc[cc] * g);
      }
      for (int r = gw; r < 512; r += NGW) { const int h = r >> 6, ie = r & 63, i = ie >> 1, e = ie & 1;
#pragma unroll
        for (int kk = 0; kk < 6; ++kk) { const int k = lane + 64 * kk; Wq[(size_t)(320 * h + 256 + ie) * 384 + k] = (bf16)f2bf(wuq[(size_t)k * 1536 + h * 192 + 128 + 32 * e + i] * qn[k]); } } }
    }
    if (mask & 64) {
    { const float* wuv = p.in[21]; const float* wo = p.in[22]; bf16* Wov = p.w<bf16>(WS_WOV);
      for (int it = gw; it < 2048; it += NGW) { const int h = it >> 8, cg = (it >> 2) & 63, nb = it & 3, c0 = cg * 4, n = nb * 256 + lane * 4;
        f32x4 acc[4];
#pragma unroll
        for (int cc = 0; cc < 4; ++cc) acc[cc] = (f32x4){0.f, 0.f, 0.f, 0.f};
        for (int v = 0; v < 128; ++v) { const f32x4 b = *(const f32x4*)(wo + (size_t)(h * 128 + v) * D + n);
#pragma unroll
            for (int cc = 0; cc < 4; ++cc) { const float a = wuv[(size_t)(c0 + cc) * 1024 + h * 128 + v]; acc[cc] += b * a; } }
#pragma unroll
        for (int jn = 0; jn < 4; ++jn) *(u32x2*)(Wov + (size_t)(n + jn) * 2048 + h * 256 + c0) = (u32x2){pk2(acc[0][jn], acc[1][jn]), pk2(acc[2][jn], acc[3][jn])};
      } }
    }
}
}
namespace mk {
#ifdef MK_DRYPROBE
#define MK_DRY(E) ((E).dry)
#define MK_DRYFIELD int dry;
#else
#define MK_DRY(E) 0
#define MK_DRYFIELD
#endif
typedef const f32x4 (&AccRef)[2][2][4][2];
__device__ __forceinline__ float quad_red(float v) { v += __shfl_xor(v, 16); v += __shfl_xor(v, 32); return v; }
__device__ __forceinline__ u32x4 pack8(const f32x4 a, const f32x4 b) { u32x4 w; w.x = cvt_pk_bf16(a[0], a[1]); w.y = cvt_pk_bf16(a[2], a[3]); w.z = cvt_pk_bf16(b[0], b[1]); w.w = cvt_pk_bf16(b[2], b[3]); return w; }
__device__ __forceinline__ float sumsq8(const f32x4 a, const f32x4 b) { return ((a[0] * a[0] + a[1] * a[1]) + (a[2] * a[2] + a[3] * a[3])) + ((b[0] * b[0] + b[1] * b[1]) + (b[2] * b[2] + b[3] * b[3])); }
__device__ __forceinline__ float sum8(const f32x4 a, const f32x4 b) { return ((a[0] + a[1]) + (a[2] + a[3])) + ((b[0] + b[1]) + (b[2] + b[3])); }
#define MK_EPI_CALL() \
    __device__ __forceinline__ void operator()(AccRef acc, const pg8::Unit& u, int wr, int wc, int fr, int fq) const { \
        _Pragma("unroll") for (int ai = 0; ai < 2; ++ai) _Pragma("unroll") for (int m = 0; m < 4; ++m) \
            rg(u.pm * 256 + ai * 128 + wr * 64 + m * 16 + fr, u.pn, wc, fq, acc[ai][0][m][0], acc[ai][0][m][1], acc[ai][1][m][0], acc[ai][1][m][1]); }
#define MK_EPI_CALL_DENSE() \
    __device__ __forceinline__ void operator()(AccRef acc, const pg8::Unit& u, int wr, int wc, int fr, int fq) const { \
        _Pragma("unroll") for (int ai = 0; ai < 2; ++ai) { float s1 = 0.f, s2 = 0.f; \
            _Pragma("unroll") for (int m = 0; m < 4; ++m) { float t1, t2; \
                rgs(u.pm * 256 + ai * 128 + wr * 64 + m * 16 + fr, u.pn, wc, fq, acc[ai][0][m][0], acc[ai][0][m][1], acc[ai][1][m][0], acc[ai][1][m][1], t1, t2); \
                s1 = (fq == m) ? t1 : s1; s2 = (fq == m) ? t2 : s2; } \
            stats(u.pm * 256 + ai * 128 + wr * 64 + fq * 16 + fr, u.pn, s1, s2); } } \
    __device__ __forceinline__ void rg(int r, int pn, int wc, int fq, f32x4 a0, f32x4 b0, f32x4 a1, f32x4 b1) const { float t1, t2; rgs(r, pn, wc, fq, a0, b0, a1, b1, t1, t2); if (fq == 0) stats(r, pn, t1, t2); }

struct EpiA1 {
    static constexpr bool PERM = true, AFTER_DRAIN = false;
    bf16* U; bf16* GV; const long long* ssq; long long* lns; long long* lnq; MK_DRYFIELD
    __device__ __forceinline__ void rgs(int r, int pn, int wc, int fq, f32x4 a0, f32x4 b0, f32x4 a1, f32x4 b1, float& s1, float& s2) const {
        const bool isv = pn >= 4; bf16* dst = (isv ? GV : U) + (size_t)r * 1024 + (pn & 3) * 256 + wc * 32 + 8 * fq; const float rs = rsqrtf(stat_get(ssq + r) * (1.0f / 1024.0f) + RMS_EPS);
        a0 *= rs; b0 *= rs; a1 *= rs; b1 *= rs;
#pragma unroll
        for (int e = 0; e < 4; ++e) { a0[e] = gelu_tanh_f(a0[e]); b0[e] = gelu_tanh_f(b0[e]); a1[e] = gelu_tanh_f(a1[e]); b1[e] = gelu_tanh_f(b1[e]); }
        *(u32x4*)dst = pack8(a0, b0); *(u32x4*)(dst + 128) = pack8(a1, b1);
        s1 = 0.f; s2 = 0.f;
        if (isv) { s1 = quad_red(sum8(a0, b0) + sum8(a1, b1)); s2 = quad_red(sumsq8(a0, b0) + sumsq8(a1, b1)); }
    }
    __device__ __forceinline__ void stats(int r, int pn, float s1, float s2) const { if (pn >= 4 && !MK_DRY(*this)) { stat_add(lns + r, s1); stat_add(lnq + r, s2); } }
    MK_EPI_CALL_DENSE()
};
struct EpiRes {
    static constexpr bool PERM = true, AFTER_DRAIN = false;
    bf16* HB; long long* ssq_out; MK_DRYFIELD
    __device__ __forceinline__ void rgs(int r, int pn, int wc, int fq, f32x4 a0, f32x4 b0, f32x4 a1, f32x4 b1, float& s1, float& s2) const {
        const size_t o = (size_t)r * 1024 + pn * 256 + wc * 32 + 8 * fq; bf16* hp = HB + o;
        if (MK_DRY(*this) == 2) { a0 *= 0.f; b0 *= 0.f; a1 *= 0.f; b1 *= 0.f; }
        const u32x4 h0 = *(const u32x4*)hp, h1 = *(const u32x4*)(hp + 128);
        a0 += (f32x4){bflo(h0.x), bfhi(h0.x), bflo(h0.y), bfhi(h0.y)}; b0 += (f32x4){bflo(h0.z), bfhi(h0.z), bflo(h0.w), bfhi(h0.w)};
        a1 += (f32x4){bflo(h1.x), bfhi(h1.x), bflo(h1.y), bfhi(h1.y)}; b1 += (f32x4){bflo(h1.z), bfhi(h1.z), bflo(h1.w), bfhi(h1.w)};
        s1 = quad_red(sumsq8(a0, b0) + sumsq8(a1, b1)); s2 = 0.f;
        if (MK_DRY(*this) == 1) { if (s1 == 12345.678f) *(u32x4*)hp = pack8(a0, b0); return; }
        *(u32x4*)hp = pack8(a0, b0); *(u32x4*)(hp + 128) = pack8(a1, b1);
    }
    __device__ __forceinline__ void stats(int r, int pn, float s1, float s2) const { if (!MK_DRY(*this)) stat_add(ssq_out + r, s1); }
    MK_EPI_CALL_DENSE()
};
struct EpiF1 {
    static constexpr bool PERM = true, AFTER_DRAIN = false;
    bf16* ACT; const long long* ssq;
    __device__ __forceinline__ void rg(int r, int pn, int wc, int fq, f32x4 a0, f32x4 b0, f32x4 a1, f32x4 b1) const {
        const float rs = rsqrtf(stat_get(ssq + r) * (1.0f / 1024.0f) + RMS_EPS); f32x4 a, b;
#pragma unroll
        for (int e = 0; e < 4; ++e) { a[e] = silu_f(a0[e] * rs) * (a1[e] * rs); b[e] = silu_f(b0[e] * rs) * (b1[e] * rs); }
        *(u32x4*)(ACT + (size_t)r * DFF + pn * 128 + wc * 32 + 8 * fq) = pack8(a, b);
    }
    MK_EPI_CALL()
};
struct EpiB1 {
    static constexpr bool PERM = true, AFTER_DRAIN = false;
    float* RAW; bf16* CQB; const long long* ssq; long long* ssq_kv; long long* ssq_q; MK_DRYFIELD
    __device__ __forceinline__ void half(int r, int c, f32x4 a, f32x4 b, float& qkv, float& qq) const {
        if (c < 256) { *(f32x4*)(RAW + (size_t)r * 768 + c) = a; *(f32x4*)(RAW + (size_t)r * 768 + c + 4) = b; qkv += sumsq8(a, b); }
        else if (c < 640) { *(u32x4*)(CQB + (size_t)r * 384 + (c - 256)) = pack8(a, b); qq += sumsq8(a, b); }
        else if (c < 704) { *(f32x4*)(RAW + (size_t)r * 768 + c) = a; *(f32x4*)(RAW + (size_t)r * 768 + c + 4) = b; } }
    __device__ __forceinline__ void rgs(int r, int pn, int wc, int fq, f32x4 a0, f32x4 b0, f32x4 a1, f32x4 b1, float& s1, float& s2) const {
        const float rs = rsqrtf(stat_get(ssq + r) * (1.0f / 1024.0f) + RMS_EPS); const int c = pn * 256 + wc * 32 + 8 * fq; float qkv = 0.f, qq = 0.f;
        half(r, c, a0 * rs, b0 * rs, qkv, qq); half(r, c + 128, a1 * rs, b1 * rs, qkv, qq);
        s1 = quad_red(qkv); s2 = quad_red(qq);
    }
    __device__ __forceinline__ void stats(int r, int pn, float s1, float s2) const { if (!MK_DRY(*this)) { if (pn == 0) stat_add(ssq_kv + r, s1); else stat_add(ssq_q + r, s2); } }
    MK_EPI_CALL_DENSE()
};
struct EpiB2 {
    static constexpr bool PERM = true, AFTER_DRAIN = false;
    bf16* QF; const long long* ssq_q; const f32x2* rope;
    __device__ __forceinline__ void half(int r, int c, int tp, const f32x4 a, const f32x4 b) const {
        const int h = c / 320, w = c - h * 320;
        if (w < 256) *(u32x4*)(QF + (size_t)r * 2560 + c) = pack8(a, b);
        else { const int i0 = (w - 256) >> 1;
            const f32x4 cs01 = *(const f32x4*)(rope + (size_t)tp * 32 + i0), cs23 = *(const f32x4*)(rope + (size_t)tp * 32 + i0 + 2);
            bf16* qh = QF + (size_t)r * 2560 + h * 320 + 256;
            *(u32x2*)(qh + i0) = (u32x2){cvt_pk_bf16(a[0] * cs01[0] - a[1] * cs01[1], a[2] * cs01[2] - a[3] * cs01[3]), cvt_pk_bf16(b[0] * cs23[0] - b[1] * cs23[1], b[2] * cs23[2] - b[3] * cs23[3])};
            *(u32x2*)(qh + 32 + i0) = (u32x2){cvt_pk_bf16(a[0] * cs01[1] + a[1] * cs01[0], a[2] * cs01[3] + a[3] * cs01[2]), cvt_pk_bf16(b[0] * cs23[1] + b[1] * cs23[0], b[2] * cs23[3] + b[3] * cs23[2])}; } }
    __device__ __forceinline__ void rg(int r, int pn, int wc, int fq, f32x4 a0, f32x4 b0, f32x4 a1, f32x4 b1) const {
        const float rs = rsqrtf(stat_get(ssq_q + r) * (1.0f / 384.0f) + RMS_EPS) * MLA_SCALE; const int tp = r < MP ? (r & 2047) : 2048 + ((r - MP) & 3), c = pn * 256 + wc * 32 + 8 * fq;
        half(r, c, tp, a0 * rs, b0 * rs); half(r, c + 128, tp, a1 * rs, b1 * rs);
    }
    MK_EPI_CALL()
};
struct EpiC1 {
    static constexpr bool PERM = true, AFTER_DRAIN = false;
    bf16* GATE; float* XW; const long long* ssq;
    __device__ __forceinline__ void rg(int r, int pn, int wc, int fq, f32x4 a0, f32x4 b0, f32x4 a1, f32x4 b1) const {
        const bool isx = pn >= 5; const int c = (isx ? pn - 5 : pn) * 256 + wc * 32 + 8 * fq; const float rs = rsqrtf(stat_get(ssq + r) * (1.0f / 1024.0f) + RMS_EPS);
        a0 *= rs; b0 *= rs; a1 *= rs; b1 *= rs;
        if (isx) { float* x = XW + (size_t)r * 1280 + c; *(f32x4*)x = a0; *(f32x4*)(x + 4) = b0; *(f32x4*)(x + 128) = a1; *(f32x4*)(x + 132) = b1; }
        else {
#pragma unroll
            for (int e = 0; e < 4; ++e) { a0[e] = gelu_tanh_f(a0[e]); b0[e] = gelu_tanh_f(b0[e]); a1[e] = gelu_tanh_f(a1[e]); b1[e] = gelu_tanh_f(b1[e]); }
            bf16* g = GATE + (size_t)r * 1280 + c; *(u32x4*)g = pack8(a0, b0); *(u32x4*)(g + 128) = pack8(a1, b1); }
    }
    MK_EPI_CALL()
};

template <class Epi>
__device__ __forceinline__ void mini_gemm(const P& p, const bf16* A, int lda, const bf16* Bt, int ldb, int K, int N, const Epi& E, int first_wg) {
    constexpr int BP = 272, SLOT = 64 * BP;
    const int tid = p.tid, lane = p.lane, w = p.wave, kq = w & 3, rgp = w >> 2, l15 = lane & 15, g4 = lane >> 4, nmu = (N >> 8) * 16, nch = K >> 7, nst = (nch + 3) >> 2;
    const int t128 = (rgp << 6) | lane;
    for (int mu = (p.bid - first_wg + p.G) % p.G; mu < nmu; mu += p.G) {
        const int pn = mu >> 4, wcq = (mu >> 2) & 3, rq = mu & 3, row = MP + 32 * rq + 16 * rgp + l15;
        const bf16* arow = A + (size_t)row * lda + 8 * g4;
        const int r0 = t128 >> 4, c16 = t128 & 15;
        const bf16* bbase = Bt + (size_t)(pn * 256 + wcq * 32 + 8 * (r0 >> 2) + (r0 & 3)) * ldb + c16 * 8; const int bo0 = r0 * BP + c16 * 16;
#define MG_BSRC(q) (bbase + (size_t)(128 * ((q) >> 2) + 4 * (((q) >> 1) & 1) + 16 * ((q) & 1)) * ldb)
#define MG_BOFF(q) (bo0 + 8 * (q) * BP)
        f32x4 acc[4];
#pragma unroll
        for (int t = 0; t < 4; ++t) acc[t] = (f32x4){0.f, 0.f, 0.f, 0.f};
        u32x4 b0[8], a0[4], b1[8], a1[4], b2[8], a2[4];
#define MG_LOAD(BS, AS, ST) do { const int ch_ = 4 * (ST) + kq; if (ch_ < nch) { \
            _Pragma("unroll") for (int q = 0; q < 8; ++q) BS[q] = *(const u32x4*)(MG_BSRC(q) + (size_t)ch_ * 128); \
            _Pragma("unroll") for (int s = 0; s < 4; ++s) AS[s] = *(const u32x4*)(arow + (size_t)ch_ * 128 + 32 * s); } } while (0)
#define MG_STEP(BS, AS, ST) do { LAS unsigned char* slot = p.lds + (kq * 2 + ((ST) & 1)) * SLOT; const bool ok_ = 4 * (ST) + kq < nch; \
            if (ok_) { _Pragma("unroll") for (int q = 0; q < 8; ++q) *(LAS u32x4*)(slot + MG_BOFF(q)) = BS[q]; } \
            bf16x8 af[4]; _Pragma("unroll") for (int s = 0; s < 4; ++s) af[s] = __builtin_bit_cast(bf16x8, AS[s]); \
            __syncthreads(); \
            if ((ST) + 3 < nst) MG_LOAD(BS, AS, (ST) + 3); \
            if (ok_) { _Pragma("unroll") for (int s = 0; s < 4; ++s) _Pragma("unroll") for (int t = 0; t < 4; ++t) { \
                const bf16x8 bf = *(const LAS bf16x8*)(slot + (t * 16 + l15) * BP + (32 * s + 8 * g4) * 2); \
                acc[t] = __builtin_amdgcn_mfma_f32_16x16x32_bf16(bf, af[s], acc[t], 0, 0, 0); } } } while (0)
        MG_LOAD(b0, a0, 0); if (1 < nst) MG_LOAD(b1, a1, 1); if (2 < nst) MG_LOAD(b2, a2, 2);
        __syncthreads();
        for (int st = 0; st < nst; st += 3) {
            MG_STEP(b0, a0, st);
            if (st + 1 < nst) MG_STEP(b1, a1, st + 1);
            if (st + 2 < nst) MG_STEP(b2, a2, st + 2);
        }
#undef MG_LOAD
#undef MG_STEP
#undef MG_BSRC
#undef MG_BOFF
        __syncthreads();
        LAS f32x4* red = (LAS f32x4*)p.lds;
        if (kq > 0) {
#pragma unroll
            for (int t = 0; t < 4; ++t) red[((rgp * 3 + (kq - 1)) * 4 + t) * 64 + lane] = acc[t]; }
        __syncthreads();
        if (kq == 0) {
#pragma unroll
            for (int k2 = 0; k2 < 3; ++k2)
#pragma unroll
                for (int t = 0; t < 4; ++t) acc[t] += red[((rgp * 3 + k2) * 4 + t) * 64 + lane];
            E.rg(row, pn, wcq, g4, acc[0], acc[1], acc[2], acc[3]); }
    }
}
}
namespace mk {
__device__ __forceinline__ s16x4 tr16(const LAS unsigned char* a) { return __builtin_amdgcn_ds_read_tr16_b64_v4i16((LAS s16x4*)a); }
__device__ __forceinline__ bf16x8 cat8(const s16x4 a, const s16x4 b) { return (bf16x8){a[0], a[1], a[2], a[3], b[0], b[1], b[2], b[3]}; }
__device__ __forceinline__ bf16x8 as_bf16x8(const u32x4 w) { return __builtin_bit_cast(bf16x8, w); }
#define MFMA16(A, B, C) __builtin_amdgcn_mfma_f32_16x16x32_bf16((A), (B), (C), 0, 0, 0)
constexpr int TP = 272;
constexpr int KP = 656;
constexpr float LOG2E = 1.4426950408889634f;

__device__ __forceinline__ void a2_spatial(const P& p, int j, float* out_cv  ) {
    const bf16* U = p.w<bf16>(WS_U); const bf16* GV = p.w<bf16>(WS_GV); bf16* UM = p.w<bf16>(WS_UM);
    const long long* lns = p.stat(ST_LNS0 + 2 * j); const long long* lnq = p.stat(ST_LNQ0 + 2 * j);
    const float* ln_g = p.in[10] + j * 1024; const float* ln_b = p.in[11] + j * 1024; const float* b_s = p.in[13] + j * 1024;
    LAS unsigned char* Wt = p.lds; LAS unsigned char* Vt = p.lds + 128 * TP;
    const int tid = p.tid, lane = p.lane, w = p.wave, l15 = lane & 15, g4 = lane >> 4, q4 = (lane & 15) >> 2, pp = lane & 3;
    for (int u = p.bid; u < 129 * 8; u += p.G) {
        const int c = u >> 3, g = u & 7, row0 = c * 128; const bool smp = (c == 128);
        const bf16* Wsrc = p.w<bf16>(WS_WS + (smp ? 524288 : 0) + (size_t)j * 262144) + (size_t)g * 16384;
#pragma unroll
        for (int q = 0; q < 4; ++q) { const int ch = tid + 512 * q, row = ch >> 4, c16 = ch & 15;
            *(LAS u32x4*)(Wt + row * TP + c16 * 16) = *(const u32x4*)(Wsrc + row * 128 + c16 * 8); }
        { const int c16 = tid & 15, d0 = g * 128 + c16 * 8;
          const f32x4 g0 = *(const f32x4*)(ln_g + d0), g1 = *(const f32x4*)(ln_g + d0 + 4), b0 = *(const f32x4*)(ln_b + d0), b1 = *(const f32x4*)(ln_b + d0 + 4);
          u32x4 raw[4]; float mean[4], rstd[4];
#pragma unroll
          for (int q = 0; q < 4; ++q) { const int r = row0 + (tid >> 4) + 32 * q; raw[q] = *(const u32x4*)(GV + (size_t)r * 1024 + d0);
              const float mu = stat_get(lns + r) * (1.0f / 1024.0f), var = stat_get(lnq + r) * (1.0f / 1024.0f) - mu * mu; mean[q] = mu; rstd[q] = rsqrtf(var + LN_EPS); }
#pragma unroll
          for (int q = 0; q < 4; ++q) { const int s = (tid >> 4) + 32 * q, r = row0 + s;
            f32x4 v0, v1;
            v0[0] = bflo(raw[q].x); v0[1] = bfhi(raw[q].x); v0[2] = bflo(raw[q].y); v0[3] = bfhi(raw[q].y); v1[0] = bflo(raw[q].z); v1[1] = bfhi(raw[q].z); v1[2] = bflo(raw[q].w); v1[3] = bfhi(raw[q].w);
            v0 = (v0 - mean[q]) * rstd[q] * g0 + b0; v1 = (v1 - mean[q]) * rstd[q] * g1 + b1;
            if (smp && out_cv) { float* o = out_cv + (size_t)(r - MP) * 1024 + d0; *(f32x4*)o = v0; *(f32x4*)(o + 4) = v1; }
            *(LAS u32x4*)(Vt + s * TP + c16 * 16) = pack8(v0, v1); } }
        u32x2 uu[8];
#pragma unroll
        for (int tt = 0; tt < 8; ++tt) uu[tt] = *(const u32x2*)(U + (size_t)(row0 + 16 * tt + l15) * 1024 + g * 128 + 16 * w + 4 * g4);
        __syncthreads();
        f32x4 acc[8];
#pragma unroll
        for (int tt = 0; tt < 8; ++tt) acc[tt] = (f32x4){0.f, 0.f, 0.f, 0.f};
#pragma unroll
        for (int kk = 0; kk < 4; ++kk) {
            const bf16x8 X = cat8(tr16(Vt + (32 * kk + 8 * g4 + q4) * TP + (16 * w + 4 * pp) * 2), tr16(Vt + (32 * kk + 8 * g4 + 4 + q4) * TP + (16 * w + 4 * pp) * 2));
#pragma unroll
            for (int tt = 0; tt < 8; ++tt) if (32 * kk <= 16 * tt + 15) {
                const bf16x8 Y = *(const LAS bf16x8*)(Wt + (16 * tt + l15) * TP + (32 * kk + 8 * g4) * 2);
                acc[tt] = MFMA16(X, Y, acc[tt]); }
        }
#pragma unroll
        for (int tt = 0; tt < 8; ++tt) { const int t = 16 * tt + l15, r = row0 + t, col = g * 128 + 16 * w + 4 * g4;
            const float bias = b_s[g * 128 + (smp ? (t & 3) : t)];
            const float o0 = bflo(uu[tt].x) * (acc[tt][0] + bias), o1 = bfhi(uu[tt].x) * (acc[tt][1] + bias), o2 = bflo(uu[tt].y) * (acc[tt][2] + bias), o3 = bfhi(uu[tt].y) * (acc[tt][3] + bias);
            *(u32x2*)(UM + (size_t)r * 1024 + col) = (u32x2){cvt_pk_bf16(o0, o1), cvt_pk_bf16(o2, o3)}; }
        __syncthreads();
    }
}

__device__ __forceinline__ void b2_kvfinal(const P& p, float* out_mp, float* out_ms) {
    const float* RAW = p.w<float>(WS_RAW); bf16* KVB = p.w<bf16>(WS_KVB); const long long* ssq_kv = p.stat(ST_KV); const float* kvn = p.in[19]; const f32x2* rope = p.w<f32x2>(WS_ROPE);
    const int gw = p.bid * NWAVES + p.wave, NGW = p.G * NWAVES, lane = p.lane;
    for (int m = gw; m < MT; m += NGW) {
        float* o = m < MP ? (out_mp ? out_mp + (size_t)m * 320 : nullptr) : (out_ms ? out_ms + (size_t)(m - MP) * 320 : nullptr);
        const float rs = rsqrtf(stat_get(ssq_kv + m) * (1.0f / 256.0f) + RMS_EPS);
        const f32x4 v = *(const f32x4*)(RAW + (size_t)m * 768 + 4 * lane) * rs * *(const f32x4*)(kvn + 4 * lane);
        if (o) *(f32x4*)(o + 4 * lane) = v;
        *(u32x2*)(KVB + (size_t)m * 320 + 4 * lane) = (u32x2){cvt_pk_bf16(v[0], v[1]), cvt_pk_bf16(v[2], v[3])};
        if (lane < 32) { const int tp = m < MP ? (m & 2047) : 2048 + ((m - MP) & 3); const f32x2 cs = rope[(size_t)tp * 32 + lane];
            const float x1 = RAW[(size_t)m * 768 + 640 + lane], x2 = RAW[(size_t)m * 768 + 672 + lane];
            const float o1 = x1 * cs.x - x2 * cs.y, o2 = x1 * cs.y + x2 * cs.x;
            if (o) { o[256 + lane] = o1; o[288 + lane] = o2; }
            KVB[(size_t)m * 320 + 256 + lane] = (bf16)f2bf(o1); KVB[(size_t)m * 320 + 288 + lane] = (bf16)f2bf(o2); }
    }
}

__device__ __forceinline__ void b3_attn_prompt(const P& p) {
    const bf16* QF = p.w<bf16>(WS_QF); const bf16* KVB = p.w<bf16>(WS_KVB); bf16* OB = p.w<bf16>(WS_OB);
    const int lane = p.lane, h = p.wave, l15 = lane & 15, g4 = lane >> 4, q4 = (lane & 15) >> 2, pp = lane & 3;
    constexpr int TILE_B = 64 * 640;
    int soff[5];
#pragma unroll
    for (int i = 0; i < 5; ++i) { const int P_ = (h + 8 * i) * 64 + lane, row = P_ / 40, cph = P_ - 40 * row; soff[i] = row * 320 + ((cph ^ (row & 6)) << 3); }
    int kaddr[10];
#pragma unroll
    for (int s_ = 0; s_ < 10; ++s_) kaddr[s_] = l15 * 640 + (((4 * s_ + g4) ^ (l15 & 6)) << 4);
    int taddr[4];
    { const int rl = 4 * g4 + q4, m_ = (rl & 6) >> 1;
#pragma unroll
      for (int v3 = 0; v3 < 4; ++v3) taddr[v3] = rl * 640 + (((v3 ^ m_) << 1 | (pp >> 1)) << 4) + 8 * (pp & 1); }
#define AT_DMA(BUF, SRC) do { _Pragma("unroll") for (int i = 0; i < 5; ++i) \
        __builtin_amdgcn_global_load_lds((const unsigned*)((SRC) + soff[i]), (LAS unsigned*)((BUF) + (h + 8 * i) * 1024), 16, 0, 0); } while (0)
    for (int pi = p.bid; pi < 512; pi += p.G) {
        const int b = (p.G % 8 == 0) ? (pi & 7) : (pi >> 6), x = (p.G % 8 == 0) ? ((pi >> 3) & 63) : (pi & 63);
        for (int half = 0; half < 2; ++half) {
            const int qt = half ? 127 - x : x, t0 = 16 * qt, nkt = (t0 + 15) / 64 + 1;
            const size_t rowq = (size_t)b * 2048 + t0 + l15; const bf16* kvb = KVB + (size_t)b * 2048 * 320;
            AT_DMA(p.lds, kvb);
            bf16x8 Q[10];
#pragma unroll
            for (int s = 0; s < 10; ++s) Q[s] = as_bf16x8(*(const u32x4*)(QF + rowq * 2560 + h * 320 + 32 * s + 8 * g4));
            f32x4 O[16];
#pragma unroll
            for (int vt = 0; vt < 16; ++vt) O[vt] = (f32x4){0.f, 0.f, 0.f, 0.f};
            float mrun = -1e30f, lrun = 0.f;
            asm volatile("s_waitcnt vmcnt(0)" ::: "memory"); __syncthreads();
            for (int kt = 0; kt < nkt; ++kt) {
                LAS unsigned char* buf = p.lds + (kt & 1) * TILE_B;
                if (kt + 1 < nkt) AT_DMA(p.lds + ((kt + 1) & 1) * TILE_B, kvb + (size_t)64 * (kt + 1) * 320);
                f32x4 S[4];
#pragma unroll
                for (int k4 = 0; k4 < 4; ++k4) S[k4] = (f32x4){0.f, 0.f, 0.f, 0.f};
                { bf16x8 Kc[4], Kn[4];
#pragma unroll
                  for (int k4 = 0; k4 < 4; ++k4) Kc[k4] = *(const LAS bf16x8*)(buf + kaddr[0] + k4 * 10240);
#pragma unroll
                  for (int s = 0; s < 10; ++s) {
                      if (s < 9) {
#pragma unroll
                          for (int k4 = 0; k4 < 4; ++k4) Kn[k4] = *(const LAS bf16x8*)(buf + kaddr[s + 1] + k4 * 10240); }
#pragma unroll
                      for (int k4 = 0; k4 < 4; ++k4) S[k4] = MFMA16(Kc[k4], Q[s], S[k4]);
#pragma unroll
                      for (int k4 = 0; k4 < 4; ++k4) Kc[k4] = Kn[k4]; } }
                float mx = -1e30f;
#pragma unroll
                for (int k4 = 0; k4 < 4; ++k4)
#pragma unroll
                    for (int e = 0; e < 4; ++e) { float v = S[k4][e] * LOG2E; if (kt == nkt - 1 && 64 * kt + 16 * k4 + 4 * g4 + e > t0 + l15) v = -1e30f; S[k4][e] = v; mx = fmaxf(mx, v); }
                mx = fmaxf(mx, __shfl_xor(mx, 16)); mx = fmaxf(mx, __shfl_xor(mx, 32));
                const float mnew = fmaxf(mrun, mx), alpha = __builtin_amdgcn_exp2f(mrun - mnew); mrun = mnew;
                float ps = 0.f;
#pragma unroll
                for (int k4 = 0; k4 < 4; ++k4)
#pragma unroll
                    for (int e = 0; e < 4; ++e) { const float pv = __builtin_amdgcn_exp2f(S[k4][e] - mnew); S[k4][e] = pv; ps += pv; }
                lrun = lrun * alpha + ps;
#pragma unroll
                for (int vt = 0; vt < 16; ++vt) O[vt] *= alpha;
                bf16x8 Pf[2];
#pragma unroll
                for (int ks = 0; ks < 2; ++ks) Pf[ks] = as_bf16x8((u32x4){cvt_pk_bf16(S[2 * ks][0], S[2 * ks][1]), cvt_pk_bf16(S[2 * ks][2], S[2 * ks][3]), cvt_pk_bf16(S[2 * ks + 1][0], S[2 * ks + 1][1]), cvt_pk_bf16(S[2 * ks + 1][2], S[2 * ks + 1][3])});
#define AT_V(VT, KS, T) tr16(buf + taddr[(VT) & 3] + ((VT) >> 2) * 128 + (32 * (KS) + 16 * (T)) * 640)
                { s16x4 Vc[4], Vn[4];
                  Vc[0] = AT_V(0, 0, 0); Vc[1] = AT_V(0, 0, 1); Vc[2] = AT_V(0, 1, 0); Vc[3] = AT_V(0, 1, 1);
#pragma unroll
                  for (int vt = 0; vt < 16; ++vt) {
                      if (vt < 15) { Vn[0] = AT_V(vt + 1, 0, 0); Vn[1] = AT_V(vt + 1, 0, 1); Vn[2] = AT_V(vt + 1, 1, 0); Vn[3] = AT_V(vt + 1, 1, 1); }
                      O[vt] = MFMA16(cat8(Vc[0], Vc[1]), Pf[0], O[vt]); O[vt] = MFMA16(cat8(Vc[2], Vc[3]), Pf[1], O[vt]);
#pragma unroll
                      for (int i = 0; i < 4; ++i) Vc[i] = Vn[i]; } }
#undef AT_V
                asm volatile("s_waitcnt vmcnt(0)" ::: "memory"); __syncthreads();
            }
            const float linv = 1.0f / quad_red(lrun);
#pragma unroll
            for (int vt = 0; vt < 16; ++vt) { const f32x4 o = O[vt] * linv;
                *(u32x2*)(OB + rowq * 2048 + h * 256 + 16 * vt + 4 * g4) = (u32x2){cvt_pk_bf16(o[0], o[1]), cvt_pk_bf16(o[2], o[3])}; }
        }
    }
#undef AT_DMA
}

__device__ __forceinline__ void b3_attn_sample(const P& p) {
    const bf16* QF = p.w<bf16>(WS_QF); float* PART = p.w<float>(WS_PART); float* PML = p.w<float>(WS_PML);
    const float* cache = p.in[2]; const int* ptab = (const int*)p.in[5];
    const int tid = p.tid, lane = p.lane, w = p.wave, qt = w & 1, dvq = w >> 1, l15 = lane & 15, g4 = lane >> 4, q4 = (lane & 15) >> 2, pp = lane & 3;
    constexpr int TILE_B = 64 * KP;
    for (int u = p.bid; u < 256; u += p.G) {
        const int b = u >> 3, sp = u & 7;
        const int hq = 4 * qt + (l15 >> 2), iq = l15 & 3; const size_t rowq = (size_t)MP + 4 * b + iq;
        bf16x8 Q[10];
#pragma unroll
        for (int s = 0; s < 10; ++s) Q[s] = as_bf16x8(*(const u32x4*)(QF + rowq * 2560 + hq * 320 + 32 * s + 8 * g4));
        f32x4 O[4];
#pragma unroll
        for (int v = 0; v < 4; ++v) O[v] = (f32x4){0.f, 0.f, 0.f, 0.f};
        float mrun = -1e30f, lrun = 0.f;
        f32x4 st[10];
        auto tile_src = [&](int ti) -> const float* { const int pg = 16 * sp + (ti >> 1); return cache + ((size_t)ptab[b * 128 + pg] * 128 + 64 * (ti & 1)) * 320; };
        { const float* src = tile_src(0);
#pragma unroll
          for (int q = 0; q < 10; ++q) st[q] = __builtin_nontemporal_load((const f32x4*)(src + (size_t)(tid + 512 * q) * 4));
          __syncthreads();
#pragma unroll
          for (int q = 0; q < 10; ++q) { const int ch = tid + 512 * q, row = ch / 80, c4 = ch % 80; *(LAS u32x2*)(p.lds + row * KP + c4 * 8) = (u32x2){cvt_pk_bf16(st[q][0], st[q][1]), cvt_pk_bf16(st[q][2], st[q][3])}; }
          __syncthreads(); }
        for (int ti = 0; ti < 32; ++ti) {
            LAS unsigned char* buf = p.lds + (ti & 1) * TILE_B;
            if (ti + 1 < 32) { const float* src = tile_src(ti + 1);
#pragma unroll
                for (int q = 0; q < 10; ++q) st[q] = __builtin_nontemporal_load((const f32x4*)(src + (size_t)(tid + 512 * q) * 4)); }
            f32x4 S[4];
#pragma unroll
            for (int k4 = 0; k4 < 4; ++k4) { S[k4] = (f32x4){0.f, 0.f, 0.f, 0.f};
#pragma unroll
                for (int s = 0; s < 10; ++s) { const bf16x8 Kf = *(const LAS bf16x8*)(buf + (16 * k4 + l15) * KP + (32 * s + 8 * g4) * 2); S[k4] = MFMA16(Kf, Q[s], S[k4]); } }
            float mx = -1e30f;
#pragma unroll
            for (int k4 = 0; k4 < 4; ++k4)
#pragma unroll
                for (int e = 0; e < 4; ++e) { const float v = S[k4][e] * LOG2E; S[k4][e] = v; mx = fmaxf(mx, v); }
            mx = fmaxf(mx, __shfl_xor(mx, 16)); mx = fmaxf(mx, __shfl_xor(mx, 32));
            const float mnew = fmaxf(mrun, mx), alpha = __builtin_amdgcn_exp2f(mrun - mnew); mrun = mnew;
            float ps = 0.f;
#pragma unroll
            for (int k4 = 0; k4 < 4; ++k4)
#pragma unroll
                for (int e = 0; e < 4; ++e) { const float pv = __builtin_amdgcn_exp2f(S[k4][e] - mnew); S[k4][e] = pv; ps += pv; }
            lrun = lrun * alpha + ps;
#pragma unroll
            for (int v = 0; v < 4; ++v) O[v] *= alpha;
            bf16x8 Pf[2];
#pragma unroll
            for (int ks = 0; ks < 2; ++ks) Pf[ks] = as_bf16x8((u32x4){cvt_pk_bf16(S[2 * ks][0], S[2 * ks][1]), cvt_pk_bf16(S[2 * ks][2], S[2 * ks][3]), cvt_pk_bf16(S[2 * ks + 1][0], S[2 * ks + 1][1]), cvt_pk_bf16(S[2 * ks + 1][2], S[2 * ks + 1][3])});
#pragma unroll
            for (int v = 0; v < 4; ++v) { const int vt = 4 * dvq + v;
#pragma unroll
                for (int ks = 0; ks < 2; ++ks) {
                    const bf16x8 Vf = cat8(tr16(buf + (32 * ks + 4 * g4 + q4) * KP + (16 * vt + 4 * pp) * 2), tr16(buf + (32 * ks + 16 + 4 * g4 + q4) * KP + (16 * vt + 4 * pp) * 2));
                    O[v] = MFMA16(Vf, Pf[ks], O[v]); } }
            if (ti + 1 < 32) { LAS unsigned char* nb = p.lds + ((ti + 1) & 1) * TILE_B;
#pragma unroll
                for (int q = 0; q < 10; ++q) { const int ch = tid + 512 * q, row = ch / 80, c4 = ch % 80; *(LAS u32x2*)(nb + row * KP + c4 * 8) = (u32x2){cvt_pk_bf16(st[q][0], st[q][1]), cvt_pk_bf16(st[q][2], st[q][3])}; } }
            __syncthreads();
        }
        const float lsum = quad_red(lrun); const int qrow = 16 * qt + l15; const size_t pb = ((size_t)(b * 8 + sp) * 32 + qrow);
#pragma unroll
        for (int v = 0; v < 4; ++v) *(f32x4*)(PART + pb * 256 + 16 * (4 * dvq + v) + 4 * g4) = O[v];
        if (dvq == 0 && g4 == 0) { PML[pb * 2] = mrun; PML[pb * 2 + 1] = lsum; }
    }
}
__device__ __forceinline__ void b3_combine(const P& p) {
    const bf16* QF = p.w<bf16>(WS_QF); const bf16* KVB = p.w<bf16>(WS_KVB); bf16* OB = p.w<bf16>(WS_OB); const float* PART = p.w<float>(WS_PART); const float* PML = p.w<float>(WS_PML);
    const int dv = p.tid & 255, sub = p.tid >> 8;
    for (int it = 2 * p.bid + sub; it < 1024; it += 2 * p.G) {
        const int b = it >> 5, i = (it >> 3) & 3, h = it & 7, qt = h >> 2, ql = ((h & 3) << 2) | i, qrow = 16 * qt + ql; const size_t row = (size_t)MP + 4 * b + i;
        float sn[4];
#pragma unroll
        for (int kk = 0; kk < 4; ++kk) { float s = 0.f;
            if (kk <= i) { const unsigned* qp = (const unsigned*)(QF + row * 2560 + h * 320); const unsigned* kp = (const unsigned*)(KVB + ((size_t)MP + 4 * b + kk) * 320);
                for (int d = 0; d < 160; ++d) { const unsigned a = qp[d], c = kp[d]; s += bflo(a) * bflo(c) + bfhi(a) * bfhi(c); } }
            sn[kk] = (kk <= i) ? s * LOG2E : -1e30f; }
        float M = fmaxf(fmaxf(sn[0], sn[1]), fmaxf(sn[2], sn[3])); float ms[8], ls[8];
#pragma unroll
        for (int sp = 0; sp < 8; ++sp) { const size_t pb = ((size_t)(b * 8 + sp) * 32 + qrow); ms[sp] = PML[pb * 2]; ls[sp] = PML[pb * 2 + 1]; M = fmaxf(M, ms[sp]); }
        float L = 0.f, Oa = 0.f;
#pragma unroll
        for (int sp = 0; sp < 8; ++sp) { const size_t pb = ((size_t)(b * 8 + sp) * 32 + qrow); const float wgt = __builtin_amdgcn_exp2f(ms[sp] - M); L += ls[sp] * wgt; Oa += PART[pb * 256 + dv] * wgt; }
#pragma unroll
        for (int kk = 0; kk < 4; ++kk) { const float pk = __builtin_amdgcn_exp2f(sn[kk] - M); L += pk; Oa += pk * bf2f(KVB[((size_t)MP + 4 * b + kk) * 320 + dv]); }
        OB[row * 2048 + h * 256 + dv] = (bf16)f2bf(Oa / L);
    }
}

template <bool SMP>
__device__ __forceinline__ f32x4 conv4(const float* XW, const float* cbuf  , const float* cw, const float* cb, int m, int c) {
    f32x4 acc = *(const f32x4*)(cb + c);
    f32x4 v[4], wv[4];
#pragma unroll
    for (int k = 0; k < 4; ++k) { wv[k] = *(const f32x4*)(cw + k * 1280 + c);
        if (!SMP) { const int t = m & 2047, r = t + k - 3; v[k] = *(const f32x4*)(XW + (size_t)(m + (r >= 0 ? k - 3 : -t)) * 1280 + c); if (r < 0) wv[k] = (f32x4){0.f, 0.f, 0.f, 0.f}; }
        else { const int b = (m - MP) >> 2, t = (m - MP) & 3, r = t + k - 3; const float* ptr = (r >= 0) ? XW + (size_t)(m + k - 3) * 1280 + c : cbuf + ((size_t)b * 3 + (3 + r)) * 1280 + c; v[k] = *(const f32x4*)ptr; } }
#pragma unroll
    for (int k = 0; k < 4; ++k) acc += wv[k] * v[k];
    return acc;
}
__device__ __forceinline__ void c2_rglru(const P& p, int j, float* out_cp, float* out_cs, float* out_hs, const int mask) {
    const float* XW = p.w<float>(WS_XW); bf16* LH = p.w<bf16>(WS_AA); bf16* CPB = p.w<bf16>(WS_BB); float* AGG = p.w<float>(WS_AGG);
    const float* cbuf = p.in[4] + (size_t)j * 32 * 3 * 1280; const float* cw = p.in[25] + (size_t)j * 4 * 1280; const float* cb = p.in[26] + j * 1280;
    const float* b_a = p.in[28] + j * 1280; const float* b_i = p.in[30] + j * 1280; const float* lam = p.in[31] + j * 1280; const float* h0s = p.in[3] + (size_t)j * 32 * 1280;
    const bf16* WaT = p.w<bf16>(WS_WAT); const bf16* WiT = p.w<bf16>(WS_WIT);
    LAS unsigned char* Xt = p.lds; LAS unsigned char* At = p.lds + 128 * TP; LAS unsigned char* It = p.lds + 256 * TP;
    LAS float* LA = (LAS float*)p.lds;
    LAS unsigned char* LB = p.lds + 128 * 528;
    LAS float* QT = (LAS float*)(p.lds + 128 * 528 + 128 * TP);
    const int tid = p.tid, lane = p.lane, w = p.wave, l15 = lane & 15, g4 = lane >> 4;
    { const int gt = p.bid * 512 + tid, NGT = p.G * 512;
      for (int i = gt; i < (8 + 32) * 3 * 320; i += NGT) { const int c = (i % 320) * 4, rr = i / 320, jj = rr % 3, bb = rr / 3;
          if (bb < 8) { if (out_cp) *(f32x4*)(out_cp + ((size_t)bb * 3 + jj) * 1280 + c) = *(const f32x4*)(XW + ((size_t)bb * 2048 + 2045 + jj) * 1280 + c); }
          else { const int b = bb - 8; if (out_cs) *(f32x4*)(out_cs + ((size_t)b * 3 + jj) * 1280 + c) = *(const f32x4*)(XW + ((size_t)MP + 4 * b + 1 + jj) * 1280 + c); } } }
    for (int u = p.bid; u < 129 * 10; u += p.G) {
        const int T = u / 10, n = u % 10, row0 = T * 128;
        if (mask & 4096) {
            const int c16 = tid & 15, cch = n * 128 + c16 * 8;
            f32x4 wv[4][2], bv[2];
#pragma unroll
            for (int k = 0; k < 4; ++k) { wv[k][0] = *(const f32x4*)(cw + k * 1280 + cch); wv[k][1] = *(const f32x4*)(cw + k * 1280 + cch + 4); }
            bv[0] = *(const f32x4*)(cb + cch); bv[1] = *(const f32x4*)(cb + cch + 4);
            u32x4 wa[4], wi[4];
#pragma unroll
            for (int q = 0; q < 4; ++q) { const int row = (tid >> 4) + 32 * q; wa[q] = *(const u32x4*)(WaT + (size_t)n * 16384 + row * 128 + c16 * 8); wi[q] = *(const u32x4*)(WiT + (size_t)n * 16384 + row * 128 + c16 * 8); }
#pragma unroll
            for (int qh = 0; qh < 2; ++qh) {
                f32x4 xv[2][4][2];
#pragma unroll
                for (int qq = 0; qq < 2; ++qq) { const int m = row0 + (tid >> 4) + 32 * (2 * qh + qq);
#pragma unroll
                    for (int k = 0; k < 4; ++k) { const float* ptr;
                        if (T < 128) { const int t = m & 2047, r = t + k - 3; ptr = XW + (size_t)(m + (r >= 0 ? k - 3 : -t)) * 1280 + cch; }
                        else { const int b = (m - MP) >> 2, t = (m - MP) & 3, r = t + k - 3; ptr = (r >= 0) ? XW + (size_t)(m + k - 3) * 1280 + cch : cbuf + ((size_t)b * 3 + (3 + r)) * 1280 + cch; }
                        xv[qq][k][0] = *(const f32x4*)ptr; xv[qq][k][1] = *(const f32x4*)(ptr + 4); } }
#pragma unroll
                for (int qq = 0; qq < 2; ++qq) { const int row = (tid >> 4) + 32 * (2 * qh + qq), m = row0 + row; f32x4 v0 = bv[0], v1 = bv[1];
#pragma unroll
                    for (int k = 0; k < 4; ++k) { const bool live = (T >= 128) || (((m & 2047) + k - 3) >= 0); const f32x4 z = (f32x4){0.f, 0.f, 0.f, 0.f};
                        v0 += (live ? wv[k][0] : z) * xv[qq][k][0]; v1 += (live ? wv[k][1] : z) * xv[qq][k][1]; }
                    *(LAS u32x4*)(Xt + row * TP + c16 * 16) = pack8(v0, v1); } }
#pragma unroll
            for (int q = 0; q < 4; ++q) { const int row = (tid >> 4) + 32 * q; *(LAS u32x4*)(At + row * TP + c16 * 16) = wa[q]; *(LAS u32x4*)(It + row * TP + c16 * 16) = wi[q]; }
        }
        __syncthreads();
        f32x4 ca[8], ci[8];
#pragma unroll
        for (int tt = 0; tt < 8; ++tt) { ca[tt] = (f32x4){0.f, 0.f, 0.f, 0.f}; ci[tt] = (f32x4){0.f, 0.f, 0.f, 0.f}; }
        if (mask & 8192) {
#pragma unroll
        for (int kk = 0; kk < 4; ++kk) {
            const bf16x8 Xa = *(const LAS bf16x8*)(At + (16 * w + l15) * TP + (32 * kk + 8 * g4) * 2), Xi = *(const LAS bf16x8*)(It + (16 * w + l15) * TP + (32 * kk + 8 * g4) * 2);
#pragma unroll
            for (int tt = 0; tt < 8; ++tt) { const bf16x8 Y = *(const LAS bf16x8*)(Xt + (16 * tt + l15) * TP + (32 * kk + 8 * g4) * 2);
                ca[tt] = MFMA16(Xa, Y, ca[tt]); ci[tt] = MFMA16(Xi, Y, ci[tt]); }
        }
        const int chn = n * 128 + 16 * w + 4 * g4;
        { const f32x4 ba = *(const f32x4*)(b_a + chn), bi = *(const f32x4*)(b_i + chn), lm = *(const f32x4*)(lam + chn);
          f32x4 sp;
#pragma unroll
          for (int e = 0; e < 4; ++e) { const float nl = -lm[e]; sp[e] = -8.0f * LOG2E * ((nl > 20.f) ? nl : log1pf(expf(nl))); }
#pragma unroll
          for (int tt = 0; tt < 8; ++tt) { const u32x2 xb = *(const LAS u32x2*)(Xt + (16 * tt + l15) * TP + (16 * w + 4 * g4) * 2);
              const f32x4 xc = (f32x4){bflo(xb.x), bfhi(xb.x), bflo(xb.y), bfhi(xb.y)};
#pragma unroll
              for (int e = 0; e < 4; ++e) { const float r = fast_sigmoid_l2(LOG2E * (ca[tt][e] + ba[e])), gi = fast_sigmoid_l2(LOG2E * (ci[tt][e] + bi[e]));
                  const float a = __builtin_amdgcn_exp2f(r * sp[e]);
                  ca[tt][e] = a; ci[tt][e] = __builtin_amdgcn_sqrtf(fmaxf(__builtin_fmaf(-a, a, 1.0f), 0.f)) * gi * xc[e]; } } }
        }
        __syncthreads();
#pragma unroll
        for (int tt = 0; tt < 8; ++tt) { const int tok = 16 * tt + l15;
            *(LAS f32x4*)(LA + tok * 132 + 16 * w + 4 * g4) = ca[tt];
            *(LAS u32x2*)(LB + tok * TP + (16 * w + 4 * g4) * 2) = (u32x2){cvt_pk_bf16(ci[tt][0], ci[tt][1]), cvt_pk_bf16(ci[tt][2], ci[tt][3])}; }
        __syncthreads();
        const int ch = tid & 127, q = tid >> 7, chg = n * 128 + ch;
        if (mask & 16384) {
        if (T < 128) {
            float P_ = 1.f, H_ = 0.f;
#pragma unroll 8
            for (int t = 32 * q; t < 32 * q + 32; ++t) { const float a = LA[t * 132 + ch], b = bf2f(*(const LAS bf16*)(LB + t * TP + ch * 2)); H_ = a * H_ + b; P_ *= a; }
            QT[(q * 128 + ch) * 2] = P_; QT[(q * 128 + ch) * 2 + 1] = H_;
            __syncthreads();
            float h = 0.f, pc = 1.f;
#pragma unroll
            for (int qq = 0; qq < 3; ++qq) if (qq < q) { const float Pq = QT[(qq * 128 + ch) * 2], Hq = QT[(qq * 128 + ch) * 2 + 1]; h = Pq * h + Hq; pc *= Pq; }
#pragma unroll 8
            for (int t = 32 * q; t < 32 * q + 32; ++t) { const float a = LA[t * 132 + ch], b = bf2f(*(const LAS bf16*)(LB + t * TP + ch * 2)); h = a * h + b; pc *= a;
                LA[t * 132 + ch] = pc; *(LAS bf16*)(LB + t * TP + ch * 2) = (bf16)f2bf(h); }
            if (q == 3) { AGG[((size_t)T * 2) * 1280 + chg] = pc; AGG[((size_t)T * 2 + 1) * 1280 + chg] = h; }
        } else {
            for (int bb = 8 * q; bb < 8 * q + 8; ++bb) { float h = h0s[(size_t)bb * 1280 + chg];
#pragma unroll
                for (int i = 0; i < 4; ++i) { const int t = 4 * bb + i; const float a = LA[t * 132 + ch], b = bf2f(*(const LAS bf16*)(LB + t * TP + ch * 2)); h = a * h + b;
                    LA[t * 132 + ch] = 0.f; *(LAS bf16*)(LB + t * TP + ch * 2) = (bf16)f2bf(h); }
                if (out_hs) out_hs[(size_t)bb * 1280 + chg] = h; }
        }
        }
        __syncthreads();
        if (mask & 32768)
#pragma unroll
        for (int i = 0; i < 4; ++i) { const int cidx = tid + 512 * i, tok = cidx >> 4, c8 = (cidx & 15) * 8; const size_t o = (size_t)(row0 + tok) * 1280 + n * 128 + c8;
            *(u32x4*)(LH + o) = *(const LAS u32x4*)(LB + tok * TP + c8 * 2);
            *(u32x4*)(CPB + o) = pack8(*(const LAS f32x4*)(LA + tok * 132 + c8), *(const LAS f32x4*)(LA + tok * 132 + c8 + 4)); }
        __syncthreads();
    }
}
__device__ __forceinline__ void c5_fixup(const P& p, float* out_hp) {
    const bf16* LH = p.w<bf16>(WS_AA); const bf16* CPB = p.w<bf16>(WS_BB); const float* AGG = p.w<float>(WS_AGG); const bf16* GATE = p.w<bf16>(WS_GATE); bf16* GH = p.w<bf16>(WS_GH);
    LAS float* cr = (LAS float*)p.lds;
    const int tid = p.tid;
    for (int it = p.bid; it < 258; it += p.G) {
        const int T = it >> 1, hf = it & 1, row0 = T * 128 + 64 * hf, T0 = T & ~15;
        for (int ch = tid; ch < 1280; ch += 512) { float c = 0.f;
            if (T < 128) {
#pragma unroll
                for (int d = 0; d < 15; ++d) if (T0 + d < T) c = AGG[((size_t)(T0 + d) * 2) * 1280 + ch] * c + AGG[((size_t)(T0 + d) * 2 + 1) * 1280 + ch];
                if ((T & 15) == 15 && hf == 1 && out_hp) out_hp[(size_t)(T >> 4) * 1280 + ch] = AGG[((size_t)T * 2) * 1280 + ch] * c + AGG[((size_t)T * 2 + 1) * 1280 + ch]; }
            cr[ch] = c; }
        __syncthreads();
#pragma unroll 4
        for (int i = 0; i < 20; ++i) { const int cidx = tid + 512 * i, tok = cidx / 160, c8 = (cidx % 160) * 8; const size_t o = (size_t)(row0 + tok) * 1280 + c8;
            const u32x4 lh = *(const u32x4*)(LH + o), cp = *(const u32x4*)(CPB + o), gt = *(const u32x4*)(GATE + o);
            const f32x4 c0 = *(const LAS f32x4*)(cr + c8), c1 = *(const LAS f32x4*)(cr + c8 + 4);
            f32x4 r0, r1;
            r0[0] = bflo(gt.x) * (bflo(lh.x) + bflo(cp.x) * c0[0]); r0[1] = bfhi(gt.x) * (bfhi(lh.x) + bfhi(cp.x) * c0[1]);
            r0[2] = bflo(gt.y) * (bflo(lh.y) + bflo(cp.y) * c0[2]); r0[3] = bfhi(gt.y) * (bfhi(lh.y) + bfhi(cp.y) * c0[3]);
            r1[0] = bflo(gt.z) * (bflo(lh.z) + bflo(cp.z) * c1[0]); r1[1] = bfhi(gt.z) * (bfhi(lh.z) + bfhi(cp.z) * c1[1]);
            r1[2] = bflo(gt.w) * (bflo(lh.w) + bflo(cp.w) * c1[2]); r1[3] = bfhi(gt.w) * (bfhi(lh.w) + bfhi(cp.w) * c1[3]);
            *(u32x4*)(GH + o) = pack8(r0, r1); }
        __syncthreads();
    }
}
__device__ __forceinline__ void final_norm(const P& p, float* out_yp, float* out_ys) {
    const bf16* HB = p.w<bf16>(WS_HB); const long long* ssq = p.stat(ST_SSQ0 + 8); const float* g = p.in[8];
    const int gw = p.bid * NWAVES + p.wave, NGW = p.G * NWAVES, lane = p.lane;
    for (int m = gw; m < MT; m += NGW) { float* o = m < MP ? out_yp + (size_t)m * 1024 : out_ys + (size_t)(m - MP) * 1024; const float rs = rsqrtf(stat_get(ssq + m) * (1.0f / 1024.0f) + RMS_EPS);
#pragma unroll
        for (int jj = 0; jj < 4; ++jj) { const int c = 4 * lane + 256 * jj; const u32x2 hw = *(const u32x2*)(HB + (size_t)m * 1024 + c);
            *(f32x4*)(o + c) = (f32x4){bflo(hw.x), bfhi(hw.x), bflo(hw.y), bfhi(hw.y)} * rs * *(const f32x4*)(g + c); } }
}
}
namespace mk {
struct Args { const float* in[36]; float* out; unsigned char* ws; int ph_lo, ph_hi, li, mask; };
constexpr int NPHASE = 34;

#define MK_GEMM(EpiT, E, Aptr, LDA, Bptr, LDB, KD, NC) do { pg8::Gemm g_{(const pg8::bf16_t*)(Aptr), (const pg8::bf16_t*)(Bptr), (LDA), (LDB), (KD)}; pg8::StaticOrder S_; S_.init(MP, (NC), p.G, p.bid); \
        pg8::gemm_phase<EpiT, pg8::StaticOrder, true, true>(p.lds, g_, S_, E, p.tid); \
          \
        P q_ = p; { int t2_ = p0.tid; asm volatile("" : "+v"(t2_)); q_.tid = t2_; q_.lane = t2_ & 63; q_.wave = __builtin_amdgcn_readfirstlane(t2_ >> 6); } \
        mini_gemm<EpiT>(q_, (const bf16*)(Aptr), (LDA), (const bf16*)(Bptr), (LDB), (KD), (NC), E, (64 * ((NC) / 256)) % p.G); } while (0)

#ifdef MK_DRYPROBE
#define MK_DRYARG , ((mask >> 10) & 3)
#else
#define MK_DRYARG
#endif
#ifndef MK_REP_SEL
#define MK_REP_SEL(k) 0
#define MK_REP_N 1
#endif
#define REPF(k) for (int rep_ = 0; rep_ < (MK_REP_SEL(k) ? MK_REP_N : 1); ++rep_)
#define IN_(k) (lo <= (k) && (k) < hi)
#define PH_BEGIN() P p = p0; { int z_ = 0, t_ = p0.tid, g_ = p0.G, b_ = p0.bid; unsigned l_ = (unsigned)(size_t)p0.lds; asm volatile("" : "+s"(z_), "+v"(t_), "+s"(g_), "+s"(b_), "+s"(l_)); p.ws = p0.ws + z_; p.out = p0.out + z_; p.tid = t_; p.lane = t_ & 63; p.wave = __builtin_amdgcn_readfirstlane(t_ >> 6); p.G = g_; p.bid = b_; p.lds = (LAS unsigned char*)(size_t)l_; } float* const out = p.out; (void)out
#ifdef MK_PROF
#define STAMP(k) do { if (p0.bid == 0 && p0.tid == 0) ((unsigned long long*)(p0.ws + WS_PROF))[(k)] = (unsigned long long)wall_clock64(); } while (0)
#else
#define STAMP(k) do { } while (0)
#endif
#define ENDPH(k) do { if ((k) + 1 < hi) xcd_barrier(bar); STAMP((k) + 1); } while (0)
template <int LAYER> __device__ __forceinline__ void run_layer(const P& p0, const XcdBarrier& bar, const int lo, const int hi, const int mask) {
        constexpr int layer = LAYER, kind = layer % 3, j = layer / 3, pb = 1 + 8 * layer;
        constexpr size_t resA = kind == 0 ? WS_UM : kind == 1 ? WS_OB : WS_GH, resB = kind == 0 ? WS_WOUT + (size_t)j * 2 * MiB : kind == 1 ? WS_WOV : WS_WCO; constexpr int resK = kind == 0 ? 1024 : kind == 1 ? 2048 : 1280;
        if constexpr (kind == 0) {
            if (IN_(pb)) REPF(pb) { PH_BEGIN(); EpiA1 E{p.w<bf16>(WS_U), p.w<bf16>(WS_GV), p.stat(ST_SSQ0 + 2 * layer), p.stat(ST_LNS0 + 2 * j), p.stat(ST_LNQ0 + 2 * j) MK_DRYARG};
                MK_GEMM(EpiA1, E, p.w<bf16>(WS_HB), 1024, p.w<bf16>(WS_WIN + (size_t)j * 4 * MiB), 1024, 1024, 2048); ENDPH(pb); }
            if (IN_(pb + 1)) REPF(pb + 1) { PH_BEGIN(); a2_spatial(p, j, out + O_CV + (size_t)j * 131072); ENDPH(pb + 1); }
        } else if constexpr (kind == 1) {
            if (IN_(pb)) REPF(pb) { PH_BEGIN(); EpiB1 E{p.w<float>(WS_RAW), p.w<bf16>(WS_CQB), p.stat(ST_SSQ0 + 2 * layer), p.stat(ST_KV), p.stat(ST_Q) MK_DRYARG};
                MK_GEMM(EpiB1, E, p.w<bf16>(WS_HB), 1024, p.w<bf16>(WS_WDQKV), 1024, 1024, 768); ENDPH(pb); }
            if (IN_(pb + 1)) REPF(pb + 1) { PH_BEGIN(); b2_kvfinal(p, out + O_MP, out + O_MS);
                EpiB2 E{p.w<bf16>(WS_QF), p.stat(ST_Q), p.w<f32x2>(WS_ROPE)};
                MK_GEMM(EpiB2, E, p.w<bf16>(WS_CQB), 384, p.w<bf16>(WS_WQ), 384, 384, 2560); ENDPH(pb + 1); }
            if (IN_(pb + 2)) REPF(pb + 2) { PH_BEGIN();
                if (mask & 256) b3_attn_prompt(p); if (mask & 512) b3_attn_sample(p);
                ENDPH(pb + 2); }
            if (IN_(pb + 3)) REPF(pb + 3) { PH_BEGIN(); b3_combine(p); ENDPH(pb + 3); }
        } else {
            if (IN_(pb)) REPF(pb) { PH_BEGIN(); EpiC1 E{p.w<bf16>(WS_GATE), p.w<float>(WS_XW), p.stat(ST_SSQ0 + 2 * layer)};
                MK_GEMM(EpiC1, E, p.w<bf16>(WS_HB), 1024, p.w<bf16>(WS_WGX), 1024, 1024, 2560); ENDPH(pb); }
            if (IN_(pb + 1)) REPF(pb + 1) { PH_BEGIN(); c2_rglru(p, j, out + O_CP, out + O_CS, out + O_HS, mask); ENDPH(pb + 1); }
            if (IN_(pb + 3)) REPF(pb + 3) { PH_BEGIN(); c5_fixup(p, out + O_HP); ENDPH(pb + 3); }
        }
        if (IN_(pb + 5)) REPF(pb + 5) { PH_BEGIN(); EpiRes E{p.w<bf16>(WS_HB), p.stat(ST_SSQ0 + 2 * layer + 1) MK_DRYARG}; MK_GEMM(EpiRes, E, p.w<bf16>(resA), resK, p.w<bf16>(resB), resK, resK, 1024); ENDPH(pb + 5); }
        if (IN_(pb + 6)) REPF(pb + 6) { PH_BEGIN(); EpiF1 E{p.w<bf16>(WS_ACT), p.stat(ST_SSQ0 + 2 * layer + 1)}; MK_GEMM(EpiF1, E, p.w<bf16>(WS_HB), 1024, p.w<bf16>(WS_WGU + (size_t)layer * WGU_BYTES), 1024, 1024, 5632); ENDPH(pb + 6); }
        if (IN_(pb + 7)) REPF(pb + 7) { PH_BEGIN(); EpiRes E{p.w<bf16>(WS_HB), p.stat(ST_SSQ0 + 2 * layer + 2) MK_DRYARG}; MK_GEMM(EpiRes, E, p.w<bf16>(WS_ACT), DFF, p.w<bf16>(WS_WD + (size_t)layer * WD_BYTES), DFF, DFF, 1024); ENDPH(pb + 7); }
}
__global__ void __launch_bounds__(NWAVES * 64, 2) mk_fwd(Args a) {
    extern __shared__ __attribute__((aligned(16))) unsigned char lds_raw[];
    const int tid_ = threadIdx.x;
    const P p0{InTab{(const float* const __attribute__((address_space(4)))*)__builtin_amdgcn_kernarg_segment_ptr()}, a.out, a.ws, (LAS unsigned char*)lds_raw, tid_, tid_ & 63, __builtin_amdgcn_readfirstlane(tid_ >> 6), (int)gridDim.x, (int)blockIdx.x};
    volatile LAS unsigned* MISC = (volatile LAS unsigned*)(p0.lds + MISC_OFF);
    if (p0.tid < 64) MISC[p0.tid] = 0u;
    __syncthreads();
    XcdBarrier bar = xcd_barrier_post((unsigned*)(a.ws + WS_CTL) + CW_BAR + a.li * XCD_BAR_WORDS, MISC + 8);
    const int lo = a.ph_lo, hi = a.ph_hi, mask = a.mask;
    STAMP(0);
    if (IN_(0)) REPF(0) { PH_BEGIN(); p0_prologue(p, mask); if (mask & 128)
        { const int gt = p.bid * 512 + p.tid, NGT = p.G * 512; const u32x4 z = (u32x4){0u, 0u, 0u, 0u};
          for (int i = gt; i < 128 * 128; i += NGT) p.w<u32x4>(WS_UM + (size_t)MT * 2048)[i] = z;
          for (int i = gt; i < 128 * 256; i += NGT) p.w<u32x4>(WS_OB + (size_t)MT * 4096)[i] = z;
          for (int i = gt; i < 128 * 160; i += NGT) p.w<u32x4>(WS_GH + (size_t)MT * 2560)[i] = z; }
        ENDPH(0); }
    run_layer<0>(p0, bar, lo, hi, mask); run_layer<1>(p0, bar, lo, hi, mask); run_layer<2>(p0, bar, lo, hi, mask); run_layer<3>(p0, bar, lo, hi, mask);
    if (IN_(33)) REPF(33) { PH_BEGIN(); final_norm(p, out + O_YP, out + O_YS); VM_WAIT(); STAMP(34); }
#undef IN_
#undef ENDPH
}

inline void fill_args(Args& a, void* const* d_in, float* out, void* d_ws) { for (int i = 0; i < 36; ++i) a.in[i] = (const float*)d_in[i]; a.out = out; a.ws = (unsigned char*)d_ws; a.mask = -1; }
inline int setup_grid() {
    static int grid = 0;
    if (!grid) { int dev = 0, cus = 0; hipGetDevice(&dev); hipDeviceGetAttribute(&cus, hipDeviceAttributeMultiprocessorCount, dev);
        hipFuncSetAttribute((const void*)mk_fwd, hipFuncAttributeMaxDynamicSharedMemorySize, LDS_BYTES);
        int per_cu = 0; hipOccupancyMaxActiveBlocksPerMultiprocessor(&per_cu, (const void*)mk_fwd, NWAVES * 64, LDS_BYTES); (void)hipGetLastError();
        grid = cus > 0 ? cus : 256; }
    return grid;
}
inline void launch_range(void* const* d_in, float* out, void* d_ws, hipStream_t st, int lo, int hi, int li, int mask = -1) {
    Args a{}; fill_args(a, d_in, out, d_ws); a.ph_lo = lo; a.ph_hi = hi; a.li = li; a.mask = mask;
    hipLaunchKernelGGL(mk_fwd, dim3(setup_grid()), dim3(NWAVES * 64), LDS_BYTES, st, a);
}
}

extern "C" void kernel_launch(void* const* d_in, const int* in_sizes, int n_in, void* d_out, int out_size, void* d_ws, size_t ws_size, hipStream_t stream) {
    hipMemsetAsync(d_ws, 0, mk::CTL_BYTES, stream);
    mk::launch_range(d_in, (float*)d_out, d_ws, stream, 0, mk::NPHASE, 0);
}
```

```cpp
#include <hip/hip_runtime.h>
#include <math.h>
#define LAS __attribute__((address_space(3)))
#define GAS __attribute__((address_space(1)))
namespace pg8 {
#define PG8_LAS __attribute__((address_space(3)))
typedef unsigned short bf16_t;
typedef short bf16x8 __attribute__((ext_vector_type(8)));
typedef float f32x4 __attribute__((ext_vector_type(4)));
typedef unsigned u32x4 __attribute__((ext_vector_type(4)));
constexpr int BM = 256, BK = 64, HALF = 128, HTB = HALF * BK * 2  , STAGE_BYTES = 8 * HTB, NXCD = 8, WGM = 8;
__host__ __device__ __forceinline__ int lds_byte(int r, int c) { const int st = (r >> 4) * 2 + (c >> 5), rr = r & 15, cc = c & 31, ob = rr * 64 + cc * 2; return st * 1024 + (ob ^ (((ob >> 9) & 1) << 5)); }
__host__ __device__ __forceinline__ void stage_rc(int b, int& R, int& C) { const int st = b / 1024, sb = b % 1024, swz = sb ^ (((sb >> 9) & 1) << 5); R = (st >> 1) * 16 + swz / 64; C = (st & 1) * 32 + (swz % 64) / 2; }
__host__ __device__ __forceinline__ int perm32(int rho) { const int n = rho >> 4, i = rho & 15; return 8 * (i >> 2) + 4 * n + (i & 3); }
struct Unit { int pm, pn; };
struct Gemm { const bf16_t* A; const bf16_t* Bt; int lda, ldb, K; };
struct StaticOrder {
    int nM, nN, nwg, G, c;
    __host__ __device__ void init(int M, int N, int G_, int c_) { nM = M / BM; nN = N / BM; nwg = nM * nN; G = G_; c = c_; }
    __host__ __device__ bool next(int i, Unit& u) const {
        const long L = (long)i * G + c; if (L >= nwg) return false;
        int wgid = (int)L; { const int q = nwg / NXCD, r = nwg % NXCD, xcd = wgid % NXCD, off = wgid / NXCD; wgid = (xcd < r ? xcd * (q + 1) : r * (q + 1) + (xcd - r) * q) + off; }
        const int nig = WGM * nN, gid = wgid / nig, fm = gid * WGM, gsz = (nM - fm) < WGM ? (nM - fm) : WGM;
        u.pm = fm + ((wgid % nig) % gsz); u.pn = (wgid % nig) / gsz; return true;
    }
    __device__ __forceinline__ void a_ready(const Unit&) const {}
    __device__ __forceinline__ void done(const Unit&) const {}
};
__device__ __forceinline__ unsigned cvt_pk_bf16(float lo, float hi) { unsigned r; asm volatile("v_cvt_pk_bf16_f32 %0, %1, %2" : "=v"(r) : "v"(lo), "v"(hi)); return r; }
template <class Epi, class Sched, bool ALIGN_EPI = false, bool SP2 = false>
__device__ __forceinline__ void gemm_phase(PG8_LAS unsigned char* lds, const Gemm g, const Sched& S, const Epi& E, const int tid) {
    const int wid = __builtin_amdgcn_readfirstlane(tid >> 6), lane = tid & 63, wr = wid >> 2, wc = wid & 3, fr = lane & 15, fq = lane >> 4;
    const int K = g.K, nt = K / BK, lda = g.lda, ldb = g.ldb;
    unsigned voffA[2], voffB[2];
#pragma unroll
    for (int i = 0; i < 2; ++i) { int R, C; stage_rc(tid * 16 + i * 8192, R, C); const int Rb = Epi::PERM ? ((R & ~31) + perm32(R & 31)) : R;
        voffA[i] = (unsigned)(R * lda + C) * 2u; voffB[i] = (unsigned)(Rb * ldb + C) * 2u; }
    const size_t kstep = (size_t)(BK * 2);
    const size_t hstepA = (size_t)HALF * lda * 2, hstepB = (size_t)HALF * ldb * 2;
    const size_t tstepA = 2 * hstepA, tstepB = 2 * hstepB;
    const unsigned ldsw = (unsigned)wid * 1024u;
    const int aoff = lds_byte(wr * 64 + fr, fq * 8), boff = lds_byte(wc * 32 + fr, fq * 8);
#define PG8_SA(b, h) (((b) * 2 + (h)) * HTB)
#define PG8_SB(b, h) ((4 + (b) * 2 + (h)) * HTB)
#define PG8_STAGE(bufoff, gbase, voff) do { _Pragma("unroll") for (int _i = 0; _i < 2; ++_i) \
        __builtin_amdgcn_global_load_lds((const unsigned*)((const char*)(gbase) + (voff)[_i]), (PG8_LAS unsigned*)(lds + (bufoff) + ldsw + _i * 8192), 16, 0, 0); } while (0)
#define PG8_LDA(dst, b, h) do { _Pragma("unroll") for (int m = 0; m < 4; ++m) _Pragma("unroll") for (int k = 0; k < 2; ++k) dst[m][k] = *(const PG8_LAS bf16x8*)(lds + PG8_SA(b, h) + aoff + m * 2048 + k * 1024); } while (0)
#define PG8_LDB(dst, b, h) do { _Pragma("unroll") for (int n = 0; n < 2; ++n) _Pragma("unroll") for (int k = 0; k < 2; ++k) dst[n][k] = *(const PG8_LAS bf16x8*)(lds + PG8_SB(b, h) + boff + n * 2048 + k * 1024); } while (0)
#define PG8_MMA(ai, bj, At, Bt) do { __builtin_amdgcn_s_setprio(1); _Pragma("unroll") for (int m = 0; m < 4; ++m) _Pragma("unroll") for (int n = 0; n < 2; ++n) _Pragma("unroll") for (int k = 0; k < 2; ++k) \
        acc[ai][bj][m][n] = __builtin_amdgcn_mfma_f32_16x16x32_bf16(Bt[n][k], At[m][k], acc[ai][bj][m][n], 0, 0, 0); __builtin_amdgcn_s_setprio(0); } while (0)
#define PG8_WAIT_V(n) asm volatile("s_waitcnt vmcnt(" #n ")" ::: "memory")
#define PG8_WAIT_L(n) asm volatile("s_waitcnt lgkmcnt(" #n ")" ::: "memory")
#define PG8_BAR __builtin_amdgcn_s_barrier()
#define PG8_SCHED __builtin_amdgcn_sched_barrier(0)
    Unit cur, nxt; int ui = 0;
    if (!S.next(0, cur)) return;
    f32x4 acc[2][2][4][2];
#pragma unroll
    for (int a = 0; a < 2; ++a)
#pragma unroll
        for (int b = 0; b < 2; ++b)
#pragma unroll
            for (int m = 0; m < 4; ++m)
#pragma unroll
                for (int n = 0; n < 2; ++n) acc[a][b][m][n] = (f32x4){0.f, 0.f, 0.f, 0.f};
    bf16x8 At[4][2], B0[2][2], B1[2][2];
    const char* cA = (const char*)g.A + (size_t)cur.pm * tstepA; const char* cB = (const char*)g.Bt + (size_t)cur.pn * tstepB;
    S.a_ready(cur);
    if constexpr (SP2) {
        PG8_STAGE(PG8_SB(0, 0), cB, voffB); PG8_STAGE(PG8_SB(0, 1), cB + hstepB, voffB); PG8_STAGE(PG8_SA(0, 0), cA, voffA); PG8_STAGE(PG8_SA(0, 1), cA + hstepA, voffA);
        if (wr == 1) PG8_BAR;
        PG8_WAIT_V(2); PG8_BAR;
        PG8_STAGE(PG8_SB(1, 0), cB + kstep, voffB); PG8_STAGE(PG8_SA(1, 0), cA + kstep, voffA); PG8_STAGE(PG8_SB(1, 1), cB + hstepB + kstep, voffB);
        PG8_WAIT_V(6); PG8_BAR;
    } else {
        PG8_STAGE(PG8_SB(0, 0), cB, voffB); PG8_STAGE(PG8_SA(0, 0), cA, voffA); PG8_STAGE(PG8_SB(0, 1), cB + hstepB, voffB); PG8_STAGE(PG8_SA(0, 1), cA + hstepA, voffA);
        if (wr == 1) PG8_BAR;
        PG8_WAIT_V(4); PG8_BAR;
        PG8_STAGE(PG8_SB(1, 0), cB + kstep, voffB); PG8_STAGE(PG8_SA(1, 0), cA + kstep, voffA); PG8_STAGE(PG8_SB(1, 1), cB + hstepB + kstep, voffB);
        PG8_WAIT_V(6); PG8_BAR;
    }
    for (;;) {
        const bool has_next = S.next(ui + 1, nxt);
        const char* nA = has_next ? (const char*)g.A + (size_t)nxt.pm * tstepA : cA; const char* nB = has_next ? (const char*)g.Bt + (size_t)nxt.pn * tstepB : cB;
        for (int t = 0; t < nt; t += 2) {
            const bool last = (t == nt - 2);
            const char* a1 = cA + (size_t)(t + 1) * kstep;
            const char* a2 = last ? nA : cA + (size_t)(t + 2) * kstep; const char* b2 = last ? nB : cB + (size_t)(t + 2) * kstep;
            const char* a3 = a2 + kstep; const char* b3 = b2 + kstep;
            if (last && has_next) S.a_ready(nxt);
            if constexpr (SP2) {
            PG8_LDB(B0, 0, 0); PG8_LDB(B1, 0, 1); PG8_SCHED; PG8_LDA(At, 0, 0); PG8_STAGE(PG8_SA(1, 1), a1 + hstepA, voffA);
            PG8_WAIT_V(8); PG8_WAIT_L(0); PG8_BAR; PG8_MMA(0, 0, At, B0); PG8_MMA(0, 1, At, B1); PG8_BAR; PG8_SCHED;
            PG8_LDA(At, 0, 1); PG8_STAGE(PG8_SB(0, 0), b2, voffB); PG8_STAGE(PG8_SB(0, 1), b2 + hstepB, voffB); PG8_STAGE(PG8_SA(0, 0), a2, voffA);
            PG8_WAIT_V(8); PG8_WAIT_L(0); PG8_BAR; PG8_MMA(1, 0, At, B0); PG8_MMA(1, 1, At, B1); PG8_BAR; PG8_SCHED;
            PG8_LDB(B0, 1, 0); PG8_LDB(B1, 1, 1); PG8_SCHED; PG8_LDA(At, 1, 0); PG8_STAGE(PG8_SA(0, 1), a2 + hstepA, voffA);
            PG8_WAIT_V(8); PG8_WAIT_L(0); PG8_BAR; PG8_MMA(0, 0, At, B0); PG8_MMA(0, 1, At, B1); PG8_BAR; PG8_SCHED;
            PG8_LDA(At, 1, 1); PG8_STAGE(PG8_SB(1, 0), b3, voffB); PG8_STAGE(PG8_SB(1, 1), b3 + hstepB, voffB); PG8_STAGE(PG8_SA(1, 0), a3, voffA);
            PG8_WAIT_V(8); PG8_WAIT_L(0); PG8_BAR; PG8_MMA(1, 0, At, B0); PG8_MMA(1, 1, At, B1); PG8_BAR; PG8_SCHED;
            } else {
            PG8_LDB(B0, 0, 0); PG8_SCHED; PG8_LDA(At, 0, 0); PG8_STAGE(PG8_SA(1, 1), a1 + hstepA, voffA);
            PG8_WAIT_L(8); PG8_BAR; PG8_WAIT_L(0); PG8_MMA(0, 0, At, B0); PG8_BAR; PG8_SCHED;
            PG8_LDB(B1, 0, 1); PG8_STAGE(PG8_SB(0, 0), b2, voffB);
            PG8_BAR; PG8_WAIT_L(0); PG8_MMA(0, 1, At, B1); PG8_BAR;
            PG8_LDA(At, 0, 1); PG8_STAGE(PG8_SA(0, 0), a2, voffA);
            PG8_BAR; PG8_WAIT_L(0); PG8_MMA(1, 0, At, B0); PG8_BAR; PG8_SCHED;
            PG8_STAGE(PG8_SB(0, 1), b2 + hstepB, voffB);
            PG8_WAIT_V(6); PG8_BAR; PG8_MMA(1, 1, At, B1); PG8_BAR;
            PG8_LDB(B0, 1, 0); PG8_SCHED; PG8_LDA(At, 1, 0); PG8_STAGE(PG8_SA(0, 1), a2 + hstepA, voffA);
            PG8_WAIT_L(8); PG8_BAR; PG8_WAIT_L(0); PG8_MMA(0, 0, At, B0); PG8_BAR; PG8_SCHED;
            PG8_LDB(B1, 1, 1); PG8_STAGE(PG8_SB(1, 0), b3, voffB);
            PG8_BAR; PG8_WAIT_L(0); PG8_MMA(0, 1, At, B1); PG8_BAR;
            PG8_LDA(At, 1, 1); PG8_STAGE(PG8_SA(1, 0), a3, voffA);
            PG8_BAR; PG8_WAIT_L(0); PG8_MMA(1, 0, At, B0); PG8_BAR; PG8_SCHED;
            PG8_STAGE(PG8_SB(1, 1), b3 + hstepB, voffB);
            PG8_WAIT_V(6); PG8_BAR; PG8_MMA(1, 1, At, B1); PG8_BAR;
            }
        }
        if constexpr (ALIGN_EPI) { if (wr == 0) PG8_BAR; }
        if constexpr (!Epi::AFTER_DRAIN) { E(acc, cur, wr, wc, fr, fq); S.done(cur); }
        if (!has_next) break;
#pragma unroll
        for (int a = 0; a < 2; ++a)
#pragma unroll
            for (int b = 0; b < 2; ++b)
#pragma unroll
                for (int m = 0; m < 4; ++m)
#pragma unroll
                    for (int n = 0; n < 2; ++n) acc[a][b][m][n] = (f32x4){0.f, 0.f, 0.f, 0.f};
        cur = nxt; cA = nA; cB = nB; ++ui;
        if constexpr (ALIGN_EPI) { if (wr == 1) PG8_BAR; }
    }
    PG8_WAIT_V(0);
    if constexpr (!ALIGN_EPI) { if (wr == 0) PG8_BAR; }
    PG8_BAR;
    if constexpr (Epi::AFTER_DRAIN) { E.fused(acc, cur, wr, wc, fr, fq, lds, wid, lane); S.done(cur); }
#undef PG8_SA
#undef PG8_SB
#undef PG8_STAGE
#undef PG8_LDA
#undef PG8_LDB
#undef PG8_MMA
#undef PG8_WAIT_V
#undef PG8_WAIT_L
#undef PG8_BAR
#undef PG8_SCHED
}

}

namespace mk {
using pg8::f32x4; using pg8::bf16x8; using pg8::u32x4; using pg8::cvt_pk_bf16;
typedef unsigned short bf16;
typedef unsigned u32x2 __attribute__((ext_vector_type(2)));
typedef short s16x4 __attribute__((ext_vector_type(4)));
typedef float f32x2 __attribute__((ext_vector_type(2)));
typedef GAS unsigned gu32;
#define RLX_AGENT __ATOMIC_RELAXED, __HIP_MEMORY_SCOPE_AGENT
#define XB_TMO      128
#define XB_XCNT(j)  (256  + 64 * (j))
#define XB_XSUB(j)  (1280 + 64 * (j))
#define XB_XGEN(j)  (2304 + 64 * (j))
#define XB_TOP      3328
#define XB_TOPGEN   3392
#define XCD_BAR_WORDS 3456
#define XB_SPIN_CAP (1u << 18)

__device__ __forceinline__ unsigned xb_ld(unsigned* p)              { return __hip_atomic_load(p, __ATOMIC_RELAXED, __HIP_MEMORY_SCOPE_AGENT); }
__device__ __forceinline__ unsigned xb_add(unsigned* p, unsigned v) { return __hip_atomic_fetch_add(p, v, __ATOMIC_RELAXED, __HIP_MEMORY_SCOPE_AGENT); }
__device__ __forceinline__ unsigned xb_xcc_id() { return (unsigned)__builtin_amdgcn_s_getreg((3 << 11) | 20) & 0xFu; }
#define XB_SPIN(cond, bar) do { unsigned _sp = 0; while (cond) { __builtin_amdgcn_s_sleep(1); \
    if ((++_sp & 255u) == 0u) { if (xb_ld(&(bar)[XB_TMO])) break; if (_sp > XB_SPIN_CAP) { atomicAdd(&(bar)[XB_TMO], 1u); break; } } } } while (0)

struct XcdBarrier {
    unsigned* bar; unsigned x;
    volatile LAS unsigned* st;
};

__device__ __forceinline__ XcdBarrier xcd_barrier_post(unsigned* bar, volatile LAS unsigned* st) {
    XcdBarrier b; b.bar = bar; b.x = xb_xcc_id(); b.st = st;
    if (threadIdx.x == 0) (void)xb_add(&bar[XB_XCNT(b.x)], 1u);
    return b;
}
__device__ __forceinline__ void xcd_barrier_complete(unsigned* bar, unsigned x, unsigned& nloc, unsigned& nx) {
    const unsigned G = gridDim.x * gridDim.y * gridDim.z;
    unsigned sum, cnt, mine, sp = 0u;
    for (;;) {
        sum = 0u; cnt = 0u; mine = 0u;
#pragma unroll
        for (unsigned j = 0; j < 16; ++j) { const unsigned c = xb_ld(&bar[XB_XCNT(j)]); sum += c; cnt += (c > 0u) ? 1u : 0u; mine = (j == x) ? c : mine; }
        if (sum == G) break;
        __builtin_amdgcn_s_sleep(1);
        if ((++sp & 255u) == 0u) { if (xb_ld(&bar[XB_TMO])) break; if (sp > XB_SPIN_CAP) { atomicAdd(&bar[XB_TMO], 1u); break; } }
    }
    nloc = mine > 0u ? mine : 1u; nx = cnt > 0u ? cnt : 1u;
}

__device__ __forceinline__ void xcd_barrier(const XcdBarrier& b) {
    asm volatile("s_waitcnt vmcnt(0)" ::: "memory");
    __syncthreads();
    if (threadIdx.x == 0) {
        unsigned* bar = b.bar;
        __builtin_amdgcn_s_waitcnt(0);
        unsigned nloc = b.st[0], nx = b.st[1];
        if (nloc == 0u) { xcd_barrier_complete(bar, b.x, nloc, nx); b.st[0] = nloc; b.st[1] = nx; }
        const unsigned old = xb_add(&bar[XB_XSUB(b.x)], 1u);
        const unsigned gen = old / nloc;
        if (old + 1u == (gen + 1u) * nloc) {
            __builtin_amdgcn_fence(__ATOMIC_RELEASE, "agent");
            asm volatile("s_waitcnt vmcnt(0)" ::: "memory");
            const unsigned og = xb_add(&bar[XB_TOP], 1u);
            const unsigned tg = og / nx;
            if (og + 1u == (tg + 1u) * nx) xb_add(&bar[XB_TOPGEN], 1u);
            else XB_SPIN(xb_ld(&bar[XB_TOPGEN]) == tg, bar);
            __builtin_amdgcn_fence(__ATOMIC_ACQUIRE, "agent");
            xb_add(&bar[XB_XGEN(b.x)], 1u);
            asm volatile("s_waitcnt vmcnt(0)" ::: "memory");
        } else {
            XB_SPIN(xb_ld(&bar[XB_XGEN(b.x)]) == gen, bar);
            __builtin_amdgcn_fence(__ATOMIC_ACQUIRE, "agent");
            asm volatile("s_waitcnt vmcnt(0)" ::: "memory");
        }
    }
    __syncthreads();
}


constexpr int MP = 16384, MS = 128, MT = MP + MS, MR = 16640;
constexpr int D = 1024, DFF = 2816, NWAVES = 8;
constexpr float RMS_EPS = 1e-6f, LN_EPS = 1e-5f;
constexpr float MLA_SCALE = 0.07216878364870322f;
constexpr size_t MiB = 1u << 20;
constexpr size_t WS_CTL = 0, CTL_BYTES = 3 * MiB;
constexpr int CW_BAR = 4096;
constexpr size_t ST_OFF = 65536, ST_STRIDE = (size_t)MR * 8;
constexpr int ST_SSQ0 = 0  , ST_LNS0 = 9, ST_LNQ0 = 10  , ST_KV = 13, ST_Q = 14, NSTAT = 15;
static_assert(ST_OFF + NSTAT * ST_STRIDE <= CTL_BYTES, "stats inside CTL");
constexpr size_t WS_WGU = 3 * MiB, WGU_BYTES = 11 * MiB, WS_WD = 47 * MiB, WD_BYTES = 5767168, WS_WIN = 69 * MiB, WS_WOUT = 77 * MiB, WS_WS = 81 * MiB,
                 WS_WDQKV = 82 * MiB, WS_WQ = 84 * MiB, WS_WOV = 86 * MiB, WS_WGX = 90 * MiB, WS_WAT = 95 * MiB, WS_WIT = 95 * MiB + 512 * 1024, WS_WCO = 96 * MiB, WS_ROPE = 99 * MiB;
constexpr size_t WS_H = 100 * MiB, WS_HB = 165 * MiB, WS_U = 198 * MiB, WS_GV = 231 * MiB, WS_UM = 264 * MiB, WS_ACT = 297 * MiB, WS_RAW = 387 * MiB, WS_CQB = 436 * MiB,
                 WS_QF = 449 * MiB, WS_KVB = 531 * MiB, WS_OB = 542 * MiB, WS_PART = 607 * MiB, WS_PML = 623 * MiB, WS_GATE = 624 * MiB, WS_XW = 665 * MiB, WS_AA = 747 * MiB, WS_BB = 829 * MiB,
                 WS_AGG = 911 * MiB, WS_GH = 914 * MiB, WS_PROF = 955 * MiB, WS_MK_END = 956 * MiB;
constexpr int RING_BYTES = 131072, LDS_BYTES = 147456, MISC_OFF = LDS_BYTES - 256;
constexpr size_t O_YP = 0, O_YS = 16777216, O_CV = 16908288, O_MP = 17170432, O_MS = 22413312, O_HP = 22454272, O_HS = 22464512, O_CP = 22505472, O_CS = 22536192, O_END = 22659072;

__device__ __forceinline__ float fast_sigmoid_l2(float t) { return __builtin_amdgcn_rcpf(1.0f + __builtin_amdgcn_exp2f(-t)); }
__device__ __forceinline__ float gelu_tanh_f(float x) { return x * fast_sigmoid_l2(2.302208198f * (x + 0.044715f * x * x * x)); }
__device__ __forceinline__ float silu_f(float x) { return x * fast_sigmoid_l2(1.4426950409f * x); }
__device__ __forceinline__ unsigned f2bf(float f) { unsigned u = __builtin_bit_cast(unsigned, f); return (u + 0x7fffu + ((u >> 16) & 1u)) >> 16; }
__device__ __forceinline__ unsigned pk2(float lo, float hi) { return f2bf(lo) | (f2bf(hi) << 16); }
__device__ __forceinline__ float bf2f(unsigned short b) { return __builtin_bit_cast(float, (unsigned)b << 16); }
__device__ __forceinline__ float bflo(unsigned w) { return __builtin_bit_cast(float, w << 16); }
__device__ __forceinline__ float bfhi(unsigned w) { return __builtin_bit_cast(float, w & 0xffff0000u); }
constexpr float ST_SCALE = 16777216.0f, ST_INV = 1.0f / 16777216.0f;
__device__ __forceinline__ void stat_add(long long* p, float v) { atomicAdd((unsigned long long*)p, (unsigned long long)(long long)__float2ll_rn(v * ST_SCALE)); }
__device__ __forceinline__ void stat_set(long long* p, float v) { *p = (long long)__float2ll_rn(v * ST_SCALE); }
__device__ __forceinline__ float stat_get(const long long* p) { return (float)(*p) * ST_INV; }
#define LDS_WAIT() asm volatile("s_waitcnt lgkmcnt(0)" ::: "memory")
#define VM_WAIT() asm volatile("s_waitcnt vmcnt(0)" ::: "memory")

struct InTab { const float* const __attribute__((address_space(4)))* t; __device__ __forceinline__ const float* operator[](int i) const { return t[i]; } };
struct P {
    InTab in; float* out; unsigned char* ws;
    LAS unsigned char* lds; int tid, lane, wave, G, bid;
    __device__ __forceinline__ long long* stat(int a) const { return (long long*)(ws + ST_OFF + (size_t)a * ST_STRIDE); }
    template <class T> __device__ __forceinline__ T* w(size_t off) const { return (T*)(ws + off); }
};
}
namespace mk {
struct TrJob { const float* src; int ldsrc, K, N; bf16* dst; int lddst; const float* gain; int kind, off; };
__device__ __forceinline__ int tr_rowmap(int kind, int off, int n) { return kind == 1 ? ((n >> 7) * 256 + (n & 127) + off) : (off + n); }
__device__ __forceinline__ void tr_item(const TrJob& j, LAS float* scr, int item, int lane) {
    const int nblk = j.N / 32, kb = item / nblk, nb = item % nblk, k0 = 64 * kb, n0 = 32 * nb;
    const float* src = j.src + (size_t)(k0 + (lane >> 5)) * j.ldsrc + n0 + (lane & 31); const size_t rstep = (size_t)2 * j.ldsrc;
    float v[32];
#pragma unroll
    for (int i = 0; i < 32; ++i) v[i] = src[i * rstep];
    if (j.gain) { const float* gp = j.gain + k0 + (lane >> 5); float g[32];
#pragma unroll
        for (int i = 0; i < 32; ++i) g[i] = gp[2 * i];
#pragma unroll
        for (int i = 0; i < 32; ++i) v[i] *= g[i]; }
#pragma unroll
    for (int i = 0; i < 32; ++i) scr[(2 * i + (lane >> 5)) * 33 + (lane & 31)] = v[i];
    LDS_WAIT(); asm volatile("" ::: "memory");
    const int c = lane & 7;
#pragma unroll
    for (int jj = 0; jj < 4; ++jj) { const int n = (lane >> 3) + 8 * jj; const LAS float* s = scr + (8 * c) * 33 + n;
        u32x4 o; o.x = pk2(s[0], s[33]); o.y = pk2(s[66], s[99]); o.z = pk2(s[132], s[165]); o.w = pk2(s[198], s[231]);
        *(u32x4*)(j.dst + (size_t)tr_rowmap(j.kind, j.off, n0 + n) * j.lddst + k0 + 8 * c) = o; }
    LDS_WAIT(); asm volatile("" ::: "memory");
}
constexpr int NJOBS = 24;
__device__ __forceinline__ TrJob get_job(const P& p, int jid) {
    TrJob j; j.gain = nullptr; j.kind = 0; j.off = 0; j.src = nullptr; j.dst = nullptr; j.ldsrc = 0; j.K = 0; j.N = 0; j.lddst = 0;
    if (jid < 12) { const int l = jid / 3, t = jid % 3;
        if (t < 2) { j.src = p.in[33 + t] + (size_t)l * D * DFF; j.ldsrc = DFF; j.K = D; j.N = DFF; j.dst = p.w<bf16>(WS_WGU + l * WGU_BYTES); j.lddst = D; j.gain = p.in[7] + l * D; j.kind = 1; j.off = 128 * t; }
        else { j.src = p.in[35] + (size_t)l * DFF * D; j.ldsrc = D; j.K = DFF; j.N = D; j.dst = p.w<bf16>(WS_WD + l * WD_BYTES); j.lddst = DFF; }
    } else if (jid < 16) { const int a = (jid - 12) >> 1;
        if (((jid - 12) & 1) == 0) { j.src = p.in[9] + (size_t)a * D * 2048; j.ldsrc = 2048; j.K = D; j.N = 2048; j.dst = p.w<bf16>(WS_WIN + a * 4 * MiB); j.lddst = D; j.gain = p.in[6] + (3 * a) * D; }
        else { j.src = p.in[14] + (size_t)a * D * D; j.ldsrc = D; j.K = D; j.N = D; j.dst = p.w<bf16>(WS_WOUT + a * 2 * MiB); j.lddst = D; }
    } else if (jid == 16) { j.src = p.in[15]; j.ldsrc = 384; j.K = D; j.N = 384; j.dst = p.w<bf16>(WS_WDQKV); j.lddst = D; j.gain = p.in[6] + D; j.off = 256; }
    else if (jid == 17) { j.src = p.in[18]; j.ldsrc = 320; j.K = D; j.N = 256; j.dst = p.w<bf16>(WS_WDQKV); j.lddst = D; j.gain = p.in[6] + D; j.off = 0; }
    else if (jid == 18) { j.src = p.in[18] + 256; j.ldsrc = 320; j.K = D; j.N = 64; j.dst = p.w<bf16>(WS_WDQKV); j.lddst = D; j.gain = p.in[6] + D; j.off = 640; }
    else if (jid == 19) { j.src = p.in[24]; j.ldsrc = 1280; j.K = D; j.N = 1280; j.dst = p.w<bf16>(WS_WGX); j.lddst = D; j.gain = p.in[6] + 2 * D; j.off = 0; }
    else if (jid == 20) { j.src = p.in[23]; j.ldsrc = 1280; j.K = D; j.N = 1280; j.dst = p.w<bf16>(WS_WGX); j.lddst = D; j.gain = p.in[6] + 2 * D; j.off = 1280; }
    else if (jid == 21) { j.src = p.in[32]; j.ldsrc = D; j.K = 1280; j.N = D; j.dst = p.w<bf16>(WS_WCO); j.lddst = 1280; }
    else if (jid == 22) { j.src = p.in[27]; j.ldsrc = 128; j.K = 128; j.N = 128; j.dst = p.w<bf16>(WS_WAT); j.lddst = 128; j.kind = 2; }
    else { j.src = p.in[29]; j.ldsrc = 128; j.K = 128; j.N = 128; j.dst = p.w<bf16>(WS_WIT); j.lddst = 128; j.kind = 2; }
    return j;
}
__device__ __forceinline__ int job_items(const TrJob& j) { return j.kind == 2 ? 80 : (j.K / 64) * (j.N / 32); }

__device__ __forceinline__ void p0_prologue(const P& p, const int mask) {
    LAS float* scr = (LAS float*)(p.lds + p.wave * 16384);
    const int gw = p.bid * NWAVES + p.wave, NGW = p.G * NWAVES, lane = p.lane;
    const int gt = p.bid * (NWAVES * 64) + p.tid, NGT = p.G * NWAVES * 64;
    if (mask & 1) {
    {
        int base = 0;
        for (int jid = 0; jid < NJOBS; ++jid) {
            TrJob j = get_job(p, jid); const int nit = job_items(j);
            int first = (gw - base % NGW + NGW) % NGW;
            for (int it = first; it < nit; it += NGW) {
                if (j.kind == 2) { TrJob b = j; const int blk = it >> 3; b.src = j.src + (size_t)blk * 16384; b.dst = j.dst + (size_t)blk * 16384; b.kind = 0; tr_item(b, scr, it & 7, lane); }
                else tr_item(j, scr, it, lane);
            }
            base += nit;
        }
    }
    }
    if (mask & 2) {
    { u32x4* z = (u32x4*)(p.w<bf16>(WS_WDQKV) + (size_t)704 * D); for (int i = gt; i < 64 * D / 8; i += NGT) z[i] = (u32x4){0u, 0u, 0u, 0u}; }
    }
    if (mask & 4) {
    for (int i = gt; i < 2 * 8 * 128 * 16; i += NGT) {
        const int s0 = (i & 15) * 8, t = (i >> 4) & 127, jg = i >> 11; const float* src = p.in[12] + (size_t)jg * 16384;
        unsigned w[4], ws_[4];
#pragma unroll
        for (int e = 0; e < 4; ++e) { float v[2], vs[2];
#pragma unroll
            for (int h = 0; h < 2; ++h) { const int s = s0 + 2 * e + h; v[h] = (s <= t) ? src[t * 128 + s] : 0.f; vs[h] = ((s >> 2) == (t >> 2) && (s & 3) <= (t & 3)) ? src[(t & 3) * 128 + (s & 3)] : 0.f; }
            w[e] = pk2(v[0], v[1]); ws_[e] = pk2(vs[0], vs[1]); }
        const int j = jg >> 3, g = jg & 7;
        *(u32x4*)(p.w<bf16>(WS_WS + (size_t)j * 262144) + ((size_t)g * 128 + t) * 128 + s0) = (u32x4){w[0], w[1], w[2], w[3]};
        *(u32x4*)(p.w<bf16>(WS_WS + 524288 + (size_t)j * 262144) + ((size_t)g * 128 + t) * 128 + s0) = (u32x4){ws_[0], ws_[1], ws_[2], ws_[3]};
    }
    }
    if (mask & 8) {
    for (int i = gt; i < 2052 * 32; i += NGT) { const int tp = i >> 5, fi = i & 31, pos = tp < 2048 ? tp : 16384 + (tp - 2048);
        const float inv = 1.0f / powf(10000.0f, (float)(2 * fi) / 64.0f); const float ang = (float)pos * inv;
        p.w<f32x2>(WS_ROPE)[i] = (f32x2){cosf(ang), sinf(ang)}; }
    }
    if (mask & 16) {
    { bf16* HB = p.w<bf16>(WS_HB); long long* ssq = p.stat(ST_SSQ0);
      for (int m = gw; m < MR; m += NGW) {
        f32x4 v[4]; float s = 0.f;
#pragma unroll
        for (int jj = 0; jj < 4; ++jj) { const int c = 4 * lane + 256 * jj;
            if (m < MP) v[jj] = *(const f32x4*)(p.in[0] + (size_t)m * D + c); else if (m < MT) v[jj] = *(const f32x4*)(p.in[1] + (size_t)(m - MP) * D + c); else v[jj] = (f32x4){0.f, 0.f, 0.f, 0.f};
            s += (v[jj].x * v[jj].x + v[jj].y * v[jj].y) + (v[jj].z * v[jj].z + v[jj].w * v[jj].w); }
#pragma unroll
        for (int o = 1; o < 64; o <<= 1) s += __shfl_xor(s, o);
#pragma unroll
        for (int jj = 0; jj < 4; ++jj) { const int c = 4 * lane + 256 * jj;
            *(u32x2*)(HB + (size_t)m * D + c) = (u32x2){pk2(v[jj].x, v[jj].y), pk2(v[jj].z, v[jj].w)}; }
        if (lane == 0) stat_set(ssq + m, s);
      } }
    }
    if (mask & 32) {
    { const float* wuq = p.in[17]; const float* wuk = p.in[20]; const float* qn = p.in[16]; bf16* Wq = p.w<bf16>(WS_WQ);
      LAS float* Qs = (LAS float*)p.lds;
      for (int it = p.bid; it < 192; it += p.G) {
        const int h = it / 24, kb = (it >> 2) % 6, cq = it & 3, k0 = 64 * kb;
        __syncthreads();
#pragma unroll
        for (int q = 0; q < 4; ++q) { const int idx = p.tid + 512 * q, row = idx >> 5, c4 = idx & 31; *(LAS f32x4*)(Qs + row * 132 + c4 * 4) = *(const f32x4*)(wuq + (size_t)(k0 + row) * 1536 + h * 192 + c4 * 4); }
        __syncthreads();
        const int c0 = cq * 64 + p.wave * 8; float acc[8];
#pragma unroll
        for (int cc = 0; cc < 8; ++cc) acc[cc] = 0.f;
        for (int n4 = 0; n4 < 32; ++n4) { const f32x4 bv = *(const LAS f32x4*)(Qs + lane * 132 + n4 * 4);
#pragma unroll
            for (int cc = 0; cc < 8; ++cc) { const f32x4 av = *(const f32x4*)(wuk + (size_t)(c0 + cc) * 1024 + h * 128 + n4 * 4); acc[cc] += (av.x * bv.x + av.y * bv.y) + (av.z * bv.z + av.w * bv.w); } }
        const float g = qn[k0 + lane];
#pragma unroll
        for (int cc = 0; cc < 8; ++cc) Wq[(size_t)(320 * h + c0 + cc) * 384 + k0 + lane] = (bf16)f2bf(acc[cc] * g);
      }
      for (int r = gw; r < 512; r += NGW) { const int h = r >> 6, ie = r & 63, i = ie >> 1, e = ie & 1;
#pragma unroll
        for (int kk = 0; kk < 6; ++kk) { const int k = lane + 64 * kk; Wq[(size_t)(320 * h + 256 + ie) * 384 + k] = (bf16)f2bf(wuq[(size_t)k * 1536 + h * 192 + 128 + 32 * e + i] * qn[k]); } } }
    }
    if (mask & 64) {
    { const float* wuv = p.in[21]; const float* wo = p.in[22]; bf16* Wov = p.w<bf16>(WS_WOV);
      for (int it = gw; it < 2048; it += NGW) { const int h = it >> 8, cg = (it >> 2) & 63, nb = it & 3, c0 = cg * 4, n = nb * 256 + lane * 4;
        f32x4 acc[4];
#pragma unroll
        for (int cc = 0; cc < 4; ++cc) acc[cc] = (f32x4){0.f, 0.f, 0.f, 0.f};
        for (int v = 0; v < 128; ++v) { const f32x4 b = *(const f32x4*)(wo + (size_t)(h * 128 + v) * D + n);
#pragma unroll
            for (int cc = 0; cc < 4; ++cc) { const float a = wuv[(size_t)(c0 + cc) * 1024 + h * 128 + v]; acc[cc] += b * a; } }
#pragma unroll
        for (int jn = 0; jn < 4; ++jn) *(u32x2*)(Wov + (size_t)(n + jn) * 2048 + h * 256 + c0) = (u32x2){pk2(acc[0][jn], acc[1][jn]), pk2(acc[2][jn], acc[3][jn])};
      } }
    }
}
}
namespace mk {
#ifdef MK_DRYPROBE
#define MK_DRY(E) ((E).dry)
#define MK_DRYFIELD int dry;
#else
#define MK_DRY(E) 0
#define MK_DRYFIELD
#endif
typedef const f32x4 (&AccRef)[2][2][4][2];
__device__ __forceinline__ float quad_red(float v) { v += __shfl_xor(v, 16); v += __shfl_xor(v, 32); return v; }
__device__ __forceinline__ u32x4 pack8(const f32x4 a, const f32x4 b) { u32x4 w; w.x = cvt_pk_bf16(a[0], a[1]); w.y = cvt_pk_bf16(a[2], a[3]); w.z = cvt_pk_bf16(b[0], b[1]); w.w = cvt_pk_bf16(b[2], b[3]); return w; }
__device__ __forceinline__ float sumsq8(const f32x4 a, const f32x4 b) { return ((a[0] * a[0] + a[1] * a[1]) + (a[2] * a[2] + a[3] * a[3])) + ((b[0] * b[0] + b[1] * b[1]) + (b[2] * b[2] + b[3] * b[3])); }
__device__ __forceinline__ float sum8(const f32x4 a, const f32x4 b) { return ((a[0] + a[1]) + (a[2] + a[3])) + ((b[0] + b[1]) + (b[2] + b[3])); }
#define MK_EPI_CALL() \
    __device__ __forceinline__ void operator()(AccRef acc, const pg8::Unit& u, int wr, int wc, int fr, int fq) const { \
        Pre pre_[2][4]; \
        _Pragma("unroll") for (int ai = 0; ai < 2; ++ai) _Pragma("unroll") for (int m = 0; m < 4; ++m) pre_[ai][m] = pre(u.pm * 256 + ai * 128 + wr * 64 + m * 16 + fr, u.pn, wc, fq); \
        _Pragma("unroll") for (int ai = 0; ai < 2; ++ai) _Pragma("unroll") for (int m = 0; m < 4; ++m) \
            rgp(u.pm * 256 + ai * 128 + wr * 64 + m * 16 + fr, u.pn, wc, fq, acc[ai][0][m][0], acc[ai][0][m][1], acc[ai][1][m][0], acc[ai][1][m][1], pre_[ai][m]); } \
    __device__ __forceinline__ void rg(int r, int pn, int wc, int fq, f32x4 a0, f32x4 b0, f32x4 a1, f32x4 b1) const { rgp(r, pn, wc, fq, a0, b0, a1, b1, pre(r, pn, wc, fq)); }
#define MK_EPI_CALL_DENSE() \
    __device__ __forceinline__ void operator()(AccRef acc, const pg8::Unit& u, int wr, int wc, int fr, int fq) const { \
        Pre pre_[2][4]; \
        _Pragma("unroll") for (int ai = 0; ai < 2; ++ai) _Pragma("unroll") for (int m = 0; m < 4; ++m) pre_[ai][m] = pre(u.pm * 256 + ai * 128 + wr * 64 + m * 16 + fr, u.pn, wc, fq); \
        _Pragma("unroll") for (int ai = 0; ai < 2; ++ai) { float s1 = 0.f, s2 = 0.f; \
            _Pragma("unroll") for (int m = 0; m < 4; ++m) { float t1, t2; \
                rgs(u.pm * 256 + ai * 128 + wr * 64 + m * 16 + fr, u.pn, wc, fq, acc[ai][0][m][0], acc[ai][0][m][1], acc[ai][1][m][0], acc[ai][1][m][1], pre_[ai][m], t1, t2); \
                s1 = (fq == m) ? t1 : s1; s2 = (fq == m) ? t2 : s2; } \
            stats(u.pm * 256 + ai * 128 + wr * 64 + fq * 16 + fr, u.pn, s1, s2); } } \
    __device__ __forceinline__ void rg(int r, int pn, int wc, int fq, f32x4 a0, f32x4 b0, f32x4 a1, f32x4 b1) const { float t1, t2; rgs(r, pn, wc, fq, a0, b0, a1, b1, pre(r, pn, wc, fq), t1, t2); if (fq == 0) stats(r, pn, t1, t2); }
#define MK_PRE_STAT(PTR) typedef long long Pre; __device__ __forceinline__ Pre pre(int r, int, int, int) const { return (PTR)[r]; }
__device__ __forceinline__ float stat_f(long long v) { return (float)v * ST_INV; }

struct EpiA1 {
    static constexpr bool PERM = true, AFTER_DRAIN = false;
    bf16* U; bf16* GV; const long long* ssq; long long* lns; long long* lnq; MK_DRYFIELD
    MK_PRE_STAT(ssq)
    __device__ __forceinline__ void rgs(int r, int pn, int wc, int fq, f32x4 a0, f32x4 b0, f32x4 a1, f32x4 b1, const Pre pv, float& s1, float& s2) const {
        const bool isv = pn >= 4; bf16* dst = (isv ? GV : U) + (size_t)r * 1024 + (pn & 3) * 256 + wc * 32 + 8 * fq; const float rs = rsqrtf(stat_f(pv) * (1.0f / 1024.0f) + RMS_EPS);
        a0 *= rs; b0 *= rs; a1 *= rs; b1 *= rs;
#pragma unroll
        for (int e = 0; e < 4; ++e) { a0[e] = gelu_tanh_f(a0[e]); b0[e] = gelu_tanh_f(b0[e]); a1[e] = gelu_tanh_f(a1[e]); b1[e] = gelu_tanh_f(b1[e]); }
        *(u32x4*)dst = pack8(a0, b0); *(u32x4*)(dst + 128) = pack8(a1, b1);
        s1 = 0.f; s2 = 0.f;
        if (isv) { s1 = quad_red(sum8(a0, b0) + sum8(a1, b1)); s2 = quad_red(sumsq8(a0, b0) + sumsq8(a1, b1)); }
    }
    __device__ __forceinline__ void stats(int r, int pn, float s1, float s2) const { if (pn >= 4 && !MK_DRY(*this)) { stat_add(lns + r, s1); stat_add(lnq + r, s2); } }
    MK_EPI_CALL_DENSE()
};
struct EpiRes {
    static constexpr bool PERM = true, AFTER_DRAIN = false;
    bf16* HB; long long* ssq_out; MK_DRYFIELD
    struct Pre { u32x4 h0, h1; };
    __device__ __forceinline__ Pre pre(int r, int pn, int wc, int fq) const { const bf16* hp = HB + (size_t)r * 1024 + pn * 256 + wc * 32 + 8 * fq; Pre v; v.h0 = (u32x4){0u, 0u, 0u, 0u}; v.h1 = v.h0;
        if (MK_DRY(*this) != 3) { v.h0 = *(const u32x4*)hp; v.h1 = *(const u32x4*)(hp + 128); } return v; }
    __device__ __forceinline__ void rgs(int r, int pn, int wc, int fq, f32x4 a0, f32x4 b0, f32x4 a1, f32x4 b1, const Pre pv, float& s1, float& s2) const {
        const size_t o = (size_t)r * 1024 + pn * 256 + wc * 32 + 8 * fq; bf16* hp = HB + o;
        if (MK_DRY(*this) == 2) { a0 *= 0.f; b0 *= 0.f; a1 *= 0.f; b1 *= 0.f; }
        const u32x4 h0 = pv.h0, h1 = pv.h1;
        a0 += (f32x4){bflo(h0.x), bfhi(h0.x), bflo(h0.y), bfhi(h0.y)}; b0 += (f32x4){bflo(h0.z), bfhi(h0.z), bflo(h0.w), bfhi(h0.w)};
        a1 += (f32x4){bflo(h1.x), bfhi(h1.x), bflo(h1.y), bfhi(h1.y)}; b1 += (f32x4){bflo(h1.z), bfhi(h1.z), bflo(h1.w), bfhi(h1.w)};
        s1 = quad_red(sumsq8(a0, b0) + sumsq8(a1, b1)); s2 = 0.f;
        if (MK_DRY(*this) & 1) { if (s1 == 12345.678f) *(u32x4*)hp = pack8(a0, b0); return; }
        *(u32x4*)hp = pack8(a0, b0); *(u32x4*)(hp + 128) = pack8(a1, b1);
    }
    __device__ __forceinline__ void stats(int r, int pn, float s1, float s2) const { if (!MK_DRY(*this)) stat_add(ssq_out + r, s1); }
    MK_EPI_CALL_DENSE()
};
struct EpiF1 {
    static constexpr bool PERM = true, AFTER_DRAIN = false;
    bf16* ACT; const long long* ssq;
    MK_PRE_STAT(ssq)
    __device__ __forceinline__ void rgp(int r, int pn, int wc, int fq, f32x4 a0, f32x4 b0, f32x4 a1, f32x4 b1, const Pre pv) const {
        const float rs = rsqrtf(stat_f(pv) * (1.0f / 1024.0f) + RMS_EPS); f32x4 a, b;
#pragma unroll
        for (int e = 0; e < 4; ++e) { a[e] = silu_f(a0[e] * rs) * (a1[e] * rs); b[e] = silu_f(b0[e] * rs) * (b1[e] * rs); }
        *(u32x4*)(ACT + (size_t)r * DFF + pn * 128 + wc * 32 + 8 * fq) = pack8(a, b);
    }
    MK_EPI_CALL()
};
struct EpiB1 {
    static constexpr bool PERM = true, AFTER_DRAIN = false;
    float* RAW; bf16* CQB; const long long* ssq; long long* ssq_kv; long long* ssq_q; MK_DRYFIELD
    __device__ __forceinline__ void half(int r, int c, f32x4 a, f32x4 b, float& qkv, float& qq) const {
        if (c < 256) { *(f32x4*)(RAW + (size_t)r * 768 + c) = a; *(f32x4*)(RAW + (size_t)r * 768 + c + 4) = b; qkv += sumsq8(a, b); }
        else if (c < 640) { *(u32x4*)(CQB + (size_t)r * 384 + (c - 256)) = pack8(a, b); qq += sumsq8(a, b); }
        else if (c < 704) { *(f32x4*)(RAW + (size_t)r * 768 + c) = a; *(f32x4*)(RAW + (size_t)r * 768 + c + 4) = b; } }
    MK_PRE_STAT(ssq)
    __device__ __forceinline__ void rgs(int r, int pn, int wc, int fq, f32x4 a0, f32x4 b0, f32x4 a1, f32x4 b1, const Pre pv, float& s1, float& s2) const {
        const float rs = rsqrtf(stat_f(pv) * (1.0f / 1024.0f) + RMS_EPS); const int c = pn * 256 + wc * 32 + 8 * fq; float qkv = 0.f, qq = 0.f;
        half(r, c, a0 * rs, b0 * rs, qkv, qq); half(r, c + 128, a1 * rs, b1 * rs, qkv, qq);
        s1 = quad_red(qkv); s2 = quad_red(qq);
    }
    __device__ __forceinline__ void stats(int r, int pn, float s1, float s2) const { if (!MK_DRY(*this)) { if (pn == 0) stat_add(ssq_kv + r, s1); else stat_add(ssq_q + r, s2); } }
    MK_EPI_CALL_DENSE()
};
struct EpiB2 {
    static constexpr bool PERM = true, AFTER_DRAIN = false;
    bf16* QF; const long long* ssq_q; const f32x2* rope;
    __device__ __forceinline__ void half(int r, int c, int tp, const f32x4 a, const f32x4 b) const {
        const int h = c / 320, w = c - h * 320;
        if (w < 256) *(u32x4*)(QF + (size_t)r * 2560 + c) = pack8(a, b);
        else { const int i0 = (w - 256) >> 1;
            const f32x4 cs01 = *(const f32x4*)(rope + (size_t)tp * 32 + i0), cs23 = *(const f32x4*)(rope + (size_t)tp * 32 + i0 + 2);
            bf16* qh = QF + (size_t)r * 2560 + h * 320 + 256;
            *(u32x2*)(qh + i0) = (u32x2){cvt_pk_bf16(a[0] * cs01[0] - a[1] * cs01[1], a[2] * cs01[2] - a[3] * cs01[3]), cvt_pk_bf16(b[0] * cs23[0] - b[1] * cs23[1], b[2] * cs23[2] - b[3] * cs23[3])};
            *(u32x2*)(qh + 32 + i0) = (u32x2){cvt_pk_bf16(a[0] * cs01[1] + a[1] * cs01[0], a[2] * cs01[3] + a[3] * cs01[2]), cvt_pk_bf16(b[0] * cs23[1] + b[1] * cs23[0], b[2] * cs23[3] + b[3] * cs23[2])}; } }
    MK_PRE_STAT(ssq_q)
    __device__ __forceinline__ void rgp(int r, int pn, int wc, int fq, f32x4 a0, f32x4 b0, f32x4 a1, f32x4 b1, const Pre pv) const {
        const float rs = rsqrtf(stat_f(pv) * (1.0f / 384.0f) + RMS_EPS) * MLA_SCALE; const int tp = r < MP ? (r & 2047) : 2048 + ((r - MP) & 3), c = pn * 256 + wc * 32 + 8 * fq;
        half(r, c, tp, a0 * rs, b0 * rs); half(r, c + 128, tp, a1 * rs, b1 * rs);
    }
    MK_EPI_CALL()
};
struct EpiC1 {
    static constexpr bool PERM = true, AFTER_DRAIN = false;
    bf16* GATE; float* XW; const long long* ssq;
    MK_PRE_STAT(ssq)
    __device__ __forceinline__ void rgp(int r, int pn, int wc, int fq, f32x4 a0, f32x4 b0, f32x4 a1, f32x4 b1, const Pre pv) const {
        const bool isx = pn >= 5; const int c = (isx ? pn - 5 : pn) * 256 + wc * 32 + 8 * fq; const float rs = rsqrtf(stat_f(pv) * (1.0f / 1024.0f) + RMS_EPS);
        a0 *= rs; b0 *= rs; a1 *= rs; b1 *= rs;
        if (isx) { float* x = XW + (size_t)r * 1280 + c; *(f32x4*)x = a0; *(f32x4*)(x + 4) = b0; *(f32x4*)(x + 128) = a1; *(f32x4*)(x + 132) = b1; }
        else {
#pragma unroll
            for (int e = 0; e < 4; ++e) { a0[e] = gelu_tanh_f(a0[e]); b0[e] = gelu_tanh_f(b0[e]); a1[e] = gelu_tanh_f(a1[e]); b1[e] = gelu_tanh_f(b1[e]); }
            bf16* g = GATE + (size_t)r * 1280 + c; *(u32x4*)g = pack8(a0, b0); *(u32x4*)(g + 128) = pack8(a1, b1); }
    }
    MK_EPI_CALL()
};

template <class Epi>
__device__ __forceinline__ void mini_gemm(const P& p, const bf16* A, int lda, const bf16* Bt, int ldb, int K, int N, const Epi& E, int first_wg) {
    constexpr int BP = 272, SLOT = 64 * BP;
    const int tid = p.tid, lane = p.lane, w = p.wave, kq = w & 3, rgp = w >> 2, l15 = lane & 15, g4 = lane >> 4, nmu = (N >> 8) * 16, nch = K >> 7, nst = (nch + 3) >> 2;
    const int t128 = (rgp << 6) | lane;
    for (int mu = (p.bid - first_wg + p.G) % p.G; mu < nmu; mu += p.G) {
        const int pn = mu >> 4, wcq = (mu >> 2) & 3, rq = mu & 3, row = MP + 32 * rq + 16 * rgp + l15;
        const bf16* arow = A + (size_t)row * lda + 8 * g4;
        const int r0 = t128 >> 4, c16 = t128 & 15;
        const bf16* bbase = Bt + (size_t)(pn * 256 + wcq * 32 + 8 * (r0 >> 2) + (r0 & 3)) * ldb + c16 * 8; const int bo0 = r0 * BP + c16 * 16;
#define MG_BSRC(q) (bbase + (size_t)(128 * ((q) >> 2) + 4 * (((q) >> 1) & 1) + 16 * ((q) & 1)) * ldb)
#define MG_BOFF(q) (bo0 + 8 * (q) * BP)
        f32x4 acc[4];
#pragma unroll
        for (int t = 0; t < 4; ++t) acc[t] = (f32x4){0.f, 0.f, 0.f, 0.f};
        u32x4 b0[8], a0[4], b1[8], a1[4], b2[8], a2[4];
#define MG_LOAD(BS, AS, ST) do { const int ch_ = 4 * (ST) + kq; if (ch_ < nch) { \
            _Pragma("unroll") for (int q = 0; q < 8; ++q) BS[q] = *(const u32x4*)(MG_BSRC(q) + (size_t)ch_ * 128); \
            _Pragma("unroll") for (int s = 0; s < 4; ++s) AS[s] = *(const u32x4*)(arow + (size_t)ch_ * 128 + 32 * s); } } while (0)
#define MG_STEP(BS, AS, ST) do { LAS unsigned char* slot = p.lds + (kq * 2 + ((ST) & 1)) * SLOT; const bool ok_ = 4 * (ST) + kq < nch; \
            if (ok_) { _Pragma("unroll") for (int q = 0; q < 8; ++q) *(LAS u32x4*)(slot + MG_BOFF(q)) = BS[q]; } \
            bf16x8 af[4]; _Pragma("unroll") for (int s = 0; s < 4; ++s) af[s] = __builtin_bit_cast(bf16x8, AS[s]); \
            __syncthreads(); \
            if ((ST) + 3 < nst) MG_LOAD(BS, AS, (ST) + 3); \
            if (ok_) { _Pragma("unroll") for (int s = 0; s < 4; ++s) _Pragma("unroll") for (int t = 0; t < 4; ++t) { \
                const bf16x8 bf = *(const LAS bf16x8*)(slot + (t * 16 + l15) * BP + (32 * s + 8 * g4) * 2); \
                acc[t] = __builtin_amdgcn_mfma_f32_16x16x32_bf16(bf, af[s], acc[t], 0, 0, 0); } } } while (0)
        MG_LOAD(b0, a0, 0); if (1 < nst) MG_LOAD(b1, a1, 1); if (2 < nst) MG_LOAD(b2, a2, 2);
        __syncthreads();
        for (int st = 0; st < nst; st += 3) {
            MG_STEP(b0, a0, st);
            if (st + 1 < nst) MG_STEP(b1, a1, st + 1);
            if (st + 2 < nst) MG_STEP(b2, a2, st + 2);
        }
#undef MG_LOAD
#undef MG_STEP
#undef MG_BSRC
#undef MG_BOFF
        __syncthreads();
        LAS f32x4* red = (LAS f32x4*)p.lds;
        if (kq > 0) {
#pragma unroll
            for (int t = 0; t < 4; ++t) red[((rgp * 3 + (kq - 1)) * 4 + t) * 64 + lane] = acc[t]; }
        __syncthreads();
        if (kq == 0) {
#pragma unroll
            for (int k2 = 0; k2 < 3; ++k2)
#pragma unroll
                for (int t = 0; t < 4; ++t) acc[t] += red[((rgp * 3 + k2) * 4 + t) * 64 + lane];
            E.rg(row, pn, wcq, g4, acc[0], acc[1], acc[2], acc[3]); }
    }
}
}
namespace mk {
__device__ __forceinline__ s16x4 tr16(const LAS unsigned char* a) { return __builtin_amdgcn_ds_read_tr16_b64_v4i16((LAS s16x4*)a); }
__device__ __forceinline__ bf16x8 cat8(const s16x4 a, const s16x4 b) { return (bf16x8){a[0], a[1], a[2], a[3], b[0], b[1], b[2], b[3]}; }
__device__ __forceinline__ bf16x8 as_bf16x8(const u32x4 w) { return __builtin_bit_cast(bf16x8, w); }
#define MFMA16(A, B, C) __builtin_amdgcn_mfma_f32_16x16x32_bf16((A), (B), (C), 0, 0, 0)
constexpr int TP = 272;
constexpr int KP = 656;
constexpr float LOG2E = 1.4426950408889634f;

__device__ __forceinline__ void a2_spatial(const P& p, int j, float* out_cv  ) {
    const bf16* U = p.w<bf16>(WS_U); const bf16* GV = p.w<bf16>(WS_GV); bf16* UM = p.w<bf16>(WS_UM);
    const long long* lns = p.stat(ST_LNS0 + 2 * j); const long long* lnq = p.stat(ST_LNQ0 + 2 * j);
    const float* ln_g = p.in[10] + j * 1024; const float* ln_b = p.in[11] + j * 1024; const float* b_s = p.in[13] + j * 1024;
    LAS unsigned char* Wt = p.lds; LAS unsigned char* Vt = p.lds + 128 * TP;
    const int tid = p.tid, lane = p.lane, w = p.wave, l15 = lane & 15, g4 = lane >> 4, q4 = (lane & 15) >> 2, pp = lane & 3;
    for (int u = p.bid; u < 129 * 8; u += p.G) {
        const int c = u >> 3, g = u & 7, row0 = c * 128; const bool smp = (c == 128);
        const bf16* Wsrc = p.w<bf16>(WS_WS + (smp ? 524288 : 0) + (size_t)j * 262144) + (size_t)g * 16384;
#pragma unroll
        for (int q = 0; q < 4; ++q) { const int ch = tid + 512 * q, row = ch >> 4, c16 = ch & 15;
            *(LAS u32x4*)(Wt + row * TP + c16 * 16) = *(const u32x4*)(Wsrc + row * 128 + c16 * 8); }
        { const int c16 = tid & 15, d0 = g * 128 + c16 * 8;
          const f32x4 g0 = *(const f32x4*)(ln_g + d0), g1 = *(const f32x4*)(ln_g + d0 + 4), b0 = *(const f32x4*)(ln_b + d0), b1 = *(const f32x4*)(ln_b + d0 + 4);
          u32x4 raw[4]; float mean[4], rstd[4];
#pragma unroll
          for (int q = 0; q < 4; ++q) { const int r = row0 + (tid >> 4) + 32 * q; raw[q] = *(const u32x4*)(GV + (size_t)r * 1024 + d0);
              const float mu = stat_get(lns + r) * (1.0f / 1024.0f), var = stat_get(lnq + r) * (1.0f / 1024.0f) - mu * mu; mean[q] = mu; rstd[q] = rsqrtf(var + LN_EPS); }
#pragma unroll
          for (int q = 0; q < 4; ++q) { const int s = (tid >> 4) + 32 * q, r = row0 + s;
            f32x4 v0, v1;
            v0[0] = bflo(raw[q].x); v0[1] = bfhi(raw[q].x); v0[2] = bflo(raw[q].y); v0[3] = bfhi(raw[q].y); v1[0] = bflo(raw[q].z); v1[1] = bfhi(raw[q].z); v1[2] = bflo(raw[q].w); v1[3] = bfhi(raw[q].w);
            v0 = (v0 - mean[q]) * rstd[q] * g0 + b0; v1 = (v1 - mean[q]) * rstd[q] * g1 + b1;
            if (smp && out_cv) { float* o = out_cv + (size_t)(r - MP) * 1024 + d0; *(f32x4*)o = v0; *(f32x4*)(o + 4) = v1; }
            *(LAS u32x4*)(Vt + s * TP + c16 * 16) = pack8(v0, v1); } }
        u32x2 uu[8];
#pragma unroll
        for (int tt = 0; tt < 8; ++tt) uu[tt] = *(const u32x2*)(U + (size_t)(row0 + 16 * tt + l15) * 1024 + g * 128 + 16 * w + 4 * g4);
        __syncthreads();
        f32x4 acc[8];
#pragma unroll
        for (int tt = 0; tt < 8; ++tt) acc[tt] = (f32x4){0.f, 0.f, 0.f, 0.f};
#pragma unroll
        for (int kk = 0; kk < 4; ++kk) {
            const bf16x8 X = cat8(tr16(Vt + (32 * kk + 8 * g4 + q4) * TP + (16 * w + 4 * pp) * 2), tr16(Vt + (32 * kk + 8 * g4 + 4 + q4) * TP + (16 * w + 4 * pp) * 2));
#pragma unroll
            for (int tt = 0; tt < 8; ++tt) if (32 * kk <= 16 * tt + 15) {
                const bf16x8 Y = *(const LAS bf16x8*)(Wt + (16 * tt + l15) * TP + (32 * kk + 8 * g4) * 2);
                acc[tt] = MFMA16(X, Y, acc[tt]); }
        }
#pragma unroll
        for (int tt = 0; tt < 8; ++tt) { const int t = 16 * tt + l15, r = row0 + t, col = g * 128 + 16 * w + 4 * g4;
            const float bias = b_s[g * 128 + (smp ? (t & 3) : t)];
            const float o0 = bflo(uu[tt].x) * (acc[tt][0] + bias), o1 = bfhi(uu[tt].x) * (acc[tt][1] + bias), o2 = bflo(uu[tt].y) * (acc[tt][2] + bias), o3 = bfhi(uu[tt].y) * (acc[tt][3] + bias);
            *(u32x2*)(UM + (size_t)r * 1024 + col) = (u32x2){cvt_pk_bf16(o0, o1), cvt_pk_bf16(o2, o3)}; }
        __syncthreads();
    }
}

__device__ __forceinline__ void b2_kvfinal(const P& p, float* out_mp, float* out_ms) {
    const float* RAW = p.w<float>(WS_RAW); bf16* KVB = p.w<bf16>(WS_KVB); const long long* ssq_kv = p.stat(ST_KV); const float* kvn = p.in[19]; const f32x2* rope = p.w<f32x2>(WS_ROPE);
    const int gw = p.bid * NWAVES + p.wave, NGW = p.G * NWAVES, lane = p.lane;
    for (int m = gw; m < MT; m += NGW) {
        float* o = m < MP ? (out_mp ? out_mp + (size_t)m * 320 : nullptr) : (out_ms ? out_ms + (size_t)(m - MP) * 320 : nullptr);
        const float rs = rsqrtf(stat_get(ssq_kv + m) * (1.0f / 256.0f) + RMS_EPS);
        const f32x4 v = *(const f32x4*)(RAW + (size_t)m * 768 + 4 * lane) * rs * *(const f32x4*)(kvn + 4 * lane);
        if (o) *(f32x4*)(o + 4 * lane) = v;
        *(u32x2*)(KVB + (size_t)m * 320 + 4 * lane) = (u32x2){cvt_pk_bf16(v[0], v[1]), cvt_pk_bf16(v[2], v[3])};
        if (lane < 32) { const int tp = m < MP ? (m & 2047) : 2048 + ((m - MP) & 3); const f32x2 cs = rope[(size_t)tp * 32 + lane];
            const float x1 = RAW[(size_t)m * 768 + 640 + lane], x2 = RAW[(size_t)m * 768 + 672 + lane];
            const float o1 = x1 * cs.x - x2 * cs.y, o2 = x1 * cs.y + x2 * cs.x;
            if (o) { o[256 + lane] = o1; o[288 + lane] = o2; }
            KVB[(size_t)m * 320 + 256 + lane] = (bf16)f2bf(o1); KVB[(size_t)m * 320 + 288 + lane] = (bf16)f2bf(o2); }
    }
}

__device__ __forceinline__ void b3_attn_prompt(const P& p) {
    const bf16* QF = p.w<bf16>(WS_QF); const bf16* KVB = p.w<bf16>(WS_KVB); bf16* OB = p.w<bf16>(WS_OB);
    const int lane = p.lane, h = p.wave, l15 = lane & 15, g4 = lane >> 4, q4 = (lane & 15) >> 2, pp = lane & 3;
    constexpr int TILE_B = 64 * 640;
    int soff[5];
#pragma unroll
    for (int i = 0; i < 5; ++i) { const int P_ = (h + 8 * i) * 64 + lane, row = P_ / 40, cph = P_ - 40 * row; soff[i] = row * 320 + ((cph ^ (row & 6)) << 3); }
    int kaddr[10];
#pragma unroll
    for (int s_ = 0; s_ < 10; ++s_) kaddr[s_] = l15 * 640 + (((4 * s_ + g4) ^ (l15 & 6)) << 4);
    int taddr[4];
    { const int rl = 4 * g4 + q4, m_ = (rl & 6) >> 1;
#pragma unroll
      for (int v3 = 0; v3 < 4; ++v3) taddr[v3] = rl * 640 + (((v3 ^ m_) << 1 | (pp >> 1)) << 4) + 8 * (pp & 1); }
#define AT_DMA(BUF, SRC) do { _Pragma("unroll") for (int i = 0; i < 5; ++i) \
        __builtin_amdgcn_global_load_lds((const unsigned*)((SRC) + soff[i]), (LAS unsigned*)((BUF) + (h + 8 * i) * 1024), 16, 0, 0); } while (0)
    for (int pi = p.bid; pi < 512; pi += p.G) {
        const int b = (p.G % 8 == 0) ? (pi & 7) : (pi >> 6), x = (p.G % 8 == 0) ? ((pi >> 3) & 63) : (pi & 63);
        for (int half = 0; half < 2; ++half) {
            const int qt = half ? 127 - x : x, t0 = 16 * qt, nkt = (t0 + 15) / 64 + 1;
            const size_t rowq = (size_t)b * 2048 + t0 + l15; const bf16* kvb = KVB + (size_t)b * 2048 * 320;
            AT_DMA(p.lds, kvb);
            bf16x8 Q[10];
#pragma unroll
            for (int s = 0; s < 10; ++s) Q[s] = as_bf16x8(*(const u32x4*)(QF + rowq * 2560 + h * 320 + 32 * s + 8 * g4));
            f32x4 O[16];
#pragma unroll
            for (int vt = 0; vt < 16; ++vt) O[vt] = (f32x4){0.f, 0.f, 0.f, 0.f};
            float mrun = -1e30f, lrun = 0.f;
            asm volatile("s_waitcnt vmcnt(0)" ::: "memory"); __syncthreads();
            for (int kt = 0; kt < nkt; ++kt) {
                LAS unsigned char* buf = p.lds + (kt & 1) * TILE_B;
                if (kt + 1 < nkt) AT_DMA(p.lds + ((kt + 1) & 1) * TILE_B, kvb + (size_t)64 * (kt + 1) * 320);
                f32x4 S[4];
#pragma unroll
                for (int k4 = 0; k4 < 4; ++k4) S[k4] = (f32x4){0.f, 0.f, 0.f, 0.f};
                { bf16x8 Kc[4], Kn[4];
#pragma unroll
                  for (int k4 = 0; k4 < 4; ++k4) Kc[k4] = *(const LAS bf16x8*)(buf + kaddr[0] + k4 * 10240);
#pragma unroll
                  for (int s = 0; s < 10; ++s) {
                      if (s < 9) {
#pragma unroll
                          for (int k4 = 0; k4 < 4; ++k4) Kn[k4] = *(const LAS bf16x8*)(buf + kaddr[s + 1] + k4 * 10240); }
#pragma unroll
                      for (int k4 = 0; k4 < 4; ++k4) S[k4] = MFMA16(Kc[k4], Q[s], S[k4]);
#pragma unroll
                      for (int k4 = 0; k4 < 4; ++k4) Kc[k4] = Kn[k4]; } }
                float mx = -1e30f;
#pragma unroll
                for (int k4 = 0; k4 < 4; ++k4)
#pragma unroll
                    for (int e = 0; e < 4; ++e) { float v = S[k4][e] * LOG2E; if (kt == nkt - 1 && 64 * kt + 16 * k4 + 4 * g4 + e > t0 + l15) v = -1e30f; S[k4][e] = v; mx = fmaxf(mx, v); }
                mx = fmaxf(mx, __shfl_xor(mx, 16)); mx = fmaxf(mx, __shfl_xor(mx, 32));
                const float mnew = fmaxf(mrun, mx), alpha = __builtin_amdgcn_exp2f(mrun - mnew); mrun = mnew;
                float ps = 0.f;
#pragma unroll
                for (int k4 = 0; k4 < 4; ++k4)
#pragma unroll
                    for (int e = 0; e < 4; ++e) { const float pv = __builtin_amdgcn_exp2f(S[k4][e] - mnew); S[k4][e] = pv; ps += pv; }
                lrun = lrun * alpha + ps;
#pragma unroll
                for (int vt = 0; vt < 16; ++vt) O[vt] *= alpha;
                bf16x8 Pf[2];
#pragma unroll
                for (int ks = 0; ks < 2; ++ks) Pf[ks] = as_bf16x8((u32x4){cvt_pk_bf16(S[2 * ks][0], S[2 * ks][1]), cvt_pk_bf16(S[2 * ks][2], S[2 * ks][3]), cvt_pk_bf16(S[2 * ks + 1][0], S[2 * ks + 1][1]), cvt_pk_bf16(S[2 * ks + 1][2], S[2 * ks + 1][3])});
#define AT_V(VT, KS, T) tr16(buf + taddr[(VT) & 3] + ((VT) >> 2) * 128 + (32 * (KS) + 16 * (T)) * 640)
                { s16x4 Vc[4], Vn[4];
                  Vc[0] = AT_V(0, 0, 0); Vc[1] = AT_V(0, 0, 1); Vc[2] = AT_V(0, 1, 0); Vc[3] = AT_V(0, 1, 1);
#pragma unroll
                  for (int vt = 0; vt < 16; ++vt) {
                      if (vt < 15) { Vn[0] = AT_V(vt + 1, 0, 0); Vn[1] = AT_V(vt + 1, 0, 1); Vn[2] = AT_V(vt + 1, 1, 0); Vn[3] = AT_V(vt + 1, 1, 1); }
                      O[vt] = MFMA16(cat8(Vc[0], Vc[1]), Pf[0], O[vt]); O[vt] = MFMA16(cat8(Vc[2], Vc[3]), Pf[1], O[vt]);
#pragma unroll
                      for (int i = 0; i < 4; ++i) Vc[i] = Vn[i]; } }
#undef AT_V
                asm volatile("s_waitcnt vmcnt(0)" ::: "memory"); __syncthreads();
            }
            const float linv = 1.0f / quad_red(lrun);
#pragma unroll
            for (int vt = 0; vt < 16; ++vt) { const f32x4 o = O[vt] * linv;
                *(u32x2*)(OB + rowq * 2048 + h * 256 + 16 * vt + 4 * g4) = (u32x2){cvt_pk_bf16(o[0], o[1]), cvt_pk_bf16(o[2], o[3])}; }
        }
    }
#undef AT_DMA
}

__device__ __forceinline__ void b3_attn_sample(const P& p) {
    const bf16* QF = p.w<bf16>(WS_QF); float* PART = p.w<float>(WS_PART); float* PML = p.w<float>(WS_PML);
    const float* cache = p.in[2]; const int* ptab = (const int*)p.in[5];
    const int tid = p.tid, lane = p.lane, w = p.wave, qt = w & 1, dvq = w >> 1, l15 = lane & 15, g4 = lane >> 4, q4 = (lane & 15) >> 2, pp = lane & 3;
    constexpr int TILE_B = 64 * KP;
    for (int u = p.bid; u < 256; u += p.G) {
        const int b = u >> 3, sp = u & 7;
        const int hq = 4 * qt + (l15 >> 2), iq = l15 & 3; const size_t rowq = (size_t)MP + 4 * b + iq;
        bf16x8 Q[10];
#pragma unroll
        for (int s = 0; s < 10; ++s) Q[s] = as_bf16x8(*(const u32x4*)(QF + rowq * 2560 + hq * 320 + 32 * s + 8 * g4));
        f32x4 O[4];
#pragma unroll
        for (int v = 0; v < 4; ++v) O[v] = (f32x4){0.f, 0.f, 0.f, 0.f};
        float mrun = -1e30f, lrun = 0.f;
        f32x4 st[10];
        auto tile_src = [&](int ti) -> const float* { const int pg = 16 * sp + (ti >> 1); return cache + ((size_t)ptab[b * 128 + pg] * 128 + 64 * (ti & 1)) * 320; };
        { const float* src = tile_src(0);
#pragma unroll
          for (int q = 0; q < 10; ++q) st[q] = __builtin_nontemporal_load((const f32x4*)(src + (size_t)(tid + 512 * q) * 4));
          __syncthreads();
#pragma unroll
          for (int q = 0; q < 10; ++q) { const int ch = tid + 512 * q, row = ch / 80, c4 = ch % 80; *(LAS u32x2*)(p.lds + row * KP + c4 * 8) = (u32x2){cvt_pk_bf16(st[q][0], st[q][1]), cvt_pk_bf16(st[q][2], st[q][3])}; }
          __syncthreads(); }
        for (int ti = 0; ti < 32; ++ti) {
            LAS unsigned char* buf = p.lds + (ti & 1) * TILE_B;
            if (ti + 1 < 32) { const float* src = tile_src(ti + 1);
#pragma unroll
                for (int q = 0; q < 10; ++q) st[q] = __builtin_nontemporal_load((const f32x4*)(src + (size_t)(tid + 512 * q) * 4)); }
            f32x4 S[4];
#pragma unroll
            for (int k4 = 0; k4 < 4; ++k4) { S[k4] = (f32x4){0.f, 0.f, 0.f, 0.f};
#pragma unroll
                for (int s = 0; s < 10; ++s) { const bf16x8 Kf = *(const LAS bf16x8*)(buf + (16 * k4 + l15) * KP + (32 * s + 8 * g4) * 2); S[k4] = MFMA16(Kf, Q[s], S[k4]); } }
            float mx = -1e30f;
#pragma unroll
            for (int k4 = 0; k4 < 4; ++k4)
#pragma unroll
                for (int e = 0; e < 4; ++e) { const float v = S[k4][e] * LOG2E; S[k4][e] = v; mx = fmaxf(mx, v); }
            mx = fmaxf(mx, __shfl_xor(mx, 16)); mx = fmaxf(mx, __shfl_xor(mx, 32));
            const float mnew = fmaxf(mrun, mx), alpha = __builtin_amdgcn_exp2f(mrun - mnew); mrun = mnew;
            float ps = 0.f;
#pragma unroll
            for (int k4 = 0; k4 < 4; ++k4)
#pragma unroll
                for (int e = 0; e < 4; ++e) { const float pv = __builtin_amdgcn_exp2f(S[k4][e] - mnew); S[k4][e] = pv; ps += pv; }
            lrun = lrun * alpha + ps;
#pragma unroll
            for (int v = 0; v < 4; ++v) O[v] *= alpha;
            bf16x8 Pf[2];
#pragma unroll
            for (int ks = 0; ks < 2; ++ks) Pf[ks] = as_bf16x8((u32x4){cvt_pk_bf16(S[2 * ks][0], S[2 * ks][1]), cvt_pk_bf16(S[2 * ks][2], S[2 * ks][3]), cvt_pk_bf16(S[2 * ks + 1][0], S[2 * ks + 1][1]), cvt_pk_bf16(S[2 * ks + 1][2], S[2 * ks + 1][3])});
#pragma unroll
            for (int v = 0; v < 4; ++v) { const int vt = 4 * dvq + v;
#pragma unroll
                for (int ks = 0; ks < 2; ++ks) {
                    const bf16x8 Vf = cat8(tr16(buf + (32 * ks + 4 * g4 + q4) * KP + (16 * vt + 4 * pp) * 2), tr16(buf + (32 * ks + 16 + 4 * g4 + q4) * KP + (16 * vt + 4 * pp) * 2));
                    O[v] = MFMA16(Vf, Pf[ks], O[v]); } }
            if (ti + 1 < 32) { LAS unsigned char* nb = p.lds + ((ti + 1) & 1) * TILE_B;
#pragma unroll
                for (int q = 0; q < 10; ++q) { const int ch = tid + 512 * q, row = ch / 80, c4 = ch % 80; *(LAS u32x2*)(nb + row * KP + c4 * 8) = (u32x2){cvt_pk_bf16(st[q][0], st[q][1]), cvt_pk_bf16(st[q][2], st[q][3])}; } }
            __syncthreads();
        }
        const float lsum = quad_red(lrun); const int qrow = 16 * qt + l15; const size_t pb = ((size_t)(b * 8 + sp) * 32 + qrow);
#pragma unroll
        for (int v = 0; v < 4; ++v) *(f32x4*)(PART + pb * 256 + 16 * (4 * dvq + v) + 4 * g4) = O[v];
        if (dvq == 0 && g4 == 0) { PML[pb * 2] = mrun; PML[pb * 2 + 1] = lsum; }
    }
}
__device__ __forceinline__ void b3_combine(const P& p) {
    const bf16* QF = p.w<bf16>(WS_QF); const bf16* KVB = p.w<bf16>(WS_KVB); bf16* OB = p.w<bf16>(WS_OB); const float* PART = p.w<float>(WS_PART); const float* PML = p.w<float>(WS_PML);
    const int dv = p.tid & 255, sub = p.tid >> 8;
    for (int it = 2 * p.bid + sub; it < 1024; it += 2 * p.G) {
        const int b = it >> 5, i = (it >> 3) & 3, h = it & 7, qt = h >> 2, ql = ((h & 3) << 2) | i, qrow = 16 * qt + ql; const size_t row = (size_t)MP + 4 * b + i;
        float sn[4];
#pragma unroll
        for (int kk = 0; kk < 4; ++kk) { float s = 0.f;
            if (kk <= i) { const unsigned* qp = (const unsigned*)(QF + row * 2560 + h * 320); const unsigned* kp = (const unsigned*)(KVB + ((size_t)MP + 4 * b + kk) * 320);
                for (int d = 0; d < 160; ++d) { const unsigned a = qp[d], c = kp[d]; s += bflo(a) * bflo(c) + bfhi(a) * bfhi(c); } }
            sn[kk] = (kk <= i) ? s * LOG2E : -1e30f; }
        float M = fmaxf(fmaxf(sn[0], sn[1]), fmaxf(sn[2], sn[3])); float ms[8], ls[8];
#pragma unroll
        for (int sp = 0; sp < 8; ++sp) { const size_t pb = ((size_t)(b * 8 + sp) * 32 + qrow); ms[sp] = PML[pb * 2]; ls[sp] = PML[pb * 2 + 1]; M = fmaxf(M, ms[sp]); }
        float L = 0.f, Oa = 0.f;
#pragma unroll
        for (int sp = 0; sp < 8; ++sp) { const size_t pb = ((size_t)(b * 8 + sp) * 32 + qrow); const float wgt = __builtin_amdgcn_exp2f(ms[sp] - M); L += ls[sp] * wgt; Oa += PART[pb * 256 + dv] * wgt; }
#pragma unroll
        for (int kk = 0; kk < 4; ++kk) { const float pk = __builtin_amdgcn_exp2f(sn[kk] - M); L += pk; Oa += pk * bf2f(KVB[((size_t)MP + 4 * b + kk) * 320 + dv]); }
        OB[row * 2048 + h * 256 + dv] = (bf16)f2bf(Oa / L);
    }
}

template <bool SMP>
__device__ __forceinline__ f32x4 conv4(const float* XW, const float* cbuf  , const float* cw, const float* cb, int m, int c) {
    f32x4 acc = *(const f32x4*)(cb + c);
    f32x4 v[4], wv[4];
#pragma unroll
    for (int k = 0; k < 4; ++k) { wv[k] = *(const f32x4*)(cw + k * 1280 + c);
        if (!SMP) { const int t = m & 2047, r = t + k - 3; v[k] = *(const f32x4*)(XW + (size_t)(m + (r >= 0 ? k - 3 : -t)) * 1280 + c); if (r < 0) wv[k] = (f32x4){0.f, 0.f, 0.f, 0.f}; }
        else { const int b = (m - MP) >> 2, t = (m - MP) & 3, r = t + k - 3; const float* ptr = (r >= 0) ? XW + (size_t)(m + k - 3) * 1280 + c : cbuf + ((size_t)b * 3 + (3 + r)) * 1280 + c; v[k] = *(const f32x4*)ptr; } }
#pragma unroll
    for (int k = 0; k < 4; ++k) acc += wv[k] * v[k];
    return acc;
}
__device__ __forceinline__ void c2_rglru(const P& p, int j, float* out_cp, float* out_cs, float* out_hs, const int mask) {
    const float* XW = p.w<float>(WS_XW); bf16* LH = p.w<bf16>(WS_AA); bf16* CPB = p.w<bf16>(WS_BB); float* AGG = p.w<float>(WS_AGG);
    const float* cbuf = p.in[4] + (size_t)j * 32 * 3 * 1280; const float* cw = p.in[25] + (size_t)j * 4 * 1280; const float* cb = p.in[26] + j * 1280;
    const float* b_a = p.in[28] + j * 1280; const float* b_i = p.in[30] + j * 1280; const float* lam = p.in[31] + j * 1280; const float* h0s = p.in[3] + (size_t)j * 32 * 1280;
    const bf16* WaT = p.w<bf16>(WS_WAT); const bf16* WiT = p.w<bf16>(WS_WIT);
    LAS unsigned char* Xt = p.lds; LAS unsigned char* At = p.lds + 128 * TP; LAS unsigned char* It = p.lds + 256 * TP;
    LAS float* LA = (LAS float*)p.lds;
    LAS unsigned char* LB = p.lds + 128 * 528;
    LAS float* QT = (LAS float*)(p.lds + 128 * 528 + 128 * TP);
    const int tid = p.tid, lane = p.lane, w = p.wave, l15 = lane & 15, g4 = lane >> 4;
    { const int gt = p.bid * 512 + tid, NGT = p.G * 512;
      for (int i = gt; i < (8 + 32) * 3 * 320; i += NGT) { const int c = (i % 320) * 4, rr = i / 320, jj = rr % 3, bb = rr / 3;
          if (bb < 8) { if (out_cp) *(f32x4*)(out_cp + ((size_t)bb * 3 + jj) * 1280 + c) = *(const f32x4*)(XW + ((size_t)bb * 2048 + 2045 + jj) * 1280 + c); }
          else { const int b = bb - 8; if (out_cs) *(f32x4*)(out_cs + ((size_t)b * 3 + jj) * 1280 + c) = *(const f32x4*)(XW + ((size_t)MP + 4 * b + 1 + jj) * 1280 + c); } } }
    for (int u = p.bid; u < 129 * 10; u += p.G) {
        const int T = u / 10, n = u % 10, row0 = T * 128;
        if (mask & 4096) {
            const int c16 = tid & 15, cch = n * 128 + c16 * 8;
            f32x4 wv[4][2], bv[2];
#pragma unroll
            for (int k = 0; k < 4; ++k) { wv[k][0] = *(const f32x4*)(cw + k * 1280 + cch); wv[k][1] = *(const f32x4*)(cw + k * 1280 + cch + 4); }
            bv[0] = *(const f32x4*)(cb + cch); bv[1] = *(const f32x4*)(cb + cch + 4);
            u32x4 wa[4], wi[4];
#pragma unroll
            for (int q = 0; q < 4; ++q) { const int row = (tid >> 4) + 32 * q; wa[q] = *(const u32x4*)(WaT + (size_t)n * 16384 + row * 128 + c16 * 8); wi[q] = *(const u32x4*)(WiT + (size_t)n * 16384 + row * 128 + c16 * 8); }
#pragma unroll
            for (int qh = 0; qh < 2; ++qh) {
                f32x4 xv[2][4][2];
#pragma unroll
                for (int qq = 0; qq < 2; ++qq) { const int m = row0 + (tid >> 4) + 32 * (2 * qh + qq);
#pragma unroll
                    for (int k = 0; k < 4; ++k) { const float* ptr;
                        if (T < 128) { const int t = m & 2047, r = t + k - 3; ptr = XW + (size_t)(m + (r >= 0 ? k - 3 : -t)) * 1280 + cch; }
                        else { const int b = (m - MP) >> 2, t = (m - MP) & 3, r = t + k - 3; ptr = (r >= 0) ? XW + (size_t)(m + k - 3) * 1280 + cch : cbuf + ((size_t)b * 3 + (3 + r)) * 1280 + cch; }
                        xv[qq][k][0] = *(const f32x4*)ptr; xv[qq][k][1] = *(const f32x4*)(ptr + 4); } }
#pragma unroll
                for (int qq = 0; qq < 2; ++qq) { const int row = (tid >> 4) + 32 * (2 * qh + qq), m = row0 + row; f32x4 v0 = bv[0], v1 = bv[1];
#pragma unroll
                    for (int k = 0; k < 4; ++k) { const bool live = (T >= 128) || (((m & 2047) + k - 3) >= 0); const f32x4 z = (f32x4){0.f, 0.f, 0.f, 0.f};
                        v0 += (live ? wv[k][0] : z) * xv[qq][k][0]; v1 += (live ? wv[k][1] : z) * xv[qq][k][1]; }
                    *(LAS u32x4*)(Xt + row * TP + c16 * 16) = pack8(v0, v1); } }
#pragma unroll
            for (int q = 0; q < 4; ++q) { const int row = (tid >> 4) + 32 * q; *(LAS u32x4*)(At + row * TP + c16 * 16) = wa[q]; *(LAS u32x4*)(It + row * TP + c16 * 16) = wi[q]; }
        }
        __syncthreads();
        f32x4 ca[8], ci[8];
#pragma unroll
        for (int tt = 0; tt < 8; ++tt) { ca[tt] = (f32x4){0.f, 0.f, 0.f, 0.f}; ci[tt] = (f32x4){0.f, 0.f, 0.f, 0.f}; }
        if (mask & 8192) {
#pragma unroll
        for (int kk = 0; kk < 4; ++kk) {
            const bf16x8 Xa = *(const LAS bf16x8*)(At + (16 * w + l15) * TP + (32 * kk + 8 * g4) * 2), Xi = *(const LAS bf16x8*)(It + (16 * w + l15) * TP + (32 * kk + 8 * g4) * 2);
#pragma unroll
            for (int tt = 0; tt < 8; ++tt) { const bf16x8 Y = *(const LAS bf16x8*)(Xt + (16 * tt + l15) * TP + (32 * kk + 8 * g4) * 2);
                ca[tt] = MFMA16(Xa, Y, ca[tt]); ci[tt] = MFMA16(Xi, Y, ci[tt]); }
        }
        const int chn = n * 128 + 16 * w + 4 * g4;
        { const f32x4 ba = *(const f32x4*)(b_a + chn), bi = *(const f32x4*)(b_i + chn), lm = *(const f32x4*)(lam + chn);
          f32x4 sp;
#pragma unroll
          for (int e = 0; e < 4; ++e) { const float nl = -lm[e]; sp[e] = -8.0f * LOG2E * ((nl > 20.f) ? nl : log1pf(expf(nl))); }
#pragma unroll
          for (int tt = 0; tt < 8; ++tt) { const u32x2 xb = *(const LAS u32x2*)(Xt + (16 * tt + l15) * TP + (16 * w + 4 * g4) * 2);
              const f32x4 xc = (f32x4){bflo(xb.x), bfhi(xb.x), bflo(xb.y), bfhi(xb.y)};
#pragma unroll
              for (int e = 0; e < 4; ++e) { const float r = fast_sigmoid_l2(LOG2E * (ca[tt][e] + ba[e])), gi = fast_sigmoid_l2(LOG2E * (ci[tt][e] + bi[e]));
                  const float a = __builtin_amdgcn_exp2f(r * sp[e]);
                  ca[tt][e] = a; ci[tt][e] = __builtin_amdgcn_sqrtf(fmaxf(__builtin_fmaf(-a, a, 1.0f), 0.f)) * gi * xc[e]; } } }
        }
        __syncthreads();
#pragma unroll
        for (int tt = 0; tt < 8; ++tt) { const int tok = 16 * tt + l15;
            *(LAS f32x4*)(LA + tok * 132 + 16 * w + 4 * g4) = ca[tt];
            *(LAS u32x2*)(LB + tok * TP + (16 * w + 4 * g4) * 2) = (u32x2){cvt_pk_bf16(ci[tt][0], ci[tt][1]), cvt_pk_bf16(ci[tt][2], ci[tt][3])}; }
        __syncthreads();
        const int ch = tid & 127, q = tid >> 7, chg = n * 128 + ch;
        if (mask & 16384) {
        if (T < 128) {
            float P_ = 1.f, H_ = 0.f;
#pragma unroll 8
            for (int t = 32 * q; t < 32 * q + 32; ++t) { const float a = LA[t * 132 + ch], b = bf2f(*(const LAS bf16*)(LB + t * TP + ch * 2)); H_ = a * H_ + b; P_ *= a; }
            QT[(q * 128 + ch) * 2] = P_; QT[(q * 128 + ch) * 2 + 1] = H_;
            __syncthreads();
            float h = 0.f, pc = 1.f;
#pragma unroll
            for (int qq = 0; qq < 3; ++qq) if (qq < q) { const float Pq = QT[(qq * 128 + ch) * 2], Hq = QT[(qq * 128 + ch) * 2 + 1]; h = Pq * h + Hq; pc *= Pq; }
#pragma unroll 8
            for (int t = 32 * q; t < 32 * q + 32; ++t) { const float a = LA[t * 132 + ch], b = bf2f(*(const LAS bf16*)(LB + t * TP + ch * 2)); h = a * h + b; pc *= a;
                LA[t * 132 + ch] = pc; *(LAS bf16*)(LB + t * TP + ch * 2) = (bf16)f2bf(h); }
            if (q == 3) { AGG[((size_t)T * 2) * 1280 + chg] = pc; AGG[((size_t)T * 2 + 1) * 1280 + chg] = h; }
        } else {
            for (int bb = 8 * q; bb < 8 * q + 8; ++bb) { float h = h0s[(size_t)bb * 1280 + chg];
#pragma unroll
                for (int i = 0; i < 4; ++i) { const int t = 4 * bb + i; const float a = LA[t * 132 + ch], b = bf2f(*(const LAS bf16*)(LB + t * TP + ch * 2)); h = a * h + b;
                    LA[t * 132 + ch] = 0.f; *(LAS bf16*)(LB + t * TP + ch * 2) = (bf16)f2bf(h); }
                if (out_hs) out_hs[(size_t)bb * 1280 + chg] = h; }
        }
        }
        __syncthreads();
        if (mask & 32768)
#pragma unroll
        for (int i = 0; i < 4; ++i) { const int cidx = tid + 512 * i, tok = cidx >> 4, c8 = (cidx & 15) * 8; const size_t o = (size_t)(row0 + tok) * 1280 + n * 128 + c8;
            *(u32x4*)(LH + o) = *(const LAS u32x4*)(LB + tok * TP + c8 * 2);
            *(u32x4*)(CPB + o) = pack8(*(const LAS f32x4*)(LA + tok * 132 + c8), *(const LAS f32x4*)(LA + tok * 132 + c8 + 4)); }
        __syncthreads();
    }
}
__device__ __forceinline__ void c5_fixup(const P& p, float* out_hp) {
    const bf16* LH = p.w<bf16>(WS_AA); const bf16* CPB = p.w<bf16>(WS_BB); const float* AGG = p.w<float>(WS_AGG); const bf16* GATE = p.w<bf16>(WS_GATE); bf16* GH = p.w<bf16>(WS_GH);
    LAS float* cr = (LAS float*)p.lds;
    const int tid = p.tid;
    for (int it = p.bid; it < 258; it += p.G) {
        const int T = it >> 1, hf = it & 1, row0 = T * 128 + 64 * hf, T0 = T & ~15;
        for (int ch = tid; ch < 1280; ch += 512) { float c = 0.f;
            if (T < 128) {
#pragma unroll
                for (int d = 0; d < 15; ++d) if (T0 + d < T) c = AGG[((size_t)(T0 + d) * 2) * 1280 + ch] * c + AGG[((size_t)(T0 + d) * 2 + 1) * 1280 + ch];
                if ((T & 15) == 15 && hf == 1 && out_hp) out_hp[(size_t)(T >> 4) * 1280 + ch] = AGG[((size_t)T * 2) * 1280 + ch] * c + AGG[((size_t)T * 2 + 1) * 1280 + ch]; }
            cr[ch] = c; }
        __syncthreads();
#pragma unroll 4
        for (int i = 0; i < 20; ++i) { const int cidx = tid + 512 * i, tok = cidx / 160, c8 = (cidx % 160) * 8; const size_t o = (size_t)(row0 + tok) * 1280 + c8;
            const u32x4 lh = *(const u32x4*)(LH + o), cp = *(const u32x4*)(CPB + o), gt = *(const u32x4*)(GATE + o);
            const f32x4 c0 = *(const LAS f32x4*)(cr + c8), c1 = *(const LAS f32x4*)(cr + c8 + 4);
            f32x4 r0, r1;
            r0[0] = bflo(gt.x) * (bflo(lh.x) + bflo(cp.x) * c0[0]); r0[1] = bfhi(gt.x) * (bfhi(lh.x) + bfhi(cp.x) * c0[1]);
            r0[2] = bflo(gt.y) * (bflo(lh.y) + bflo(cp.y) * c0[2]); r0[3] = bfhi(gt.y) * (bfhi(lh.y) + bfhi(cp.y) * c0[3]);
            r1[0] = bflo(gt.z) * (bflo(lh.z) + bflo(cp.z) * c1[0]); r1[1] = bfhi(gt.z) * (bfhi(lh.z) + bfhi(cp.z) * c1[1]);
            r1[2] = bflo(gt.w) * (bflo(lh.w) + bflo(cp.w) * c1[2]); r1[3] = bfhi(gt.w) * (bfhi(lh.w) + bfhi(cp.w) * c1[3]);
            *(u32x4*)(GH + o) = pack8(r0, r1); }
        __syncthreads();
    }
}
__device__ __forceinline__ void final_norm(const P& p, float* out_yp, float* out_ys) {
    const bf16* HB = p.w<bf16>(WS_HB); const long long* ssq = p.stat(ST_SSQ0 + 8); const float* g = p.in[8];
    const int gw = p.bid * NWAVES + p.wave, NGW = p.G * NWAVES, lane = p.lane;
    for (int m = gw; m < MT; m += NGW) { float* o = m < MP ? out_yp + (size_t)m * 1024 : out_ys + (size_t)(m - MP) * 1024; const float rs = rsqrtf(stat_get(ssq + m) * (1.0f / 1024.0f) + RMS_EPS);
#pragma unroll
        for (int jj = 0; jj < 4; ++jj) { const int c = 4 * lane + 256 * jj; const u32x2 hw = *(const u32x2*)(HB + (size_t)m * 1024 + c);
            *(f32x4*)(o + c) = (f32x4){bflo(hw.x), bfhi(hw.x), bflo(hw.y), bfhi(hw.y)} * rs * *(const f32x4*)(g + c); } }
}
}
namespace mk {
struct Args { const float* in[36]; float* out; unsigned char* ws; int ph_lo, ph_hi, li, mask; };
constexpr int NPHASE = 34;

#define MK_GEMM(EpiT, E, Aptr, LDA, Bptr, LDB, KD, NC) do { pg8::Gemm g_{(const pg8::bf16_t*)(Aptr), (const pg8::bf16_t*)(Bptr), (LDA), (LDB), (KD)}; pg8::StaticOrder S_; S_.init(MP, (NC), p.G, p.bid); \
        pg8::gemm_phase<EpiT, pg8::StaticOrder, true, true>(p.lds, g_, S_, E, p.tid); \
          \
        P q_ = p; { int t2_ = p0.tid; asm volatile("" : "+v"(t2_)); q_.tid = t2_; q_.lane = t2_ & 63; q_.wave = __builtin_amdgcn_readfirstlane(t2_ >> 6); } \
        mini_gemm<EpiT>(q_, (const bf16*)(Aptr), (LDA), (const bf16*)(Bptr), (LDB), (KD), (NC), E, (64 * ((NC) / 256)) % p.G); } while (0)

#ifdef MK_DRYPROBE
#define MK_DRYARG , ((mask >> 10) & 3)
#else
#define MK_DRYARG
#endif
#ifndef MK_REP_SEL
#define MK_REP_SEL(k) 0
#define MK_REP_N 1
#endif
#define REPF(k) for (int rep_ = 0; rep_ < (MK_REP_SEL(k) ? MK_REP_N : 1); ++rep_)
#define IN_(k) (lo <= (k) && (k) < hi)
#define PH_BEGIN() P p = p0; { int z_ = 0, t_ = p0.tid, g_ = p0.G, b_ = p0.bid; unsigned l_ = (unsigned)(size_t)p0.lds; asm volatile("" : "+s"(z_), "+v"(t_), "+s"(g_), "+s"(b_), "+s"(l_)); p.ws = p0.ws + z_; p.out = p0.out + z_; p.tid = t_; p.lane = t_ & 63; p.wave = __builtin_amdgcn_readfirstlane(t_ >> 6); p.G = g_; p.bid = b_; p.lds = (LAS unsigned char*)(size_t)l_; } float* const out = p.out; (void)out
#ifdef MK_PROF
#define STAMP(k) do { if (p0.bid == 0 && p0.tid == 0) ((unsigned long long*)(p0.ws + WS_PROF))[(k)] = (unsigned long long)wall_clock64(); } while (0)
#else
#define STAMP(k) do { } while (0)
#endif
#define ENDPH(k) do { if ((k) + 1 < hi) xcd_barrier(bar); STAMP((k) + 1); } while (0)
template <int LAYER> __device__ __forceinline__ void run_layer(const P& p0, const XcdBarrier& bar, const int lo, const int hi, const int mask) {
        constexpr int layer = LAYER, kind = layer % 3, j = layer / 3, pb = 1 + 8 * layer;
        constexpr size_t resA = kind == 0 ? WS_UM : kind == 1 ? WS_OB : WS_GH, resB = kind == 0 ? WS_WOUT + (size_t)j * 2 * MiB : kind == 1 ? WS_WOV : WS_WCO; constexpr int resK = kind == 0 ? 1024 : kind == 1 ? 2048 : 1280;
        if constexpr (kind == 0) {
            if (IN_(pb)) REPF(pb) { PH_BEGIN(); EpiA1 E{p.w<bf16>(WS_U), p.w<bf16>(WS_GV), p.stat(ST_SSQ0 + 2 * layer), p.stat(ST_LNS0 + 2 * j), p.stat(ST_LNQ0 + 2 * j) MK_DRYARG};
                MK_GEMM(EpiA1, E, p.w<bf16>(WS_HB), 1024, p.w<bf16>(WS_WIN + (size_t)j * 4 * MiB), 1024, 1024, 2048); ENDPH(pb); }
            if (IN_(pb + 1)) REPF(pb + 1) { PH_BEGIN(); a2_spatial(p, j, out + O_CV + (size_t)j * 131072); ENDPH(pb + 1); }
        } else if constexpr (kind == 1) {
            if (IN_(pb)) REPF(pb) { PH_BEGIN(); EpiB1 E{p.w<float>(WS_RAW), p.w<bf16>(WS_CQB), p.stat(ST_SSQ0 + 2 * layer), p.stat(ST_KV), p.stat(ST_Q) MK_DRYARG};
                MK_GEMM(EpiB1, E, p.w<bf16>(WS_HB), 1024, p.w<bf16>(WS_WDQKV), 1024, 1024, 768); ENDPH(pb); }
            if (IN_(pb + 1)) REPF(pb + 1) { PH_BEGIN(); b2_kvfinal(p, out + O_MP, out + O_MS);
                EpiB2 E{p.w<bf16>(WS_QF), p.stat(ST_Q), p.w<f32x2>(WS_ROPE)};
                MK_GEMM(EpiB2, E, p.w<bf16>(WS_CQB), 384, p.w<bf16>(WS_WQ), 384, 384, 2560); ENDPH(pb + 1); }
            if (IN_(pb + 2)) REPF(pb + 2) { PH_BEGIN();
                if (mask & 256) b3_attn_prompt(p); if (mask & 512) b3_attn_sample(p);
                ENDPH(pb + 2); }
            if (IN_(pb + 3)) REPF(pb + 3) { PH_BEGIN(); b3_combine(p); ENDPH(pb + 3); }
        } else {
            if (IN_(pb)) REPF(pb) { PH_BEGIN(); EpiC1 E{p.w<bf16>(WS_GATE), p.w<float>(WS_XW), p.stat(ST_SSQ0 + 2 * layer)};
                MK_GEMM(EpiC1, E, p.w<bf16>(WS_HB), 1024, p.w<bf16>(WS_WGX), 1024, 1024, 2560); ENDPH(pb); }
            if (IN_(pb + 1)) REPF(pb + 1) { PH_BEGIN(); c2_rglru(p, j, out + O_CP, out + O_CS, out + O_HS, mask); ENDPH(pb + 1); }
            if (IN_(pb + 3)) REPF(pb + 3) { PH_BEGIN(); c5_fixup(p, out + O_HP); ENDPH(pb + 3); }
        }
        if (IN_(pb + 5)) REPF(pb + 5) { PH_BEGIN(); EpiRes E{p.w<bf16>(WS_HB), p.stat(ST_SSQ0 + 2 * layer + 1) MK_DRYARG}; MK_GEMM(EpiRes, E, p.w<bf16>(resA), resK, p.w<bf16>(resB), resK, resK, 1024); ENDPH(pb + 5); }
        if (IN_(pb + 6)) REPF(pb + 6) { PH_BEGIN(); EpiF1 E{p.w<bf16>(WS_ACT), p.stat(ST_SSQ0 + 2 * layer + 1)}; MK_GEMM(EpiF1, E, p.w<bf16>(WS_HB), 1024, p.w<bf16>(WS_WGU + (size_t)layer * WGU_BYTES), 1024, 1024, 5632); ENDPH(pb + 6); }
        if (IN_(pb + 7)) REPF(pb + 7) { PH_BEGIN(); EpiRes E{p.w<bf16>(WS_HB), p.stat(ST_SSQ0 + 2 * layer + 2) MK_DRYARG}; MK_GEMM(EpiRes, E, p.w<bf16>(WS_ACT), DFF, p.w<bf16>(WS_WD + (size_t)layer * WD_BYTES), DFF, DFF, 1024); ENDPH(pb + 7); }
}
__global__ void __launch_bounds__(NWAVES * 64, 2) mk_fwd(Args a) {
    extern __shared__ __attribute__((aligned(16))) unsigned char lds_raw[];
    const int tid_ = threadIdx.x;
    const P p0{InTab{(const float* const __attribute__((address_space(4)))*)__builtin_amdgcn_kernarg_segment_ptr()}, a.out, a.ws, (LAS unsigned char*)lds_raw, tid_, tid_ & 63, __builtin_amdgcn_readfirstlane(tid_ >> 6), (int)gridDim.x, (int)blockIdx.x};
    volatile LAS unsigned* MISC = (volatile LAS unsigned*)(p0.lds + MISC_OFF);
    if (p0.tid < 64) MISC[p0.tid] = 0u;
    __syncthreads();
    XcdBarrier bar = xcd_barrier_post((unsigned*)(a.ws + WS_CTL) + CW_BAR + a.li * XCD_BAR_WORDS, MISC + 8);
    const int lo = a.ph_lo, hi = a.ph_hi, mask = a.mask;
    STAMP(0);
    if (IN_(0)) REPF(0) { PH_BEGIN(); p0_prologue(p, mask); if (mask & 128)
        { const int gt = p.bid * 512 + p.tid, NGT = p.G * 512; const u32x4 z = (u32x4){0u, 0u, 0u, 0u};
          for (int i = gt; i < 128 * 128; i += NGT) p.w<u32x4>(WS_UM + (size_t)MT * 2048)[i] = z;
          for (int i = gt; i < 128 * 256; i += NGT) p.w<u32x4>(WS_OB + (size_t)MT * 4096)[i] = z;
          for (int i = gt; i < 128 * 160; i += NGT) p.w<u32x4>(WS_GH + (size_t)MT * 2560)[i] = z; }
        ENDPH(0); }
    run_layer<0>(p0, bar, lo, hi, mask); run_layer<1>(p0, bar, lo, hi, mask); run_layer<2>(p0, bar, lo, hi, mask); run_layer<3>(p0, bar, lo, hi, mask);
    if (IN_(33)) REPF(33) { PH_BEGIN(); final_norm(p, out + O_YP, out + O_YS); VM_WAIT(); STAMP(34); }
#undef IN_
#undef ENDPH
}

inline void fill_args(Args& a, void* const* d_in, float* out, void* d_ws) { for (int i = 0; i < 36; ++i) a.in[i] = (const float*)d_in[i]; a.out = out; a.ws = (unsigned char*)d_ws; a.mask = -1; }
inline int setup_grid() {
    static int grid = 0;
    if (!grid) { int dev = 0, cus = 0; hipGetDevice(&dev); hipDeviceGetAttribute(&cus, hipDeviceAttributeMultiprocessorCount, dev);
        hipFuncSetAttribute((const void*)mk_fwd, hipFuncAttributeMaxDynamicSharedMemorySize, LDS_BYTES);
        int per_cu = 0; hipOccupancyMaxActiveBlocksPerMultiprocessor(&per_cu, (const void*)mk_fwd, NWAVES * 64, LDS_BYTES); (void)hipGetLastError();
        grid = cus > 0 ? cus : 256; }
    return grid;
}
inline void launch_range(void* const* d_in, float* out, void* d_ws, hipStream_t st, int lo, int hi, int li, int mask = -1) {
    Args a{}; fill_args(a, d_in, out, d_ws); a.ph_lo = lo; a.ph_hi = hi; a.li = li; a.mask = mask;
    hipLaunchKernelGGL(mk_fwd, dim3(setup_grid()), dim3(NWAVES * 64), LDS_BYTES, st, a);
}
}

extern "C" void kernel_launch(void* const* d_in, const int* in_sizes, int n_in, void* d_out, int out_size, void* d_ws, size_t ws_size, hipStream_t stream) {
    hipMemsetAsync(d_ws, 0, mk::CTL_BYTES, stream);
    mk::launch_range(d_in, (float*)d_out, d_ws, stream, 0, mk::NPHASE, 0);
}
```

```cpp
#include <hip/hip_runtime.h>
#include <math.h>
#define LAS __attribute__((address_space(3)))
#define GAS __attribute__((address_space(1)))
namespace pg8 {
#define PG8_LAS __attribute__((address_space(3)))
typedef unsigned short bf16_t;
typedef short bf16x8 __attribute__((ext_vector_type(8)));
typedef float f32x4 __attribute__((ext_vector_type(4)));
typedef unsigned u32x4 __attribute__((ext_vector_type(4)));
constexpr int BM = 256, BK = 64, HALF = 128, HTB = HALF * BK * 2  , STAGE_BYTES = 8 * HTB, NXCD = 8, WGM = 8;
__host__ __device__ __forceinline__ int lds_byte(int r, int c) { const int st = (r >> 4) * 2 + (c >> 5), rr = r & 15, cc = c & 31, ob = rr * 64 + cc * 2; return st * 1024 + (ob ^ (((ob >> 9) & 1) << 5)); }
__host__ __device__ __forceinline__ void stage_rc(int b, int& R, int& C) { const int st = b / 1024, sb = b % 1024, swz = sb ^ (((sb >> 9) & 1) << 5); R = (st >> 1) * 16 + swz / 64; C = (st & 1) * 32 + (swz % 64) / 2; }
__host__ __device__ __forceinline__ int perm32(int rho) { const int n = rho >> 4, i = rho & 15; return 8 * (i >> 2) + 4 * n + (i & 3); }
struct Unit { int pm, pn; };
struct Gemm { const bf16_t* A; const bf16_t* Bt; int lda, ldb, K; };
struct StaticOrder {
    int nM, nN, nwg, G, c;
    __host__ __device__ void init(int M, int N, int G_, int c_) { nM = M / BM; nN = N / BM; nwg = nM * nN; G = G_; c = c_; }
    __host__ __device__ bool next(int i, Unit& u) const {
        const long L = (long)i * G + c; if (L >= nwg) return false;
        int wgid = (int)L; { const int q = nwg / NXCD, r = nwg % NXCD, xcd = wgid % NXCD, off = wgid / NXCD; wgid = (xcd < r ? xcd * (q + 1) : r * (q + 1) + (xcd - r) * q) + off; }
        const int nig = WGM * nN, gid = wgid / nig, fm = gid * WGM, gsz = (nM - fm) < WGM ? (nM - fm) : WGM;
        u.pm = fm + ((wgid % nig) % gsz); u.pn = (wgid % nig) / gsz; return true;
    }
    __device__ __forceinline__ void a_ready(const Unit&) const {}
    __device__ __forceinline__ void done(const Unit&) const {}
};
__device__ __forceinline__ unsigned cvt_pk_bf16(float lo, float hi) { unsigned r; asm volatile("v_cvt_pk_bf16_f32 %0, %1, %2" : "=v"(r) : "v"(lo), "v"(hi)); return r; }
template <class Epi, class Sched, bool ALIGN_EPI = false, bool SP2 = false>
__device__ __forceinline__ void gemm_phase(PG8_LAS unsigned char* lds, const Gemm g, const Sched& S, const Epi& E, const int tid) {
    const int wid = __builtin_amdgcn_readfirstlane(tid >> 6), lane = tid & 63, wr = wid >> 2, wc = wid & 3, fr = lane & 15, fq = lane >> 4;
    const int K = g.K, nt = K / BK, lda = g.lda, ldb = g.ldb;
    unsigned voffA[2], voffB[2];
#pragma unroll
    for (int i = 0; i < 2; ++i) { int R, C; stage_rc(tid * 16 + i * 8192, R, C); const int Rb = Epi::PERM ? ((R & ~31) + perm32(R & 31)) : R;
        voffA[i] = (unsigned)(R * lda + C) * 2u; voffB[i] = (unsigned)(Rb * ldb + C) * 2u; }
    const size_t kstep = (size_t)(BK * 2);
    const size_t hstepA = (size_t)HALF * lda * 2, hstepB = (size_t)HALF * ldb * 2;
    const size_t tstepA = 2 * hstepA, tstepB = 2 * hstepB;
    const unsigned ldsw = (unsigned)wid * 1024u;
    const int aoff = lds_byte(wr * 64 + fr, fq * 8), boff = lds_byte(wc * 32 + fr, fq * 8);
#define PG8_SA(b, h) (((b) * 2 + (h)) * HTB)
#define PG8_SB(b, h) ((4 + (b) * 2 + (h)) * HTB)
#define PG8_STAGE(bufoff, gbase, voff) do { _Pragma("unroll") for (int _i = 0; _i < 2; ++_i) \
        __builtin_amdgcn_global_load_lds((const unsigned*)((const char*)(gbase) + (voff)[_i]), (PG8_LAS unsigned*)(lds + (bufoff) + ldsw + _i * 8192), 16, 0, 0); } while (0)
#define PG8_LDA(dst, b, h) do { _Pragma("unroll") for (int m = 0; m < 4; ++m) _Pragma("unroll") for (int k = 0; k < 2; ++k) dst[m][k] = *(const PG8_LAS bf16x8*)(lds + PG8_SA(b, h) + aoff + m * 2048 + k * 1024); } while (0)
#define PG8_LDB(dst, b, h) do { _Pragma("unroll") for (int n = 0; n < 2; ++n) _Pragma("unroll") for (int k = 0; k < 2; ++k) dst[n][k] = *(const PG8_LAS bf16x8*)(lds + PG8_SB(b, h) + boff + n * 2048 + k * 1024); } while (0)
#define PG8_MMA(ai, bj, At, Bt) do { __builtin_amdgcn_s_setprio(1); _Pragma("unroll") for (int m = 0; m < 4; ++m) _Pragma("unroll") for (int n = 0; n < 2; ++n) _Pragma("unroll") for (int k = 0; k < 2; ++k) \
        acc[ai][bj][m][n] = __builtin_amdgcn_mfma_f32_16x16x32_bf16(Bt[n][k], At[m][k], acc[ai][bj][m][n], 0, 0, 0); __builtin_amdgcn_s_setprio(0); } while (0)
#define PG8_WAIT_V(n) asm volatile("s_waitcnt vmcnt(" #n ")" ::: "memory")
#define PG8_WAIT_L(n) asm volatile("s_waitcnt lgkmcnt(" #n ")" ::: "memory")
#define PG8_BAR __builtin_amdgcn_s_barrier()
#define PG8_SCHED __builtin_amdgcn_sched_barrier(0)
    Unit cur, nxt; int ui = 0;
    if (!S.next(0, cur)) return;
    f32x4 acc[2][2][4][2];
    E.init(acc, cur, wr, wc, fr, fq);
    bf16x8 At[4][2], B0[2][2], B1[2][2];
    const char* cA = (const char*)g.A + (size_t)cur.pm * tstepA; const char* cB = (const char*)g.Bt + (size_t)cur.pn * tstepB;
    S.a_ready(cur);
    if constexpr (SP2) {
        PG8_STAGE(PG8_SB(0, 0), cB, voffB); PG8_STAGE(PG8_SB(0, 1), cB + hstepB, voffB); PG8_STAGE(PG8_SA(0, 0), cA, voffA); PG8_STAGE(PG8_SA(0, 1), cA + hstepA, voffA);
        if (wr == 1) PG8_BAR;
        PG8_WAIT_V(2); PG8_BAR;
        PG8_STAGE(PG8_SB(1, 0), cB + kstep, voffB); PG8_STAGE(PG8_SA(1, 0), cA + kstep, voffA); PG8_STAGE(PG8_SB(1, 1), cB + hstepB + kstep, voffB);
        PG8_WAIT_V(6); PG8_BAR;
    } else {
        PG8_STAGE(PG8_SB(0, 0), cB, voffB); PG8_STAGE(PG8_SA(0, 0), cA, voffA); PG8_STAGE(PG8_SB(0, 1), cB + hstepB, voffB); PG8_STAGE(PG8_SA(0, 1), cA + hstepA, voffA);
        if (wr == 1) PG8_BAR;
        PG8_WAIT_V(4); PG8_BAR;
        PG8_STAGE(PG8_SB(1, 0), cB + kstep, voffB); PG8_STAGE(PG8_SA(1, 0), cA + kstep, voffA); PG8_STAGE(PG8_SB(1, 1), cB + hstepB + kstep, voffB);
        PG8_WAIT_V(6); PG8_BAR;
    }
    for (;;) {
        const bool has_next = S.next(ui + 1, nxt);
        const char* nA = has_next ? (const char*)g.A + (size_t)nxt.pm * tstepA : cA; const char* nB = has_next ? (const char*)g.Bt + (size_t)nxt.pn * tstepB : cB;
        for (int t = 0; t < nt; t += 2) {
            const bool last = (t == nt - 2);
            const char* a1 = cA + (size_t)(t + 1) * kstep;
            const char* a2 = last ? nA : cA + (size_t)(t + 2) * kstep; const char* b2 = last ? nB : cB + (size_t)(t + 2) * kstep;
            const char* a3 = a2 + kstep; const char* b3 = b2 + kstep;
            if (last && has_next) S.a_ready(nxt);
            if constexpr (SP2) {
            PG8_LDB(B0, 0, 0); PG8_LDB(B1, 0, 1); PG8_SCHED; PG8_LDA(At, 0, 0); PG8_STAGE(PG8_SA(1, 1), a1 + hstepA, voffA);
            PG8_WAIT_V(8); PG8_WAIT_L(0); PG8_BAR; PG8_MMA(0, 0, At, B0); PG8_MMA(0, 1, At, B1); PG8_BAR; PG8_SCHED;
            PG8_LDA(At, 0, 1); PG8_STAGE(PG8_SB(0, 0), b2, voffB); PG8_STAGE(PG8_SB(0, 1), b2 + hstepB, voffB); PG8_STAGE(PG8_SA(0, 0), a2, voffA);
            PG8_WAIT_V(8); PG8_WAIT_L(0); PG8_BAR; PG8_MMA(1, 0, At, B0); PG8_MMA(1, 1, At, B1); PG8_BAR; PG8_SCHED;
            PG8_LDB(B0, 1, 0); PG8_LDB(B1, 1, 1); PG8_SCHED; PG8_LDA(At, 1, 0); PG8_STAGE(PG8_SA(0, 1), a2 + hstepA, voffA);
            PG8_WAIT_V(8); PG8_WAIT_L(0); PG8_BAR; PG8_MMA(0, 0, At, B0); PG8_MMA(0, 1, At, B1); PG8_BAR; PG8_SCHED;
            PG8_LDA(At, 1, 1); PG8_STAGE(PG8_SB(1, 0), b3, voffB); PG8_STAGE(PG8_SB(1, 1), b3 + hstepB, voffB); PG8_STAGE(PG8_SA(1, 0), a3, voffA);
            PG8_WAIT_V(8); PG8_WAIT_L(0); PG8_BAR; PG8_MMA(1, 0, At, B0); PG8_MMA(1, 1, At, B1); PG8_BAR; PG8_SCHED;
            } else {
            PG8_LDB(B0, 0, 0); PG8_SCHED; PG8_LDA(At, 0, 0); PG8_STAGE(PG8_SA(1, 1), a1 + hstepA, voffA);
            PG8_WAIT_L(8); PG8_BAR; PG8_WAIT_L(0); PG8_MMA(0, 0, At, B0); PG8_BAR; PG8_SCHED;
            PG8_LDB(B1, 0, 1); PG8_STAGE(PG8_SB(0, 0), b2, voffB);
            PG8_BAR; PG8_WAIT_L(0); PG8_MMA(0, 1, At, B1); PG8_BAR;
            PG8_LDA(At, 0, 1); PG8_STAGE(PG8_SA(0, 0), a2, voffA);
            PG8_BAR; PG8_WAIT_L(0); PG8_MMA(1, 0, At, B0); PG8_BAR; PG8_SCHED;
            PG8_STAGE(PG8_SB(0, 1), b2 + hstepB, voffB);
            PG8_WAIT_V(6); PG8_BAR; PG8_MMA(1, 1, At, B1); PG8_BAR;
            PG8_LDB(B0, 1, 0); PG8_SCHED; PG8_LDA(At, 1, 0); PG8_STAGE(PG8_SA(0, 1), a2 + hstepA, voffA);
            PG8_WAIT_L(8); PG8_BAR; PG8_WAIT_L(0); PG8_MMA(0, 0, At, B0); PG8_BAR; PG8_SCHED;
            PG8_LDB(B1, 1, 1); PG8_STAGE(PG8_SB(1, 0), b3, voffB);
            PG8_BAR; PG8_WAIT_L(0); PG8_MMA(0, 1, At, B1); PG8_BAR;
            PG8_LDA(At, 1, 1); PG8_STAGE(PG8_SA(1, 0), a3, voffA);
            PG8_BAR; PG8_WAIT_L(0); PG8_MMA(1, 0, At, B0); PG8_BAR; PG8_SCHED;
            PG8_STAGE(PG8_SB(1, 1), b3 + hstepB, voffB);
            PG8_WAIT_V(6); PG8_BAR; PG8_MMA(1, 1, At, B1); PG8_BAR;
            }
        }
        if constexpr (ALIGN_EPI) { if (wr == 0) PG8_BAR; }
        if constexpr (!Epi::AFTER_DRAIN) { E(acc, cur, wr, wc, fr, fq); S.done(cur); }
        if (!has_next) break;
        E.init(acc, nxt, wr, wc, fr, fq);
        cur = nxt; cA = nA; cB = nB; ++ui;
        if constexpr (ALIGN_EPI) { if (wr == 1) PG8_BAR; }
    }
    PG8_WAIT_V(0);
    if constexpr (!ALIGN_EPI) { if (wr == 0) PG8_BAR; }
    PG8_BAR;
    if constexpr (Epi::AFTER_DRAIN) { E.fused(acc, cur, wr, wc, fr, fq, lds, wid, lane); S.done(cur); }
#undef PG8_SA
#undef PG8_SB
#undef PG8_STAGE
#undef PG8_LDA
#undef PG8_LDB
#undef PG8_MMA
#undef PG8_WAIT_V
#undef PG8_WAIT_L
#undef PG8_BAR
#undef PG8_SCHED
}

}

namespace mk {
using pg8::f32x4; using pg8::bf16x8; using pg8::u32x4; using pg8::cvt_pk_bf16;
typedef unsigned short bf16;
typedef unsigned u32x2 __attribute__((ext_vector_type(2)));
typedef short s16x4 __attribute__((ext_vector_type(4)));
typedef float f32x2 __attribute__((ext_vector_type(2)));
typedef GAS unsigned gu32;
#define RLX_AGENT __ATOMIC_RELAXED, __HIP_MEMORY_SCOPE_AGENT
#define XB_TMO      128
#define XB_XCNT(j)  (256  + 64 * (j))
#define XB_XSUB(j)  (1280 + 64 * (j))
#define XB_XGEN(j)  (2304 + 64 * (j))
#define XB_TOP      3328
#define XB_TOPGEN   3392
#define XCD_BAR_WORDS 3456
#define XB_SPIN_CAP (1u << 18)

__device__ __forceinline__ unsigned xb_ld(unsigned* p)              { return __hip_atomic_load(p, __ATOMIC_RELAXED, __HIP_MEMORY_SCOPE_AGENT); }
__device__ __forceinline__ unsigned xb_add(unsigned* p, unsigned v) { return __hip_atomic_fetch_add(p, v, __ATOMIC_RELAXED, __HIP_MEMORY_SCOPE_AGENT); }
__device__ __forceinline__ unsigned xb_xcc_id() { return (unsigned)__builtin_amdgcn_s_getreg((3 << 11) | 20) & 0xFu; }
#define XB_SPIN(cond, bar) do { unsigned _sp = 0; while (cond) { __builtin_amdgcn_s_sleep(1); \
    if ((++_sp & 255u) == 0u) { if (xb_ld(&(bar)[XB_TMO])) break; if (_sp > XB_SPIN_CAP) { atomicAdd(&(bar)[XB_TMO], 1u); break; } } } } while (0)

struct XcdBarrier {
    unsigned* bar; unsigned x;
    volatile LAS unsigned* st;
};

__device__ __forceinline__ XcdBarrier xcd_barrier_post(unsigned* bar, volatile LAS unsigned* st) {
    XcdBarrier b; b.bar = bar; b.x = xb_xcc_id(); b.st = st;
    if (threadIdx.x == 0) (void)xb_add(&bar[XB_XCNT(b.x)], 1u);
    return b;
}
__device__ __forceinline__ void xcd_barrier_complete(unsigned* bar, unsigned x, unsigned& nloc, unsigned& nx) {
    const unsigned G = gridDim.x * gridDim.y * gridDim.z;
    unsigned sum, cnt, mine, sp = 0u;
    for (;;) {
        sum = 0u; cnt = 0u; mine = 0u;
#pragma unroll
        for (unsigned j = 0; j < 16; ++j) { const unsigned c = xb_ld(&bar[XB_XCNT(j)]); sum += c; cnt += (c > 0u) ? 1u : 0u; mine = (j == x) ? c : mine; }
        if (sum == G) break;
        __builtin_amdgcn_s_sleep(1);
        if ((++sp & 255u) == 0u) { if (xb_ld(&bar[XB_TMO])) break; if (sp > XB_SPIN_CAP) { atomicAdd(&bar[XB_TMO], 1u); break; } }
    }
    nloc = mine > 0u ? mine : 1u; nx = cnt > 0u ? cnt : 1u;
}

__device__ __forceinline__ void xcd_barrier(const XcdBarrier& b) {
    asm volatile("s_waitcnt vmcnt(0)" ::: "memory");
    __syncthreads();
    if (threadIdx.x == 0) {
        unsigned* bar = b.bar;
        __builtin_amdgcn_s_waitcnt(0);
        unsigned nloc = b.st[0], nx = b.st[1];
        if (nloc == 0u) { xcd_barrier_complete(bar, b.x, nloc, nx); b.st[0] = nloc; b.st[1] = nx; }
        const unsigned old = xb_add(&bar[XB_XSUB(b.x)], 1u);
        const unsigned gen = old / nloc;
        if (old + 1u == (gen + 1u) * nloc) {
            __builtin_amdgcn_fence(__ATOMIC_RELEASE, "agent");
            asm volatile("s_waitcnt vmcnt(0)" ::: "memory");
            const unsigned og = xb_add(&bar[XB_TOP], 1u);
            const unsigned tg = og / nx;
            if (og + 1u == (tg + 1u) * nx) xb_add(&bar[XB_TOPGEN], 1u);
            else XB_SPIN(xb_ld(&bar[XB_TOPGEN]) == tg, bar);
            __builtin_amdgcn_fence(__ATOMIC_ACQUIRE, "agent");
            xb_add(&bar[XB_XGEN(b.x)], 1u);
            asm volatile("s_waitcnt vmcnt(0)" ::: "memory");
        } else {
            XB_SPIN(xb_ld(&bar[XB_XGEN(b.x)]) == gen, bar);
            __builtin_amdgcn_fence(__ATOMIC_ACQUIRE, "agent");
            asm volatile("s_waitcnt vmcnt(0)" ::: "memory");
        }
    }
    __syncthreads();
}


constexpr int MP = 16384, MS = 128, MT = MP + MS, MR = 16640;
constexpr int D = 1024, DFF = 2816, NWAVES = 8;
constexpr float RMS_EPS = 1e-6f, LN_EPS = 1e-5f;
constexpr float MLA_SCALE = 0.07216878364870322f;
constexpr size_t MiB = 1u << 20;
constexpr size_t WS_CTL = 0, CTL_BYTES = 3 * MiB;
constexpr int CW_BAR = 4096;
constexpr size_t ST_OFF = 65536, ST_STRIDE = (size_t)MR * 8;
constexpr int ST_SSQ0 = 0  , ST_LNS0 = 9, ST_LNQ0 = 10  , ST_KV = 13, ST_Q = 14, NSTAT = 15;
static_assert(ST_OFF + NSTAT * ST_STRIDE <= CTL_BYTES, "stats inside CTL");
constexpr size_t WS_WGU = 3 * MiB, WGU_BYTES = 11 * MiB, WS_WD = 47 * MiB, WD_BYTES = 5767168, WS_WIN = 69 * MiB, WS_WOUT = 77 * MiB, WS_WS = 81 * MiB,
                 WS_WDQKV = 82 * MiB, WS_WQ = 84 * MiB, WS_WOV = 86 * MiB, WS_WGX = 90 * MiB, WS_WAT = 95 * MiB, WS_WIT = 95 * MiB + 512 * 1024, WS_WCO = 96 * MiB, WS_ROPE = 99 * MiB;
constexpr size_t WS_H = 100 * MiB, WS_HB = 165 * MiB, WS_U = 198 * MiB, WS_GV = 231 * MiB, WS_UM = 264 * MiB, WS_ACT = 297 * MiB, WS_RAW = 387 * MiB, WS_CQB = 436 * MiB,
                 WS_QF = 449 * MiB, WS_KVB = 531 * MiB, WS_OB = 542 * MiB, WS_PART = 607 * MiB, WS_PML = 623 * MiB, WS_GATE = 624 * MiB, WS_XW = 665 * MiB, WS_AA = 747 * MiB, WS_BB = 829 * MiB,
                 WS_AGG = 911 * MiB, WS_GH = 914 * MiB, WS_PROF = 955 * MiB, WS_MK_END = 956 * MiB;
constexpr int RING_BYTES = 131072, LDS_BYTES = 147456, MISC_OFF = LDS_BYTES - 256;
constexpr size_t O_YP = 0, O_YS = 16777216, O_CV = 16908288, O_MP = 17170432, O_MS = 22413312, O_HP = 22454272, O_HS = 22464512, O_CP = 22505472, O_CS = 22536192, O_END = 22659072;

__device__ __forceinline__ float fast_sigmoid_l2(float t) { return __builtin_amdgcn_rcpf(1.0f + __builtin_amdgcn_exp2f(-t)); }
__device__ __forceinline__ float gelu_tanh_f(float x) { return x * fast_sigmoid_l2(2.302208198f * (x + 0.044715f * x * x * x)); }
__device__ __forceinline__ float silu_f(float x) { return x * fast_sigmoid_l2(1.4426950409f * x); }
__device__ __forceinline__ unsigned f2bf(float f) { unsigned u = __builtin_bit_cast(unsigned, f); return (u + 0x7fffu + ((u >> 16) & 1u)) >> 16; }
__device__ __forceinline__ unsigned pk2(float lo, float hi) { return f2bf(lo) | (f2bf(hi) << 16); }
__device__ __forceinline__ float bf2f(unsigned short b) { return __builtin_bit_cast(float, (unsigned)b << 16); }
__device__ __forceinline__ float bflo(unsigned w) { return __builtin_bit_cast(float, w << 16); }
__device__ __forceinline__ float bfhi(unsigned w) { return __builtin_bit_cast(float, w & 0xffff0000u); }
constexpr float ST_SCALE = 16777216.0f, ST_INV = 1.0f / 16777216.0f;
__device__ __forceinline__ void stat_add(long long* p, float v) { atomicAdd((unsigned long long*)p, (unsigned long long)(long long)__float2ll_rn(v * ST_SCALE)); }
__device__ __forceinline__ void stat_set(long long* p, float v) { *p = (long long)__float2ll_rn(v * ST_SCALE); }
__device__ __forceinline__ float stat_get(const long long* p) { return (float)(*p) * ST_INV; }
#define LDS_WAIT() asm volatile("s_waitcnt lgkmcnt(0)" ::: "memory")
#define VM_WAIT() asm volatile("s_waitcnt vmcnt(0)" ::: "memory")

struct InTab { const float* const __attribute__((address_space(4)))* t; __device__ __forceinline__ const float* operator[](int i) const { return t[i]; } };
struct P {
    InTab in; float* out; unsigned char* ws;
    LAS unsigned char* lds; int tid, lane, wave, G, bid;
    __device__ __forceinline__ long long* stat(int a) const { return (long long*)(ws + ST_OFF + (size_t)a * ST_STRIDE); }
    template <class T> __device__ __forceinline__ T* w(size_t off) const { return (T*)(ws + off); }
};
}
namespace mk {
struct TrJob { const float* src; int ldsrc, K, N; bf16* dst; int lddst; const float* gain; int kind, off; };
__device__ __forceinline__ int tr_rowmap(int kind, int off, int n) { return kind == 1 ? ((n >> 7) * 256 + (n & 127) + off) : (off + n); }
__device__ __forceinline__ void tr_item(const TrJob& j, LAS float* scr, int item, int lane) {
    const int nblk = j.N / 32, kb = item / nblk, nb = item % nblk, k0 = 64 * kb, n0 = 32 * nb;
    const float* src = j.src + (size_t)(k0 + (lane >> 5)) * j.ldsrc + n0 + (lane & 31); const size_t rstep = (size_t)2 * j.ldsrc;
    float v[32];
#pragma unroll
    for (int i = 0; i < 32; ++i) v[i] = src[i * rstep];
    if (j.gain) { const float* gp = j.gain + k0 + (lane >> 5); float g[32];
#pragma unroll
        for (int i = 0; i < 32; ++i) g[i] = gp[2 * i];
#pragma unroll
        for (int i = 0; i < 32; ++i) v[i] *= g[i]; }
#pragma unroll
    for (int i = 0; i < 32; ++i) scr[(2 * i + (lane >> 5)) * 33 + (lane & 31)] = v[i];
    LDS_WAIT(); asm volatile("" ::: "memory");
    const int c = lane & 7;
#pragma unroll
    for (int jj = 0; jj < 4; ++jj) { const int n = (lane >> 3) + 8 * jj; const LAS float* s = scr + (8 * c) * 33 + n;
        u32x4 o; o.x = pk2(s[0], s[33]); o.y = pk2(s[66], s[99]); o.z = pk2(s[132], s[165]); o.w = pk2(s[198], s[231]);
        *(u32x4*)(j.dst + (size_t)tr_rowmap(j.kind, j.off, n0 + n) * j.lddst + k0 + 8 * c) = o; }
    LDS_WAIT(); asm volatile("" ::: "memory");
}
constexpr int NJOBS = 24;
__device__ __forceinline__ TrJob get_job(const P& p, int jid) {
    TrJob j; j.gain = nullptr; j.kind = 0; j.off = 0; j.src = nullptr; j.dst = nullptr; j.ldsrc = 0; j.K = 0; j.N = 0; j.lddst = 0;
    if (jid < 12) { const int l = jid / 3, t = jid % 3;
        if (t < 2) { j.src = p.in[33 + t] + (size_t)l * D * DFF; j.ldsrc = DFF; j.K = D; j.N = DFF; j.dst = p.w<bf16>(WS_WGU + l * WGU_BYTES); j.lddst = D; j.gain = p.in[7] + l * D; j.kind = 1; j.off = 128 * t; }
        else { j.src = p.in[35] + (size_t)l * DFF * D; j.ldsrc = D; j.K = DFF; j.N = D; j.dst = p.w<bf16>(WS_WD + l * WD_BYTES); j.lddst = DFF; }
    } else if (jid < 16) { const int a = (jid - 12) >> 1;
        if (((jid - 12) & 1) == 0) { j.src = p.in[9] + (size_t)a * D * 2048; j.ldsrc = 2048; j.K = D; j.N = 2048; j.dst = p.w<bf16>(WS_WIN + a * 4 * MiB); j.lddst = D; j.gain = p.in[6] + (3 * a) * D; }
        else { j.src = p.in[14] + (size_t)a * D * D; j.ldsrc = D; j.K = D; j.N = D; j.dst = p.w<bf16>(WS_WOUT + a * 2 * MiB); j.lddst = D; }
    } else if (jid == 16) { j.src = p.in[15]; j.ldsrc = 384; j.K = D; j.N = 384; j.dst = p.w<bf16>(WS_WDQKV); j.lddst = D; j.gain = p.in[6] + D; j.off = 256; }
    else if (jid == 17) { j.src = p.in[18]; j.ldsrc = 320; j.K = D; j.N = 256; j.dst = p.w<bf16>(WS_WDQKV); j.lddst = D; j.gain = p.in[6] + D; j.off = 0; }
    else if (jid == 18) { j.src = p.in[18] + 256; j.ldsrc = 320; j.K = D; j.N = 64; j.dst = p.w<bf16>(WS_WDQKV); j.lddst = D; j.gain = p.in[6] + D; j.off = 640; }
    else if (jid == 19) { j.src = p.in[24]; j.ldsrc = 1280; j.K = D; j.N = 1280; j.dst = p.w<bf16>(WS_WGX); j.lddst = D; j.gain = p.in[6] + 2 * D; j.off = 0; }
    else if (jid == 20) { j.src = p.in[23]; j.ldsrc = 1280; j.K = D; j.N = 1280; j.dst = p.w<bf16>(WS_WGX); j.lddst = D; j.gain = p.in[6] + 2 * D; j.off = 1280; }
    else if (jid == 21) { j.src = p.in[32]; j.ldsrc = D; j.K = 1280; j.N = D; j.dst = p.w<bf16>(WS_WCO); j.lddst = 1280; }
    else if (jid == 22) { j.src = p.in[27]; j.ldsrc = 128; j.K = 128; j.N = 128; j.dst = p.w<bf16>(WS_WAT); j.lddst = 128; j.kind = 2; }
    else { j.src = p.in[29]; j.ldsrc = 128; j.K = 128; j.N = 128; j.dst = p.w<bf16>(WS_WIT); j.lddst = 128; j.kind = 2; }
    return j;
}
__device__ __forceinline__ int job_items(const TrJob& j) { return j.kind == 2 ? 80 : (j.K / 64) * (j.N / 32); }

__device__ __forceinline__ void p0_prologue(const P& p, const int mask) {
    LAS float* scr = (LAS float*)(p.lds + p.wave * 16384);
    const int gw = p.bid * NWAVES + p.wave, NGW = p.G * NWAVES, lane = p.lane;
    const int gt = p.bid * (NWAVES * 64) + p.tid, NGT = p.G * NWAVES * 64;
    if (mask & 1) {
    {
        int base = 0;
        for (int jid = 0; jid < NJOBS; ++jid) {
            TrJob j = get_job(p, jid); const int nit = job_items(j);
            int first = (gw - base % NGW + NGW) % NGW;
            for (int it = first; it < nit; it += NGW) {
                if (j.kind == 2) { TrJob b = j; const int blk = it >> 3; b.src = j.src + (size_t)blk * 16384; b.dst = j.dst + (size_t)blk * 16384; b.kind = 0; tr_item(b, scr, it & 7, lane); }
                else tr_item(j, scr, it, lane);
            }
            base += nit;
        }
    }
    }
    if (mask & 2) {
    { u32x4* z = (u32x4*)(p.w<bf16>(WS_WDQKV) + (size_t)704 * D); for (int i = gt; i < 64 * D / 8; i += NGT) z[i] = (u32x4){0u, 0u, 0u, 0u}; }
    }
    if (mask & 4) {
    for (int i = gt; i < 2 * 8 * 128 * 16; i += NGT) {
        const int s0 = (i & 15) * 8, t = (i >> 4) & 127, jg = i >> 11; const float* src = p.in[12] + (size_t)jg * 16384;
        unsigned w[4], ws_[4];
#pragma unroll
        for (int e = 0; e < 4; ++e) { float v[2], vs[2];
#pragma unroll
            for (int h = 0; h < 2; ++h) { const int s = s0 + 2 * e + h; v[h] = (s <= t) ? src[t * 128 + s] : 0.f; vs[h] = ((s >> 2) == (t >> 2) && (s & 3) <= (t & 3)) ? src[(t & 3) * 128 + (s & 3)] : 0.f; }
            w[e] = pk2(v[0], v[1]); ws_[e] = pk2(vs[0], vs[1]); }
        const int j = jg >> 3, g = jg & 7;
        *(u32x4*)(p.w<bf16>(WS_WS + (size_t)j * 262144) + ((size_t)g * 128 + t) * 128 + s0) = (u32x4){w[0], w[1], w[2], w[3]};
        *(u32x4*)(p.w<bf16>(WS_WS + 524288 + (size_t)j * 262144) + ((size_t)g * 128 + t) * 128 + s0) = (u32x4){ws_[0], ws_[1], ws_[2], ws_[3]};
    }
    }
    if (mask & 8) {
    for (int i = gt; i < 2052 * 32; i += NGT) { const int tp = i >> 5, fi = i & 31, pos = tp < 2048 ? tp : 16384 + (tp - 2048);
        const float inv = 1.0f / powf(10000.0f, (float)(2 * fi) / 64.0f); const float ang = (float)pos * inv;
        p.w<f32x2>(WS_ROPE)[i] = (f32x2){cosf(ang), sinf(ang)}; }
    }
    if (mask & 16) {
    { bf16* HB = p.w<bf16>(WS_HB); long long* ssq = p.stat(ST_SSQ0);
      for (int m = gw; m < MR; m += NGW) {
        f32x4 v[4]; float s = 0.f;
#pragma unroll
        for (int jj = 0; jj < 4; ++jj) { const int c = 4 * lane + 256 * jj;
            if (m < MP) v[jj] = *(const f32x4*)(p.in[0] + (size_t)m * D + c); else if (m < MT) v[jj] = *(const f32x4*)(p.in[1] + (size_t)(m - MP) * D + c); else v[jj] = (f32x4){0.f, 0.f, 0.f, 0.f};
            s += (v[jj].x * v[jj].x + v[jj].y * v[jj].y) + (v[jj].z * v[jj].z + v[jj].w * v[jj].w); }
#pragma unroll
        for (int o = 1; o < 64; o <<= 1) s += __shfl_xor(s, o);
#pragma unroll
        for (int jj = 0; jj < 4; ++jj) { const int c = 4 * lane + 256 * jj;
            *(u32x2*)(HB + (size_t)m * D + c) = (u32x2){pk2(v[jj].x, v[jj].y), pk2(v[jj].z, v[jj].w)}; }
        if (lane == 0) stat_set(ssq + m, s);
      } }
    }
    if (mask & 32) {
    { const float* wuq = p.in[17]; const float* wuk = p.in[20]; const float* qn = p.in[16]; bf16* Wq = p.w<bf16>(WS_WQ);
      LAS float* Qs = (LAS float*)p.lds;
      for (int it = p.bid; it < 192; it += p.G) {
        const int h = it / 24, kb = (it >> 2) % 6, cq = it & 3, k0 = 64 * kb;
        __syncthreads();
#pragma unroll
        for (int q = 0; q < 4; ++q) { const int idx = p.tid + 512 * q, row = idx >> 5, c4 = idx & 31; *(LAS f32x4*)(Qs + row * 132 + c4 * 4) = *(const f32x4*)(wuq + (size_t)(k0 + row) * 1536 + h * 192 + c4 * 4); }
        __syncthreads();
        const int c0 = cq * 64 + p.wave * 8; float acc[8];
#pragma unroll
        for (int cc = 0; cc < 8; ++cc) acc[cc] = 0.f;
        for (int n4 = 0; n4 < 32; ++n4) { const f32x4 bv = *(const LAS f32x4*)(Qs + lane * 132 + n4 * 4);
#pragma unroll
            for (int cc = 0; cc < 8; ++cc) { const f32x4 av = *(const f32x4*)(wuk + (size_t)(c0 + cc) * 1024 + h * 128 + n4 * 4); acc[cc] += (av.x * bv.x + av.y * bv.y) + (av.z * bv.z + av.w * bv.w); } }
        const float g = qn[k0 + lane];
#pragma unroll
        for (int cc = 0; cc < 8; ++cc) Wq[(size_t)(320 * h + c0 + cc) * 384 + k0 + lane] = (bf16)f2bf(acc[cc] * g);
      }
      for (int r = gw; r < 512; r += NGW) { const int h = r >> 6, ie = r & 63, i = ie >> 1, e = ie & 1;
#pragma unroll
        for (int kk = 0; kk < 6; ++kk) { const int k = lane + 64 * kk; Wq[(size_t)(320 * h + 256 + ie) * 384 + k] = (bf16)f2bf(wuq[(size_t)k * 1536 + h * 192 + 128 + 32 * e + i] * qn[k]); } } }
    }
    if (mask & 64) {
    { const float* wuv = p.in[21]; const float* wo = p.in[22]; bf16* Wov = p.w<bf16>(WS_WOV);
      for (int it = gw; it < 2048; it += NGW) { const int h = it >> 8, cg = (it >> 2) & 63, nb = it & 3, c0 = cg * 4, n = nb * 256 + lane * 4;
        f32x4 acc[4];
#pragma unroll
        for (int cc = 0; cc < 4; ++cc) acc[cc] = (f32x4){0.f, 0.f, 0.f, 0.f};
        for (int v = 0; v < 128; ++v) { const f32x4 b = *(const f32x4*)(wo + (size_t)(h * 128 + v) * D + n);
#pragma unroll
            for (int cc = 0; cc < 4; ++cc) { const float a = wuv[(size_t)(c0 + cc) * 1024 + h * 128 + v]; acc[cc] += b * a; } }
#pragma unroll
        for (int jn = 0; jn < 4; ++jn) *(u32x2*)(Wov + (size_t)(n + jn) * 2048 + h * 256 + c0) = (u32x2){pk2(acc[0][jn], acc[1][jn]), pk2(acc[2][jn], acc[3][jn])};
      } }
    }
}
}
namespace mk {
#ifdef MK_DRYPROBE
#define MK_DRY(E) ((E).dry)
#define MK_DRYFIELD int dry;
#else
#define MK_DRY(E) 0
#define MK_DRYFIELD
#endif
typedef const f32x4 (&AccRef)[2][2][4][2];
__device__ __forceinline__ float quad_red(float v) { v += __shfl_xor(v, 16); v += __shfl_xor(v, 32); return v; }
__device__ __forceinline__ u32x4 pack8(const f32x4 a, const f32x4 b) { u32x4 w; w.x = cvt_pk_bf16(a[0], a[1]); w.y = cvt_pk_bf16(a[2], a[3]); w.z = cvt_pk_bf16(b[0], b[1]); w.w = cvt_pk_bf16(b[2], b[3]); return w; }
__device__ __forceinline__ float sumsq8(const f32x4 a, const f32x4 b) { return ((a[0] * a[0] + a[1] * a[1]) + (a[2] * a[2] + a[3] * a[3])) + ((b[0] * b[0] + b[1] * b[1]) + (b[2] * b[2] + b[3] * b[3])); }
__device__ __forceinline__ float sum8(const f32x4 a, const f32x4 b) { return ((a[0] + a[1]) + (a[2] + a[3])) + ((b[0] + b[1]) + (b[2] + b[3])); }
#define MK_EPI_CALL() \
    __device__ __forceinline__ void operator()(AccRef acc, const pg8::Unit& u, int wr, int wc, int fr, int fq) const { \
        Pre pre_[2][4]; \
        _Pragma("unroll") for (int ai = 0; ai < 2; ++ai) _Pragma("unroll") for (int m = 0; m < 4; ++m) pre_[ai][m] = pre(u.pm * 256 + ai * 128 + wr * 64 + m * 16 + fr, u.pn, wc, fq); \
        _Pragma("unroll") for (int ai = 0; ai < 2; ++ai) _Pragma("unroll") for (int m = 0; m < 4; ++m) \
            rgp(u.pm * 256 + ai * 128 + wr * 64 + m * 16 + fr, u.pn, wc, fq, acc[ai][0][m][0], acc[ai][0][m][1], acc[ai][1][m][0], acc[ai][1][m][1], pre_[ai][m]); } \
    __device__ __forceinline__ void rg(int r, int pn, int wc, int fq, f32x4 a0, f32x4 b0, f32x4 a1, f32x4 b1) const { rgp(r, pn, wc, fq, a0, b0, a1, b1, pre(r, pn, wc, fq)); }
#define MK_EPI_CALL_DENSE() \
    __device__ __forceinline__ void operator()(AccRef acc, const pg8::Unit& u, int wr, int wc, int fr, int fq) const { \
        Pre pre_[2][4]; \
        _Pragma("unroll") for (int ai = 0; ai < 2; ++ai) _Pragma("unroll") for (int m = 0; m < 4; ++m) pre_[ai][m] = pre(u.pm * 256 + ai * 128 + wr * 64 + m * 16 + fr, u.pn, wc, fq); \
        _Pragma("unroll") for (int ai = 0; ai < 2; ++ai) { float s1 = 0.f, s2 = 0.f; \
            _Pragma("unroll") for (int m = 0; m < 4; ++m) { float t1, t2; \
                rgs(u.pm * 256 + ai * 128 + wr * 64 + m * 16 + fr, u.pn, wc, fq, acc[ai][0][m][0], acc[ai][0][m][1], acc[ai][1][m][0], acc[ai][1][m][1], pre_[ai][m], t1, t2); \
                s1 = (fq == m) ? t1 : s1; s2 = (fq == m) ? t2 : s2; } \
            stats(u.pm * 256 + ai * 128 + wr * 64 + fq * 16 + fr, u.pn, s1, s2); } } \
    __device__ __forceinline__ void rg(int r, int pn, int wc, int fq, f32x4 a0, f32x4 b0, f32x4 a1, f32x4 b1) const { float t1, t2; rgs(r, pn, wc, fq, a0, b0, a1, b1, pre(r, pn, wc, fq), t1, t2); if (fq == 0) stats(r, pn, t1, t2); }
#define MK_INIT_ZERO() __device__ __forceinline__ void init(f32x4 (&acc)[2][2][4][2], const pg8::Unit&, int, int, int, int) const { \
        _Pragma("unroll") for (int a = 0; a < 2; ++a) _Pragma("unroll") for (int b = 0; b < 2; ++b) _Pragma("unroll") for (int m = 0; m < 4; ++m) _Pragma("unroll") for (int n = 0; n < 2; ++n) acc[a][b][m][n] = (f32x4){0.f, 0.f, 0.f, 0.f}; }
#define MK_PRE_STAT(PTR) MK_INIT_ZERO() typedef long long Pre; __device__ __forceinline__ Pre pre(int r, int, int, int) const { return (PTR)[r]; }
__device__ __forceinline__ float stat_f(long long v) { return (float)v * ST_INV; }

struct EpiA1 {
    static constexpr bool PERM = true, AFTER_DRAIN = false;
    bf16* U; bf16* GV; const long long* ssq; long long* lns; long long* lnq; MK_DRYFIELD
    MK_PRE_STAT(ssq)
    __device__ __forceinline__ void rgs(int r, int pn, int wc, int fq, f32x4 a0, f32x4 b0, f32x4 a1, f32x4 b1, const Pre pv, float& s1, float& s2) const {
        const bool isv = pn >= 4; bf16* dst = (isv ? GV : U) + (size_t)r * 1024 + (pn & 3) * 256 + wc * 32 + 8 * fq; const float rs = rsqrtf(stat_f(pv) * (1.0f / 1024.0f) + RMS_EPS);
        a0 *= rs; b0 *= rs; a1 *= rs; b1 *= rs;
#pragma unroll
        for (int e = 0; e < 4; ++e) { a0[e] = gelu_tanh_f(a0[e]); b0[e] = gelu_tanh_f(b0[e]); a1[e] = gelu_tanh_f(a1[e]); b1[e] = gelu_tanh_f(b1[e]); }
        *(u32x4*)dst = pack8(a0, b0); *(u32x4*)(dst + 128) = pack8(a1, b1);
        s1 = 0.f; s2 = 0.f;
        if (isv) { s1 = quad_red(sum8(a0, b0) + sum8(a1, b1)); s2 = quad_red(sumsq8(a0, b0) + sumsq8(a1, b1)); }
    }
    __device__ __forceinline__ void stats(int r, int pn, float s1, float s2) const { if (pn >= 4 && !MK_DRY(*this)) { stat_add(lns + r, s1); stat_add(lnq + r, s2); } }
    MK_EPI_CALL_DENSE()
};
struct EpiRes {
    static constexpr bool PERM = true, AFTER_DRAIN = false;
    bf16* HB; long long* ssq_out; MK_DRYFIELD
    struct Pre { u32x4 h0, h1; };
    static __device__ __forceinline__ f32x4 lo4(const u32x4 h) { return (f32x4){bflo(h.x), bfhi(h.x), bflo(h.y), bfhi(h.y)}; }
    static __device__ __forceinline__ f32x4 hi4(const u32x4 h) { return (f32x4){bflo(h.z), bfhi(h.z), bflo(h.w), bfhi(h.w)}; }
    __device__ __forceinline__ Pre pre(int r, int pn, int wc, int fq) const { const bf16* hp = HB + (size_t)r * 1024 + pn * 256 + wc * 32 + 8 * fq; Pre v; v.h0 = *(const u32x4*)hp; v.h1 = *(const u32x4*)(hp + 128); return v; }
    __device__ __forceinline__ void init(f32x4 (&acc)[2][2][4][2], const pg8::Unit& u, int wr, int wc, int fr, int fq) const {
        Pre v[2][4];
#pragma unroll
        for (int ai = 0; ai < 2; ++ai)
#pragma unroll
            for (int m = 0; m < 4; ++m) v[ai][m] = pre(u.pm * 256 + ai * 128 + wr * 64 + m * 16 + fr, u.pn, wc, fq);
#pragma unroll
        for (int ai = 0; ai < 2; ++ai)
#pragma unroll
            for (int m = 0; m < 4; ++m) { acc[ai][0][m][0] = lo4(v[ai][m].h0); acc[ai][0][m][1] = hi4(v[ai][m].h0); acc[ai][1][m][0] = lo4(v[ai][m].h1); acc[ai][1][m][1] = hi4(v[ai][m].h1); }
    }
    __device__ __forceinline__ void fin(int r, int pn, int wc, int fq, const f32x4 a0, const f32x4 b0, const f32x4 a1, const f32x4 b1, float& s1) const {
        bf16* hp = HB + (size_t)r * 1024 + pn * 256 + wc * 32 + 8 * fq;
        s1 = quad_red(sumsq8(a0, b0) + sumsq8(a1, b1));
        if (MK_DRY(*this)) { if (s1 == 12345.678f) *(u32x4*)hp = pack8(a0, b0); return; }
        *(u32x4*)hp = pack8(a0, b0); *(u32x4*)(hp + 128) = pack8(a1, b1);
    }
    __device__ __forceinline__ void stats(int r, int pn, float s1, float s2) const { if (!MK_DRY(*this)) stat_add(ssq_out + r, s1); }
    __device__ __forceinline__ void operator()(AccRef acc, const pg8::Unit& u, int wr, int wc, int fr, int fq) const {
#pragma unroll
        for (int ai = 0; ai < 2; ++ai) { float s1 = 0.f;
#pragma unroll
            for (int m = 0; m < 4; ++m) { float t1; fin(u.pm * 256 + ai * 128 + wr * 64 + m * 16 + fr, u.pn, wc, fq, acc[ai][0][m][0], acc[ai][0][m][1], acc[ai][1][m][0], acc[ai][1][m][1], t1); s1 = (fq == m) ? t1 : s1; }
            stats(u.pm * 256 + ai * 128 + wr * 64 + fq * 16 + fr, u.pn, s1, 0.f); } }
    __device__ __forceinline__ void rg(int r, int pn, int wc, int fq, f32x4 a0, f32x4 b0, f32x4 a1, f32x4 b1) const { const Pre v = pre(r, pn, wc, fq); float t1;
        fin(r, pn, wc, fq, a0 + lo4(v.h0), b0 + hi4(v.h0), a1 + lo4(v.h1), b1 + hi4(v.h1), t1); if (fq == 0) stats(r, pn, t1, 0.f); }
};
struct EpiF1 {
    static constexpr bool PERM = true, AFTER_DRAIN = false;
    bf16* ACT; const long long* ssq;
    MK_PRE_STAT(ssq)
    __device__ __forceinline__ void rgp(int r, int pn, int wc, int fq, f32x4 a0, f32x4 b0, f32x4 a1, f32x4 b1, const Pre pv) const {
        const float rs = rsqrtf(stat_f(pv) * (1.0f / 1024.0f) + RMS_EPS); f32x4 a, b;
#pragma unroll
        for (int e = 0; e < 4; ++e) { a[e] = silu_f(a0[e] * rs) * (a1[e] * rs); b[e] = silu_f(b0[e] * rs) * (b1[e] * rs); }
        *(u32x4*)(ACT + (size_t)r * DFF + pn * 128 + wc * 32 + 8 * fq) = pack8(a, b);
    }
    MK_EPI_CALL()
};
struct EpiB1 {
    static constexpr bool PERM = true, AFTER_DRAIN = false;
    float* RAW; bf16* CQB; const long long* ssq; long long* ssq_kv; long long* ssq_q; MK_DRYFIELD
    __device__ __forceinline__ void half(int r, int c, f32x4 a, f32x4 b, float& qkv, float& qq) const {
        if (c < 256) { *(f32x4*)(RAW + (size_t)r * 768 + c) = a; *(f32x4*)(RAW + (size_t)r * 768 + c + 4) = b; qkv += sumsq8(a, b); }
        else if (c < 640) { *(u32x4*)(CQB + (size_t)r * 384 + (c - 256)) = pack8(a, b); qq += sumsq8(a, b); }
        else if (c < 704) { *(f32x4*)(RAW + (size_t)r * 768 + c) = a; *(f32x4*)(RAW + (size_t)r * 768 + c + 4) = b; } }
    MK_PRE_STAT(ssq)
    __device__ __forceinline__ void rgs(int r, int pn, int wc, int fq, f32x4 a0, f32x4 b0, f32x4 a1, f32x4 b1, const Pre pv, float& s1, float& s2) const {
        const float rs = rsqrtf(stat_f(pv) * (1.0f / 1024.0f) + RMS_EPS); const int c = pn * 256 + wc * 32 + 8 * fq; float qkv = 0.f, qq = 0.f;
        half(r, c, a0 * rs, b0 * rs, qkv, qq); half(r, c + 128, a1 * rs, b1 * rs, qkv, qq);
        s1 = quad_red(qkv); s2 = quad_red(qq);
    }
    __device__ __forceinline__ void stats(int r, int pn, float s1, float s2) const { if (!MK_DRY(*this)) { if (pn == 0) stat_add(ssq_kv + r, s1); else stat_add(ssq_q + r, s2); } }
    MK_EPI_CALL_DENSE()
};
struct EpiB2 {
    static constexpr bool PERM = true, AFTER_DRAIN = false;
    bf16* QF; const long long* ssq_q; const f32x2* rope;
    __device__ __forceinline__ void half(int r, int c, int tp, const f32x4 a, const f32x4 b) const {
        const int h = c / 320, w = c - h * 320;
        if (w < 256) *(u32x4*)(QF + (size_t)r * 2560 + c) = pack8(a, b);
        else { const int i0 = (w - 256) >> 1;
            const f32x4 cs01 = *(const f32x4*)(rope + (size_t)tp * 32 + i0), cs23 = *(const f32x4*)(rope + (size_t)tp * 32 + i0 + 2);
            bf16* qh = QF + (size_t)r * 2560 + h * 320 + 256;
            *(u32x2*)(qh + i0) = (u32x2){cvt_pk_bf16(a[0] * cs01[0] - a[1] * cs01[1], a[2] * cs01[2] - a[3] * cs01[3]), cvt_pk_bf16(b[0] * cs23[0] - b[1] * cs23[1], b[2] * cs23[2] - b[3] * cs23[3])};
            *(u32x2*)(qh + 32 + i0) = (u32x2){cvt_pk_bf16(a[0] * cs01[1] + a[1] * cs01[0], a[2] * cs01[3] + a[3] * cs01[2]), cvt_pk_bf16(b[0] * cs23[1] + b[1] * cs23[0], b[2] * cs23[3] + b[3] * cs23[2])}; } }
    MK_PRE_STAT(ssq_q)
    __device__ __forceinline__ void rgp(int r, int pn, int wc, int fq, f32x4 a0, f32x4 b0, f32x4 a1, f32x4 b1, const Pre pv) const {
        const float rs = rsqrtf(stat_f(pv) * (1.0f / 384.0f) + RMS_EPS) * MLA_SCALE; const int tp = r < MP ? (r & 2047) : 2048 + ((r - MP) & 3), c = pn * 256 + wc * 32 + 8 * fq;
        half(r, c, tp, a0 * rs, b0 * rs); half(r, c + 128, tp, a1 * rs, b1 * rs);
    }
    MK_EPI_CALL()
};
struct EpiC1 {
    static constexpr bool PERM = true, AFTER_DRAIN = false;
    bf16* GATE; float* XW; const long long* ssq;
    MK_PRE_STAT(ssq)
    __device__ __forceinline__ void rgp(int r, int pn, int wc, int fq, f32x4 a0, f32x4 b0, f32x4 a1, f32x4 b1, const Pre pv) const {
        const bool isx = pn >= 5; const int c = (isx ? pn - 5 : pn) * 256 + wc * 32 + 8 * fq; const float rs = rsqrtf(stat_f(pv) * (1.0f / 1024.0f) + RMS_EPS);
        a0 *= rs; b0 *= rs; a1 *= rs; b1 *= rs;
        if (isx) { float* x = XW + (size_t)r * 1280 + c; *(f32x4*)x = a0; *(f32x4*)(x + 4) = b0; *(f32x4*)(x + 128) = a1; *(f32x4*)(x + 132) = b1; }
        else {
#pragma unroll
            for (int e = 0; e < 4; ++e) { a0[e] = gelu_tanh_f(a0[e]); b0[e] = gelu_tanh_f(b0[e]); a1[e] = gelu_tanh_f(a1[e]); b1[e] = gelu_tanh_f(b1[e]); }
            bf16* g = GATE + (size_t)r * 1280 + c; *(u32x4*)g = pack8(a0, b0); *(u32x4*)(g + 128) = pack8(a1, b1); }
    }
    MK_EPI_CALL()
};

template <class Epi>
__device__ __forceinline__ void mini_gemm(const P& p, const bf16* A, int lda, const bf16* Bt, int ldb, int K, int N, const Epi& E, int first_wg) {
    constexpr int BP = 272, SLOT = 64 * BP;
    const int tid = p.tid, lane = p.lane, w = p.wave, kq = w & 3, rgp = w >> 2, l15 = lane & 15, g4 = lane >> 4, nmu = (N >> 8) * 16, nch = K >> 7, nst = (nch + 3) >> 2;
    const int t128 = (rgp << 6) | lane;
    for (int mu = (p.bid - first_wg + p.G) % p.G; mu < nmu; mu += p.G) {
        const int pn = mu >> 4, wcq = (mu >> 2) & 3, rq = mu & 3, row = MP + 32 * rq + 16 * rgp + l15;
        const bf16* arow = A + (size_t)row * lda + 8 * g4;
        const int r0 = t128 >> 4, c16 = t128 & 15;
        const bf16* bbase = Bt + (size_t)(pn * 256 + wcq * 32 + 8 * (r0 >> 2) + (r0 & 3)) * ldb + c16 * 8; const int bo0 = r0 * BP + c16 * 16;
#define MG_BSRC(q) (bbase + (size_t)(128 * ((q) >> 2) + 4 * (((q) >> 1) & 1) + 16 * ((q) & 1)) * ldb)
#define MG_BOFF(q) (bo0 + 8 * (q) * BP)
        f32x4 acc[4];
#pragma unroll
        for (int t = 0; t < 4; ++t) acc[t] = (f32x4){0.f, 0.f, 0.f, 0.f};
        u32x4 b0[8], a0[4], b1[8], a1[4], b2[8], a2[4];
#define MG_LOAD(BS, AS, ST) do { const int ch_ = 4 * (ST) + kq; if (ch_ < nch) { \
            _Pragma("unroll") for (int q = 0; q < 8; ++q) BS[q] = *(const u32x4*)(MG_BSRC(q) + (size_t)ch_ * 128); \
            _Pragma("unroll") for (int s = 0; s < 4; ++s) AS[s] = *(const u32x4*)(arow + (size_t)ch_ * 128 + 32 * s); } } while (0)
#define MG_STEP(BS, AS, ST) do { LAS unsigned char* slot = p.lds + (kq * 2 + ((ST) & 1)) * SLOT; const bool ok_ = 4 * (ST) + kq < nch; \
            if (ok_) { _Pragma("unroll") for (int q = 0; q < 8; ++q) *(LAS u32x4*)(slot + MG_BOFF(q)) = BS[q]; } \
            bf16x8 af[4]; _Pragma("unroll") for (int s = 0; s < 4; ++s) af[s] = __builtin_bit_cast(bf16x8, AS[s]); \
            __syncthreads(); \
            if ((ST) + 3 < nst) MG_LOAD(BS, AS, (ST) + 3); \
            if (ok_) { _Pragma("unroll") for (int s = 0; s < 4; ++s) _Pragma("unroll") for (int t = 0; t < 4; ++t) { \
                const bf16x8 bf = *(const LAS bf16x8*)(slot + (t * 16 + l15) * BP + (32 * s + 8 * g4) * 2); \
                acc[t] = __builtin_amdgcn_mfma_f32_16x16x32_bf16(bf, af[s], acc[t], 0, 0, 0); } } } while (0)
        MG_LOAD(b0, a0, 0); if (1 < nst) MG_LOAD(b1, a1, 1); if (2 < nst) MG_LOAD(b2, a2, 2);
        __syncthreads();
        for (int st = 0; st < nst; st += 3) {
            MG_STEP(b0, a0, st);
            if (st + 1 < nst) MG_STEP(b1, a1, st + 1);
            if (st + 2 < nst) MG_STEP(b2, a2, st + 2);
        }
#undef MG_LOAD
#undef MG_STEP
#undef MG_BSRC
#undef MG_BOFF
        __syncthreads();
        LAS f32x4* red = (LAS f32x4*)p.lds;
        if (kq > 0) {
#pragma unroll
            for (int t = 0; t < 4; ++t) red[((rgp * 3 + (kq - 1)) * 4 + t) * 64 + lane] = acc[t]; }
        __syncthreads();
        if (kq == 0) {
#pragma unroll
            for (int k2 = 0; k2 < 3; ++k2)
#pragma unroll
                for (int t = 0; t < 4; ++t) acc[t] += red[((rgp * 3 + k2) * 4 + t) * 64 + lane];
            E.rg(row, pn, wcq, g4, acc[0], acc[1], acc[2], acc[3]); }
    }
}
}
namespace mk {
__device__ __forceinline__ s16x4 tr16(const LAS unsigned char* a) { return __builtin_amdgcn_ds_read_tr16_b64_v4i16((LAS s16x4*)a); }
__device__ __forceinline__ bf16x8 cat8(const s16x4 a, const s16x4 b) { return (bf16x8){a[0], a[1], a[2], a[3], b[0], b[1], b[2], b[3]}; }
__device__ __forceinline__ bf16x8 as_bf16x8(const u32x4 w) { return __builtin_bit_cast(bf16x8, w); }
#define MFMA16(A, B, C) __builtin_amdgcn_mfma_f32_16x16x32_bf16((A), (B), (C), 0, 0, 0)
constexpr int TP = 272;
constexpr int KP = 656;
constexpr float LOG2E = 1.4426950408889634f;

__device__ __forceinline__ void a2_spatial(const P& p, int j, float* out_cv  ) {
    const bf16* U = p.w<bf16>(WS_U); const bf16* GV = p.w<bf16>(WS_GV); bf16* UM = p.w<bf16>(WS_UM);
    const long long* lns = p.stat(ST_LNS0 + 2 * j); const long long* lnq = p.stat(ST_LNQ0 + 2 * j);
    const float* ln_g = p.in[10] + j * 1024; const float* ln_b = p.in[11] + j * 1024; const float* b_s = p.in[13] + j * 1024;
    LAS unsigned char* Wt = p.lds; LAS unsigned char* Vt = p.lds + 128 * TP;
    const int tid = p.tid, lane = p.lane, w = p.wave, l15 = lane & 15, g4 = lane >> 4, q4 = (lane & 15) >> 2, pp = lane & 3;
    for (int u = p.bid; u < 129 * 8; u += p.G) {
        const int c = u >> 3, g = u & 7, row0 = c * 128; const bool smp = (c == 128);
        const bf16* Wsrc = p.w<bf16>(WS_WS + (smp ? 524288 : 0) + (size_t)j * 262144) + (size_t)g * 16384;
#pragma unroll
        for (int q = 0; q < 4; ++q) { const int ch = tid + 512 * q, row = ch >> 4, c16 = ch & 15;
            *(LAS u32x4*)(Wt + row * TP + c16 * 16) = *(const u32x4*)(Wsrc + row * 128 + c16 * 8); }
        { const int c16 = tid & 15, d0 = g * 128 + c16 * 8;
          const f32x4 g0 = *(const f32x4*)(ln_g + d0), g1 = *(const f32x4*)(ln_g + d0 + 4), b0 = *(const f32x4*)(ln_b + d0), b1 = *(const f32x4*)(ln_b + d0 + 4);
          u32x4 raw[4]; float mean[4], rstd[4];
#pragma unroll
          for (int q = 0; q < 4; ++q) { const int r = row0 + (tid >> 4) + 32 * q; raw[q] = *(const u32x4*)(GV + (size_t)r * 1024 + d0);
              const float mu = stat_get(lns + r) * (1.0f / 1024.0f), var = stat_get(lnq + r) * (1.0f / 1024.0f) - mu * mu; mean[q] = mu; rstd[q] = rsqrtf(var + LN_EPS); }
#pragma unroll
          for (int q = 0; q < 4; ++q) { const int s = (tid >> 4) + 32 * q, r = row0 + s;
            f32x4 v0, v1;
            v0[0] = bflo(raw[q].x); v0[1] = bfhi(raw[q].x); v0[2] = bflo(raw[q].y); v0[3] = bfhi(raw[q].y); v1[0] = bflo(raw[q].z); v1[1] = bfhi(raw[q].z); v1[2] = bflo(raw[q].w); v1[3] = bfhi(raw[q].w);
            v0 = (v0 - mean[q]) * rstd[q] * g0 + b0; v1 = (v1 - mean[q]) * rstd[q] * g1 + b1;
            if (smp && out_cv) { float* o = out_cv + (size_t)(r - MP) * 1024 + d0; *(f32x4*)o = v0; *(f32x4*)(o + 4) = v1; }
            *(LAS u32x4*)(Vt + s * TP + c16 * 16) = pack8(v0, v1); } }
        u32x2 uu[8];
#pragma unroll
        for (int tt = 0; tt < 8; ++tt) uu[tt] = *(const u32x2*)(U + (size_t)(row0 + 16 * tt + l15) * 1024 + g * 128 + 16 * w + 4 * g4);
        __syncthreads();
        f32x4 acc[8];
#pragma unroll
        for (int tt = 0; tt < 8; ++tt) acc[tt] = (f32x4){0.f, 0.f, 0.f, 0.f};
#pragma unroll
        for (int kk = 0; kk < 4; ++kk) {
            const bf16x8 X = cat8(tr16(Vt + (32 * kk + 8 * g4 + q4) * TP + (16 * w + 4 * pp) * 2), tr16(Vt + (32 * kk + 8 * g4 + 4 + q4) * TP + (16 * w + 4 * pp) * 2));
#pragma unroll
            for (int tt = 0; tt < 8; ++tt) if (32 * kk <= 16 * tt + 15) {
                const bf16x8 Y = *(const LAS bf16x8*)(Wt + (16 * tt + l15) * TP + (32 * kk + 8 * g4) * 2);
                acc[tt] = MFMA16(X, Y, acc[tt]); }
        }
#pragma unroll
        for (int tt = 0; tt < 8; ++tt) { const int t = 16 * tt + l15, r = row0 + t, col = g * 128 + 16 * w + 4 * g4;
            const float bias = b_s[g * 128 + (smp ? (t & 3) : t)];
            const float o0 = bflo(uu[tt].x) * (acc[tt][0] + bias), o1 = bfhi(uu[tt].x) * (acc[tt][1] + bias), o2 = bflo(uu[tt].y) * (acc[tt][2] + bias), o3 = bfhi(uu[tt].y) * (acc[tt][3] + bias);
            *(u32x2*)(UM + (size_t)r * 1024 + col) = (u32x2){cvt_pk_bf16(o0, o1), cvt_pk_bf16(o2, o3)}; }
        __syncthreads();
    }
}

__device__ __forceinline__ void b2_kvfinal(const P& p, float* out_mp, float* out_ms) {
    const float* RAW = p.w<float>(WS_RAW); bf16* KVB = p.w<bf16>(WS_KVB); const long long* ssq_kv = p.stat(ST_KV); const float* kvn = p.in[19]; const f32x2* rope = p.w<f32x2>(WS_ROPE);
    const int gw = p.bid * NWAVES + p.wave, NGW = p.G * NWAVES, lane = p.lane;
    for (int m = gw; m < MT; m += NGW) {
        float* o = m < MP ? (out_mp ? out_mp + (size_t)m * 320 : nullptr) : (out_ms ? out_ms + (size_t)(m - MP) * 320 : nullptr);
        const float rs = rsqrtf(stat_get(ssq_kv + m) * (1.0f / 256.0f) + RMS_EPS);
        const f32x4 v = *(const f32x4*)(RAW + (size_t)m * 768 + 4 * lane) * rs * *(const f32x4*)(kvn + 4 * lane);
        if (o) *(f32x4*)(o + 4 * lane) = v;
        *(u32x2*)(KVB + (size_t)m * 320 + 4 * lane) = (u32x2){cvt_pk_bf16(v[0], v[1]), cvt_pk_bf16(v[2], v[3])};
        if (lane < 32) { const int tp = m < MP ? (m & 2047) : 2048 + ((m - MP) & 3); const f32x2 cs = rope[(size_t)tp * 32 + lane];
            const float x1 = RAW[(size_t)m * 768 + 640 + lane], x2 = RAW[(size_t)m * 768 + 672 + lane];
            const float o1 = x1 * cs.x - x2 * cs.y, o2 = x1 * cs.y + x2 * cs.x;
            if (o) { o[256 + lane] = o1; o[288 + lane] = o2; }
            KVB[(size_t)m * 320 + 256 + lane] = (bf16)f2bf(o1); KVB[(size_t)m * 320 + 288 + lane] = (bf16)f2bf(o2); }
    }
}

__device__ __forceinline__ void b3_attn_prompt(const P& p) {
    const bf16* QF = p.w<bf16>(WS_QF); const bf16* KVB = p.w<bf16>(WS_KVB); bf16* OB = p.w<bf16>(WS_OB);
    const int lane = p.lane, h = p.wave, l15 = lane & 15, g4 = lane >> 4, q4 = (lane & 15) >> 2, pp = lane & 3;
    constexpr int TILE_B = 64 * 640;
    int soff[5];
#pragma unroll
    for (int i = 0; i < 5; ++i) { const int P_ = (h + 8 * i) * 64 + lane, row = P_ / 40, cph = P_ - 40 * row; soff[i] = row * 320 + ((cph ^ (row & 6)) << 3); }
    int kaddr[10];
#pragma unroll
    for (int s_ = 0; s_ < 10; ++s_) kaddr[s_] = l15 * 640 + (((4 * s_ + g4) ^ (l15 & 6)) << 4);
    int taddr[4];
    { const int rl = 4 * g4 + q4, m_ = (rl & 6) >> 1;
#pragma unroll
      for (int v3 = 0; v3 < 4; ++v3) taddr[v3] = rl * 640 + (((v3 ^ m_) << 1 | (pp >> 1)) << 4) + 8 * (pp & 1); }
#define AT_DMA(BUF, SRC) do { _Pragma("unroll") for (int i = 0; i < 5; ++i) \
        __builtin_amdgcn_global_load_lds((const unsigned*)((SRC) + soff[i]), (LAS unsigned*)((BUF) + (h + 8 * i) * 1024), 16, 0, 0); } while (0)
    for (int pi = p.bid; pi < 512; pi += p.G) {
        const int b = (p.G % 8 == 0) ? (pi & 7) : (pi >> 6), x = (p.G % 8 == 0) ? ((pi >> 3) & 63) : (pi & 63);
        for (int half = 0; half < 2; ++half) {
            const int qt = half ? 127 - x : x, t0 = 16 * qt, nkt = (t0 + 15) / 64 + 1;
            const size_t rowq = (size_t)b * 2048 + t0 + l15; const bf16* kvb = KVB + (size_t)b * 2048 * 320;
            AT_DMA(p.lds, kvb);
            bf16x8 Q[10];
#pragma unroll
            for (int s = 0; s < 10; ++s) Q[s] = as_bf16x8(*(const u32x4*)(QF + rowq * 2560 + h * 320 + 32 * s + 8 * g4));
            f32x4 O[16];
#pragma unroll
            for (int vt = 0; vt < 16; ++vt) O[vt] = (f32x4){0.f, 0.f, 0.f, 0.f};
            float mrun = -1e30f, lrun = 0.f;
            asm volatile("s_waitcnt vmcnt(0)" ::: "memory"); __syncthreads();
            for (int kt = 0; kt < nkt; ++kt) {
                LAS unsigned char* buf = p.lds + (kt & 1) * TILE_B;
                if (kt + 1 < nkt) AT_DMA(p.lds + ((kt + 1) & 1) * TILE_B, kvb + (size_t)64 * (kt + 1) * 320);
                f32x4 S[4];
#pragma unroll
                for (int k4 = 0; k4 < 4; ++k4) S[k4] = (f32x4){0.f, 0.f, 0.f, 0.f};
                { bf16x8 Kc[4], Kn[4];
#pragma unroll
                  for (int k4 = 0; k4 < 4; ++k4) Kc[k4] = *(const LAS bf16x8*)(buf + kaddr[0] + k4 * 10240);
#pragma unroll
                  for (int s = 0; s < 10; ++s) {
                      if (s < 9) {
#pragma unroll
                          for (int k4 = 0; k4 < 4; ++k4) Kn[k4] = *(const LAS bf16x8*)(buf + kaddr[s + 1] + k4 * 10240); }
#pragma unroll
                      for (int k4 = 0; k4 < 4; ++k4) S[k4] = MFMA16(Kc[k4], Q[s], S[k4]);
#pragma unroll
                      for (int k4 = 0; k4 < 4; ++k4) Kc[k4] = Kn[k4]; } }
                float mx = -1e30f;
#pragma unroll
                for (int k4 = 0; k4 < 4; ++k4)
#pragma unroll
                    for (int e = 0; e < 4; ++e) { float v = S[k4][e] * LOG2E; if (kt == nkt - 1 && 64 * kt + 16 * k4 + 4 * g4 + e > t0 + l15) v = -1e30f; S[k4][e] = v; mx = fmaxf(mx, v); }
                mx = fmaxf(mx, __shfl_xor(mx, 16)); mx = fmaxf(mx, __shfl_xor(mx, 32));
                const float mnew = fmaxf(mrun, mx), alpha = __builtin_amdgcn_exp2f(mrun - mnew); mrun = mnew;
                float ps = 0.f;
#pragma unroll
                for (int k4 = 0; k4 < 4; ++k4)
#pragma unroll
                    for (int e = 0; e < 4; ++e) { const float pv = __builtin_amdgcn_exp2f(S[k4][e] - mnew); S[k4][e] = pv; ps += pv; }
                lrun = lrun * alpha + ps;
#pragma unroll
                for (int vt = 0; vt < 16; ++vt) O[vt] *= alpha;
                bf16x8 Pf[2];
#pragma unroll
                for (int ks = 0; ks < 2; ++ks) Pf[ks] = as_bf16x8((u32x4){cvt_pk_bf16(S[2 * ks][0], S[2 * ks][1]), cvt_pk_bf16(S[2 * ks][2], S[2 * ks][3]), cvt_pk_bf16(S[2 * ks + 1][0], S[2 * ks + 1][1]), cvt_pk_bf16(S[2 * ks + 1][2], S[2 * ks + 1][3])});
#define AT_V(VT, KS, T) tr16(buf + taddr[(VT) & 3] + ((VT) >> 2) * 128 + (32 * (KS) + 16 * (T)) * 640)
                { s16x4 Vc[4], Vn[4];
                  Vc[0] = AT_V(0, 0, 0); Vc[1] = AT_V(0, 0, 1); Vc[2] = AT_V(0, 1, 0); Vc[3] = AT_V(0, 1, 1);
#pragma unroll
                  for (int vt = 0; vt < 16; ++vt) {
                      if (vt < 15) { Vn[0] = AT_V(vt + 1, 0, 0); Vn[1] = AT_V(vt + 1, 0, 1); Vn[2] = AT_V(vt + 1, 1, 0); Vn[3] = AT_V(vt + 1, 1, 1); }
                      O[vt] = MFMA16(cat8(Vc[0], Vc[1]), Pf[0], O[vt]); O[vt] = MFMA16(cat8(Vc[2], Vc[3]), Pf[1], O[vt]);
#pragma unroll
                      for (int i = 0; i < 4; ++i) Vc[i] = Vn[i]; } }
#undef AT_V
                asm volatile("s_waitcnt vmcnt(0)" ::: "memory"); __syncthreads();
            }
            const float linv = 1.0f / quad_red(lrun);
#pragma unroll
            for (int vt = 0; vt < 16; ++vt) { const f32x4 o = O[vt] * linv;
                *(u32x2*)(OB + rowq * 2048 + h * 256 + 16 * vt + 4 * g4) = (u32x2){cvt_pk_bf16(o[0], o[1]), cvt_pk_bf16(o[2], o[3])}; }
        }
    }
#undef AT_DMA
}

__device__ __forceinline__ void b3_attn_sample(const P& p) {
    const bf16* QF = p.w<bf16>(WS_QF); float* PART = p.w<float>(WS_PART); float* PML = p.w<float>(WS_PML);
    const float* cache = p.in[2]; const int* ptab = (const int*)p.in[5];
    const int tid = p.tid, lane = p.lane, w = p.wave, qt = w & 1, dvq = w >> 1, l15 = lane & 15, g4 = lane >> 4, q4 = (lane & 15) >> 2, pp = lane & 3;
    constexpr int TILE_B = 64 * KP;
    for (int u = p.bid; u < 256; u += p.G) {
        const int b = u >> 3, sp = u & 7;
        const int hq = 4 * qt + (l15 >> 2), iq = l15 & 3; const size_t rowq = (size_t)MP + 4 * b + iq;
        bf16x8 Q[10];
#pragma unroll
        for (int s = 0; s < 10; ++s) Q[s] = as_bf16x8(*(const u32x4*)(QF + rowq * 2560 + hq * 320 + 32 * s + 8 * g4));
        f32x4 O[4];
#pragma unroll
        for (int v = 0; v < 4; ++v) O[v] = (f32x4){0.f, 0.f, 0.f, 0.f};
        float mrun = -1e30f, lrun = 0.f;
        f32x4 st[10];
        auto tile_src = [&](int ti) -> const float* { const int pg = 16 * sp + (ti >> 1); return cache + ((size_t)ptab[b * 128 + pg] * 128 + 64 * (ti & 1)) * 320; };
        { const float* src = tile_src(0);
#pragma unroll
          for (int q = 0; q < 10; ++q) st[q] = __builtin_nontemporal_load((const f32x4*)(src + (size_t)(tid + 512 * q) * 4));
          __syncthreads();
#pragma unroll
          for (int q = 0; q < 10; ++q) { const int ch = tid + 512 * q, row = ch / 80, c4 = ch % 80; *(LAS u32x2*)(p.lds + row * KP + c4 * 8) = (u32x2){cvt_pk_bf16(st[q][0], st[q][1]), cvt_pk_bf16(st[q][2], st[q][3])}; }
          __syncthreads(); }
        for (int ti = 0; ti < 32; ++ti) {
            LAS unsigned char* buf = p.lds + (ti & 1) * TILE_B;
            if (ti + 1 < 32) { const float* src = tile_src(ti + 1);
#pragma unroll
                for (int q = 0; q < 10; ++q) st[q] = __builtin_nontemporal_load((const f32x4*)(src + (size_t)(tid + 512 * q) * 4)); }
            f32x4 S[4];
#pragma unroll
            for (int k4 = 0; k4 < 4; ++k4) { S[k4] = (f32x4){0.f, 0.f, 0.f, 0.f};
#pragma unroll
                for (int s = 0; s < 10; ++s) { const bf16x8 Kf = *(const LAS bf16x8*)(buf + (16 * k4 + l15) * KP + (32 * s + 8 * g4) * 2); S[k4] = MFMA16(Kf, Q[s], S[k4]); } }
            float mx = -1e30f;
#pragma unroll
            for (int k4 = 0; k4 < 4; ++k4)
#pragma unroll
                for (int e = 0; e < 4; ++e) { const float v = S[k4][e] * LOG2E; S[k4][e] = v; mx = fmaxf(mx, v); }
            mx = fmaxf(mx, __shfl_xor(mx, 16)); mx = fmaxf(mx, __shfl_xor(mx, 32));
            const float mnew = fmaxf(mrun, mx), alpha = __builtin_amdgcn_exp2f(mrun - mnew); mrun = mnew;
            float ps = 0.f;
#pragma unroll
            for (int k4 = 0; k4 < 4; ++k4)
#pragma unroll
                for (int e = 0; e < 4; ++e) { const float pv = __builtin_amdgcn_exp2f(S[k4][e] - mnew); S[k4][e] = pv; ps += pv; }
            lrun = lrun * alpha + ps;
#pragma unroll
            for (int v = 0; v < 4; ++v) O[v] *= alpha;
            bf16x8 Pf[2];
#pragma unroll
            for (int ks = 0; ks < 2; ++ks) Pf[ks] = as_bf16x8((u32x4){cvt_pk_bf16(S[2 * ks][0], S[2 * ks][1]), cvt_pk_bf16(S[2 * ks][2], S[2 * ks][3]), cvt_pk_bf16(S[2 * ks + 1][0], S[2 * ks + 1][1]), cvt_pk_bf16(S[2 * ks + 1][2], S[2 * ks + 1][3])});
#pragma unroll
            for (int v = 0; v < 4; ++v) { const int vt = 4 * dvq + v;
#pragma unroll
                for (int ks = 0; ks < 2; ++ks) {
                    const bf16x8 Vf = cat8(tr16(buf + (32 * ks + 4 * g4 + q4) * KP + (16 * vt + 4 * pp) * 2), tr16(buf + (32 * ks + 16 + 4 * g4 + q4) * KP + (16 * vt + 4 * pp) * 2));
                    O[v] = MFMA16(Vf, Pf[ks], O[v]); } }
            if (ti + 1 < 32) { LAS unsigned char* nb = p.lds + ((ti + 1) & 1) * TILE_B;
#pragma unroll
                for (int q = 0; q < 10; ++q) { const int ch = tid + 512 * q, row = ch / 80, c4 = ch % 80; *(LAS u32x2*)(nb + row * KP + c4 * 8) = (u32x2){cvt_pk_bf16(st[q][0], st[q][1]), cvt_pk_bf16(st[q][2], st[q][3])}; } }
            __syncthreads();
        }
        const float lsum = quad_red(lrun); const int qrow = 16 * qt + l15; const size_t pb = ((size_t)(b * 8 + sp) * 32 + qrow);
#pragma unroll
        for (int v = 0; v < 4; ++v) *(f32x4*)(PART + pb * 256 + 16 * (4 * dvq + v) + 4 * g4) = O[v];
        if (dvq == 0 && g4 == 0) { PML[pb * 2] = mrun; PML[pb * 2 + 1] = lsum; }
    }
}
__device__ __forceinline__ void b3_combine(const P& p) {
    const bf16* QF = p.w<bf16>(WS_QF); const bf16* KVB = p.w<bf16>(WS_KVB); bf16* OB = p.w<bf16>(WS_OB); const float* PART = p.w<float>(WS_PART); const float* PML = p.w<float>(WS_PML);
    const int dv = p.tid & 255, sub = p.tid >> 8;
    for (int it = 2 * p.bid + sub; it < 1024; it += 2 * p.G) {
        const int b = it >> 5, i = (it >> 3) & 3, h = it & 7, qt = h >> 2, ql = ((h & 3) << 2) | i, qrow = 16 * qt + ql; const size_t row = (size_t)MP + 4 * b + i;
        float sn[4];
#pragma unroll
        for (int kk = 0; kk < 4; ++kk) { float s = 0.f;
            if (kk <= i) { const unsigned* qp = (const unsigned*)(QF + row * 2560 + h * 320); const unsigned* kp = (const unsigned*)(KVB + ((size_t)MP + 4 * b + kk) * 320);
                for (int d = 0; d < 160; ++d) { const unsigned a = qp[d], c = kp[d]; s += bflo(a) * bflo(c) + bfhi(a) * bfhi(c); } }
            sn[kk] = (kk <= i) ? s * LOG2E : -1e30f; }
        float M = fmaxf(fmaxf(sn[0], sn[1]), fmaxf(sn[2], sn[3])); float ms[8], ls[8];
#pragma unroll
        for (int sp = 0; sp < 8; ++sp) { const size_t pb = ((size_t)(b * 8 + sp) * 32 + qrow); ms[sp] = PML[pb * 2]; ls[sp] = PML[pb * 2 + 1]; M = fmaxf(M, ms[sp]); }
        float L = 0.f, Oa = 0.f;
#pragma unroll
        for (int sp = 0; sp < 8; ++sp) { const size_t pb = ((size_t)(b * 8 + sp) * 32 + qrow); const float wgt = __builtin_amdgcn_exp2f(ms[sp] - M); L += ls[sp] * wgt; Oa += PART[pb * 256 + dv] * wgt; }
#pragma unroll
        for (int kk = 0; kk < 4; ++kk) { const float pk = __builtin_amdgcn_exp2f(sn[kk] - M); L += pk; Oa += pk * bf2f(KVB[((size_t)MP + 4 * b + kk) * 320 + dv]); }
        OB[row * 2048 + h * 256 + dv] = (bf16)f2bf(Oa / L);
    }
}

template <bool SMP>
__device__ __forceinline__ f32x4 conv4(const float* XW, const float* cbuf  , const float* cw, const float* cb, int m, int c) {
    f32x4 acc = *(const f32x4*)(cb + c);
    f32x4 v[4], wv[4];
#pragma unroll
    for (int k = 0; k < 4; ++k) { wv[k] = *(const f32x4*)(cw + k * 1280 + c);
        if (!SMP) { const int t = m & 2047, r = t + k - 3; v[k] = *(const f32x4*)(XW + (size_t)(m + (r >= 0 ? k - 3 : -t)) * 1280 + c); if (r < 0) wv[k] = (f32x4){0.f, 0.f, 0.f, 0.f}; }
        else { const int b = (m - MP) >> 2, t = (m - MP) & 3, r = t + k - 3; const float* ptr = (r >= 0) ? XW + (size_t)(m + k - 3) * 1280 + c : cbuf + ((size_t)b * 3 + (3 + r)) * 1280 + c; v[k] = *(const f32x4*)ptr; } }
#pragma unroll
    for (int k = 0; k < 4; ++k) acc += wv[k] * v[k];
    return acc;
}
__device__ __forceinline__ void c2_rglru(const P& p, int j, float* out_cp, float* out_cs, float* out_hs, const int mask) {
    const float* XW = p.w<float>(WS_XW); bf16* LH = p.w<bf16>(WS_AA); bf16* CPB = p.w<bf16>(WS_BB); float* AGG = p.w<float>(WS_AGG);
    const float* cbuf = p.in[4] + (size_t)j * 32 * 3 * 1280; const float* cw = p.in[25] + (size_t)j * 4 * 1280; const float* cb = p.in[26] + j * 1280;
    const float* b_a = p.in[28] + j * 1280; const float* b_i = p.in[30] + j * 1280; const float* lam = p.in[31] + j * 1280; const float* h0s = p.in[3] + (size_t)j * 32 * 1280;
    const bf16* WaT = p.w<bf16>(WS_WAT); const bf16* WiT = p.w<bf16>(WS_WIT);
    LAS unsigned char* Xt = p.lds; LAS unsigned char* At = p.lds + 128 * TP; LAS unsigned char* It = p.lds + 256 * TP;
    LAS float* LA = (LAS float*)p.lds;
    LAS unsigned char* LB = p.lds + 128 * 528;
    LAS float* QT = (LAS float*)(p.lds + 128 * 528 + 128 * TP);
    const int tid = p.tid, lane = p.lane, w = p.wave, l15 = lane & 15, g4 = lane >> 4;
    { const int gt = p.bid * 512 + tid, NGT = p.G * 512;
      for (int i = gt; i < (8 + 32) * 3 * 320; i += NGT) { const int c = (i % 320) * 4, rr = i / 320, jj = rr % 3, bb = rr / 3;
          if (bb < 8) { if (out_cp) *(f32x4*)(out_cp + ((size_t)bb * 3 + jj) * 1280 + c) = *(const f32x4*)(XW + ((size_t)bb * 2048 + 2045 + jj) * 1280 + c); }
          else { const int b = bb - 8; if (out_cs) *(f32x4*)(out_cs + ((size_t)b * 3 + jj) * 1280 + c) = *(const f32x4*)(XW + ((size_t)MP + 4 * b + 1 + jj) * 1280 + c); } } }
    for (int u = p.bid; u < 129 * 10; u += p.G) {
        const int T = u / 10, n = u % 10, row0 = T * 128;
        if (mask & 4096) {
            const int c16 = tid & 15, cch = n * 128 + c16 * 8;
            f32x4 wv[4][2], bv[2];
#pragma unroll
            for (int k = 0; k < 4; ++k) { wv[k][0] = *(const f32x4*)(cw + k * 1280 + cch); wv[k][1] = *(const f32x4*)(cw + k * 1280 + cch + 4); }
            bv[0] = *(const f32x4*)(cb + cch); bv[1] = *(const f32x4*)(cb + cch + 4);
            u32x4 wa[4], wi[4];
#pragma unroll
            for (int q = 0; q < 4; ++q) { const int row = (tid >> 4) + 32 * q; wa[q] = *(const u32x4*)(WaT + (size_t)n * 16384 + row * 128 + c16 * 8); wi[q] = *(const u32x4*)(WiT + (size_t)n * 16384 + row * 128 + c16 * 8); }
#pragma unroll
            for (int qh = 0; qh < 2; ++qh) {
                f32x4 xv[2][4][2];
#pragma unroll
                for (int qq = 0; qq < 2; ++qq) { const int m = row0 + (tid >> 4) + 32 * (2 * qh + qq);
#pragma unroll
                    for (int k = 0; k < 4; ++k) { const float* ptr;
                        if (T < 128) { const int t = m & 2047, r = t + k - 3; ptr = XW + (size_t)(m + (r >= 0 ? k - 3 : -t)) * 1280 + cch; }
                        else { const int b = (m - MP) >> 2, t = (m - MP) & 3, r = t + k - 3; ptr = (r >= 0) ? XW + (size_t)(m + k - 3) * 1280 + cch : cbuf + ((size_t)b * 3 + (3 + r)) * 1280 + cch; }
                        xv[qq][k][0] = *(const f32x4*)ptr; xv[qq][k][1] = *(const f32x4*)(ptr + 4); } }
#pragma unroll
                for (int qq = 0; qq < 2; ++qq) { const int row = (tid >> 4) + 32 * (2 * qh + qq), m = row0 + row; f32x4 v0 = bv[0], v1 = bv[1];
#pragma unroll
                    for (int k = 0; k < 4; ++k) { const bool live = (T >= 128) || (((m & 2047) + k - 3) >= 0); const f32x4 z = (f32x4){0.f, 0.f, 0.f, 0.f};
                        v0 += (live ? wv[k][0] : z) * xv[qq][k][0]; v1 += (live ? wv[k][1] : z) * xv[qq][k][1]; }
                    *(LAS u32x4*)(Xt + row * TP + c16 * 16) = pack8(v0, v1); } }
#pragma unroll
            for (int q = 0; q < 4; ++q) { const int row = (tid >> 4) + 32 * q; *(LAS u32x4*)(At + row * TP + c16 * 16) = wa[q]; *(LAS u32x4*)(It + row * TP + c16 * 16) = wi[q]; }
        }
        __syncthreads();
        f32x4 ca[8], ci[8];
#pragma unroll
        for (int tt = 0; tt < 8; ++tt) { ca[tt] = (f32x4){0.f, 0.f, 0.f, 0.f}; ci[tt] = (f32x4){0.f, 0.f, 0.f, 0.f}; }
        if (mask & 8192) {
#pragma unroll
        for (int kk = 0; kk < 4; ++kk) {
            const bf16x8 Xa = *(const LAS bf16x8*)(At + (16 * w + l15) * TP + (32 * kk + 8 * g4) * 2), Xi = *(const LAS bf16x8*)(It + (16 * w + l15) * TP + (32 * kk + 8 * g4) * 2);
#pragma unroll
            for (int tt = 0; tt < 8; ++tt) { const bf16x8 Y = *(const LAS bf16x8*)(Xt + (16 * tt + l15) * TP + (32 * kk + 8 * g4) * 2);
                ca[tt] = MFMA16(Xa, Y, ca[tt]); ci[tt] = MFMA16(Xi, Y, ci[tt]); }
        }
        const int chn = n * 128 + 16 * w + 4 * g4;
        { const f32x4 ba = *(const f32x4*)(b_a + chn), bi = *(const f32x4*)(b_i + chn), lm = *(const f32x4*)(lam + chn);
          f32x4 sp;
#pragma unroll
          for (int e = 0; e < 4; ++e) { const float nl = -lm[e]; sp[e] = -8.0f * LOG2E * ((nl > 20.f) ? nl : log1pf(expf(nl))); }
#pragma unroll
          for (int tt = 0; tt < 8; ++tt) { const u32x2 xb = *(const LAS u32x2*)(Xt + (16 * tt + l15) * TP + (16 * w + 4 * g4) * 2);
              const f32x4 xc = (f32x4){bflo(xb.x), bfhi(xb.x), bflo(xb.y), bfhi(xb.y)};
#pragma unroll
              for (int e = 0; e < 4; ++e) { const float r = fast_sigmoid_l2(LOG2E * (ca[tt][e] + ba[e])), gi = fast_sigmoid_l2(LOG2E * (ci[tt][e] + bi[e]));
                  const float a = __builtin_amdgcn_exp2f(r * sp[e]);
                  ca[tt][e] = a; ci[tt][e] = __builtin_amdgcn_sqrtf(fmaxf(__builtin_fmaf(-a, a, 1.0f), 0.f)) * gi * xc[e]; } } }
        }
        __syncthreads();
#pragma unroll
        for (int tt = 0; tt < 8; ++tt) { const int tok = 16 * tt + l15;
            *(LAS f32x4*)(LA + tok * 132 + 16 * w + 4 * g4) = ca[tt];
            *(LAS u32x2*)(LB + tok * TP + (16 * w + 4 * g4) * 2) = (u32x2){cvt_pk_bf16(ci[tt][0], ci[tt][1]), cvt_pk_bf16(ci[tt][2], ci[tt][3])}; }
        __syncthreads();
        const int ch = tid & 127, q = tid >> 7, chg = n * 128 + ch;
        if (mask & 16384) {
        if (T < 128) {
            float P_ = 1.f, H_ = 0.f;
#pragma unroll 8
            for (int t = 32 * q; t < 32 * q + 32; ++t) { const float a = LA[t * 132 + ch], b = bf2f(*(const LAS bf16*)(LB + t * TP + ch * 2)); H_ = a * H_ + b; P_ *= a; }
            QT[(q * 128 + ch) * 2] = P_; QT[(q * 128 + ch) * 2 + 1] = H_;
            __syncthreads();
            float h = 0.f, pc = 1.f;
#pragma unroll
            for (int qq = 0; qq < 3; ++qq) if (qq < q) { const float Pq = QT[(qq * 128 + ch) * 2], Hq = QT[(qq * 128 + ch) * 2 + 1]; h = Pq * h + Hq; pc *= Pq; }
#pragma unroll 8
            for (int t = 32 * q; t < 32 * q + 32; ++t) { const float a = LA[t * 132 + ch], b = bf2f(*(const LAS bf16*)(LB + t * TP + ch * 2)); h = a * h + b; pc *= a;
                LA[t * 132 + ch] = pc; *(LAS bf16*)(LB + t * TP + ch * 2) = (bf16)f2bf(h); }
            if (q == 3) { AGG[((size_t)T * 2) * 1280 + chg] = pc; AGG[((size_t)T * 2 + 1) * 1280 + chg] = h; }
        } else {
            for (int bb = 8 * q; bb < 8 * q + 8; ++bb) { float h = h0s[(size_t)bb * 1280 + chg];
#pragma unroll
                for (int i = 0; i < 4; ++i) { const int t = 4 * bb + i; const float a = LA[t * 132 + ch], b = bf2f(*(const LAS bf16*)(LB + t * TP + ch * 2)); h = a * h + b;
                    LA[t * 132 + ch] = 0.f; *(LAS bf16*)(LB + t * TP + ch * 2) = (bf16)f2bf(h); }
                if (out_hs) out_hs[(size_t)bb * 1280 + chg] = h; }
        }
        }
        __syncthreads();
        if (mask & 32768)
#pragma unroll
        for (int i = 0; i < 4; ++i) { const int cidx = tid + 512 * i, tok = cidx >> 4, c8 = (cidx & 15) * 8; const size_t o = (size_t)(row0 + tok) * 1280 + n * 128 + c8;
            *(u32x4*)(LH + o) = *(const LAS u32x4*)(LB + tok * TP + c8 * 2);
            *(u32x4*)(CPB + o) = pack8(*(const LAS f32x4*)(LA + tok * 132 + c8), *(const LAS f32x4*)(LA + tok * 132 + c8 + 4)); }
        __syncthreads();
    }
}
__device__ __forceinline__ void c5_fixup(const P& p, float* out_hp) {
    const bf16* LH = p.w<bf16>(WS_AA); const bf16* CPB = p.w<bf16>(WS_BB); const float* AGG = p.w<float>(WS_AGG); const bf16* GATE = p.w<bf16>(WS_GATE); bf16* GH = p.w<bf16>(WS_GH);
    LAS float* cr = (LAS float*)p.lds;
    const int tid = p.tid;
    for (int ci = p.bid * 512 + tid; ci < 128 * 160; ci += p.G * 512) { const size_t o = (size_t)MP * 1280 + (size_t)ci * 8;
        const u32x4 lh = *(const u32x4*)(LH + o), gt = *(const u32x4*)(GATE + o); f32x4 r0, r1;
        r0[0] = bflo(gt.x) * bflo(lh.x); r0[1] = bfhi(gt.x) * bfhi(lh.x); r0[2] = bflo(gt.y) * bflo(lh.y); r0[3] = bfhi(gt.y) * bfhi(lh.y);
        r1[0] = bflo(gt.z) * bflo(lh.z); r1[1] = bfhi(gt.z) * bfhi(lh.z); r1[2] = bflo(gt.w) * bflo(lh.w); r1[3] = bfhi(gt.w) * bfhi(lh.w);
        *(u32x4*)(GH + o) = pack8(r0, r1); }
    for (int it = p.bid; it < 256; it += p.G) {
        const int T = it >> 1, hf = it & 1, row0 = T * 128 + 64 * hf, T0 = T & ~15, nd = T - T0;
        const size_t ob = (size_t)row0 * 1280 + (size_t)tid * 8;
#define C5_LOAD(LHV, CPV, GTV, K) do { _Pragma("unroll") for (int i = 0; i < 5; ++i) { const size_t o = ob + (size_t)(5 * (K) + i) * 4096; \
            LHV[i] = *(const u32x4*)(LH + o); CPV[i] = *(const u32x4*)(CPB + o); GTV[i] = *(const u32x4*)(GATE + o); } } while (0)
        u32x4 lhA[5], cpA[5], gtA[5], lhB[5], cpB[5], gtB[5];
        C5_LOAD(lhA, cpA, gtA, 0);
        for (int ch = tid; ch < 1280; ch += 512) {
            float pa[16], ha[16];
#pragma unroll
            for (int d = 0; d < 16; ++d) { pa[d] = AGG[((size_t)(T0 + d) * 2) * 1280 + ch]; ha[d] = AGG[((size_t)(T0 + d) * 2 + 1) * 1280 + ch]; }
            float c = 0.f;
#pragma unroll
            for (int d = 0; d < 15; ++d) c = (d < nd) ? pa[d] * c + ha[d] : c;
            if (nd == 15 && hf == 1 && out_hp) out_hp[(size_t)(T >> 4) * 1280 + ch] = pa[15] * c + ha[15];
            cr[ch] = c; }
        __syncthreads();
#define C5_ITEM(LHV, CPV, GTV, I) do { const int c8 = ((tid + 512 * (I)) % 160) * 8; const size_t o = ob + (size_t)(I) * 4096; \
            const f32x4 c0 = *(const LAS f32x4*)(cr + c8), c1 = *(const LAS f32x4*)(cr + c8 + 4); f32x4 r0, r1; \
            r0[0] = bflo(GTV.x) * (bflo(LHV.x) + bflo(CPV.x) * c0[0]); r0[1] = bfhi(GTV.x) * (bfhi(LHV.x) + bfhi(CPV.x) * c0[1]); \
            r0[2] = bflo(GTV.y) * (bflo(LHV.y) + bflo(CPV.y) * c0[2]); r0[3] = bfhi(GTV.y) * (bfhi(LHV.y) + bfhi(CPV.y) * c0[3]); \
            r1[0] = bflo(GTV.z) * (bflo(LHV.z) + bflo(CPV.z) * c1[0]); r1[1] = bfhi(GTV.z) * (bfhi(LHV.z) + bfhi(CPV.z) * c1[1]); \
            r1[2] = bflo(GTV.w) * (bflo(LHV.w) + bflo(CPV.w) * c1[2]); r1[3] = bfhi(GTV.w) * (bfhi(LHV.w) + bfhi(CPV.w) * c1[3]); \
            *(u32x4*)(GH + o) = pack8(r0, r1); } while (0)
        C5_LOAD(lhB, cpB, gtB, 1);
#pragma unroll
        for (int i = 0; i < 5; ++i) C5_ITEM(lhA[i], cpA[i], gtA[i], i);
        C5_LOAD(lhA, cpA, gtA, 2);
#pragma unroll
        for (int i = 0; i < 5; ++i) C5_ITEM(lhB[i], cpB[i], gtB[i], 5 + i);
        C5_LOAD(lhB, cpB, gtB, 3);
#pragma unroll
        for (int i = 0; i < 5; ++i) C5_ITEM(lhA[i], cpA[i], gtA[i], 10 + i);
#pragma unroll
        for (int i = 0; i < 5; ++i) C5_ITEM(lhB[i], cpB[i], gtB[i], 15 + i);
#undef C5_LOAD
#undef C5_ITEM
        __syncthreads();
    }
}
__device__ __forceinline__ void final_norm(const P& p, float* out_yp, float* out_ys) {
    const bf16* HB = p.w<bf16>(WS_HB); const long long* ssq = p.stat(ST_SSQ0 + 8); const float* g = p.in[8];
    const int gw = p.bid * NWAVES + p.wave, NGW = p.G * NWAVES, lane = p.lane;
    f32x4 gv[4];
#pragma unroll
    for (int jj = 0; jj < 4; ++jj) gv[jj] = *(const f32x4*)(g + 4 * lane + 256 * jj);
    u32x2 hw[4], hn[4]; long long sq = 0, sn = 0;
    if (gw < MT) { sq = ssq[gw];
#pragma unroll
        for (int jj = 0; jj < 4; ++jj) hw[jj] = *(const u32x2*)(HB + (size_t)gw * 1024 + 4 * lane + 256 * jj); }
    for (int m = gw; m < MT; m += NGW) { float* o = m < MP ? out_yp + (size_t)m * 1024 : out_ys + (size_t)(m - MP) * 1024;
        const int mn = (m + NGW < MT) ? m + NGW : m; sn = ssq[mn];
#pragma unroll
        for (int jj = 0; jj < 4; ++jj) hn[jj] = *(const u32x2*)(HB + (size_t)mn * 1024 + 4 * lane + 256 * jj);
        const float rs = rsqrtf((float)sq * ST_INV * (1.0f / 1024.0f) + RMS_EPS);
#pragma unroll
        for (int jj = 0; jj < 4; ++jj) *(f32x4*)(o + 4 * lane + 256 * jj) = (f32x4){bflo(hw[jj].x), bfhi(hw[jj].x), bflo(hw[jj].y), bfhi(hw[jj].y)} * rs * gv[jj];
#pragma unroll
        for (int jj = 0; jj < 4; ++jj) hw[jj] = hn[jj];
        sq = sn; }
}
}
namespace mk {
struct Args { const float* in[36]; float* out; unsigned char* ws; int ph_lo, ph_hi, li, mask; };
constexpr int NPHASE = 34;

#define MK_GEMM(EpiT, E, Aptr, LDA, Bptr, LDB, KD, NC) do { pg8::Gemm g_{(const pg8::bf16_t*)(Aptr), (const pg8::bf16_t*)(Bptr), (LDA), (LDB), (KD)}; pg8::StaticOrder S_; S_.init(MP, (NC), p.G, p.bid); \
        pg8::gemm_phase<EpiT, pg8::StaticOrder, true, true>(p.lds, g_, S_, E, p.tid); \
          \
        P q_ = p; { int t2_ = p0.tid; asm volatile("" : "+v"(t2_)); q_.tid = t2_; q_.lane = t2_ & 63; q_.wave = __builtin_amdgcn_readfirstlane(t2_ >> 6); } \
        mini_gemm<EpiT>(q_, (const bf16*)(Aptr), (LDA), (const bf16*)(Bptr), (LDB), (KD), (NC), E, (64 * ((NC) / 256)) % p.G); } while (0)

#ifdef MK_DRYPROBE
#define MK_DRYARG , ((mask >> 10) & 1)
#else
#define MK_DRYARG
#endif
#ifndef MK_REP_SEL
#define MK_REP_SEL(k) 0
#define MK_REP_N 1
#endif
#define REPF(k) for (int rep_ = 0; rep_ < (MK_REP_SEL(k) ? MK_REP_N : 1); ++rep_)
#define IN_(k) (lo <= (k) && (k) < hi)
#define PH_BEGIN() P p = p0; { int z_ = 0, t_ = p0.tid, g_ = p0.G, b_ = p0.bid; unsigned l_ = (unsigned)(size_t)p0.lds; asm volatile("" : "+s"(z_), "+v"(t_), "+s"(g_), "+s"(b_), "+s"(l_)); p.ws = p0.ws + z_; p.out = p0.out + z_; p.tid = t_; p.lane = t_ & 63; p.wave = __builtin_amdgcn_readfirstlane(t_ >> 6); p.G = g_; p.bid = b_; p.lds = (LAS unsigned char*)(size_t)l_; } float* const out = p.out; (void)out
#ifdef MK_PROF
#define STAMP(k) do { if (p0.bid == 0 && p0.tid == 0) ((unsigned long long*)(p0.ws + WS_PROF))[(k)] = (unsigned long long)wall_clock64(); } while (0)
#else
#define STAMP(k) do { } while (0)
#endif
#define ENDPH(k) do { if ((k) + 1 < hi) xcd_barrier(bar); STAMP((k) + 1); } while (0)
template <int LAYER> __device__ __forceinline__ void run_layer(const P& p0, const XcdBarrier& bar, const int lo, const int hi, const int mask) {
        constexpr int layer = LAYER, kind = layer % 3, j = layer / 3, pb = 1 + 8 * layer;
        constexpr size_t resA = kind == 0 ? WS_UM : kind == 1 ? WS_OB : WS_GH, resB = kind == 0 ? WS_WOUT + (size_t)j * 2 * MiB : kind == 1 ? WS_WOV : WS_WCO; constexpr int resK = kind == 0 ? 1024 : kind == 1 ? 2048 : 1280;
        if constexpr (kind == 0) {
            if (IN_(pb)) REPF(pb) { PH_BEGIN(); EpiA1 E{p.w<bf16>(WS_U), p.w<bf16>(WS_GV), p.stat(ST_SSQ0 + 2 * layer), p.stat(ST_LNS0 + 2 * j), p.stat(ST_LNQ0 + 2 * j) MK_DRYARG};
                MK_GEMM(EpiA1, E, p.w<bf16>(WS_HB), 1024, p.w<bf16>(WS_WIN + (size_t)j * 4 * MiB), 1024, 1024, 2048); ENDPH(pb); }
            if (IN_(pb + 1)) REPF(pb + 1) { PH_BEGIN(); a2_spatial(p, j, out + O_CV + (size_t)j * 131072); ENDPH(pb + 1); }
        } else if constexpr (kind == 1) {
            if (IN_(pb)) REPF(pb) { PH_BEGIN(); EpiB1 E{p.w<float>(WS_RAW), p.w<bf16>(WS_CQB), p.stat(ST_SSQ0 + 2 * layer), p.stat(ST_KV), p.stat(ST_Q) MK_DRYARG};
                MK_GEMM(EpiB1, E, p.w<bf16>(WS_HB), 1024, p.w<bf16>(WS_WDQKV), 1024, 1024, 768); ENDPH(pb); }
            if (IN_(pb + 1)) REPF(pb + 1) { PH_BEGIN(); b2_kvfinal(p, out + O_MP, out + O_MS);
                EpiB2 E{p.w<bf16>(WS_QF), p.stat(ST_Q), p.w<f32x2>(WS_ROPE)};
                MK_GEMM(EpiB2, E, p.w<bf16>(WS_CQB), 384, p.w<bf16>(WS_WQ), 384, 384, 2560); ENDPH(pb + 1); }
            if (IN_(pb + 2)) REPF(pb + 2) { PH_BEGIN();
                if (mask & 256) b3_attn_prompt(p); if (mask & 512) b3_attn_sample(p);
                ENDPH(pb + 2); }
            if (IN_(pb + 3)) REPF(pb + 3) { PH_BEGIN(); b3_combine(p); ENDPH(pb + 3); }
        } else {
            if (IN_(pb)) REPF(pb) { PH_BEGIN(); EpiC1 E{p.w<bf16>(WS_GATE), p.w<float>(WS_XW), p.stat(ST_SSQ0 + 2 * layer)};
                MK_GEMM(EpiC1, E, p.w<bf16>(WS_HB), 1024, p.w<bf16>(WS_WGX), 1024, 1024, 2560); ENDPH(pb); }
            if (IN_(pb + 1)) REPF(pb + 1) { PH_BEGIN(); c2_rglru(p, j, out + O_CP, out + O_CS, out + O_HS, mask); ENDPH(pb + 1); }
            if (IN_(pb + 3)) REPF(pb + 3) { PH_BEGIN(); c5_fixup(p, out + O_HP); ENDPH(pb + 3); }
        }
        if (IN_(pb + 5)) REPF(pb + 5) { PH_BEGIN(); EpiRes E{p.w<bf16>(WS_HB), p.stat(ST_SSQ0 + 2 * layer + 1) MK_DRYARG}; MK_GEMM(EpiRes, E, p.w<bf16>(resA), resK, p.w<bf16>(resB), resK, resK, 1024); ENDPH(pb + 5); }
        if (IN_(pb + 6)) REPF(pb + 6) { PH_BEGIN(); EpiF1 E{p.w<bf16>(WS_ACT), p.stat(ST_SSQ0 + 2 * layer + 1)}; MK_GEMM(EpiF1, E, p.w<bf16>(WS_HB), 1024, p.w<bf16>(WS_WGU + (size_t)layer * WGU_BYTES), 1024, 1024, 5632); ENDPH(pb + 6); }
        if (IN_(pb + 7)) REPF(pb + 7) { PH_BEGIN(); EpiRes E{p.w<bf16>(WS_HB), p.stat(ST_SSQ0 + 2 * layer + 2) MK_DRYARG}; MK_GEMM(EpiRes, E, p.w<bf16>(WS_ACT), DFF, p.w<bf16>(WS_WD + (size_t)layer * WD_BYTES), DFF, DFF, 1024); ENDPH(pb + 7); }
}
__global__ void __launch_bounds__(NWAVES * 64, 2) mk_fwd(Args a) {
    extern __shared__ __attribute__((aligned(16))) unsigned char lds_raw[];
    const int tid_ = threadIdx.x;
    const P p0{InTab{(const float* const __attribute__((address_space(4)))*)__builtin_amdgcn_kernarg_segment_ptr()}, a.out, a.ws, (LAS unsigned char*)lds_raw, tid_, tid_ & 63, __builtin_amdgcn_readfirstlane(tid_ >> 6), (int)gridDim.x, (int)blockIdx.x};
    volatile LAS unsigned* MISC = (volatile LAS unsigned*)(p0.lds + MISC_OFF);
    if (p0.tid < 64) MISC[p0.tid] = 0u;
    __syncthreads();
    XcdBarrier bar = xcd_barrier_post((unsigned*)(a.ws + WS_CTL) + CW_BAR + a.li * XCD_BAR_WORDS, MISC + 8);
    const int lo = a.ph_lo, hi = a.ph_hi, mask = a.mask;
    STAMP(0);
    if (IN_(0)) REPF(0) { PH_BEGIN(); p0_prologue(p, mask); if (mask & 128)
        { const int gt = p.bid * 512 + p.tid, NGT = p.G * 512; const u32x4 z = (u32x4){0u, 0u, 0u, 0u};
          for (int i = gt; i < 128 * 128; i += NGT) p.w<u32x4>(WS_UM + (size_t)MT * 2048)[i] = z;
          for (int i = gt; i < 128 * 256; i += NGT) p.w<u32x4>(WS_OB + (size_t)MT * 4096)[i] = z;
          for (int i = gt; i < 128 * 160; i += NGT) p.w<u32x4>(WS_GH + (size_t)MT * 2560)[i] = z; }
        ENDPH(0); }
    run_layer<0>(p0, bar, lo, hi, mask); run_layer<1>(p0, bar, lo, hi, mask); run_layer<2>(p0, bar, lo, hi, mask); run_layer<3>(p0, bar, lo, hi, mask);
    if (IN_(33)) REPF(33) { PH_BEGIN(); final_norm(p, out + O_YP, out + O_YS); VM_WAIT(); STAMP(34); }
#undef IN_
#undef ENDPH
}

inline void fill_args(Args& a, void* const* d_in, float* out, void* d_ws) { for (int i = 0; i < 36; ++i) a.in[i] = (const float*)d_in[i]; a.out = out; a.ws = (unsigned char*)d_ws; a.mask = -1; }
inline int setup_grid() {
    static int grid = 0;
    if (!grid) { int dev = 0, cus = 0; hipGetDevice(&dev); hipDeviceGetAttribute(&cus, hipDeviceAttributeMultiprocessorCount, dev);
        hipFuncSetAttribute((const void*)mk_fwd, hipFuncAttributeMaxDynamicSharedMemorySize, LDS_BYTES);
        int per_cu = 0; hipOccupancyMaxActiveBlocksPerMultiprocessor(&per_cu, (const void*)mk_fwd, NWAVES * 64, LDS_BYTES); (void)hipGetLastError();
        grid = cus > 0 ? cus : 256; }
    return grid;
}
inline void launch_range(void* const* d_in, float* out, void* d_ws, hipStream_t st, int lo, int hi, int li, int mask = -1) {
    Args a{}; fill_args(a, d_in, out, d_ws); a.ph_lo = lo; a.ph_hi = hi; a.li = li; a.mask = mask;
    hipLaunchKernelGGL(mk_fwd, dim3(setup_grid()), dim3(NWAVES * 64), LDS_BYTES, st, a);
}
}

extern "C" void kernel_launch(void* const* d_in, const int* in_sizes, int n_in, void* d_out, int out_size, void* d_ws, size_t ws_size, hipStream_t stream) {
    hipMemsetAsync(d_ws, 0, mk::CTL_BYTES, stream);
    mk::launch_range(d_in, (float*)d_out, d_ws, stream, 0, mk::NPHASE, 0);
}
```

```cpp
#include <hip/hip_runtime.h>
#include <math.h>
#define LAS __attribute__((address_space(3)))
#define GAS __attribute__((address_space(1)))
namespace pg8 {
#define PG8_LAS __attribute__((address_space(3)))
typedef unsigned short bf16_t;
typedef short bf16x8 __attribute__((ext_vector_type(8)));
typedef float f32x4 __attribute__((ext_vector_type(4)));
typedef unsigned u32x4 __attribute__((ext_vector_type(4)));
constexpr int BM = 256, BK = 64, HALF = 128, HTB = HALF * BK * 2  , STAGE_BYTES = 8 * HTB, NXCD = 8, WGM = 8;
__host__ __device__ __forceinline__ int lds_byte(int r, int c) { const int st = (r >> 4) * 2 + (c >> 5), rr = r & 15, cc = c & 31, ob = rr * 64 + cc * 2; return st * 1024 + (ob ^ (((ob >> 9) & 1) << 5)); }
__host__ __device__ __forceinline__ void stage_rc(int b, int& R, int& C) { const int st = b / 1024, sb = b % 1024, swz = sb ^ (((sb >> 9) & 1) << 5); R = (st >> 1) * 16 + swz / 64; C = (st & 1) * 32 + (swz % 64) / 2; }
__host__ __device__ __forceinline__ int perm32(int rho) { const int n = rho >> 4, i = rho & 15; return 8 * (i >> 2) + 4 * n + (i & 3); }
struct Unit { int pm, pn; };
struct Gemm { const bf16_t* A; const bf16_t* Bt; int lda, ldb, K; };
struct StaticOrder {
    int nM, nN, nwg, G, c;
    __host__ __device__ void init(int M, int N, int G_, int c_) { nM = M / BM; nN = N / BM; nwg = nM * nN; G = G_; c = c_; }
    __host__ __device__ bool next(int i, Unit& u) const {
        const long L = (long)i * G + c; if (L >= nwg) return false;
        int wgid = (int)L; { const int q = nwg / NXCD, r = nwg % NXCD, xcd = wgid % NXCD, off = wgid / NXCD; wgid = (xcd < r ? xcd * (q + 1) : r * (q + 1) + (xcd - r) * q) + off; }
        const int nig = WGM * nN, gid = wgid / nig, fm = gid * WGM, gsz = (nM - fm) < WGM ? (nM - fm) : WGM;
        u.pm = fm + ((wgid % nig) % gsz); u.pn = (wgid % nig) / gsz; return true;
    }
    __device__ __forceinline__ void a_ready(const Unit&) const {}
    __device__ __forceinline__ void done(const Unit&) const {}
};
__device__ __forceinline__ unsigned cvt_pk_bf16(float lo, float hi) { unsigned r; asm volatile("v_cvt_pk_bf16_f32 %0, %1, %2" : "=v"(r) : "v"(lo), "v"(hi)); return r; }
template <class Epi, class Sched, bool ALIGN_EPI = false, bool SP2 = false>
__device__ __forceinline__ void gemm_phase(PG8_LAS unsigned char* lds, const Gemm g, const Sched& S, const Epi& E, const int tid) {
    const int wid = __builtin_amdgcn_readfirstlane(tid >> 6), lane = tid & 63, wr = wid >> 2, wc = wid & 3, fr = lane & 15, fq = lane >> 4;
    const int K = g.K, nt = K / BK, lda = g.lda, ldb = g.ldb;
    unsigned voffA[2], voffB[2];
#pragma unroll
    for (int i = 0; i < 2; ++i) { int R, C; stage_rc(tid * 16 + i * 8192, R, C); const int Rb = Epi::PERM ? ((R & ~31) + perm32(R & 31)) : R;
        voffA[i] = (unsigned)(R * lda + C) * 2u; voffB[i] = (unsigned)(Rb * ldb + C) * 2u; }
    const size_t kstep = (size_t)(BK * 2);
    const size_t hstepA = (size_t)HALF * lda * 2, hstepB = (size_t)HALF * ldb * 2;
    const size_t tstepA = 2 * hstepA, tstepB = 2 * hstepB;
    const unsigned ldsw = (unsigned)wid * 1024u;
    const int aoff = lds_byte(wr * 64 + fr, fq * 8), boff = lds_byte(wc * 32 + fr, fq * 8);
#define PG8_SA(b, h) (((b) * 2 + (h)) * HTB)
#define PG8_SB(b, h) ((4 + (b) * 2 + (h)) * HTB)
#define PG8_STAGE(bufoff, gbase, voff) do { _Pragma("unroll") for (int _i = 0; _i < 2; ++_i) \
        __builtin_amdgcn_global_load_lds((const unsigned*)((const char*)(gbase) + (voff)[_i]), (PG8_LAS unsigned*)(lds + (bufoff) + ldsw + _i * 8192), 16, 0, 0); } while (0)
#define PG8_LDA(dst, b, h) do { _Pragma("unroll") for (int m = 0; m < 4; ++m) _Pragma("unroll") for (int k = 0; k < 2; ++k) dst[m][k] = *(const PG8_LAS bf16x8*)(lds + PG8_SA(b, h) + aoff + m * 2048 + k * 1024); } while (0)
#define PG8_LDB(dst, b, h) do { _Pragma("unroll") for (int n = 0; n < 2; ++n) _Pragma("unroll") for (int k = 0; k < 2; ++k) dst[n][k] = *(const PG8_LAS bf16x8*)(lds + PG8_SB(b, h) + boff + n * 2048 + k * 1024); } while (0)
#define PG8_MMA(ai, bj, At, Bt) do { __builtin_amdgcn_s_setprio(1); _Pragma("unroll") for (int m = 0; m < 4; ++m) _Pragma("unroll") for (int n = 0; n < 2; ++n) _Pragma("unroll") for (int k = 0; k < 2; ++k) \
        acc[ai][bj][m][n] = __builtin_amdgcn_mfma_f32_16x16x32_bf16(Bt[n][k], At[m][k], acc[ai][bj][m][n], 0, 0, 0); __builtin_amdgcn_s_setprio(0); } while (0)
#define PG8_WAIT_V(n) asm volatile("s_waitcnt vmcnt(" #n ")" ::: "memory")
#define PG8_WAIT_L(n) asm volatile("s_waitcnt lgkmcnt(" #n ")" ::: "memory")
#define PG8_BAR __builtin_amdgcn_s_barrier()
#define PG8_SCHED __builtin_amdgcn_sched_barrier(0)
    Unit cur, nxt; int ui = 0;
    if (!S.next(0, cur)) return;
    f32x4 acc[2][2][4][2];
    E.init(acc, cur, wr, wc, fr, fq);
    bf16x8 At[4][2], B0[2][2], B1[2][2];
    const char* cA = (const char*)g.A + (size_t)cur.pm * tstepA; const char* cB = (const char*)g.Bt + (size_t)cur.pn * tstepB;
    S.a_ready(cur);
    if constexpr (SP2) {
        PG8_STAGE(PG8_SB(0, 0), cB, voffB); PG8_STAGE(PG8_SB(0, 1), cB + hstepB, voffB); PG8_STAGE(PG8_SA(0, 0), cA, voffA); PG8_STAGE(PG8_SA(0, 1), cA + hstepA, voffA);
        if (wr == 1) PG8_BAR;
        PG8_WAIT_V(2); PG8_BAR;
        PG8_STAGE(PG8_SB(1, 0), cB + kstep, voffB); PG8_STAGE(PG8_SA(1, 0), cA + kstep, voffA); PG8_STAGE(PG8_SB(1, 1), cB + hstepB + kstep, voffB);
        PG8_WAIT_V(6); PG8_BAR;
    } else {
        PG8_STAGE(PG8_SB(0, 0), cB, voffB); PG8_STAGE(PG8_SA(0, 0), cA, voffA); PG8_STAGE(PG8_SB(0, 1), cB + hstepB, voffB); PG8_STAGE(PG8_SA(0, 1), cA + hstepA, voffA);
        if (wr == 1) PG8_BAR;
        PG8_WAIT_V(4); PG8_BAR;
        PG8_STAGE(PG8_SB(1, 0), cB + kstep, voffB); PG8_STAGE(PG8_SA(1, 0), cA + kstep, voffA); PG8_STAGE(PG8_SB(1, 1), cB + hstepB + kstep, voffB);
        PG8_WAIT_V(6); PG8_BAR;
    }
    for (;;) {
        const bool has_next = S.next(ui + 1, nxt);
        const char* nA = has_next ? (const char*)g.A + (size_t)nxt.pm * tstepA : cA; const char* nB = has_next ? (const char*)g.Bt + (size_t)nxt.pn * tstepB : cB;
        for (int t = 0; t < nt; t += 2) {
            const bool last = (t == nt - 2);
            const char* a1 = cA + (size_t)(t + 1) * kstep;
            const char* a2 = last ? nA : cA + (size_t)(t + 2) * kstep; const char* b2 = last ? nB : cB + (size_t)(t + 2) * kstep;
            const char* a3 = a2 + kstep; const char* b3 = b2 + kstep;
            if (last && has_next) S.a_ready(nxt);
            if constexpr (SP2) {
            PG8_LDB(B0, 0, 0); PG8_LDB(B1, 0, 1); PG8_SCHED; PG8_LDA(At, 0, 0); PG8_STAGE(PG8_SA(1, 1), a1 + hstepA, voffA);
            PG8_WAIT_V(8); PG8_WAIT_L(0); PG8_BAR; PG8_MMA(0, 0, At, B0); PG8_MMA(0, 1, At, B1); PG8_BAR; PG8_SCHED;
            PG8_LDA(At, 0, 1); PG8_STAGE(PG8_SB(0, 0), b2, voffB); PG8_STAGE(PG8_SB(0, 1), b2 + hstepB, voffB); PG8_STAGE(PG8_SA(0, 0), a2, voffA);
            PG8_WAIT_V(8); PG8_WAIT_L(0); PG8_BAR; PG8_MMA(1, 0, At, B0); PG8_MMA(1, 1, At, B1); PG8_BAR; PG8_SCHED;
            PG8_LDB(B0, 1, 0); PG8_LDB(B1, 1, 1); PG8_SCHED; PG8_LDA(At, 1, 0); PG8_STAGE(PG8_SA(0, 1), a2 + hstepA, voffA);
            PG8_WAIT_V(8); PG8_WAIT_L(0); PG8_BAR; PG8_MMA(0, 0, At, B0); PG8_MMA(0, 1, At, B1); PG8_BAR; PG8_SCHED;
            PG8_LDA(At, 1, 1); PG8_STAGE(PG8_SB(1, 0), b3, voffB); PG8_STAGE(PG8_SB(1, 1), b3 + hstepB, voffB); PG8_STAGE(PG8_SA(1, 0), a3, voffA);
            PG8_WAIT_V(8); PG8_WAIT_L(0); PG8_BAR; PG8_MMA(1, 0, At, B0); PG8_MMA(1, 1, At, B1); PG8_BAR; PG8_SCHED;
            } else {
            PG8_LDB(B0, 0, 0); PG8_SCHED; PG8_LDA(At, 0, 0); PG8_STAGE(PG8_SA(1, 1), a1 + hstepA, voffA);
            PG8_WAIT_L(8); PG8_BAR; PG8_WAIT_L(0); PG8_MMA(0, 0, At, B0); PG8_BAR; PG8_SCHED;
            PG8_LDB(B1, 0, 1); PG8_STAGE(PG8_SB(0, 0), b2, voffB);
            PG8_BAR; PG8_WAIT_L(0); PG8_MMA(0, 1, At, B1); PG8_BAR;
            PG8_LDA(At, 0, 1); PG8_STAGE(PG8_SA(0, 0), a2, voffA);
            PG8_BAR; PG8_WAIT_L(0); PG8_MMA(1, 0, At, B0); PG8_BAR; PG8_SCHED;
            PG8_STAGE(PG8_SB(0, 1), b2 + hstepB, voffB);
            PG8_WAIT_V(6); PG8_BAR; PG8_MMA(1, 1, At, B1); PG8_BAR;
            PG8_LDB(B0, 1, 0); PG8_SCHED; PG8_LDA(At, 1, 0); PG8_STAGE(PG8_SA(0, 1), a2 + hstepA, voffA);
            PG8_WAIT_L(8); PG8_BAR; PG8_WAIT_L(0); PG8_MMA(0, 0, At, B0); PG8_BAR; PG8_SCHED;
            PG8_LDB(B1, 1, 1); PG8_STAGE(PG8_SB(1, 0), b3, voffB);
            PG8_BAR; PG8_WAIT_L(0); PG8_MMA(0, 1, At, B1); PG8_BAR;
            PG8_LDA(At, 1, 1); PG8_STAGE(PG8_SA(1, 0), a3, voffA);
            PG8_BAR; PG8_WAIT_L(0); PG8_MMA(1, 0, At, B0); PG8_BAR; PG8_SCHED;
            PG8_STAGE(PG8_SB(1, 1), b3 + hstepB, voffB);
            PG8_WAIT_V(6); PG8_BAR; PG8_MMA(1, 1, At, B1); PG8_BAR;
            }
        }
        if constexpr (ALIGN_EPI) { if (wr == 0) PG8_BAR; }
        if constexpr (!Epi::AFTER_DRAIN) { E(acc, cur, wr, wc, fr, fq); S.done(cur); }
        if (!has_next) break;
        E.init(acc, nxt, wr, wc, fr, fq);
        cur = nxt; cA = nA; cB = nB; ++ui;
        if constexpr (ALIGN_EPI) { if (wr == 1) PG8_BAR; }
    }
    PG8_WAIT_V(0);
    if constexpr (!ALIGN_EPI) { if (wr == 0) PG8_BAR; }
    PG8_BAR;
    if constexpr (Epi::AFTER_DRAIN) { E.fused(acc, cur, wr, wc, fr, fq, lds, wid, lane); S.done(cur); }
#undef PG8_SA
#undef PG8_SB
#undef PG8_STAGE
#undef PG8_LDA
#undef PG8_LDB
#undef PG8_MMA
#undef PG8_WAIT_V
#undef PG8_WAIT_L
#undef PG8_BAR
#undef PG8_SCHED
}

}

namespace mk {
using pg8::f32x4; using pg8::bf16x8; using pg8::u32x4; using pg8::cvt_pk_bf16;
typedef unsigned short bf16;
typedef unsigned u32x2 __attribute__((ext_vector_type(2)));
typedef short s16x4 __attribute__((ext_vector_type(4)));
typedef float f32x2 __attribute__((ext_vector_type(2)));
typedef GAS unsigned gu32;
#define RLX_AGENT __ATOMIC_RELAXED, __HIP_MEMORY_SCOPE_AGENT
#define XB_TMO      128
#define XB_XCNT(j)  (256  + 64 * (j))
#define XB_XSUB(j)  (1280 + 64 * (j))
#define XB_XGEN(j)  (2304 + 64 * (j))
#define XB_TOP      3328
#define XB_TOPGEN   3392
#define XCD_BAR_WORDS 3456
#define XB_SPIN_CAP (1u << 18)

__device__ __forceinline__ unsigned xb_ld(unsigned* p)              { return __hip_atomic_load(p, __ATOMIC_RELAXED, __HIP_MEMORY_SCOPE_AGENT); }
__device__ __forceinline__ unsigned xb_add(unsigned* p, unsigned v) { return __hip_atomic_fetch_add(p, v, __ATOMIC_RELAXED, __HIP_MEMORY_SCOPE_AGENT); }
__device__ __forceinline__ unsigned xb_xcc_id() { return (unsigned)__builtin_amdgcn_s_getreg((3 << 11) | 20) & 0xFu; }
#define XB_SPIN(cond, bar) do { unsigned _sp = 0; while (cond) { __builtin_amdgcn_s_sleep(1); \
    if ((++_sp & 255u) == 0u) { if (xb_ld(&(bar)[XB_TMO])) break; if (_sp > XB_SPIN_CAP) { atomicAdd(&(bar)[XB_TMO], 1u); break; } } } } while (0)

struct XcdBarrier {
    unsigned* bar; unsigned x;
    volatile LAS unsigned* st;
};

__device__ __forceinline__ XcdBarrier xcd_barrier_post(unsigned* bar, volatile LAS unsigned* st) {
    XcdBarrier b; b.bar = bar; b.x = xb_xcc_id(); b.st = st;
    if (threadIdx.x == 0) (void)xb_add(&bar[XB_XCNT(b.x)], 1u);
    return b;
}
__device__ __forceinline__ void xcd_barrier_complete(unsigned* bar, unsigned x, unsigned& nloc, unsigned& nx) {
    const unsigned G = gridDim.x * gridDim.y * gridDim.z;
    unsigned sum, cnt, mine, sp = 0u;
    for (;;) {
        sum = 0u; cnt = 0u; mine = 0u;
#pragma unroll
        for (unsigned j = 0; j < 16; ++j) { const unsigned c = xb_ld(&bar[XB_XCNT(j)]); sum += c; cnt += (c > 0u) ? 1u : 0u; mine = (j == x) ? c : mine; }
        if (sum == G) break;
        __builtin_amdgcn_s_sleep(1);
        if ((++sp & 255u) == 0u) { if (xb_ld(&bar[XB_TMO])) break; if (sp > XB_SPIN_CAP) { atomicAdd(&bar[XB_TMO], 1u); break; } }
    }
    nloc = mine > 0u ? mine : 1u; nx = cnt > 0u ? cnt : 1u;
}

__device__ __forceinline__ void xcd_barrier(const XcdBarrier& b) {
    asm volatile("s_waitcnt vmcnt(0)" ::: "memory");
    __syncthreads();
    if (threadIdx.x == 0) {
        unsigned* bar = b.bar;
        __builtin_amdgcn_s_waitcnt(0);
        unsigned nloc = b.st[0], nx = b.st[1];
        if (nloc == 0u) { xcd_barrier_complete(bar, b.x, nloc, nx); b.st[0] = nloc; b.st[1] = nx; }
        const unsigned old = xb_add(&bar[XB_XSUB(b.x)], 1u);
        const unsigned gen = old / nloc;
        if (old + 1u == (gen + 1u) * nloc) {
            __builtin_amdgcn_fence(__ATOMIC_RELEASE, "agent");
            asm volatile("s_waitcnt vmcnt(0)" ::: "memory");
            const unsigned og = xb_add(&bar[XB_TOP], 1u);
            const unsigned tg = og / nx;
            if (og + 1u == (tg + 1u) * nx) xb_add(&bar[XB_TOPGEN], 1u);
            else XB_SPIN(xb_ld(&bar[XB_TOPGEN]) == tg, bar);
            __builtin_amdgcn_fence(__ATOMIC_ACQUIRE, "agent");
            xb_add(&bar[XB_XGEN(b.x)], 1u);
            asm volatile("s_waitcnt vmcnt(0)" ::: "memory");
        } else {
            XB_SPIN(xb_ld(&bar[XB_XGEN(b.x)]) == gen, bar);
            __builtin_amdgcn_fence(__ATOMIC_ACQUIRE, "agent");
            asm volatile("s_waitcnt vmcnt(0)" ::: "memory");
        }
    }
    __syncthreads();
}


constexpr int MP = 16384, MS = 128, MT = MP + MS, MR = 16640;
constexpr int D = 1024, DFF = 2816, NWAVES = 8;
constexpr float RMS_EPS = 1e-6f, LN_EPS = 1e-5f;
constexpr float MLA_SCALE = 0.07216878364870322f;
constexpr size_t MiB = 1u << 20;
constexpr size_t WS_CTL = 0, CTL_BYTES = 3 * MiB;
constexpr int CW_BAR = 4096;
constexpr size_t ST_OFF = 65536, ST_STRIDE = (size_t)MR * 8;
constexpr int ST_SSQ0 = 0  , ST_LNS0 = 9, ST_LNQ0 = 10  , ST_KV = 13, ST_Q = 14, NSTAT = 15;
static_assert(ST_OFF + NSTAT * ST_STRIDE <= CTL_BYTES, "stats inside CTL");
constexpr size_t WS_WGU = 3 * MiB, WGU_BYTES = 11 * MiB, WS_WD = 47 * MiB, WD_BYTES = 5767168, WS_WIN = 69 * MiB, WS_WOUT = 77 * MiB, WS_WS = 81 * MiB,
                 WS_WDQKV = 82 * MiB, WS_WQ = 84 * MiB, WS_WOV = 86 * MiB, WS_WGX = 90 * MiB, WS_WAT = 95 * MiB, WS_WIT = 95 * MiB + 512 * 1024, WS_WCO = 96 * MiB, WS_ROPE = 99 * MiB;
constexpr size_t WS_H = 100 * MiB, WS_HB = 165 * MiB, WS_U = 198 * MiB, WS_GV = 231 * MiB, WS_UM = 264 * MiB, WS_ACT = 297 * MiB, WS_RAW = 387 * MiB, WS_CQB = 436 * MiB,
                 WS_QF = 449 * MiB, WS_KVB = 531 * MiB, WS_OB = 542 * MiB, WS_PART = 607 * MiB, WS_PML = 623 * MiB, WS_GATE = 624 * MiB, WS_XW = 665 * MiB, WS_AA = 747 * MiB, WS_BB = 829 * MiB,
                 WS_AGG = 911 * MiB, WS_GH = 914 * MiB, WS_PROF = 955 * MiB, WS_MK_END = 956 * MiB;
constexpr int RING_BYTES = 131072, LDS_BYTES = 147456, MISC_OFF = LDS_BYTES - 256;
constexpr size_t O_YP = 0, O_YS = 16777216, O_CV = 16908288, O_MP = 17170432, O_MS = 22413312, O_HP = 22454272, O_HS = 22464512, O_CP = 22505472, O_CS = 22536192, O_END = 22659072;

__device__ __forceinline__ float fast_sigmoid_l2(float t) { return __builtin_amdgcn_rcpf(1.0f + __builtin_amdgcn_exp2f(-t)); }
__device__ __forceinline__ float gelu_tanh_f(float x) { return x * fast_sigmoid_l2(2.302208198f * (x + 0.044715f * x * x * x)); }
__device__ __forceinline__ float silu_f(float x) { return x * fast_sigmoid_l2(1.4426950409f * x); }
__device__ __forceinline__ unsigned f2bf(float f) { unsigned u = __builtin_bit_cast(unsigned, f); return (u + 0x7fffu + ((u >> 16) & 1u)) >> 16; }
__device__ __forceinline__ unsigned pk2(float lo, float hi) { return f2bf(lo) | (f2bf(hi) << 16); }
__device__ __forceinline__ float bf2f(unsigned short b) { return __builtin_bit_cast(float, (unsigned)b << 16); }
__device__ __forceinline__ float bflo(unsigned w) { return __builtin_bit_cast(float, w << 16); }
__device__ __forceinline__ float bfhi(unsigned w) { return __builtin_bit_cast(float, w & 0xffff0000u); }
constexpr float ST_SCALE = 16777216.0f, ST_INV = 1.0f / 16777216.0f;
__device__ __forceinline__ void stat_add(long long* p, float v) { atomicAdd((unsigned long long*)p, (unsigned long long)(long long)__float2ll_rn(v * ST_SCALE)); }
__device__ __forceinline__ void stat_set(long long* p, float v) { *p = (long long)__float2ll_rn(v * ST_SCALE); }
__device__ __forceinline__ float stat_get(const long long* p) { return (float)(*p) * ST_INV; }
#define LDS_WAIT() asm volatile("s_waitcnt lgkmcnt(0)" ::: "memory")
#define VM_WAIT() asm volatile("s_waitcnt vmcnt(0)" ::: "memory")

struct InTab { const float* const __attribute__((address_space(4)))* t; __device__ __forceinline__ const float* operator[](int i) const { return t[i]; } };
struct P {
    InTab in; float* out; unsigned char* ws;
    LAS unsigned char* lds; int tid, lane, wave, G, bid;
    __device__ __forceinline__ long long* stat(int a) const { return (long long*)(ws + ST_OFF + (size_t)a * ST_STRIDE); }
    template <class T> __device__ __forceinline__ T* w(size_t off) const { return (T*)(ws + off); }
};
}
namespace mk {
struct TrJob { const float* src; int ldsrc, K, N; bf16* dst; int lddst; const float* gain; int kind, off; };
__device__ __forceinline__ int tr_rowmap(int kind, int off, int n) { return kind == 1 ? ((n >> 7) * 256 + (n & 127) + off) : (off + n); }
__device__ __forceinline__ void tr_item(const TrJob& j, LAS float* scr, int item, int lane) {
    const int nblk = j.N / 32, kb = item / nblk, nb = item % nblk, k0 = 64 * kb, n0 = 32 * nb;
    const float* src = j.src + (size_t)(k0 + (lane >> 5)) * j.ldsrc + n0 + (lane & 31); const size_t rstep = (size_t)2 * j.ldsrc;
    float v[32];
#pragma unroll
    for (int i = 0; i < 32; ++i) v[i] = src[i * rstep];
    if (j.gain) { const float* gp = j.gain + k0 + (lane >> 5); float g[32];
#pragma unroll
        for (int i = 0; i < 32; ++i) g[i] = gp[2 * i];
#pragma unroll
        for (int i = 0; i < 32; ++i) v[i] *= g[i]; }
#pragma unroll
    for (int i = 0; i < 32; ++i) scr[(2 * i + (lane >> 5)) * 33 + (lane & 31)] = v[i];
    LDS_WAIT(); asm volatile("" ::: "memory");
    const int c = lane & 7;
#pragma unroll
    for (int jj = 0; jj < 4; ++jj) { const int n = (lane >> 3) + 8 * jj; const LAS float* s = scr + (8 * c) * 33 + n;
        u32x4 o; o.x = pk2(s[0], s[33]); o.y = pk2(s[66], s[99]); o.z = pk2(s[132], s[165]); o.w = pk2(s[198], s[231]);
        *(u32x4*)(j.dst + (size_t)tr_rowmap(j.kind, j.off, n0 + n) * j.lddst + k0 + 8 * c) = o; }
    LDS_WAIT(); asm volatile("" ::: "memory");
}
constexpr int NJOBS = 24;
__device__ __forceinline__ TrJob get_job(const P& p, int jid) {
    TrJob j; j.gain = nullptr; j.kind = 0; j.off = 0; j.src = nullptr; j.dst = nullptr; j.ldsrc = 0; j.K = 0; j.N = 0; j.lddst = 0;
    if (jid < 12) { const int l = jid / 3, t = jid % 3;
        if (t < 2) { j.src = p.in[33 + t] + (size_t)l * D * DFF; j.ldsrc = DFF; j.K = D; j.N = DFF; j.dst = p.w<bf16>(WS_WGU + l * WGU_BYTES); j.lddst = D; j.gain = p.in[7] + l * D; j.kind = 1; j.off = 128 * t; }
        else { j.src = p.in[35] + (size_t)l * DFF * D; j.ldsrc = D; j.K = DFF; j.N = D; j.dst = p.w<bf16>(WS_WD + l * WD_BYTES); j.lddst = DFF; }
    } else if (jid < 16) { const int a = (jid - 12) >> 1;
        if (((jid - 12) & 1) == 0) { j.src = p.in[9] + (size_t)a * D * 2048; j.ldsrc = 2048; j.K = D; j.N = 2048; j.dst = p.w<bf16>(WS_WIN + a * 4 * MiB); j.lddst = D; j.gain = p.in[6] + (3 * a) * D; }
        else { j.src = p.in[14] + (size_t)a * D * D; j.ldsrc = D; j.K = D; j.N = D; j.dst = p.w<bf16>(WS_WOUT + a * 2 * MiB); j.lddst = D; }
    } else if (jid == 16) { j.src = p.in[15]; j.ldsrc = 384; j.K = D; j.N = 384; j.dst = p.w<bf16>(WS_WDQKV); j.lddst = D; j.gain = p.in[6] + D; j.off = 256; }
    else if (jid == 17) { j.src = p.in[18]; j.ldsrc = 320; j.K = D; j.N = 256; j.dst = p.w<bf16>(WS_WDQKV); j.lddst = D; j.gain = p.in[6] + D; j.off = 0; }
    else if (jid == 18) { j.src = p.in[18] + 256; j.ldsrc = 320; j.K = D; j.N = 64; j.dst = p.w<bf16>(WS_WDQKV); j.lddst = D; j.gain = p.in[6] + D; j.off = 640; }
    else if (jid == 19) { j.src = p.in[24]; j.ldsrc = 1280; j.K = D; j.N = 1280; j.dst = p.w<bf16>(WS_WGX); j.lddst = D; j.gain = p.in[6] + 2 * D; j.off = 0; }
    else if (jid == 20) { j.src = p.in[23]; j.ldsrc = 1280; j.K = D; j.N = 1280; j.dst = p.w<bf16>(WS_WGX); j.lddst = D; j.gain = p.in[6] + 2 * D; j.off = 1280; }
    else if (jid == 21) { j.src = p.in[32]; j.ldsrc = D; j.K = 1280; j.N = D; j.dst = p.w<bf16>(WS_WCO); j.lddst = 1280; }
    else if (jid == 22) { j.src = p.in[27]; j.ldsrc = 128; j.K = 128; j.N = 128; j.dst = p.w<bf16>(WS_WAT); j.lddst = 128; j.kind = 2; }
    else { j.src = p.in[29]; j.ldsrc = 128; j.K = 128; j.N = 128; j.dst = p.w<bf16>(WS_WIT); j.lddst = 128; j.kind = 2; }
    return j;
}
__device__ __forceinline__ int job_items(const TrJob& j) { return j.kind == 2 ? 80 : (j.K / 64) * (j.N / 32); }

__device__ __forceinline__ void p0_prologue(const P& p, const int mask) {
    LAS float* scr = (LAS float*)(p.lds + p.wave * 16384);
    const int gw = p.bid * NWAVES + p.wave, NGW = p.G * NWAVES, lane = p.lane;
    const int gt = p.bid * (NWAVES * 64) + p.tid, NGT = p.G * NWAVES * 64;
    if (mask & 1) {
    {
        int base = 0;
        for (int jid = 0; jid < NJOBS; ++jid) {
            TrJob j = get_job(p, jid); const int nit = job_items(j);
            int first = (gw - base % NGW + NGW) % NGW;
            for (int it = first; it < nit; it += NGW) {
                if (j.kind == 2) { TrJob b = j; const int blk = it >> 3; b.src = j.src + (size_t)blk * 16384; b.dst = j.dst + (size_t)blk * 16384; b.kind = 0; tr_item(b, scr, it & 7, lane); }
                else tr_item(j, scr, it, lane);
            }
            base += nit;
        }
    }
    }
    if (mask & 2) {
    { u32x4* z = (u32x4*)(p.w<bf16>(WS_WDQKV) + (size_t)704 * D); for (int i = gt; i < 64 * D / 8; i += NGT) z[i] = (u32x4){0u, 0u, 0u, 0u}; }
    }
    if (mask & 4) {
    for (int i = gt; i < 2 * 8 * 128 * 16; i += NGT) {
        const int s0 = (i & 15) * 8, t = (i >> 4) & 127, jg = i >> 11; const float* src = p.in[12] + (size_t)jg * 16384;
        unsigned w[4], ws_[4];
#pragma unroll
        for (int e = 0; e < 4; ++e) { float v[2], vs[2];
#pragma unroll
            for (int h = 0; h < 2; ++h) { const int s = s0 + 2 * e + h; v[h] = (s <= t) ? src[t * 128 + s] : 0.f; vs[h] = ((s >> 2) == (t >> 2) && (s & 3) <= (t & 3)) ? src[(t & 3) * 128 + (s & 3)] : 0.f; }
            w[e] = pk2(v[0], v[1]); ws_[e] = pk2(vs[0], vs[1]); }
        const int j = jg >> 3, g = jg & 7;
        *(u32x4*)(p.w<bf16>(WS_WS + (size_t)j * 262144) + ((size_t)g * 128 + t) * 128 + s0) = (u32x4){w[0], w[1], w[2], w[3]};
        *(u32x4*)(p.w<bf16>(WS_WS + 524288 + (size_t)j * 262144) + ((size_t)g * 128 + t) * 128 + s0) = (u32x4){ws_[0], ws_[1], ws_[2], ws_[3]};
    }
    }
    if (mask & 8) {
    for (int i = gt; i < 2052 * 32; i += NGT) { const int tp = i >> 5, fi = i & 31, pos = tp < 2048 ? tp : 16384 + (tp - 2048);
        const float inv = 1.0f / powf(10000.0f, (float)(2 * fi) / 64.0f); const float ang = (float)pos * inv;
        p.w<f32x2>(WS_ROPE)[i] = (f32x2){cosf(ang), sinf(ang)}; }
    }
    if (mask & 16) {
    { bf16* HB = p.w<bf16>(WS_HB); long long* ssq = p.stat(ST_SSQ0);
      for (int m = gw; m < MR; m += NGW) {
        f32x4 v[4]; float s = 0.f;
#pragma unroll
        for (int jj = 0; jj < 4; ++jj) { const int c = 4 * lane + 256 * jj;
            if (m < MP) v[jj] = *(const f32x4*)(p.in[0] + (size_t)m * D + c); else if (m < MT) v[jj] = *(const f32x4*)(p.in[1] + (size_t)(m - MP) * D + c); else v[jj] = (f32x4){0.f, 0.f, 0.f, 0.f};
            s += (v[jj].x * v[jj].x + v[jj].y * v[jj].y) + (v[jj].z * v[jj].z + v[jj].w * v[jj].w); }
#pragma unroll
        for (int o = 1; o < 64; o <<= 1) s += __shfl_xor(s, o);
#pragma unroll
        for (int jj = 0; jj < 4; ++jj) { const int c = 4 * lane + 256 * jj;
            *(u32x2*)(HB + (size_t)m * D + c) = (u32x2){pk2(v[jj].x, v[jj].y), pk2(v[jj].z, v[jj].w)}; }
        if (lane == 0) stat_set(ssq + m, s);
      } }
    }
    if (mask & 32) {
    { const float* wuq = p.in[17]; const float* wuk = p.in[20]; const float* qn = p.in[16]; bf16* Wq = p.w<bf16>(WS_WQ);
      LAS float* Qs = (LAS float*)p.lds;
      for (int it = p.bid; it < 192; it += p.G) {
        const int h = it / 24, kb = (it >> 2) % 6, cq = it & 3, k0 = 64 * kb;
        __syncthreads();
#pragma unroll
        for (int q = 0; q < 4; ++q) { const int idx = p.tid + 512 * q, row = idx >> 5, c4 = idx & 31; *(LAS f32x4*)(Qs + row * 132 + c4 * 4) = *(const f32x4*)(wuq + (size_t)(k0 + row) * 1536 + h * 192 + c4 * 4); }
        __syncthreads();
        const int c0 = cq * 64 + p.wave * 8; float acc[8];
#pragma unroll
        for (int cc = 0; cc < 8; ++cc) acc[cc] = 0.f;
        for (int n4 = 0; n4 < 32; ++n4) { const f32x4 bv = *(const LAS f32x4*)(Qs + lane * 132 + n4 * 4);
#pragma unroll
            for (int cc = 0; cc < 8; ++cc) { const f32x4 av = *(const f32x4*)(wuk + (size_t)(c0 + cc) * 1024 + h * 128 + n4 * 4); acc[cc] += (av.x * bv.x + av.y * bv.y) + (av.z * bv.z + av.w * bv.w); } }
        const float g = qn[k0 + lane];
#pragma unroll
        for (int cc = 0; cc < 8; ++cc) Wq[(size_t)(320 * h + c0 + cc) * 384 + k0 + lane] = (bf16)f2bf(acc[cc] * g);
      }
      for (int r = gw; r < 512; r += NGW) { const int h = r >> 6, ie = r & 63, i = ie >> 1, e = ie & 1;
#pragma unroll
        for (int kk = 0; kk < 6; ++kk) { const int k = lane + 64 * kk; Wq[(size_t)(320 * h + 256 + ie) * 384 + k] = (bf16)f2bf(wuq[(size_t)k * 1536 + h * 192 + 128 + 32 * e + i] * qn[k]); } } }
    }
    if (mask & 64) {
    { const float* wuv = p.in[21]; const float* wo = p.in[22]; bf16* Wov = p.w<bf16>(WS_WOV);
      for (int it = gw; it < 2048; it += NGW) { const int h = it >> 8, cg = (it >> 2) & 63, nb = it & 3, c0 = cg * 4, n = nb * 256 + lane * 4;
        f32x4 acc[4];
#pragma unroll
        for (int cc = 0; cc < 4; ++cc) acc[cc] = (f32x4){0.f, 0.f, 0.f, 0.f};
        for (int v = 0; v < 128; ++v) { const f32x4 b = *(const f32x4*)(wo + (size_t)(h * 128 + v) * D + n);
#pragma unroll
            for (int cc = 0; cc < 4; ++cc) { const float a = wuv[(size_t)(c0 + cc) * 1024 + h * 128 + v]; acc[cc] += b * a; } }
#pragma unroll
        for (int jn = 0; jn < 4; ++jn) *(u32x2*)(Wov + (size_t)(n + jn) * 2048 + h * 256 + c0) = (u32x2){pk2(acc[0][jn], acc[1][jn]), pk2(acc[2][jn], acc[3][jn])};
      } }
    }
}
}
namespace mk {
#ifdef MK_DRYPROBE
#define MK_DRY(E) ((E).dry)
#define MK_DRYFIELD int dry;
#else
#define MK_DRY(E) 0
#define MK_DRYFIELD
#endif
typedef const f32x4 (&AccRef)[2][2][4][2];
__device__ __forceinline__ float quad_red(float v) { v += __shfl_xor(v, 16); v += __shfl_xor(v, 32); return v; }
__device__ __forceinline__ u32x4 pack8(const f32x4 a, const f32x4 b) { u32x4 w; w.x = cvt_pk_bf16(a[0], a[1]); w.y = cvt_pk_bf16(a[2], a[3]); w.z = cvt_pk_bf16(b[0], b[1]); w.w = cvt_pk_bf16(b[2], b[3]); return w; }
__device__ __forceinline__ float sumsq8(const f32x4 a, const f32x4 b) { return ((a[0] * a[0] + a[1] * a[1]) + (a[2] * a[2] + a[3] * a[3])) + ((b[0] * b[0] + b[1] * b[1]) + (b[2] * b[2] + b[3] * b[3])); }
__device__ __forceinline__ float sum8(const f32x4 a, const f32x4 b) { return ((a[0] + a[1]) + (a[2] + a[3])) + ((b[0] + b[1]) + (b[2] + b[3])); }
#define MK_EPI_CALL() \
    __device__ __forceinline__ void operator()(AccRef acc, const pg8::Unit& u, int wr, int wc, int fr, int fq) const { \
        Pre pre_[2][4]; \
        _Pragma("unroll") for (int ai = 0; ai < 2; ++ai) _Pragma("unroll") for (int m = 0; m < 4; ++m) pre_[ai][m] = pre(u.pm * 256 + ai * 128 + wr * 64 + m * 16 + fr, u.pn, wc, fq); \
        _Pragma("unroll") for (int ai = 0; ai < 2; ++ai) _Pragma("unroll") for (int m = 0; m < 4; ++m) \
            rgp(u.pm * 256 + ai * 128 + wr * 64 + m * 16 + fr, u.pn, wc, fq, acc[ai][0][m][0], acc[ai][0][m][1], acc[ai][1][m][0], acc[ai][1][m][1], pre_[ai][m]); } \
    __device__ __forceinline__ void rg(int r, int pn, int wc, int fq, f32x4 a0, f32x4 b0, f32x4 a1, f32x4 b1) const { rgp(r, pn, wc, fq, a0, b0, a1, b1, pre(r, pn, wc, fq)); }
#define MK_EPI_CALL_DENSE() \
    __device__ __forceinline__ void operator()(AccRef acc, const pg8::Unit& u, int wr, int wc, int fr, int fq) const { \
        Pre pre_[2][4]; \
        _Pragma("unroll") for (int ai = 0; ai < 2; ++ai) _Pragma("unroll") for (int m = 0; m < 4; ++m) pre_[ai][m] = pre(u.pm * 256 + ai * 128 + wr * 64 + m * 16 + fr, u.pn, wc, fq); \
        _Pragma("unroll") for (int ai = 0; ai < 2; ++ai) { float s1 = 0.f, s2 = 0.f; \
            _Pragma("unroll") for (int m = 0; m < 4; ++m) { float t1, t2; \
                rgs(u.pm * 256 + ai * 128 + wr * 64 + m * 16 + fr, u.pn, wc, fq, acc[ai][0][m][0], acc[ai][0][m][1], acc[ai][1][m][0], acc[ai][1][m][1], pre_[ai][m], t1, t2); \
                s1 = (fq == m) ? t1 : s1; s2 = (fq == m) ? t2 : s2; } \
            stats(u.pm * 256 + ai * 128 + wr * 64 + fq * 16 + fr, u.pn, s1, s2); } } \
    __device__ __forceinline__ void rg(int r, int pn, int wc, int fq, f32x4 a0, f32x4 b0, f32x4 a1, f32x4 b1) const { float t1, t2; rgs(r, pn, wc, fq, a0, b0, a1, b1, pre(r, pn, wc, fq), t1, t2); if (fq == 0) stats(r, pn, t1, t2); }
#define MK_INIT_ZERO() __device__ __forceinline__ void init(f32x4 (&acc)[2][2][4][2], const pg8::Unit&, int, int, int, int) const { \
        _Pragma("unroll") for (int a = 0; a < 2; ++a) _Pragma("unroll") for (int b = 0; b < 2; ++b) _Pragma("unroll") for (int m = 0; m < 4; ++m) _Pragma("unroll") for (int n = 0; n < 2; ++n) acc[a][b][m][n] = (f32x4){0.f, 0.f, 0.f, 0.f}; }
#define MK_PRE_STAT(PTR) MK_INIT_ZERO() typedef long long Pre; __device__ __forceinline__ Pre pre(int r, int, int, int) const { return (PTR)[r]; }
__device__ __forceinline__ float stat_f(long long v) { return (float)v * ST_INV; }

struct EpiA1 {
    static constexpr bool PERM = true, AFTER_DRAIN = false;
    bf16* U; bf16* GV; const long long* ssq; long long* lns; long long* lnq; MK_DRYFIELD
    MK_PRE_STAT(ssq)
    __device__ __forceinline__ void rgs(int r, int pn, int wc, int fq, f32x4 a0, f32x4 b0, f32x4 a1, f32x4 b1, const Pre pv, float& s1, float& s2) const {
        const bool isv = pn >= 4; bf16* dst = (isv ? GV : U) + (size_t)r * 1024 + (pn & 3) * 256 + wc * 32 + 8 * fq; const float rs = rsqrtf(stat_f(pv) * (1.0f / 1024.0f) + RMS_EPS);
        a0 *= rs; b0 *= rs; a1 *= rs; b1 *= rs;
#pragma unroll
        for (int e = 0; e < 4; ++e) { a0[e] = gelu_tanh_f(a0[e]); b0[e] = gelu_tanh_f(b0[e]); a1[e] = gelu_tanh_f(a1[e]); b1[e] = gelu_tanh_f(b1[e]); }
        *(u32x4*)dst = pack8(a0, b0); *(u32x4*)(dst + 128) = pack8(a1, b1);
        s1 = 0.f; s2 = 0.f;
        if (isv) { s1 = quad_red(sum8(a0, b0) + sum8(a1, b1)); s2 = quad_red(sumsq8(a0, b0) + sumsq8(a1, b1)); }
    }
    __device__ __forceinline__ void stats(int r, int pn, float s1, float s2) const { if (pn >= 4 && !MK_DRY(*this)) { stat_add(lns + r, s1); stat_add(lnq + r, s2); } }
    MK_EPI_CALL_DENSE()
};
struct EpiRes {
    static constexpr bool PERM = true, AFTER_DRAIN = false;
    bf16* HB; long long* ssq_out; MK_DRYFIELD
    struct Pre { u32x4 h0, h1; };
    static __device__ __forceinline__ f32x4 lo4(const u32x4 h) { return (f32x4){bflo(h.x), bfhi(h.x), bflo(h.y), bfhi(h.y)}; }
    static __device__ __forceinline__ f32x4 hi4(const u32x4 h) { return (f32x4){bflo(h.z), bfhi(h.z), bflo(h.w), bfhi(h.w)}; }
    __device__ __forceinline__ Pre pre(int r, int pn, int wc, int fq) const { const bf16* hp = HB + (size_t)r * 1024 + pn * 256 + wc * 32 + 8 * fq; Pre v; v.h0 = *(const u32x4*)hp; v.h1 = *(const u32x4*)(hp + 128); return v; }
    __device__ __forceinline__ void init(f32x4 (&acc)[2][2][4][2], const pg8::Unit& u, int wr, int wc, int fr, int fq) const {
        Pre v[2][4];
#pragma unroll
        for (int ai = 0; ai < 2; ++ai)
#pragma unroll
            for (int m = 0; m < 4; ++m) v[ai][m] = pre(u.pm * 256 + ai * 128 + wr * 64 + m * 16 + fr, u.pn, wc, fq);
#pragma unroll
        for (int ai = 0; ai < 2; ++ai)
#pragma unroll
            for (int m = 0; m < 4; ++m) { acc[ai][0][m][0] = lo4(v[ai][m].h0); acc[ai][0][m][1] = hi4(v[ai][m].h0); acc[ai][1][m][0] = lo4(v[ai][m].h1); acc[ai][1][m][1] = hi4(v[ai][m].h1); }
    }
    __device__ __forceinline__ void fin(int r, int pn, int wc, int fq, const f32x4 a0, const f32x4 b0, const f32x4 a1, const f32x4 b1, float& s1) const {
        bf16* hp = HB + (size_t)r * 1024 + pn * 256 + wc * 32 + 8 * fq;
        s1 = quad_red(sumsq8(a0, b0) + sumsq8(a1, b1));
        if (MK_DRY(*this)) { if (s1 == 12345.678f) *(u32x4*)hp = pack8(a0, b0); return; }
        *(u32x4*)hp = pack8(a0, b0); *(u32x4*)(hp + 128) = pack8(a1, b1);
    }
    __device__ __forceinline__ void stats(int r, int pn, float s1, float s2) const { if (!MK_DRY(*this)) stat_add(ssq_out + r, s1); }
    __device__ __forceinline__ void operator()(AccRef acc, const pg8::Unit& u, int wr, int wc, int fr, int fq) const {
#pragma unroll
        for (int ai = 0; ai < 2; ++ai) { float s1 = 0.f;
#pragma unroll
            for (int m = 0; m < 4; ++m) { float t1; fin(u.pm * 256 + ai * 128 + wr * 64 + m * 16 + fr, u.pn, wc, fq, acc[ai][0][m][0], acc[ai][0][m][1], acc[ai][1][m][0], acc[ai][1][m][1], t1); s1 = (fq == m) ? t1 : s1; }
            stats(u.pm * 256 + ai * 128 + wr * 64 + fq * 16 + fr, u.pn, s1, 0.f); } }
    __device__ __forceinline__ void rg(int r, int pn, int wc, int fq, f32x4 a0, f32x4 b0, f32x4 a1, f32x4 b1) const { const Pre v = pre(r, pn, wc, fq); float t1;
        fin(r, pn, wc, fq, a0 + lo4(v.h0), b0 + hi4(v.h0), a1 + lo4(v.h1), b1 + hi4(v.h1), t1); if (fq == 0) stats(r, pn, t1, 0.f); }
};
struct EpiF1 {
    static constexpr bool PERM = true, AFTER_DRAIN = false;
    bf16* ACT; const long long* ssq;
    MK_PRE_STAT(ssq)
    __device__ __forceinline__ void rgp(int r, int pn, int wc, int fq, f32x4 a0, f32x4 b0, f32x4 a1, f32x4 b1, const Pre pv) const {
        const float rs = rsqrtf(stat_f(pv) * (1.0f / 1024.0f) + RMS_EPS); f32x4 a, b;
#pragma unroll
        for (int e = 0; e < 4; ++e) { a[e] = silu_f(a0[e] * rs) * (a1[e] * rs); b[e] = silu_f(b0[e] * rs) * (b1[e] * rs); }
        *(u32x4*)(ACT + (size_t)r * DFF + pn * 128 + wc * 32 + 8 * fq) = pack8(a, b);
    }
    MK_EPI_CALL()
};
struct EpiB1 {
    static constexpr bool PERM = true, AFTER_DRAIN = false;
    float* RAW; bf16* CQB; const long long* ssq; long long* ssq_kv; long long* ssq_q; MK_DRYFIELD
    __device__ __forceinline__ void half(int r, int c, f32x4 a, f32x4 b, float& qkv, float& qq) const {
        if (c < 256) { *(f32x4*)(RAW + (size_t)r * 768 + c) = a; *(f32x4*)(RAW + (size_t)r * 768 + c + 4) = b; qkv += sumsq8(a, b); }
        else if (c < 640) { *(u32x4*)(CQB + (size_t)r * 384 + (c - 256)) = pack8(a, b); qq += sumsq8(a, b); }
        else if (c < 704) { *(f32x4*)(RAW + (size_t)r * 768 + c) = a; *(f32x4*)(RAW + (size_t)r * 768 + c + 4) = b; } }
    MK_PRE_STAT(ssq)
    __device__ __forceinline__ void rgs(int r, int pn, int wc, int fq, f32x4 a0, f32x4 b0, f32x4 a1, f32x4 b1, const Pre pv, float& s1, float& s2) const {
        const float rs = rsqrtf(stat_f(pv) * (1.0f / 1024.0f) + RMS_EPS); const int c = pn * 256 + wc * 32 + 8 * fq; float qkv = 0.f, qq = 0.f;
        half(r, c, a0 * rs, b0 * rs, qkv, qq); half(r, c + 128, a1 * rs, b1 * rs, qkv, qq);
        s1 = quad_red(qkv); s2 = quad_red(qq);
    }
    __device__ __forceinline__ void stats(int r, int pn, float s1, float s2) const { if (!MK_DRY(*this)) { if (pn == 0) stat_add(ssq_kv + r, s1); else stat_add(ssq_q + r, s2); } }
    MK_EPI_CALL_DENSE()
};
struct EpiB2 {
    static constexpr bool PERM = true, AFTER_DRAIN = false;
    bf16* QF; const long long* ssq_q; const f32x2* rope;
    __device__ __forceinline__ void half(int r, int c, int tp, const f32x4 a, const f32x4 b) const {
        const int h = c / 320, w = c - h * 320;
        if (w < 256) *(u32x4*)(QF + (size_t)r * 2560 + c) = pack8(a, b);
        else { const int i0 = (w - 256) >> 1;
            const f32x4 cs01 = *(const f32x4*)(rope + (size_t)tp * 32 + i0), cs23 = *(const f32x4*)(rope + (size_t)tp * 32 + i0 + 2);
            bf16* qh = QF + (size_t)r * 2560 + h * 320 + 256;
            *(u32x2*)(qh + i0) = (u32x2){cvt_pk_bf16(a[0] * cs01[0] - a[1] * cs01[1], a[2] * cs01[2] - a[3] * cs01[3]), cvt_pk_bf16(b[0] * cs23[0] - b[1] * cs23[1], b[2] * cs23[2] - b[3] * cs23[3])};
            *(u32x2*)(qh + 32 + i0) = (u32x2){cvt_pk_bf16(a[0] * cs01[1] + a[1] * cs01[0], a[2] * cs01[3] + a[3] * cs01[2]), cvt_pk_bf16(b[0] * cs23[1] + b[1] * cs23[0], b[2] * cs23[3] + b[3] * cs23[2])}; } }
    MK_PRE_STAT(ssq_q)
    __device__ __forceinline__ void rgp(int r, int pn, int wc, int fq, f32x4 a0, f32x4 b0, f32x4 a1, f32x4 b1, const Pre pv) const {
        const float rs = rsqrtf(stat_f(pv) * (1.0f / 384.0f) + RMS_EPS) * (MLA_SCALE * 1.4426950408889634f)  ; const int tp = r < MP ? (r & 2047) : 2048 + ((r - MP) & 3), c = pn * 256 + wc * 32 + 8 * fq;
        half(r, c, tp, a0 * rs, b0 * rs); half(r, c + 128, tp, a1 * rs, b1 * rs);
    }
    MK_EPI_CALL()
};
struct EpiC1 {
    static constexpr bool PERM = true, AFTER_DRAIN = false;
    bf16* GATE; float* XW; const long long* ssq;
    MK_PRE_STAT(ssq)
    __device__ __forceinline__ void rgp(int r, int pn, int wc, int fq, f32x4 a0, f32x4 b0, f32x4 a1, f32x4 b1, const Pre pv) const {
        const bool isx = pn >= 5; const int c = (isx ? pn - 5 : pn) * 256 + wc * 32 + 8 * fq; const float rs = rsqrtf(stat_f(pv) * (1.0f / 1024.0f) + RMS_EPS);
        a0 *= rs; b0 *= rs; a1 *= rs; b1 *= rs;
        if (isx) { float* x = XW + (size_t)r * 1280 + c; *(f32x4*)x = a0; *(f32x4*)(x + 4) = b0; *(f32x4*)(x + 128) = a1; *(f32x4*)(x + 132) = b1; }
        else {
#pragma unroll
            for (int e = 0; e < 4; ++e) { a0[e] = gelu_tanh_f(a0[e]); b0[e] = gelu_tanh_f(b0[e]); a1[e] = gelu_tanh_f(a1[e]); b1[e] = gelu_tanh_f(b1[e]); }
            bf16* g = GATE + (size_t)r * 1280 + c; *(u32x4*)g = pack8(a0, b0); *(u32x4*)(g + 128) = pack8(a1, b1); }
    }
    MK_EPI_CALL()
};

template <class Epi>
__device__ __forceinline__ void mini_gemm(const P& p, const bf16* A, int lda, const bf16* Bt, int ldb, int K, int N, const Epi& E, int first_wg) {
    constexpr int BP = 272, SLOT = 64 * BP;
    const int tid = p.tid, lane = p.lane, w = p.wave, kq = w & 3, rgp = w >> 2, l15 = lane & 15, g4 = lane >> 4, nmu = (N >> 8) * 16, nch = K >> 7, nst = (nch + 3) >> 2;
    const int t128 = (rgp << 6) | lane;
    for (int mu = (p.bid - first_wg + p.G) % p.G; mu < nmu; mu += p.G) {
        const int pn = mu >> 4, wcq = (mu >> 2) & 3, rq = mu & 3, row = MP + 32 * rq + 16 * rgp + l15;
        const bf16* arow = A + (size_t)row * lda + 8 * g4;
        const int r0 = t128 >> 4, c16 = t128 & 15;
        const bf16* bbase = Bt + (size_t)(pn * 256 + wcq * 32 + 8 * (r0 >> 2) + (r0 & 3)) * ldb + c16 * 8; const int bo0 = r0 * BP + c16 * 16;
#define MG_BSRC(q) (bbase + (size_t)(128 * ((q) >> 2) + 4 * (((q) >> 1) & 1) + 16 * ((q) & 1)) * ldb)
#define MG_BOFF(q) (bo0 + 8 * (q) * BP)
        f32x4 acc[4];
#pragma unroll
        for (int t = 0; t < 4; ++t) acc[t] = (f32x4){0.f, 0.f, 0.f, 0.f};
        u32x4 b0[8], a0[4], b1[8], a1[4], b2[8], a2[4];
#define MG_LOAD(BS, AS, ST) do { const int ch_ = 4 * (ST) + kq; if (ch_ < nch) { \
            _Pragma("unroll") for (int q = 0; q < 8; ++q) BS[q] = *(const u32x4*)(MG_BSRC(q) + (size_t)ch_ * 128); \
            _Pragma("unroll") for (int s = 0; s < 4; ++s) AS[s] = *(const u32x4*)(arow + (size_t)ch_ * 128 + 32 * s); } } while (0)
#define MG_STEP(BS, AS, ST) do { LAS unsigned char* slot = p.lds + (kq * 2 + ((ST) & 1)) * SLOT; const bool ok_ = 4 * (ST) + kq < nch; \
            if (ok_) { _Pragma("unroll") for (int q = 0; q < 8; ++q) *(LAS u32x4*)(slot + MG_BOFF(q)) = BS[q]; } \
            bf16x8 af[4]; _Pragma("unroll") for (int s = 0; s < 4; ++s) af[s] = __builtin_bit_cast(bf16x8, AS[s]); \
            __syncthreads(); \
            if ((ST) + 3 < nst) MG_LOAD(BS, AS, (ST) + 3); \
            if (ok_) { _Pragma("unroll") for (int s = 0; s < 4; ++s) _Pragma("unroll") for (int t = 0; t < 4; ++t) { \
                const bf16x8 bf = *(const LAS bf16x8*)(slot + (t * 16 + l15) * BP + (32 * s + 8 * g4) * 2); \
                acc[t] = __builtin_amdgcn_mfma_f32_16x16x32_bf16(bf, af[s], acc[t], 0, 0, 0); } } } while (0)
        MG_LOAD(b0, a0, 0); if (1 < nst) MG_LOAD(b1, a1, 1); if (2 < nst) MG_LOAD(b2, a2, 2);
        __syncthreads();
        for (int st = 0; st < nst; st += 3) {
            MG_STEP(b0, a0, st);
            if (st + 1 < nst) MG_STEP(b1, a1, st + 1);
            if (st + 2 < nst) MG_STEP(b2, a2, st + 2);
        }
#undef MG_LOAD
#undef MG_STEP
#undef MG_BSRC
#undef MG_BOFF
        __syncthreads();
        LAS f32x4* red = (LAS f32x4*)p.lds;
        if (kq > 0) {
#pragma unroll
            for (int t = 0; t < 4; ++t) red[((rgp * 3 + (kq - 1)) * 4 + t) * 64 + lane] = acc[t]; }
        __syncthreads();
        if (kq == 0) {
#pragma unroll
            for (int k2 = 0; k2 < 3; ++k2)
#pragma unroll
                for (int t = 0; t < 4; ++t) acc[t] += red[((rgp * 3 + k2) * 4 + t) * 64 + lane];
            E.rg(row, pn, wcq, g4, acc[0], acc[1], acc[2], acc[3]); }
    }
}
}
namespace mk {
__device__ __forceinline__ s16x4 tr16(const LAS unsigned char* a) { return __builtin_amdgcn_ds_read_tr16_b64_v4i16((LAS s16x4*)a); }
__device__ __forceinline__ bf16x8 cat8(const s16x4 a, const s16x4 b) { return (bf16x8){a[0], a[1], a[2], a[3], b[0], b[1], b[2], b[3]}; }
__device__ __forceinline__ bf16x8 as_bf16x8(const u32x4 w) { return __builtin_bit_cast(bf16x8, w); }
#define MFMA16(A, B, C) __builtin_amdgcn_mfma_f32_16x16x32_bf16((A), (B), (C), 0, 0, 0)
constexpr int TP = 272;
constexpr int KP = 656;
constexpr float LOG2E = 1.4426950408889634f;

__device__ __forceinline__ void a2_spatial(const P& p, int j, float* out_cv  ) {
    const bf16* U = p.w<bf16>(WS_U); const bf16* GV = p.w<bf16>(WS_GV); bf16* UM = p.w<bf16>(WS_UM);
    const long long* lns = p.stat(ST_LNS0 + 2 * j); const long long* lnq = p.stat(ST_LNQ0 + 2 * j);
    const float* ln_g = p.in[10] + j * 1024; const float* ln_b = p.in[11] + j * 1024; const float* b_s = p.in[13] + j * 1024;
    LAS unsigned char* Wt = p.lds; LAS unsigned char* Vt = p.lds + 128 * TP;
    const int tid = p.tid, lane = p.lane, w = p.wave, l15 = lane & 15, g4 = lane >> 4, q4 = (lane & 15) >> 2, pp = lane & 3;
    { const float* aws = p.in[12] + (size_t)j * 8 * 16384;
      for (int idx = p.bid * 512 + tid; idx < 128 * 1024; idx += p.G * 512) {
        const int t = idx >> 10, d = idx & 1023, g = d >> 7, i = t & 3; const size_t r = (size_t)MP + t, rb = r - i;
        const float lg = ln_g[d], lb = ln_b[d]; float mixed = b_s[g * 128 + i], vi = 0.f;
#pragma unroll
        for (int s2 = 0; s2 < 4; ++s2) { const size_t rs = rb + s2;
            const float mu = stat_get(lns + rs) * (1.0f / 1024.0f), var = stat_get(lnq + rs) * (1.0f / 1024.0f) - mu * mu;
            const float v = (bf2f(GV[rs * 1024 + d]) - mu) * rsqrtf(var + LN_EPS) * lg + lb, wv = aws[(size_t)g * 16384 + i * 128 + s2];
            mixed += (s2 <= i) ? wv * v : 0.f; vi = (s2 == i) ? v : vi; }
        if (out_cv) out_cv[(size_t)t * 1024 + d] = vi;
        UM[r * 1024 + d] = (bf16)f2bf(bf2f(U[r * 1024 + d]) * mixed); } }
    for (int u = p.bid; u < 128 * 8; u += p.G) {
        const int c = u >> 3, g = u & 7, row0 = c * 128; const bool smp = false;
        const bf16* Wsrc = p.w<bf16>(WS_WS + (smp ? 524288 : 0) + (size_t)j * 262144) + (size_t)g * 16384;
#pragma unroll
        for (int q = 0; q < 4; ++q) { const int ch = tid + 512 * q, row = ch >> 4, c16 = ch & 15;
            *(LAS u32x4*)(Wt + row * TP + c16 * 16) = *(const u32x4*)(Wsrc + row * 128 + c16 * 8); }
        { const int c16 = tid & 15, d0 = g * 128 + c16 * 8;
          const f32x4 g0 = *(const f32x4*)(ln_g + d0), g1 = *(const f32x4*)(ln_g + d0 + 4), b0 = *(const f32x4*)(ln_b + d0), b1 = *(const f32x4*)(ln_b + d0 + 4);
          u32x4 raw[4]; float mean[4], rstd[4];
#pragma unroll
          for (int q = 0; q < 4; ++q) { const int r = row0 + (tid >> 4) + 32 * q; raw[q] = *(const u32x4*)(GV + (size_t)r * 1024 + d0);
              const float mu = stat_get(lns + r) * (1.0f / 1024.0f), var = stat_get(lnq + r) * (1.0f / 1024.0f) - mu * mu; mean[q] = mu; rstd[q] = rsqrtf(var + LN_EPS); }
#pragma unroll
          for (int q = 0; q < 4; ++q) { const int s = (tid >> 4) + 32 * q, r = row0 + s;
            f32x4 v0, v1;
            v0[0] = bflo(raw[q].x); v0[1] = bfhi(raw[q].x); v0[2] = bflo(raw[q].y); v0[3] = bfhi(raw[q].y); v1[0] = bflo(raw[q].z); v1[1] = bfhi(raw[q].z); v1[2] = bflo(raw[q].w); v1[3] = bfhi(raw[q].w);
            v0 = (v0 - mean[q]) * rstd[q] * g0 + b0; v1 = (v1 - mean[q]) * rstd[q] * g1 + b1;
            if (smp && out_cv) { float* o = out_cv + (size_t)(r - MP) * 1024 + d0; *(f32x4*)o = v0; *(f32x4*)(o + 4) = v1; }
            *(LAS u32x4*)(Vt + s * TP + c16 * 16) = pack8(v0, v1); } }
        u32x2 uu[8];
#pragma unroll
        for (int tt = 0; tt < 8; ++tt) uu[tt] = *(const u32x2*)(U + (size_t)(row0 + 16 * tt + l15) * 1024 + g * 128 + 16 * w + 4 * g4);
        __syncthreads();
        f32x4 acc[8];
#pragma unroll
        for (int tt = 0; tt < 8; ++tt) acc[tt] = (f32x4){0.f, 0.f, 0.f, 0.f};
#pragma unroll
        for (int kk = 0; kk < 4; ++kk) {
            const bf16x8 X = cat8(tr16(Vt + (32 * kk + 8 * g4 + q4) * TP + (16 * w + 4 * pp) * 2), tr16(Vt + (32 * kk + 8 * g4 + 4 + q4) * TP + (16 * w + 4 * pp) * 2));
#pragma unroll
            for (int tt = 0; tt < 8; ++tt) if (32 * kk <= 16 * tt + 15) {
                const bf16x8 Y = *(const LAS bf16x8*)(Wt + (16 * tt + l15) * TP + (32 * kk + 8 * g4) * 2);
                acc[tt] = MFMA16(X, Y, acc[tt]); }
        }
#pragma unroll
        for (int tt = 0; tt < 8; ++tt) { const int t = 16 * tt + l15, r = row0 + t, col = g * 128 + 16 * w + 4 * g4;
            const float bias = b_s[g * 128 + (smp ? (t & 3) : t)];
            const float o0 = bflo(uu[tt].x) * (acc[tt][0] + bias), o1 = bfhi(uu[tt].x) * (acc[tt][1] + bias), o2 = bflo(uu[tt].y) * (acc[tt][2] + bias), o3 = bfhi(uu[tt].y) * (acc[tt][3] + bias);
            *(u32x2*)(UM + (size_t)r * 1024 + col) = (u32x2){cvt_pk_bf16(o0, o1), cvt_pk_bf16(o2, o3)}; }
        __syncthreads();
    }
}

__device__ __forceinline__ void b2_kvfinal(const P& p, float* out_mp, float* out_ms) {
    const float* RAW = p.w<float>(WS_RAW); bf16* KVB = p.w<bf16>(WS_KVB); const long long* ssq_kv = p.stat(ST_KV); const float* kvn = p.in[19]; const f32x2* rope = p.w<f32x2>(WS_ROPE);
    const int gw = p.bid * NWAVES + p.wave, NGW = p.G * NWAVES, lane = p.lane, l31 = lane & 31;
    const f32x4 kn = *(const f32x4*)(kvn + 4 * lane);
    auto tpos = [&](int m) { return m < MP ? (m & 2047) : 2048 + ((m - MP) & 3); };
    long long sq = 0, sqn = 0; f32x4 rv = (f32x4){0.f, 0.f, 0.f, 0.f}, rvn = rv; f32x2 cs = (f32x2){0.f, 0.f}, csn = cs; float x1 = 0.f, x2 = 0.f, x1n = 0.f, x2n = 0.f;
    if (gw < MT) { const int m = gw; sq = ssq_kv[m]; rv = *(const f32x4*)(RAW + (size_t)m * 768 + 4 * lane); cs = rope[(size_t)tpos(m) * 32 + l31]; x1 = RAW[(size_t)m * 768 + 640 + l31]; x2 = RAW[(size_t)m * 768 + 672 + l31]; }
    for (int m = gw; m < MT; m += NGW) {
        { const int mn = (m + NGW < MT) ? m + NGW : m; sqn = ssq_kv[mn]; rvn = *(const f32x4*)(RAW + (size_t)mn * 768 + 4 * lane); csn = rope[(size_t)tpos(mn) * 32 + l31]; x1n = RAW[(size_t)mn * 768 + 640 + l31]; x2n = RAW[(size_t)mn * 768 + 672 + l31]; }
        float* o = m < MP ? (out_mp ? out_mp + (size_t)m * 320 : nullptr) : (out_ms ? out_ms + (size_t)(m - MP) * 320 : nullptr);
        const float rs = rsqrtf((float)sq * ST_INV * (1.0f / 256.0f) + RMS_EPS);
        const f32x4 v = rv * rs * kn;
        if (o) *(f32x4*)(o + 4 * lane) = v;
        *(u32x2*)(KVB + (size_t)m * 320 + 4 * lane) = (u32x2){cvt_pk_bf16(v[0], v[1]), cvt_pk_bf16(v[2], v[3])};
        if (lane < 32) {
            const float o1 = x1 * cs.x - x2 * cs.y, o2 = x1 * cs.y + x2 * cs.x;
            if (o) { o[256 + lane] = o1; o[288 + lane] = o2; }
            KVB[(size_t)m * 320 + 256 + lane] = (bf16)f2bf(o1); KVB[(size_t)m * 320 + 288 + lane] = (bf16)f2bf(o2); }
        sq = sqn; rv = rvn; cs = csn; x1 = x1n; x2 = x2n;
    }
}

__device__ __forceinline__ void b3_attn_prompt(const P& p) {
    const bf16* QF = p.w<bf16>(WS_QF); const bf16* KVB = p.w<bf16>(WS_KVB); bf16* OB = p.w<bf16>(WS_OB);
    const int lane = p.lane, h = p.wave, l15 = lane & 15, g4 = lane >> 4, q4 = (lane & 15) >> 2, pp = lane & 3;
    constexpr int TILE_B = 64 * 640;
    int soff[5];
#pragma unroll
    for (int i = 0; i < 5; ++i) { const int P_ = (h + 8 * i) * 64 + lane, row = P_ / 40, cph = P_ - 40 * row; soff[i] = row * 320 + ((cph ^ (row & 6)) << 3); }
    int kaddr[10];
#pragma unroll
    for (int s_ = 0; s_ < 10; ++s_) kaddr[s_] = l15 * 640 + (((4 * s_ + g4) ^ (l15 & 6)) << 4);
    int taddr[4];
    { const int rl = 4 * g4 + q4, m_ = (rl & 6) >> 1;
#pragma unroll
      for (int v3 = 0; v3 < 4; ++v3) taddr[v3] = rl * 640 + (((v3 ^ m_) << 1 | (pp >> 1)) << 4) + 8 * (pp & 1); }
#define AT_DMA(BUF, SRC) do { _Pragma("unroll") for (int i = 0; i < 5; ++i) \
        __builtin_amdgcn_global_load_lds((const unsigned*)((SRC) + soff[i]), (LAS unsigned*)((BUF) + (h + 8 * i) * 1024), 16, 0, 0); } while (0)
    for (int pi = p.bid; pi < 512; pi += p.G) {
        const int b = (p.G % 8 == 0) ? (pi & 7) : (pi >> 6), x = (p.G % 8 == 0) ? ((pi >> 3) & 63) : (pi & 63);
        for (int half = 0; half < 2; ++half) {
            const int qt = half ? 127 - x : x, t0 = 16 * qt, nkt = (t0 + 15) / 64 + 1;
            const size_t rowq = (size_t)b * 2048 + t0 + l15; const bf16* kvb = KVB + (size_t)b * 2048 * 320;
            AT_DMA(p.lds, kvb);
            bf16x8 Q[10];
#pragma unroll
            for (int s = 0; s < 10; ++s) Q[s] = as_bf16x8(*(const u32x4*)(QF + rowq * 2560 + h * 320 + 32 * s + 8 * g4));
            f32x4 O[16];
#pragma unroll
            for (int vt = 0; vt < 16; ++vt) O[vt] = (f32x4){0.f, 0.f, 0.f, 0.f};
            float mrun = -1e30f, lrun = 0.f;
            asm volatile("s_waitcnt vmcnt(0)" ::: "memory"); __syncthreads();
#define AT_TILE(BUF, KT, MASKED) do { \
                f32x4 S[4]; \
                _Pragma("unroll") for (int k4 = 0; k4 < 4; ++k4) S[k4] = (f32x4){0.f, 0.f, 0.f, 0.f}; \
                { bf16x8 Kc[4], Kn[4]; \
                  _Pragma("unroll") for (int k4 = 0; k4 < 4; ++k4) Kc[k4] = *(const LAS bf16x8*)((BUF) + kaddr[0] + k4 * 10240); \
                  _Pragma("unroll") for (int s = 0; s < 10; ++s) { \
                      if (s < 9) { _Pragma("unroll") for (int k4 = 0; k4 < 4; ++k4) Kn[k4] = *(const LAS bf16x8*)((BUF) + kaddr[s < 9 ? s + 1 : 9] + k4 * 10240); } \
                      _Pragma("unroll") for (int k4 = 0; k4 < 4; ++k4) S[k4] = MFMA16(Kc[k4], Q[s], S[k4]); \
                      _Pragma("unroll") for (int k4 = 0; k4 < 4; ++k4) Kc[k4] = Kn[k4]; } } \
                  \
                float mx = -1e30f; \
                _Pragma("unroll") for (int k4 = 0; k4 < 4; ++k4) _Pragma("unroll") for (int e = 0; e < 4; ++e) { float v = S[k4][e]; if ((MASKED) && 64 * (KT) + 16 * k4 + 4 * g4 + e > t0 + l15) v = -1e30f; S[k4][e] = v; mx = fmaxf(mx, v); } \
                mx = fmaxf(mx, __shfl_xor(mx, 16)); mx = fmaxf(mx, __shfl_xor(mx, 32)); \
                const float mnew = fmaxf(mrun, mx), alpha = __builtin_amdgcn_exp2f(mrun - mnew); mrun = mnew; \
                float ps = 0.f; \
                _Pragma("unroll") for (int k4 = 0; k4 < 4; ++k4) _Pragma("unroll") for (int e = 0; e < 4; ++e) { const float pv = __builtin_amdgcn_exp2f(S[k4][e] - mnew); S[k4][e] = pv; ps += pv; } \
                lrun = lrun * alpha + ps; \
                _Pragma("unroll") for (int vt = 0; vt < 16; ++vt) O[vt] *= alpha; \
                bf16x8 Pf[2]; \
                _Pragma("unroll") for (int ks = 0; ks < 2; ++ks) Pf[ks] = as_bf16x8((u32x4){cvt_pk_bf16(S[2 * ks][0], S[2 * ks][1]), cvt_pk_bf16(S[2 * ks][2], S[2 * ks][3]), cvt_pk_bf16(S[2 * ks + 1][0], S[2 * ks + 1][1]), cvt_pk_bf16(S[2 * ks + 1][2], S[2 * ks + 1][3])}); \
                  \
                { s16x4 Vc[4], Vn[4]; \
                  Vc[0] = AT_V(BUF, 0, 0, 0); Vc[1] = AT_V(BUF, 0, 0, 1); Vc[2] = AT_V(BUF, 0, 1, 0); Vc[3] = AT_V(BUF, 0, 1, 1); \
                  _Pragma("unroll") for (int vt = 0; vt < 16; ++vt) { \
                      if (vt < 15) { Vn[0] = AT_V(BUF, (vt < 15 ? vt + 1 : 15), 0, 0); Vn[1] = AT_V(BUF, (vt < 15 ? vt + 1 : 15), 0, 1); Vn[2] = AT_V(BUF, (vt < 15 ? vt + 1 : 15), 1, 0); Vn[3] = AT_V(BUF, (vt < 15 ? vt + 1 : 15), 1, 1); } \
                      O[vt] = MFMA16(cat8(Vc[0], Vc[1]), Pf[0], O[vt]); O[vt] = MFMA16(cat8(Vc[2], Vc[3]), Pf[1], O[vt]); \
                      _Pragma("unroll") for (int i = 0; i < 4; ++i) Vc[i] = Vn[i]; } } } while (0)
#define AT_V(BUF, VT, KS, T) tr16((BUF) + taddr[(VT) & 3] + ((VT) >> 2) * 128 + (32 * (KS) + 16 * (T)) * 640)
            for (int kt = 0; kt < nkt - 1; ++kt) {
                LAS unsigned char* buf = p.lds + (kt & 1) * TILE_B;
                AT_DMA(p.lds + ((kt + 1) & 1) * TILE_B, kvb + (size_t)64 * (kt + 1) * 320);
                AT_TILE(buf, kt, false);
                asm volatile("s_waitcnt vmcnt(0)" ::: "memory"); __syncthreads();
            }
            { const int kt = nkt - 1; LAS unsigned char* buf = p.lds + (kt & 1) * TILE_B;
              AT_TILE(buf, kt, true);
              __syncthreads(); }
#undef AT_TILE
#undef AT_V
            const float linv = 1.0f / quad_red(lrun);
#pragma unroll
            for (int vt = 0; vt < 16; ++vt) { const f32x4 o = O[vt] * linv;
                *(u32x2*)(OB + rowq * 2048 + h * 256 + 16 * vt + 4 * g4) = (u32x2){cvt_pk_bf16(o[0], o[1]), cvt_pk_bf16(o[2], o[3])}; }
        }
    }
#undef AT_DMA
}

__device__ __forceinline__ void b3_attn_sample(const P& p) {
    const bf16* QF = p.w<bf16>(WS_QF); float* PART = p.w<float>(WS_PART); float* PML = p.w<float>(WS_PML);
    const float* cache = p.in[2]; const int* ptab = (const int*)p.in[5];
    const int tid = p.tid, lane = p.lane, w = p.wave, qt = w & 1, dvq = w >> 1, l15 = lane & 15, g4 = lane >> 4, q4 = (lane & 15) >> 2, pp = lane & 3;
    constexpr int TILE_B = 64 * KP;
    for (int u = p.bid; u < 256; u += p.G) {
        const int b = u >> 3, sp = u & 7;
        const int hq = 4 * qt + (l15 >> 2), iq = l15 & 3; const size_t rowq = (size_t)MP + 4 * b + iq;
        bf16x8 Q[10];
#pragma unroll
        for (int s = 0; s < 10; ++s) Q[s] = as_bf16x8(*(const u32x4*)(QF + rowq * 2560 + hq * 320 + 32 * s + 8 * g4));
        f32x4 O[4];
#pragma unroll
        for (int v = 0; v < 4; ++v) O[v] = (f32x4){0.f, 0.f, 0.f, 0.f};
        float mrun = -1e30f, lrun = 0.f;
        f32x4 st[10];
        auto tile_src = [&](int ti) -> const float* { const int pg = 16 * sp + (ti >> 1); return cache + ((size_t)ptab[b * 128 + pg] * 128 + 64 * (ti & 1)) * 320; };
        { const float* src = tile_src(0);
#pragma unroll
          for (int q = 0; q < 10; ++q) st[q] = __builtin_nontemporal_load((const f32x4*)(src + (size_t)(tid + 512 * q) * 4));
          __syncthreads();
#pragma unroll
          for (int q = 0; q < 10; ++q) { const int ch = tid + 512 * q, row = ch / 80, c4 = ch % 80; *(LAS u32x2*)(p.lds + row * KP + c4 * 8) = (u32x2){cvt_pk_bf16(st[q][0], st[q][1]), cvt_pk_bf16(st[q][2], st[q][3])}; }
          __syncthreads(); }
        for (int ti = 0; ti < 32; ++ti) {
            LAS unsigned char* buf = p.lds + (ti & 1) * TILE_B;
            if (ti + 1 < 32) { const float* src = tile_src(ti + 1);
#pragma unroll
                for (int q = 0; q < 10; ++q) st[q] = __builtin_nontemporal_load((const f32x4*)(src + (size_t)(tid + 512 * q) * 4)); }
            f32x4 S[4];
#pragma unroll
            for (int k4 = 0; k4 < 4; ++k4) { S[k4] = (f32x4){0.f, 0.f, 0.f, 0.f};
#pragma unroll
                for (int s = 0; s < 10; ++s) { const bf16x8 Kf = *(const LAS bf16x8*)(buf + (16 * k4 + l15) * KP + (32 * s + 8 * g4) * 2); S[k4] = MFMA16(Kf, Q[s], S[k4]); } }
            float mx = -1e30f;
#pragma unroll
            for (int k4 = 0; k4 < 4; ++k4)
#pragma unroll
                for (int e = 0; e < 4; ++e) { const float v = S[k4][e]; mx = fmaxf(mx, v); }
            mx = fmaxf(mx, __shfl_xor(mx, 16)); mx = fmaxf(mx, __shfl_xor(mx, 32));
            const float mnew = fmaxf(mrun, mx), alpha = __builtin_amdgcn_exp2f(mrun - mnew); mrun = mnew;
            float ps = 0.f;
#pragma unroll
            for (int k4 = 0; k4 < 4; ++k4)
#pragma unroll
                for (int e = 0; e < 4; ++e) { const float pv = __builtin_amdgcn_exp2f(S[k4][e] - mnew); S[k4][e] = pv; ps += pv; }
            lrun = lrun * alpha + ps;
#pragma unroll
            for (int v = 0; v < 4; ++v) O[v] *= alpha;
            bf16x8 Pf[2];
#pragma unroll
            for (int ks = 0; ks < 2; ++ks) Pf[ks] = as_bf16x8((u32x4){cvt_pk_bf16(S[2 * ks][0], S[2 * ks][1]), cvt_pk_bf16(S[2 * ks][2], S[2 * ks][3]), cvt_pk_bf16(S[2 * ks + 1][0], S[2 * ks + 1][1]), cvt_pk_bf16(S[2 * ks + 1][2], S[2 * ks + 1][3])});
#pragma unroll
            for (int v = 0; v < 4; ++v) { const int vt = 4 * dvq + v;
#pragma unroll
                for (int ks = 0; ks < 2; ++ks) {
                    const bf16x8 Vf = cat8(tr16(buf + (32 * ks + 4 * g4 + q4) * KP + (16 * vt + 4 * pp) * 2), tr16(buf + (32 * ks + 16 + 4 * g4 + q4) * KP + (16 * vt + 4 * pp) * 2));
                    O[v] = MFMA16(Vf, Pf[ks], O[v]); } }
            if (ti + 1 < 32) { LAS unsigned char* nb = p.lds + ((ti + 1) & 1) * TILE_B;
#pragma unroll
                for (int q = 0; q < 10; ++q) { const int ch = tid + 512 * q, row = ch / 80, c4 = ch % 80; *(LAS u32x2*)(nb + row * KP + c4 * 8) = (u32x2){cvt_pk_bf16(st[q][0], st[q][1]), cvt_pk_bf16(st[q][2], st[q][3])}; } }
            __syncthreads();
        }
        const float lsum = quad_red(lrun); const int qrow = 16 * qt + l15; const size_t pb = ((size_t)(b * 8 + sp) * 32 + qrow);
#pragma unroll
        for (int v = 0; v < 4; ++v) *(f32x4*)(PART + pb * 256 + 16 * (4 * dvq + v) + 4 * g4) = O[v];
        if (dvq == 0 && g4 == 0) { PML[pb * 2] = mrun; PML[pb * 2 + 1] = lsum; }
    }
}
__device__ __forceinline__ void b3_combine(const P& p) {
    const bf16* QF = p.w<bf16>(WS_QF); const bf16* KVB = p.w<bf16>(WS_KVB); bf16* OB = p.w<bf16>(WS_OB); const float* PART = p.w<float>(WS_PART); const float* PML = p.w<float>(WS_PML);
    const int dv = p.tid & 255, sub = p.tid >> 8;
    for (int it = 2 * p.bid + sub; it < 1024; it += 2 * p.G) {
        const int b = it >> 5, i = (it >> 3) & 3, h = it & 7, qt = h >> 2, ql = ((h & 3) << 2) | i, qrow = 16 * qt + ql; const size_t row = (size_t)MP + 4 * b + i;
        float sn[4];
#pragma unroll
        for (int kk = 0; kk < 4; ++kk) { float s = 0.f;
            if (kk <= i) { const unsigned* qp = (const unsigned*)(QF + row * 2560 + h * 320); const unsigned* kp = (const unsigned*)(KVB + ((size_t)MP + 4 * b + kk) * 320);
                for (int d = 0; d < 160; ++d) { const unsigned a = qp[d], c = kp[d]; s += bflo(a) * bflo(c) + bfhi(a) * bfhi(c); } }
            sn[kk] = (kk <= i) ? s : -1e30f; }
        float M = fmaxf(fmaxf(sn[0], sn[1]), fmaxf(sn[2], sn[3])); float ms[8], ls[8];
#pragma unroll
        for (int sp = 0; sp < 8; ++sp) { const size_t pb = ((size_t)(b * 8 + sp) * 32 + qrow); ms[sp] = PML[pb * 2]; ls[sp] = PML[pb * 2 + 1]; M = fmaxf(M, ms[sp]); }
        float L = 0.f, Oa = 0.f;
#pragma unroll
        for (int sp = 0; sp < 8; ++sp) { const size_t pb = ((size_t)(b * 8 + sp) * 32 + qrow); const float wgt = __builtin_amdgcn_exp2f(ms[sp] - M); L += ls[sp] * wgt; Oa += PART[pb * 256 + dv] * wgt; }
#pragma unroll
        for (int kk = 0; kk < 4; ++kk) { const float pk = __builtin_amdgcn_exp2f(sn[kk] - M); L += pk; Oa += pk * bf2f(KVB[((size_t)MP + 4 * b + kk) * 320 + dv]); }
        OB[row * 2048 + h * 256 + dv] = (bf16)f2bf(Oa / L);
    }
}

template <bool SMP>
__device__ __forceinline__ f32x4 conv4(const float* XW, const float* cbuf  , const float* cw, const float* cb, int m, int c) {
    f32x4 acc = *(const f32x4*)(cb + c);
    f32x4 v[4], wv[4];
#pragma unroll
    for (int k = 0; k < 4; ++k) { wv[k] = *(const f32x4*)(cw + k * 1280 + c);
        if (!SMP) { const int t = m & 2047, r = t + k - 3; v[k] = *(const f32x4*)(XW + (size_t)(m + (r >= 0 ? k - 3 : -t)) * 1280 + c); if (r < 0) wv[k] = (f32x4){0.f, 0.f, 0.f, 0.f}; }
        else { const int b = (m - MP) >> 2, t = (m - MP) & 3, r = t + k - 3; const float* ptr = (r >= 0) ? XW + (size_t)(m + k - 3) * 1280 + c : cbuf + ((size_t)b * 3 + (3 + r)) * 1280 + c; v[k] = *(const f32x4*)ptr; } }
#pragma unroll
    for (int k = 0; k < 4; ++k) acc += wv[k] * v[k];
    return acc;
}
__device__ __forceinline__ void c2_rglru(const P& p, int j, float* out_cp, float* out_cs, float* out_hs, const int mask) {
    const float* XW = p.w<float>(WS_XW); bf16* LH = p.w<bf16>(WS_AA); bf16* CPB = p.w<bf16>(WS_BB); float* AGG = p.w<float>(WS_AGG);
    const float* cbuf = p.in[4] + (size_t)j * 32 * 3 * 1280; const float* cw = p.in[25] + (size_t)j * 4 * 1280; const float* cb = p.in[26] + j * 1280;
    const float* b_a = p.in[28] + j * 1280; const float* b_i = p.in[30] + j * 1280; const float* lam = p.in[31] + j * 1280; const float* h0s = p.in[3] + (size_t)j * 32 * 1280;
    const bf16* WaT = p.w<bf16>(WS_WAT); const bf16* WiT = p.w<bf16>(WS_WIT);
    LAS unsigned char* Xt = p.lds; LAS unsigned char* At = p.lds + 128 * TP; LAS unsigned char* It = p.lds + 256 * TP;
    LAS float* LA = (LAS float*)p.lds;
    LAS unsigned char* LB = p.lds + 128 * 528;
    LAS float* QT = (LAS float*)(p.lds + 128 * 528 + 128 * TP);
    const int tid = p.tid, lane = p.lane, w = p.wave, l15 = lane & 15, g4 = lane >> 4;
    { const int gt = p.bid * 512 + tid, NGT = p.G * 512;
      for (int i = gt; i < (8 + 32) * 3 * 320; i += NGT) { const int c = (i % 320) * 4, rr = i / 320, jj = rr % 3, bb = rr / 3;
          if (bb < 8) { if (out_cp) *(f32x4*)(out_cp + ((size_t)bb * 3 + jj) * 1280 + c) = *(const f32x4*)(XW + ((size_t)bb * 2048 + 2045 + jj) * 1280 + c); }
          else { const int b = bb - 8; if (out_cs) *(f32x4*)(out_cs + ((size_t)b * 3 + jj) * 1280 + c) = *(const f32x4*)(XW + ((size_t)MP + 4 * b + 1 + jj) * 1280 + c); } } }
    const int c16 = tid & 15;
    f32x4 wv[4][2], bv[2], xv0[2][4][2]; u32x4 wa[4], wi[4];
#define C2_LOADW(U) do { const int n_ = (U) % 10, cch_ = n_ * 128 + c16 * 8; \
        _Pragma("unroll") for (int k = 0; k < 4; ++k) { wv[k][0] = *(const f32x4*)(cw + k * 1280 + cch_); wv[k][1] = *(const f32x4*)(cw + k * 1280 + cch_ + 4); } \
        bv[0] = *(const f32x4*)(cb + cch_); bv[1] = *(const f32x4*)(cb + cch_ + 4); } while (0)
#define C2_LOADG(U) do { const int n_ = (U) % 10; \
        _Pragma("unroll") for (int q = 0; q < 4; ++q) { const int row = (tid >> 4) + 32 * q; wa[q] = *(const u32x4*)(WaT + (size_t)n_ * 16384 + row * 128 + c16 * 8); wi[q] = *(const u32x4*)(WiT + (size_t)n_ * 16384 + row * 128 + c16 * 8); } } while (0)
#define C2_LOADX(U, QH, XV) do { const int T_ = (U) / 10, cch_ = ((U) % 10) * 128 + c16 * 8; \
        _Pragma("unroll") for (int qq = 0; qq < 2; ++qq) { const int m = T_ * 128 + (tid >> 4) + 32 * (2 * (QH) + qq); \
            _Pragma("unroll") for (int k = 0; k < 4; ++k) { const float* ptr; \
                if (T_ < 128) { const int t = m & 2047, r = t + k - 3; ptr = XW + (size_t)(m + (r >= 0 ? k - 3 : -t)) * 1280 + cch_; } \
                else { const int b = (m - MP) >> 2, t = (m - MP) & 3, r = t + k - 3; ptr = (r >= 0) ? XW + (size_t)(m + k - 3) * 1280 + cch_ : cbuf + ((size_t)b * 3 + (3 + r)) * 1280 + cch_; } \
                XV[qq][k][0] = *(const f32x4*)ptr; XV[qq][k][1] = *(const f32x4*)(ptr + 4); } } } while (0)
#define C2_CONV(U, QH, XV) do { const int T_ = (U) / 10; \
        _Pragma("unroll") for (int qq = 0; qq < 2; ++qq) { const int row = (tid >> 4) + 32 * (2 * (QH) + qq), m = T_ * 128 + row; f32x4 v0 = bv[0], v1 = bv[1]; \
            _Pragma("unroll") for (int k = 0; k < 4; ++k) { const bool live = (T_ >= 128) || (((m & 2047) + k - 3) >= 0); const f32x4 z = (f32x4){0.f, 0.f, 0.f, 0.f}; \
                v0 += (live ? wv[k][0] : z) * XV[qq][k][0]; v1 += (live ? wv[k][1] : z) * XV[qq][k][1]; } \
            *(LAS u32x4*)(Xt + row * TP + c16 * 16) = pack8(v0, v1); } } while (0)
    if (p.bid < 129 * 10) { C2_LOADX(p.bid, 0, xv0); }
    for (int u = p.bid; u < 129 * 10; u += p.G) {
        int tl_ = p.tid; asm volatile("" : "+v"(tl_)); const int tid = tl_, lane = tl_ & 63, l15 = lane & 15, g4 = lane >> 4, c16 = tl_ & 15;
        const int T = u / 10, n = u % 10, row0 = T * 128;
        {
            C2_LOADW(u); C2_LOADG(u);
            C2_CONV(u, 0, xv0); C2_LOADX(u, 1, xv0); C2_CONV(u, 1, xv0);
#pragma unroll
            for (int q = 0; q < 4; ++q) { const int row = (tid >> 4) + 32 * q; *(LAS u32x4*)(At + row * TP + c16 * 16) = wa[q]; *(LAS u32x4*)(It + row * TP + c16 * 16) = wi[q]; }
        }
        __syncthreads();
        f32x4 ca[8], ci[8];
#pragma unroll
        for (int tt = 0; tt < 8; ++tt) { ca[tt] = (f32x4){0.f, 0.f, 0.f, 0.f}; ci[tt] = (f32x4){0.f, 0.f, 0.f, 0.f}; }
        {
#pragma unroll
        for (int kk = 0; kk < 4; ++kk) {
            const bf16x8 Xa = *(const LAS bf16x8*)(At + (16 * w + l15) * TP + (32 * kk + 8 * g4) * 2), Xi = *(const LAS bf16x8*)(It + (16 * w + l15) * TP + (32 * kk + 8 * g4) * 2);
#pragma unroll
            for (int tt = 0; tt < 8; ++tt) { const bf16x8 Y = *(const LAS bf16x8*)(Xt + (16 * tt + l15) * TP + (32 * kk + 8 * g4) * 2);
                ca[tt] = MFMA16(Xa, Y, ca[tt]); ci[tt] = MFMA16(Xi, Y, ci[tt]); }
        }
        const int chn = n * 128 + 16 * w + 4 * g4;
        { const f32x4 ba = *(const f32x4*)(b_a + chn), bi = *(const f32x4*)(b_i + chn), lm = *(const f32x4*)(lam + chn);
          f32x4 sp;
#pragma unroll
          for (int e = 0; e < 4; ++e) { const float nl = -lm[e]; sp[e] = -8.0f * LOG2E * ((nl > 20.f) ? nl : log1pf(expf(nl))); }
#pragma unroll
          for (int tt = 0; tt < 8; ++tt) { const u32x2 xb = *(const LAS u32x2*)(Xt + (16 * tt + l15) * TP + (16 * w + 4 * g4) * 2);
              const f32x4 xc = (f32x4){bflo(xb.x), bfhi(xb.x), bflo(xb.y), bfhi(xb.y)};
#pragma unroll
              for (int e = 0; e < 4; ++e) { const float r = fast_sigmoid_l2(LOG2E * (ca[tt][e] + ba[e])), gi = fast_sigmoid_l2(LOG2E * (ci[tt][e] + bi[e]));
                  const float a = __builtin_amdgcn_exp2f(r * sp[e]);
                  ca[tt][e] = a; ci[tt][e] = __builtin_amdgcn_sqrtf(fmaxf(__builtin_fmaf(-a, a, 1.0f), 0.f)) * gi * xc[e]; } } }
        }
        __syncthreads();
#pragma unroll
        for (int tt = 0; tt < 8; ++tt) { const int tok = 16 * tt + l15;
            *(LAS f32x4*)(LA + tok * 132 + 16 * w + 4 * g4) = ca[tt];
            *(LAS u32x2*)(LB + tok * TP + (16 * w + 4 * g4) * 2) = (u32x2){cvt_pk_bf16(ci[tt][0], ci[tt][1]), cvt_pk_bf16(ci[tt][2], ci[tt][3])}; }
        __syncthreads();
        { const int un = u + p.G; if (un < 129 * 10) { C2_LOADX(un, 0, xv0); } }
        const int ch = tid & 127, q = tid >> 7, chg = n * 128 + ch;
        {
        if (T < 128) {
            float P_ = 1.f, H_ = 0.f;
#pragma unroll 4
            for (int t = 32 * q; t < 32 * q + 32; ++t) { const float a = LA[t * 132 + ch], b = bf2f(*(const LAS bf16*)(LB + t * TP + ch * 2)); H_ = a * H_ + b; P_ *= a; }
            QT[(q * 128 + ch) * 2] = P_; QT[(q * 128 + ch) * 2 + 1] = H_;
            __syncthreads();
            float h = 0.f, pc = 1.f;
#pragma unroll
            for (int qq = 0; qq < 3; ++qq) if (qq < q) { const float Pq = QT[(qq * 128 + ch) * 2], Hq = QT[(qq * 128 + ch) * 2 + 1]; h = Pq * h + Hq; pc *= Pq; }
#pragma unroll 4
            for (int t = 32 * q; t < 32 * q + 32; ++t) { const float a = LA[t * 132 + ch], b = bf2f(*(const LAS bf16*)(LB + t * TP + ch * 2)); h = a * h + b; pc *= a;
                LA[t * 132 + ch] = pc; *(LAS bf16*)(LB + t * TP + ch * 2) = (bf16)f2bf(h); }
            if (q == 3) { AGG[((size_t)T * 2) * 1280 + chg] = pc; AGG[((size_t)T * 2 + 1) * 1280 + chg] = h; }
        } else {
            for (int bb = 8 * q; bb < 8 * q + 8; ++bb) { float h = h0s[(size_t)bb * 1280 + chg];
#pragma unroll
                for (int i = 0; i < 4; ++i) { const int t = 4 * bb + i; const float a = LA[t * 132 + ch], b = bf2f(*(const LAS bf16*)(LB + t * TP + ch * 2)); h = a * h + b;
                    LA[t * 132 + ch] = 0.f; *(LAS bf16*)(LB + t * TP + ch * 2) = (bf16)f2bf(h); }
                if (out_hs) out_hs[(size_t)bb * 1280 + chg] = h; }
        }
        }
        __syncthreads();
#pragma unroll
        for (int i = 0; i < 4; ++i) { const int cidx = tid + 512 * i, tok = cidx >> 4, c8 = (cidx & 15) * 8; const size_t o = (size_t)(row0 + tok) * 1280 + n * 128 + c8;
            *(u32x4*)(LH + o) = *(const LAS u32x4*)(LB + tok * TP + c8 * 2);
            *(u32x4*)(CPB + o) = pack8(*(const LAS f32x4*)(LA + tok * 132 + c8), *(const LAS f32x4*)(LA + tok * 132 + c8 + 4)); }
        __syncthreads();
    }
#undef C2_LOADW
#undef C2_LOADG
#undef C2_LOADX
#undef C2_CONV
}
__device__ __forceinline__ void c5_fixup(const P& p, float* out_hp) {
    const bf16* LH = p.w<bf16>(WS_AA); const bf16* CPB = p.w<bf16>(WS_BB); const float* AGG = p.w<float>(WS_AGG); const bf16* GATE = p.w<bf16>(WS_GATE); bf16* GH = p.w<bf16>(WS_GH);
    LAS float* cr = (LAS float*)p.lds;
    const int tid = p.tid;
    for (int ci = p.bid * 512 + tid; ci < 128 * 160; ci += p.G * 512) { const size_t o = (size_t)MP * 1280 + (size_t)ci * 8;
        const u32x4 lh = *(const u32x4*)(LH + o), gt = *(const u32x4*)(GATE + o); f32x4 r0, r1;
        r0[0] = bflo(gt.x) * bflo(lh.x); r0[1] = bfhi(gt.x) * bfhi(lh.x); r0[2] = bflo(gt.y) * bflo(lh.y); r0[3] = bfhi(gt.y) * bfhi(lh.y);
        r1[0] = bflo(gt.z) * bflo(lh.z); r1[1] = bfhi(gt.z) * bfhi(lh.z); r1[2] = bflo(gt.w) * bflo(lh.w); r1[3] = bfhi(gt.w) * bfhi(lh.w);
        *(u32x4*)(GH + o) = pack8(r0, r1); }
    for (int it = p.bid; it < 256; it += p.G) {
        const int T = it >> 1, hf = it & 1, row0 = T * 128 + 64 * hf, T0 = T & ~15, nd = T - T0;
        const size_t ob = (size_t)row0 * 1280 + (size_t)tid * 8;
#define C5_LOAD(LHV, CPV, GTV, K) do { _Pragma("unroll") for (int i = 0; i < 5; ++i) { const size_t o = ob + (size_t)(5 * (K) + i) * 4096; \
            LHV[i] = *(const u32x4*)(LH + o); CPV[i] = *(const u32x4*)(CPB + o); GTV[i] = *(const u32x4*)(GATE + o); } } while (0)
        u32x4 lhA[5], cpA[5], gtA[5], lhB[5], cpB[5], gtB[5];
        C5_LOAD(lhA, cpA, gtA, 0);
        for (int ch = tid; ch < 1280; ch += 512) {
            float pa[16], ha[16];
#pragma unroll
            for (int d = 0; d < 16; ++d) { pa[d] = AGG[((size_t)(T0 + d) * 2) * 1280 + ch]; ha[d] = AGG[((size_t)(T0 + d) * 2 + 1) * 1280 + ch]; }
            float c = 0.f;
#pragma unroll
            for (int d = 0; d < 15; ++d) c = (d < nd) ? pa[d] * c + ha[d] : c;
            if (nd == 15 && hf == 1 && out_hp) out_hp[(size_t)(T >> 4) * 1280 + ch] = pa[15] * c + ha[15];
            cr[ch] = c; }
        __syncthreads();
#define C5_ITEM(LHV, CPV, GTV, I) do { const int c8 = ((tid + 512 * (I)) % 160) * 8; const size_t o = ob + (size_t)(I) * 4096; \
            const f32x4 c0 = *(const LAS f32x4*)(cr + c8), c1 = *(const LAS f32x4*)(cr + c8 + 4); f32x4 r0, r1; \
            r0[0] = bflo(GTV.x) * (bflo(LHV.x) + bflo(CPV.x) * c0[0]); r0[1] = bfhi(GTV.x) * (bfhi(LHV.x) + bfhi(CPV.x) * c0[1]); \
            r0[2] = bflo(GTV.y) * (bflo(LHV.y) + bflo(CPV.y) * c0[2]); r0[3] = bfhi(GTV.y) * (bfhi(LHV.y) + bfhi(CPV.y) * c0[3]); \
            r1[0] = bflo(GTV.z) * (bflo(LHV.z) + bflo(CPV.z) * c1[0]); r1[1] = bfhi(GTV.z) * (bfhi(LHV.z) + bfhi(CPV.z) * c1[1]); \
            r1[2] = bflo(GTV.w) * (bflo(LHV.w) + bflo(CPV.w) * c1[2]); r1[3] = bfhi(GTV.w) * (bfhi(LHV.w) + bfhi(CPV.w) * c1[3]); \
            *(u32x4*)(GH + o) = pack8(r0, r1); } while (0)
        C5_LOAD(lhB, cpB, gtB, 1);
#pragma unroll
        for (int i = 0; i < 5; ++i) C5_ITEM(lhA[i], cpA[i], gtA[i], i);
        C5_LOAD(lhA, cpA, gtA, 2);
#pragma unroll
        for (int i = 0; i < 5; ++i) C5_ITEM(lhB[i], cpB[i], gtB[i], 5 + i);
        C5_LOAD(lhB, cpB, gtB, 3);
#pragma unroll
        for (int i = 0; i < 5; ++i) C5_ITEM(lhA[i], cpA[i], gtA[i], 10 + i);
#pragma unroll
        for (int i = 0; i < 5; ++i) C5_ITEM(lhB[i], cpB[i], gtB[i], 15 + i);
#undef C5_LOAD
#undef C5_ITEM
        __syncthreads();
    }
}
__device__ __forceinline__ void final_norm(const P& p, float* out_yp, float* out_ys) {
    const bf16* HB = p.w<bf16>(WS_HB); const long long* ssq = p.stat(ST_SSQ0 + 8); const float* g = p.in[8];
    const int gw = p.bid * NWAVES + p.wave, NGW = p.G * NWAVES, lane = p.lane;
    f32x4 gv[4];
#pragma unroll
    for (int jj = 0; jj < 4; ++jj) gv[jj] = *(const f32x4*)(g + 4 * lane + 256 * jj);
    u32x2 hw[4], hn[4]; long long sq = 0, sn = 0;
    if (gw < MT) { sq = ssq[gw];
#pragma unroll
        for (int jj = 0; jj < 4; ++jj) hw[jj] = *(const u32x2*)(HB + (size_t)gw * 1024 + 4 * lane + 256 * jj); }
    for (int m = gw; m < MT; m += NGW) { float* o = m < MP ? out_yp + (size_t)m * 1024 : out_ys + (size_t)(m - MP) * 1024;
        const int mn = (m + NGW < MT) ? m + NGW : m; sn = ssq[mn];
#pragma unroll
        for (int jj = 0; jj < 4; ++jj) hn[jj] = *(const u32x2*)(HB + (size_t)mn * 1024 + 4 * lane + 256 * jj);
        const float rs = rsqrtf((float)sq * ST_INV * (1.0f / 1024.0f) + RMS_EPS);
#pragma unroll
        for (int jj = 0; jj < 4; ++jj) *(f32x4*)(o + 4 * lane + 256 * jj) = (f32x4){bflo(hw[jj].x), bfhi(hw[jj].x), bflo(hw[jj].y), bfhi(hw[jj].y)} * rs * gv[jj];
#pragma unroll
        for (int jj = 0; jj < 4; ++jj) hw[jj] = hn[jj];
        sq = sn; }
}
}
namespace mk {
struct Args { const float* in[36]; float* out; unsigned char* ws; int ph_lo, ph_hi, li, mask; };
constexpr int NPHASE = 34;

#define MK_GEMM(EpiT, E, Aptr, LDA, Bptr, LDB, KD, NC) do { pg8::Gemm g_{(const pg8::bf16_t*)(Aptr), (const pg8::bf16_t*)(Bptr), (LDA), (LDB), (KD)}; pg8::StaticOrder S_; S_.init(MP, (NC), p.G, p.bid); \
        pg8::gemm_phase<EpiT, pg8::StaticOrder, true, true>(p.lds, g_, S_, E, p.tid); \
          \
        P q_ = p; { int t2_ = p0.tid; asm volatile("" : "+v"(t2_)); q_.tid = t2_; q_.lane = t2_ & 63; q_.wave = __builtin_amdgcn_readfirstlane(t2_ >> 6); } \
        mini_gemm<EpiT>(q_, (const bf16*)(Aptr), (LDA), (const bf16*)(Bptr), (LDB), (KD), (NC), E, (64 * ((NC) / 256)) % p.G); } while (0)

#ifdef MK_DRYPROBE
#define MK_DRYARG , ((mask >> 10) & 1)
#else
#define MK_DRYARG
#endif
#ifndef MK_REP_SEL
#define MK_REP_SEL(k) 0
#define MK_REP_N 1
#endif
#define REPF(k) for (int rep_ = 0; rep_ < (MK_REP_SEL(k) ? MK_REP_N : 1); ++rep_)
#define IN_(k) (lo <= (k) && (k) < hi)
#define PH_BEGIN() P p = p0; { int z_ = 0, t_ = p0.tid, g_ = p0.G, b_ = p0.bid; unsigned l_ = (unsigned)(size_t)p0.lds; asm volatile("" : "+s"(z_), "+v"(t_), "+s"(g_), "+s"(b_), "+s"(l_)); p.ws = p0.ws + z_; p.out = p0.out + z_; p.tid = t_; p.lane = t_ & 63; p.wave = __builtin_amdgcn_readfirstlane(t_ >> 6); p.G = g_; p.bid = b_; p.lds = (LAS unsigned char*)(size_t)l_; } float* const out = p.out; (void)out
#ifdef MK_PROF
#define STAMP(k) do { if (p0.bid == 0 && p0.tid == 0) ((unsigned long long*)(p0.ws + WS_PROF))[(k)] = (unsigned long long)wall_clock64(); } while (0)
#else
#define STAMP(k) do { } while (0)
#endif
#define ENDPH(k) do { if ((k) + 1 < hi) xcd_barrier(bar); STAMP((k) + 1); } while (0)
template <int LAYER> __device__ __forceinline__ void run_layer(const P& p0, const XcdBarrier& bar, const int lo, const int hi, const int mask) {
        constexpr int layer = LAYER, kind = layer % 3, j = layer / 3, pb = 1 + 8 * layer;
        constexpr size_t resA = kind == 0 ? WS_UM : kind == 1 ? WS_OB : WS_GH, resB = kind == 0 ? WS_WOUT + (size_t)j * 2 * MiB : kind == 1 ? WS_WOV : WS_WCO; constexpr int resK = kind == 0 ? 1024 : kind == 1 ? 2048 : 1280;
        if constexpr (kind == 0) {
            if (IN_(pb)) REPF(pb) { PH_BEGIN(); EpiA1 E{p.w<bf16>(WS_U), p.w<bf16>(WS_GV), p.stat(ST_SSQ0 + 2 * layer), p.stat(ST_LNS0 + 2 * j), p.stat(ST_LNQ0 + 2 * j) MK_DRYARG};
                MK_GEMM(EpiA1, E, p.w<bf16>(WS_HB), 1024, p.w<bf16>(WS_WIN + (size_t)j * 4 * MiB), 1024, 1024, 2048); ENDPH(pb); }
            if (IN_(pb + 1)) REPF(pb + 1) { PH_BEGIN(); a2_spatial(p, j, out + O_CV + (size_t)j * 131072); ENDPH(pb + 1); }
        } else if constexpr (kind == 1) {
            if (IN_(pb)) REPF(pb) { PH_BEGIN(); EpiB1 E{p.w<float>(WS_RAW), p.w<bf16>(WS_CQB), p.stat(ST_SSQ0 + 2 * layer), p.stat(ST_KV), p.stat(ST_Q) MK_DRYARG};
                MK_GEMM(EpiB1, E, p.w<bf16>(WS_HB), 1024, p.w<bf16>(WS_WDQKV), 1024, 1024, 768); ENDPH(pb); }
            if (IN_(pb + 1)) REPF(pb + 1) { PH_BEGIN(); b2_kvfinal(p, out + O_MP, out + O_MS);
                EpiB2 E{p.w<bf16>(WS_QF), p.stat(ST_Q), p.w<f32x2>(WS_ROPE)};
                MK_GEMM(EpiB2, E, p.w<bf16>(WS_CQB), 384, p.w<bf16>(WS_WQ), 384, 384, 2560); ENDPH(pb + 1); }
            if (IN_(pb + 2)) REPF(pb + 2) { PH_BEGIN();
                if (mask & 256) b3_attn_prompt(p); if (mask & 512) b3_attn_sample(p);
                ENDPH(pb + 2); }
            if (IN_(pb + 3)) REPF(pb + 3) { PH_BEGIN(); b3_combine(p); ENDPH(pb + 3); }
        } else {
            if (IN_(pb)) REPF(pb) { PH_BEGIN(); EpiC1 E{p.w<bf16>(WS_GATE), p.w<float>(WS_XW), p.stat(ST_SSQ0 + 2 * layer)};
                MK_GEMM(EpiC1, E, p.w<bf16>(WS_HB), 1024, p.w<bf16>(WS_WGX), 1024, 1024, 2560); ENDPH(pb); }
            if (IN_(pb + 1)) REPF(pb + 1) { PH_BEGIN(); c2_rglru(p, j, out + O_CP, out + O_CS, out + O_HS, mask); ENDPH(pb + 1); }
            if (IN_(pb + 3)) REPF(pb + 3) { PH_BEGIN(); c5_fixup(p, out + O_HP); ENDPH(pb + 3); }
        }
        if (IN_(pb + 5)) REPF(pb + 5) { PH_BEGIN(); EpiRes E{p.w<bf16>(WS_HB), p.stat(ST_SSQ0 + 2 * layer + 1) MK_DRYARG}; MK_GEMM(EpiRes, E, p.w<bf16>(resA), resK, p.w<bf16>(resB), resK, resK, 1024); ENDPH(pb + 5); }
        if (IN_(pb + 6)) REPF(pb + 6) { PH_BEGIN(); EpiF1 E{p.w<bf16>(WS_ACT), p.stat(ST_SSQ0 + 2 * layer + 1)}; MK_GEMM(EpiF1, E, p.w<bf16>(WS_HB), 1024, p.w<bf16>(WS_WGU + (size_t)layer * WGU_BYTES), 1024, 1024, 5632); ENDPH(pb + 6); }
        if (IN_(pb + 7)) REPF(pb + 7) { PH_BEGIN(); EpiRes E{p.w<bf16>(WS_HB), p.stat(ST_SSQ0 + 2 * layer + 2) MK_DRYARG}; MK_GEMM(EpiRes, E, p.w<bf16>(WS_ACT), DFF, p.w<bf16>(WS_WD + (size_t)layer * WD_BYTES), DFF, DFF, 1024); ENDPH(pb + 7); }
}
__global__ void __launch_bounds__(NWAVES * 64, 2) mk_fwd(Args a) {
    extern __shared__ __attribute__((aligned(16))) unsigned char lds_raw[];
    const int tid_ = threadIdx.x;
    const P p0{InTab{(const float* const __attribute__((address_space(4)))*)__builtin_amdgcn_kernarg_segment_ptr()}, a.out, a.ws, (LAS unsigned char*)lds_raw, tid_, tid_ & 63, __builtin_amdgcn_readfirstlane(tid_ >> 6), (int)gridDim.x, (int)blockIdx.x};
    volatile LAS unsigned* MISC = (volatile LAS unsigned*)(p0.lds + MISC_OFF);
    if (p0.tid < 64) MISC[p0.tid] = 0u;
    __syncthreads();
    XcdBarrier bar = xcd_barrier_post((unsigned*)(a.ws + WS_CTL) + CW_BAR + a.li * XCD_BAR_WORDS, MISC + 8);
    const int lo = a.ph_lo, hi = a.ph_hi, mask = a.mask;
    STAMP(0);
    if (IN_(0)) REPF(0) { PH_BEGIN(); p0_prologue(p, mask); if (mask & 128)
        { const int gt = p.bid * 512 + p.tid, NGT = p.G * 512; const u32x4 z = (u32x4){0u, 0u, 0u, 0u};
          for (int i = gt; i < 128 * 128; i += NGT) p.w<u32x4>(WS_UM + (size_t)MT * 2048)[i] = z;
          for (int i = gt; i < 128 * 256; i += NGT) p.w<u32x4>(WS_OB + (size_t)MT * 4096)[i] = z;
          for (int i = gt; i < 128 * 160; i += NGT) p.w<u32x4>(WS_GH + (size_t)MT * 2560)[i] = z; }
        ENDPH(0); }
    run_layer<0>(p0, bar, lo, hi, mask); run_layer<1>(p0, bar, lo, hi, mask); run_layer<2>(p0, bar, lo, hi, mask); run_layer<3>(p0, bar, lo, hi, mask);
    if (IN_(33)) REPF(33) { PH_BEGIN(); final_norm(p, out + O_YP, out + O_YS); VM_WAIT(); STAMP(34); }
#undef IN_
#undef ENDPH
}

inline void fill_args(Args& a, void* const* d_in, float* out, void* d_ws) { for (int i = 0; i < 36; ++i) a.in[i] = (const float*)d_in[i]; a.out = out; a.ws = (unsigned char*)d_ws; a.mask = -1; }
inline int setup_grid() {
    static int grid = 0;
    if (!grid) { int dev = 0, cus = 0; hipGetDevice(&dev); hipDeviceGetAttribute(&cus, hipDeviceAttributeMultiprocessorCount, dev);
        hipFuncSetAttribute((const void*)mk_fwd, hipFuncAttributeMaxDynamicSharedMemorySize, LDS_BYTES);
        int per_cu = 0; hipOccupancyMaxActiveBlocksPerMultiprocessor(&per_cu, (const void*)mk_fwd, NWAVES * 64, LDS_BYTES); (void)hipGetLastError();
        grid = cus > 0 ? cus : 256; }
    return grid;
}
inline void launch_range(void* const* d_in, float* out, void* d_ws, hipStream_t st, int lo, int hi, int li, int mask = -1) {
    Args a{}; fill_args(a, d_in, out, d_ws); a.ph_lo = lo; a.ph_hi = hi; a.li = li; a.mask = mask;
    hipLaunchKernelGGL(mk_fwd, dim3(setup_grid()), dim3(NWAVES * 64), LDS_BYTES, st, a);
}
}

extern "C" void kernel_launch(void* const* d_in, const int* in_sizes, int n_in, void* d_out, int out_size, void* d_ws, size_t ws_size, hipStream_t stream) {
    hipMemsetAsync(d_ws, 0, mk::CTL_BYTES, stream);
    mk::launch_range(d_in, (float*)d_out, d_ws, stream, 0, mk::NPHASE, 0);
}
```

```cpp
#include <hip/hip_runtime.h>
#include <math.h>
#define LAS __attribute__((address_space(3)))
#define GAS __attribute__((address_space(1)))
namespace pg8 {
#define PG8_LAS __attribute__((address_space(3)))
typedef unsigned short bf16_t;
typedef short bf16x8 __attribute__((ext_vector_type(8)));
typedef float f32x4 __attribute__((ext_vector_type(4)));
typedef unsigned u32x4 __attribute__((ext_vector_type(4)));
constexpr int BM = 256, BK = 64, HALF = 128, HTB = HALF * BK * 2  , STAGE_BYTES = 8 * HTB, NXCD = 8, WGM = 8;
__host__ __device__ __forceinline__ int lds_byte(int r, int c) { const int st = (r >> 4) * 2 + (c >> 5), rr = r & 15, cc = c & 31, ob = rr * 64 + cc * 2; return st * 1024 + (ob ^ (((ob >> 9) & 1) << 5)); }
__host__ __device__ __forceinline__ void stage_rc(int b, int& R, int& C) { const int st = b / 1024, sb = b % 1024, swz = sb ^ (((sb >> 9) & 1) << 5); R = (st >> 1) * 16 + swz / 64; C = (st & 1) * 32 + (swz % 64) / 2; }
__host__ __device__ __forceinline__ int perm32(int rho) { const int n = rho >> 4, i = rho & 15; return 8 * (i >> 2) + 4 * n + (i & 3); }
struct Unit { int pm, pn; };
struct Gemm { const bf16_t* A; const bf16_t* Bt; int lda, ldb, K; };
struct StaticOrder {
    int nM, nN, nwg, G, c;
    __host__ __device__ void init(int M, int N, int G_, int c_) { nM = M / BM; nN = N / BM; nwg = nM * nN; G = G_; c = c_; }
    __host__ __device__ bool next(int i, Unit& u) const {
        const long L = (long)i * G + c; if (L >= nwg) return false;
        int wgid = (int)L; { const int q = nwg / NXCD, r = nwg % NXCD, xcd = wgid % NXCD, off = wgid / NXCD; wgid = (xcd < r ? xcd * (q + 1) : r * (q + 1) + (xcd - r) * q) + off; }
        const int nig = WGM * nN, gid = wgid / nig, fm = gid * WGM, gsz = (nM - fm) < WGM ? (nM - fm) : WGM;
        u.pm = fm + ((wgid % nig) % gsz); u.pn = (wgid % nig) / gsz; return true;
    }
    __device__ __forceinline__ void a_ready(const Unit&) const {}
    __device__ __forceinline__ void done(const Unit&) const {}
};
__device__ __forceinline__ unsigned cvt_pk_bf16(float lo, float hi) { unsigned r; asm volatile("v_cvt_pk_bf16_f32 %0, %1, %2" : "=v"(r) : "v"(lo), "v"(hi)); return r; }
template <class Epi, class Sched, bool ALIGN_EPI = false, bool SP2 = false>
__device__ __forceinline__ void gemm_phase(PG8_LAS unsigned char* lds, const Gemm g, const Sched& S, const Epi& E, const int tid) {
    const int wid = __builtin_amdgcn_readfirstlane(tid >> 6), lane = tid & 63, wr = wid >> 2, wc = wid & 3, fr = lane & 15, fq = lane >> 4;
    const int K = g.K, nt = K / BK, lda = g.lda, ldb = g.ldb;
    unsigned voffA[2], voffB[2];
#pragma unroll
    for (int i = 0; i < 2; ++i) { int R, C; stage_rc(tid * 16 + i * 8192, R, C); const int Rb = Epi::PERM ? ((R & ~31) + perm32(R & 31)) : R;
        voffA[i] = (unsigned)(R * lda + C) * 2u; voffB[i] = (unsigned)(Rb * ldb + C) * 2u; }
    const size_t kstep = (size_t)(BK * 2);
    const size_t hstepA = (size_t)HALF * lda * 2, hstepB = (size_t)HALF * ldb * 2;
    const size_t tstepA = 2 * hstepA, tstepB = 2 * hstepB;
    const unsigned ldsw = (unsigned)wid * 1024u;
    const int aoff = lds_byte(wr * 64 + fr, fq * 8), boff = lds_byte(wc * 32 + fr, fq * 8);
#define PG8_SA(b, h) (((b) * 2 + (h)) * HTB)
#define PG8_SB(b, h) ((4 + (b) * 2 + (h)) * HTB)
#define PG8_STAGE(bufoff, gbase, voff) do { _Pragma("unroll") for (int _i = 0; _i < 2; ++_i) \
        __builtin_amdgcn_global_load_lds((const unsigned*)((const char*)(gbase) + (voff)[_i]), (PG8_LAS unsigned*)(lds + (bufoff) + ldsw + _i * 8192), 16, 0, 0); } while (0)
#define PG8_LDA(dst, b, h) do { _Pragma("unroll") for (int m = 0; m < 4; ++m) _Pragma("unroll") for (int k = 0; k < 2; ++k) dst[m][k] = *(const PG8_LAS bf16x8*)(lds + PG8_SA(b, h) + aoff + m * 2048 + k * 1024); } while (0)
#define PG8_LDB(dst, b, h) do { _Pragma("unroll") for (int n = 0; n < 2; ++n) _Pragma("unroll") for (int k = 0; k < 2; ++k) dst[n][k] = *(const PG8_LAS bf16x8*)(lds + PG8_SB(b, h) + boff + n * 2048 + k * 1024); } while (0)
#define PG8_MMA(ai, bj, At, Bt) do { __builtin_amdgcn_s_setprio(1); _Pragma("unroll") for (int m = 0; m < 4; ++m) _Pragma("unroll") for (int n = 0; n < 2; ++n) _Pragma("unroll") for (int k = 0; k < 2; ++k) \
        acc[ai][bj][m][n] = __builtin_amdgcn_mfma_f32_16x16x32_bf16(Bt[n][k], At[m][k], acc[ai][bj][m][n], 0, 0, 0); __builtin_amdgcn_s_setprio(0); } while (0)
#define PG8_WAIT_V(n) asm volatile("s_waitcnt vmcnt(" #n ")" ::: "memory")
#define PG8_WAIT_L(n) asm volatile("s_waitcnt lgkmcnt(" #n ")" ::: "memory")
#define PG8_BAR __builtin_amdgcn_s_barrier()
#define PG8_SCHED __builtin_amdgcn_sched_barrier(0)
    Unit cur, nxt; int ui = 0;
    if (!S.next(0, cur)) return;
    f32x4 acc[2][2][4][2];
    E.init(acc, cur, wr, wc, fr, fq);
    bf16x8 At[4][2], B0[2][2], B1[2][2];
    const char* cA = (const char*)g.A + (size_t)cur.pm * tstepA; const char* cB = (const char*)g.Bt + (size_t)cur.pn * tstepB;
    S.a_ready(cur);
    if constexpr (SP2) {
        PG8_STAGE(PG8_SB(0, 0), cB, voffB); PG8_STAGE(PG8_SB(0, 1), cB + hstepB, voffB); PG8_STAGE(PG8_SA(0, 0), cA, voffA); PG8_STAGE(PG8_SA(0, 1), cA + hstepA, voffA);
        if (wr == 1) PG8_BAR;
        PG8_WAIT_V(2); PG8_BAR;
        PG8_STAGE(PG8_SB(1, 0), cB + kstep, voffB); PG8_STAGE(PG8_SA(1, 0), cA + kstep, voffA); PG8_STAGE(PG8_SB(1, 1), cB + hstepB + kstep, voffB);
        PG8_WAIT_V(6); PG8_BAR;
    } else {
        PG8_STAGE(PG8_SB(0, 0), cB, voffB); PG8_STAGE(PG8_SA(0, 0), cA, voffA); PG8_STAGE(PG8_SB(0, 1), cB + hstepB, voffB); PG8_STAGE(PG8_SA(0, 1), cA + hstepA, voffA);
        if (wr == 1) PG8_BAR;
        PG8_WAIT_V(4); PG8_BAR;
        PG8_STAGE(PG8_SB(1, 0), cB + kstep, voffB); PG8_STAGE(PG8_SA(1, 0), cA + kstep, voffA); PG8_STAGE(PG8_SB(1, 1), cB + hstepB + kstep, voffB);
        PG8_WAIT_V(6); PG8_BAR;
    }
    for (;;) {
        const bool has_next = S.next(ui + 1, nxt);
        const char* nA = has_next ? (const char*)g.A + (size_t)nxt.pm * tstepA : cA; const char* nB = has_next ? (const char*)g.Bt + (size_t)nxt.pn * tstepB : cB;
        for (int t = 0; t < nt; t += 2) {
            const bool last = (t == nt - 2);
            const char* a1 = cA + (size_t)(t + 1) * kstep;
            const char* a2 = last ? nA : cA + (size_t)(t + 2) * kstep; const char* b2 = last ? nB : cB + (size_t)(t + 2) * kstep;
            const char* a3 = a2 + kstep; const char* b3 = b2 + kstep;
            if (last && has_next) S.a_ready(nxt);
            if constexpr (SP2) {
            PG8_LDB(B0, 0, 0); PG8_LDB(B1, 0, 1); PG8_SCHED; PG8_LDA(At, 0, 0); PG8_STAGE(PG8_SA(1, 1), a1 + hstepA, voffA);
            PG8_WAIT_V(8); PG8_WAIT_L(0); PG8_BAR; PG8_MMA(0, 0, At, B0); PG8_MMA(0, 1, At, B1); PG8_BAR; PG8_SCHED;
            PG8_LDA(At, 0, 1); PG8_STAGE(PG8_SB(0, 0), b2, voffB); PG8_STAGE(PG8_SB(0, 1), b2 + hstepB, voffB); PG8_STAGE(PG8_SA(0, 0), a2, voffA);
            PG8_WAIT_V(8); PG8_WAIT_L(0); PG8_BAR; PG8_MMA(1, 0, At, B0); PG8_MMA(1, 1, At, B1); PG8_BAR; PG8_SCHED;
            PG8_LDB(B0, 1, 0); PG8_LDB(B1, 1, 1); PG8_SCHED; PG8_LDA(At, 1, 0); PG8_STAGE(PG8_SA(0, 1), a2 + hstepA, voffA);
            PG8_WAIT_V(8); PG8_WAIT_L(0); PG8_BAR; PG8_MMA(0, 0, At, B0); PG8_MMA(0, 1, At, B1); PG8_BAR; PG8_SCHED;
            PG8_LDA(At, 1, 1); PG8_STAGE(PG8_SB(1, 0), b3, voffB); PG8_STAGE(PG8_SB(1, 1), b3 + hstepB, voffB); PG8_STAGE(PG8_SA(1, 0), a3, voffA);
            PG8_WAIT_V(8); PG8_WAIT_L(0); PG8_BAR; PG8_MMA(1, 0, At, B0); PG8_MMA(1, 1, At, B1); PG8_BAR; PG8_SCHED;
            } else {
            PG8_LDB(B0, 0, 0); PG8_SCHED; PG8_LDA(At, 0, 0); PG8_STAGE(PG8_SA(1, 1), a1 + hstepA, voffA);
            PG8_WAIT_L(8); PG8_BAR; PG8_WAIT_L(0); PG8_MMA(0, 0, At, B0); PG8_BAR; PG8_SCHED;
            PG8_LDB(B1, 0, 1); PG8_STAGE(PG8_SB(0, 0), b2, voffB);
            PG8_BAR; PG8_WAIT_L(0); PG8_MMA(0, 1, At, B1); PG8_BAR;
            PG8_LDA(At, 0, 1); PG8_STAGE(PG8_SA(0, 0), a2, voffA);
            PG8_BAR; PG8_WAIT_L(0); PG8_MMA(1, 0, At, B0); PG8_BAR; PG8_SCHED;
            PG8_STAGE(PG8_SB(0, 1), b2 + hstepB, voffB);
            PG8_WAIT_V(6); PG8_BAR; PG8_MMA(1, 1, At, B1); PG8_BAR;
            PG8_LDB(B0, 1, 0); PG8_SCHED; PG8_LDA(At, 1, 0); PG8_STAGE(PG8_SA(0, 1), a2 + hstepA, voffA);
            PG8_WAIT_L(8); PG8_BAR; PG8_WAIT_L(0); PG8_MMA(0, 0, At, B0); PG8_BAR; PG8_SCHED;
            PG8_LDB(B1, 1, 1); PG8_STAGE(PG8_SB(1, 0), b3, voffB);
            PG8_BAR; PG8_WAIT_L(0); PG8_MMA(0, 1, At, B1); PG8_BAR;
            PG8_LDA(At, 1, 1); PG8_STAGE(PG8_SA(1, 0), a3, voffA);
            PG8_BAR; PG8_WAIT_L(0); PG8_MMA(1, 0, At, B0); PG8_BAR; PG8_SCHED;
            PG8_STAGE(PG8_SB(1, 1), b3 + hstepB, voffB);
            PG8_WAIT_V(6); PG8_BAR; PG8_MMA(1, 1, At, B1); PG8_BAR;
            }
        }
        if constexpr (ALIGN_EPI) { if (wr == 0) PG8_BAR; }
        if constexpr (!Epi::AFTER_DRAIN) { E(acc, cur, wr, wc, fr, fq); S.done(cur); }
        if (!has_next) break;
        E.init(acc, nxt, wr, wc, fr, fq);
        cur = nxt; cA = nA; cB = nB; ++ui;
        if constexpr (ALIGN_EPI) { if (wr == 1) PG8_BAR; }
    }
    PG8_WAIT_V(0);
    if constexpr (!ALIGN_EPI) { if (wr == 0) PG8_BAR; }
    PG8_BAR;
    if constexpr (Epi::AFTER_DRAIN) { E.fused(acc, cur, wr, wc, fr, fq, lds, wid, lane); S.done(cur); }
#undef PG8_SA
#undef PG8_SB
#undef PG8_STAGE
#undef PG8_LDA
#undef PG8_LDB
#undef PG8_MMA
#undef PG8_WAIT_V
#undef PG8_WAIT_L
#undef PG8_BAR
#undef PG8_SCHED
}

}

namespace mk {
using pg8::f32x4; using pg8::bf16x8; using pg8::u32x4; using pg8::cvt_pk_bf16;
typedef unsigned short bf16;
typedef unsigned u32x2 __attribute__((ext_vector_type(2)));
typedef short s16x4 __attribute__((ext_vector_type(4)));
typedef float f32x2 __attribute__((ext_vector_type(2)));
typedef GAS unsigned gu32;
#define RLX_AGENT __ATOMIC_RELAXED, __HIP_MEMORY_SCOPE_AGENT
#define XB_TMO      128
#define XB_XCNT(j)  (256  + 64 * (j))
#define XB_XSUB(j)  (1280 + 64 * (j))
#define XB_XGEN(j)  (2304 + 64 * (j))
#define XB_TOP      3328
#define XB_TOPGEN   3392
#define XCD_BAR_WORDS 3456
#define XB_SPIN_CAP (1u << 18)

__device__ __forceinline__ unsigned xb_ld(unsigned* p)              { return __hip_atomic_load(p, __ATOMIC_RELAXED, __HIP_MEMORY_SCOPE_AGENT); }
__device__ __forceinline__ unsigned xb_add(unsigned* p, unsigned v) { return __hip_atomic_fetch_add(p, v, __ATOMIC_RELAXED, __HIP_MEMORY_SCOPE_AGENT); }
__device__ __forceinline__ unsigned xb_xcc_id() { return (unsigned)__builtin_amdgcn_s_getreg((3 << 11) | 20) & 0xFu; }
#define XB_SPIN(cond, bar) do { unsigned _sp = 0; while (cond) { __builtin_amdgcn_s_sleep(1); \
    if ((++_sp & 255u) == 0u) { if (xb_ld(&(bar)[XB_TMO])) break; if (_sp > XB_SPIN_CAP) { atomicAdd(&(bar)[XB_TMO], 1u); break; } } } } while (0)

struct XcdBarrier {
    unsigned* bar; unsigned x;
    volatile LAS unsigned* st;
};

__device__ __forceinline__ XcdBarrier xcd_barrier_post(unsigned* bar, volatile LAS unsigned* st) {
    XcdBarrier b; b.bar = bar; b.x = xb_xcc_id(); b.st = st;
    if (threadIdx.x == 0) (void)xb_add(&bar[XB_XCNT(b.x)], 1u);
    return b;
}
__device__ __forceinline__ void xcd_barrier_complete(unsigned* bar, unsigned x, unsigned& nloc, unsigned& nx) {
    const unsigned G = gridDim.x * gridDim.y * gridDim.z;
    unsigned sum, cnt, mine, sp = 0u;
    for (;;) {
        sum = 0u; cnt = 0u; mine = 0u;
#pragma unroll
        for (unsigned j = 0; j < 16; ++j) { const unsigned c = xb_ld(&bar[XB_XCNT(j)]); sum += c; cnt += (c > 0u) ? 1u : 0u; mine = (j == x) ? c : mine; }
        if (sum == G) break;
        __builtin_amdgcn_s_sleep(1);
        if ((++sp & 255u) == 0u) { if (xb_ld(&bar[XB_TMO])) break; if (sp > XB_SPIN_CAP) { atomicAdd(&bar[XB_TMO], 1u); break; } }
    }
    nloc = mine > 0u ? mine : 1u; nx = cnt > 0u ? cnt : 1u;
}

__device__ __forceinline__ void xcd_barrier(const XcdBarrier& b) {
    asm volatile("s_waitcnt vmcnt(0)" ::: "memory");
    __syncthreads();
    if (threadIdx.x == 0) {
        unsigned* bar = b.bar;
        __builtin_amdgcn_s_waitcnt(0);
        unsigned nloc = b.st[0], nx = b.st[1];
        if (nloc == 0u) { xcd_barrier_complete(bar, b.x, nloc, nx); b.st[0] = nloc; b.st[1] = nx; }
        const unsigned old = xb_add(&bar[XB_XSUB(b.x)], 1u);
        const unsigned gen = old / nloc;
        if (old + 1u == (gen + 1u) * nloc) {
            __builtin_amdgcn_fence(__ATOMIC_RELEASE, "agent");
            asm volatile("s_waitcnt vmcnt(0)" ::: "memory");
            const unsigned og = xb_add(&bar[XB_TOP], 1u);
            const unsigned tg = og / nx;
            if (og + 1u == (tg + 1u) * nx) xb_add(&bar[XB_TOPGEN], 1u);
            else XB_SPIN(xb_ld(&bar[XB_TOPGEN]) == tg, bar);
            __builtin_amdgcn_fence(__ATOMIC_ACQUIRE, "agent");
            xb_add(&bar[XB_XGEN(b.x)], 1u);
            asm volatile("s_waitcnt vmcnt(0)" ::: "memory");
        } else {
            XB_SPIN(xb_ld(&bar[XB_XGEN(b.x)]) == gen, bar);
            __builtin_amdgcn_fence(__ATOMIC_ACQUIRE, "agent");
            asm volatile("s_waitcnt vmcnt(0)" ::: "memory");
        }
    }
    __syncthreads();
}


constexpr int MP = 16384, MS = 128, MT = MP + MS, MR = 16640;
constexpr int D = 1024, DFF = 2816, NWAVES = 8;
constexpr float RMS_EPS = 1e-6f, LN_EPS = 1e-5f;
constexpr float MLA_SCALE = 0.07216878364870322f;
constexpr size_t MiB = 1u << 20;
constexpr size_t WS_CTL = 0, CTL_BYTES = 3 * MiB;
constexpr int CW_BAR = 4096;
constexpr size_t ST_OFF = 65536, ST_STRIDE = (size_t)MR * 8;
constexpr int ST_SSQ0 = 0  , ST_LNS0 = 9, ST_LNQ0 = 10  , ST_KV = 13, ST_Q = 14, NSTAT = 15;
static_assert(ST_OFF + NSTAT * ST_STRIDE <= CTL_BYTES, "stats inside CTL");
constexpr size_t WS_WGU = 3 * MiB, WGU_BYTES = 11 * MiB, WS_WD = 47 * MiB, WD_BYTES = 5767168, WS_WIN = 69 * MiB, WS_WOUT = 77 * MiB, WS_WS = 81 * MiB,
                 WS_WDQKV = 82 * MiB, WS_WQ = 84 * MiB, WS_WOV = 86 * MiB, WS_WGX = 90 * MiB, WS_WAT = 95 * MiB, WS_WIT = 95 * MiB + 512 * 1024, WS_WCO = 96 * MiB, WS_ROPE = 99 * MiB;
constexpr size_t WS_H = 100 * MiB, WS_HB = 165 * MiB, WS_U = 198 * MiB, WS_GV = 231 * MiB, WS_UM = 264 * MiB, WS_ACT = 297 * MiB, WS_RAW = 387 * MiB, WS_CQB = 436 * MiB,
                 WS_QF = 449 * MiB, WS_KVB = 531 * MiB, WS_OB = 542 * MiB, WS_PART = 607 * MiB, WS_PML = 623 * MiB, WS_GATE = 624 * MiB, WS_XW = 665 * MiB, WS_AA = 747 * MiB, WS_BB = 829 * MiB,
                 WS_AGG = 911 * MiB, WS_GH = 914 * MiB, WS_PROF = 955 * MiB, WS_MK_END = 956 * MiB;
constexpr int RING_BYTES = 131072, LDS_BYTES = 147456, MISC_OFF = LDS_BYTES - 256;
constexpr size_t O_YP = 0, O_YS = 16777216, O_CV = 16908288, O_MP = 17170432, O_MS = 22413312, O_HP = 22454272, O_HS = 22464512, O_CP = 22505472, O_CS = 22536192, O_END = 22659072;

__device__ __forceinline__ float fast_sigmoid_l2(float t) { return __builtin_amdgcn_rcpf(1.0f + __builtin_amdgcn_exp2f(-t)); }
__device__ __forceinline__ float gelu_tanh_f(float x) { return x * fast_sigmoid_l2(2.302208198f * (x + 0.044715f * x * x * x)); }
__device__ __forceinline__ float silu_f(float x) { return x * fast_sigmoid_l2(1.4426950409f * x); }
__device__ __forceinline__ unsigned f2bf(float f) { unsigned u = __builtin_bit_cast(unsigned, f); return (u + 0x7fffu + ((u >> 16) & 1u)) >> 16; }
__device__ __forceinline__ unsigned pk2(float lo, float hi) { return f2bf(lo) | (f2bf(hi) << 16); }
__device__ __forceinline__ float bf2f(unsigned short b) { return __builtin_bit_cast(float, (unsigned)b << 16); }
__device__ __forceinline__ float bflo(unsigned w) { return __builtin_bit_cast(float, w << 16); }
__device__ __forceinline__ float bfhi(unsigned w) { return __builtin_bit_cast(float, w & 0xffff0000u); }
constexpr float ST_SCALE = 16777216.0f, ST_INV = 1.0f / 16777216.0f;
__device__ __forceinline__ void stat_add(long long* p, float v) { atomicAdd((unsigned long long*)p, (unsigned long long)(long long)__float2ll_rn(v * ST_SCALE)); }
__device__ __forceinline__ void stat_set(long long* p, float v) { *p = (long long)__float2ll_rn(v * ST_SCALE); }
__device__ __forceinline__ float stat_get(const long long* p) { return (float)(*p) * ST_INV; }
#define LDS_WAIT() asm volatile("s_waitcnt lgkmcnt(0)" ::: "memory")
#define VM_WAIT() asm volatile("s_waitcnt vmcnt(0)" ::: "memory")

struct InTab { const float* const __attribute__((address_space(4)))* t; __device__ __forceinline__ const float* operator[](int i) const { return t[i]; } };
struct P {
    InTab in; float* out; unsigned char* ws;
    LAS unsigned char* lds; int tid, lane, wave, G, bid;
    __device__ __forceinline__ long long* stat(int a) const { return (long long*)(ws + ST_OFF + (size_t)a * ST_STRIDE); }
    template <class T> __device__ __forceinline__ T* w(size_t off) const { return (T*)(ws + off); }
};
}
namespace mk {
struct TrJob { const float* src; int ldsrc, K, N; bf16* dst; int lddst; const float* gain; int kind, off; };
__device__ __forceinline__ int tr_rowmap(int kind, int off, int n) { return kind == 1 ? ((n >> 7) * 256 + (n & 127) + off) : (off + n); }
__device__ __forceinline__ void tr_item(const TrJob& j, LAS float* scr, int item, int lane) {
    const int nblk = j.N / 32, kb = item / nblk, nb = item % nblk, k0 = 64 * kb, n0 = 32 * nb;
    const float* src = j.src + (size_t)(k0 + (lane >> 5)) * j.ldsrc + n0 + (lane & 31); const size_t rstep = (size_t)2 * j.ldsrc;
    float v[32];
#pragma unroll
    for (int i = 0; i < 32; ++i) v[i] = src[i * rstep];
    if (j.gain) { const float* gp = j.gain + k0 + (lane >> 5); float g[32];
#pragma unroll
        for (int i = 0; i < 32; ++i) g[i] = gp[2 * i];
#pragma unroll
        for (int i = 0; i < 32; ++i) v[i] *= g[i]; }
#pragma unroll
    for (int i = 0; i < 32; ++i) scr[(2 * i + (lane >> 5)) * 33 + (lane & 31)] = v[i];
    LDS_WAIT(); asm volatile("" ::: "memory");
    const int c = lane & 7;
#pragma unroll
    for (int jj = 0; jj < 4; ++jj) { const int n = (lane >> 3) + 8 * jj; const LAS float* s = scr + (8 * c) * 33 + n;
        u32x4 o; o.x = pk2(s[0], s[33]); o.y = pk2(s[66], s[99]); o.z = pk2(s[132], s[165]); o.w = pk2(s[198], s[231]);
        *(u32x4*)(j.dst + (size_t)tr_rowmap(j.kind, j.off, n0 + n) * j.lddst + k0 + 8 * c) = o; }
    LDS_WAIT(); asm volatile("" ::: "memory");
}
constexpr int NJOBS = 24;
__device__ __forceinline__ TrJob get_job(const P& p, int jid) {
    TrJob j; j.gain = nullptr; j.kind = 0; j.off = 0; j.src = nullptr; j.dst = nullptr; j.ldsrc = 0; j.K = 0; j.N = 0; j.lddst = 0;
    if (jid < 12) { const int l = jid / 3, t = jid % 3;
        if (t < 2) { j.src = p.in[33 + t] + (size_t)l * D * DFF; j.ldsrc = DFF; j.K = D; j.N = DFF; j.dst = p.w<bf16>(WS_WGU + l * WGU_BYTES); j.lddst = D; j.gain = p.in[7] + l * D; j.kind = 1; j.off = 128 * t; }
        else { j.src = p.in[35] + (size_t)l * DFF * D; j.ldsrc = D; j.K = DFF; j.N = D; j.dst = p.w<bf16>(WS_WD + l * WD_BYTES); j.lddst = DFF; }
    } else if (jid < 16) { const int a = (jid - 12) >> 1;
        if (((jid - 12) & 1) == 0) { j.src = p.in[9] + (size_t)a * D * 2048; j.ldsrc = 2048; j.K = D; j.N = 2048; j.dst = p.w<bf16>(WS_WIN + a * 4 * MiB); j.lddst = D; j.gain = p.in[6] + (3 * a) * D; }
        else { j.src = p.in[14] + (size_t)a * D * D; j.ldsrc = D; j.K = D; j.N = D; j.dst = p.w<bf16>(WS_WOUT + a * 2 * MiB); j.lddst = D; }
    } else if (jid == 16) { j.src = p.in[15]; j.ldsrc = 384; j.K = D; j.N = 384; j.dst = p.w<bf16>(WS_WDQKV); j.lddst = D; j.gain = p.in[6] + D; j.off = 256; }
    else if (jid == 17) { j.src = p.in[18]; j.ldsrc = 320; j.K = D; j.N = 256; j.dst = p.w<bf16>(WS_WDQKV); j.lddst = D; j.gain = p.in[6] + D; j.off = 0; }
    else if (jid == 18) { j.src = p.in[18] + 256; j.ldsrc = 320; j.K = D; j.N = 64; j.dst = p.w<bf16>(WS_WDQKV); j.lddst = D; j.gain = p.in[6] + D; j.off = 640; }
    else if (jid == 19) { j.src = p.in[24]; j.ldsrc = 1280; j.K = D; j.N = 1280; j.dst = p.w<bf16>(WS_WGX); j.lddst = D; j.gain = p.in[6] + 2 * D; j.off = 0; }
    else if (jid == 20) { j.src = p.in[23]; j.ldsrc = 1280; j.K = D; j.N = 1280; j.dst = p.w<bf16>(WS_WGX); j.lddst = D; j.gain = p.in[6] + 2 * D; j.off = 1280; }
    else if (jid == 21) { j.src = p.in[32]; j.ldsrc = D; j.K = 1280; j.N = D; j.dst = p.w<bf16>(WS_WCO); j.lddst = 1280; }
    else if (jid == 22) { j.src = p.in[27]; j.ldsrc = 128; j.K = 128; j.N = 128; j.dst = p.w<bf16>(WS_WAT); j.lddst = 128; j.kind = 2; }
    else { j.src = p.in[29]; j.ldsrc = 128; j.K = 128; j.N = 128; j.dst = p.w<bf16>(WS_WIT); j.lddst = 128; j.kind = 2; }
    return j;
}
__device__ __forceinline__ int job_items(const TrJob& j) { return j.kind == 2 ? 80 : (j.K / 64) * (j.N / 32); }

__device__ __forceinline__ void p0_prologue(const P& p, const int mask) {
    LAS float* scr = (LAS float*)(p.lds + p.wave * 16384);
    const int gw = p.bid * NWAVES + p.wave, NGW = p.G * NWAVES, lane = p.lane;
    const int gt = p.bid * (NWAVES * 64) + p.tid, NGT = p.G * NWAVES * 64;
    if (mask & 1) {
    {
        int base = 0;
        for (int jid = 0; jid < NJOBS; ++jid) {
            TrJob j = get_job(p, jid); const int nit = job_items(j);
            int first = (gw - base % NGW + NGW) % NGW;
            for (int it = first; it < nit; it += NGW) {
                if (j.kind == 2) { TrJob b = j; const int blk = it >> 3; b.src = j.src + (size_t)blk * 16384; b.dst = j.dst + (size_t)blk * 16384; b.kind = 0; tr_item(b, scr, it & 7, lane); }
                else tr_item(j, scr, it, lane);
            }
            base += nit;
        }
    }
    }
    if (mask & 2) {
    { u32x4* z = (u32x4*)(p.w<bf16>(WS_WDQKV) + (size_t)704 * D); for (int i = gt; i < 64 * D / 8; i += NGT) z[i] = (u32x4){0u, 0u, 0u, 0u}; }
    }
    if (mask & 4) {
    for (int i = gt; i < 2 * 8 * 128 * 16; i += NGT) {
        const int s0 = (i & 15) * 8, t = (i >> 4) & 127, jg = i >> 11; const float* src = p.in[12] + (size_t)jg * 16384 + t * 128 + s0;
        const f32x4 v0 = *(const f32x4*)src, v1 = *(const f32x4*)(src + 4); unsigned w[4];
#pragma unroll
        for (int e = 0; e < 2; ++e) { w[e] = pk2((s0 + 2 * e <= t) ? v0[2 * e] : 0.f, (s0 + 2 * e + 1 <= t) ? v0[2 * e + 1] : 0.f); w[2 + e] = pk2((s0 + 4 + 2 * e <= t) ? v1[2 * e] : 0.f, (s0 + 5 + 2 * e <= t) ? v1[2 * e + 1] : 0.f); }
        const int j = jg >> 3, g = jg & 7;
        *(u32x4*)(p.w<bf16>(WS_WS + (size_t)j * 262144) + ((size_t)g * 128 + t) * 128 + s0) = (u32x4){w[0], w[1], w[2], w[3]};
    }
    }
    if (mask & 8) {
    for (int i = gt; i < 2052 * 32; i += NGT) { const int tp = i >> 5, fi = i & 31, pos = tp < 2048 ? tp : 16384 + (tp - 2048);
        const float inv = 1.0f / powf(10000.0f, (float)(2 * fi) / 64.0f); const float ang = (float)pos * inv;
        p.w<f32x2>(WS_ROPE)[i] = (f32x2){cosf(ang), sinf(ang)}; }
    }
    if (mask & 16) {
    { bf16* HB = p.w<bf16>(WS_HB); long long* ssq = p.stat(ST_SSQ0);
      auto rowp = [&](int m) -> const float* { return m < MP ? p.in[0] + (size_t)m * D : p.in[1] + (size_t)((m < MT ? m : MT - 1) - MP) * D; };
      f32x4 v[4], vn[4];
      if (gw < MR) { const float* r = rowp(gw);
#pragma unroll
        for (int jj = 0; jj < 4; ++jj) v[jj] = *(const f32x4*)(r + 4 * lane + 256 * jj); }
      for (int m = gw; m < MR; m += NGW) {
        { const float* r = rowp(m + NGW < MR ? m + NGW : m);
#pragma unroll
          for (int jj = 0; jj < 4; ++jj) vn[jj] = *(const f32x4*)(r + 4 * lane + 256 * jj); }
        float s = 0.f;
#pragma unroll
        for (int jj = 0; jj < 4; ++jj) { if (m >= MT) v[jj] = (f32x4){0.f, 0.f, 0.f, 0.f};
            s += (v[jj].x * v[jj].x + v[jj].y * v[jj].y) + (v[jj].z * v[jj].z + v[jj].w * v[jj].w); }
#pragma unroll
        for (int o = 1; o < 64; o <<= 1) s += __shfl_xor(s, o);
#pragma unroll
        for (int jj = 0; jj < 4; ++jj) { const int c = 4 * lane + 256 * jj;
            *(u32x2*)(HB + (size_t)m * D + c) = (u32x2){pk2(v[jj].x, v[jj].y), pk2(v[jj].z, v[jj].w)}; }
        if (lane == 0) stat_set(ssq + m, s);
#pragma unroll
        for (int jj = 0; jj < 4; ++jj) v[jj] = vn[jj];
      } }
    }
    if (mask & 32) {
    { const float* wuq = p.in[17]; const float* wuk = p.in[20]; const float* qn = p.in[16]; bf16* Wq = p.w<bf16>(WS_WQ);
      LAS float* Qs = (LAS float*)p.lds; LAS float* Ks = (LAS float*)(p.lds + 64 * 132 * 4);
      for (int it = p.bid; it < 192; it += p.G) {
        const int h = it / 24, kb = (it >> 2) % 6, cq = it & 3, k0 = 64 * kb;
        __syncthreads();
#pragma unroll
        for (int q = 0; q < 4; ++q) { const int idx = p.tid + 512 * q, row = idx >> 5, c4 = idx & 31;
            *(LAS f32x4*)(Qs + row * 132 + c4 * 4) = *(const f32x4*)(wuq + (size_t)(k0 + row) * 1536 + h * 192 + c4 * 4);
            *(LAS f32x4*)(Ks + row * 132 + c4 * 4) = *(const f32x4*)(wuk + (size_t)(cq * 64 + row) * 1024 + h * 128 + c4 * 4); }
        __syncthreads();
        const int cl = p.wave * 8, c0 = cq * 64 + cl; float acc[8];
#pragma unroll
        for (int cc = 0; cc < 8; ++cc) acc[cc] = 0.f;
#pragma unroll 4
        for (int n4 = 0; n4 < 32; ++n4) { const f32x4 bv = *(const LAS f32x4*)(Qs + lane * 132 + n4 * 4);
#pragma unroll
            for (int cc = 0; cc < 8; ++cc) { const f32x4 av = *(const LAS f32x4*)(Ks + (cl + cc) * 132 + n4 * 4); acc[cc] += (av.x * bv.x + av.y * bv.y) + (av.z * bv.z + av.w * bv.w); } }
        const float g = qn[k0 + lane];
#pragma unroll
        for (int cc = 0; cc < 8; ++cc) Wq[(size_t)(320 * h + c0 + cc) * 384 + k0 + lane] = (bf16)f2bf(acc[cc] * g);
      }
      for (int r = gw; r < 512; r += NGW) { const int h = r >> 6, ie = r & 63, i = ie >> 1, e = ie & 1;
#pragma unroll
        for (int kk = 0; kk < 6; ++kk) { const int k = lane + 64 * kk; Wq[(size_t)(320 * h + 256 + ie) * 384 + k] = (bf16)f2bf(wuq[(size_t)k * 1536 + h * 192 + 128 + 32 * e + i] * qn[k]); } } }
    }
    if (mask & 64) {
    { const float* wuv = p.in[21]; const float* wo = p.in[22]; bf16* Wov = p.w<bf16>(WS_WOV);
      LAS float* Os = (LAS float*)p.lds;
      for (int it = p.bid; it < 256; it += p.G) { const int h = it >> 5, cg = (it >> 2) & 7, nb = it & 3, c0 = cg * 32 + p.wave * 4, n = nb * 256 + lane * 4;
        __syncthreads();
#pragma unroll
        for (int q = 0; q < 16; ++q) { const int idx = p.tid + 512 * q, v = idx >> 6, c4 = idx & 63; *(LAS f32x4*)(Os + v * 256 + c4 * 4) = *(const f32x4*)(wo + (size_t)(h * 128 + v) * D + nb * 256 + c4 * 4); }
        __syncthreads();
        f32x4 acc[4];
#pragma unroll
        for (int cc = 0; cc < 4; ++cc) acc[cc] = (f32x4){0.f, 0.f, 0.f, 0.f};
#pragma unroll 8
        for (int v = 0; v < 128; ++v) { const f32x4 b = *(const LAS f32x4*)(Os + v * 256 + lane * 4);
#pragma unroll
            for (int cc = 0; cc < 4; ++cc) { const float a = wuv[(size_t)(c0 + cc) * 1024 + h * 128 + v]; acc[cc] += b * a; } }
#pragma unroll
        for (int jn = 0; jn < 4; ++jn) *(u32x2*)(Wov + (size_t)(n + jn) * 2048 + h * 256 + c0) = (u32x2){pk2(acc[0][jn], acc[1][jn]), pk2(acc[2][jn], acc[3][jn])};
      }
      __syncthreads(); }
    }
}
}
namespace mk {
#ifdef MK_DRYPROBE
#define MK_DRY(E) ((E).dry)
#define MK_DRYFIELD int dry;
#else
#define MK_DRY(E) 0
#define MK_DRYFIELD
#endif
typedef const f32x4 (&AccRef)[2][2][4][2];
__device__ __forceinline__ float quad_red(float v) { v += __shfl_xor(v, 16); v += __shfl_xor(v, 32); return v; }
__device__ __forceinline__ u32x4 pack8(const f32x4 a, const f32x4 b) { u32x4 w; w.x = cvt_pk_bf16(a[0], a[1]); w.y = cvt_pk_bf16(a[2], a[3]); w.z = cvt_pk_bf16(b[0], b[1]); w.w = cvt_pk_bf16(b[2], b[3]); return w; }
__device__ __forceinline__ float sumsq8(const f32x4 a, const f32x4 b) { return ((a[0] * a[0] + a[1] * a[1]) + (a[2] * a[2] + a[3] * a[3])) + ((b[0] * b[0] + b[1] * b[1]) + (b[2] * b[2] + b[3] * b[3])); }
__device__ __forceinline__ float sum8(const f32x4 a, const f32x4 b) { return ((a[0] + a[1]) + (a[2] + a[3])) + ((b[0] + b[1]) + (b[2] + b[3])); }
#define MK_EPI_CALL() \
    __device__ __forceinline__ void operator()(AccRef acc, const pg8::Unit& u, int wr, int wc, int fr, int fq) const { \
        Pre pre_[2][4]; \
        _Pragma("unroll") for (int ai = 0; ai < 2; ++ai) _Pragma("unroll") for (int m = 0; m < 4; ++m) pre_[ai][m] = pre(u.pm * 256 + ai * 128 + wr * 64 + m * 16 + fr, u.pn, wc, fq); \
        _Pragma("unroll") for (int ai = 0; ai < 2; ++ai) _Pragma("unroll") for (int m = 0; m < 4; ++m) \
            rgp(u.pm * 256 + ai * 128 + wr * 64 + m * 16 + fr, u.pn, wc, fq, acc[ai][0][m][0], acc[ai][0][m][1], acc[ai][1][m][0], acc[ai][1][m][1], pre_[ai][m]); } \
    __device__ __forceinline__ void rg(int r, int pn, int wc, int fq, f32x4 a0, f32x4 b0, f32x4 a1, f32x4 b1) const { rgp(r, pn, wc, fq, a0, b0, a1, b1, pre(r, pn, wc, fq)); }
#define MK_EPI_CALL_DENSE() \
    __device__ __forceinline__ void operator()(AccRef acc, const pg8::Unit& u, int wr, int wc, int fr, int fq) const { \
        Pre pre_[2][4]; \
        _Pragma("unroll") for (int ai = 0; ai < 2; ++ai) _Pragma("unroll") for (int m = 0; m < 4; ++m) pre_[ai][m] = pre(u.pm * 256 + ai * 128 + wr * 64 + m * 16 + fr, u.pn, wc, fq); \
        _Pragma("unroll") for (int ai = 0; ai < 2; ++ai) { float s1 = 0.f, s2 = 0.f; \
            _Pragma("unroll") for (int m = 0; m < 4; ++m) { float t1, t2; \
                rgs(u.pm * 256 + ai * 128 + wr * 64 + m * 16 + fr, u.pn, wc, fq, acc[ai][0][m][0], acc[ai][0][m][1], acc[ai][1][m][0], acc[ai][1][m][1], pre_[ai][m], t1, t2); \
                s1 = (fq == m) ? t1 : s1; s2 = (fq == m) ? t2 : s2; } \
            stats(u.pm * 256 + ai * 128 + wr * 64 + fq * 16 + fr, u.pn, s1, s2); } } \
    __device__ __forceinline__ void rg(int r, int pn, int wc, int fq, f32x4 a0, f32x4 b0, f32x4 a1, f32x4 b1) const { float t1, t2; rgs(r, pn, wc, fq, a0, b0, a1, b1, pre(r, pn, wc, fq), t1, t2); if (fq == 0) stats(r, pn, t1, t2); }
#define MK_INIT_ZERO() __device__ __forceinline__ void init(f32x4 (&acc)[2][2][4][2], const pg8::Unit&, int, int, int, int) const { \
        _Pragma("unroll") for (int a = 0; a < 2; ++a) _Pragma("unroll") for (int b = 0; b < 2; ++b) _Pragma("unroll") for (int m = 0; m < 4; ++m) _Pragma("unroll") for (int n = 0; n < 2; ++n) acc[a][b][m][n] = (f32x4){0.f, 0.f, 0.f, 0.f}; }
#define MK_PRE_STAT(PTR) MK_INIT_ZERO() typedef long long Pre; __device__ __forceinline__ Pre pre(int r, int, int, int) const { return (PTR)[r]; }
__device__ __forceinline__ float stat_f(long long v) { return (float)v * ST_INV; }

struct EpiA1 {
    static constexpr bool PERM = true, AFTER_DRAIN = false;
    bf16* U; bf16* GV; const long long* ssq; long long* lns; long long* lnq; MK_DRYFIELD
    MK_PRE_STAT(ssq)
    __device__ __forceinline__ void rgs(int r, int pn, int wc, int fq, f32x4 a0, f32x4 b0, f32x4 a1, f32x4 b1, const Pre pv, float& s1, float& s2) const {
        const bool isv = pn >= 4; bf16* dst = (isv ? GV : U) + (size_t)r * 1024 + (pn & 3) * 256 + wc * 32 + 8 * fq; const float rs = rsqrtf(stat_f(pv) * (1.0f / 1024.0f) + RMS_EPS);
        a0 *= rs; b0 *= rs; a1 *= rs; b1 *= rs;
#pragma unroll
        for (int e = 0; e < 4; ++e) { a0[e] = gelu_tanh_f(a0[e]); b0[e] = gelu_tanh_f(b0[e]); a1[e] = gelu_tanh_f(a1[e]); b1[e] = gelu_tanh_f(b1[e]); }
        *(u32x4*)dst = pack8(a0, b0); *(u32x4*)(dst + 128) = pack8(a1, b1);
        s1 = 0.f; s2 = 0.f;
        if (isv) { s1 = quad_red(sum8(a0, b0) + sum8(a1, b1)); s2 = quad_red(sumsq8(a0, b0) + sumsq8(a1, b1)); }
    }
    __device__ __forceinline__ void stats(int r, int pn, float s1, float s2) const { if (pn >= 4 && !MK_DRY(*this)) { stat_add(lns + r, s1); stat_add(lnq + r, s2); } }
    MK_EPI_CALL_DENSE()
};
struct EpiRes {
    static constexpr bool PERM = true, AFTER_DRAIN = false;
    bf16* HB; long long* ssq_out; MK_DRYFIELD
    struct Pre { u32x4 h0, h1; };
    static __device__ __forceinline__ f32x4 lo4(const u32x4 h) { return (f32x4){bflo(h.x), bfhi(h.x), bflo(h.y), bfhi(h.y)}; }
    static __device__ __forceinline__ f32x4 hi4(const u32x4 h) { return (f32x4){bflo(h.z), bfhi(h.z), bflo(h.w), bfhi(h.w)}; }
    __device__ __forceinline__ Pre pre(int r, int pn, int wc, int fq) const { const bf16* hp = HB + (size_t)r * 1024 + pn * 256 + wc * 32 + 8 * fq; Pre v; v.h0 = *(const u32x4*)hp; v.h1 = *(const u32x4*)(hp + 128); return v; }
    __device__ __forceinline__ void init(f32x4 (&acc)[2][2][4][2], const pg8::Unit& u, int wr, int wc, int fr, int fq) const {
        Pre v[2][4];
#pragma unroll
        for (int ai = 0; ai < 2; ++ai)
#pragma unroll
            for (int m = 0; m < 4; ++m) v[ai][m] = pre(u.pm * 256 + ai * 128 + wr * 64 + m * 16 + fr, u.pn, wc, fq);
#pragma unroll
        for (int ai = 0; ai < 2; ++ai)
#pragma unroll
            for (int m = 0; m < 4; ++m) { acc[ai][0][m][0] = lo4(v[ai][m].h0); acc[ai][0][m][1] = hi4(v[ai][m].h0); acc[ai][1][m][0] = lo4(v[ai][m].h1); acc[ai][1][m][1] = hi4(v[ai][m].h1); }
    }
    __device__ __forceinline__ void fin(int r, int pn, int wc, int fq, const f32x4 a0, const f32x4 b0, const f32x4 a1, const f32x4 b1, float& s1) const {
        bf16* hp = HB + (size_t)r * 1024 + pn * 256 + wc * 32 + 8 * fq;
        s1 = quad_red(sumsq8(a0, b0) + sumsq8(a1, b1));
        if (MK_DRY(*this)) { if (s1 == 12345.678f) *(u32x4*)hp = pack8(a0, b0); return; }
        *(u32x4*)hp = pack8(a0, b0); *(u32x4*)(hp + 128) = pack8(a1, b1);
    }
    __device__ __forceinline__ void stats(int r, int pn, float s1, float s2) const { if (!MK_DRY(*this)) stat_add(ssq_out + r, s1); }
    __device__ __forceinline__ void operator()(AccRef acc, const pg8::Unit& u, int wr, int wc, int fr, int fq) const {
#pragma unroll
        for (int ai = 0; ai < 2; ++ai) { float s1 = 0.f;
#pragma unroll
            for (int m = 0; m < 4; ++m) { float t1; fin(u.pm * 256 + ai * 128 + wr * 64 + m * 16 + fr, u.pn, wc, fq, acc[ai][0][m][0], acc[ai][0][m][1], acc[ai][1][m][0], acc[ai][1][m][1], t1); s1 = (fq == m) ? t1 : s1; }
            stats(u.pm * 256 + ai * 128 + wr * 64 + fq * 16 + fr, u.pn, s1, 0.f); } }
    __device__ __forceinline__ void rg(int r, int pn, int wc, int fq, f32x4 a0, f32x4 b0, f32x4 a1, f32x4 b1) const { const Pre v = pre(r, pn, wc, fq); float t1;
        fin(r, pn, wc, fq, a0 + lo4(v.h0), b0 + hi4(v.h0), a1 + lo4(v.h1), b1 + hi4(v.h1), t1); if (fq == 0) stats(r, pn, t1, 0.f); }
};
struct EpiF1 {
    static constexpr bool PERM = true, AFTER_DRAIN = false;
    bf16* ACT; const long long* ssq;
    MK_PRE_STAT(ssq)
    __device__ __forceinline__ void rgp(int r, int pn, int wc, int fq, f32x4 a0, f32x4 b0, f32x4 a1, f32x4 b1, const Pre pv) const {
        const float rs = rsqrtf(stat_f(pv) * (1.0f / 1024.0f) + RMS_EPS); f32x4 a, b;
#pragma unroll
        for (int e = 0; e < 4; ++e) { a[e] = silu_f(a0[e] * rs) * (a1[e] * rs); b[e] = silu_f(b0[e] * rs) * (b1[e] * rs); }
        *(u32x4*)(ACT + (size_t)r * DFF + pn * 128 + wc * 32 + 8 * fq) = pack8(a, b);
    }
    MK_EPI_CALL()
};
struct EpiB1 {
    static constexpr bool PERM = true, AFTER_DRAIN = false;
    float* RAW; bf16* CQB; const long long* ssq; long long* ssq_kv; long long* ssq_q; MK_DRYFIELD
    __device__ __forceinline__ void half(int r, int c, f32x4 a, f32x4 b, float& qkv, float& qq) const {
        if (c < 256) { *(f32x4*)(RAW + (size_t)r * 768 + c) = a; *(f32x4*)(RAW + (size_t)r * 768 + c + 4) = b; qkv += sumsq8(a, b); }
        else if (c < 640) { *(u32x4*)(CQB + (size_t)r * 384 + (c - 256)) = pack8(a, b); qq += sumsq8(a, b); }
        else if (c < 704) { *(f32x4*)(RAW + (size_t)r * 768 + c) = a; *(f32x4*)(RAW + (size_t)r * 768 + c + 4) = b; } }
    MK_PRE_STAT(ssq)
    __device__ __forceinline__ void rgs(int r, int pn, int wc, int fq, f32x4 a0, f32x4 b0, f32x4 a1, f32x4 b1, const Pre pv, float& s1, float& s2) const {
        const float rs = rsqrtf(stat_f(pv) * (1.0f / 1024.0f) + RMS_EPS); const int c = pn * 256 + wc * 32 + 8 * fq; float qkv = 0.f, qq = 0.f;
        half(r, c, a0 * rs, b0 * rs, qkv, qq); half(r, c + 128, a1 * rs, b1 * rs, qkv, qq);
        s1 = quad_red(qkv); s2 = quad_red(qq);
    }
    __device__ __forceinline__ void stats(int r, int pn, float s1, float s2) const { if (!MK_DRY(*this)) { if (pn == 0) stat_add(ssq_kv + r, s1); else stat_add(ssq_q + r, s2); } }
    MK_EPI_CALL_DENSE()
};
struct EpiB2 {
    static constexpr bool PERM = true, AFTER_DRAIN = false;
    bf16* QF; const long long* ssq_q; const f32x2* rope;
    __device__ __forceinline__ void half(int r, int c, int tp, const f32x4 a, const f32x4 b) const {
        const int h = c / 320, w = c - h * 320;
        if (w < 256) *(u32x4*)(QF + (size_t)r * 2560 + c) = pack8(a, b);
        else { const int i0 = (w - 256) >> 1;
            const f32x4 cs01 = *(const f32x4*)(rope + (size_t)tp * 32 + i0), cs23 = *(const f32x4*)(rope + (size_t)tp * 32 + i0 + 2);
            bf16* qh = QF + (size_t)r * 2560 + h * 320 + 256;
            *(u32x2*)(qh + i0) = (u32x2){cvt_pk_bf16(a[0] * cs01[0] - a[1] * cs01[1], a[2] * cs01[2] - a[3] * cs01[3]), cvt_pk_bf16(b[0] * cs23[0] - b[1] * cs23[1], b[2] * cs23[2] - b[3] * cs23[3])};
            *(u32x2*)(qh + 32 + i0) = (u32x2){cvt_pk_bf16(a[0] * cs01[1] + a[1] * cs01[0], a[2] * cs01[3] + a[3] * cs01[2]), cvt_pk_bf16(b[0] * cs23[1] + b[1] * cs23[0], b[2] * cs23[3] + b[3] * cs23[2])}; } }
    MK_PRE_STAT(ssq_q)
    __device__ __forceinline__ void rgp(int r, int pn, int wc, int fq, f32x4 a0, f32x4 b0, f32x4 a1, f32x4 b1, const Pre pv) const {
        const float rs = rsqrtf(stat_f(pv) * (1.0f / 384.0f) + RMS_EPS) * (MLA_SCALE * 1.4426950408889634f)  ; const int tp = r < MP ? (r & 2047) : 2048 + ((r - MP) & 3), c = pn * 256 + wc * 32 + 8 * fq;
        half(r, c, tp, a0 * rs, b0 * rs); half(r, c + 128, tp, a1 * rs, b1 * rs);
    }
    MK_EPI_CALL()
};
struct EpiC1 {
    static constexpr bool PERM = true, AFTER_DRAIN = false;
    bf16* GATE; float* XW; const long long* ssq;
    MK_PRE_STAT(ssq)
    __device__ __forceinline__ void rgp(int r, int pn, int wc, int fq, f32x4 a0, f32x4 b0, f32x4 a1, f32x4 b1, const Pre pv) const {
        const bool isx = pn >= 5; const int c = (isx ? pn - 5 : pn) * 256 + wc * 32 + 8 * fq; const float rs = rsqrtf(stat_f(pv) * (1.0f / 1024.0f) + RMS_EPS);
        a0 *= rs; b0 *= rs; a1 *= rs; b1 *= rs;
        if (isx) { float* x = XW + (size_t)r * 1280 + c; *(f32x4*)x = a0; *(f32x4*)(x + 4) = b0; *(f32x4*)(x + 128) = a1; *(f32x4*)(x + 132) = b1; }
        else {
#pragma unroll
            for (int e = 0; e < 4; ++e) { a0[e] = gelu_tanh_f(a0[e]); b0[e] = gelu_tanh_f(b0[e]); a1[e] = gelu_tanh_f(a1[e]); b1[e] = gelu_tanh_f(b1[e]); }
            bf16* g = GATE + (size_t)r * 1280 + c; *(u32x4*)g = pack8(a0, b0); *(u32x4*)(g + 128) = pack8(a1, b1); }
    }
    MK_EPI_CALL()
};

template <class Epi>
__device__ __forceinline__ void mini_gemm(const P& p, const bf16* A, int lda, const bf16* Bt, int ldb, int K, int N, const Epi& E, int first_wg) {
    constexpr int BP = 272, SLOT = 64 * BP;
    const int tid = p.tid, lane = p.lane, w = p.wave, kq = w & 3, rgp = w >> 2, l15 = lane & 15, g4 = lane >> 4, nmu = (N >> 8) * 16, nch = K >> 7, nst = (nch + 3) >> 2;
    const int t128 = (rgp << 6) | lane;
    for (int mu = (p.bid - first_wg + p.G) % p.G; mu < nmu; mu += p.G) {
        const int pn = mu >> 4, wcq = (mu >> 2) & 3, rq = mu & 3, row = MP + 32 * rq + 16 * rgp + l15;
        const bf16* arow = A + (size_t)row * lda + 8 * g4;
        const int r0 = t128 >> 4, c16 = t128 & 15;
        const bf16* bbase = Bt + (size_t)(pn * 256 + wcq * 32 + 8 * (r0 >> 2) + (r0 & 3)) * ldb + c16 * 8; const int bo0 = r0 * BP + c16 * 16;
#define MG_BSRC(q) (bbase + (size_t)(128 * ((q) >> 2) + 4 * (((q) >> 1) & 1) + 16 * ((q) & 1)) * ldb)
#define MG_BOFF(q) (bo0 + 8 * (q) * BP)
        f32x4 acc[4];
#pragma unroll
        for (int t = 0; t < 4; ++t) acc[t] = (f32x4){0.f, 0.f, 0.f, 0.f};
        u32x4 b0[8], a0[4], b1[8], a1[4], b2[8], a2[4];
#define MG_LOAD(BS, AS, ST) do { const int ch_ = 4 * (ST) + kq; if (ch_ < nch) { \
            _Pragma("unroll") for (int q = 0; q < 8; ++q) BS[q] = *(const u32x4*)(MG_BSRC(q) + (size_t)ch_ * 128); \
            _Pragma("unroll") for (int s = 0; s < 4; ++s) AS[s] = *(const u32x4*)(arow + (size_t)ch_ * 128 + 32 * s); } } while (0)
#define MG_STEP(BS, AS, ST) do { LAS unsigned char* slot = p.lds + (kq * 2 + ((ST) & 1)) * SLOT; const bool ok_ = 4 * (ST) + kq < nch; \
            if (ok_) { _Pragma("unroll") for (int q = 0; q < 8; ++q) *(LAS u32x4*)(slot + MG_BOFF(q)) = BS[q]; } \
            bf16x8 af[4]; _Pragma("unroll") for (int s = 0; s < 4; ++s) af[s] = __builtin_bit_cast(bf16x8, AS[s]); \
            __syncthreads(); \
            if ((ST) + 3 < nst) MG_LOAD(BS, AS, (ST) + 3); \
            if (ok_) { _Pragma("unroll") for (int s = 0; s < 4; ++s) _Pragma("unroll") for (int t = 0; t < 4; ++t) { \
                const bf16x8 bf = *(const LAS bf16x8*)(slot + (t * 16 + l15) * BP + (32 * s + 8 * g4) * 2); \
                acc[t] = __builtin_amdgcn_mfma_f32_16x16x32_bf16(bf, af[s], acc[t], 0, 0, 0); } } } while (0)
        MG_LOAD(b0, a0, 0); if (1 < nst) MG_LOAD(b1, a1, 1); if (2 < nst) MG_LOAD(b2, a2, 2);
        __syncthreads();
        for (int st = 0; st < nst; st += 3) {
            MG_STEP(b0, a0, st);
            if (st + 1 < nst) MG_STEP(b1, a1, st + 1);
            if (st + 2 < nst) MG_STEP(b2, a2, st + 2);
        }
#undef MG_LOAD
#undef MG_STEP
#undef MG_BSRC
#undef MG_BOFF
        __syncthreads();
        LAS f32x4* red = (LAS f32x4*)p.lds;
        if (kq > 0) {
#pragma unroll
            for (int t = 0; t < 4; ++t) red[((rgp * 3 + (kq - 1)) * 4 + t) * 64 + lane] = acc[t]; }
        __syncthreads();
        if (kq == 0) {
#pragma unroll
            for (int k2 = 0; k2 < 3; ++k2)
#pragma unroll
                for (int t = 0; t < 4; ++t) acc[t] += red[((rgp * 3 + k2) * 4 + t) * 64 + lane];
            E.rg(row, pn, wcq, g4, acc[0], acc[1], acc[2], acc[3]); }
    }
}
}
namespace mk {
__device__ __forceinline__ s16x4 tr16(const LAS unsigned char* a) { return __builtin_amdgcn_ds_read_tr16_b64_v4i16((LAS s16x4*)a); }
__device__ __forceinline__ bf16x8 cat8(const s16x4 a, const s16x4 b) { return (bf16x8){a[0], a[1], a[2], a[3], b[0], b[1], b[2], b[3]}; }
__device__ __forceinline__ bf16x8 as_bf16x8(const u32x4 w) { return __builtin_bit_cast(bf16x8, w); }
#define MFMA16(A, B, C) __builtin_amdgcn_mfma_f32_16x16x32_bf16((A), (B), (C), 0, 0, 0)
constexpr int TP = 272;
constexpr int KP = 656;
constexpr float LOG2E = 1.4426950408889634f;

__device__ __forceinline__ void a2_spatial(const P& p, int j, float* out_cv  ) {
    const bf16* U = p.w<bf16>(WS_U); const bf16* GV = p.w<bf16>(WS_GV); bf16* UM = p.w<bf16>(WS_UM);
    const long long* lns = p.stat(ST_LNS0 + 2 * j); const long long* lnq = p.stat(ST_LNQ0 + 2 * j);
    const float* ln_g = p.in[10] + j * 1024; const float* ln_b = p.in[11] + j * 1024; const float* b_s = p.in[13] + j * 1024;
    LAS unsigned char* Wt = p.lds; LAS unsigned char* Vt = p.lds + 128 * TP;
    const int tid = p.tid, lane = p.lane, w = p.wave, l15 = lane & 15, g4 = lane >> 4, q4 = (lane & 15) >> 2, pp = lane & 3;
    { const float* aws = p.in[12] + (size_t)j * 8 * 16384;
      for (int idx = p.bid * 512 + tid; idx < 128 * 1024; idx += p.G * 512) {
        const int t = idx >> 10, d = idx & 1023, g = d >> 7, i = t & 3; const size_t r = (size_t)MP + t, rb = r - i;
        const float lg = ln_g[d], lb = ln_b[d]; float mixed = b_s[g * 128 + i], vi = 0.f;
#pragma unroll
        for (int s2 = 0; s2 < 4; ++s2) { const size_t rs = rb + s2;
            const float mu = stat_get(lns + rs) * (1.0f / 1024.0f), var = stat_get(lnq + rs) * (1.0f / 1024.0f) - mu * mu;
            const float v = (bf2f(GV[rs * 1024 + d]) - mu) * rsqrtf(var + LN_EPS) * lg + lb, wv = aws[(size_t)g * 16384 + i * 128 + s2];
            mixed += (s2 <= i) ? wv * v : 0.f; vi = (s2 == i) ? v : vi; }
        if (out_cv) out_cv[(size_t)t * 1024 + d] = vi;
        UM[r * 1024 + d] = (bf16)f2bf(bf2f(U[r * 1024 + d]) * mixed); } }
    for (int u = p.bid; u < 128 * 8; u += p.G) {
        const int c = u >> 3, g = u & 7, row0 = c * 128; const bool smp = false;
        const bf16* Wsrc = p.w<bf16>(WS_WS + (smp ? 524288 : 0) + (size_t)j * 262144) + (size_t)g * 16384;
#pragma unroll
        for (int q = 0; q < 4; ++q) { const int ch = tid + 512 * q, row = ch >> 4, c16 = ch & 15;
            *(LAS u32x4*)(Wt + row * TP + c16 * 16) = *(const u32x4*)(Wsrc + row * 128 + c16 * 8); }
        { const int c16 = tid & 15, d0 = g * 128 + c16 * 8;
          const f32x4 g0 = *(const f32x4*)(ln_g + d0), g1 = *(const f32x4*)(ln_g + d0 + 4), b0 = *(const f32x4*)(ln_b + d0), b1 = *(const f32x4*)(ln_b + d0 + 4);
          u32x4 raw[4]; float mean[4], rstd[4];
#pragma unroll
          for (int q = 0; q < 4; ++q) { const int r = row0 + (tid >> 4) + 32 * q; raw[q] = *(const u32x4*)(GV + (size_t)r * 1024 + d0);
              const float mu = stat_get(lns + r) * (1.0f / 1024.0f), var = stat_get(lnq + r) * (1.0f / 1024.0f) - mu * mu; mean[q] = mu; rstd[q] = rsqrtf(var + LN_EPS); }
#pragma unroll
          for (int q = 0; q < 4; ++q) { const int s = (tid >> 4) + 32 * q, r = row0 + s;
            f32x4 v0, v1;
            v0[0] = bflo(raw[q].x); v0[1] = bfhi(raw[q].x); v0[2] = bflo(raw[q].y); v0[3] = bfhi(raw[q].y); v1[0] = bflo(raw[q].z); v1[1] = bfhi(raw[q].z); v1[2] = bflo(raw[q].w); v1[3] = bfhi(raw[q].w);
            v0 = (v0 - mean[q]) * rstd[q] * g0 + b0; v1 = (v1 - mean[q]) * rstd[q] * g1 + b1;
            if (smp && out_cv) { float* o = out_cv + (size_t)(r - MP) * 1024 + d0; *(f32x4*)o = v0; *(f32x4*)(o + 4) = v1; }
            *(LAS u32x4*)(Vt + s * TP + c16 * 16) = pack8(v0, v1); } }
        u32x2 uu[8];
#pragma unroll
        for (int tt = 0; tt < 8; ++tt) uu[tt] = *(const u32x2*)(U + (size_t)(row0 + 16 * tt + l15) * 1024 + g * 128 + 16 * w + 4 * g4);
        __syncthreads();
        f32x4 acc[8];
#pragma unroll
        for (int tt = 0; tt < 8; ++tt) acc[tt] = (f32x4){0.f, 0.f, 0.f, 0.f};
#pragma unroll
        for (int kk = 0; kk < 4; ++kk) {
            const bf16x8 X = cat8(tr16(Vt + (32 * kk + 8 * g4 + q4) * TP + (16 * w + 4 * pp) * 2), tr16(Vt + (32 * kk + 8 * g4 + 4 + q4) * TP + (16 * w + 4 * pp) * 2));
#pragma unroll
            for (int tt = 0; tt < 8; ++tt) if (32 * kk <= 16 * tt + 15) {
                const bf16x8 Y = *(const LAS bf16x8*)(Wt + (16 * tt + l15) * TP + (32 * kk + 8 * g4) * 2);
                acc[tt] = MFMA16(X, Y, acc[tt]); }
        }
#pragma unroll
        for (int tt = 0; tt < 8; ++tt) { const int t = 16 * tt + l15, r = row0 + t, col = g * 128 + 16 * w + 4 * g4;
            const float bias = b_s[g * 128 + (smp ? (t & 3) : t)];
            const float o0 = bflo(uu[tt].x) * (acc[tt][0] + bias), o1 = bfhi(uu[tt].x) * (acc[tt][1] + bias), o2 = bflo(uu[tt].y) * (acc[tt][2] + bias), o3 = bfhi(uu[tt].y) * (acc[tt][3] + bias);
            *(u32x2*)(UM + (size_t)r * 1024 + col) = (u32x2){cvt_pk_bf16(o0, o1), cvt_pk_bf16(o2, o3)}; }
        __syncthreads();
    }
}

__device__ __forceinline__ void b2_kvfinal(const P& p, float* out_mp, float* out_ms) {
    const float* RAW = p.w<float>(WS_RAW); bf16* KVB = p.w<bf16>(WS_KVB); const long long* ssq_kv = p.stat(ST_KV); const float* kvn = p.in[19]; const f32x2* rope = p.w<f32x2>(WS_ROPE);
    const int gw = p.bid * NWAVES + p.wave, NGW = p.G * NWAVES, lane = p.lane, l31 = lane & 31;
    const f32x4 kn = *(const f32x4*)(kvn + 4 * lane);
    auto tpos = [&](int m) { return m < MP ? (m & 2047) : 2048 + ((m - MP) & 3); };
    long long sq = 0, sqn = 0; f32x4 rv = (f32x4){0.f, 0.f, 0.f, 0.f}, rvn = rv; f32x2 cs = (f32x2){0.f, 0.f}, csn = cs; float x1 = 0.f, x2 = 0.f, x1n = 0.f, x2n = 0.f;
    if (gw < MT) { const int m = gw; sq = ssq_kv[m]; rv = *(const f32x4*)(RAW + (size_t)m * 768 + 4 * lane); cs = rope[(size_t)tpos(m) * 32 + l31]; x1 = RAW[(size_t)m * 768 + 640 + l31]; x2 = RAW[(size_t)m * 768 + 672 + l31]; }
    for (int m = gw; m < MT; m += NGW) {
        { const int mn = (m + NGW < MT) ? m + NGW : m; sqn = ssq_kv[mn]; rvn = *(const f32x4*)(RAW + (size_t)mn * 768 + 4 * lane); csn = rope[(size_t)tpos(mn) * 32 + l31]; x1n = RAW[(size_t)mn * 768 + 640 + l31]; x2n = RAW[(size_t)mn * 768 + 672 + l31]; }
        float* o = m < MP ? (out_mp ? out_mp + (size_t)m * 320 : nullptr) : (out_ms ? out_ms + (size_t)(m - MP) * 320 : nullptr);
        const float rs = rsqrtf((float)sq * ST_INV * (1.0f / 256.0f) + RMS_EPS);
        const f32x4 v = rv * rs * kn;
        if (o) *(f32x4*)(o + 4 * lane) = v;
        *(u32x2*)(KVB + (size_t)m * 320 + 4 * lane) = (u32x2){cvt_pk_bf16(v[0], v[1]), cvt_pk_bf16(v[2], v[3])};
        if (lane < 32) {
            const float o1 = x1 * cs.x - x2 * cs.y, o2 = x1 * cs.y + x2 * cs.x;
            if (o) { o[256 + lane] = o1; o[288 + lane] = o2; }
            KVB[(size_t)m * 320 + 256 + lane] = (bf16)f2bf(o1); KVB[(size_t)m * 320 + 288 + lane] = (bf16)f2bf(o2); }
        sq = sqn; rv = rvn; cs = csn; x1 = x1n; x2 = x2n;
    }
}

__device__ __forceinline__ void b3_attn_prompt(const P& p) {
    const bf16* QF = p.w<bf16>(WS_QF); const bf16* KVB = p.w<bf16>(WS_KVB); bf16* OB = p.w<bf16>(WS_OB);
    const int lane = p.lane, h = p.wave, l15 = lane & 15, g4 = lane >> 4, q4 = (lane & 15) >> 2, pp = lane & 3;
    constexpr int TILE_B = 64 * 640;
    int soff[5];
#pragma unroll
    for (int i = 0; i < 5; ++i) { const int P_ = (h + 8 * i) * 64 + lane, row = P_ / 40, cph = P_ - 40 * row; soff[i] = row * 320 + ((cph ^ (row & 6)) << 3); }
    int kaddr[10];
#pragma unroll
    for (int s_ = 0; s_ < 10; ++s_) kaddr[s_] = l15 * 640 + (((4 * s_ + g4) ^ (l15 & 6)) << 4);
    int taddr[4];
    { const int rl = 4 * g4 + q4, m_ = (rl & 6) >> 1;
#pragma unroll
      for (int v3 = 0; v3 < 4; ++v3) taddr[v3] = rl * 640 + (((v3 ^ m_) << 1 | (pp >> 1)) << 4) + 8 * (pp & 1); }
#define AT_DMA(BUF, SRC) do { _Pragma("unroll") for (int i = 0; i < 5; ++i) \
        __builtin_amdgcn_global_load_lds((const unsigned*)((SRC) + soff[i]), (LAS unsigned*)((BUF) + (h + 8 * i) * 1024), 16, 0, 0); } while (0)
    for (int pi = p.bid; pi < 512; pi += p.G) {
        const int b = (p.G % 8 == 0) ? (pi & 7) : (pi >> 6), x = (p.G % 8 == 0) ? ((pi >> 3) & 63) : (pi & 63);
        for (int half = 0; half < 2; ++half) {
            const int qt = half ? 127 - x : x, t0 = 16 * qt, nkt = (t0 + 15) / 64 + 1;
            const size_t rowq = (size_t)b * 2048 + t0 + l15; const bf16* kvb = KVB + (size_t)b * 2048 * 320;
            AT_DMA(p.lds, kvb);
            bf16x8 Q[10];
#pragma unroll
            for (int s = 0; s < 10; ++s) Q[s] = as_bf16x8(*(const u32x4*)(QF + rowq * 2560 + h * 320 + 32 * s + 8 * g4));
            f32x4 O[16];
#pragma unroll
            for (int vt = 0; vt < 16; ++vt) O[vt] = (f32x4){0.f, 0.f, 0.f, 0.f};
            float mrun = -1e30f, lrun = 0.f;
            asm volatile("s_waitcnt vmcnt(0)" ::: "memory"); __syncthreads();
#define AT_TILE(BUF, KT, MASKED) do { \
                f32x4 S[4]; \
                _Pragma("unroll") for (int k4 = 0; k4 < 4; ++k4) S[k4] = (f32x4){0.f, 0.f, 0.f, 0.f}; \
                { bf16x8 Kc[4], Kn[4]; \
                  _Pragma("unroll") for (int k4 = 0; k4 < 4; ++k4) Kc[k4] = *(const LAS bf16x8*)((BUF) + kaddr[0] + k4 * 10240); \
                  _Pragma("unroll") for (int s = 0; s < 10; ++s) { \
                      if (s < 9) { _Pragma("unroll") for (int k4 = 0; k4 < 4; ++k4) Kn[k4] = *(const LAS bf16x8*)((BUF) + kaddr[s < 9 ? s + 1 : 9] + k4 * 10240); } \
                      _Pragma("unroll") for (int k4 = 0; k4 < 4; ++k4) S[k4] = MFMA16(Kc[k4], Q[s], S[k4]); \
                      _Pragma("unroll") for (int k4 = 0; k4 < 4; ++k4) Kc[k4] = Kn[k4]; } } \
                  \
                float mx = -1e30f; \
                _Pragma("unroll") for (int k4 = 0; k4 < 4; ++k4) _Pragma("unroll") for (int e = 0; e < 4; ++e) { float v = S[k4][e]; if ((MASKED) && 64 * (KT) + 16 * k4 + 4 * g4 + e > t0 + l15) v = -1e30f; S[k4][e] = v; mx = fmaxf(mx, v); } \
                mx = fmaxf(mx, __shfl_xor(mx, 16)); mx = fmaxf(mx, __shfl_xor(mx, 32)); \
                const float mnew = fmaxf(mrun, mx), alpha = __builtin_amdgcn_exp2f(mrun - mnew); mrun = mnew; \
                float ps = 0.f; \
                _Pragma("unroll") for (int k4 = 0; k4 < 4; ++k4) _Pragma("unroll") for (int e = 0; e < 4; ++e) { const float pv = __builtin_amdgcn_exp2f(S[k4][e] - mnew); S[k4][e] = pv; ps += pv; } \
                lrun = lrun * alpha + ps; \
                _Pragma("unroll") for (int vt = 0; vt < 16; ++vt) O[vt] *= alpha; \
                bf16x8 Pf[2]; \
                _Pragma("unroll") for (int ks = 0; ks < 2; ++ks) Pf[ks] = as_bf16x8((u32x4){cvt_pk_bf16(S[2 * ks][0], S[2 * ks][1]), cvt_pk_bf16(S[2 * ks][2], S[2 * ks][3]), cvt_pk_bf16(S[2 * ks + 1][0], S[2 * ks + 1][1]), cvt_pk_bf16(S[2 * ks + 1][2], S[2 * ks + 1][3])}); \
                  \
                { s16x4 Vc[4], Vn[4]; \
                  Vc[0] = AT_V(BUF, 0, 0, 0); Vc[1] = AT_V(BUF, 0, 0, 1); Vc[2] = AT_V(BUF, 0, 1, 0); Vc[3] = AT_V(BUF, 0, 1, 1); \
                  _Pragma("unroll") for (int vt = 0; vt < 16; ++vt) { \
                      if (vt < 15) { Vn[0] = AT_V(BUF, (vt < 15 ? vt + 1 : 15), 0, 0); Vn[1] = AT_V(BUF, (vt < 15 ? vt + 1 : 15), 0, 1); Vn[2] = AT_V(BUF, (vt < 15 ? vt + 1 : 15), 1, 0); Vn[3] = AT_V(BUF, (vt < 15 ? vt + 1 : 15), 1, 1); } \
                      O[vt] = MFMA16(cat8(Vc[0], Vc[1]), Pf[0], O[vt]); O[vt] = MFMA16(cat8(Vc[2], Vc[3]), Pf[1], O[vt]); \
                      _Pragma("unroll") for (int i = 0; i < 4; ++i) Vc[i] = Vn[i]; } } } while (0)
#define AT_V(BUF, VT, KS, T) tr16((BUF) + taddr[(VT) & 3] + ((VT) >> 2) * 128 + (32 * (KS) + 16 * (T)) * 640)
            for (int kt = 0; kt < nkt - 1; ++kt) {
                LAS unsigned char* buf = p.lds + (kt & 1) * TILE_B;
                AT_DMA(p.lds + ((kt + 1) & 1) * TILE_B, kvb + (size_t)64 * (kt + 1) * 320);
                AT_TILE(buf, kt, false);
                asm volatile("s_waitcnt vmcnt(0)" ::: "memory"); __syncthreads();
            }
            { const int kt = nkt - 1; LAS unsigned char* buf = p.lds + (kt & 1) * TILE_B;
              AT_TILE(buf, kt, true);
              __syncthreads(); }
#undef AT_TILE
#undef AT_V
            const float linv = 1.0f / quad_red(lrun);
#pragma unroll
            for (int vt = 0; vt < 16; ++vt) { const f32x4 o = O[vt] * linv;
                *(u32x2*)(OB + rowq * 2048 + h * 256 + 16 * vt + 4 * g4) = (u32x2){cvt_pk_bf16(o[0], o[1]), cvt_pk_bf16(o[2], o[3])}; }
        }
    }
#undef AT_DMA
}

__device__ __forceinline__ void b3_attn_sample(const P& p) {
    const bf16* QF = p.w<bf16>(WS_QF); float* PART = p.w<float>(WS_PART); float* PML = p.w<float>(WS_PML);
    const float* cache = p.in[2]; const int* ptab = (const int*)p.in[5];
    const int tid = p.tid, lane = p.lane, w = p.wave, qt = w & 1, dvq = w >> 1, l15 = lane & 15, g4 = lane >> 4, q4 = (lane & 15) >> 2, pp = lane & 3;
    constexpr int TILE_B = 64 * KP;
    for (int u = p.bid; u < 256; u += p.G) {
        const int b = u >> 3, sp = u & 7;
        const int hq = 4 * qt + (l15 >> 2), iq = l15 & 3; const size_t rowq = (size_t)MP + 4 * b + iq;
        bf16x8 Q[10];
#pragma unroll
        for (int s = 0; s < 10; ++s) Q[s] = as_bf16x8(*(const u32x4*)(QF + rowq * 2560 + hq * 320 + 32 * s + 8 * g4));
        f32x4 O[4];
#pragma unroll
        for (int v = 0; v < 4; ++v) O[v] = (f32x4){0.f, 0.f, 0.f, 0.f};
        float mrun = -1e30f, lrun = 0.f;
        f32x4 st[10];
        auto tile_src = [&](int ti) -> const float* { const int pg = 16 * sp + (ti >> 1); return cache + ((size_t)ptab[b * 128 + pg] * 128 + 64 * (ti & 1)) * 320; };
        { const float* src = tile_src(0);
#pragma unroll
          for (int q = 0; q < 10; ++q) st[q] = __builtin_nontemporal_load((const f32x4*)(src + (size_t)(tid + 512 * q) * 4));
          __syncthreads();
#pragma unroll
          for (int q = 0; q < 10; ++q) { const int ch = tid + 512 * q, row = ch / 80, c4 = ch % 80; *(LAS u32x2*)(p.lds + row * KP + c4 * 8) = (u32x2){cvt_pk_bf16(st[q][0], st[q][1]), cvt_pk_bf16(st[q][2], st[q][3])}; }
          __syncthreads(); }
        for (int ti = 0; ti < 32; ++ti) {
            LAS unsigned char* buf = p.lds + (ti & 1) * TILE_B;
            if (ti + 1 < 32) { const float* src = tile_src(ti + 1);
#pragma unroll
                for (int q = 0; q < 10; ++q) st[q] = __builtin_nontemporal_load((const f32x4*)(src + (size_t)(tid + 512 * q) * 4)); }
            f32x4 S[4];
#pragma unroll
            for (int k4 = 0; k4 < 4; ++k4) { S[k4] = (f32x4){0.f, 0.f, 0.f, 0.f};
#pragma unroll
                for (int s = 0; s < 10; ++s) { const bf16x8 Kf = *(const LAS bf16x8*)(buf + (16 * k4 + l15) * KP + (32 * s + 8 * g4) * 2); S[k4] = MFMA16(Kf, Q[s], S[k4]); } }
            float mx = -1e30f;
#pragma unroll
            for (int k4 = 0; k4 < 4; ++k4)
#pragma unroll
                for (int e = 0; e < 4; ++e) { const float v = S[k4][e]; mx = fmaxf(mx, v); }
            mx = fmaxf(mx, __shfl_xor(mx, 16)); mx = fmaxf(mx, __shfl_xor(mx, 32));
            const float mnew = fmaxf(mrun, mx), alpha = __builtin_amdgcn_exp2f(mrun - mnew); mrun = mnew;
            float ps = 0.f;
#pragma unroll
            for (int k4 = 0; k4 < 4; ++k4)
#pragma unroll
                for (int e = 0; e < 4; ++e) { const float pv = __builtin_amdgcn_exp2f(S[k4][e] - mnew); S[k4][e] = pv; ps += pv; }
            lrun = lrun * alpha + ps;
#pragma unroll
            for (int v = 0; v < 4; ++v) O[v] *= alpha;
            bf16x8 Pf[2];
#pragma unroll
            for (int ks = 0; ks < 2; ++ks) Pf[ks] = as_bf16x8((u32x4){cvt_pk_bf16(S[2 * ks][0], S[2 * ks][1]), cvt_pk_bf16(S[2 * ks][2], S[2 * ks][3]), cvt_pk_bf16(S[2 * ks + 1][0], S[2 * ks + 1][1]), cvt_pk_bf16(S[2 * ks + 1][2], S[2 * ks + 1][3])});
#pragma unroll
            for (int v = 0; v < 4; ++v) { const int vt = 4 * dvq + v;
#pragma unroll
                for (int ks = 0; ks < 2; ++ks) {
                    const bf16x8 Vf = cat8(tr16(buf + (32 * ks + 4 * g4 + q4) * KP + (16 * vt + 4 * pp) * 2), tr16(buf + (32 * ks + 16 + 4 * g4 + q4) * KP + (16 * vt + 4 * pp) * 2));
                    O[v] = MFMA16(Vf, Pf[ks], O[v]); } }
            if (ti + 1 < 32) { LAS unsigned char* nb = p.lds + ((ti + 1) & 1) * TILE_B;
#pragma unroll
                for (int q = 0; q < 10; ++q) { const int ch = tid + 512 * q, row = ch / 80, c4 = ch % 80; *(LAS u32x2*)(nb + row * KP + c4 * 8) = (u32x2){cvt_pk_bf16(st[q][0], st[q][1]), cvt_pk_bf16(st[q][2], st[q][3])}; } }
            __syncthreads();
        }
        const float lsum = quad_red(lrun); const int qrow = 16 * qt + l15; const size_t pb = ((size_t)(b * 8 + sp) * 32 + qrow);
#pragma unroll
        for (int v = 0; v < 4; ++v) *(f32x4*)(PART + pb * 256 + 16 * (4 * dvq + v) + 4 * g4) = O[v];
        if (dvq == 0 && g4 == 0) { PML[pb * 2] = mrun; PML[pb * 2 + 1] = lsum; }
    }
}
__device__ __forceinline__ void b3_combine(const P& p) {
    const bf16* QF = p.w<bf16>(WS_QF); const bf16* KVB = p.w<bf16>(WS_KVB); bf16* OB = p.w<bf16>(WS_OB); const float* PART = p.w<float>(WS_PART); const float* PML = p.w<float>(WS_PML);
    const int dv = p.tid & 255, sub = p.tid >> 8, lane = p.lane, w4 = p.wave & 3;
    LAS float* red = (LAS float*)p.lds;
    for (int base = 2 * p.bid; base < 1024; base += 2 * p.G) {
        const bool live = base + sub < 1024; const int it = live ? base + sub : 1023;
        const int b = it >> 5, i = (it >> 3) & 3, h = it & 7, qt = h >> 2, ql = ((h & 3) << 2) | i, qrow = 16 * qt + ql; const size_t row = (size_t)MP + 4 * b + i;
        { const int wd = dv < 160 ? dv : 159; const unsigned a = ((const unsigned*)(QF + row * 2560 + h * 320))[wd]; float pk[4];
#pragma unroll
          for (int kk = 0; kk < 4; ++kk) { const unsigned c = ((const unsigned*)(KVB + ((size_t)MP + 4 * b + kk) * 320))[wd]; pk[kk] = (dv < 160) ? bflo(a) * bflo(c) + bfhi(a) * bfhi(c) : 0.f; }
#pragma unroll
          for (int kk = 0; kk < 4; ++kk) {
#pragma unroll
              for (int o = 1; o < 64; o <<= 1) pk[kk] += __shfl_xor(pk[kk], o);
              if (lane == 0) red[(sub * 4 + w4) * 4 + kk] = pk[kk]; } }
        __syncthreads();
        float sn[4];
#pragma unroll
        for (int kk = 0; kk < 4; ++kk) { const float s = (red[(sub * 4 + 0) * 4 + kk] + red[(sub * 4 + 1) * 4 + kk]) + (red[(sub * 4 + 2) * 4 + kk] + red[(sub * 4 + 3) * 4 + kk]); sn[kk] = (kk <= i) ? s : -1e30f; }
        float M = fmaxf(fmaxf(sn[0], sn[1]), fmaxf(sn[2], sn[3])); float ms[8], ls[8];
#pragma unroll
        for (int sp = 0; sp < 8; ++sp) { const size_t pb = ((size_t)(b * 8 + sp) * 32 + qrow); ms[sp] = PML[pb * 2]; ls[sp] = PML[pb * 2 + 1]; M = fmaxf(M, ms[sp]); }
        float L = 0.f, Oa = 0.f;
#pragma unroll
        for (int sp = 0; sp < 8; ++sp) { const size_t pb = ((size_t)(b * 8 + sp) * 32 + qrow); const float wgt = __builtin_amdgcn_exp2f(ms[sp] - M); L += ls[sp] * wgt; Oa += PART[pb * 256 + dv] * wgt; }
#pragma unroll
        for (int kk = 0; kk < 4; ++kk) { const float pk = __builtin_amdgcn_exp2f(sn[kk] - M); L += pk; Oa += pk * bf2f(KVB[((size_t)MP + 4 * b + kk) * 320 + dv]); }
        if (live) OB[row * 2048 + h * 256 + dv] = (bf16)f2bf(Oa / L);
        __syncthreads();
    }
}

template <bool SMP>
__device__ __forceinline__ f32x4 conv4(const float* XW, const float* cbuf  , const float* cw, const float* cb, int m, int c) {
    f32x4 acc = *(const f32x4*)(cb + c);
    f32x4 v[4], wv[4];
#pragma unroll
    for (int k = 0; k < 4; ++k) { wv[k] = *(const f32x4*)(cw + k * 1280 + c);
        if (!SMP) { const int t = m & 2047, r = t + k - 3; v[k] = *(const f32x4*)(XW + (size_t)(m + (r >= 0 ? k - 3 : -t)) * 1280 + c); if (r < 0) wv[k] = (f32x4){0.f, 0.f, 0.f, 0.f}; }
        else { const int b = (m - MP) >> 2, t = (m - MP) & 3, r = t + k - 3; const float* ptr = (r >= 0) ? XW + (size_t)(m + k - 3) * 1280 + c : cbuf + ((size_t)b * 3 + (3 + r)) * 1280 + c; v[k] = *(const f32x4*)ptr; } }
#pragma unroll
    for (int k = 0; k < 4; ++k) acc += wv[k] * v[k];
    return acc;
}
__device__ __forceinline__ void c2_rglru(const P& p, int j, float* out_cp, float* out_cs, float* out_hs, const int mask) {
    const float* XW = p.w<float>(WS_XW); bf16* LH = p.w<bf16>(WS_AA); bf16* CPB = p.w<bf16>(WS_BB); float* AGG = p.w<float>(WS_AGG);
    const float* cbuf = p.in[4] + (size_t)j * 32 * 3 * 1280; const float* cw = p.in[25] + (size_t)j * 4 * 1280; const float* cb = p.in[26] + j * 1280;
    const float* b_a = p.in[28] + j * 1280; const float* b_i = p.in[30] + j * 1280; const float* lam = p.in[31] + j * 1280; const float* h0s = p.in[3] + (size_t)j * 32 * 1280;
    const bf16* WaT = p.w<bf16>(WS_WAT); const bf16* WiT = p.w<bf16>(WS_WIT);
    LAS unsigned char* Xt = p.lds; LAS unsigned char* At = p.lds + 128 * TP; LAS unsigned char* It = p.lds + 256 * TP;
    LAS float* LA = (LAS float*)p.lds;
    LAS unsigned char* LB = p.lds + 128 * 528;
    LAS float* QT = (LAS float*)(p.lds + 128 * 528 + 128 * TP);
    const int tid = p.tid, lane = p.lane, w = p.wave, l15 = lane & 15, g4 = lane >> 4;
    { const int gt = p.bid * 512 + tid, NGT = p.G * 512;
      for (int i = gt; i < (8 + 32) * 3 * 320; i += NGT) { const int c = (i % 320) * 4, rr = i / 320, jj = rr % 3, bb = rr / 3;
          if (bb < 8) { if (out_cp) *(f32x4*)(out_cp + ((size_t)bb * 3 + jj) * 1280 + c) = *(const f32x4*)(XW + ((size_t)bb * 2048 + 2045 + jj) * 1280 + c); }
          else { const int b = bb - 8; if (out_cs) *(f32x4*)(out_cs + ((size_t)b * 3 + jj) * 1280 + c) = *(const f32x4*)(XW + ((size_t)MP + 4 * b + 1 + jj) * 1280 + c); } } }
    const int c16 = tid & 15;
    f32x4 wv[4][2], bv[2], xv0[2][4][2]; u32x4 wa[4], wi[4];
#define C2_LOADW(U) do { const int n_ = (U) % 10, cch_ = n_ * 128 + c16 * 8; \
        _Pragma("unroll") for (int k = 0; k < 4; ++k) { wv[k][0] = *(const f32x4*)(cw + k * 1280 + cch_); wv[k][1] = *(const f32x4*)(cw + k * 1280 + cch_ + 4); } \
        bv[0] = *(const f32x4*)(cb + cch_); bv[1] = *(const f32x4*)(cb + cch_ + 4); } while (0)
#define C2_LOADG(U) do { const int n_ = (U) % 10; \
        _Pragma("unroll") for (int q = 0; q < 4; ++q) { const int row = (tid >> 4) + 32 * q; wa[q] = *(const u32x4*)(WaT + (size_t)n_ * 16384 + row * 128 + c16 * 8); wi[q] = *(const u32x4*)(WiT + (size_t)n_ * 16384 + row * 128 + c16 * 8); } } while (0)
#define C2_LOADX(U, QH, XV) do { const int T_ = (U) / 10, cch_ = ((U) % 10) * 128 + c16 * 8; \
        _Pragma("unroll") for (int qq = 0; qq < 2; ++qq) { const int m = T_ * 128 + (tid >> 4) + 32 * (2 * (QH) + qq); \
            _Pragma("unroll") for (int k = 0; k < 4; ++k) { const float* ptr; \
                if (T_ < 128) { const int t = m & 2047, r = t + k - 3; ptr = XW + (size_t)(m + (r >= 0 ? k - 3 : -t)) * 1280 + cch_; } \
                else { const int b = (m - MP) >> 2, t = (m - MP) & 3, r = t + k - 3; ptr = (r >= 0) ? XW + (size_t)(m + k - 3) * 1280 + cch_ : cbuf + ((size_t)b * 3 + (3 + r)) * 1280 + cch_; } \
                XV[qq][k][0] = *(const f32x4*)ptr; XV[qq][k][1] = *(const f32x4*)(ptr + 4); } } } while (0)
#define C2_CONV(U, QH, XV) do { const int T_ = (U) / 10; \
        _Pragma("unroll") for (int qq = 0; qq < 2; ++qq) { const int row = (tid >> 4) + 32 * (2 * (QH) + qq), m = T_ * 128 + row; f32x4 v0 = bv[0], v1 = bv[1]; \
            _Pragma("unroll") for (int k = 0; k < 4; ++k) { const bool live = (T_ >= 128) || (((m & 2047) + k - 3) >= 0); const f32x4 z = (f32x4){0.f, 0.f, 0.f, 0.f}; \
                v0 += (live ? wv[k][0] : z) * XV[qq][k][0]; v1 += (live ? wv[k][1] : z) * XV[qq][k][1]; } \
            *(LAS u32x4*)(Xt + row * TP + c16 * 16) = pack8(v0, v1); } } while (0)
    if (p.bid < 129 * 10) { C2_LOADX(p.bid, 0, xv0); }
    for (int u = p.bid; u < 129 * 10; u += p.G) {
        int tl_ = p.tid; asm volatile("" : "+v"(tl_)); const int tid = tl_, lane = tl_ & 63, l15 = lane & 15, g4 = lane >> 4, c16 = tl_ & 15;
        const int T = u / 10, n = u % 10, row0 = T * 128;
        {
            C2_LOADW(u); C2_LOADG(u);
            C2_CONV(u, 0, xv0); C2_LOADX(u, 1, xv0); C2_CONV(u, 1, xv0);
#pragma unroll
            for (int q = 0; q < 4; ++q) { const int row = (tid >> 4) + 32 * q; *(LAS u32x4*)(At + row * TP + c16 * 16) = wa[q]; *(LAS u32x4*)(It + row * TP + c16 * 16) = wi[q]; }
        }
        __syncthreads();
        f32x4 ca[8], ci[8];
#pragma unroll
        for (int tt = 0; tt < 8; ++tt) { ca[tt] = (f32x4){0.f, 0.f, 0.f, 0.f}; ci[tt] = (f32x4){0.f, 0.f, 0.f, 0.f}; }
        {
#pragma unroll
        for (int kk = 0; kk < 4; ++kk) {
            const bf16x8 Xa = *(const LAS bf16x8*)(At + (16 * w + l15) * TP + (32 * kk + 8 * g4) * 2), Xi = *(const LAS bf16x8*)(It + (16 * w + l15) * TP + (32 * kk + 8 * g4) * 2);
#pragma unroll
            for (int tt = 0; tt < 8; ++tt) { const bf16x8 Y = *(const LAS bf16x8*)(Xt + (16 * tt + l15) * TP + (32 * kk + 8 * g4) * 2);
                ca[tt] = MFMA16(Xa, Y, ca[tt]); ci[tt] = MFMA16(Xi, Y, ci[tt]); }
        }
        const int chn = n * 128 + 16 * w + 4 * g4;
        { const f32x4 ba = *(const f32x4*)(b_a + chn), bi = *(const f32x4*)(b_i + chn), lm = *(const f32x4*)(lam + chn);
          f32x4 sp;
#pragma unroll
          for (int e = 0; e < 4; ++e) { const float nl = -lm[e]; sp[e] = -8.0f * LOG2E * ((nl > 20.f) ? nl : log1pf(expf(nl))); }
#pragma unroll
          for (int tt = 0; tt < 8; ++tt) { const u32x2 xb = *(const LAS u32x2*)(Xt + (16 * tt + l15) * TP + (16 * w + 4 * g4) * 2);
              const f32x4 xc = (f32x4){bflo(xb.x), bfhi(xb.x), bflo(xb.y), bfhi(xb.y)};
#pragma unroll
              for (int e = 0; e < 4; ++e) { const float r = fast_sigmoid_l2(LOG2E * (ca[tt][e] + ba[e])), gi = fast_sigmoid_l2(LOG2E * (ci[tt][e] + bi[e]));
                  const float a = __builtin_amdgcn_exp2f(r * sp[e]);
                  ca[tt][e] = a; ci[tt][e] = __builtin_amdgcn_sqrtf(fmaxf(__builtin_fmaf(-a, a, 1.0f), 0.f)) * gi * xc[e]; } } }
        }
        __syncthreads();
#pragma unroll
        for (int tt = 0; tt < 8; ++tt) { const int tok = 16 * tt + l15;
            *(LAS f32x4*)(LA + tok * 132 + 16 * w + 4 * g4) = ca[tt];
            *(LAS u32x2*)(LB + tok * TP + (16 * w + 4 * g4) * 2) = (u32x2){cvt_pk_bf16(ci[tt][0], ci[tt][1]), cvt_pk_bf16(ci[tt][2], ci[tt][3])}; }
        __syncthreads();
        { const int un = u + p.G; if (un < 129 * 10) { C2_LOADX(un, 0, xv0); } }
        const int ch = tid & 127, q = tid >> 7, chg = n * 128 + ch;
        {
        if (T < 128) {
            float P_ = 1.f, H_ = 0.f;
#pragma unroll 4
            for (int t = 32 * q; t < 32 * q + 32; ++t) { const float a = LA[t * 132 + ch], b = bf2f(*(const LAS bf16*)(LB + t * TP + ch * 2)); H_ = a * H_ + b; P_ *= a; }
            QT[(q * 128 + ch) * 2] = P_; QT[(q * 128 + ch) * 2 + 1] = H_;
            __syncthreads();
            float h = 0.f, pc = 1.f;
#pragma unroll
            for (int qq = 0; qq < 3; ++qq) if (qq < q) { const float Pq = QT[(qq * 128 + ch) * 2], Hq = QT[(qq * 128 + ch) * 2 + 1]; h = Pq * h + Hq; pc *= Pq; }
#pragma unroll 4
            for (int t = 32 * q; t < 32 * q + 32; ++t) { const float a = LA[t * 132 + ch], b = bf2f(*(const LAS bf16*)(LB + t * TP + ch * 2)); h = a * h + b; pc *= a;
                LA[t * 132 + ch] = pc; *(LAS bf16*)(LB + t * TP + ch * 2) = (bf16)f2bf(h); }
            if (q == 3) { AGG[((size_t)T * 2) * 1280 + chg] = pc; AGG[((size_t)T * 2 + 1) * 1280 + chg] = h; }
        } else {
            for (int bb = 8 * q; bb < 8 * q + 8; ++bb) { float h = h0s[(size_t)bb * 1280 + chg];
#pragma unroll
                for (int i = 0; i < 4; ++i) { const int t = 4 * bb + i; const float a = LA[t * 132 + ch], b = bf2f(*(const LAS bf16*)(LB + t * TP + ch * 2)); h = a * h + b;
                    LA[t * 132 + ch] = 0.f; *(LAS bf16*)(LB + t * TP + ch * 2) = (bf16)f2bf(h); }
                if (out_hs) out_hs[(size_t)bb * 1280 + chg] = h; }
        }
        }
        __syncthreads();
#pragma unroll
        for (int i = 0; i < 4; ++i) { const int cidx = tid + 512 * i, tok = cidx >> 4, c8 = (cidx & 15) * 8; const size_t o = (size_t)(row0 + tok) * 1280 + n * 128 + c8;
            *(u32x4*)(LH + o) = *(const LAS u32x4*)(LB + tok * TP + c8 * 2);
            *(u32x4*)(CPB + o) = pack8(*(const LAS f32x4*)(LA + tok * 132 + c8), *(const LAS f32x4*)(LA + tok * 132 + c8 + 4)); }
        __syncthreads();
    }
#undef C2_LOADW
#undef C2_LOADG
#undef C2_LOADX
#undef C2_CONV
}
__device__ __forceinline__ void c5_fixup(const P& p, float* out_hp) {
    const bf16* LH = p.w<bf16>(WS_AA); const bf16* CPB = p.w<bf16>(WS_BB); const float* AGG = p.w<float>(WS_AGG); const bf16* GATE = p.w<bf16>(WS_GATE); bf16* GH = p.w<bf16>(WS_GH);
    LAS float* cr = (LAS float*)p.lds;
    const int tid = p.tid;
    for (int ci = p.bid * 512 + tid; ci < 128 * 160; ci += p.G * 512) { const size_t o = (size_t)MP * 1280 + (size_t)ci * 8;
        const u32x4 lh = *(const u32x4*)(LH + o), gt = *(const u32x4*)(GATE + o); f32x4 r0, r1;
        r0[0] = bflo(gt.x) * bflo(lh.x); r0[1] = bfhi(gt.x) * bfhi(lh.x); r0[2] = bflo(gt.y) * bflo(lh.y); r0[3] = bfhi(gt.y) * bfhi(lh.y);
        r1[0] = bflo(gt.z) * bflo(lh.z); r1[1] = bfhi(gt.z) * bfhi(lh.z); r1[2] = bflo(gt.w) * bflo(lh.w); r1[3] = bfhi(gt.w) * bfhi(lh.w);
        *(u32x4*)(GH + o) = pack8(r0, r1); }
    for (int it = p.bid; it < 256; it += p.G) {
        const int T = it >> 1, hf = it & 1, row0 = T * 128 + 64 * hf, T0 = T & ~15, nd = T - T0;
        const size_t ob = (size_t)row0 * 1280 + (size_t)tid * 8;
#define C5_LOAD(LHV, CPV, GTV, K) do { _Pragma("unroll") for (int i = 0; i < 5; ++i) { const size_t o = ob + (size_t)(5 * (K) + i) * 4096; \
            LHV[i] = *(const u32x4*)(LH + o); CPV[i] = *(const u32x4*)(CPB + o); GTV[i] = *(const u32x4*)(GATE + o); } } while (0)
        u32x4 lhA[5], cpA[5], gtA[5], lhB[5], cpB[5], gtB[5];
        C5_LOAD(lhA, cpA, gtA, 0);
        for (int ch = tid; ch < 1280; ch += 512) {
            float pa[16], ha[16];
#pragma unroll
            for (int d = 0; d < 16; ++d) { pa[d] = AGG[((size_t)(T0 + d) * 2) * 1280 + ch]; ha[d] = AGG[((size_t)(T0 + d) * 2 + 1) * 1280 + ch]; }
            float c = 0.f;
#pragma unroll
            for (int d = 0; d < 15; ++d) c = (d < nd) ? pa[d] * c + ha[d] : c;
            if (nd == 15 && hf == 1 && out_hp) out_hp[(size_t)(T >> 4) * 1280 + ch] = pa[15] * c + ha[15];
            cr[ch] = c; }
        __syncthreads();
#define C5_ITEM(LHV, CPV, GTV, I) do { const int c8 = ((tid + 512 * (I)) % 160) * 8; const size_t o = ob + (size_t)(I) * 4096; \
            const f32x4 c0 = *(const LAS f32x4*)(cr + c8), c1 = *(const LAS f32x4*)(cr + c8 + 4); f32x4 r0, r1; \
            r0[0] = bflo(GTV.x) * (bflo(LHV.x) + bflo(CPV.x) * c0[0]); r0[1] = bfhi(GTV.x) * (bfhi(LHV.x) + bfhi(CPV.x) * c0[1]); \
            r0[2] = bflo(GTV.y) * (bflo(LHV.y) + bflo(CPV.y) * c0[2]); r0[3] = bfhi(GTV.y) * (bfhi(LHV.y) + bfhi(CPV.y) * c0[3]); \
            r1[0] = bflo(GTV.z) * (bflo(LHV.z) + bflo(CPV.z) * c1[0]); r1[1] = bfhi(GTV.z) * (bfhi(LHV.z) + bfhi(CPV.z) * c1[1]); \
            r1[2] = bflo(GTV.w) * (bflo(LHV.w) + bflo(CPV.w) * c1[2]); r1[3] = bfhi(GTV.w) * (bfhi(LHV.w) + bfhi(CPV.w) * c1[3]); \
            *(u32x4*)(GH + o) = pack8(r0, r1); } while (0)
        C5_LOAD(lhB, cpB, gtB, 1);
#pragma unroll
        for (int i = 0; i < 5; ++i) C5_ITEM(lhA[i], cpA[i], gtA[i], i);
        C5_LOAD(lhA, cpA, gtA, 2);
#pragma unroll
        for (int i = 0; i < 5; ++i) C5_ITEM(lhB[i], cpB[i], gtB[i], 5 + i);
        C5_LOAD(lhB, cpB, gtB, 3);
#pragma unroll
        for (int i = 0; i < 5; ++i) C5_ITEM(lhA[i], cpA[i], gtA[i], 10 + i);
#pragma unroll
        for (int i = 0; i < 5; ++i) C5_ITEM(lhB[i], cpB[i], gtB[i], 15 + i);
#undef C5_LOAD
#undef C5_ITEM
        __syncthreads();
    }
}
__device__ __forceinline__ void final_norm(const P& p, float* out_yp, float* out_ys) {
    const bf16* HB = p.w<bf16>(WS_HB); const long long* ssq = p.stat(ST_SSQ0 + 8); const float* g = p.in[8];
    const int gw = p.bid * NWAVES + p.wave, NGW = p.G * NWAVES, lane = p.lane;
    f32x4 gv[4];
#pragma unroll
    for (int jj = 0; jj < 4; ++jj) gv[jj] = *(const f32x4*)(g + 4 * lane + 256 * jj);
    u32x2 hw[4], hn[4]; long long sq = 0, sn = 0;
    if (gw < MT) { sq = ssq[gw];
#pragma unroll
        for (int jj = 0; jj < 4; ++jj) hw[jj] = *(const u32x2*)(HB + (size_t)gw * 1024 + 4 * lane + 256 * jj); }
    for (int m = gw; m < MT; m += NGW) { float* o = m < MP ? out_yp + (size_t)m * 1024 : out_ys + (size_t)(m - MP) * 1024;
        const int mn = (m + NGW < MT) ? m + NGW : m; sn = ssq[mn];
#pragma unroll
        for (int jj = 0; jj < 4; ++jj) hn[jj] = *(const u32x2*)(HB + (size_t)mn * 1024 + 4 * lane + 256 * jj);
        const float rs = rsqrtf((float)sq * ST_INV * (1.0f / 1024.0f) + RMS_EPS);
#pragma unroll
        for (int jj = 0; jj < 4; ++jj) *(f32x4*)(o + 4 * lane + 256 * jj) = (f32x4){bflo(hw[jj].x), bfhi(hw[jj].x), bflo(hw[jj].y), bfhi(hw[jj].y)} * rs * gv[jj];
#pragma unroll
        for (int jj = 0; jj < 4; ++jj) hw[jj] = hn[jj];
        sq = sn; }
}
}
namespace mk {
struct Args { const float* in[36]; float* out; unsigned char* ws; int ph_lo, ph_hi, li, mask; };
constexpr int NPHASE = 34;

#define MK_GEMM(EpiT, E, Aptr, LDA, Bptr, LDB, KD, NC) do { pg8::Gemm g_{(const pg8::bf16_t*)(Aptr), (const pg8::bf16_t*)(Bptr), (LDA), (LDB), (KD)}; pg8::StaticOrder S_; S_.init(MP, (NC), p.G, p.bid); \
        pg8::gemm_phase<EpiT, pg8::StaticOrder, true, true>(p.lds, g_, S_, E, p.tid); \
          \
        P q_ = p; { int t2_ = p0.tid; asm volatile("" : "+v"(t2_)); q_.tid = t2_; q_.lane = t2_ & 63; q_.wave = __builtin_amdgcn_readfirstlane(t2_ >> 6); } \
        mini_gemm<EpiT>(q_, (const bf16*)(Aptr), (LDA), (const bf16*)(Bptr), (LDB), (KD), (NC), E, (64 * ((NC) / 256)) % p.G); } while (0)

#ifdef MK_DRYPROBE
#define MK_DRYARG , ((mask >> 10) & 1)
#else
#define MK_DRYARG
#endif
#ifndef MK_REP_SEL
#define MK_REP_SEL(k) 0
#define MK_REP_N 1
#endif
#define REPF(k) for (int rep_ = 0; rep_ < (MK_REP_SEL(k) ? MK_REP_N : 1); ++rep_)
#define IN_(k) (lo <= (k) && (k) < hi)
#define PH_BEGIN() P p = p0; { int z_ = 0, t_ = p0.tid, g_ = p0.G, b_ = p0.bid; unsigned l_ = (unsigned)(size_t)p0.lds; asm volatile("" : "+s"(z_), "+v"(t_), "+s"(g_), "+s"(b_), "+s"(l_)); p.ws = p0.ws + z_; p.out = p0.out + z_; p.tid = t_; p.lane = t_ & 63; p.wave = __builtin_amdgcn_readfirstlane(t_ >> 6); p.G = g_; p.bid = b_; p.lds = (LAS unsigned char*)(size_t)l_; } float* const out = p.out; (void)out
#ifdef MK_PROF
#define STAMP(k) do { if (p0.bid == 0 && p0.tid == 0) ((unsigned long long*)(p0.ws + WS_PROF))[(k)] = (unsigned long long)wall_clock64(); } while (0)
#else
#define STAMP(k) do { } while (0)
#endif
#define ENDPH(k) do { if ((k) + 1 < hi) xcd_barrier(bar); STAMP((k) + 1); } while (0)
template <int LAYER> __device__ __forceinline__ void run_layer(const P& p0, const XcdBarrier& bar, const int lo, const int hi, const int mask) {
        constexpr int layer = LAYER, kind = layer % 3, j = layer / 3, pb = 1 + 8 * layer;
        constexpr size_t resA = kind == 0 ? WS_UM : kind == 1 ? WS_OB : WS_GH, resB = kind == 0 ? WS_WOUT + (size_t)j * 2 * MiB : kind == 1 ? WS_WOV : WS_WCO; constexpr int resK = kind == 0 ? 1024 : kind == 1 ? 2048 : 1280;
        if constexpr (kind == 0) {
            if (IN_(pb)) REPF(pb) { PH_BEGIN(); EpiA1 E{p.w<bf16>(WS_U), p.w<bf16>(WS_GV), p.stat(ST_SSQ0 + 2 * layer), p.stat(ST_LNS0 + 2 * j), p.stat(ST_LNQ0 + 2 * j) MK_DRYARG};
                MK_GEMM(EpiA1, E, p.w<bf16>(WS_HB), 1024, p.w<bf16>(WS_WIN + (size_t)j * 4 * MiB), 1024, 1024, 2048); ENDPH(pb); }
            if (IN_(pb + 1)) REPF(pb + 1) { PH_BEGIN(); a2_spatial(p, j, out + O_CV + (size_t)j * 131072); ENDPH(pb + 1); }
        } else if constexpr (kind == 1) {
            if (IN_(pb)) REPF(pb) { PH_BEGIN(); EpiB1 E{p.w<float>(WS_RAW), p.w<bf16>(WS_CQB), p.stat(ST_SSQ0 + 2 * layer), p.stat(ST_KV), p.stat(ST_Q) MK_DRYARG};
                MK_GEMM(EpiB1, E, p.w<bf16>(WS_HB), 1024, p.w<bf16>(WS_WDQKV), 1024, 1024, 768); ENDPH(pb); }
            if (IN_(pb + 1)) REPF(pb + 1) { PH_BEGIN(); b2_kvfinal(p, out + O_MP, out + O_MS);
                EpiB2 E{p.w<bf16>(WS_QF), p.stat(ST_Q), p.w<f32x2>(WS_ROPE)};
                MK_GEMM(EpiB2, E, p.w<bf16>(WS_CQB), 384, p.w<bf16>(WS_WQ), 384, 384, 2560); ENDPH(pb + 1); }
            if (IN_(pb + 2)) REPF(pb + 2) { PH_BEGIN();
                if (mask & 256) b3_attn_prompt(p); if (mask & 512) b3_attn_sample(p);
                ENDPH(pb + 2); }
            if (IN_(pb + 3)) REPF(pb + 3) { PH_BEGIN(); b3_combine(p); ENDPH(pb + 3); }
        } else {
            if (IN_(pb)) REPF(pb) { PH_BEGIN(); EpiC1 E{p.w<bf16>(WS_GATE), p.w<float>(WS_XW), p.stat(ST_SSQ0 + 2 * layer)};
                MK_GEMM(EpiC1, E, p.w<bf16>(WS_HB), 1024, p.w<bf16>(WS_WGX), 1024, 1024, 2560); ENDPH(pb); }
            if (IN_(pb + 1)) REPF(pb + 1) { PH_BEGIN(); c2_rglru(p, j, out + O_CP, out + O_CS, out + O_HS, mask); ENDPH(pb + 1); }
            if (IN_(pb + 3)) REPF(pb + 3) { PH_BEGIN(); c5_fixup(p, out + O_HP); ENDPH(pb + 3); }
        }
        if (IN_(pb + 5)) REPF(pb + 5) { PH_BEGIN(); EpiRes E{p.w<bf16>(WS_HB), p.stat(ST_SSQ0 + 2 * layer + 1) MK_DRYARG}; MK_GEMM(EpiRes, E, p.w<bf16>(resA), resK, p.w<bf16>(resB), resK, resK, 1024); ENDPH(pb + 5); }
        if (IN_(pb + 6)) REPF(pb + 6) { PH_BEGIN(); EpiF1 E{p.w<bf16>(WS_ACT), p.stat(ST_SSQ0 + 2 * layer + 1)}; MK_GEMM(EpiF1, E, p.w<bf16>(WS_HB), 1024, p.w<bf16>(WS_WGU + (size_t)layer * WGU_BYTES), 1024, 1024, 5632); ENDPH(pb + 6); }
        if (IN_(pb + 7)) REPF(pb + 7) { PH_BEGIN(); EpiRes E{p.w<bf16>(WS_HB), p.stat(ST_SSQ0 + 2 * layer + 2) MK_DRYARG}; MK_GEMM(EpiRes, E, p.w<bf16>(WS_ACT), DFF, p.w<bf16>(WS_WD + (size_t)layer * WD_BYTES), DFF, DFF, 1024); ENDPH(pb + 7); }
}
__global__ void __launch_bounds__(NWAVES * 64, 2) mk_fwd(Args a) {
    extern __shared__ __attribute__((aligned(16))) unsigned char lds_raw[];
    const int tid_ = threadIdx.x;
    const P p0{InTab{(const float* const __attribute__((address_space(4)))*)__builtin_amdgcn_kernarg_segment_ptr()}, a.out, a.ws, (LAS unsigned char*)lds_raw, tid_, tid_ & 63, __builtin_amdgcn_readfirstlane(tid_ >> 6), (int)gridDim.x, (int)blockIdx.x};
    volatile LAS unsigned* MISC = (volatile LAS unsigned*)(p0.lds + MISC_OFF);
    if (p0.tid < 64) MISC[p0.tid] = 0u;
    __syncthreads();
    XcdBarrier bar = xcd_barrier_post((unsigned*)(a.ws + WS_CTL) + CW_BAR + a.li * XCD_BAR_WORDS, MISC + 8);
    const int lo = a.ph_lo, hi = a.ph_hi, mask = a.mask;
    STAMP(0);
    if (IN_(0)) REPF(0) { PH_BEGIN(); p0_prologue(p, mask); if (mask & 128)
        { const int gt = p.bid * 512 + p.tid, NGT = p.G * 512; const u32x4 z = (u32x4){0u, 0u, 0u, 0u};
          for (int i = gt; i < 128 * 128; i += NGT) p.w<u32x4>(WS_UM + (size_t)MT * 2048)[i] = z;
          for (int i = gt; i < 128 * 256; i += NGT) p.w<u32x4>(WS_OB + (size_t)MT * 4096)[i] = z;
          for (int i = gt; i < 128 * 160; i += NGT) p.w<u32x4>(WS_GH + (size_t)MT * 2560)[i] = z; }
        ENDPH(0); }
    run_layer<0>(p0, bar, lo, hi, mask); run_layer<1>(p0, bar, lo, hi, mask); run_layer<2>(p0, bar, lo, hi, mask); run_layer<3>(p0, bar, lo, hi, mask);
    if (IN_(33)) REPF(33) { PH_BEGIN(); final_norm(p, out + O_YP, out + O_YS); VM_WAIT(); STAMP(34); }
#undef IN_
#undef ENDPH
}

inline void fill_args(Args& a, void* const* d_in, float* out, void* d_ws) { for (int i = 0; i < 36; ++i) a.in[i] = (const float*)d_in[i]; a.out = out; a.ws = (unsigned char*)d_ws; a.mask = -1; }
inline int setup_grid() {
    static int grid = 0;
    if (!grid) { int dev = 0, cus = 0; hipGetDevice(&dev); hipDeviceGetAttribute(&cus, hipDeviceAttributeMultiprocessorCount, dev);
        hipFuncSetAttribute((const void*)mk_fwd, hipFuncAttributeMaxDynamicSharedMemorySize, LDS_BYTES);
        int per_cu = 0; hipOccupancyMaxActiveBlocksPerMultiprocessor(&per_cu, (const void*)mk_fwd, NWAVES * 64, LDS_BYTES); (void)hipGetLastError();
        grid = cus > 0 ? cus : 256; }
    return grid;
}
inline void launch_range(void* const* d_in, float* out, void* d_ws, hipStream_t st, int lo, int hi, int li, int mask = -1) {
    Args a{}; fill_args(a, d_in, out, d_ws); a.ph_lo = lo; a.ph_hi = hi; a.li = li; a.mask = mask;
    hipLaunchKernelGGL(mk_fwd, dim3(setup_grid()), dim3(NWAVES * 64), LDS_BYTES, st, a);
}
}

extern "C" void kernel_launch(void* const* d_in, const int* in_sizes, int n_in, void* d_out, int out_size, void* d_ws, size_t ws_size, hipStream_t stream) {
    hipMemsetAsync(d_ws, 0, mk::CTL_BYTES, stream);
    mk::launch_range(d_in, (float*)d_out, d_ws, stream, 0, mk::NPHASE, 0);
}
```

```cpp
#include <hip/hip_runtime.h>
#include <math.h>
#define LAS __attribute__((address_space(3)))
#define GAS __attribute__((address_space(1)))
namespace pg8 {
#define PG8_LAS __attribute__((address_space(3)))
typedef unsigned short bf16_t;
typedef short bf16x8 __attribute__((ext_vector_type(8)));
typedef float f32x4 __attribute__((ext_vector_type(4)));
typedef unsigned u32x4 __attribute__((ext_vector_type(4)));
constexpr int BM = 256, BK = 64, HALF = 128, HTB = HALF * BK * 2  , STAGE_BYTES = 8 * HTB, NXCD = 8, WGM = 8;
__host__ __device__ __forceinline__ int lds_byte(int r, int c) { const int st = (r >> 4) * 2 + (c >> 5), rr = r & 15, cc = c & 31, ob = rr * 64 + cc * 2; return st * 1024 + (ob ^ (((ob >> 9) & 1) << 5)); }
__host__ __device__ __forceinline__ void stage_rc(int b, int& R, int& C) { const int st = b / 1024, sb = b % 1024, swz = sb ^ (((sb >> 9) & 1) << 5); R = (st >> 1) * 16 + swz / 64; C = (st & 1) * 32 + (swz % 64) / 2; }
__host__ __device__ __forceinline__ int perm32(int rho) { const int n = rho >> 4, i = rho & 15; return 8 * (i >> 2) + 4 * n + (i & 3); }
struct Unit { int pm, pn; };
struct Gemm { const bf16_t* A; const bf16_t* Bt; int lda, ldb, K; };
struct StaticOrder {
    int nM, nN, nwg, G, c;
    __host__ __device__ void init(int M, int N, int G_, int c_) { nM = M / BM; nN = N / BM; nwg = nM * nN; G = G_; c = c_; }
    __host__ __device__ bool next(int i, Unit& u) const {
        const long L = (long)i * G + c; if (L >= nwg) return false;
        int wgid = (int)L; { const int q = nwg / NXCD, r = nwg % NXCD, xcd = wgid % NXCD, off = wgid / NXCD; wgid = (xcd < r ? xcd * (q + 1) : r * (q + 1) + (xcd - r) * q) + off; }
        const int nig = WGM * nN, gid = wgid / nig, fm = gid * WGM, gsz = (nM - fm) < WGM ? (nM - fm) : WGM;
        u.pm = fm + ((wgid % nig) % gsz); u.pn = (wgid % nig) / gsz; return true;
    }
    __device__ __forceinline__ void a_ready(const Unit&) const {}
    __device__ __forceinline__ void done(const Unit&) const {}
};
__device__ __forceinline__ unsigned cvt_pk_bf16(float lo, float hi) { unsigned r; asm volatile("v_cvt_pk_bf16_f32 %0, %1, %2" : "=v"(r) : "v"(lo), "v"(hi)); return r; }
template <class Epi, class Sched, bool ALIGN_EPI = false, bool SP2 = false>
__device__ __forceinline__ void gemm_phase(PG8_LAS unsigned char* lds, const Gemm g, const Sched& S, const Epi& E, const int tid) {
    const int wid = __builtin_amdgcn_readfirstlane(tid >> 6), lane = tid & 63, wr = wid >> 2, wc = wid & 3, fr = lane & 15, fq = lane >> 4;
    const int K = g.K, nt = K / BK, lda = g.lda, ldb = g.ldb;
    unsigned voffA[2], voffB[2];
#pragma unroll
    for (int i = 0; i < 2; ++i) { int R, C; stage_rc(tid * 16 + i * 8192, R, C); const int Rb = Epi::PERM ? ((R & ~31) + perm32(R & 31)) : R;
        voffA[i] = (unsigned)(R * lda + C) * 2u; voffB[i] = (unsigned)(Rb * ldb + C) * 2u; }
    const size_t kstep = (size_t)(BK * 2);
    const size_t hstepA = (size_t)HALF * lda * 2, hstepB = (size_t)HALF * ldb * 2;
    const size_t tstepA = 2 * hstepA, tstepB = 2 * hstepB;
    const unsigned ldsw = (unsigned)wid * 1024u;
    const int aoff = lds_byte(wr * 64 + fr, fq * 8), boff = lds_byte(wc * 32 + fr, fq * 8);
#define PG8_SA(b, h) (((b) * 2 + (h)) * HTB)
#define PG8_SB(b, h) ((4 + (b) * 2 + (h)) * HTB)
#define PG8_STAGE(bufoff, gbase, voff) do { _Pragma("unroll") for (int _i = 0; _i < 2; ++_i) \
        __builtin_amdgcn_global_load_lds((const unsigned*)((const char*)(gbase) + (voff)[_i]), (PG8_LAS unsigned*)(lds + (bufoff) + ldsw + _i * 8192), 16, 0, 0); } while (0)
#define PG8_LDA(dst, b, h) do { _Pragma("unroll") for (int m = 0; m < 4; ++m) _Pragma("unroll") for (int k = 0; k < 2; ++k) dst[m][k] = *(const PG8_LAS bf16x8*)(lds + PG8_SA(b, h) + aoff + m * 2048 + k * 1024); } while (0)
#define PG8_LDB(dst, b, h) do { _Pragma("unroll") for (int n = 0; n < 2; ++n) _Pragma("unroll") for (int k = 0; k < 2; ++k) dst[n][k] = *(const PG8_LAS bf16x8*)(lds + PG8_SB(b, h) + boff + n * 2048 + k * 1024); } while (0)
#define PG8_MMA(ai, bj, At, Bt) do { __builtin_amdgcn_s_setprio(1); _Pragma("unroll") for (int m = 0; m < 4; ++m) _Pragma("unroll") for (int n = 0; n < 2; ++n) _Pragma("unroll") for (int k = 0; k < 2; ++k) \
        acc[ai][bj][m][n] = __builtin_amdgcn_mfma_f32_16x16x32_bf16(Bt[n][k], At[m][k], acc[ai][bj][m][n], 0, 0, 0); __builtin_amdgcn_s_setprio(0); } while (0)
#define PG8_WAIT_V(n) asm volatile("s_waitcnt vmcnt(" #n ")" ::: "memory")
#define PG8_WAIT_L(n) asm volatile("s_waitcnt lgkmcnt(" #n ")" ::: "memory")
#define PG8_BAR __builtin_amdgcn_s_barrier()
#define PG8_SCHED __builtin_amdgcn_sched_barrier(0)
    Unit cur, nxt; int ui = 0;
    if (!S.next(0, cur)) return;
    f32x4 acc[2][2][4][2];
    E.init(acc, cur, wr, wc, fr, fq);
    bf16x8 At[4][2], B0[2][2], B1[2][2];
    const char* cA = (const char*)g.A + (size_t)cur.pm * tstepA; const char* cB = (const char*)g.Bt + (size_t)cur.pn * tstepB;
    S.a_ready(cur);
    if constexpr (SP2) {
        PG8_STAGE(PG8_SB(0, 0), cB, voffB); PG8_STAGE(PG8_SB(0, 1), cB + hstepB, voffB); PG8_STAGE(PG8_SA(0, 0), cA, voffA); PG8_STAGE(PG8_SA(0, 1), cA + hstepA, voffA);
        if (wr == 1) PG8_BAR;
        PG8_WAIT_V(2); PG8_BAR;
        PG8_STAGE(PG8_SB(1, 0), cB + kstep, voffB); PG8_STAGE(PG8_SA(1, 0), cA + kstep, voffA); PG8_STAGE(PG8_SB(1, 1), cB + hstepB + kstep, voffB);
        PG8_WAIT_V(6); PG8_BAR;
    } else {
        PG8_STAGE(PG8_SB(0, 0), cB, voffB); PG8_STAGE(PG8_SA(0, 0), cA, voffA); PG8_STAGE(PG8_SB(0, 1), cB + hstepB, voffB); PG8_STAGE(PG8_SA(0, 1), cA + hstepA, voffA);
        if (wr == 1) PG8_BAR;
        PG8_WAIT_V(4); PG8_BAR;
        PG8_STAGE(PG8_SB(1, 0), cB + kstep, voffB); PG8_STAGE(PG8_SA(1, 0), cA + kstep, voffA); PG8_STAGE(PG8_SB(1, 1), cB + hstepB + kstep, voffB);
        PG8_WAIT_V(6); PG8_BAR;
    }
    for (;;) {
        const bool has_next = S.next(ui + 1, nxt);
        const char* nA = has_next ? (const char*)g.A + (size_t)nxt.pm * tstepA : cA; const char* nB = has_next ? (const char*)g.Bt + (size_t)nxt.pn * tstepB : cB;
        for (int t = 0; t < nt; t += 2) {
            const bool last = (t == nt - 2);
            const char* a1 = cA + (size_t)(t + 1) * kstep;
            const char* a2 = last ? nA : cA + (size_t)(t + 2) * kstep; const char* b2 = last ? nB : cB + (size_t)(t + 2) * kstep;
            const char* a3 = a2 + kstep; const char* b3 = b2 + kstep;
            if (last && has_next) S.a_ready(nxt);
            if constexpr (SP2) {
            PG8_LDB(B0, 0, 0); PG8_LDB(B1, 0, 1); PG8_SCHED; PG8_LDA(At, 0, 0); PG8_STAGE(PG8_SA(1, 1), a1 + hstepA, voffA);
            PG8_WAIT_V(8); PG8_WAIT_L(0); PG8_BAR; PG8_MMA(0, 0, At, B0); PG8_MMA(0, 1, At, B1); PG8_BAR; PG8_SCHED;
            PG8_LDA(At, 0, 1); PG8_STAGE(PG8_SB(0, 0), b2, voffB); PG8_STAGE(PG8_SB(0, 1), b2 + hstepB, voffB); PG8_STAGE(PG8_SA(0, 0), a2, voffA);
            PG8_WAIT_V(8); PG8_WAIT_L(0); PG8_BAR; PG8_MMA(1, 0, At, B0); PG8_MMA(1, 1, At, B1); PG8_BAR; PG8_SCHED;
            PG8_LDB(B0, 1, 0); PG8_LDB(B1, 1, 1); PG8_SCHED; PG8_LDA(At, 1, 0); PG8_STAGE(PG8_SA(0, 1), a2 + hstepA, voffA);
            PG8_WAIT_V(8); PG8_WAIT_L(0); PG8_BAR; PG8_MMA(0, 0, At, B0); PG8_MMA(0, 1, At, B1); PG8_BAR; PG8_SCHED;
            PG8_LDA(At, 1, 1); PG8_STAGE(PG8_SB(1, 0), b3, voffB); PG8_STAGE(PG8_SB(1, 1), b3 + hstepB, voffB); PG8_STAGE(PG8_SA(1, 0), a3, voffA);
            PG8_WAIT_V(8); PG8_WAIT_L(0); PG8_BAR; PG8_MMA(1, 0, At, B0); PG8_MMA(1, 1, At, B1); PG8_BAR; PG8_SCHED;
            } else {
            PG8_LDB(B0, 0, 0); PG8_SCHED; PG8_LDA(At, 0, 0); PG8_STAGE(PG8_SA(1, 1), a1 + hstepA, voffA);
            PG8_WAIT_L(8); PG8_BAR; PG8_WAIT_L(0); PG8_MMA(0, 0, At, B0); PG8_BAR; PG8_SCHED;
            PG8_LDB(B1, 0, 1); PG8_STAGE(PG8_SB(0, 0), b2, voffB);
            PG8_BAR; PG8_WAIT_L(0); PG8_MMA(0, 1, At, B1); PG8_BAR;
            PG8_LDA(At, 0, 1); PG8_STAGE(PG8_SA(0, 0), a2, voffA);
            PG8_BAR; PG8_WAIT_L(0); PG8_MMA(1, 0, At, B0); PG8_BAR; PG8_SCHED;
            PG8_STAGE(PG8_SB(0, 1), b2 + hstepB, voffB);
            PG8_WAIT_V(6); PG8_BAR; PG8_MMA(1, 1, At, B1); PG8_BAR;
            PG8_LDB(B0, 1, 0); PG8_SCHED; PG8_LDA(At, 1, 0); PG8_STAGE(PG8_SA(0, 1), a2 + hstepA, voffA);
            PG8_WAIT_L(8); PG8_BAR; PG8_WAIT_L(0); PG8_MMA(0, 0, At, B0); PG8_BAR; PG8_SCHED;
            PG8_LDB(B1, 1, 1); PG8_STAGE(PG8_SB(1, 0), b3, voffB);
            PG8_BAR; PG8_WAIT_L(0); PG8_MMA(0, 1, At, B1); PG8_BAR;
            PG8_LDA(At, 1, 1); PG8_STAGE(PG8_SA(1, 0), a3, voffA);
            PG8_BAR; PG8_WAIT_L(0); PG8_MMA(1, 0, At, B0); PG8_BAR; PG8_SCHED;
            PG8_STAGE(PG8_SB(1, 1), b3 + hstepB, voffB);
            PG8_WAIT_V(6); PG8_BAR; PG8_MMA(1, 1, At, B1); PG8_BAR;
            }
        }
        if constexpr (ALIGN_EPI) { if (wr == 0) PG8_BAR; }
        if constexpr (!Epi::AFTER_DRAIN) { E(acc, cur, wr, wc, fr, fq); S.done(cur); }
        if (!has_next) break;
        E.init(acc, nxt, wr, wc, fr, fq);
        cur = nxt; cA = nA; cB = nB; ++ui;
        if constexpr (ALIGN_EPI) { if (wr == 1) PG8_BAR; }
    }
    PG8_WAIT_V(0);
    if constexpr (!ALIGN_EPI) { if (wr == 0) PG8_BAR; }
    PG8_BAR;
    if constexpr (Epi::AFTER_DRAIN) { E.fused(acc, cur, wr, wc, fr, fq, lds, wid, lane); S.done(cur); }
#undef PG8_SA
#undef PG8_SB
#undef PG8_STAGE
#undef PG8_LDA
#undef PG8_LDB
#undef PG8_MMA
#undef PG8_WAIT_V
#undef PG8_WAIT_L
#undef PG8_BAR
#undef PG8_SCHED
}

}

namespace mk {
using pg8::f32x4; using pg8::bf16x8; using pg8::u32x4; using pg8::cvt_pk_bf16;
typedef unsigned short bf16;
typedef unsigned u32x2 __attribute__((ext_vector_type(2)));
typedef short s16x4 __attribute__((ext_vector_type(4)));
typedef float f32x2 __attribute__((ext_vector_type(2)));
typedef GAS unsigned gu32;
#define RLX_AGENT __ATOMIC_RELAXED, __HIP_MEMORY_SCOPE_AGENT
#define XB_TMO      128
#define XB_XCNT(j)  (256  + 64 * (j))
#define XB_XSUB(j)  (1280 + 64 * (j))
#define XB_XGEN(j)  (2304 + 64 * (j))
#define XB_TOP      3328
#define XB_TOPGEN   3392
#define XCD_BAR_WORDS 3456
#define XB_SPIN_CAP (1u << 18)

__device__ __forceinline__ unsigned xb_ld(unsigned* p)              { return __hip_atomic_load(p, __ATOMIC_RELAXED, __HIP_MEMORY_SCOPE_AGENT); }
__device__ __forceinline__ unsigned xb_add(unsigned* p, unsigned v) { return __hip_atomic_fetch_add(p, v, __ATOMIC_RELAXED, __HIP_MEMORY_SCOPE_AGENT); }
__device__ __forceinline__ unsigned xb_xcc_id() { return (unsigned)__builtin_amdgcn_s_getreg((3 << 11) | 20) & 0xFu; }
#define XB_SPIN(cond, bar) do { unsigned _sp = 0; while (cond) { __builtin_amdgcn_s_sleep(1); \
    if ((++_sp & 255u) == 0u) { if (xb_ld(&(bar)[XB_TMO])) break; if (_sp > XB_SPIN_CAP) { atomicAdd(&(bar)[XB_TMO], 1u); break; } } } } while (0)

struct XcdBarrier {
    unsigned* bar; unsigned x;
    volatile LAS unsigned* st;
};

__device__ __forceinline__ XcdBarrier xcd_barrier_post(unsigned* bar, volatile LAS unsigned* st) {
    XcdBarrier b; b.bar = bar; b.x = xb_xcc_id(); b.st = st;
    if (threadIdx.x == 0) (void)xb_add(&bar[XB_XCNT(b.x)], 1u);
    return b;
}
__device__ __forceinline__ void xcd_barrier_complete(unsigned* bar, unsigned x, unsigned& nloc, unsigned& nx) {
    const unsigned G = gridDim.x * gridDim.y * gridDim.z;
    unsigned sum, cnt, mine, sp = 0u;
    for (;;) {
        sum = 0u; cnt = 0u; mine = 0u;
#pragma unroll
        for (unsigned j = 0; j < 16; ++j) { const unsigned c = xb_ld(&bar[XB_XCNT(j)]); sum += c; cnt += (c > 0u) ? 1u : 0u; mine = (j == x) ? c : mine; }
        if (sum == G) break;
        __builtin_amdgcn_s_sleep(1);
        if ((++sp & 255u) == 0u) { if (xb_ld(&bar[XB_TMO])) break; if (sp > XB_SPIN_CAP) { atomicAdd(&bar[XB_TMO], 1u); break; } }
    }
    nloc = mine > 0u ? mine : 1u; nx = cnt > 0u ? cnt : 1u;
}

__device__ __forceinline__ void xcd_barrier(const XcdBarrier& b) {
    asm volatile("s_waitcnt vmcnt(0)" ::: "memory");
    __syncthreads();
    if (threadIdx.x == 0) {
        unsigned* bar = b.bar;
        __builtin_amdgcn_s_waitcnt(0);
        unsigned nloc = b.st[0], nx = b.st[1];
        if (nloc == 0u) { xcd_barrier_complete(bar, b.x, nloc, nx); b.st[0] = nloc; b.st[1] = nx; }
        const unsigned old = xb_add(&bar[XB_XSUB(b.x)], 1u);
        const unsigned gen = old / nloc;
        if (old + 1u == (gen + 1u) * nloc) {
            __builtin_amdgcn_fence(__ATOMIC_RELEASE, "agent");
            asm volatile("s_waitcnt vmcnt(0)" ::: "memory");
            const unsigned og = xb_add(&bar[XB_TOP], 1u);
            const unsigned tg = og / nx;
            if (og + 1u == (tg + 1u) * nx) xb_add(&bar[XB_TOPGEN], 1u);
            else XB_SPIN(xb_ld(&bar[XB_TOPGEN]) == tg, bar);
            __builtin_amdgcn_fence(__ATOMIC_ACQUIRE, "agent");
            xb_add(&bar[XB_XGEN(b.x)], 1u);
            asm volatile("s_waitcnt vmcnt(0)" ::: "memory");
        } else {
            XB_SPIN(xb_ld(&bar[XB_XGEN(b.x)]) == gen, bar);
            __builtin_amdgcn_fence(__ATOMIC_ACQUIRE, "agent");
            asm volatile("s_waitcnt vmcnt(0)" ::: "memory");
        }
    }
    __syncthreads();
}


constexpr int MP = 16384, MS = 128, MT = MP + MS, MR = 16640;
constexpr int D = 1024, DFF = 2816, NWAVES = 8;
constexpr float RMS_EPS = 1e-6f, LN_EPS = 1e-5f;
constexpr float MLA_SCALE = 0.07216878364870322f;
constexpr size_t MiB = 1u << 20;
constexpr size_t WS_CTL = 0, CTL_BYTES = 3 * MiB;
constexpr int CW_BAR = 4096;
constexpr size_t ST_OFF = 65536, ST_STRIDE = (size_t)MR * 8;
constexpr int ST_SSQ0 = 0  , ST_LNS0 = 9, ST_LNQ0 = 10  , ST_KV = 13, ST_Q = 14, NSTAT = 15;
static_assert(ST_OFF + NSTAT * ST_STRIDE <= CTL_BYTES, "stats inside CTL");
constexpr size_t WS_WGU = 3 * MiB, WGU_BYTES = 11 * MiB, WS_WD = 47 * MiB, WD_BYTES = 5767168, WS_WIN = 69 * MiB, WS_WOUT = 77 * MiB, WS_WS = 81 * MiB,
                 WS_WDQKV = 82 * MiB, WS_WQ = 84 * MiB, WS_WOV = 86 * MiB, WS_WGX = 90 * MiB, WS_WAT = 95 * MiB, WS_WIT = 95 * MiB + 512 * 1024, WS_WCO = 96 * MiB, WS_ROPE = 99 * MiB;
constexpr size_t WS_H = 100 * MiB, WS_HB = 165 * MiB, WS_U = 198 * MiB, WS_GV = 231 * MiB, WS_UM = 264 * MiB, WS_ACT = 297 * MiB, WS_RAW = 387 * MiB, WS_CQB = 436 * MiB,
                 WS_QF = 449 * MiB, WS_KVB = 531 * MiB, WS_OB = 542 * MiB, WS_PART = 607 * MiB, WS_PML = 623 * MiB, WS_GATE = 624 * MiB, WS_XW = 665 * MiB, WS_AA = 747 * MiB, WS_BB = 829 * MiB,
                 WS_AGG = 911 * MiB, WS_GH = 914 * MiB, WS_PROF = 955 * MiB, WS_MK_END = 956 * MiB;
constexpr int RING_BYTES = 131072, LDS_BYTES = 147456, MISC_OFF = LDS_BYTES - 256;
constexpr size_t O_YP = 0, O_YS = 16777216, O_CV = 16908288, O_MP = 17170432, O_MS = 22413312, O_HP = 22454272, O_HS = 22464512, O_CP = 22505472, O_CS = 22536192, O_END = 22659072;

__device__ __forceinline__ float fast_sigmoid_l2(float t) { return __builtin_amdgcn_rcpf(1.0f + __builtin_amdgcn_exp2f(-t)); }
__device__ __forceinline__ float gelu_tanh_f(float x) { return x * fast_sigmoid_l2(2.302208198f * (x + 0.044715f * x * x * x)); }
__device__ __forceinline__ float silu_f(float x) { return x * fast_sigmoid_l2(1.4426950409f * x); }
__device__ __forceinline__ unsigned f2bf(float f) { unsigned u = __builtin_bit_cast(unsigned, f); return (u + 0x7fffu + ((u >> 16) & 1u)) >> 16; }
__device__ __forceinline__ unsigned pk2(float lo, float hi) { return f2bf(lo) | (f2bf(hi) << 16); }
__device__ __forceinline__ float bf2f(unsigned short b) { return __builtin_bit_cast(float, (unsigned)b << 16); }
__device__ __forceinline__ float bflo(unsigned w) { return __builtin_bit_cast(float, w << 16); }
__device__ __forceinline__ float bfhi(unsigned w) { return __builtin_bit_cast(float, w & 0xffff0000u); }
constexpr float ST_SCALE = 16777216.0f, ST_INV = 1.0f / 16777216.0f;
__device__ __forceinline__ void stat_add(long long* p, float v) { atomicAdd((unsigned long long*)p, (unsigned long long)(long long)__float2ll_rn(v * ST_SCALE)); }
__device__ __forceinline__ void stat_set(long long* p, float v) { *p = (long long)__float2ll_rn(v * ST_SCALE); }
__device__ __forceinline__ float stat_get(const long long* p) { return (float)(*p) * ST_INV; }
#define LDS_WAIT() asm volatile("s_waitcnt lgkmcnt(0)" ::: "memory")
#define VM_WAIT() asm volatile("s_waitcnt vmcnt(0)" ::: "memory")

struct InTab { const float* const __attribute__((address_space(4)))* t; __device__ __forceinline__ const float* operator[](int i) const { return t[i]; } };
struct P {
    InTab in; float* out; unsigned char* ws;
    LAS unsigned char* lds; int tid, lane, wave, G, bid;
    __device__ __forceinline__ long long* stat(int a) const { return (long long*)(ws + ST_OFF + (size_t)a * ST_STRIDE); }
    template <class T> __device__ __forceinline__ T* w(size_t off) const { return (T*)(ws + off); }
};
}
namespace mk {
struct TrJob { const float* src; int ldsrc, K, N; bf16* dst; int lddst; const float* gain; int kind, off; };
__device__ __forceinline__ int tr_rowmap(int kind, int off, int n) { return kind == 1 ? ((n >> 7) * 256 + (n & 127) + off) : (off + n); }
__device__ __forceinline__ void tr_item(const TrJob& j, LAS float* scr, int item, int lane) {
    const int nblk = j.N / 32, kb = item / nblk, nb = item % nblk, k0 = 64 * kb, n0 = 32 * nb;
    const float* src = j.src + (size_t)(k0 + (lane >> 5)) * j.ldsrc + n0 + (lane & 31); const size_t rstep = (size_t)2 * j.ldsrc;
    float v[32];
#pragma unroll
    for (int i = 0; i < 32; ++i) v[i] = src[i * rstep];
    if (j.gain) { const float* gp = j.gain + k0 + (lane >> 5); float g[32];
#pragma unroll
        for (int i = 0; i < 32; ++i) g[i] = gp[2 * i];
#pragma unroll
        for (int i = 0; i < 32; ++i) v[i] *= g[i]; }
#pragma unroll
    for (int i = 0; i < 32; ++i) scr[(2 * i + (lane >> 5)) * 33 + (lane & 31)] = v[i];
    LDS_WAIT(); asm volatile("" ::: "memory");
    const int c = lane & 7;
#pragma unroll
    for (int jj = 0; jj < 4; ++jj) { const int n = (lane >> 3) + 8 * jj; const LAS float* s = scr + (8 * c) * 33 + n;
        u32x4 o; o.x = pk2(s[0], s[33]); o.y = pk2(s[66], s[99]); o.z = pk2(s[132], s[165]); o.w = pk2(s[198], s[231]);
        *(u32x4*)(j.dst + (size_t)tr_rowmap(j.kind, j.off, n0 + n) * j.lddst + k0 + 8 * c) = o; }
    LDS_WAIT(); asm volatile("" ::: "memory");
}
constexpr int NJOBS = 24;
__device__ __forceinline__ TrJob get_job(const P& p, int jid) {
    TrJob j; j.gain = nullptr; j.kind = 0; j.off = 0; j.src = nullptr; j.dst = nullptr; j.ldsrc = 0; j.K = 0; j.N = 0; j.lddst = 0;
    if (jid < 12) { const int l = jid / 3, t = jid % 3;
        if (t < 2) { j.src = p.in[33 + t] + (size_t)l * D * DFF; j.ldsrc = DFF; j.K = D; j.N = DFF; j.dst = p.w<bf16>(WS_WGU + l * WGU_BYTES); j.lddst = D; j.gain = p.in[7] + l * D; j.kind = 1; j.off = 128 * t; }
        else { j.src = p.in[35] + (size_t)l * DFF * D; j.ldsrc = D; j.K = DFF; j.N = D; j.dst = p.w<bf16>(WS_WD + l * WD_BYTES); j.lddst = DFF; }
    } else if (jid < 16) { const int a = (jid - 12) >> 1;
        if (((jid - 12) & 1) == 0) { j.src = p.in[9] + (size_t)a * D * 2048; j.ldsrc = 2048; j.K = D; j.N = 2048; j.dst = p.w<bf16>(WS_WIN + a * 4 * MiB); j.lddst = D; j.gain = p.in[6] + (3 * a) * D; }
        else { j.src = p.in[14] + (size_t)a * D * D; j.ldsrc = D; j.K = D; j.N = D; j.dst = p.w<bf16>(WS_WOUT + a * 2 * MiB); j.lddst = D; }
    } else if (jid == 16) { j.src = p.in[15]; j.ldsrc = 384; j.K = D; j.N = 384; j.dst = p.w<bf16>(WS_WDQKV); j.lddst = D; j.gain = p.in[6] + D; j.off = 256; }
    else if (jid == 17) { j.src = p.in[18]; j.ldsrc = 320; j.K = D; j.N = 256; j.dst = p.w<bf16>(WS_WDQKV); j.lddst = D; j.gain = p.in[6] + D; j.off = 0; }
    else if (jid == 18) { j.src = p.in[18] + 256; j.ldsrc = 320; j.K = D; j.N = 64; j.dst = p.w<bf16>(WS_WDQKV); j.lddst = D; j.gain = p.in[6] + D; j.off = 640; }
    else if (jid == 19) { j.src = p.in[24]; j.ldsrc = 1280; j.K = D; j.N = 1280; j.dst = p.w<bf16>(WS_WGX); j.lddst = D; j.gain = p.in[6] + 2 * D; j.off = 0; }
    else if (jid == 20) { j.src = p.in[23]; j.ldsrc = 1280; j.K = D; j.N = 1280; j.dst = p.w<bf16>(WS_WGX); j.lddst = D; j.gain = p.in[6] + 2 * D; j.off = 1280; }
    else if (jid == 21) { j.src = p.in[32]; j.ldsrc = D; j.K = 1280; j.N = D; j.dst = p.w<bf16>(WS_WCO); j.lddst = 1280; }
    else if (jid == 22) { j.src = p.in[27]; j.ldsrc = 128; j.K = 128; j.N = 128; j.dst = p.w<bf16>(WS_WAT); j.lddst = 128; j.kind = 2; }
    else { j.src = p.in[29]; j.ldsrc = 128; j.K = 128; j.N = 128; j.dst = p.w<bf16>(WS_WIT); j.lddst = 128; j.kind = 2; }
    return j;
}
__device__ __forceinline__ int job_items(const TrJob& j) { return j.kind == 2 ? 80 : (j.K / 64) * (j.N / 32); }

__device__ __forceinline__ void p0_prologue(const P& p, const int mask) {
    LAS float* scr = (LAS float*)(p.lds + p.wave * 16384);
    const int gw = p.bid * NWAVES + p.wave, NGW = p.G * NWAVES, lane = p.lane;
    const int gt = p.bid * (NWAVES * 64) + p.tid, NGT = p.G * NWAVES * 64;
    if (mask & 1) {
    {
        int base = 0;
        for (int jid = 0; jid < NJOBS; ++jid) {
            TrJob j = get_job(p, jid); const int nit = job_items(j);
            int first = (gw - base % NGW + NGW) % NGW;
            for (int it = first; it < nit; it += NGW) {
                if (j.kind == 2) { TrJob b = j; const int blk = it >> 3; b.src = j.src + (size_t)blk * 16384; b.dst = j.dst + (size_t)blk * 16384; b.kind = 0; tr_item(b, scr, it & 7, lane); }
                else tr_item(j, scr, it, lane);
            }
            base += nit;
        }
    }
    }
    if (mask & 2) {
    { u32x4* z = (u32x4*)(p.w<bf16>(WS_WDQKV) + (size_t)704 * D); for (int i = gt; i < 64 * D / 8; i += NGT) z[i] = (u32x4){0u, 0u, 0u, 0u}; }
    }
    if (mask & 4) {
    for (int i = gt; i < 2 * 8 * 128 * 16; i += NGT) {
        const int s0 = (i & 15) * 8, t = (i >> 4) & 127, jg = i >> 11; const float* src = p.in[12] + (size_t)jg * 16384 + t * 128 + s0;
        const f32x4 v0 = *(const f32x4*)src, v1 = *(const f32x4*)(src + 4); unsigned w[4];
#pragma unroll
        for (int e = 0; e < 2; ++e) { w[e] = pk2((s0 + 2 * e <= t) ? v0[2 * e] : 0.f, (s0 + 2 * e + 1 <= t) ? v0[2 * e + 1] : 0.f); w[2 + e] = pk2((s0 + 4 + 2 * e <= t) ? v1[2 * e] : 0.f, (s0 + 5 + 2 * e <= t) ? v1[2 * e + 1] : 0.f); }
        const int j = jg >> 3, g = jg & 7;
        *(u32x4*)(p.w<bf16>(WS_WS + (size_t)j * 262144) + ((size_t)g * 128 + t) * 128 + s0) = (u32x4){w[0], w[1], w[2], w[3]};
    }
    }
    if (mask & 8) {
    for (int i = gt; i < 2052 * 32; i += NGT) { const int tp = i >> 5, fi = i & 31, pos = tp < 2048 ? tp : 16384 + (tp - 2048);
        const float inv = 1.0f / powf(10000.0f, (float)(2 * fi) / 64.0f); const float ang = (float)pos * inv;
        p.w<f32x2>(WS_ROPE)[i] = (f32x2){cosf(ang), sinf(ang)}; }
    }
    if (mask & 16) {
    { bf16* HB = p.w<bf16>(WS_HB); long long* ssq = p.stat(ST_SSQ0);
      auto rowp = [&](int m) -> const float* { return m < MP ? p.in[0] + (size_t)m * D : p.in[1] + (size_t)((m < MT ? m : MT - 1) - MP) * D; };
      f32x4 v[4], vn[4];
      if (gw < MR) { const float* r = rowp(gw);
#pragma unroll
        for (int jj = 0; jj < 4; ++jj) v[jj] = *(const f32x4*)(r + 4 * lane + 256 * jj); }
      for (int m = gw; m < MR; m += NGW) {
        { const float* r = rowp(m + NGW < MR ? m + NGW : m);
#pragma unroll
          for (int jj = 0; jj < 4; ++jj) vn[jj] = *(const f32x4*)(r + 4 * lane + 256 * jj); }
        float s = 0.f;
#pragma unroll
        for (int jj = 0; jj < 4; ++jj) { if (m >= MT) v[jj] = (f32x4){0.f, 0.f, 0.f, 0.f};
            s += (v[jj].x * v[jj].x + v[jj].y * v[jj].y) + (v[jj].z * v[jj].z + v[jj].w * v[jj].w); }
#pragma unroll
        for (int o = 1; o < 64; o <<= 1) s += __shfl_xor(s, o);
#pragma unroll
        for (int jj = 0; jj < 4; ++jj) { const int c = 4 * lane + 256 * jj;
            *(u32x2*)(HB + (size_t)m * D + c) = (u32x2){pk2(v[jj].x, v[jj].y), pk2(v[jj].z, v[jj].w)}; }
        if (lane == 0) stat_set(ssq + m, s);
#pragma unroll
        for (int jj = 0; jj < 4; ++jj) v[jj] = vn[jj];
      } }
    }
    if (mask & 32) {
    { const float* wuq = p.in[17]; const float* wuk = p.in[20]; const float* qn = p.in[16]; bf16* Wq = p.w<bf16>(WS_WQ);
      LAS float* Qs = (LAS float*)p.lds; LAS float* Ks = (LAS float*)(p.lds + 64 * 132 * 4);
      for (int it = p.bid; it < 192; it += p.G) {
        const int h = it / 24, kb = (it >> 2) % 6, cq = it & 3, k0 = 64 * kb;
        __syncthreads();
#pragma unroll
        for (int q = 0; q < 4; ++q) { const int idx = p.tid + 512 * q, row = idx >> 5, c4 = idx & 31;
            *(LAS f32x4*)(Qs + row * 132 + c4 * 4) = *(const f32x4*)(wuq + (size_t)(k0 + row) * 1536 + h * 192 + c4 * 4);
            *(LAS f32x4*)(Ks + row * 132 + c4 * 4) = *(const f32x4*)(wuk + (size_t)(cq * 64 + row) * 1024 + h * 128 + c4 * 4); }
        __syncthreads();
        const int cl = p.wave * 8, c0 = cq * 64 + cl; float acc[8];
#pragma unroll
        for (int cc = 0; cc < 8; ++cc) acc[cc] = 0.f;
#pragma unroll 4
        for (int n4 = 0; n4 < 32; ++n4) { const f32x4 bv = *(const LAS f32x4*)(Qs + lane * 132 + n4 * 4);
#pragma unroll
            for (int cc = 0; cc < 8; ++cc) { const f32x4 av = *(const LAS f32x4*)(Ks + (cl + cc) * 132 + n4 * 4); acc[cc] += (av.x * bv.x + av.y * bv.y) + (av.z * bv.z + av.w * bv.w); } }
        const float g = qn[k0 + lane];
#pragma unroll
        for (int cc = 0; cc < 8; ++cc) Wq[(size_t)(320 * h + c0 + cc) * 384 + k0 + lane] = (bf16)f2bf(acc[cc] * g);
      }
      for (int r = gw; r < 512; r += NGW) { const int h = r >> 6, ie = r & 63, i = ie >> 1, e = ie & 1;
#pragma unroll
        for (int kk = 0; kk < 6; ++kk) { const int k = lane + 64 * kk; Wq[(size_t)(320 * h + 256 + ie) * 384 + k] = (bf16)f2bf(wuq[(size_t)k * 1536 + h * 192 + 128 + 32 * e + i] * qn[k]); } } }
    }
    if (mask & 64) {
    { const float* wuv = p.in[21]; const float* wo = p.in[22]; bf16* Wov = p.w<bf16>(WS_WOV);
      LAS float* Os = (LAS float*)p.lds;
      for (int it = p.bid; it < 256; it += p.G) { const int h = it >> 5, cg = (it >> 2) & 7, nb = it & 3, c0 = cg * 32 + p.wave * 4, n = nb * 256 + lane * 4;
        __syncthreads();
#pragma unroll
        for (int q = 0; q < 16; ++q) { const int idx = p.tid + 512 * q, v = idx >> 6, c4 = idx & 63; *(LAS f32x4*)(Os + v * 256 + c4 * 4) = *(const f32x4*)(wo + (size_t)(h * 128 + v) * D + nb * 256 + c4 * 4); }
        __syncthreads();
        f32x4 acc[4];
#pragma unroll
        for (int cc = 0; cc < 4; ++cc) acc[cc] = (f32x4){0.f, 0.f, 0.f, 0.f};
#pragma unroll 8
        for (int v = 0; v < 128; ++v) { const f32x4 b = *(const LAS f32x4*)(Os + v * 256 + lane * 4);
#pragma unroll
            for (int cc = 0; cc < 4; ++cc) { const float a = wuv[(size_t)(c0 + cc) * 1024 + h * 128 + v]; acc[cc] += b * a; } }
#pragma unroll
        for (int jn = 0; jn < 4; ++jn) *(u32x2*)(Wov + (size_t)(n + jn) * 2048 + h * 256 + c0) = (u32x2){pk2(acc[0][jn], acc[1][jn]), pk2(acc[2][jn], acc[3][jn])};
      }
      __syncthreads(); }
    }
}
}
namespace mk {
#ifdef MK_DRYPROBE
#define MK_DRY(E) ((E).dry)
#define MK_DRYFIELD int dry;
#else
#define MK_DRY(E) 0
#define MK_DRYFIELD
#endif
typedef const f32x4 (&AccRef)[2][2][4][2];
__device__ __forceinline__ float quad_red(float v) { v += __shfl_xor(v, 16); v += __shfl_xor(v, 32); return v; }
__device__ __forceinline__ u32x4 pack8(const f32x4 a, const f32x4 b) { u32x4 w; w.x = cvt_pk_bf16(a[0], a[1]); w.y = cvt_pk_bf16(a[2], a[3]); w.z = cvt_pk_bf16(b[0], b[1]); w.w = cvt_pk_bf16(b[2], b[3]); return w; }
__device__ __forceinline__ float sumsq8(const f32x4 a, const f32x4 b) { return ((a[0] * a[0] + a[1] * a[1]) + (a[2] * a[2] + a[3] * a[3])) + ((b[0] * b[0] + b[1] * b[1]) + (b[2] * b[2] + b[3] * b[3])); }
__device__ __forceinline__ float sum8(const f32x4 a, const f32x4 b) { return ((a[0] + a[1]) + (a[2] + a[3])) + ((b[0] + b[1]) + (b[2] + b[3])); }
#define MK_EPI_CALL() \
    __device__ __forceinline__ void operator()(AccRef acc, const pg8::Unit& u, int wr, int wc, int fr, int fq) const { \
        Pre pre_[2][4]; \
        _Pragma("unroll") for (int ai = 0; ai < 2; ++ai) _Pragma("unroll") for (int m = 0; m < 4; ++m) pre_[ai][m] = pre(u.pm * 256 + ai * 128 + wr * 64 + m * 16 + fr, u.pn, wc, fq); \
        _Pragma("unroll") for (int ai = 0; ai < 2; ++ai) _Pragma("unroll") for (int m = 0; m < 4; ++m) \
            rgp(u.pm * 256 + ai * 128 + wr * 64 + m * 16 + fr, u.pn, wc, fq, acc[ai][0][m][0], acc[ai][0][m][1], acc[ai][1][m][0], acc[ai][1][m][1], pre_[ai][m]); } \
    __device__ __forceinline__ void rgq(int r, int pn, int wc, int fq, f32x4 a0, f32x4 b0, f32x4 a1, f32x4 b1, const Pre pv) const { rgp(r, pn, wc, fq, a0, b0, a1, b1, pv); }
#define MK_EPI_CALL_DENSE() \
    __device__ __forceinline__ void operator()(AccRef acc, const pg8::Unit& u, int wr, int wc, int fr, int fq) const { \
        Pre pre_[2][4]; \
        _Pragma("unroll") for (int ai = 0; ai < 2; ++ai) _Pragma("unroll") for (int m = 0; m < 4; ++m) pre_[ai][m] = pre(u.pm * 256 + ai * 128 + wr * 64 + m * 16 + fr, u.pn, wc, fq); \
        _Pragma("unroll") for (int ai = 0; ai < 2; ++ai) { float s1 = 0.f, s2 = 0.f; \
            _Pragma("unroll") for (int m = 0; m < 4; ++m) { float t1, t2; \
                rgs(u.pm * 256 + ai * 128 + wr * 64 + m * 16 + fr, u.pn, wc, fq, acc[ai][0][m][0], acc[ai][0][m][1], acc[ai][1][m][0], acc[ai][1][m][1], pre_[ai][m], t1, t2); \
                s1 = (fq == m) ? t1 : s1; s2 = (fq == m) ? t2 : s2; } \
            stats(u.pm * 256 + ai * 128 + wr * 64 + fq * 16 + fr, u.pn, s1, s2); } } \
    __device__ __forceinline__ void rgq(int r, int pn, int wc, int fq, f32x4 a0, f32x4 b0, f32x4 a1, f32x4 b1, const Pre pv) const { float t1, t2; rgs(r, pn, wc, fq, a0, b0, a1, b1, pv, t1, t2); if (fq == 0) stats(r, pn, t1, t2); }
#define MK_INIT_ZERO() __device__ __forceinline__ void init(f32x4 (&acc)[2][2][4][2], const pg8::Unit&, int, int, int, int) const { \
        _Pragma("unroll") for (int a = 0; a < 2; ++a) _Pragma("unroll") for (int b = 0; b < 2; ++b) _Pragma("unroll") for (int m = 0; m < 4; ++m) _Pragma("unroll") for (int n = 0; n < 2; ++n) acc[a][b][m][n] = (f32x4){0.f, 0.f, 0.f, 0.f}; }
#define MK_PRE_STAT(PTR) MK_INIT_ZERO() typedef long long Pre; __device__ __forceinline__ Pre pre(int r, int, int, int) const { return (PTR)[r]; }
__device__ __forceinline__ float stat_f(long long v) { const int hi = (int)(v >> 32); const unsigned lo = (unsigned)v; return __builtin_fmaf((float)hi, 4294967296.0f * ST_INV, (float)lo * ST_INV); }
__device__ __forceinline__ float rsq_f(float x) { return __builtin_amdgcn_rsqf(x); }

struct EpiA1 {
    static constexpr bool PERM = true, AFTER_DRAIN = false;
    bf16* U; bf16* GV; const long long* ssq; long long* lns; long long* lnq; MK_DRYFIELD
    MK_PRE_STAT(ssq)
    __device__ __forceinline__ void rgs(int r, int pn, int wc, int fq, f32x4 a0, f32x4 b0, f32x4 a1, f32x4 b1, const Pre pv, float& s1, float& s2) const {
        const bool isv = pn >= 4; bf16* dst = (isv ? GV : U) + (size_t)r * 1024 + (pn & 3) * 256 + wc * 32 + 8 * fq; const float rs = rsq_f(stat_f(pv) * (1.0f / 1024.0f) + RMS_EPS);
        a0 *= rs; b0 *= rs; a1 *= rs; b1 *= rs;
#pragma unroll
        for (int e = 0; e < 4; ++e) { a0[e] = gelu_tanh_f(a0[e]); b0[e] = gelu_tanh_f(b0[e]); a1[e] = gelu_tanh_f(a1[e]); b1[e] = gelu_tanh_f(b1[e]); }
        *(u32x4*)dst = pack8(a0, b0); *(u32x4*)(dst + 128) = pack8(a1, b1);
        s1 = 0.f; s2 = 0.f;
        if (isv) { s1 = quad_red(sum8(a0, b0) + sum8(a1, b1)); s2 = quad_red(sumsq8(a0, b0) + sumsq8(a1, b1)); }
    }
    __device__ __forceinline__ void stats(int r, int pn, float s1, float s2) const { if (pn >= 4 && !MK_DRY(*this)) { stat_add(lns + r, s1); stat_add(lnq + r, s2); } }
    MK_EPI_CALL_DENSE()
};
struct EpiRes {
    static constexpr bool PERM = true, AFTER_DRAIN = false;
    bf16* HB; long long* ssq_out; MK_DRYFIELD
    struct Pre { u32x4 h0, h1; };
    static __device__ __forceinline__ f32x4 lo4(const u32x4 h) { return (f32x4){bflo(h.x), bfhi(h.x), bflo(h.y), bfhi(h.y)}; }
    static __device__ __forceinline__ f32x4 hi4(const u32x4 h) { return (f32x4){bflo(h.z), bfhi(h.z), bflo(h.w), bfhi(h.w)}; }
    __device__ __forceinline__ Pre pre(int r, int pn, int wc, int fq) const { const bf16* hp = HB + (size_t)r * 1024 + pn * 256 + wc * 32 + 8 * fq; Pre v; v.h0 = *(const u32x4*)hp; v.h1 = *(const u32x4*)(hp + 128); return v; }
    __device__ __forceinline__ void init(f32x4 (&acc)[2][2][4][2], const pg8::Unit& u, int wr, int wc, int fr, int fq) const {
        Pre v[2][4];
#pragma unroll
        for (int ai = 0; ai < 2; ++ai)
#pragma unroll
            for (int m = 0; m < 4; ++m) v[ai][m] = pre(u.pm * 256 + ai * 128 + wr * 64 + m * 16 + fr, u.pn, wc, fq);
#pragma unroll
        for (int ai = 0; ai < 2; ++ai)
#pragma unroll
            for (int m = 0; m < 4; ++m) { acc[ai][0][m][0] = lo4(v[ai][m].h0); acc[ai][0][m][1] = hi4(v[ai][m].h0); acc[ai][1][m][0] = lo4(v[ai][m].h1); acc[ai][1][m][1] = hi4(v[ai][m].h1); }
    }
    __device__ __forceinline__ void fin(int r, int pn, int wc, int fq, const f32x4 a0, const f32x4 b0, const f32x4 a1, const f32x4 b1, float& s1) const {
        bf16* hp = HB + (size_t)r * 1024 + pn * 256 + wc * 32 + 8 * fq;
        s1 = quad_red(sumsq8(a0, b0) + sumsq8(a1, b1));
        if (MK_DRY(*this)) { if (s1 == 12345.678f) *(u32x4*)hp = pack8(a0, b0); return; }
        *(u32x4*)hp = pack8(a0, b0); *(u32x4*)(hp + 128) = pack8(a1, b1);
    }
    __device__ __forceinline__ void stats(int r, int pn, float s1, float s2) const { if (!MK_DRY(*this)) stat_add(ssq_out + r, s1); }
    __device__ __forceinline__ void operator()(AccRef acc, const pg8::Unit& u, int wr, int wc, int fr, int fq) const {
#pragma unroll
        for (int ai = 0; ai < 2; ++ai) { float s1 = 0.f;
#pragma unroll
            for (int m = 0; m < 4; ++m) { float t1; fin(u.pm * 256 + ai * 128 + wr * 64 + m * 16 + fr, u.pn, wc, fq, acc[ai][0][m][0], acc[ai][0][m][1], acc[ai][1][m][0], acc[ai][1][m][1], t1); s1 = (fq == m) ? t1 : s1; }
            stats(u.pm * 256 + ai * 128 + wr * 64 + fq * 16 + fr, u.pn, s1, 0.f); } }
    __device__ __forceinline__ void rgq(int r, int pn, int wc, int fq, f32x4 a0, f32x4 b0, f32x4 a1, f32x4 b1, const Pre v) const { float t1;
        fin(r, pn, wc, fq, a0 + lo4(v.h0), b0 + hi4(v.h0), a1 + lo4(v.h1), b1 + hi4(v.h1), t1); if (fq == 0) stats(r, pn, t1, 0.f); }
};
struct EpiF1 {
    static constexpr bool PERM = true, AFTER_DRAIN = false;
    bf16* ACT; const long long* ssq;
    MK_PRE_STAT(ssq)
    __device__ __forceinline__ void rgp(int r, int pn, int wc, int fq, f32x4 a0, f32x4 b0, f32x4 a1, f32x4 b1, const Pre pv) const {
        const float rs = rsq_f(stat_f(pv) * (1.0f / 1024.0f) + RMS_EPS), kx = -1.4426950409f * rs, r2 = rs * rs; f32x4 a, b;
#pragma unroll
        for (int e = 0; e < 4; ++e) { a[e] = a0[e] * __builtin_amdgcn_rcpf(1.0f + __builtin_amdgcn_exp2f(a0[e] * kx)) * (a1[e] * r2); b[e] = b0[e] * __builtin_amdgcn_rcpf(1.0f + __builtin_amdgcn_exp2f(b0[e] * kx)) * (b1[e] * r2); }
        *(u32x4*)(ACT + (size_t)r * DFF + pn * 128 + wc * 32 + 8 * fq) = pack8(a, b);
    }
    MK_EPI_CALL()
};
struct EpiB1 {
    static constexpr bool PERM = true, AFTER_DRAIN = false;
    float* RAW; bf16* CQB; const long long* ssq; long long* ssq_kv; long long* ssq_q; MK_DRYFIELD
    __device__ __forceinline__ void half(int r, int c, f32x4 a, f32x4 b, float& qkv, float& qq) const {
        if (c < 256) { *(f32x4*)(RAW + (size_t)r * 768 + c) = a; *(f32x4*)(RAW + (size_t)r * 768 + c + 4) = b; qkv += sumsq8(a, b); }
        else if (c < 640) { *(u32x4*)(CQB + (size_t)r * 384 + (c - 256)) = pack8(a, b); qq += sumsq8(a, b); }
        else if (c < 704) { *(f32x4*)(RAW + (size_t)r * 768 + c) = a; *(f32x4*)(RAW + (size_t)r * 768 + c + 4) = b; } }
    MK_PRE_STAT(ssq)
    __device__ __forceinline__ void rgs(int r, int pn, int wc, int fq, f32x4 a0, f32x4 b0, f32x4 a1, f32x4 b1, const Pre pv, float& s1, float& s2) const {
        const float rs = rsq_f(stat_f(pv) * (1.0f / 1024.0f) + RMS_EPS); const int c = pn * 256 + wc * 32 + 8 * fq; float qkv = 0.f, qq = 0.f;
        half(r, c, a0 * rs, b0 * rs, qkv, qq); half(r, c + 128, a1 * rs, b1 * rs, qkv, qq);
        s1 = quad_red(qkv); s2 = quad_red(qq);
    }
    __device__ __forceinline__ void stats(int r, int pn, float s1, float s2) const { if (!MK_DRY(*this)) { if (pn == 0) stat_add(ssq_kv + r, s1); else stat_add(ssq_q + r, s2); } }
    MK_EPI_CALL_DENSE()
};
struct EpiB2 {
    static constexpr bool PERM = true, AFTER_DRAIN = false;
    bf16* QF; const long long* ssq_q; const f32x2* rope;
    __device__ __forceinline__ void half(int r, int c, int tp, const f32x4 a, const f32x4 b) const {
        const int h = c / 320, w = c - h * 320;
        if (w < 256) *(u32x4*)(QF + (size_t)r * 2560 + c) = pack8(a, b);
        else { const int i0 = (w - 256) >> 1;
            const f32x4 cs01 = *(const f32x4*)(rope + (size_t)tp * 32 + i0), cs23 = *(const f32x4*)(rope + (size_t)tp * 32 + i0 + 2);
            bf16* qh = QF + (size_t)r * 2560 + h * 320 + 256;
            *(u32x2*)(qh + i0) = (u32x2){cvt_pk_bf16(a[0] * cs01[0] - a[1] * cs01[1], a[2] * cs01[2] - a[3] * cs01[3]), cvt_pk_bf16(b[0] * cs23[0] - b[1] * cs23[1], b[2] * cs23[2] - b[3] * cs23[3])};
            *(u32x2*)(qh + 32 + i0) = (u32x2){cvt_pk_bf16(a[0] * cs01[1] + a[1] * cs01[0], a[2] * cs01[3] + a[3] * cs01[2]), cvt_pk_bf16(b[0] * cs23[1] + b[1] * cs23[0], b[2] * cs23[3] + b[3] * cs23[2])}; } }
    MK_PRE_STAT(ssq_q)
    __device__ __forceinline__ void rgp(int r, int pn, int wc, int fq, f32x4 a0, f32x4 b0, f32x4 a1, f32x4 b1, const Pre pv) const {
        const float rs = rsq_f(stat_f(pv) * (1.0f / 384.0f) + RMS_EPS) * (MLA_SCALE * 1.4426950408889634f)  ; const int tp = r < MP ? (r & 2047) : 2048 + ((r - MP) & 3), c = pn * 256 + wc * 32 + 8 * fq;
        half(r, c, tp, a0 * rs, b0 * rs); half(r, c + 128, tp, a1 * rs, b1 * rs);
    }
    MK_EPI_CALL()
};
struct EpiC1 {
    static constexpr bool PERM = true, AFTER_DRAIN = false;
    bf16* GATE; float* XW; const long long* ssq;
    MK_PRE_STAT(ssq)
    __device__ __forceinline__ void rgp(int r, int pn, int wc, int fq, f32x4 a0, f32x4 b0, f32x4 a1, f32x4 b1, const Pre pv) const {
        const bool isx = pn >= 5; const int c = (isx ? pn - 5 : pn) * 256 + wc * 32 + 8 * fq; const float rs = rsq_f(stat_f(pv) * (1.0f / 1024.0f) + RMS_EPS);
        a0 *= rs; b0 *= rs; a1 *= rs; b1 *= rs;
        if (isx) { float* x = XW + (size_t)r * 1280 + c; *(f32x4*)x = a0; *(f32x4*)(x + 4) = b0; *(f32x4*)(x + 128) = a1; *(f32x4*)(x + 132) = b1; }
        else {
#pragma unroll
            for (int e = 0; e < 4; ++e) { a0[e] = gelu_tanh_f(a0[e]); b0[e] = gelu_tanh_f(b0[e]); a1[e] = gelu_tanh_f(a1[e]); b1[e] = gelu_tanh_f(b1[e]); }
            bf16* g = GATE + (size_t)r * 1280 + c; *(u32x4*)g = pack8(a0, b0); *(u32x4*)(g + 128) = pack8(a1, b1); }
    }
    MK_EPI_CALL()
};

template <class Epi>
__device__ __forceinline__ void mini_gemm(const P& p, const bf16* A, int lda, const bf16* Bt, int ldb, int K, int N, const Epi& E, int first_wg) {
    constexpr int BP = 272, SLOT = 64 * BP;
    const int tid = p.tid, lane = p.lane, w = p.wave, kq = w & 3, rgp = w >> 2, l15 = lane & 15, g4 = lane >> 4, nmu = (N >> 8) * 16, nch = K >> 7, nst = (nch + 3) >> 2;
    const int t128 = (rgp << 6) | lane;
    for (int mu = (p.bid - first_wg + p.G) % p.G; mu < nmu; mu += p.G) {
        const int pn = mu >> 4, wcq = (mu >> 2) & 3, rq = mu & 3, row = MP + 32 * rq + 16 * rgp + l15;
        const bf16* arow = A + (size_t)row * lda + 8 * g4;
        const int r0 = t128 >> 4, c16 = t128 & 15;
        const bf16* bbase = Bt + (size_t)(pn * 256 + wcq * 32 + 8 * (r0 >> 2) + (r0 & 3)) * ldb + c16 * 8; const int bo0 = r0 * BP + c16 * 16;
#define MG_BSRC(q) (bbase + (size_t)(128 * ((q) >> 2) + 4 * (((q) >> 1) & 1) + 16 * ((q) & 1)) * ldb)
#define MG_BOFF(q) (bo0 + 8 * (q) * BP)
        typename Epi::Pre pv_{}; if (kq == 0) pv_ = E.pre(row, pn, wcq, g4);
        f32x4 acc[4];
#pragma unroll
        for (int t = 0; t < 4; ++t) acc[t] = (f32x4){0.f, 0.f, 0.f, 0.f};
        u32x4 b0[8], a0[4], b1[8], a1[4], b2[8], a2[4];
#define MG_LOAD(BS, AS, ST) do { const int ch_ = 4 * (ST) + kq; if (ch_ < nch) { \
            _Pragma("unroll") for (int q = 0; q < 8; ++q) BS[q] = *(const u32x4*)(MG_BSRC(q) + (size_t)ch_ * 128); \
            _Pragma("unroll") for (int s = 0; s < 4; ++s) AS[s] = *(const u32x4*)(arow + (size_t)ch_ * 128 + 32 * s); } } while (0)
#define MG_STEP(BS, AS, ST) do { LAS unsigned char* slot = p.lds + (kq * 2 + ((ST) & 1)) * SLOT; const bool ok_ = 4 * (ST) + kq < nch; \
            if (ok_) { _Pragma("unroll") for (int q = 0; q < 8; ++q) *(LAS u32x4*)(slot + MG_BOFF(q)) = BS[q]; } \
            bf16x8 af[4]; _Pragma("unroll") for (int s = 0; s < 4; ++s) af[s] = __builtin_bit_cast(bf16x8, AS[s]); \
            __syncthreads(); \
            if ((ST) + 3 < nst) MG_LOAD(BS, AS, (ST) + 3); \
            if (ok_) { _Pragma("unroll") for (int s = 0; s < 4; ++s) _Pragma("unroll") for (int t = 0; t < 4; ++t) { \
                const bf16x8 bf = *(const LAS bf16x8*)(slot + (t * 16 + l15) * BP + (32 * s + 8 * g4) * 2); \
                acc[t] = __builtin_amdgcn_mfma_f32_16x16x32_bf16(bf, af[s], acc[t], 0, 0, 0); } } } while (0)
        MG_LOAD(b0, a0, 0); if (1 < nst) MG_LOAD(b1, a1, 1); if (2 < nst) MG_LOAD(b2, a2, 2);
        __syncthreads();
        for (int st = 0; st < nst; st += 3) {
            MG_STEP(b0, a0, st);
            if (st + 1 < nst) MG_STEP(b1, a1, st + 1);
            if (st + 2 < nst) MG_STEP(b2, a2, st + 2);
        }
#undef MG_LOAD
#undef MG_STEP
#undef MG_BSRC
#undef MG_BOFF
        __syncthreads();
        LAS f32x4* red = (LAS f32x4*)p.lds;
        if (kq > 0) {
#pragma unroll
            for (int t = 0; t < 4; ++t) red[((rgp * 3 + (kq - 1)) * 4 + t) * 64 + lane] = acc[t]; }
        __syncthreads();
        if (kq == 0) {
#pragma unroll
            for (int k2 = 0; k2 < 3; ++k2)
#pragma unroll
                for (int t = 0; t < 4; ++t) acc[t] += red[((rgp * 3 + k2) * 4 + t) * 64 + lane];
            E.rgq(row, pn, wcq, g4, acc[0], acc[1], acc[2], acc[3], pv_); }
    }
}
}
namespace mk {
__device__ __forceinline__ s16x4 tr16(const LAS unsigned char* a) { return __builtin_amdgcn_ds_read_tr16_b64_v4i16((LAS s16x4*)a); }
__device__ __forceinline__ bf16x8 cat8(const s16x4 a, const s16x4 b) { return (bf16x8){a[0], a[1], a[2], a[3], b[0], b[1], b[2], b[3]}; }
__device__ __forceinline__ bf16x8 as_bf16x8(const u32x4 w) { return __builtin_bit_cast(bf16x8, w); }
#define MFMA16(A, B, C) __builtin_amdgcn_mfma_f32_16x16x32_bf16((A), (B), (C), 0, 0, 0)
constexpr int TP = 272;
constexpr int KP = 656;
constexpr float LOG2E = 1.4426950408889634f;

__device__ __forceinline__ void a2_spatial(const P& p, int j, float* out_cv  ) {
    const bf16* U = p.w<bf16>(WS_U); const bf16* GV = p.w<bf16>(WS_GV); bf16* UM = p.w<bf16>(WS_UM);
    const long long* lns = p.stat(ST_LNS0 + 2 * j); const long long* lnq = p.stat(ST_LNQ0 + 2 * j);
    const float* ln_g = p.in[10] + j * 1024; const float* ln_b = p.in[11] + j * 1024; const float* b_s = p.in[13] + j * 1024;
    LAS unsigned char* Wt = p.lds; LAS unsigned char* Vt = p.lds + 128 * TP;
    const int tid = p.tid, lane = p.lane, w = p.wave, l15 = lane & 15, g4 = lane >> 4, q4 = (lane & 15) >> 2, pp = lane & 3;
    { const float* aws = p.in[12] + (size_t)j * 8 * 16384;
      for (int idx = p.bid * 512 + tid; idx < 128 * 1024; idx += p.G * 512) {
        const int t = idx >> 10, d = idx & 1023, g = d >> 7, i = t & 3; const size_t r = (size_t)MP + t, rb = r - i;
        const float lg = ln_g[d], lb = ln_b[d]; float mixed = b_s[g * 128 + i], vi = 0.f;
#pragma unroll
        for (int s2 = 0; s2 < 4; ++s2) { const size_t rs = rb + s2;
            const float mu = stat_get(lns + rs) * (1.0f / 1024.0f), var = stat_get(lnq + rs) * (1.0f / 1024.0f) - mu * mu;
            const float v = (bf2f(GV[rs * 1024 + d]) - mu) * rsqrtf(var + LN_EPS) * lg + lb, wv = aws[(size_t)g * 16384 + i * 128 + s2];
            mixed += (s2 <= i) ? wv * v : 0.f; vi = (s2 == i) ? v : vi; }
        if (out_cv) out_cv[(size_t)t * 1024 + d] = vi;
        UM[r * 1024 + d] = (bf16)f2bf(bf2f(U[r * 1024 + d]) * mixed); } }
    for (int u = p.bid; u < 128 * 8; u += p.G) {
        const int c = u >> 3, g = u & 7, row0 = c * 128; const bool smp = false;
        const bf16* Wsrc = p.w<bf16>(WS_WS + (smp ? 524288 : 0) + (size_t)j * 262144) + (size_t)g * 16384;
#pragma unroll
        for (int q = 0; q < 4; ++q) { const int ch = tid + 512 * q, row = ch >> 4, c16 = ch & 15;
            *(LAS u32x4*)(Wt + row * TP + c16 * 16) = *(const u32x4*)(Wsrc + row * 128 + c16 * 8); }
        { const int c16 = tid & 15, d0 = g * 128 + c16 * 8;
          const f32x4 g0 = *(const f32x4*)(ln_g + d0), g1 = *(const f32x4*)(ln_g + d0 + 4), b0 = *(const f32x4*)(ln_b + d0), b1 = *(const f32x4*)(ln_b + d0 + 4);
          u32x4 raw[4]; float mean[4], rstd[4];
#pragma unroll
          for (int q = 0; q < 4; ++q) { const int r = row0 + (tid >> 4) + 32 * q; raw[q] = *(const u32x4*)(GV + (size_t)r * 1024 + d0);
              const float mu = stat_get(lns + r) * (1.0f / 1024.0f), var = stat_get(lnq + r) * (1.0f / 1024.0f) - mu * mu; mean[q] = mu; rstd[q] = rsqrtf(var + LN_EPS); }
#pragma unroll
          for (int q = 0; q < 4; ++q) { const int s = (tid >> 4) + 32 * q, r = row0 + s;
            f32x4 v0, v1;
            v0[0] = bflo(raw[q].x); v0[1] = bfhi(raw[q].x); v0[2] = bflo(raw[q].y); v0[3] = bfhi(raw[q].y); v1[0] = bflo(raw[q].z); v1[1] = bfhi(raw[q].z); v1[2] = bflo(raw[q].w); v1[3] = bfhi(raw[q].w);
            v0 = (v0 - mean[q]) * rstd[q] * g0 + b0; v1 = (v1 - mean[q]) * rstd[q] * g1 + b1;
            if (smp && out_cv) { float* o = out_cv + (size_t)(r - MP) * 1024 + d0; *(f32x4*)o = v0; *(f32x4*)(o + 4) = v1; }
            *(LAS u32x4*)(Vt + s * TP + c16 * 16) = pack8(v0, v1); } }
        u32x2 uu[8];
#pragma unroll
        for (int tt = 0; tt < 8; ++tt) uu[tt] = *(const u32x2*)(U + (size_t)(row0 + 16 * tt + l15) * 1024 + g * 128 + 16 * w + 4 * g4);
        __syncthreads();
        f32x4 acc[8];
#pragma unroll
        for (int tt = 0; tt < 8; ++tt) acc[tt] = (f32x4){0.f, 0.f, 0.f, 0.f};
#pragma unroll
        for (int kk = 0; kk < 4; ++kk) {
            const bf16x8 X = cat8(tr16(Vt + (32 * kk + 8 * g4 + q4) * TP + (16 * w + 4 * pp) * 2), tr16(Vt + (32 * kk + 8 * g4 + 4 + q4) * TP + (16 * w + 4 * pp) * 2));
#pragma unroll
            for (int tt = 0; tt < 8; ++tt) if (32 * kk <= 16 * tt + 15) {
                const bf16x8 Y = *(const LAS bf16x8*)(Wt + (16 * tt + l15) * TP + (32 * kk + 8 * g4) * 2);
                acc[tt] = MFMA16(X, Y, acc[tt]); }
        }
#pragma unroll
        for (int tt = 0; tt < 8; ++tt) { const int t = 16 * tt + l15, r = row0 + t, col = g * 128 + 16 * w + 4 * g4;
            const float bias = b_s[g * 128 + (smp ? (t & 3) : t)];
            const float o0 = bflo(uu[tt].x) * (acc[tt][0] + bias), o1 = bfhi(uu[tt].x) * (acc[tt][1] + bias), o2 = bflo(uu[tt].y) * (acc[tt][2] + bias), o3 = bfhi(uu[tt].y) * (acc[tt][3] + bias);
            *(u32x2*)(UM + (size_t)r * 1024 + col) = (u32x2){cvt_pk_bf16(o0, o1), cvt_pk_bf16(o2, o3)}; }
        __syncthreads();
    }
}

__device__ __forceinline__ void b2_kvfinal(const P& p, float* out_mp, float* out_ms) {
    const float* RAW = p.w<float>(WS_RAW); bf16* KVB = p.w<bf16>(WS_KVB); const long long* ssq_kv = p.stat(ST_KV); const float* kvn = p.in[19]; const f32x2* rope = p.w<f32x2>(WS_ROPE);
    const int gw = p.bid * NWAVES + p.wave, NGW = p.G * NWAVES, lane = p.lane, l31 = lane & 31;
    const f32x4 kn = *(const f32x4*)(kvn + 4 * lane);
    auto tpos = [&](int m) { return m < MP ? (m & 2047) : 2048 + ((m - MP) & 3); };
    long long sq = 0, sqn = 0; f32x4 rv = (f32x4){0.f, 0.f, 0.f, 0.f}, rvn = rv; f32x2 cs = (f32x2){0.f, 0.f}, csn = cs; float x1 = 0.f, x2 = 0.f, x1n = 0.f, x2n = 0.f;
    if (gw < MT) { const int m = gw; sq = ssq_kv[m]; rv = *(const f32x4*)(RAW + (size_t)m * 768 + 4 * lane); cs = rope[(size_t)tpos(m) * 32 + l31]; x1 = RAW[(size_t)m * 768 + 640 + l31]; x2 = RAW[(size_t)m * 768 + 672 + l31]; }
    for (int m = gw; m < MT; m += NGW) {
        { const int mn = (m + NGW < MT) ? m + NGW : m; sqn = ssq_kv[mn]; rvn = *(const f32x4*)(RAW + (size_t)mn * 768 + 4 * lane); csn = rope[(size_t)tpos(mn) * 32 + l31]; x1n = RAW[(size_t)mn * 768 + 640 + l31]; x2n = RAW[(size_t)mn * 768 + 672 + l31]; }
        float* o = m < MP ? (out_mp ? out_mp + (size_t)m * 320 : nullptr) : (out_ms ? out_ms + (size_t)(m - MP) * 320 : nullptr);
        const float rs = rsqrtf((float)sq * ST_INV * (1.0f / 256.0f) + RMS_EPS);
        const f32x4 v = rv * rs * kn;
        if (o) *(f32x4*)(o + 4 * lane) = v;
        *(u32x2*)(KVB + (size_t)m * 320 + 4 * lane) = (u32x2){cvt_pk_bf16(v[0], v[1]), cvt_pk_bf16(v[2], v[3])};
        if (lane < 32) {
            const float o1 = x1 * cs.x - x2 * cs.y, o2 = x1 * cs.y + x2 * cs.x;
            if (o) { o[256 + lane] = o1; o[288 + lane] = o2; }
            KVB[(size_t)m * 320 + 256 + lane] = (bf16)f2bf(o1); KVB[(size_t)m * 320 + 288 + lane] = (bf16)f2bf(o2); }
        sq = sqn; rv = rvn; cs = csn; x1 = x1n; x2 = x2n;
    }
}

__device__ __forceinline__ void b3_attn_prompt(const P& p) {
    const bf16* QF = p.w<bf16>(WS_QF); const bf16* KVB = p.w<bf16>(WS_KVB); bf16* OB = p.w<bf16>(WS_OB);
    const int lane = p.lane, h = p.wave, l15 = lane & 15, g4 = lane >> 4, q4 = (lane & 15) >> 2, pp = lane & 3;
    constexpr int TILE_B = 64 * 640;
    int soff[5];
#pragma unroll
    for (int i = 0; i < 5; ++i) { const int P_ = (h + 8 * i) * 64 + lane, row = P_ / 40, cph = P_ - 40 * row; soff[i] = row * 320 + ((cph ^ (row & 6)) << 3); }
    int kaddr[10];
#pragma unroll
    for (int s_ = 0; s_ < 10; ++s_) kaddr[s_] = l15 * 640 + (((4 * s_ + g4) ^ (l15 & 6)) << 4);
    int taddr[4];
    { const int rl = 4 * g4 + q4, m_ = (rl & 6) >> 1;
#pragma unroll
      for (int v3 = 0; v3 < 4; ++v3) taddr[v3] = rl * 640 + (((v3 ^ m_) << 1 | (pp >> 1)) << 4) + 8 * (pp & 1); }
#define AT_DMA(BUF, SRC) do { _Pragma("unroll") for (int i = 0; i < 5; ++i) \
        __builtin_amdgcn_global_load_lds((const unsigned*)((SRC) + soff[i]), (LAS unsigned*)((BUF) + (h + 8 * i) * 1024), 16, 0, 0); } while (0)
    for (int pi = p.bid; pi < 512; pi += p.G) {
        const int b = (p.G % 8 == 0) ? (pi & 7) : (pi >> 6), x = (p.G % 8 == 0) ? ((pi >> 3) & 63) : (pi & 63);
        for (int half = 0; half < 2; ++half) {
            const int qt = half ? 127 - x : x, t0 = 16 * qt, nkt = (t0 + 15) / 64 + 1;
            const size_t rowq = (size_t)b * 2048 + t0 + l15; const bf16* kvb = KVB + (size_t)b * 2048 * 320;
            AT_DMA(p.lds, kvb);
            bf16x8 Q[10];
#pragma unroll
            for (int s = 0; s < 10; ++s) Q[s] = as_bf16x8(*(const u32x4*)(QF + rowq * 2560 + h * 320 + 32 * s + 8 * g4));
            f32x4 O[16];
#pragma unroll
            for (int vt = 0; vt < 16; ++vt) O[vt] = (f32x4){0.f, 0.f, 0.f, 0.f};
            float mrun = -1e30f, lrun = 0.f;
            asm volatile("s_waitcnt vmcnt(0)" ::: "memory"); __syncthreads();
#define AT_TILE(BUF, KT, MASKED) do { \
                f32x4 S[4]; \
                _Pragma("unroll") for (int k4 = 0; k4 < 4; ++k4) S[k4] = (f32x4){0.f, 0.f, 0.f, 0.f}; \
                { bf16x8 Kc[4], Kn[4]; \
                  _Pragma("unroll") for (int k4 = 0; k4 < 4; ++k4) Kc[k4] = *(const LAS bf16x8*)((BUF) + kaddr[0] + k4 * 10240); \
                  _Pragma("unroll") for (int s = 0; s < 10; ++s) { \
                      if (s < 9) { _Pragma("unroll") for (int k4 = 0; k4 < 4; ++k4) Kn[k4] = *(const LAS bf16x8*)((BUF) + kaddr[s < 9 ? s + 1 : 9] + k4 * 10240); } \
                      _Pragma("unroll") for (int k4 = 0; k4 < 4; ++k4) S[k4] = MFMA16(Kc[k4], Q[s], S[k4]); \
                      _Pragma("unroll") for (int k4 = 0; k4 < 4; ++k4) Kc[k4] = Kn[k4]; } } \
                  \
                float mx = -1e30f; \
                _Pragma("unroll") for (int k4 = 0; k4 < 4; ++k4) _Pragma("unroll") for (int e = 0; e < 4; ++e) { float v = S[k4][e]; if ((MASKED) && 64 * (KT) + 16 * k4 + 4 * g4 + e > t0 + l15) v = -1e30f; S[k4][e] = v; mx = fmaxf(mx, v); } \
                mx = fmaxf(mx, __shfl_xor(mx, 16)); mx = fmaxf(mx, __shfl_xor(mx, 32)); \
                const float mnew = fmaxf(mrun, mx), alpha = __builtin_amdgcn_exp2f(mrun - mnew); mrun = mnew; \
                float ps = 0.f; \
                _Pragma("unroll") for (int k4 = 0; k4 < 4; ++k4) _Pragma("unroll") for (int e = 0; e < 4; ++e) { const float pv = __builtin_amdgcn_exp2f(S[k4][e] - mnew); S[k4][e] = pv; ps += pv; } \
                lrun = lrun * alpha + ps; \
                _Pragma("unroll") for (int vt = 0; vt < 16; ++vt) O[vt] *= alpha; \
                bf16x8 Pf[2]; \
                _Pragma("unroll") for (int ks = 0; ks < 2; ++ks) Pf[ks] = as_bf16x8((u32x4){cvt_pk_bf16(S[2 * ks][0], S[2 * ks][1]), cvt_pk_bf16(S[2 * ks][2], S[2 * ks][3]), cvt_pk_bf16(S[2 * ks + 1][0], S[2 * ks + 1][1]), cvt_pk_bf16(S[2 * ks + 1][2], S[2 * ks + 1][3])}); \
                  \
                { s16x4 Vc[4], Vn[4]; \
                  Vc[0] = AT_V(BUF, 0, 0, 0); Vc[1] = AT_V(BUF, 0, 0, 1); Vc[2] = AT_V(BUF, 0, 1, 0); Vc[3] = AT_V(BUF, 0, 1, 1); \
                  _Pragma("unroll") for (int vt = 0; vt < 16; ++vt) { \
                      if (vt < 15) { Vn[0] = AT_V(BUF, (vt < 15 ? vt + 1 : 15), 0, 0); Vn[1] = AT_V(BUF, (vt < 15 ? vt + 1 : 15), 0, 1); Vn[2] = AT_V(BUF, (vt < 15 ? vt + 1 : 15), 1, 0); Vn[3] = AT_V(BUF, (vt < 15 ? vt + 1 : 15), 1, 1); } \
                      O[vt] = MFMA16(cat8(Vc[0], Vc[1]), Pf[0], O[vt]); O[vt] = MFMA16(cat8(Vc[2], Vc[3]), Pf[1], O[vt]); \
                      _Pragma("unroll") for (int i = 0; i < 4; ++i) Vc[i] = Vn[i]; } } } while (0)
#define AT_V(BUF, VT, KS, T) tr16((BUF) + taddr[(VT) & 3] + ((VT) >> 2) * 128 + (32 * (KS) + 16 * (T)) * 640)
            for (int kt = 0; kt < nkt - 1; ++kt) {
                LAS unsigned char* buf = p.lds + (kt & 1) * TILE_B;
                AT_DMA(p.lds + ((kt + 1) & 1) * TILE_B, kvb + (size_t)64 * (kt + 1) * 320);
                AT_TILE(buf, kt, false);
                asm volatile("s_waitcnt vmcnt(0)" ::: "memory"); __syncthreads();
            }
            { const int kt = nkt - 1; LAS unsigned char* buf = p.lds + (kt & 1) * TILE_B;
              AT_TILE(buf, kt, true);
              __syncthreads(); }
#undef AT_TILE
#undef AT_V
            const float linv = 1.0f / quad_red(lrun);
#pragma unroll
            for (int vt = 0; vt < 16; ++vt) { const f32x4 o = O[vt] * linv;
                *(u32x2*)(OB + rowq * 2048 + h * 256 + 16 * vt + 4 * g4) = (u32x2){cvt_pk_bf16(o[0], o[1]), cvt_pk_bf16(o[2], o[3])}; }
        }
    }
#undef AT_DMA
}

__device__ __forceinline__ void b3_attn_sample(const P& p) {
    const bf16* QF = p.w<bf16>(WS_QF); float* PART = p.w<float>(WS_PART); float* PML = p.w<float>(WS_PML);
    const float* cache = p.in[2]; const int* ptab = (const int*)p.in[5];
    const int tid = p.tid, lane = p.lane, w = p.wave, qt = w & 1, dvq = w >> 1, l15 = lane & 15, g4 = lane >> 4, q4 = (lane & 15) >> 2, pp = lane & 3;
    constexpr int TILE_B = 64 * KP;
    for (int u = p.bid; u < 256; u += p.G) {
        const int b = u >> 3, sp = u & 7;
        const int hq = 4 * qt + (l15 >> 2), iq = l15 & 3; const size_t rowq = (size_t)MP + 4 * b + iq;
        bf16x8 Q[10];
#pragma unroll
        for (int s = 0; s < 10; ++s) Q[s] = as_bf16x8(*(const u32x4*)(QF + rowq * 2560 + hq * 320 + 32 * s + 8 * g4));
        f32x4 O[4];
#pragma unroll
        for (int v = 0; v < 4; ++v) O[v] = (f32x4){0.f, 0.f, 0.f, 0.f};
        float mrun = -1e30f, lrun = 0.f;
        f32x4 st[10];
        auto tile_src = [&](int ti) -> const float* { const int pg = 16 * sp + (ti >> 1); return cache + ((size_t)ptab[b * 128 + pg] * 128 + 64 * (ti & 1)) * 320; };
        { const float* src = tile_src(0);
#pragma unroll
          for (int q = 0; q < 10; ++q) st[q] = __builtin_nontemporal_load((const f32x4*)(src + (size_t)(tid + 512 * q) * 4));
          __syncthreads();
#pragma unroll
          for (int q = 0; q < 10; ++q) { const int ch = tid + 512 * q, row = ch / 80, c4 = ch % 80; *(LAS u32x2*)(p.lds + row * KP + c4 * 8) = (u32x2){cvt_pk_bf16(st[q][0], st[q][1]), cvt_pk_bf16(st[q][2], st[q][3])}; }
          __syncthreads(); }
        for (int ti = 0; ti < 32; ++ti) {
            LAS unsigned char* buf = p.lds + (ti & 1) * TILE_B;
            if (ti + 1 < 32) { const float* src = tile_src(ti + 1);
#pragma unroll
                for (int q = 0; q < 10; ++q) st[q] = __builtin_nontemporal_load((const f32x4*)(src + (size_t)(tid + 512 * q) * 4)); }
            f32x4 S[4];
#pragma unroll
            for (int k4 = 0; k4 < 4; ++k4) { S[k4] = (f32x4){0.f, 0.f, 0.f, 0.f};
#pragma unroll
                for (int s = 0; s < 10; ++s) { const bf16x8 Kf = *(const LAS bf16x8*)(buf + (16 * k4 + l15) * KP + (32 * s + 8 * g4) * 2); S[k4] = MFMA16(Kf, Q[s], S[k4]); } }
            float mx = -1e30f;
#pragma unroll
            for (int k4 = 0; k4 < 4; ++k4)
#pragma unroll
                for (int e = 0; e < 4; ++e) { const float v = S[k4][e]; mx = fmaxf(mx, v); }
            mx = fmaxf(mx, __shfl_xor(mx, 16)); mx = fmaxf(mx, __shfl_xor(mx, 32));
            const float mnew = fmaxf(mrun, mx), alpha = __builtin_amdgcn_exp2f(mrun - mnew); mrun = mnew;
            float ps = 0.f;
#pragma unroll
            for (int k4 = 0; k4 < 4; ++k4)
#pragma unroll
                for (int e = 0; e < 4; ++e) { const float pv = __builtin_amdgcn_exp2f(S[k4][e] - mnew); S[k4][e] = pv; ps += pv; }
            lrun = lrun * alpha + ps;
#pragma unroll
            for (int v = 0; v < 4; ++v) O[v] *= alpha;
            bf16x8 Pf[2];
#pragma unroll
            for (int ks = 0; ks < 2; ++ks) Pf[ks] = as_bf16x8((u32x4){cvt_pk_bf16(S[2 * ks][0], S[2 * ks][1]), cvt_pk_bf16(S[2 * ks][2], S[2 * ks][3]), cvt_pk_bf16(S[2 * ks + 1][0], S[2 * ks + 1][1]), cvt_pk_bf16(S[2 * ks + 1][2], S[2 * ks + 1][3])});
#pragma unroll
            for (int v = 0; v < 4; ++v) { const int vt = 4 * dvq + v;
#pragma unroll
                for (int ks = 0; ks < 2; ++ks) {
                    const bf16x8 Vf = cat8(tr16(buf + (32 * ks + 4 * g4 + q4) * KP + (16 * vt + 4 * pp) * 2), tr16(buf + (32 * ks + 16 + 4 * g4 + q4) * KP + (16 * vt + 4 * pp) * 2));
                    O[v] = MFMA16(Vf, Pf[ks], O[v]); } }
            if (ti + 1 < 32) { LAS unsigned char* nb = p.lds + ((ti + 1) & 1) * TILE_B;
#pragma unroll
                for (int q = 0; q < 10; ++q) { const int ch = tid + 512 * q, row = ch / 80, c4 = ch % 80; *(LAS u32x2*)(nb + row * KP + c4 * 8) = (u32x2){cvt_pk_bf16(st[q][0], st[q][1]), cvt_pk_bf16(st[q][2], st[q][3])}; } }
            __syncthreads();
        }
        const float lsum = quad_red(lrun); const int qrow = 16 * qt + l15; const size_t pb = ((size_t)(b * 8 + sp) * 32 + qrow);
#pragma unroll
        for (int v = 0; v < 4; ++v) *(f32x4*)(PART + pb * 256 + 16 * (4 * dvq + v) + 4 * g4) = O[v];
        if (dvq == 0 && g4 == 0) { PML[pb * 2] = mrun; PML[pb * 2 + 1] = lsum; }
    }
}
__device__ __forceinline__ void b3_combine(const P& p) {
    const bf16* QF = p.w<bf16>(WS_QF); const bf16* KVB = p.w<bf16>(WS_KVB); bf16* OB = p.w<bf16>(WS_OB); const float* PART = p.w<float>(WS_PART); const float* PML = p.w<float>(WS_PML);
    const int dv = p.tid & 255, sub = p.tid >> 8, lane = p.lane, w4 = p.wave & 3;
    LAS float* red = (LAS float*)p.lds;
    for (int base = 2 * p.bid; base < 1024; base += 2 * p.G) {
        const bool live = base + sub < 1024; const int it = live ? base + sub : 1023;
        const int b = it >> 5, i = (it >> 3) & 3, h = it & 7, qt = h >> 2, ql = ((h & 3) << 2) | i, qrow = 16 * qt + ql; const size_t row = (size_t)MP + 4 * b + i;
        { const int wd = dv < 160 ? dv : 159; const unsigned a = ((const unsigned*)(QF + row * 2560 + h * 320))[wd]; float pk[4];
#pragma unroll
          for (int kk = 0; kk < 4; ++kk) { const unsigned c = ((const unsigned*)(KVB + ((size_t)MP + 4 * b + kk) * 320))[wd]; pk[kk] = (dv < 160) ? bflo(a) * bflo(c) + bfhi(a) * bfhi(c) : 0.f; }
#pragma unroll
          for (int kk = 0; kk < 4; ++kk) {
#pragma unroll
              for (int o = 1; o < 64; o <<= 1) pk[kk] += __shfl_xor(pk[kk], o);
              if (lane == 0) red[(sub * 4 + w4) * 4 + kk] = pk[kk]; } }
        __syncthreads();
        float sn[4];
#pragma unroll
        for (int kk = 0; kk < 4; ++kk) { const float s = (red[(sub * 4 + 0) * 4 + kk] + red[(sub * 4 + 1) * 4 + kk]) + (red[(sub * 4 + 2) * 4 + kk] + red[(sub * 4 + 3) * 4 + kk]); sn[kk] = (kk <= i) ? s : -1e30f; }
        float M = fmaxf(fmaxf(sn[0], sn[1]), fmaxf(sn[2], sn[3])); float ms[8], ls[8];
#pragma unroll
        for (int sp = 0; sp < 8; ++sp) { const size_t pb = ((size_t)(b * 8 + sp) * 32 + qrow); ms[sp] = PML[pb * 2]; ls[sp] = PML[pb * 2 + 1]; M = fmaxf(M, ms[sp]); }
        float L = 0.f, Oa = 0.f;
#pragma unroll
        for (int sp = 0; sp < 8; ++sp) { const size_t pb = ((size_t)(b * 8 + sp) * 32 + qrow); const float wgt = __builtin_amdgcn_exp2f(ms[sp] - M); L += ls[sp] * wgt; Oa += PART[pb * 256 + dv] * wgt; }
#pragma unroll
        for (int kk = 0; kk < 4; ++kk) { const float pk = __builtin_amdgcn_exp2f(sn[kk] - M); L += pk; Oa += pk * bf2f(KVB[((size_t)MP + 4 * b + kk) * 320 + dv]); }
        if (live) OB[row * 2048 + h * 256 + dv] = (bf16)f2bf(Oa / L);
        __syncthreads();
    }
}

template <bool SMP>
__device__ __forceinline__ f32x4 conv4(const float* XW, const float* cbuf  , const float* cw, const float* cb, int m, int c) {
    f32x4 acc = *(const f32x4*)(cb + c);
    f32x4 v[4], wv[4];
#pragma unroll
    for (int k = 0; k < 4; ++k) { wv[k] = *(const f32x4*)(cw + k * 1280 + c);
        if (!SMP) { const int t = m & 2047, r = t + k - 3; v[k] = *(const f32x4*)(XW + (size_t)(m + (r >= 0 ? k - 3 : -t)) * 1280 + c); if (r < 0) wv[k] = (f32x4){0.f, 0.f, 0.f, 0.f}; }
        else { const int b = (m - MP) >> 2, t = (m - MP) & 3, r = t + k - 3; const float* ptr = (r >= 0) ? XW + (size_t)(m + k - 3) * 1280 + c : cbuf + ((size_t)b * 3 + (3 + r)) * 1280 + c; v[k] = *(const f32x4*)ptr; } }
#pragma unroll
    for (int k = 0; k < 4; ++k) acc += wv[k] * v[k];
    return acc;
}
__device__ __forceinline__ void c2_sample_item(const P& p, int j, int item, float* out_hs) {
    const float* XW = p.w<float>(WS_XW); bf16* LH = p.w<bf16>(WS_AA);
    const float* cbuf = p.in[4] + (size_t)j * 32 * 3 * 1280; const float* cw = p.in[25] + (size_t)j * 4 * 1280; const float* cb = p.in[26] + j * 1280;
    const float* b_a = p.in[28] + j * 1280; const float* b_i = p.in[30] + j * 1280; const float* lam = p.in[31] + j * 1280; const float* h0s = p.in[3] + (size_t)j * 32 * 1280;
    const bf16* WaT = p.w<bf16>(WS_WAT); const bf16* WiT = p.w<bf16>(WS_WIT);
    LAS unsigned char* Xs = p.lds;
    const int tid = p.tid, lane = p.lane, w = p.wave, l15 = lane & 15, g4 = lane >> 4, rgq = item / 10, n = item % 10;
    const int chl = 16 * w + l15, chn = n * 128 + chl; u32x4 wa[4], wi[4];
#pragma unroll
    for (int kk = 0; kk < 4; ++kk) { wa[kk] = *(const u32x4*)(WaT + (size_t)n * 16384 + chl * 128 + 32 * kk + 8 * g4); wi[kk] = *(const u32x4*)(WiT + (size_t)n * 16384 + chl * 128 + 32 * kk + 8 * g4); }
    const int bb = 4 * rgq + g4; float h = h0s[(size_t)bb * 1280 + chn]; const float ba = b_a[chn], bi = b_i[chn], lm = lam[chn];
    { const int r16 = tid >> 5, c4 = (tid & 31) * 4; const f32x4 xc = conv4<true>(XW, cbuf, cw, cb, MP + 16 * rgq + r16, n * 128 + c4);
      __syncthreads();
      *(LAS u32x2*)(Xs + r16 * TP + c4 * 2) = (u32x2){cvt_pk_bf16(xc[0], xc[1]), cvt_pk_bf16(xc[2], xc[3])}; }
    __syncthreads();
    f32x4 ca = (f32x4){0.f, 0.f, 0.f, 0.f}, ci = ca;
#pragma unroll
    for (int kk = 0; kk < 4; ++kk) { const bf16x8 X = *(const LAS bf16x8*)(Xs + l15 * TP + (32 * kk + 8 * g4) * 2);
        ca = MFMA16(X, as_bf16x8(wa[kk]), ca); ci = MFMA16(X, as_bf16x8(wi[kk]), ci); }
    const float nl = -lm, sp = -8.0f * LOG2E * ((nl > 20.f) ? nl : log1pf(expf(nl)));
#pragma unroll
    for (int e = 0; e < 4; ++e) { const float xc = bf2f(*(const LAS bf16*)(Xs + (4 * g4 + e) * TP + chl * 2));
        const float r = fast_sigmoid_l2(LOG2E * (ca[e] + ba)), gi = fast_sigmoid_l2(LOG2E * (ci[e] + bi)), a = __builtin_amdgcn_exp2f(r * sp);
        const float bt = bf2f((bf16)f2bf(__builtin_amdgcn_sqrtf(fmaxf(__builtin_fmaf(-a, a, 1.0f), 0.f)) * gi * xc));
        h = a * h + bt;
        LH[(size_t)(MP + 4 * bb + e) * 1280 + chn] = (bf16)f2bf(h); }
    if (out_hs) out_hs[(size_t)bb * 1280 + chn] = h;
}
__device__ __forceinline__ void c2_rglru(const P& p, int j, float* out_cp, float* out_cs, float* out_hs, const int mask) {
    const float* XW = p.w<float>(WS_XW); bf16* LH = p.w<bf16>(WS_AA); bf16* CPB = p.w<bf16>(WS_BB); float* AGG = p.w<float>(WS_AGG);
    const float* cbuf = p.in[4] + (size_t)j * 32 * 3 * 1280; const float* cw = p.in[25] + (size_t)j * 4 * 1280; const float* cb = p.in[26] + j * 1280;
    const float* b_a = p.in[28] + j * 1280; const float* b_i = p.in[30] + j * 1280; const float* lam = p.in[31] + j * 1280; const float* h0s = p.in[3] + (size_t)j * 32 * 1280;
    const bf16* WaT = p.w<bf16>(WS_WAT); const bf16* WiT = p.w<bf16>(WS_WIT);
    LAS unsigned char* Xt = p.lds; LAS unsigned char* At = p.lds + 128 * TP; LAS unsigned char* It = p.lds + 256 * TP;
    LAS float* LA = (LAS float*)p.lds;
    LAS unsigned char* LB = p.lds + 128 * 528;
    LAS float* QT = (LAS float*)(p.lds + 128 * 528 + 128 * TP);
    const int tid = p.tid, lane = p.lane, w = p.wave, l15 = lane & 15, g4 = lane >> 4;
    { const int gt = p.bid * 512 + tid, NGT = p.G * 512;
      for (int i = gt; i < (8 + 32) * 3 * 320; i += NGT) { const int c = (i % 320) * 4, rr = i / 320, jj = rr % 3, bb = rr / 3;
          if (bb < 8) { if (out_cp) *(f32x4*)(out_cp + ((size_t)bb * 3 + jj) * 1280 + c) = *(const f32x4*)(XW + ((size_t)bb * 2048 + 2045 + jj) * 1280 + c); }
          else { const int b = bb - 8; if (out_cs) *(f32x4*)(out_cs + ((size_t)b * 3 + jj) * 1280 + c) = *(const f32x4*)(XW + ((size_t)MP + 4 * b + 1 + jj) * 1280 + c); } } }
    const int c16 = tid & 15;
    f32x4 wv[4][2], bv[2], xv0[2][4][2]; u32x4 wa[4], wi[4];
#define C2_LOADW(U) do { const int n_ = (U) % 10, cch_ = n_ * 128 + c16 * 8; \
        _Pragma("unroll") for (int k = 0; k < 4; ++k) { wv[k][0] = *(const f32x4*)(cw + k * 1280 + cch_); wv[k][1] = *(const f32x4*)(cw + k * 1280 + cch_ + 4); } \
        bv[0] = *(const f32x4*)(cb + cch_); bv[1] = *(const f32x4*)(cb + cch_ + 4); } while (0)
#define C2_LOADG(U) do { const int n_ = (U) % 10; \
        _Pragma("unroll") for (int q = 0; q < 4; ++q) { const int row = (tid >> 4) + 32 * q; wa[q] = *(const u32x4*)(WaT + (size_t)n_ * 16384 + row * 128 + c16 * 8); wi[q] = *(const u32x4*)(WiT + (size_t)n_ * 16384 + row * 128 + c16 * 8); } } while (0)
#define C2_LOADX(U, QH, XV) do { const int T_ = (U) / 10, cch_ = ((U) % 10) * 128 + c16 * 8; \
        _Pragma("unroll") for (int qq = 0; qq < 2; ++qq) { const int m = T_ * 128 + (tid >> 4) + 32 * (2 * (QH) + qq); \
            _Pragma("unroll") for (int k = 0; k < 4; ++k) { const float* ptr; \
                if (T_ < 128) { const int t = m & 2047, r = t + k - 3; ptr = XW + (size_t)(m + (r >= 0 ? k - 3 : -t)) * 1280 + cch_; } \
                else { const int b = (m - MP) >> 2, t = (m - MP) & 3, r = t + k - 3; ptr = (r >= 0) ? XW + (size_t)(m + k - 3) * 1280 + cch_ : cbuf + ((size_t)b * 3 + (3 + r)) * 1280 + cch_; } \
                XV[qq][k][0] = *(const f32x4*)ptr; XV[qq][k][1] = *(const f32x4*)(ptr + 4); } } } while (0)
#define C2_CONV(U, QH, XV) do { const int T_ = (U) / 10; \
        _Pragma("unroll") for (int qq = 0; qq < 2; ++qq) { const int row = (tid >> 4) + 32 * (2 * (QH) + qq), m = T_ * 128 + row; f32x4 v0 = bv[0], v1 = bv[1]; \
            _Pragma("unroll") for (int k = 0; k < 4; ++k) { const bool live = (T_ >= 128) || (((m & 2047) + k - 3) >= 0); const f32x4 z = (f32x4){0.f, 0.f, 0.f, 0.f}; \
                v0 += (live ? wv[k][0] : z) * XV[qq][k][0]; v1 += (live ? wv[k][1] : z) * XV[qq][k][1]; } \
            *(LAS u32x4*)(Xt + row * TP + c16 * 16) = pack8(v0, v1); } } while (0)
    if (p.bid < 128 * 10) { C2_LOADX(p.bid, 0, xv0); }
    for (int u = p.bid; u < 128 * 10; u += p.G) {
        int tl_ = p.tid; asm volatile("" : "+v"(tl_)); const int tid = tl_, lane = tl_ & 63, l15 = lane & 15, g4 = lane >> 4, c16 = tl_ & 15;
        const int T = u / 10, n = u % 10, row0 = T * 128;
        {
            C2_LOADW(u); C2_LOADG(u);
            C2_CONV(u, 0, xv0); C2_LOADX(u, 1, xv0); C2_CONV(u, 1, xv0);
#pragma unroll
            for (int q = 0; q < 4; ++q) { const int row = (tid >> 4) + 32 * q; *(LAS u32x4*)(At + row * TP + c16 * 16) = wa[q]; *(LAS u32x4*)(It + row * TP + c16 * 16) = wi[q]; }
        }
        __syncthreads();
        f32x4 ca[8], ci[8];
#pragma unroll
        for (int tt = 0; tt < 8; ++tt) { ca[tt] = (f32x4){0.f, 0.f, 0.f, 0.f}; ci[tt] = (f32x4){0.f, 0.f, 0.f, 0.f}; }
        {
#pragma unroll
        for (int kk = 0; kk < 4; ++kk) {
            const bf16x8 Xa = *(const LAS bf16x8*)(At + (16 * w + l15) * TP + (32 * kk + 8 * g4) * 2), Xi = *(const LAS bf16x8*)(It + (16 * w + l15) * TP + (32 * kk + 8 * g4) * 2);
#pragma unroll
            for (int tt = 0; tt < 8; ++tt) { const bf16x8 Y = *(const LAS bf16x8*)(Xt + (16 * tt + l15) * TP + (32 * kk + 8 * g4) * 2);
                ca[tt] = MFMA16(Xa, Y, ca[tt]); ci[tt] = MFMA16(Xi, Y, ci[tt]); }
        }
        const int chn = n * 128 + 16 * w + 4 * g4;
        { const f32x4 ba = *(const f32x4*)(b_a + chn), bi = *(const f32x4*)(b_i + chn), lm = *(const f32x4*)(lam + chn);
          f32x4 sp;
#pragma unroll
          for (int e = 0; e < 4; ++e) { const float nl = -lm[e]; sp[e] = -8.0f * LOG2E * ((nl > 20.f) ? nl : log1pf(expf(nl))); }
#pragma unroll
          for (int tt = 0; tt < 8; ++tt) { const u32x2 xb = *(const LAS u32x2*)(Xt + (16 * tt + l15) * TP + (16 * w + 4 * g4) * 2);
              const f32x4 xc = (f32x4){bflo(xb.x), bfhi(xb.x), bflo(xb.y), bfhi(xb.y)};
#pragma unroll
              for (int e = 0; e < 4; ++e) { const float r = fast_sigmoid_l2(LOG2E * (ca[tt][e] + ba[e])), gi = fast_sigmoid_l2(LOG2E * (ci[tt][e] + bi[e]));
                  const float a = __builtin_amdgcn_exp2f(r * sp[e]);
                  ca[tt][e] = a; ci[tt][e] = __builtin_amdgcn_sqrtf(fmaxf(__builtin_fmaf(-a, a, 1.0f), 0.f)) * gi * xc[e]; } } }
        }
        __syncthreads();
#pragma unroll
        for (int tt = 0; tt < 8; ++tt) { const int tok = 16 * tt + l15;
            *(LAS f32x4*)(LA + tok * 132 + 16 * w + 4 * g4) = ca[tt];
            *(LAS u32x2*)(LB + tok * TP + (16 * w + 4 * g4) * 2) = (u32x2){cvt_pk_bf16(ci[tt][0], ci[tt][1]), cvt_pk_bf16(ci[tt][2], ci[tt][3])}; }
        __syncthreads();
        { const int un = u + p.G; if (un < 128 * 10) { C2_LOADX(un, 0, xv0); } }
        const int ch = tid & 127, q = tid >> 7, chg = n * 128 + ch;
        {
        if (T < 128) {
            float P_ = 1.f, H_ = 0.f;
#pragma unroll 4
            for (int t = 32 * q; t < 32 * q + 32; ++t) { const float a = LA[t * 132 + ch], b = bf2f(*(const LAS bf16*)(LB + t * TP + ch * 2)); H_ = a * H_ + b; P_ *= a; }
            QT[(q * 128 + ch) * 2] = P_; QT[(q * 128 + ch) * 2 + 1] = H_;
            __syncthreads();
            float h = 0.f, pc = 1.f;
#pragma unroll
            for (int qq = 0; qq < 3; ++qq) if (qq < q) { const float Pq = QT[(qq * 128 + ch) * 2], Hq = QT[(qq * 128 + ch) * 2 + 1]; h = Pq * h + Hq; pc *= Pq; }
#pragma unroll 4
            for (int t = 32 * q; t < 32 * q + 32; ++t) { const float a = LA[t * 132 + ch], b = bf2f(*(const LAS bf16*)(LB + t * TP + ch * 2)); h = a * h + b; pc *= a;
                LA[t * 132 + ch] = pc; *(LAS bf16*)(LB + t * TP + ch * 2) = (bf16)f2bf(h); }
            if (q == 3) { AGG[((size_t)T * 2) * 1280 + chg] = pc; AGG[((size_t)T * 2 + 1) * 1280 + chg] = h; }
        } else {
            for (int bb = 8 * q; bb < 8 * q + 8; ++bb) { float h = h0s[(size_t)bb * 1280 + chg];
#pragma unroll
                for (int i = 0; i < 4; ++i) { const int t = 4 * bb + i; const float a = LA[t * 132 + ch], b = bf2f(*(const LAS bf16*)(LB + t * TP + ch * 2)); h = a * h + b;
                    LA[t * 132 + ch] = 0.f; *(LAS bf16*)(LB + t * TP + ch * 2) = (bf16)f2bf(h); }
                if (out_hs) out_hs[(size_t)bb * 1280 + chg] = h; }
        }
        }
        __syncthreads();
#pragma unroll
        for (int i = 0; i < 4; ++i) { const int cidx = tid + 512 * i, tok = cidx >> 4, c8 = (cidx & 15) * 8; const size_t o = (size_t)(row0 + tok) * 1280 + n * 128 + c8;
            *(u32x4*)(LH + o) = *(const LAS u32x4*)(LB + tok * TP + c8 * 2);
            *(u32x4*)(CPB + o) = pack8(*(const LAS f32x4*)(LA + tok * 132 + c8), *(const LAS f32x4*)(LA + tok * 132 + c8 + 4)); }
        __syncthreads();
    }
#undef C2_LOADW
#undef C2_LOADG
#undef C2_LOADX
#undef C2_CONV
    for (int it = (p.bid + 80) % p.G; it < 80; it += p.G) c2_sample_item(p, j, it, out_hs);
}
__device__ __forceinline__ void c5_fixup(const P& p, float* out_hp) {
    const bf16* LH = p.w<bf16>(WS_AA); const bf16* CPB = p.w<bf16>(WS_BB); const float* AGG = p.w<float>(WS_AGG); const bf16* GATE = p.w<bf16>(WS_GATE); bf16* GH = p.w<bf16>(WS_GH);
    LAS float* cr = (LAS float*)p.lds;
    const int tid = p.tid;
    for (int ci = p.bid * 512 + tid; ci < 128 * 160; ci += p.G * 512) { const size_t o = (size_t)MP * 1280 + (size_t)ci * 8;
        const u32x4 lh = *(const u32x4*)(LH + o), gt = *(const u32x4*)(GATE + o); f32x4 r0, r1;
        r0[0] = bflo(gt.x) * bflo(lh.x); r0[1] = bfhi(gt.x) * bfhi(lh.x); r0[2] = bflo(gt.y) * bflo(lh.y); r0[3] = bfhi(gt.y) * bfhi(lh.y);
        r1[0] = bflo(gt.z) * bflo(lh.z); r1[1] = bfhi(gt.z) * bfhi(lh.z); r1[2] = bflo(gt.w) * bflo(lh.w); r1[3] = bfhi(gt.w) * bfhi(lh.w);
        *(u32x4*)(GH + o) = pack8(r0, r1); }
    for (int it = p.bid; it < 256; it += p.G) {
        const int T = it >> 1, hf = it & 1, row0 = T * 128 + 64 * hf, T0 = T & ~15, nd = T - T0;
        const size_t ob = (size_t)row0 * 1280 + (size_t)tid * 8;
#define C5_LOAD(LHV, CPV, GTV, K) do { _Pragma("unroll") for (int i = 0; i < 5; ++i) { const size_t o = ob + (size_t)(5 * (K) + i) * 4096; \
            LHV[i] = *(const u32x4*)(LH + o); CPV[i] = *(const u32x4*)(CPB + o); GTV[i] = *(const u32x4*)(GATE + o); } } while (0)
        u32x4 lhA[5], cpA[5], gtA[5], lhB[5], cpB[5], gtB[5];
        C5_LOAD(lhA, cpA, gtA, 0);
        for (int ch = tid; ch < 1280; ch += 512) {
            float pa[16], ha[16];
#pragma unroll
            for (int d = 0; d < 16; ++d) { pa[d] = AGG[((size_t)(T0 + d) * 2) * 1280 + ch]; ha[d] = AGG[((size_t)(T0 + d) * 2 + 1) * 1280 + ch]; }
            float c = 0.f;
#pragma unroll
            for (int d = 0; d < 15; ++d) c = (d < nd) ? pa[d] * c + ha[d] : c;
            if (nd == 15 && hf == 1 && out_hp) out_hp[(size_t)(T >> 4) * 1280 + ch] = pa[15] * c + ha[15];
            cr[ch] = c; }
        __syncthreads();
#define C5_ITEM(LHV, CPV, GTV, I) do { const int c8 = ((tid + 512 * (I)) % 160) * 8; const size_t o = ob + (size_t)(I) * 4096; \
            const f32x4 c0 = *(const LAS f32x4*)(cr + c8), c1 = *(const LAS f32x4*)(cr + c8 + 4); f32x4 r0, r1; \
            r0[0] = bflo(GTV.x) * (bflo(LHV.x) + bflo(CPV.x) * c0[0]); r0[1] = bfhi(GTV.x) * (bfhi(LHV.x) + bfhi(CPV.x) * c0[1]); \
            r0[2] = bflo(GTV.y) * (bflo(LHV.y) + bflo(CPV.y) * c0[2]); r0[3] = bfhi(GTV.y) * (bfhi(LHV.y) + bfhi(CPV.y) * c0[3]); \
            r1[0] = bflo(GTV.z) * (bflo(LHV.z) + bflo(CPV.z) * c1[0]); r1[1] = bfhi(GTV.z) * (bfhi(LHV.z) + bfhi(CPV.z) * c1[1]); \
            r1[2] = bflo(GTV.w) * (bflo(LHV.w) + bflo(CPV.w) * c1[2]); r1[3] = bfhi(GTV.w) * (bfhi(LHV.w) + bfhi(CPV.w) * c1[3]); \
            *(u32x4*)(GH + o) = pack8(r0, r1); } while (0)
        C5_LOAD(lhB, cpB, gtB, 1);
#pragma unroll
        for (int i = 0; i < 5; ++i) C5_ITEM(lhA[i], cpA[i], gtA[i], i);
        C5_LOAD(lhA, cpA, gtA, 2);
#pragma unroll
        for (int i = 0; i < 5; ++i) C5_ITEM(lhB[i], cpB[i], gtB[i], 5 + i);
        C5_LOAD(lhB, cpB, gtB, 3);
#pragma unroll
        for (int i = 0; i < 5; ++i) C5_ITEM(lhA[i], cpA[i], gtA[i], 10 + i);
#pragma unroll
        for (int i = 0; i < 5; ++i) C5_ITEM(lhB[i], cpB[i], gtB[i], 15 + i);
#undef C5_LOAD
#undef C5_ITEM
        __syncthreads();
    }
}
__device__ __forceinline__ void final_norm(const P& p, float* out_yp, float* out_ys) {
    const bf16* HB = p.w<bf16>(WS_HB); const long long* ssq = p.stat(ST_SSQ0 + 8); const float* g = p.in[8];
    const int gw = p.bid * NWAVES + p.wave, NGW = p.G * NWAVES, lane = p.lane;
    f32x4 gv[4];
#pragma unroll
    for (int jj = 0; jj < 4; ++jj) gv[jj] = *(const f32x4*)(g + 4 * lane + 256 * jj);
    u32x2 hw[4], hn[4]; long long sq = 0, sn = 0;
    if (gw < MT) { sq = ssq[gw];
#pragma unroll
        for (int jj = 0; jj < 4; ++jj) hw[jj] = *(const u32x2*)(HB + (size_t)gw * 1024 + 4 * lane + 256 * jj); }
    for (int m = gw; m < MT; m += NGW) { float* o = m < MP ? out_yp + (size_t)m * 1024 : out_ys + (size_t)(m - MP) * 1024;
        const int mn = (m + NGW < MT) ? m + NGW : m; sn = ssq[mn];
#pragma unroll
        for (int jj = 0; jj < 4; ++jj) hn[jj] = *(const u32x2*)(HB + (size_t)mn * 1024 + 4 * lane + 256 * jj);
        const float rs = rsqrtf((float)sq * ST_INV * (1.0f / 1024.0f) + RMS_EPS);
#pragma unroll
        for (int jj = 0; jj < 4; ++jj) *(f32x4*)(o + 4 * lane + 256 * jj) = (f32x4){bflo(hw[jj].x), bfhi(hw[jj].x), bflo(hw[jj].y), bfhi(hw[jj].y)} * rs * gv[jj];
#pragma unroll
        for (int jj = 0; jj < 4; ++jj) hw[jj] = hn[jj];
        sq = sn; }
}
}
namespace mk {
struct Args { const float* in[36]; float* out; unsigned char* ws; int ph_lo, ph_hi, li, mask; };
constexpr int NPHASE = 34;

#define MK_GEMM(EpiT, E, Aptr, LDA, Bptr, LDB, KD, NC) do { pg8::Gemm g_{(const pg8::bf16_t*)(Aptr), (const pg8::bf16_t*)(Bptr), (LDA), (LDB), (KD)}; pg8::StaticOrder S_; S_.init(MP, (NC), p.G, p.bid); \
        pg8::gemm_phase<EpiT, pg8::StaticOrder, MK_ALIGN_EPI, MK_SP2>(p.lds, g_, S_, E, p.tid); \
          \
        P q_ = p; { int t2_ = p0.tid; asm volatile("" : "+v"(t2_)); q_.tid = t2_; q_.lane = t2_ & 63; q_.wave = __builtin_amdgcn_readfirstlane(t2_ >> 6); } \
        if (MK_MINI_ON) mini_gemm<EpiT>(q_, (const bf16*)(Aptr), (LDA), (const bf16*)(Bptr), (LDB), (KD), (NC), E, (64 * ((NC) / 256)) % p.G); } while (0)

#ifndef MK_SP2
#define MK_SP2 true
#endif
#ifndef MK_ALIGN_EPI
#define MK_ALIGN_EPI true
#endif
#ifdef MK_DRYPROBE
#define MK_DRYARG , ((mask >> 10) & 1)
#define MK_MINI_ON ((mask >> 11) & 1)
#else
#define MK_DRYARG
#define MK_MINI_ON 1
#endif
#ifndef MK_REP_SEL
#define MK_REP_SEL(k) 0
#define MK_REP_N 1
#endif
#define REPF(k) for (int rep_ = 0; rep_ < (MK_REP_SEL(k) ? MK_REP_N : 1); ++rep_)
#define IN_(k) (lo <= (k) && (k) < hi)
#define PH_BEGIN() P p = p0; { int z_ = 0, t_ = p0.tid, g_ = p0.G, b_ = p0.bid; unsigned l_ = (unsigned)(size_t)p0.lds; asm volatile("" : "+s"(z_), "+v"(t_), "+s"(g_), "+s"(b_), "+s"(l_)); p.ws = p0.ws + z_; p.out = p0.out + z_; p.tid = t_; p.lane = t_ & 63; p.wave = __builtin_amdgcn_readfirstlane(t_ >> 6); p.G = g_; p.bid = b_; p.lds = (LAS unsigned char*)(size_t)l_; } float* const out = p.out; (void)out
#ifdef MK_PROF
#define STAMP(k) do { if (p0.bid == 0 && p0.tid == 0) ((unsigned long long*)(p0.ws + WS_PROF))[(k)] = (unsigned long long)wall_clock64(); } while (0)
#else
#define STAMP(k) do { } while (0)
#endif
#define ENDPH(k) do { if ((k) + 1 < hi) xcd_barrier(bar); STAMP((k) + 1); } while (0)
template <int LAYER> __device__ __forceinline__ void run_layer(const P& p0, const XcdBarrier& bar, const int lo, const int hi, const int mask) {
        constexpr int layer = LAYER, kind = layer % 3, j = layer / 3, pb = 1 + 8 * layer;
        constexpr size_t resA = kind == 0 ? WS_UM : kind == 1 ? WS_OB : WS_GH, resB = kind == 0 ? WS_WOUT + (size_t)j * 2 * MiB : kind == 1 ? WS_WOV : WS_WCO; constexpr int resK = kind == 0 ? 1024 : kind == 1 ? 2048 : 1280;
        if constexpr (kind == 0) {
            if (IN_(pb)) REPF(pb) { PH_BEGIN(); EpiA1 E{p.w<bf16>(WS_U), p.w<bf16>(WS_GV), p.stat(ST_SSQ0 + 2 * layer), p.stat(ST_LNS0 + 2 * j), p.stat(ST_LNQ0 + 2 * j) MK_DRYARG};
                MK_GEMM(EpiA1, E, p.w<bf16>(WS_HB), 1024, p.w<bf16>(WS_WIN + (size_t)j * 4 * MiB), 1024, 1024, 2048); ENDPH(pb); }
            if (IN_(pb + 1)) REPF(pb + 1) { PH_BEGIN(); a2_spatial(p, j, out + O_CV + (size_t)j * 131072); ENDPH(pb + 1); }
        } else if constexpr (kind == 1) {
            if (IN_(pb)) REPF(pb) { PH_BEGIN(); EpiB1 E{p.w<float>(WS_RAW), p.w<bf16>(WS_CQB), p.stat(ST_SSQ0 + 2 * layer), p.stat(ST_KV), p.stat(ST_Q) MK_DRYARG};
                MK_GEMM(EpiB1, E, p.w<bf16>(WS_HB), 1024, p.w<bf16>(WS_WDQKV), 1024, 1024, 768); ENDPH(pb); }
            if (IN_(pb + 1)) REPF(pb + 1) { PH_BEGIN(); b2_kvfinal(p, out + O_MP, out + O_MS);
                EpiB2 E{p.w<bf16>(WS_QF), p.stat(ST_Q), p.w<f32x2>(WS_ROPE)};
                MK_GEMM(EpiB2, E, p.w<bf16>(WS_CQB), 384, p.w<bf16>(WS_WQ), 384, 384, 2560); ENDPH(pb + 1); }
            if (IN_(pb + 2)) REPF(pb + 2) { PH_BEGIN();
                if (mask & 256) b3_attn_prompt(p); if (mask & 512) b3_attn_sample(p);
                ENDPH(pb + 2); }
            if (IN_(pb + 3)) REPF(pb + 3) { PH_BEGIN(); b3_combine(p); ENDPH(pb + 3); }
        } else {
            if (IN_(pb)) REPF(pb) { PH_BEGIN(); EpiC1 E{p.w<bf16>(WS_GATE), p.w<float>(WS_XW), p.stat(ST_SSQ0 + 2 * layer)};
                MK_GEMM(EpiC1, E, p.w<bf16>(WS_HB), 1024, p.w<bf16>(WS_WGX), 1024, 1024, 2560); ENDPH(pb); }
            if (IN_(pb + 1)) REPF(pb + 1) { PH_BEGIN(); c2_rglru(p, j, out + O_CP, out + O_CS, out + O_HS, mask); ENDPH(pb + 1); }
            if (IN_(pb + 3)) REPF(pb + 3) { PH_BEGIN(); c5_fixup(p, out + O_HP); ENDPH(pb + 3); }
        }
        if (IN_(pb + 5)) REPF(pb + 5) { PH_BEGIN(); EpiRes E{p.w<bf16>(WS_HB), p.stat(ST_SSQ0 + 2 * layer + 1) MK_DRYARG}; MK_GEMM(EpiRes, E, p.w<bf16>(resA), resK, p.w<bf16>(resB), resK, resK, 1024); ENDPH(pb + 5); }
        if (IN_(pb + 6)) REPF(pb + 6) { PH_BEGIN(); EpiF1 E{p.w<bf16>(WS_ACT), p.stat(ST_SSQ0 + 2 * layer + 1)}; MK_GEMM(EpiF1, E, p.w<bf16>(WS_HB), 1024, p.w<bf16>(WS_WGU + (size_t)layer * WGU_BYTES), 1024, 1024, 5632); ENDPH(pb + 6); }
        if (IN_(pb + 7)) REPF(pb + 7) { PH_BEGIN(); EpiRes E{p.w<bf16>(WS_HB), p.stat(ST_SSQ0 + 2 * layer + 2) MK_DRYARG}; MK_GEMM(EpiRes, E, p.w<bf16>(WS_ACT), DFF, p.w<bf16>(WS_WD + (size_t)layer * WD_BYTES), DFF, DFF, 1024); ENDPH(pb + 7); }
}
__global__ void __launch_bounds__(NWAVES * 64, 2) mk_fwd(Args a) {
    extern __shared__ __attribute__((aligned(16))) unsigned char lds_raw[];
    const int tid_ = threadIdx.x;
    const P p0{InTab{(const float* const __attribute__((address_space(4)))*)__builtin_amdgcn_kernarg_segment_ptr()}, a.out, a.ws, (LAS unsigned char*)lds_raw, tid_, tid_ & 63, __builtin_amdgcn_readfirstlane(tid_ >> 6), (int)gridDim.x, (int)blockIdx.x};
    volatile LAS unsigned* MISC = (volatile LAS unsigned*)(p0.lds + MISC_OFF);
    if (p0.tid < 64) MISC[p0.tid] = 0u;
    __syncthreads();
    XcdBarrier bar = xcd_barrier_post((unsigned*)(a.ws + WS_CTL) + CW_BAR + a.li * XCD_BAR_WORDS, MISC + 8);
    const int lo = a.ph_lo, hi = a.ph_hi, mask = a.mask;
    STAMP(0);
    if (IN_(0)) REPF(0) { PH_BEGIN(); p0_prologue(p, mask); if (mask & 128)
        { const int gt = p.bid * 512 + p.tid, NGT = p.G * 512; const u32x4 z = (u32x4){0u, 0u, 0u, 0u};
          for (int i = gt; i < 128 * 128; i += NGT) p.w<u32x4>(WS_UM + (size_t)MT * 2048)[i] = z;
          for (int i = gt; i < 128 * 256; i += NGT) p.w<u32x4>(WS_OB + (size_t)MT * 4096)[i] = z;
          for (int i = gt; i < 128 * 160; i += NGT) p.w<u32x4>(WS_GH + (size_t)MT * 2560)[i] = z; }
        ENDPH(0); }
    run_layer<0>(p0, bar, lo, hi, mask); run_layer<1>(p0, bar, lo, hi, mask); run_layer<2>(p0, bar, lo, hi, mask); run_layer<3>(p0, bar, lo, hi, mask);
    if (IN_(33)) REPF(33) { PH_BEGIN(); final_norm(p, out + O_YP, out + O_YS); VM_WAIT(); STAMP(34); }
#undef IN_
#undef ENDPH
}

inline void fill_args(Args& a, void* const* d_in, float* out, void* d_ws) { for (int i = 0; i < 36; ++i) a.in[i] = (const float*)d_in[i]; a.out = out; a.ws = (unsigned char*)d_ws; a.mask = -1; }
inline int setup_grid() {
    static int grid = 0;
    if (!grid) { int dev = 0, cus = 0; hipGetDevice(&dev); hipDeviceGetAttribute(&cus, hipDeviceAttributeMultiprocessorCount, dev);
        hipFuncSetAttribute((const void*)mk_fwd, hipFuncAttributeMaxDynamicSharedMemorySize, LDS_BYTES);
        int per_cu = 0; hipOccupancyMaxActiveBlocksPerMultiprocessor(&per_cu, (const void*)mk_fwd, NWAVES * 64, LDS_BYTES); (void)hipGetLastError();
        grid = cus > 0 ? cus : 256; }
    return grid;
}
inline void launch_range(void* const* d_in, float* out, void* d_ws, hipStream_t st, int lo, int hi, int li, int mask = -1) {
    Args a{}; fill_args(a, d_in, out, d_ws); a.ph_lo = lo; a.ph_hi = hi; a.li = li; a.mask = mask;
    hipLaunchKernelGGL(mk_fwd, dim3(setup_grid()), dim3(NWAVES * 64), LDS_BYTES, st, a);
}
}

extern "C" void kernel_launch(void* const* d_in, const int* in_sizes, int n_in, void* d_out, int out_size, void* d_ws, size_t ws_size, hipStream_t stream) {
    hipMemsetAsync(d_ws, 0, mk::CTL_BYTES, stream);
    mk::launch_range(d_in, (float*)d_out, d_ws, stream, 0, mk::NPHASE, 0);
}
```

```cpp
#include <hip/hip_runtime.h>
#include <math.h>
#define LAS __attribute__((address_space(3)))
#define GAS __attribute__((address_space(1)))
namespace pg8 {
#define PG8_LAS __attribute__((address_space(3)))
typedef unsigned short bf16_t;
typedef short bf16x8 __attribute__((ext_vector_type(8)));
typedef float f32x4 __attribute__((ext_vector_type(4)));
typedef unsigned u32x4 __attribute__((ext_vector_type(4)));
constexpr int BM = 256, BK = 64, HALF = 128, HTB = HALF * BK * 2  , STAGE_BYTES = 8 * HTB, NXCD = 8, WGM = 8;
__host__ __device__ __forceinline__ int lds_byte(int r, int c) { const int st = (r >> 4) * 2 + (c >> 5), rr = r & 15, cc = c & 31, ob = rr * 64 + cc * 2; return st * 1024 + (ob ^ (((ob >> 9) & 1) << 5)); }
__host__ __device__ __forceinline__ void stage_rc(int b, int& R, int& C) { const int st = b / 1024, sb = b % 1024, swz = sb ^ (((sb >> 9) & 1) << 5); R = (st >> 1) * 16 + swz / 64; C = (st & 1) * 32 + (swz % 64) / 2; }
__host__ __device__ __forceinline__ int perm32(int rho) { const int n = rho >> 4, i = rho & 15; return 8 * (i >> 2) + 4 * n + (i & 3); }
struct Unit { int pm, pn; };
struct Gemm { const bf16_t* A; const bf16_t* Bt; int lda, ldb, K; };
struct StaticOrder {
    int nM, nN, nwg, G, c;
    __host__ __device__ void init(int M, int N, int G_, int c_) { nM = M / BM; nN = N / BM; nwg = nM * nN; G = G_; c = c_; }
    __host__ __device__ bool next(int i, Unit& u) const {
        const long L = (long)i * G + c; if (L >= nwg) return false;
        int wgid = (int)L; { const int q = nwg / NXCD, r = nwg % NXCD, xcd = wgid % NXCD, off = wgid / NXCD; wgid = (xcd < r ? xcd * (q + 1) : r * (q + 1) + (xcd - r) * q) + off; }
        const int nig = WGM * nN, gid = wgid / nig, fm = gid * WGM, gsz = (nM - fm) < WGM ? (nM - fm) : WGM;
        u.pm = fm + ((wgid % nig) % gsz); u.pn = (wgid % nig) / gsz; return true;
    }
    __device__ __forceinline__ void a_ready(const Unit&) const {}
    __device__ __forceinline__ void done(const Unit&) const {}
};
__device__ __forceinline__ unsigned cvt_pk_bf16(float lo, float hi) { unsigned r; asm volatile("v_cvt_pk_bf16_f32 %0, %1, %2" : "=v"(r) : "v"(lo), "v"(hi)); return r; }
template <class Epi, class Sched, bool ALIGN_EPI = false, bool SP2 = false>
__device__ __forceinline__ void gemm_phase(PG8_LAS unsigned char* lds, const Gemm g, const Sched& S, const Epi& E, const int tid) {
    const int wid = __builtin_amdgcn_readfirstlane(tid >> 6), lane = tid & 63, wr = wid >> 2, wc = wid & 3, fr = lane & 15, fq = lane >> 4;
    const int K = g.K, nt = K / BK, lda = g.lda, ldb = g.ldb;
    unsigned voffA[2], voffB[2];
#pragma unroll
    for (int i = 0; i < 2; ++i) { int R, C; stage_rc(tid * 16 + i * 8192, R, C); const int Rb = Epi::PERM ? ((R & ~31) + perm32(R & 31)) : R;
        voffA[i] = (unsigned)(R * lda + C) * 2u; voffB[i] = (unsigned)(Rb * ldb + C) * 2u; }
    const size_t kstep = (size_t)(BK * 2);
    const size_t hstepA = (size_t)HALF * lda * 2, hstepB = (size_t)HALF * ldb * 2;
    const size_t tstepA = 2 * hstepA, tstepB = 2 * hstepB;
    const unsigned ldsw = (unsigned)wid * 1024u;
    const int aoff = lds_byte(wr * 64 + fr, fq * 8), boff = lds_byte(wc * 32 + fr, fq * 8);
#define PG8_SA(b, h) (((b) * 2 + (h)) * HTB)
#define PG8_SB(b, h) ((4 + (b) * 2 + (h)) * HTB)
#define PG8_STAGE(bufoff, gbase, voff) do { _Pragma("unroll") for (int _i = 0; _i < 2; ++_i) \
        __builtin_amdgcn_global_load_lds((const unsigned*)((const char*)(gbase) + (voff)[_i]), (PG8_LAS unsigned*)(lds + (bufoff) + ldsw + _i * 8192), 16, 0, 0); } while (0)
#define PG8_LDA(dst, b, h) do { _Pragma("unroll") for (int m = 0; m < 4; ++m) _Pragma("unroll") for (int k = 0; k < 2; ++k) dst[m][k] = *(const PG8_LAS bf16x8*)(lds + PG8_SA(b, h) + aoff + m * 2048 + k * 1024); } while (0)
#define PG8_LDB(dst, b, h) do { _Pragma("unroll") for (int n = 0; n < 2; ++n) _Pragma("unroll") for (int k = 0; k < 2; ++k) dst[n][k] = *(const PG8_LAS bf16x8*)(lds + PG8_SB(b, h) + boff + n * 2048 + k * 1024); } while (0)
#define PG8_MMA(ai, bj, At, Bt) do { __builtin_amdgcn_s_setprio(1); _Pragma("unroll") for (int m = 0; m < 4; ++m) _Pragma("unroll") for (int n = 0; n < 2; ++n) _Pragma("unroll") for (int k = 0; k < 2; ++k) \
        acc[ai][bj][m][n] = __builtin_amdgcn_mfma_f32_16x16x32_bf16(Bt[n][k], At[m][k], acc[ai][bj][m][n], 0, 0, 0); __builtin_amdgcn_s_setprio(0); } while (0)
#define PG8_WAIT_V(n) asm volatile("s_waitcnt vmcnt(" #n ")" ::: "memory")
#define PG8_WAIT_L(n) asm volatile("s_waitcnt lgkmcnt(" #n ")" ::: "memory")
#define PG8_BAR __builtin_amdgcn_s_barrier()
#define PG8_SCHED __builtin_amdgcn_sched_barrier(0)
    Unit cur, nxt; int ui = 0;
    if (!S.next(0, cur)) return;
    f32x4 acc[2][2][4][2];
    E.init(acc, cur, wr, wc, fr, fq);
    bf16x8 At[4][2], B0[2][2], B1[2][2];
    const char* cA = (const char*)g.A + (size_t)cur.pm * tstepA; const char* cB = (const char*)g.Bt + (size_t)cur.pn * tstepB;
    S.a_ready(cur);
    if constexpr (SP2) {
        PG8_STAGE(PG8_SB(0, 0), cB, voffB); PG8_STAGE(PG8_SB(0, 1), cB + hstepB, voffB); PG8_STAGE(PG8_SA(0, 0), cA, voffA); PG8_STAGE(PG8_SA(0, 1), cA + hstepA, voffA);
        if (wr == 1) PG8_BAR;
        PG8_WAIT_V(2); PG8_BAR;
        PG8_STAGE(PG8_SB(1, 0), cB + kstep, voffB); PG8_STAGE(PG8_SA(1, 0), cA + kstep, voffA); PG8_STAGE(PG8_SB(1, 1), cB + hstepB + kstep, voffB);
        PG8_WAIT_V(6); PG8_BAR;
    } else {
        PG8_STAGE(PG8_SB(0, 0), cB, voffB); PG8_STAGE(PG8_SA(0, 0), cA, voffA); PG8_STAGE(PG8_SB(0, 1), cB + hstepB, voffB); PG8_STAGE(PG8_SA(0, 1), cA + hstepA, voffA);
        if (wr == 1) PG8_BAR;
        PG8_WAIT_V(4); PG8_BAR;
        PG8_STAGE(PG8_SB(1, 0), cB + kstep, voffB); PG8_STAGE(PG8_SA(1, 0), cA + kstep, voffA); PG8_STAGE(PG8_SB(1, 1), cB + hstepB + kstep, voffB);
        PG8_WAIT_V(6); PG8_BAR;
    }
    for (;;) {
        const bool has_next = S.next(ui + 1, nxt);
        const char* nA = has_next ? (const char*)g.A + (size_t)nxt.pm * tstepA : cA; const char* nB = has_next ? (const char*)g.Bt + (size_t)nxt.pn * tstepB : cB;
        for (int t = 0; t < nt; t += 2) {
            const bool last = (t == nt - 2);
            const char* a1 = cA + (size_t)(t + 1) * kstep;
            const char* a2 = last ? nA : cA + (size_t)(t + 2) * kstep; const char* b2 = last ? nB : cB + (size_t)(t + 2) * kstep;
            const char* a3 = a2 + kstep; const char* b3 = b2 + kstep;
            if (last && has_next) S.a_ready(nxt);
            if constexpr (SP2) {
            PG8_LDB(B0, 0, 0); PG8_LDB(B1, 0, 1); PG8_SCHED; PG8_LDA(At, 0, 0); PG8_STAGE(PG8_SA(1, 1), a1 + hstepA, voffA);
            PG8_WAIT_V(8); PG8_WAIT_L(0); PG8_BAR; PG8_MMA(0, 0, At, B0); PG8_MMA(0, 1, At, B1); PG8_BAR; PG8_SCHED;
            PG8_LDA(At, 0, 1); PG8_STAGE(PG8_SB(0, 0), b2, voffB); PG8_STAGE(PG8_SB(0, 1), b2 + hstepB, voffB); PG8_STAGE(PG8_SA(0, 0), a2, voffA);
            PG8_WAIT_V(8); PG8_WAIT_L(0); PG8_BAR; PG8_MMA(1, 0, At, B0); PG8_MMA(1, 1, At, B1); PG8_BAR; PG8_SCHED;
            PG8_LDB(B0, 1, 0); PG8_LDB(B1, 1, 1); PG8_SCHED; PG8_LDA(At, 1, 0); PG8_STAGE(PG8_SA(0, 1), a2 + hstepA, voffA);
            PG8_WAIT_V(8); PG8_WAIT_L(0); PG8_BAR; PG8_MMA(0, 0, At, B0); PG8_MMA(0, 1, At, B1); PG8_BAR; PG8_SCHED;
            PG8_LDA(At, 1, 1); PG8_STAGE(PG8_SB(1, 0), b3, voffB); PG8_STAGE(PG8_SB(1, 1), b3 + hstepB, voffB); PG8_STAGE(PG8_SA(1, 0), a3, voffA);
            PG8_WAIT_V(8); PG8_WAIT_L(0); PG8_BAR; PG8_MMA(1, 0, At, B0); PG8_MMA(1, 1, At, B1); PG8_BAR; PG8_SCHED;
            } else {
            PG8_LDB(B0, 0, 0); PG8_SCHED; PG8_LDA(At, 0, 0); PG8_STAGE(PG8_SA(1, 1), a1 + hstepA, voffA);
            PG8_WAIT_L(8); PG8_BAR; PG8_WAIT_L(0); PG8_MMA(0, 0, At, B0); PG8_BAR; PG8_SCHED;
            PG8_LDB(B1, 0, 1); PG8_STAGE(PG8_SB(0, 0), b2, voffB);
            PG8_BAR; PG8_WAIT_L(0); PG8_MMA(0, 1, At, B1); PG8_BAR;
            PG8_LDA(At, 0, 1); PG8_STAGE(PG8_SA(0, 0), a2, voffA);
            PG8_BAR; PG8_WAIT_L(0); PG8_MMA(1, 0, At, B0); PG8_BAR; PG8_SCHED;
            PG8_STAGE(PG8_SB(0, 1), b2 + hstepB, voffB);
            PG8_WAIT_V(6); PG8_BAR; PG8_MMA(1, 1, At, B1); PG8_BAR;
            PG8_LDB(B0, 1, 0); PG8_SCHED; PG8_LDA(At, 1, 0); PG8_STAGE(PG8_SA(0, 1), a2 + hstepA, voffA);
            PG8_WAIT_L(8); PG8_BAR; PG8_WAIT_L(0); PG8_MMA(0, 0, At, B0); PG8_BAR; PG8_SCHED;
            PG8_LDB(B1, 1, 1); PG8_STAGE(PG8_SB(1, 0), b3, voffB);
            PG8_BAR; PG8_WAIT_L(0); PG8_MMA(0, 1, At, B1); PG8_BAR;
            PG8_LDA(At, 1, 1); PG8_STAGE(PG8_SA(1, 0), a3, voffA);
            PG8_BAR; PG8_WAIT_L(0); PG8_MMA(1, 0, At, B0); PG8_BAR; PG8_SCHED;
            PG8_STAGE(PG8_SB(1, 1), b3 + hstepB, voffB);
            PG8_WAIT_V(6); PG8_BAR; PG8_MMA(1, 1, At, B1); PG8_BAR;
            }
        }
        if constexpr (ALIGN_EPI) { if (wr == 0) PG8_BAR; }
        if constexpr (!Epi::AFTER_DRAIN) { E(acc, cur, wr, wc, fr, fq); S.done(cur); }
        if (!has_next) break;
        E.init(acc, nxt, wr, wc, fr, fq);
        cur = nxt; cA = nA; cB = nB; ++ui;
        if constexpr (ALIGN_EPI) { if (wr == 1) PG8_BAR; }
    }
    PG8_WAIT_V(0);
    if constexpr (!ALIGN_EPI) { if (wr == 0) PG8_BAR; }
    PG8_BAR;
    if constexpr (Epi::AFTER_DRAIN) { E.fused(acc, cur, wr, wc, fr, fq, lds, wid, lane); S.done(cur); }
#undef PG8_SA
#undef PG8_SB
#undef PG8_STAGE
#undef PG8_LDA
#undef PG8_LDB
#undef PG8_MMA
#undef PG8_WAIT_V
#undef PG8_WAIT_L
#undef PG8_BAR
#undef PG8_SCHED
}

}

namespace mk {
using pg8::f32x4; using pg8::bf16x8; using pg8::u32x4; using pg8::cvt_pk_bf16;
typedef unsigned short bf16;
typedef unsigned u32x2 __attribute__((ext_vector_type(2)));
typedef short s16x4 __attribute__((ext_vector_type(4)));
typedef float f32x2 __attribute__((ext_vector_type(2)));
typedef GAS unsigned gu32;
#define RLX_AGENT __ATOMIC_RELAXED, __HIP_MEMORY_SCOPE_AGENT
#define XB_TMO      128
#define XB_XCNT(j)  (256  + 64 * (j))
#define XB_XSUB(j)  (1280 + 64 * (j))
#define XB_XGEN(j)  (2304 + 64 * (j))
#define XB_TOP      3328
#define XB_TOPGEN   3392
#define XCD_BAR_WORDS 3456
#define XB_SPIN_CAP (1u << 18)

__device__ __forceinline__ unsigned xb_ld(unsigned* p)              { return __hip_atomic_load(p, __ATOMIC_RELAXED, __HIP_MEMORY_SCOPE_AGENT); }
__device__ __forceinline__ unsigned xb_add(unsigned* p, unsigned v) { return __hip_atomic_fetch_add(p, v, __ATOMIC_RELAXED, __HIP_MEMORY_SCOPE_AGENT); }
__device__ __forceinline__ unsigned xb_xcc_id() { return (unsigned)__builtin_amdgcn_s_getreg((3 << 11) | 20) & 0xFu; }
#define XB_SPIN(cond, bar) do { unsigned _sp = 0; while (cond) { __builtin_amdgcn_s_sleep(1); \
    if ((++_sp & 255u) == 0u) { if (xb_ld(&(bar)[XB_TMO])) break; if (_sp > XB_SPIN_CAP) { atomicAdd(&(bar)[XB_TMO], 1u); break; } } } } while (0)

struct XcdBarrier {
    unsigned* bar; unsigned x;
    volatile LAS unsigned* st;
};

__device__ __forceinline__ XcdBarrier xcd_barrier_post(unsigned* bar, volatile LAS unsigned* st) {
    XcdBarrier b; b.bar = bar; b.x = xb_xcc_id(); b.st = st;
    if (threadIdx.x == 0) (void)xb_add(&bar[XB_XCNT(b.x)], 1u);
    return b;
}
__device__ __forceinline__ void xcd_barrier_complete(unsigned* bar, unsigned x, unsigned& nloc, unsigned& nx) {
    const unsigned G = gridDim.x * gridDim.y * gridDim.z;
    unsigned sum, cnt, mine, sp = 0u;
    for (;;) {
        sum = 0u; cnt = 0u; mine = 0u;
#pragma unroll
        for (unsigned j = 0; j < 16; ++j) { const unsigned c = xb_ld(&bar[XB_XCNT(j)]); sum += c; cnt += (c > 0u) ? 1u : 0u; mine = (j == x) ? c : mine; }
        if (sum == G) break;
        __builtin_amdgcn_s_sleep(1);
        if ((++sp & 255u) == 0u) { if (xb_ld(&bar[XB_TMO])) break; if (sp > XB_SPIN_CAP) { atomicAdd(&bar[XB_TMO], 1u); break; } }
    }
    nloc = mine > 0u ? mine : 1u; nx = cnt > 0u ? cnt : 1u;
}

__device__ __forceinline__ void xcd_barrier(const XcdBarrier& b) {
    asm volatile("s_waitcnt vmcnt(0)" ::: "memory");
    __syncthreads();
    if (threadIdx.x == 0) {
        unsigned* bar = b.bar;
        __builtin_amdgcn_s_waitcnt(0);
        unsigned nloc = b.st[0], nx = b.st[1];
        if (nloc == 0u) { xcd_barrier_complete(bar, b.x, nloc, nx); b.st[0] = nloc; b.st[1] = nx; }
        const unsigned old = xb_add(&bar[XB_XSUB(b.x)], 1u);
        const unsigned gen = old / nloc;
        if (old + 1u == (gen + 1u) * nloc) {
            __builtin_amdgcn_fence(__ATOMIC_RELEASE, "agent");
            asm volatile("s_waitcnt vmcnt(0)" ::: "memory");
            const unsigned og = xb_add(&bar[XB_TOP], 1u);
            const unsigned tg = og / nx;
            if (og + 1u == (tg + 1u) * nx) xb_add(&bar[XB_TOPGEN], 1u);
            else XB_SPIN(xb_ld(&bar[XB_TOPGEN]) == tg, bar);
            __builtin_amdgcn_fence(__ATOMIC_ACQUIRE, "agent");
            xb_add(&bar[XB_XGEN(b.x)], 1u);
            asm volatile("s_waitcnt vmcnt(0)" ::: "memory");
        } else {
            XB_SPIN(xb_ld(&bar[XB_XGEN(b.x)]) == gen, bar);
            __builtin_amdgcn_fence(__ATOMIC_ACQUIRE, "agent");
            asm volatile("s_waitcnt vmcnt(0)" ::: "memory");
        }
    }
    __syncthreads();
}


constexpr int MP = 16384, MS = 128, MT = MP + MS, MR = 16640;
constexpr int D = 1024, DFF = 2816, NWAVES = 8;
constexpr float RMS_EPS = 1e-6f, LN_EPS = 1e-5f;
constexpr float MLA_SCALE = 0.07216878364870322f;
constexpr size_t MiB = 1u << 20;
constexpr size_t WS_CTL = 0, CTL_BYTES = 3 * MiB;
constexpr int CW_BAR = 4096;
constexpr size_t ST_OFF = 65536, ST_STRIDE = (size_t)MR * 8;
constexpr int ST_SSQ0 = 0  , ST_LNS0 = 9, ST_LNQ0 = 10  , ST_KV = 13, ST_Q = 14, NSTAT = 15;
static_assert(ST_OFF + NSTAT * ST_STRIDE <= CTL_BYTES, "stats inside CTL");
constexpr size_t WS_WGU = 3 * MiB, WGU_BYTES = 11 * MiB, WS_WD = 47 * MiB, WD_BYTES = 5767168, WS_WIN = 69 * MiB, WS_WOUT = 77 * MiB, WS_WS = 81 * MiB,
                 WS_WDQKV = 82 * MiB, WS_WQ = 84 * MiB, WS_WOV = 86 * MiB, WS_WGX = 90 * MiB, WS_WAT = 95 * MiB, WS_WIT = 95 * MiB + 512 * 1024, WS_WCO = 96 * MiB, WS_ROPE = 99 * MiB;
constexpr size_t WS_H = 100 * MiB, WS_HB = 165 * MiB, WS_U = 198 * MiB, WS_GV = 231 * MiB, WS_UM = 264 * MiB, WS_ACT = 297 * MiB, WS_RAW = 387 * MiB, WS_CQB = 436 * MiB,
                 WS_QF = 449 * MiB, WS_KVB = 531 * MiB, WS_OB = 542 * MiB, WS_PART = 607 * MiB, WS_PML = 623 * MiB, WS_GATE = 624 * MiB, WS_XW = 665 * MiB, WS_AA = 747 * MiB, WS_BB = 829 * MiB,
                 WS_AGG = 911 * MiB, WS_GH = 914 * MiB, WS_PROF = 955 * MiB, WS_MK_END = 956 * MiB;
constexpr int RING_BYTES = 131072, LDS_BYTES = 147456, MISC_OFF = LDS_BYTES - 256;
constexpr size_t O_YP = 0, O_YS = 16777216, O_CV = 16908288, O_MP = 17170432, O_MS = 22413312, O_HP = 22454272, O_HS = 22464512, O_CP = 22505472, O_CS = 22536192, O_END = 22659072;

__device__ __forceinline__ float fast_sigmoid_l2(float t) { return __builtin_amdgcn_rcpf(1.0f + __builtin_amdgcn_exp2f(-t)); }
__device__ __forceinline__ float gelu_tanh_f(float x) { return x * fast_sigmoid_l2(2.302208198f * (x + 0.044715f * x * x * x)); }
__device__ __forceinline__ float silu_f(float x) { return x * fast_sigmoid_l2(1.4426950409f * x); }
__device__ __forceinline__ unsigned f2bf(float f) { unsigned u = __builtin_bit_cast(unsigned, f); return (u + 0x7fffu + ((u >> 16) & 1u)) >> 16; }
__device__ __forceinline__ unsigned pk2(float lo, float hi) { return f2bf(lo) | (f2bf(hi) << 16); }
__device__ __forceinline__ float bf2f(unsigned short b) { return __builtin_bit_cast(float, (unsigned)b << 16); }
__device__ __forceinline__ float bflo(unsigned w) { return __builtin_bit_cast(float, w << 16); }
__device__ __forceinline__ float bfhi(unsigned w) { return __builtin_bit_cast(float, w & 0xffff0000u); }
constexpr float ST_SCALE = 16777216.0f, ST_INV = 1.0f / 16777216.0f;
__device__ __forceinline__ void stat_add(long long* p, float v) { atomicAdd((unsigned long long*)p, (unsigned long long)(long long)__float2ll_rn(v * ST_SCALE)); }
__device__ __forceinline__ void stat_set(long long* p, float v) { *p = (long long)__float2ll_rn(v * ST_SCALE); }
__device__ __forceinline__ float stat_get(const long long* p) { return (float)(*p) * ST_INV; }
#define LDS_WAIT() asm volatile("s_waitcnt lgkmcnt(0)" ::: "memory")
#define VM_WAIT() asm volatile("s_waitcnt vmcnt(0)" ::: "memory")

struct InTab { const float* const __attribute__((address_space(4)))* t; __device__ __forceinline__ const float* operator[](int i) const { return t[i]; } };
struct P {
    InTab in; float* out; unsigned char* ws;
    LAS unsigned char* lds; int tid, lane, wave, G, bid;
    __device__ __forceinline__ long long* stat(int a) const { return (long long*)(ws + ST_OFF + (size_t)a * ST_STRIDE); }
    template <class T> __device__ __forceinline__ T* w(size_t off) const { return (T*)(ws + off); }
};
}
namespace mk {
struct TrJob { const float* src; int ldsrc, K, N; bf16* dst; int lddst; const float* gain; int kind, off; };
__device__ __forceinline__ int tr_rowmap(int kind, int off, int n) { return kind == 1 ? ((n >> 7) * 256 + (n & 127) + off) : (off + n); }
__device__ __forceinline__ void tr_item(const TrJob& j, LAS float* scr, int item, int lane) {
    const int nblk = j.N / 32, kb = item / nblk, nb = item % nblk, k0 = 64 * kb, n0 = 32 * nb;
    const float* src = j.src + (size_t)(k0 + (lane >> 5)) * j.ldsrc + n0 + (lane & 31); const size_t rstep = (size_t)2 * j.ldsrc;
    float v[32];
#pragma unroll
    for (int i = 0; i < 32; ++i) v[i] = src[i * rstep];
    if (j.gain) { const float* gp = j.gain + k0 + (lane >> 5); float g[32];
#pragma unroll
        for (int i = 0; i < 32; ++i) g[i] = gp[2 * i];
#pragma unroll
        for (int i = 0; i < 32; ++i) v[i] *= g[i]; }
#pragma unroll
    for (int i = 0; i < 32; ++i) scr[(2 * i + (lane >> 5)) * 33 + (lane & 31)] = v[i];
    LDS_WAIT(); asm volatile("" ::: "memory");
    const int c = lane & 7;
#pragma unroll
    for (int jj = 0; jj < 4; ++jj) { const int n = (lane >> 3) + 8 * jj; const LAS float* s = scr + (8 * c) * 33 + n;
        u32x4 o; o.x = pk2(s[0], s[33]); o.y = pk2(s[66], s[99]); o.z = pk2(s[132], s[165]); o.w = pk2(s[198], s[231]);
        *(u32x4*)(j.dst + (size_t)tr_rowmap(j.kind, j.off, n0 + n) * j.lddst + k0 + 8 * c) = o; }
    LDS_WAIT(); asm volatile("" ::: "memory");
}
constexpr int NJOBS = 24;
__device__ __forceinline__ TrJob get_job(const P& p, int jid) {
    TrJob j; j.gain = nullptr; j.kind = 0; j.off = 0; j.src = nullptr; j.dst = nullptr; j.ldsrc = 0; j.K = 0; j.N = 0; j.lddst = 0;
    if (jid < 12) { const int l = jid / 3, t = jid % 3;
        if (t < 2) { j.src = p.in[33 + t] + (size_t)l * D * DFF; j.ldsrc = DFF; j.K = D; j.N = DFF; j.dst = p.w<bf16>(WS_WGU + l * WGU_BYTES); j.lddst = D; j.gain = p.in[7] + l * D; j.kind = 1; j.off = 128 * t; }
        else { j.src = p.in[35] + (size_t)l * DFF * D; j.ldsrc = D; j.K = DFF; j.N = D; j.dst = p.w<bf16>(WS_WD + l * WD_BYTES); j.lddst = DFF; }
    } else if (jid < 16) { const int a = (jid - 12) >> 1;
        if (((jid - 12) & 1) == 0) { j.src = p.in[9] + (size_t)a * D * 2048; j.ldsrc = 2048; j.K = D; j.N = 2048; j.dst = p.w<bf16>(WS_WIN + a * 4 * MiB); j.lddst = D; j.gain = p.in[6] + (3 * a) * D; }
        else { j.src = p.in[14] + (size_t)a * D * D; j.ldsrc = D; j.K = D; j.N = D; j.dst = p.w<bf16>(WS_WOUT + a * 2 * MiB); j.lddst = D; }
    } else if (jid == 16) { j.src = p.in[15]; j.ldsrc = 384; j.K = D; j.N = 384; j.dst = p.w<bf16>(WS_WDQKV); j.lddst = D; j.gain = p.in[6] + D; j.off = 256; }
    else if (jid == 17) { j.src = p.in[18]; j.ldsrc = 320; j.K = D; j.N = 256; j.dst = p.w<bf16>(WS_WDQKV); j.lddst = D; j.gain = p.in[6] + D; j.off = 0; }
    else if (jid == 18) { j.src = p.in[18] + 256; j.ldsrc = 320; j.K = D; j.N = 64; j.dst = p.w<bf16>(WS_WDQKV); j.lddst = D; j.gain = p.in[6] + D; j.off = 640; }
    else if (jid == 19) { j.src = p.in[24]; j.ldsrc = 1280; j.K = D; j.N = 1280; j.dst = p.w<bf16>(WS_WGX); j.lddst = D; j.gain = p.in[6] + 2 * D; j.off = 0; }
    else if (jid == 20) { j.src = p.in[23]; j.ldsrc = 1280; j.K = D; j.N = 1280; j.dst = p.w<bf16>(WS_WGX); j.lddst = D; j.gain = p.in[6] + 2 * D; j.off = 1280; }
    else if (jid == 21) { j.src = p.in[32]; j.ldsrc = D; j.K = 1280; j.N = D; j.dst = p.w<bf16>(WS_WCO); j.lddst = 1280; }
    else if (jid == 22) { j.src = p.in[27]; j.ldsrc = 128; j.K = 128; j.N = 128; j.dst = p.w<bf16>(WS_WAT); j.lddst = 128; j.kind = 2; }
    else { j.src = p.in[29]; j.ldsrc = 128; j.K = 128; j.N = 128; j.dst = p.w<bf16>(WS_WIT); j.lddst = 128; j.kind = 2; }
    return j;
}
__device__ __forceinline__ int job_items(const TrJob& j) { return j.kind == 2 ? 80 : (j.K / 64) * (j.N / 32); }

__device__ __forceinline__ void p0_prologue(const P& p, const int mask) {
    LAS float* scr = (LAS float*)(p.lds + p.wave * 16384);
    const int gw = p.bid * NWAVES + p.wave, NGW = p.G * NWAVES, lane = p.lane;
    const int gt = p.bid * (NWAVES * 64) + p.tid, NGT = p.G * NWAVES * 64;
    if (mask & 1) {
    {
        int base = 0;
        for (int jid = 0; jid < NJOBS; ++jid) {
            TrJob j = get_job(p, jid); const int nit = job_items(j);
            int first = (gw - base % NGW + NGW) % NGW;
            for (int it = first; it < nit; it += NGW) {
                if (j.kind == 2) { TrJob b = j; const int blk = it >> 3; b.src = j.src + (size_t)blk * 16384; b.dst = j.dst + (size_t)blk * 16384; b.kind = 0; tr_item(b, scr, it & 7, lane); }
                else tr_item(j, scr, it, lane);
            }
            base += nit;
        }
    }
    }
    if (mask & 2) {
    { u32x4* z = (u32x4*)(p.w<bf16>(WS_WDQKV) + (size_t)704 * D); for (int i = gt; i < 64 * D / 8; i += NGT) z[i] = (u32x4){0u, 0u, 0u, 0u}; }
    }
    if (mask & 4) {
    for (int i = gt; i < 2 * 8 * 128 * 16; i += NGT) {
        const int s0 = (i & 15) * 8, t = (i >> 4) & 127, jg = i >> 11; const float* src = p.in[12] + (size_t)jg * 16384 + t * 128 + s0;
        const f32x4 v0 = *(const f32x4*)src, v1 = *(const f32x4*)(src + 4); unsigned w[4];
#pragma unroll
        for (int e = 0; e < 2; ++e) { w[e] = pk2((s0 + 2 * e <= t) ? v0[2 * e] : 0.f, (s0 + 2 * e + 1 <= t) ? v0[2 * e + 1] : 0.f); w[2 + e] = pk2((s0 + 4 + 2 * e <= t) ? v1[2 * e] : 0.f, (s0 + 5 + 2 * e <= t) ? v1[2 * e + 1] : 0.f); }
        const int j = jg >> 3, g = jg & 7;
        *(u32x4*)(p.w<bf16>(WS_WS + (size_t)j * 262144) + ((size_t)g * 128 + t) * 128 + s0) = (u32x4){w[0], w[1], w[2], w[3]};
    }
    }
    if (mask & 8) {
    for (int i = gt; i < 2052 * 32; i += NGT) { const int tp = i >> 5, fi = i & 31, pos = tp < 2048 ? tp : 16384 + (tp - 2048);
        const float inv = 1.0f / powf(10000.0f, (float)(2 * fi) / 64.0f); const float ang = (float)pos * inv;
        p.w<f32x2>(WS_ROPE)[i] = (f32x2){cosf(ang), sinf(ang)}; }
    }
    if (mask & 16) {
    { bf16* HB = p.w<bf16>(WS_HB); long long* ssq = p.stat(ST_SSQ0);
      auto rowp = [&](int m) -> const float* { return m < MP ? p.in[0] + (size_t)m * D : p.in[1] + (size_t)((m < MT ? m : MT - 1) - MP) * D; };
      f32x4 v[4], vn[4];
      if (gw < MR) { const float* r = rowp(gw);
#pragma unroll
        for (int jj = 0; jj < 4; ++jj) v[jj] = *(const f32x4*)(r + 4 * lane + 256 * jj); }
      for (int m = gw; m < MR; m += NGW) {
        { const float* r = rowp(m + NGW < MR ? m + NGW : m);
#pragma unroll
          for (int jj = 0; jj < 4; ++jj) vn[jj] = *(const f32x4*)(r + 4 * lane + 256 * jj); }
        float s = 0.f;
#pragma unroll
        for (int jj = 0; jj < 4; ++jj) { if (m >= MT) v[jj] = (f32x4){0.f, 0.f, 0.f, 0.f};
            s += (v[jj].x * v[jj].x + v[jj].y * v[jj].y) + (v[jj].z * v[jj].z + v[jj].w * v[jj].w); }
#pragma unroll
        for (int o = 1; o < 64; o <<= 1) s += __shfl_xor(s, o);
#pragma unroll
        for (int jj = 0; jj < 4; ++jj) { const int c = 4 * lane + 256 * jj;
            *(u32x2*)(HB + (size_t)m * D + c) = (u32x2){pk2(v[jj].x, v[jj].y), pk2(v[jj].z, v[jj].w)}; }
        if (lane == 0) stat_set(ssq + m, s);
#pragma unroll
        for (int jj = 0; jj < 4; ++jj) v[jj] = vn[jj];
      } }
    }
    if (mask & 32) {
    { const float* wuq = p.in[17]; const float* wuk = p.in[20]; const float* qn = p.in[16]; bf16* Wq = p.w<bf16>(WS_WQ);
      LAS float* Qs = (LAS float*)p.lds; LAS float* Ks = (LAS float*)(p.lds + 64 * 132 * 4);
      for (int it = p.bid; it < 192; it += p.G) {
        const int h = it / 24, kb = (it >> 2) % 6, cq = it & 3, k0 = 64 * kb;
        __syncthreads();
#pragma unroll
        for (int q = 0; q < 4; ++q) { const int idx = p.tid + 512 * q, row = idx >> 5, c4 = idx & 31;
            *(LAS f32x4*)(Qs + row * 132 + c4 * 4) = *(const f32x4*)(wuq + (size_t)(k0 + row) * 1536 + h * 192 + c4 * 4);
            *(LAS f32x4*)(Ks + row * 132 + c4 * 4) = *(const f32x4*)(wuk + (size_t)(cq * 64 + row) * 1024 + h * 128 + c4 * 4); }
        __syncthreads();
        const int cl = p.wave * 8, c0 = cq * 64 + cl; float acc[8];
#pragma unroll
        for (int cc = 0; cc < 8; ++cc) acc[cc] = 0.f;
#pragma unroll 4
        for (int n4 = 0; n4 < 32; ++n4) { const f32x4 bv = *(const LAS f32x4*)(Qs + lane * 132 + n4 * 4);
#pragma unroll
            for (int cc = 0; cc < 8; ++cc) { const f32x4 av = *(const LAS f32x4*)(Ks + (cl + cc) * 132 + n4 * 4); acc[cc] += (av.x * bv.x + av.y * bv.y) + (av.z * bv.z + av.w * bv.w); } }
        const float g = qn[k0 + lane];
#pragma unroll
        for (int cc = 0; cc < 8; ++cc) Wq[(size_t)(320 * h + c0 + cc) * 384 + k0 + lane] = (bf16)f2bf(acc[cc] * g);
      }
      for (int r = gw; r < 512; r += NGW) { const int h = r >> 6, ie = r & 63, i = ie >> 1, e = ie & 1;
#pragma unroll
        for (int kk = 0; kk < 6; ++kk) { const int k = lane + 64 * kk; Wq[(size_t)(320 * h + 256 + ie) * 384 + k] = (bf16)f2bf(wuq[(size_t)k * 1536 + h * 192 + 128 + 32 * e + i] * qn[k]); } } }
    }
    if (mask & 64) {
    { const float* wuv = p.in[21]; const float* wo = p.in[22]; bf16* Wov = p.w<bf16>(WS_WOV);
      LAS float* Os = (LAS float*)p.lds;
      for (int it = p.bid; it < 256; it += p.G) { const int h = it >> 5, cg = (it >> 2) & 7, nb = it & 3, c0 = cg * 32 + p.wave * 4, n = nb * 256 + lane * 4;
        __syncthreads();
#pragma unroll
        for (int q = 0; q < 16; ++q) { const int idx = p.tid + 512 * q, v = idx >> 6, c4 = idx & 63; *(LAS f32x4*)(Os + v * 256 + c4 * 4) = *(const f32x4*)(wo + (size_t)(h * 128 + v) * D + nb * 256 + c4 * 4); }
        __syncthreads();
        f32x4 acc[4];
#pragma unroll
        for (int cc = 0; cc < 4; ++cc) acc[cc] = (f32x4){0.f, 0.f, 0.f, 0.f};
#pragma unroll 8
        for (int v = 0; v < 128; ++v) { const f32x4 b = *(const LAS f32x4*)(Os + v * 256 + lane * 4);
#pragma unroll
            for (int cc = 0; cc < 4; ++cc) { const float a = wuv[(size_t)(c0 + cc) * 1024 + h * 128 + v]; acc[cc] += b * a; } }
#pragma unroll
        for (int jn = 0; jn < 4; ++jn) *(u32x2*)(Wov + (size_t)(n + jn) * 2048 + h * 256 + c0) = (u32x2){pk2(acc[0][jn], acc[1][jn]), pk2(acc[2][jn], acc[3][jn])};
      }
      __syncthreads(); }
    }
}
}
namespace mk {
#ifdef MK_DRYPROBE
#define MK_DRY(E) ((E).dry)
#define MK_DRYFIELD int dry;
#else
#define MK_DRY(E) 0
#define MK_DRYFIELD
#endif
typedef const f32x4 (&AccRef)[2][2][4][2];
__device__ __forceinline__ float quad_red(float v) { v += __shfl_xor(v, 16); v += __shfl_xor(v, 32); return v; }
__device__ __forceinline__ u32x4 pack8(const f32x4 a, const f32x4 b) { u32x4 w; w.x = cvt_pk_bf16(a[0], a[1]); w.y = cvt_pk_bf16(a[2], a[3]); w.z = cvt_pk_bf16(b[0], b[1]); w.w = cvt_pk_bf16(b[2], b[3]); return w; }
__device__ __forceinline__ float sumsq8(const f32x4 a, const f32x4 b) { return ((a[0] * a[0] + a[1] * a[1]) + (a[2] * a[2] + a[3] * a[3])) + ((b[0] * b[0] + b[1] * b[1]) + (b[2] * b[2] + b[3] * b[3])); }
__device__ __forceinline__ float sum8(const f32x4 a, const f32x4 b) { return ((a[0] + a[1]) + (a[2] + a[3])) + ((b[0] + b[1]) + (b[2] + b[3])); }
#define MK_EPI_CALL() \
    __device__ __forceinline__ void operator()(AccRef acc, const pg8::Unit& u, int wr, int wc, int fr, int fq) const { \
        Pre pre_[2][4]; \
        _Pragma("unroll") for (int ai = 0; ai < 2; ++ai) _Pragma("unroll") for (int m = 0; m < 4; ++m) pre_[ai][m] = pre(u.pm * 256 + ai * 128 + wr * 64 + m * 16 + fr, u.pn, wc, fq); \
        _Pragma("unroll") for (int ai = 0; ai < 2; ++ai) _Pragma("unroll") for (int m = 0; m < 4; ++m) \
            rgp(u.pm * 256 + ai * 128 + wr * 64 + m * 16 + fr, u.pn, wc, fq, acc[ai][0][m][0], acc[ai][0][m][1], acc[ai][1][m][0], acc[ai][1][m][1], pre_[ai][m]); } \
    __device__ __forceinline__ void rgq(int r, int pn, int wc, int fq, f32x4 a0, f32x4 b0, f32x4 a1, f32x4 b1, const Pre pv) const { rgp(r, pn, wc, fq, a0, b0, a1, b1, pv); }
#define MK_EPI_CALL_DENSE() \
    __device__ __forceinline__ void operator()(AccRef acc, const pg8::Unit& u, int wr, int wc, int fr, int fq) const { \
        Pre pre_[2][4]; \
        _Pragma("unroll") for (int ai = 0; ai < 2; ++ai) _Pragma("unroll") for (int m = 0; m < 4; ++m) pre_[ai][m] = pre(u.pm * 256 + ai * 128 + wr * 64 + m * 16 + fr, u.pn, wc, fq); \
        _Pragma("unroll") for (int ai = 0; ai < 2; ++ai) { float s1 = 0.f, s2 = 0.f; \
            _Pragma("unroll") for (int m = 0; m < 4; ++m) { float t1, t2; \
                rgs(u.pm * 256 + ai * 128 + wr * 64 + m * 16 + fr, u.pn, wc, fq, acc[ai][0][m][0], acc[ai][0][m][1], acc[ai][1][m][0], acc[ai][1][m][1], pre_[ai][m], t1, t2); \
                s1 = (fq == m) ? t1 : s1; s2 = (fq == m) ? t2 : s2; } \
            stats(u.pm * 256 + ai * 128 + wr * 64 + fq * 16 + fr, u.pn, s1, s2); } } \
    __device__ __forceinline__ void rgq(int r, int pn, int wc, int fq, f32x4 a0, f32x4 b0, f32x4 a1, f32x4 b1, const Pre pv) const { float t1, t2; rgs(r, pn, wc, fq, a0, b0, a1, b1, pv, t1, t2); if (fq == 0) stats(r, pn, t1, t2); }
#define MK_INIT_ZERO() __device__ __forceinline__ void init(f32x4 (&acc)[2][2][4][2], const pg8::Unit&, int, int, int, int) const { \
        _Pragma("unroll") for (int a = 0; a < 2; ++a) _Pragma("unroll") for (int b = 0; b < 2; ++b) _Pragma("unroll") for (int m = 0; m < 4; ++m) _Pragma("unroll") for (int n = 0; n < 2; ++n) acc[a][b][m][n] = (f32x4){0.f, 0.f, 0.f, 0.f}; }
#define MK_PRE_STAT(PTR) MK_INIT_ZERO() typedef long long Pre; __device__ __forceinline__ Pre pre(int r, int, int, int) const { return (PTR)[r]; }
__device__ __forceinline__ float stat_f(long long v) { const int hi = (int)(v >> 32); const unsigned lo = (unsigned)v; return __builtin_fmaf((float)hi, 4294967296.0f * ST_INV, (float)lo * ST_INV); }
__device__ __forceinline__ float rsq_f(float x) { return __builtin_amdgcn_rsqf(x); }

struct EpiA1 {
    static constexpr bool PERM = true, AFTER_DRAIN = false;
    bf16* U; bf16* GV; const long long* ssq; long long* lns; long long* lnq; MK_DRYFIELD
    MK_PRE_STAT(ssq)
    __device__ __forceinline__ void rgs(int r, int pn, int wc, int fq, f32x4 a0, f32x4 b0, f32x4 a1, f32x4 b1, const Pre pv, float& s1, float& s2) const {
        const bool isv = pn >= 4; bf16* dst = (isv ? GV : U) + (size_t)r * 1024 + (pn & 3) * 256 + wc * 32 + 8 * fq; const float rs = rsq_f(stat_f(pv) * (1.0f / 1024.0f) + RMS_EPS);
        a0 *= rs; b0 *= rs; a1 *= rs; b1 *= rs;
#pragma unroll
        for (int e = 0; e < 4; ++e) { a0[e] = gelu_tanh_f(a0[e]); b0[e] = gelu_tanh_f(b0[e]); a1[e] = gelu_tanh_f(a1[e]); b1[e] = gelu_tanh_f(b1[e]); }
        *(u32x4*)dst = pack8(a0, b0); *(u32x4*)(dst + 128) = pack8(a1, b1);
        s1 = 0.f; s2 = 0.f;
        if (isv) { s1 = quad_red(sum8(a0, b0) + sum8(a1, b1)); s2 = quad_red(sumsq8(a0, b0) + sumsq8(a1, b1)); }
    }
    __device__ __forceinline__ void stats(int r, int pn, float s1, float s2) const { if (pn >= 4 && !MK_DRY(*this)) { stat_add(lns + r, s1); stat_add(lnq + r, s2); } }
    MK_EPI_CALL_DENSE()
};
struct EpiRes {
    static constexpr bool PERM = true, AFTER_DRAIN = false;
    bf16* HB; long long* ssq_out; MK_DRYFIELD
    struct Pre { u32x4 h0, h1; };
    static __device__ __forceinline__ f32x4 lo4(const u32x4 h) { return (f32x4){bflo(h.x), bfhi(h.x), bflo(h.y), bfhi(h.y)}; }
    static __device__ __forceinline__ f32x4 hi4(const u32x4 h) { return (f32x4){bflo(h.z), bfhi(h.z), bflo(h.w), bfhi(h.w)}; }
    __device__ __forceinline__ Pre pre(int r, int pn, int wc, int fq) const { const bf16* hp = HB + (size_t)r * 1024 + pn * 256 + wc * 32 + 8 * fq; Pre v; v.h0 = *(const u32x4*)hp; v.h1 = *(const u32x4*)(hp + 128); return v; }
    __device__ __forceinline__ void init(f32x4 (&acc)[2][2][4][2], const pg8::Unit& u, int wr, int wc, int fr, int fq) const {
        Pre v[2][4];
#pragma unroll
        for (int ai = 0; ai < 2; ++ai)
#pragma unroll
            for (int m = 0; m < 4; ++m) v[ai][m] = pre(u.pm * 256 + ai * 128 + wr * 64 + m * 16 + fr, u.pn, wc, fq);
#pragma unroll
        for (int ai = 0; ai < 2; ++ai)
#pragma unroll
            for (int m = 0; m < 4; ++m) { acc[ai][0][m][0] = lo4(v[ai][m].h0); acc[ai][0][m][1] = hi4(v[ai][m].h0); acc[ai][1][m][0] = lo4(v[ai][m].h1); acc[ai][1][m][1] = hi4(v[ai][m].h1); }
    }
    __device__ __forceinline__ void fin(int r, int pn, int wc, int fq, const f32x4 a0, const f32x4 b0, const f32x4 a1, const f32x4 b1, float& s1) const {
        bf16* hp = HB + (size_t)r * 1024 + pn * 256 + wc * 32 + 8 * fq;
        s1 = quad_red(sumsq8(a0, b0) + sumsq8(a1, b1));
        if (MK_DRY(*this)) { if (s1 == 12345.678f) *(u32x4*)hp = pack8(a0, b0); return; }
        *(u32x4*)hp = pack8(a0, b0); *(u32x4*)(hp + 128) = pack8(a1, b1);
    }
    __device__ __forceinline__ void stats(int r, int pn, float s1, float s2) const { if (!MK_DRY(*this)) stat_add(ssq_out + r, s1); }
    __device__ __forceinline__ void operator()(AccRef acc, const pg8::Unit& u, int wr, int wc, int fr, int fq) const {
#pragma unroll
        for (int ai = 0; ai < 2; ++ai) { float s1 = 0.f;
#pragma unroll
            for (int m = 0; m < 4; ++m) { float t1; fin(u.pm * 256 + ai * 128 + wr * 64 + m * 16 + fr, u.pn, wc, fq, acc[ai][0][m][0], acc[ai][0][m][1], acc[ai][1][m][0], acc[ai][1][m][1], t1); s1 = (fq == m) ? t1 : s1; }
            stats(u.pm * 256 + ai * 128 + wr * 64 + fq * 16 + fr, u.pn, s1, 0.f); } }
    __device__ __forceinline__ void rgq(int r, int pn, int wc, int fq, f32x4 a0, f32x4 b0, f32x4 a1, f32x4 b1, const Pre v) const { float t1;
        fin(r, pn, wc, fq, a0 + lo4(v.h0), b0 + hi4(v.h0), a1 + lo4(v.h1), b1 + hi4(v.h1), t1); if (fq == 0) stats(r, pn, t1, 0.f); }
};
struct EpiF1 {
    static constexpr bool PERM = true, AFTER_DRAIN = false;
    bf16* ACT; const long long* ssq;
    MK_PRE_STAT(ssq)
    __device__ __forceinline__ void rgp(int r, int pn, int wc, int fq, f32x4 a0, f32x4 b0, f32x4 a1, f32x4 b1, const Pre pv) const {
        const float rs = rsq_f(stat_f(pv) * (1.0f / 1024.0f) + RMS_EPS), kx = -1.4426950409f * rs, r2 = rs * rs; f32x4 a, b;
#pragma unroll
        for (int e = 0; e < 4; ++e) { a[e] = a0[e] * __builtin_amdgcn_rcpf(1.0f + __builtin_amdgcn_exp2f(a0[e] * kx)) * (a1[e] * r2); b[e] = b0[e] * __builtin_amdgcn_rcpf(1.0f + __builtin_amdgcn_exp2f(b0[e] * kx)) * (b1[e] * r2); }
        *(u32x4*)(ACT + (size_t)r * DFF + pn * 128 + wc * 32 + 8 * fq) = pack8(a, b);
    }
    MK_EPI_CALL()
};
struct EpiB1 {
    static constexpr bool PERM = true, AFTER_DRAIN = false;
    float* RAW; bf16* CQB; const long long* ssq; long long* ssq_kv; long long* ssq_q; MK_DRYFIELD
    __device__ __forceinline__ void half(int r, int c, f32x4 a, f32x4 b, float& qkv, float& qq) const {
        if (c < 256) { *(f32x4*)(RAW + (size_t)r * 768 + c) = a; *(f32x4*)(RAW + (size_t)r * 768 + c + 4) = b; qkv += sumsq8(a, b); }
        else if (c < 640) { *(u32x4*)(CQB + (size_t)r * 384 + (c - 256)) = pack8(a, b); qq += sumsq8(a, b); }
        else if (c < 704) { *(f32x4*)(RAW + (size_t)r * 768 + c) = a; *(f32x4*)(RAW + (size_t)r * 768 + c + 4) = b; } }
    MK_PRE_STAT(ssq)
    __device__ __forceinline__ void rgs(int r, int pn, int wc, int fq, f32x4 a0, f32x4 b0, f32x4 a1, f32x4 b1, const Pre pv, float& s1, float& s2) const {
        const float rs = rsq_f(stat_f(pv) * (1.0f / 1024.0f) + RMS_EPS); const int c = pn * 256 + wc * 32 + 8 * fq; float qkv = 0.f, qq = 0.f;
        half(r, c, a0 * rs, b0 * rs, qkv, qq); half(r, c + 128, a1 * rs, b1 * rs, qkv, qq);
        s1 = quad_red(qkv); s2 = quad_red(qq);
    }
    __device__ __forceinline__ void stats(int r, int pn, float s1, float s2) const { if (!MK_DRY(*this)) { if (pn == 0) stat_add(ssq_kv + r, s1); else stat_add(ssq_q + r, s2); } }
    MK_EPI_CALL_DENSE()
};
struct EpiB2 {
    static constexpr bool PERM = true, AFTER_DRAIN = false;
    bf16* QF; const long long* ssq_q; const f32x2* rope;
    __device__ __forceinline__ void half(int r, int c, int tp, const f32x4 a, const f32x4 b) const {
        const int h = c / 320, w = c - h * 320;
        if (w < 256) *(u32x4*)(QF + (size_t)r * 2560 + c) = pack8(a, b);
        else { const int i0 = (w - 256) >> 1;
            const f32x4 cs01 = *(const f32x4*)(rope + (size_t)tp * 32 + i0), cs23 = *(const f32x4*)(rope + (size_t)tp * 32 + i0 + 2);
            bf16* qh = QF + (size_t)r * 2560 + h * 320 + 256;
            *(u32x2*)(qh + i0) = (u32x2){cvt_pk_bf16(a[0] * cs01[0] - a[1] * cs01[1], a[2] * cs01[2] - a[3] * cs01[3]), cvt_pk_bf16(b[0] * cs23[0] - b[1] * cs23[1], b[2] * cs23[2] - b[3] * cs23[3])};
            *(u32x2*)(qh + 32 + i0) = (u32x2){cvt_pk_bf16(a[0] * cs01[1] + a[1] * cs01[0], a[2] * cs01[3] + a[3] * cs01[2]), cvt_pk_bf16(b[0] * cs23[1] + b[1] * cs23[0], b[2] * cs23[3] + b[3] * cs23[2])}; } }
    MK_PRE_STAT(ssq_q)
    __device__ __forceinline__ void rgp(int r, int pn, int wc, int fq, f32x4 a0, f32x4 b0, f32x4 a1, f32x4 b1, const Pre pv) const {
        const float rs = rsq_f(stat_f(pv) * (1.0f / 384.0f) + RMS_EPS) * (MLA_SCALE * 1.4426950408889634f)  ; const int tp = r < MP ? (r & 2047) : 2048 + ((r - MP) & 3), c = pn * 256 + wc * 32 + 8 * fq;
        half(r, c, tp, a0 * rs, b0 * rs); half(r, c + 128, tp, a1 * rs, b1 * rs);
    }
    MK_EPI_CALL()
};
struct EpiC1 {
    static constexpr bool PERM = true, AFTER_DRAIN = false;
    bf16* GATE; float* XW; const long long* ssq;
    MK_PRE_STAT(ssq)
    __device__ __forceinline__ void rgp(int r, int pn, int wc, int fq, f32x4 a0, f32x4 b0, f32x4 a1, f32x4 b1, const Pre pv) const {
        const bool isx = pn >= 5; const int c = (isx ? pn - 5 : pn) * 256 + wc * 32 + 8 * fq; const float rs = rsq_f(stat_f(pv) * (1.0f / 1024.0f) + RMS_EPS);
        a0 *= rs; b0 *= rs; a1 *= rs; b1 *= rs;
        if (isx) { float* x = XW + (size_t)r * 1280 + c; *(f32x4*)x = a0; *(f32x4*)(x + 4) = b0; *(f32x4*)(x + 128) = a1; *(f32x4*)(x + 132) = b1; }
        else {
#pragma unroll
            for (int e = 0; e < 4; ++e) { a0[e] = gelu_tanh_f(a0[e]); b0[e] = gelu_tanh_f(b0[e]); a1[e] = gelu_tanh_f(a1[e]); b1[e] = gelu_tanh_f(b1[e]); }
            bf16* g = GATE + (size_t)r * 1280 + c; *(u32x4*)g = pack8(a0, b0); *(u32x4*)(g + 128) = pack8(a1, b1); }
    }
    MK_EPI_CALL()
};

template <class Epi>
__device__ __forceinline__ void mini_gemm(const P& p, const bf16* A, int lda, const bf16* Bt, int ldb, int K, int N, const Epi& E, int first_wg) {
    constexpr int BP = 272, SLOT = 64 * BP;
    const int tid = p.tid, lane = p.lane, w = p.wave, kq = w & 3, rgp = w >> 2, l15 = lane & 15, g4 = lane >> 4, nmu = (N >> 8) * 16, nch = K >> 7, nst = (nch + 3) >> 2;
    const int t128 = (rgp << 6) | lane;
    const int nshare = first_wg ? p.G - first_wg : p.G, myi = (p.bid - first_wg + p.G) % p.G;
    for (int mu = myi < nshare ? myi : nmu; mu < nmu; mu += nshare) {
        const int pn = mu >> 4, wcq = (mu >> 2) & 3, rq = mu & 3, row = MP + 32 * rq + 16 * rgp + l15;
        const bf16* arow = A + (size_t)row * lda + 8 * g4;
        const int r0 = t128 >> 4, c16 = t128 & 15;
        const bf16* bbase = Bt + (size_t)(pn * 256 + wcq * 32 + 8 * (r0 >> 2) + (r0 & 3)) * ldb + c16 * 8; const int bo0 = r0 * BP + c16 * 16;
#define MG_BSRC(q) (bbase + (size_t)(128 * ((q) >> 2) + 4 * (((q) >> 1) & 1) + 16 * ((q) & 1)) * ldb)
#define MG_BOFF(q) (bo0 + 8 * (q) * BP)
        typename Epi::Pre pv_{}; if (kq == 0) pv_ = E.pre(row, pn, wcq, g4);
        f32x4 acc[4];
#pragma unroll
        for (int t = 0; t < 4; ++t) acc[t] = (f32x4){0.f, 0.f, 0.f, 0.f};
        u32x4 b0[8], a0[4], b1[8], a1[4], b2[8], a2[4];
#define MG_LOAD(BS, AS, ST) do { const int ch_ = 4 * (ST) + kq; if (ch_ < nch) { \
            _Pragma("unroll") for (int q = 0; q < 8; ++q) BS[q] = *(const u32x4*)(MG_BSRC(q) + (size_t)ch_ * 128); \
            _Pragma("unroll") for (int s = 0; s < 4; ++s) AS[s] = *(const u32x4*)(arow + (size_t)ch_ * 128 + 32 * s); } } while (0)
#define MG_STEP(BS, AS, ST) do { LAS unsigned char* slot = p.lds + (kq * 2 + ((ST) & 1)) * SLOT; const bool ok_ = 4 * (ST) + kq < nch; \
            if (ok_) { _Pragma("unroll") for (int q = 0; q < 8; ++q) *(LAS u32x4*)(slot + MG_BOFF(q)) = BS[q]; } \
            bf16x8 af[4]; _Pragma("unroll") for (int s = 0; s < 4; ++s) af[s] = __builtin_bit_cast(bf16x8, AS[s]); \
            __syncthreads(); \
            if ((ST) + 3 < nst) MG_LOAD(BS, AS, (ST) + 3); \
            if (ok_) { _Pragma("unroll") for (int s = 0; s < 4; ++s) _Pragma("unroll") for (int t = 0; t < 4; ++t) { \
                const bf16x8 bf = *(const LAS bf16x8*)(slot + (t * 16 + l15) * BP + (32 * s + 8 * g4) * 2); \
                acc[t] = __builtin_amdgcn_mfma_f32_16x16x32_bf16(bf, af[s], acc[t], 0, 0, 0); } } } while (0)
        MG_LOAD(b0, a0, 0); if (1 < nst) MG_LOAD(b1, a1, 1); if (2 < nst) MG_LOAD(b2, a2, 2);
        __syncthreads();
        for (int st = 0; st < nst; st += 3) {
            MG_STEP(b0, a0, st);
            if (st + 1 < nst) MG_STEP(b1, a1, st + 1);
            if (st + 2 < nst) MG_STEP(b2, a2, st + 2);
        }
#undef MG_LOAD
#undef MG_STEP
#undef MG_BSRC
#undef MG_BOFF
        __syncthreads();
        LAS f32x4* red = (LAS f32x4*)p.lds;
        if (kq > 0) {
#pragma unroll
            for (int t = 0; t < 4; ++t) red[((rgp * 3 + (kq - 1)) * 4 + t) * 64 + lane] = acc[t]; }
        __syncthreads();
        if (kq == 0) {
#pragma unroll
            for (int k2 = 0; k2 < 3; ++k2)
#pragma unroll
                for (int t = 0; t < 4; ++t) acc[t] += red[((rgp * 3 + k2) * 4 + t) * 64 + lane];
            E.rgq(row, pn, wcq, g4, acc[0], acc[1], acc[2], acc[3], pv_); }
    }
}
}
namespace mk {
__device__ __forceinline__ s16x4 tr16(const LAS unsigned char* a) { return __builtin_amdgcn_ds_read_tr16_b64_v4i16((LAS s16x4*)a); }
__device__ __forceinline__ bf16x8 cat8(const s16x4 a, const s16x4 b) { return (bf16x8){a[0], a[1], a[2], a[3], b[0], b[1], b[2], b[3]}; }
__device__ __forceinline__ bf16x8 as_bf16x8(const u32x4 w) { return __builtin_bit_cast(bf16x8, w); }
#define MFMA16(A, B, C) __builtin_amdgcn_mfma_f32_16x16x32_bf16((A), (B), (C), 0, 0, 0)
template <int OFF> __device__ __forceinline__ bf16x8 dsr128(unsigned a) { bf16x8 r; asm volatile("ds_read_b128 %0, %1 offset:%2" : "=&v"(r) : "v"(a), "i"(OFF) : "memory"); return r; }
template <int OFF> __device__ __forceinline__ s16x4 dstr64(unsigned a) { s16x4 r; asm volatile("ds_read_b64_tr_b16 %0, %1 offset:%2" : "=&v"(r) : "v"(a), "i"(OFF) : "memory"); return r; }
#define LDS_WAIT_PIN() do { asm volatile("s_waitcnt lgkmcnt(0)" ::: "memory"); __builtin_amdgcn_sched_barrier(0); } while (0)
constexpr int TP = 272;
constexpr int KP = 656;
constexpr float LOG2E = 1.4426950408889634f;

__device__ __forceinline__ void a2_spatial(const P& p, int j, float* out_cv  ) {
    const bf16* U = p.w<bf16>(WS_U); const bf16* GV = p.w<bf16>(WS_GV); bf16* UM = p.w<bf16>(WS_UM);
    const long long* lns = p.stat(ST_LNS0 + 2 * j); const long long* lnq = p.stat(ST_LNQ0 + 2 * j);
    const float* ln_g = p.in[10] + j * 1024; const float* ln_b = p.in[11] + j * 1024; const float* b_s = p.in[13] + j * 1024;
    LAS unsigned char* Wt = p.lds; LAS unsigned char* Vt = p.lds + 128 * TP;
    const int tid = p.tid, lane = p.lane, w = p.wave, l15 = lane & 15, g4 = lane >> 4, q4 = (lane & 15) >> 2, pp = lane & 3;
    { const float* aws = p.in[12] + (size_t)j * 8 * 16384;
      for (int idx = p.bid * 512 + tid; idx < 128 * 1024; idx += p.G * 512) {
        const int t = idx >> 10, d = idx & 1023, g = d >> 7, i = t & 3; const size_t r = (size_t)MP + t, rb = r - i;
        const float lg = ln_g[d], lb = ln_b[d]; float mixed = b_s[g * 128 + i], vi = 0.f;
#pragma unroll
        for (int s2 = 0; s2 < 4; ++s2) { const size_t rs = rb + s2;
            const float mu = stat_get(lns + rs) * (1.0f / 1024.0f), var = stat_get(lnq + rs) * (1.0f / 1024.0f) - mu * mu;
            const float v = (bf2f(GV[rs * 1024 + d]) - mu) * rsqrtf(var + LN_EPS) * lg + lb, wv = aws[(size_t)g * 16384 + i * 128 + s2];
            mixed += (s2 <= i) ? wv * v : 0.f; vi = (s2 == i) ? v : vi; }
        if (out_cv) out_cv[(size_t)t * 1024 + d] = vi;
        UM[r * 1024 + d] = (bf16)f2bf(bf2f(U[r * 1024 + d]) * mixed); } }
    for (int u = p.bid; u < 128 * 8; u += p.G) {
        const int c = u >> 3, g = u & 7, row0 = c * 128; const bool smp = false;
        const bf16* Wsrc = p.w<bf16>(WS_WS + (smp ? 524288 : 0) + (size_t)j * 262144) + (size_t)g * 16384;
#pragma unroll
        for (int q = 0; q < 4; ++q) { const int ch = tid + 512 * q, row = ch >> 4, c16 = ch & 15;
            *(LAS u32x4*)(Wt + row * TP + c16 * 16) = *(const u32x4*)(Wsrc + row * 128 + c16 * 8); }
        { const int c16 = tid & 15, d0 = g * 128 + c16 * 8;
          const f32x4 g0 = *(const f32x4*)(ln_g + d0), g1 = *(const f32x4*)(ln_g + d0 + 4), b0 = *(const f32x4*)(ln_b + d0), b1 = *(const f32x4*)(ln_b + d0 + 4);
          u32x4 raw[4]; float mean[4], rstd[4];
#pragma unroll
          for (int q = 0; q < 4; ++q) { const int r = row0 + (tid >> 4) + 32 * q; raw[q] = *(const u32x4*)(GV + (size_t)r * 1024 + d0);
              const float mu = stat_get(lns + r) * (1.0f / 1024.0f), var = stat_get(lnq + r) * (1.0f / 1024.0f) - mu * mu; mean[q] = mu; rstd[q] = rsqrtf(var + LN_EPS); }
#pragma unroll
          for (int q = 0; q < 4; ++q) { const int s = (tid >> 4) + 32 * q, r = row0 + s;
            f32x4 v0, v1;
            v0[0] = bflo(raw[q].x); v0[1] = bfhi(raw[q].x); v0[2] = bflo(raw[q].y); v0[3] = bfhi(raw[q].y); v1[0] = bflo(raw[q].z); v1[1] = bfhi(raw[q].z); v1[2] = bflo(raw[q].w); v1[3] = bfhi(raw[q].w);
            v0 = (v0 - mean[q]) * rstd[q] * g0 + b0; v1 = (v1 - mean[q]) * rstd[q] * g1 + b1;
            if (smp && out_cv) { float* o = out_cv + (size_t)(r - MP) * 1024 + d0; *(f32x4*)o = v0; *(f32x4*)(o + 4) = v1; }
            *(LAS u32x4*)(Vt + s * TP + c16 * 16) = pack8(v0, v1); } }
        u32x2 uu[8];
#pragma unroll
        for (int tt = 0; tt < 8; ++tt) uu[tt] = *(const u32x2*)(U + (size_t)(row0 + 16 * tt + l15) * 1024 + g * 128 + 16 * w + 4 * g4);
        __syncthreads();
        f32x4 acc[8];
#pragma unroll
        for (int tt = 0; tt < 8; ++tt) acc[tt] = (f32x4){0.f, 0.f, 0.f, 0.f};
#pragma unroll
        for (int kk = 0; kk < 4; ++kk) {
            const bf16x8 X = cat8(tr16(Vt + (32 * kk + 8 * g4 + q4) * TP + (16 * w + 4 * pp) * 2), tr16(Vt + (32 * kk + 8 * g4 + 4 + q4) * TP + (16 * w + 4 * pp) * 2));
#pragma unroll
            for (int tt = 0; tt < 8; ++tt) if (32 * kk <= 16 * tt + 15) {
                const bf16x8 Y = *(const LAS bf16x8*)(Wt + (16 * tt + l15) * TP + (32 * kk + 8 * g4) * 2);
                acc[tt] = MFMA16(X, Y, acc[tt]); }
        }
#pragma unroll
        for (int tt = 0; tt < 8; ++tt) { const int t = 16 * tt + l15, r = row0 + t, col = g * 128 + 16 * w + 4 * g4;
            const float bias = b_s[g * 128 + (smp ? (t & 3) : t)];
            const float o0 = bflo(uu[tt].x) * (acc[tt][0] + bias), o1 = bfhi(uu[tt].x) * (acc[tt][1] + bias), o2 = bflo(uu[tt].y) * (acc[tt][2] + bias), o3 = bfhi(uu[tt].y) * (acc[tt][3] + bias);
            *(u32x2*)(UM + (size_t)r * 1024 + col) = (u32x2){cvt_pk_bf16(o0, o1), cvt_pk_bf16(o2, o3)}; }
        __syncthreads();
    }
}

__device__ __forceinline__ void b2_kvfinal(const P& p, float* out_mp, float* out_ms) {
    const float* RAW = p.w<float>(WS_RAW); bf16* KVB = p.w<bf16>(WS_KVB); const long long* ssq_kv = p.stat(ST_KV); const float* kvn = p.in[19]; const f32x2* rope = p.w<f32x2>(WS_ROPE);
    const int gw = p.bid * NWAVES + p.wave, NGW = p.G * NWAVES, lane = p.lane, l31 = lane & 31;
    const f32x4 kn = *(const f32x4*)(kvn + 4 * lane);
    auto tpos = [&](int m) { return m < MP ? (m & 2047) : 2048 + ((m - MP) & 3); };
    long long sq = 0, sqn = 0; f32x4 rv = (f32x4){0.f, 0.f, 0.f, 0.f}, rvn = rv; f32x2 cs = (f32x2){0.f, 0.f}, csn = cs; float x1 = 0.f, x2 = 0.f, x1n = 0.f, x2n = 0.f;
    if (gw < MT) { const int m = gw; sq = ssq_kv[m]; rv = *(const f32x4*)(RAW + (size_t)m * 768 + 4 * lane); cs = rope[(size_t)tpos(m) * 32 + l31]; x1 = RAW[(size_t)m * 768 + 640 + l31]; x2 = RAW[(size_t)m * 768 + 672 + l31]; }
    for (int m = gw; m < MT; m += NGW) {
        { const int mn = (m + NGW < MT) ? m + NGW : m; sqn = ssq_kv[mn]; rvn = *(const f32x4*)(RAW + (size_t)mn * 768 + 4 * lane); csn = rope[(size_t)tpos(mn) * 32 + l31]; x1n = RAW[(size_t)mn * 768 + 640 + l31]; x2n = RAW[(size_t)mn * 768 + 672 + l31]; }
        float* o = m < MP ? (out_mp ? out_mp + (size_t)m * 320 : nullptr) : (out_ms ? out_ms + (size_t)(m - MP) * 320 : nullptr);
        const float rs = rsqrtf((float)sq * ST_INV * (1.0f / 256.0f) + RMS_EPS);
        const f32x4 v = rv * rs * kn;
        if (o) *(f32x4*)(o + 4 * lane) = v;
        *(u32x2*)(KVB + (size_t)m * 320 + 4 * lane) = (u32x2){cvt_pk_bf16(v[0], v[1]), cvt_pk_bf16(v[2], v[3])};
        if (lane < 32) {
            const float o1 = x1 * cs.x - x2 * cs.y, o2 = x1 * cs.y + x2 * cs.x;
            if (o) { o[256 + lane] = o1; o[288 + lane] = o2; }
            KVB[(size_t)m * 320 + 256 + lane] = (bf16)f2bf(o1); KVB[(size_t)m * 320 + 288 + lane] = (bf16)f2bf(o2); }
        sq = sqn; rv = rvn; cs = csn; x1 = x1n; x2 = x2n;
    }
}

__device__ __forceinline__ void b3_attn_prompt(const P& p) {
    const bf16* QF = p.w<bf16>(WS_QF); const bf16* KVB = p.w<bf16>(WS_KVB); bf16* OB = p.w<bf16>(WS_OB);
    const int lane = p.lane, h = p.wave, l15 = lane & 15, g4 = lane >> 4, q4 = (lane & 15) >> 2, pp = lane & 3;
    constexpr int TILE_B = 64 * 640;
    int soff[5];
#pragma unroll
    for (int i = 0; i < 5; ++i) { const int P_ = (h + 8 * i) * 64 + lane, row = P_ / 40, cph = P_ - 40 * row; soff[i] = row * 320 + ((cph ^ (row & 6)) << 3); }
    const int kb_ = l15 * 640 + ((g4 ^ (l15 & 2)) << 4), km_ = ((l15 >> 2) & 1) << 6, kbase0 = kb_ + km_, kbase1 = kb_ - km_;
    int taddr[4];
    { const int rl = 4 * g4 + q4, m_ = (rl & 6) >> 1;
#pragma unroll
      for (int v3 = 0; v3 < 4; ++v3) taddr[v3] = rl * 640 + (((v3 ^ m_) << 1 | (pp >> 1)) << 4) + 8 * (pp & 1); }
#define AT_DMA(BUF, SRC) do { _Pragma("unroll") for (int i = 0; i < 5; ++i) \
        __builtin_amdgcn_global_load_lds((const unsigned*)((SRC) + soff[i]), (LAS unsigned*)((BUF) + (h + 8 * i) * 1024), 16, 0, 0); } while (0)
    for (int pi = p.bid; pi < 512; pi += p.G) {
        const int b = (p.G % 8 == 0) ? (pi & 7) : (pi >> 6), x = (p.G % 8 == 0) ? ((pi >> 3) & 63) : (pi & 63);
        for (int half = 0; half < 2; ++half) {
            const int qt = half ? 127 - x : x, t0 = 16 * qt, nkt = (t0 + 15) / 64 + 1;
            const size_t rowq = (size_t)b * 2048 + t0 + l15; const bf16* kvb = KVB + (size_t)b * 2048 * 320;
            AT_DMA(p.lds, kvb);
            bf16x8 Q[10];
#pragma unroll
            for (int s = 0; s < 10; ++s) Q[s] = as_bf16x8(*(const u32x4*)(QF + rowq * 2560 + h * 320 + 32 * s + 8 * g4));
            f32x4 O[16];
#pragma unroll
            for (int vt = 0; vt < 16; ++vt) O[vt] = (f32x4){0.f, 0.f, 0.f, 0.f};
            float mrun = -1e30f, lrun = 0.f;
            asm volatile("s_waitcnt vmcnt(0)" ::: "memory"); __syncthreads();
#define AT_TILE(BUF, KT, MASKED) do { \
                const unsigned lb_ = (unsigned)(size_t)(BUF), kb0_ = lb_ + kbase0, kb1_ = lb_ + kbase1; \
                f32x4 S[4]; \
                _Pragma("unroll") for (int k4 = 0; k4 < 4; ++k4) S[k4] = (f32x4){0.f, 0.f, 0.f, 0.f}; \
                { const bf16x8 ka0 = dsr128<0>(kb0_), ka1 = dsr128<10240>(kb0_), ka2 = dsr128<20480>(kb0_), ka3 = dsr128<30720>(kb0_), kc0 = dsr128<64>(kb1_), kc1 = dsr128<10304>(kb1_), kc2 = dsr128<20544>(kb1_), kc3 = dsr128<30784>(kb1_); \
                  LDS_WAIT_PIN(); \
                  S[0] = MFMA16(ka0, Q[0], S[0]); S[1] = MFMA16(ka1, Q[0], S[1]); S[2] = MFMA16(ka2, Q[0], S[2]); S[3] = MFMA16(ka3, Q[0], S[3]); S[0] = MFMA16(kc0, Q[1], S[0]); S[1] = MFMA16(kc1, Q[1], S[1]); S[2] = MFMA16(kc2, Q[1], S[2]); S[3] = MFMA16(kc3, Q[1], S[3]); } \
                { const bf16x8 ka0 = dsr128<128>(kb0_), ka1 = dsr128<10368>(kb0_), ka2 = dsr128<20608>(kb0_), ka3 = dsr128<30848>(kb0_), kc0 = dsr128<192>(kb1_), kc1 = dsr128<10432>(kb1_), kc2 = dsr128<20672>(kb1_), kc3 = dsr128<30912>(kb1_); \
                  LDS_WAIT_PIN(); \
                  S[0] = MFMA16(ka0, Q[2], S[0]); S[1] = MFMA16(ka1, Q[2], S[1]); S[2] = MFMA16(ka2, Q[2], S[2]); S[3] = MFMA16(ka3, Q[2], S[3]); S[0] = MFMA16(kc0, Q[3], S[0]); S[1] = MFMA16(kc1, Q[3], S[1]); S[2] = MFMA16(kc2, Q[3], S[2]); S[3] = MFMA16(kc3, Q[3], S[3]); } \
                { const bf16x8 ka0 = dsr128<256>(kb0_), ka1 = dsr128<10496>(kb0_), ka2 = dsr128<20736>(kb0_), ka3 = dsr128<30976>(kb0_), kc0 = dsr128<320>(kb1_), kc1 = dsr128<10560>(kb1_), kc2 = dsr128<20800>(kb1_), kc3 = dsr128<31040>(kb1_); \
                  LDS_WAIT_PIN(); \
                  S[0] = MFMA16(ka0, Q[4], S[0]); S[1] = MFMA16(ka1, Q[4], S[1]); S[2] = MFMA16(ka2, Q[4], S[2]); S[3] = MFMA16(ka3, Q[4], S[3]); S[0] = MFMA16(kc0, Q[5], S[0]); S[1] = MFMA16(kc1, Q[5], S[1]); S[2] = MFMA16(kc2, Q[5], S[2]); S[3] = MFMA16(kc3, Q[5], S[3]); } \
                { const bf16x8 ka0 = dsr128<384>(kb0_), ka1 = dsr128<10624>(kb0_), ka2 = dsr128<20864>(kb0_), ka3 = dsr128<31104>(kb0_), kc0 = dsr128<448>(kb1_), kc1 = dsr128<10688>(kb1_), kc2 = dsr128<20928>(kb1_), kc3 = dsr128<31168>(kb1_); \
                  LDS_WAIT_PIN(); \
                  S[0] = MFMA16(ka0, Q[6], S[0]); S[1] = MFMA16(ka1, Q[6], S[1]); S[2] = MFMA16(ka2, Q[6], S[2]); S[3] = MFMA16(ka3, Q[6], S[3]); S[0] = MFMA16(kc0, Q[7], S[0]); S[1] = MFMA16(kc1, Q[7], S[1]); S[2] = MFMA16(kc2, Q[7], S[2]); S[3] = MFMA16(kc3, Q[7], S[3]); } \
                { const bf16x8 ka0 = dsr128<512>(kb0_), ka1 = dsr128<10752>(kb0_), ka2 = dsr128<20992>(kb0_), ka3 = dsr128<31232>(kb0_), kc0 = dsr128<576>(kb1_), kc1 = dsr128<10816>(kb1_), kc2 = dsr128<21056>(kb1_), kc3 = dsr128<31296>(kb1_); \
                  LDS_WAIT_PIN(); \
                  S[0] = MFMA16(ka0, Q[8], S[0]); S[1] = MFMA16(ka1, Q[8], S[1]); S[2] = MFMA16(ka2, Q[8], S[2]); S[3] = MFMA16(ka3, Q[8], S[3]); S[0] = MFMA16(kc0, Q[9], S[0]); S[1] = MFMA16(kc1, Q[9], S[1]); S[2] = MFMA16(kc2, Q[9], S[2]); S[3] = MFMA16(kc3, Q[9], S[3]); } \
                  \
                float mx = -1e30f; \
                _Pragma("unroll") for (int k4 = 0; k4 < 4; ++k4) _Pragma("unroll") for (int e = 0; e < 4; ++e) { float v = S[k4][e]; if ((MASKED) && 64 * (KT) + 16 * k4 + 4 * g4 + e > t0 + l15) v = -1e30f; S[k4][e] = v; mx = fmaxf(mx, v); } \
                mx = fmaxf(mx, __shfl_xor(mx, 16)); mx = fmaxf(mx, __shfl_xor(mx, 32)); \
                const float mnew = fmaxf(mrun, mx), alpha = __builtin_amdgcn_exp2f(mrun - mnew); mrun = mnew; \
                float ps = 0.f; \
                _Pragma("unroll") for (int k4 = 0; k4 < 4; ++k4) _Pragma("unroll") for (int e = 0; e < 4; ++e) { const float pv = __builtin_amdgcn_exp2f(S[k4][e] - mnew); S[k4][e] = pv; ps += pv; } \
                lrun = lrun * alpha + ps; \
                _Pragma("unroll") for (int vt = 0; vt < 16; ++vt) O[vt] *= alpha; \
                bf16x8 Pf[2]; \
                _Pragma("unroll") for (int ks = 0; ks < 2; ++ks) Pf[ks] = as_bf16x8((u32x4){cvt_pk_bf16(S[2 * ks][0], S[2 * ks][1]), cvt_pk_bf16(S[2 * ks][2], S[2 * ks][3]), cvt_pk_bf16(S[2 * ks + 1][0], S[2 * ks + 1][1]), cvt_pk_bf16(S[2 * ks + 1][2], S[2 * ks + 1][3])}); \
                  \
                { const unsigned tb0_ = lb_ + taddr[0], tb1_ = lb_ + taddr[1], tb2_ = lb_ + taddr[2], tb3_ = lb_ + taddr[3]; \
                  { const s16x4 v000 = dstr64<0>(tb0_), v001 = dstr64<10240>(tb0_), v010 = dstr64<20480>(tb0_), v011 = dstr64<30720>(tb0_), v100 = dstr64<0>(tb1_), v101 = dstr64<10240>(tb1_), v110 = dstr64<20480>(tb1_), v111 = dstr64<30720>(tb1_), v200 = dstr64<0>(tb2_), v201 = dstr64<10240>(tb2_), v210 = dstr64<20480>(tb2_), v211 = dstr64<30720>(tb2_), v300 = dstr64<0>(tb3_), v301 = dstr64<10240>(tb3_), v310 = dstr64<20480>(tb3_), v311 = dstr64<30720>(tb3_); \
                    LDS_WAIT_PIN(); \
                    O[0] = MFMA16(cat8(v000, v001), Pf[0], O[0]); O[0] = MFMA16(cat8(v010, v011), Pf[1], O[0]); O[1] = MFMA16(cat8(v100, v101), Pf[0], O[1]); O[1] = MFMA16(cat8(v110, v111), Pf[1], O[1]); O[2] = MFMA16(cat8(v200, v201), Pf[0], O[2]); O[2] = MFMA16(cat8(v210, v211), Pf[1], O[2]); O[3] = MFMA16(cat8(v300, v301), Pf[0], O[3]); O[3] = MFMA16(cat8(v310, v311), Pf[1], O[3]); } \
                  { const s16x4 v000 = dstr64<128>(tb0_), v001 = dstr64<10368>(tb0_), v010 = dstr64<20608>(tb0_), v011 = dstr64<30848>(tb0_), v100 = dstr64<128>(tb1_), v101 = dstr64<10368>(tb1_), v110 = dstr64<20608>(tb1_), v111 = dstr64<30848>(tb1_), v200 = dstr64<128>(tb2_), v201 = dstr64<10368>(tb2_), v210 = dstr64<20608>(tb2_), v211 = dstr64<30848>(tb2_), v300 = dstr64<128>(tb3_), v301 = dstr64<10368>(tb3_), v310 = dstr64<20608>(tb3_), v311 = dstr64<30848>(tb3_); \
                    LDS_WAIT_PIN(); \
                    O[4] = MFMA16(cat8(v000, v001), Pf[0], O[4]); O[4] = MFMA16(cat8(v010, v011), Pf[1], O[4]); O[5] = MFMA16(cat8(v100, v101), Pf[0], O[5]); O[5] = MFMA16(cat8(v110, v111), Pf[1], O[5]); O[6] = MFMA16(cat8(v200, v201), Pf[0], O[6]); O[6] = MFMA16(cat8(v210, v211), Pf[1], O[6]); O[7] = MFMA16(cat8(v300, v301), Pf[0], O[7]); O[7] = MFMA16(cat8(v310, v311), Pf[1], O[7]); } \
                  { const s16x4 v000 = dstr64<256>(tb0_), v001 = dstr64<10496>(tb0_), v010 = dstr64<20736>(tb0_), v011 = dstr64<30976>(tb0_), v100 = dstr64<256>(tb1_), v101 = dstr64<10496>(tb1_), v110 = dstr64<20736>(tb1_), v111 = dstr64<30976>(tb1_), v200 = dstr64<256>(tb2_), v201 = dstr64<10496>(tb2_), v210 = dstr64<20736>(tb2_), v211 = dstr64<30976>(tb2_), v300 = dstr64<256>(tb3_), v301 = dstr64<10496>(tb3_), v310 = dstr64<20736>(tb3_), v311 = dstr64<30976>(tb3_); \
                    LDS_WAIT_PIN(); \
                    O[8] = MFMA16(cat8(v000, v001), Pf[0], O[8]); O[8] = MFMA16(cat8(v010, v011), Pf[1], O[8]); O[9] = MFMA16(cat8(v100, v101), Pf[0], O[9]); O[9] = MFMA16(cat8(v110, v111), Pf[1], O[9]); O[10] = MFMA16(cat8(v200, v201), Pf[0], O[10]); O[10] = MFMA16(cat8(v210, v211), Pf[1], O[10]); O[11] = MFMA16(cat8(v300, v301), Pf[0], O[11]); O[11] = MFMA16(cat8(v310, v311), Pf[1], O[11]); } \
                  { const s16x4 v000 = dstr64<384>(tb0_), v001 = dstr64<10624>(tb0_), v010 = dstr64<20864>(tb0_), v011 = dstr64<31104>(tb0_), v100 = dstr64<384>(tb1_), v101 = dstr64<10624>(tb1_), v110 = dstr64<20864>(tb1_), v111 = dstr64<31104>(tb1_), v200 = dstr64<384>(tb2_), v201 = dstr64<10624>(tb2_), v210 = dstr64<20864>(tb2_), v211 = dstr64<31104>(tb2_), v300 = dstr64<384>(tb3_), v301 = dstr64<10624>(tb3_), v310 = dstr64<20864>(tb3_), v311 = dstr64<31104>(tb3_); \
                    LDS_WAIT_PIN(); \
                    O[12] = MFMA16(cat8(v000, v001), Pf[0], O[12]); O[12] = MFMA16(cat8(v010, v011), Pf[1], O[12]); O[13] = MFMA16(cat8(v100, v101), Pf[0], O[13]); O[13] = MFMA16(cat8(v110, v111), Pf[1], O[13]); O[14] = MFMA16(cat8(v200, v201), Pf[0], O[14]); O[14] = MFMA16(cat8(v210, v211), Pf[1], O[14]); O[15] = MFMA16(cat8(v300, v301), Pf[0], O[15]); O[15] = MFMA16(cat8(v310, v311), Pf[1], O[15]); } \
                } } while (0)
#define AT_V(BUF, VT, KS, T) tr16((BUF) + taddr[(VT) & 3] + ((VT) >> 2) * 128 + (32 * (KS) + 16 * (T)) * 640)
            for (int kt = 0; kt < nkt - 1; ++kt) {
                LAS unsigned char* buf = p.lds + (kt & 1) * TILE_B;
                AT_DMA(p.lds + ((kt + 1) & 1) * TILE_B, kvb + (size_t)64 * (kt + 1) * 320);
                AT_TILE(buf, kt, false);
                asm volatile("s_waitcnt vmcnt(0)" ::: "memory"); __syncthreads();
            }
            { const int kt = nkt - 1; LAS unsigned char* buf = p.lds + (kt & 1) * TILE_B;
              AT_TILE(buf, kt, true);
              __syncthreads(); }
#undef AT_TILE
#undef AT_V
            const float linv = 1.0f / quad_red(lrun);
#pragma unroll
            for (int vt = 0; vt < 16; ++vt) { const f32x4 o = O[vt] * linv;
                *(u32x2*)(OB + rowq * 2048 + h * 256 + 16 * vt + 4 * g4) = (u32x2){cvt_pk_bf16(o[0], o[1]), cvt_pk_bf16(o[2], o[3])}; }
        }
    }
#undef AT_DMA
}

__device__ __forceinline__ void b3_attn_sample(const P& p) {
    const bf16* QF = p.w<bf16>(WS_QF); float* PART = p.w<float>(WS_PART); float* PML = p.w<float>(WS_PML);
    const float* cache = p.in[2]; const int* ptab = (const int*)p.in[5];
    const int tid = p.tid, lane = p.lane, w = p.wave, qt = w & 1, dvq = w >> 1, l15 = lane & 15, g4 = lane >> 4, q4 = (lane & 15) >> 2, pp = lane & 3;
    constexpr int TILE_B = 64 * KP;
    for (int u = p.bid; u < 256; u += p.G) {
        const int b = u >> 3, sp = u & 7;
        const int hq = 4 * qt + (l15 >> 2), iq = l15 & 3; const size_t rowq = (size_t)MP + 4 * b + iq;
        bf16x8 Q[10];
#pragma unroll
        for (int s = 0; s < 10; ++s) Q[s] = as_bf16x8(*(const u32x4*)(QF + rowq * 2560 + hq * 320 + 32 * s + 8 * g4));
        f32x4 O[4];
#pragma unroll
        for (int v = 0; v < 4; ++v) O[v] = (f32x4){0.f, 0.f, 0.f, 0.f};
        float mrun = -1e30f, lrun = 0.f;
        f32x4 st[10];
        auto tile_src = [&](int ti) -> const float* { const int pg = 16 * sp + (ti >> 1); return cache + ((size_t)ptab[b * 128 + pg] * 128 + 64 * (ti & 1)) * 320; };
        { const float* src = tile_src(0);
#pragma unroll
          for (int q = 0; q < 10; ++q) st[q] = __builtin_nontemporal_load((const f32x4*)(src + (size_t)(tid + 512 * q) * 4));
          __syncthreads();
#pragma unroll
          for (int q = 0; q < 10; ++q) { const int ch = tid + 512 * q, row = ch / 80, c4 = ch % 80; *(LAS u32x2*)(p.lds + row * KP + c4 * 8) = (u32x2){cvt_pk_bf16(st[q][0], st[q][1]), cvt_pk_bf16(st[q][2], st[q][3])}; }
          __syncthreads(); }
        for (int ti = 0; ti < 32; ++ti) {
            LAS unsigned char* buf = p.lds + (ti & 1) * TILE_B;
            if (ti + 1 < 32) { const float* src = tile_src(ti + 1);
#pragma unroll
                for (int q = 0; q < 10; ++q) st[q] = __builtin_nontemporal_load((const f32x4*)(src + (size_t)(tid + 512 * q) * 4)); }
            f32x4 S[4];
#pragma unroll
            for (int k4 = 0; k4 < 4; ++k4) { S[k4] = (f32x4){0.f, 0.f, 0.f, 0.f};
#pragma unroll
                for (int s = 0; s < 10; ++s) { const bf16x8 Kf = *(const LAS bf16x8*)(buf + (16 * k4 + l15) * KP + (32 * s + 8 * g4) * 2); S[k4] = MFMA16(Kf, Q[s], S[k4]); } }
            float mx = -1e30f;
#pragma unroll
            for (int k4 = 0; k4 < 4; ++k4)
#pragma unroll
                for (int e = 0; e < 4; ++e) { const float v = S[k4][e]; mx = fmaxf(mx, v); }
            mx = fmaxf(mx, __shfl_xor(mx, 16)); mx = fmaxf(mx, __shfl_xor(mx, 32));
            const float mnew = fmaxf(mrun, mx), alpha = __builtin_amdgcn_exp2f(mrun - mnew); mrun = mnew;
            float ps = 0.f;
#pragma unroll
            for (int k4 = 0; k4 < 4; ++k4)
#pragma unroll
                for (int e = 0; e < 4; ++e) { const float pv = __builtin_amdgcn_exp2f(S[k4][e] - mnew); S[k4][e] = pv; ps += pv; }
            lrun = lrun * alpha + ps;
#pragma unroll
            for (int v = 0; v < 4; ++v) O[v] *= alpha;
            bf16x8 Pf[2];
#pragma unroll
            for (int ks = 0; ks < 2; ++ks) Pf[ks] = as_bf16x8((u32x4){cvt_pk_bf16(S[2 * ks][0], S[2 * ks][1]), cvt_pk_bf16(S[2 * ks][2], S[2 * ks][3]), cvt_pk_bf16(S[2 * ks + 1][0], S[2 * ks + 1][1]), cvt_pk_bf16(S[2 * ks + 1][2], S[2 * ks + 1][3])});
#pragma unroll
            for (int v = 0; v < 4; ++v) { const int vt = 4 * dvq + v;
#pragma unroll
                for (int ks = 0; ks < 2; ++ks) {
                    const bf16x8 Vf = cat8(tr16(buf + (32 * ks + 4 * g4 + q4) * KP + (16 * vt + 4 * pp) * 2), tr16(buf + (32 * ks + 16 + 4 * g4 + q4) * KP + (16 * vt + 4 * pp) * 2));
                    O[v] = MFMA16(Vf, Pf[ks], O[v]); } }
            if (ti + 1 < 32) { LAS unsigned char* nb = p.lds + ((ti + 1) & 1) * TILE_B;
#pragma unroll
                for (int q = 0; q < 10; ++q) { const int ch = tid + 512 * q, row = ch / 80, c4 = ch % 80; *(LAS u32x2*)(nb + row * KP + c4 * 8) = (u32x2){cvt_pk_bf16(st[q][0], st[q][1]), cvt_pk_bf16(st[q][2], st[q][3])}; } }
            __syncthreads();
        }
        const float lsum = quad_red(lrun); const int qrow = 16 * qt + l15; const size_t pb = ((size_t)(b * 8 + sp) * 32 + qrow);
#pragma unroll
        for (int v = 0; v < 4; ++v) *(f32x4*)(PART + pb * 256 + 16 * (4 * dvq + v) + 4 * g4) = O[v];
        if (dvq == 0 && g4 == 0) { PML[pb * 2] = mrun; PML[pb * 2 + 1] = lsum; }
    }
}
__device__ __forceinline__ void b3_combine(const P& p) {
    const bf16* QF = p.w<bf16>(WS_QF); const bf16* KVB = p.w<bf16>(WS_KVB); bf16* OB = p.w<bf16>(WS_OB); const float* PART = p.w<float>(WS_PART); const float* PML = p.w<float>(WS_PML);
    const int dv = p.tid & 255, sub = p.tid >> 8, lane = p.lane, w4 = p.wave & 3;
    LAS float* red = (LAS float*)p.lds;
    for (int base = 2 * p.bid; base < 1024; base += 2 * p.G) {
        const bool live = base + sub < 1024; const int it = live ? base + sub : 1023;
        const int b = it >> 5, i = (it >> 3) & 3, h = it & 7, qt = h >> 2, ql = ((h & 3) << 2) | i, qrow = 16 * qt + ql; const size_t row = (size_t)MP + 4 * b + i;
        { const int wd = dv < 160 ? dv : 159; const unsigned a = ((const unsigned*)(QF + row * 2560 + h * 320))[wd]; float pk[4];
#pragma unroll
          for (int kk = 0; kk < 4; ++kk) { const unsigned c = ((const unsigned*)(KVB + ((size_t)MP + 4 * b + kk) * 320))[wd]; pk[kk] = (dv < 160) ? bflo(a) * bflo(c) + bfhi(a) * bfhi(c) : 0.f; }
#pragma unroll
          for (int kk = 0; kk < 4; ++kk) {
#pragma unroll
              for (int o = 1; o < 64; o <<= 1) pk[kk] += __shfl_xor(pk[kk], o);
              if (lane == 0) red[(sub * 4 + w4) * 4 + kk] = pk[kk]; } }
        __syncthreads();
        float sn[4];
#pragma unroll
        for (int kk = 0; kk < 4; ++kk) { const float s = (red[(sub * 4 + 0) * 4 + kk] + red[(sub * 4 + 1) * 4 + kk]) + (red[(sub * 4 + 2) * 4 + kk] + red[(sub * 4 + 3) * 4 + kk]); sn[kk] = (kk <= i) ? s : -1e30f; }
        float M = fmaxf(fmaxf(sn[0], sn[1]), fmaxf(sn[2], sn[3])); float ms[8], ls[8];
#pragma unroll
        for (int sp = 0; sp < 8; ++sp) { const size_t pb = ((size_t)(b * 8 + sp) * 32 + qrow); ms[sp] = PML[pb * 2]; ls[sp] = PML[pb * 2 + 1]; M = fmaxf(M, ms[sp]); }
        float L = 0.f, Oa = 0.f;
#pragma unroll
        for (int sp = 0; sp < 8; ++sp) { const size_t pb = ((size_t)(b * 8 + sp) * 32 + qrow); const float wgt = __builtin_amdgcn_exp2f(ms[sp] - M); L += ls[sp] * wgt; Oa += PART[pb * 256 + dv] * wgt; }
#pragma unroll
        for (int kk = 0; kk < 4; ++kk) { const float pk = __builtin_amdgcn_exp2f(sn[kk] - M); L += pk; Oa += pk * bf2f(KVB[((size_t)MP + 4 * b + kk) * 320 + dv]); }
        if (live) OB[row * 2048 + h * 256 + dv] = (bf16)f2bf(Oa / L);
        __syncthreads();
    }
}

template <bool SMP>
__device__ __forceinline__ f32x4 conv4(const float* XW, const float* cbuf  , const float* cw, const float* cb, int m, int c) {
    f32x4 acc = *(const f32x4*)(cb + c);
    f32x4 v[4], wv[4];
#pragma unroll
    for (int k = 0; k < 4; ++k) { wv[k] = *(const f32x4*)(cw + k * 1280 + c);
        if (!SMP) { const int t = m & 2047, r = t + k - 3; v[k] = *(const f32x4*)(XW + (size_t)(m + (r >= 0 ? k - 3 : -t)) * 1280 + c); if (r < 0) wv[k] = (f32x4){0.f, 0.f, 0.f, 0.f}; }
        else { const int b = (m - MP) >> 2, t = (m - MP) & 3, r = t + k - 3; const float* ptr = (r >= 0) ? XW + (size_t)(m + k - 3) * 1280 + c : cbuf + ((size_t)b * 3 + (3 + r)) * 1280 + c; v[k] = *(const f32x4*)ptr; } }
#pragma unroll
    for (int k = 0; k < 4; ++k) acc += wv[k] * v[k];
    return acc;
}
__device__ __forceinline__ void c2_sample_item(const P& p, int j, int item, float* out_hs) {
    const float* XW = p.w<float>(WS_XW); bf16* LH = p.w<bf16>(WS_AA);
    const float* cbuf = p.in[4] + (size_t)j * 32 * 3 * 1280; const float* cw = p.in[25] + (size_t)j * 4 * 1280; const float* cb = p.in[26] + j * 1280;
    const float* b_a = p.in[28] + j * 1280; const float* b_i = p.in[30] + j * 1280; const float* lam = p.in[31] + j * 1280; const float* h0s = p.in[3] + (size_t)j * 32 * 1280;
    const bf16* WaT = p.w<bf16>(WS_WAT); const bf16* WiT = p.w<bf16>(WS_WIT);
    LAS unsigned char* Xs = p.lds;
    const int tid = p.tid, lane = p.lane, w = p.wave, l15 = lane & 15, g4 = lane >> 4, rgq = item / 10, n = item % 10;
    const int chl = 16 * w + l15, chn = n * 128 + chl; u32x4 wa[4], wi[4];
#pragma unroll
    for (int kk = 0; kk < 4; ++kk) { wa[kk] = *(const u32x4*)(WaT + (size_t)n * 16384 + chl * 128 + 32 * kk + 8 * g4); wi[kk] = *(const u32x4*)(WiT + (size_t)n * 16384 + chl * 128 + 32 * kk + 8 * g4); }
    const int bb = 4 * rgq + g4; float h = h0s[(size_t)bb * 1280 + chn]; const float ba = b_a[chn], bi = b_i[chn], lm = lam[chn];
    { const int r16 = tid >> 5, c4 = (tid & 31) * 4; const f32x4 xc = conv4<true>(XW, cbuf, cw, cb, MP + 16 * rgq + r16, n * 128 + c4);
      __syncthreads();
      *(LAS u32x2*)(Xs + r16 * TP + c4 * 2) = (u32x2){cvt_pk_bf16(xc[0], xc[1]), cvt_pk_bf16(xc[2], xc[3])}; }
    __syncthreads();
    f32x4 ca = (f32x4){0.f, 0.f, 0.f, 0.f}, ci = ca;
#pragma unroll
    for (int kk = 0; kk < 4; ++kk) { const bf16x8 X = *(const LAS bf16x8*)(Xs + l15 * TP + (32 * kk + 8 * g4) * 2);
        ca = MFMA16(X, as_bf16x8(wa[kk]), ca); ci = MFMA16(X, as_bf16x8(wi[kk]), ci); }
    const float nl = -lm, sp = -8.0f * LOG2E * ((nl > 20.f) ? nl : log1pf(expf(nl)));
#pragma unroll
    for (int e = 0; e < 4; ++e) { const float xc = bf2f(*(const LAS bf16*)(Xs + (4 * g4 + e) * TP + chl * 2));
        const float r = fast_sigmoid_l2(LOG2E * (ca[e] + ba)), gi = fast_sigmoid_l2(LOG2E * (ci[e] + bi)), a = __builtin_amdgcn_exp2f(r * sp);
        const float bt = bf2f((bf16)f2bf(__builtin_amdgcn_sqrtf(fmaxf(__builtin_fmaf(-a, a, 1.0f), 0.f)) * gi * xc));
        h = a * h + bt;
        LH[(size_t)(MP + 4 * bb + e) * 1280 + chn] = (bf16)f2bf(h); }
    if (out_hs) out_hs[(size_t)bb * 1280 + chn] = h;
}
__device__ __forceinline__ void c2_rglru(const P& p, int j, float* out_cp, float* out_cs, float* out_hs, const int mask) {
    const float* XW = p.w<float>(WS_XW); bf16* LH = p.w<bf16>(WS_AA); bf16* CPB = p.w<bf16>(WS_BB); float* AGG = p.w<float>(WS_AGG);
    const float* cbuf = p.in[4] + (size_t)j * 32 * 3 * 1280; const float* cw = p.in[25] + (size_t)j * 4 * 1280; const float* cb = p.in[26] + j * 1280;
    const float* b_a = p.in[28] + j * 1280; const float* b_i = p.in[30] + j * 1280; const float* lam = p.in[31] + j * 1280; const float* h0s = p.in[3] + (size_t)j * 32 * 1280;
    const bf16* WaT = p.w<bf16>(WS_WAT); const bf16* WiT = p.w<bf16>(WS_WIT);
    LAS unsigned char* Xt = p.lds; LAS unsigned char* At = p.lds + 128 * TP; LAS unsigned char* It = p.lds + 256 * TP;
    LAS float* LA = (LAS float*)p.lds;
    LAS unsigned char* LB = p.lds + 128 * 528;
    LAS float* QT = (LAS float*)(p.lds + 128 * 528 + 128 * TP);
    const int tid = p.tid, lane = p.lane, w = p.wave, l15 = lane & 15, g4 = lane >> 4;
    { const int gt = p.bid * 512 + tid, NGT = p.G * 512;
      for (int i = gt; i < (8 + 32) * 3 * 320; i += NGT) { const int c = (i % 320) * 4, rr = i / 320, jj = rr % 3, bb = rr / 3;
          if (bb < 8) { if (out_cp) *(f32x4*)(out_cp + ((size_t)bb * 3 + jj) * 1280 + c) = *(const f32x4*)(XW + ((size_t)bb * 2048 + 2045 + jj) * 1280 + c); }
          else { const int b = bb - 8; if (out_cs) *(f32x4*)(out_cs + ((size_t)b * 3 + jj) * 1280 + c) = *(const f32x4*)(XW + ((size_t)MP + 4 * b + 1 + jj) * 1280 + c); } } }
    const int c16 = tid & 15;
    f32x4 wv[4][2], bv[2], xv0[2][4][2]; u32x4 wa[4], wi[4];
#define C2_LOADW(U) do { const int n_ = (U) % 10, cch_ = n_ * 128 + c16 * 8; \
        _Pragma("unroll") for (int k = 0; k < 4; ++k) { wv[k][0] = *(const f32x4*)(cw + k * 1280 + cch_); wv[k][1] = *(const f32x4*)(cw + k * 1280 + cch_ + 4); } \
        bv[0] = *(const f32x4*)(cb + cch_); bv[1] = *(const f32x4*)(cb + cch_ + 4); } while (0)
#define C2_LOADG(U) do { const int n_ = (U) % 10; \
        _Pragma("unroll") for (int q = 0; q < 4; ++q) { const int row = (tid >> 4) + 32 * q; wa[q] = *(const u32x4*)(WaT + (size_t)n_ * 16384 + row * 128 + c16 * 8); wi[q] = *(const u32x4*)(WiT + (size_t)n_ * 16384 + row * 128 + c16 * 8); } } while (0)
#define C2_LOADX(U, QH, XV) do { const int T_ = (U) / 10, cch_ = ((U) % 10) * 128 + c16 * 8; \
        _Pragma("unroll") for (int qq = 0; qq < 2; ++qq) { const int m = T_ * 128 + (tid >> 4) + 32 * (2 * (QH) + qq); \
            _Pragma("unroll") for (int k = 0; k < 4; ++k) { const float* ptr; \
                if (T_ < 128) { const int t = m & 2047, r = t + k - 3; ptr = XW + (size_t)(m + (r >= 0 ? k - 3 : -t)) * 1280 + cch_; } \
                else { const int b = (m - MP) >> 2, t = (m - MP) & 3, r = t + k - 3; ptr = (r >= 0) ? XW + (size_t)(m + k - 3) * 1280 + cch_ : cbuf + ((size_t)b * 3 + (3 + r)) * 1280 + cch_; } \
                XV[qq][k][0] = *(const f32x4*)ptr; XV[qq][k][1] = *(const f32x4*)(ptr + 4); } } } while (0)
#define C2_CONV(U, QH, XV) do { const int T_ = (U) / 10; \
        _Pragma("unroll") for (int qq = 0; qq < 2; ++qq) { const int row = (tid >> 4) + 32 * (2 * (QH) + qq), m = T_ * 128 + row; f32x4 v0 = bv[0], v1 = bv[1]; \
            _Pragma("unroll") for (int k = 0; k < 4; ++k) { const bool live = (T_ >= 128) || (((m & 2047) + k - 3) >= 0); const f32x4 z = (f32x4){0.f, 0.f, 0.f, 0.f}; \
                v0 += (live ? wv[k][0] : z) * XV[qq][k][0]; v1 += (live ? wv[k][1] : z) * XV[qq][k][1]; } \
            *(LAS u32x4*)(Xt + row * TP + c16 * 16) = pack8(v0, v1); } } while (0)
    if (p.bid < 128 * 10) { C2_LOADX(p.bid, 0, xv0); }
    for (int u = p.bid; u < 128 * 10; u += p.G) {
        int tl_ = p.tid; asm volatile("" : "+v"(tl_)); const int tid = tl_, lane = tl_ & 63, l15 = lane & 15, g4 = lane >> 4, c16 = tl_ & 15;
        const int T = u / 10, n = u % 10, row0 = T * 128;
        {
            C2_LOADW(u); C2_LOADG(u);
            C2_CONV(u, 0, xv0); C2_LOADX(u, 1, xv0); C2_CONV(u, 1, xv0);
#pragma unroll
            for (int q = 0; q < 4; ++q) { const int row = (tid >> 4) + 32 * q; *(LAS u32x4*)(At + row * TP + c16 * 16) = wa[q]; *(LAS u32x4*)(It + row * TP + c16 * 16) = wi[q]; }
        }
        __syncthreads();
        f32x4 ca[8], ci[8];
#pragma unroll
        for (int tt = 0; tt < 8; ++tt) { ca[tt] = (f32x4){0.f, 0.f, 0.f, 0.f}; ci[tt] = (f32x4){0.f, 0.f, 0.f, 0.f}; }
        {
#pragma unroll
        for (int kk = 0; kk < 4; ++kk) {
            const bf16x8 Xa = *(const LAS bf16x8*)(At + (16 * w + l15) * TP + (32 * kk + 8 * g4) * 2), Xi = *(const LAS bf16x8*)(It + (16 * w + l15) * TP + (32 * kk + 8 * g4) * 2);
#pragma unroll
            for (int tt = 0; tt < 8; ++tt) { const bf16x8 Y = *(const LAS bf16x8*)(Xt + (16 * tt + l15) * TP + (32 * kk + 8 * g4) * 2);
                ca[tt] = MFMA16(Xa, Y, ca[tt]); ci[tt] = MFMA16(Xi, Y, ci[tt]); }
        }
        const int chn = n * 128 + 16 * w + 4 * g4;
        { const f32x4 ba = *(const f32x4*)(b_a + chn), bi = *(const f32x4*)(b_i + chn), lm = *(const f32x4*)(lam + chn);
          f32x4 sp;
#pragma unroll
          for (int e = 0; e < 4; ++e) { const float nl = -lm[e]; sp[e] = -8.0f * LOG2E * ((nl > 20.f) ? nl : log1pf(expf(nl))); }
#pragma unroll
          for (int tt = 0; tt < 8; ++tt) { const u32x2 xb = *(const LAS u32x2*)(Xt + (16 * tt + l15) * TP + (16 * w + 4 * g4) * 2);
              const f32x4 xc = (f32x4){bflo(xb.x), bfhi(xb.x), bflo(xb.y), bfhi(xb.y)};
#pragma unroll
              for (int e = 0; e < 4; ++e) { const float r = fast_sigmoid_l2(LOG2E * (ca[tt][e] + ba[e])), gi = fast_sigmoid_l2(LOG2E * (ci[tt][e] + bi[e]));
                  const float a = __builtin_amdgcn_exp2f(r * sp[e]);
                  ca[tt][e] = a; ci[tt][e] = __builtin_amdgcn_sqrtf(fmaxf(__builtin_fmaf(-a, a, 1.0f), 0.f)) * gi * xc[e]; } } }
        }
        __syncthreads();
#pragma unroll
        for (int tt = 0; tt < 8; ++tt) { const int tok = 16 * tt + l15;
            *(LAS f32x4*)(LA + tok * 132 + 16 * w + 4 * g4) = ca[tt];
            *(LAS u32x2*)(LB + tok * TP + (16 * w + 4 * g4) * 2) = (u32x2){cvt_pk_bf16(ci[tt][0], ci[tt][1]), cvt_pk_bf16(ci[tt][2], ci[tt][3])}; }
        __syncthreads();
        { const int un = u + p.G; if (un < 128 * 10) { C2_LOADX(un, 0, xv0); } }
        const int ch = tid & 127, q = tid >> 7, chg = n * 128 + ch;
        {
        if (T < 128) {
            float P_ = 1.f, H_ = 0.f;
#pragma unroll 4
            for (int t = 32 * q; t < 32 * q + 32; ++t) { const float a = LA[t * 132 + ch], b = bf2f(*(const LAS bf16*)(LB + t * TP + ch * 2)); H_ = a * H_ + b; P_ *= a; }
            QT[(q * 128 + ch) * 2] = P_; QT[(q * 128 + ch) * 2 + 1] = H_;
            __syncthreads();
            float h = 0.f, pc = 1.f;
#pragma unroll
            for (int qq = 0; qq < 3; ++qq) if (qq < q) { const float Pq = QT[(qq * 128 + ch) * 2], Hq = QT[(qq * 128 + ch) * 2 + 1]; h = Pq * h + Hq; pc *= Pq; }
#pragma unroll 4
            for (int t = 32 * q; t < 32 * q + 32; ++t) { const float a = LA[t * 132 + ch], b = bf2f(*(const LAS bf16*)(LB + t * TP + ch * 2)); h = a * h + b; pc *= a;
                LA[t * 132 + ch] = pc; *(LAS bf16*)(LB + t * TP + ch * 2) = (bf16)f2bf(h); }
            if (q == 3) { AGG[((size_t)T * 2) * 1280 + chg] = pc; AGG[((size_t)T * 2 + 1) * 1280 + chg] = h; }
        } else {
            for (int bb = 8 * q; bb < 8 * q + 8; ++bb) { float h = h0s[(size_t)bb * 1280 + chg];
#pragma unroll
                for (int i = 0; i < 4; ++i) { const int t = 4 * bb + i; const float a = LA[t * 132 + ch], b = bf2f(*(const LAS bf16*)(LB + t * TP + ch * 2)); h = a * h + b;
                    LA[t * 132 + ch] = 0.f; *(LAS bf16*)(LB + t * TP + ch * 2) = (bf16)f2bf(h); }
                if (out_hs) out_hs[(size_t)bb * 1280 + chg] = h; }
        }
        }
        __syncthreads();
#pragma unroll
        for (int i = 0; i < 4; ++i) { const int cidx = tid + 512 * i, tok = cidx >> 4, c8 = (cidx & 15) * 8; const size_t o = (size_t)(row0 + tok) * 1280 + n * 128 + c8;
            *(u32x4*)(LH + o) = *(const LAS u32x4*)(LB + tok * TP + c8 * 2);
            *(u32x4*)(CPB + o) = pack8(*(const LAS f32x4*)(LA + tok * 132 + c8), *(const LAS f32x4*)(LA + tok * 132 + c8 + 4)); }
        __syncthreads();
    }
#undef C2_LOADW
#undef C2_LOADG
#undef C2_LOADX
#undef C2_CONV
    for (int it = (p.bid + 80) % p.G; it < 80; it += p.G) c2_sample_item(p, j, it, out_hs);
}
__device__ __forceinline__ void c5_fixup(const P& p, float* out_hp) {
    const bf16* LH = p.w<bf16>(WS_AA); const bf16* CPB = p.w<bf16>(WS_BB); const float* AGG = p.w<float>(WS_AGG); const bf16* GATE = p.w<bf16>(WS_GATE); bf16* GH = p.w<bf16>(WS_GH);
    LAS float* cr = (LAS float*)p.lds;
    const int tid = p.tid;
    for (int ci = p.bid * 512 + tid; ci < 128 * 160; ci += p.G * 512) { const size_t o = (size_t)MP * 1280 + (size_t)ci * 8;
        const u32x4 lh = *(const u32x4*)(LH + o), gt = *(const u32x4*)(GATE + o); f32x4 r0, r1;
        r0[0] = bflo(gt.x) * bflo(lh.x); r0[1] = bfhi(gt.x) * bfhi(lh.x); r0[2] = bflo(gt.y) * bflo(lh.y); r0[3] = bfhi(gt.y) * bfhi(lh.y);
        r1[0] = bflo(gt.z) * bflo(lh.z); r1[1] = bfhi(gt.z) * bfhi(lh.z); r1[2] = bflo(gt.w) * bflo(lh.w); r1[3] = bfhi(gt.w) * bfhi(lh.w);
        *(u32x4*)(GH + o) = pack8(r0, r1); }
    for (int it = p.bid; it < 256; it += p.G) {
        const int T = it >> 1, hf = it & 1, row0 = T * 128 + 64 * hf, T0 = T & ~15, nd = T - T0;
        const size_t ob = (size_t)row0 * 1280 + (size_t)tid * 8;
#define C5_LOAD(LHV, CPV, GTV, K) do { _Pragma("unroll") for (int i = 0; i < 5; ++i) { const size_t o = ob + (size_t)(5 * (K) + i) * 4096; \
            LHV[i] = *(const u32x4*)(LH + o); CPV[i] = *(const u32x4*)(CPB + o); GTV[i] = *(const u32x4*)(GATE + o); } } while (0)
        u32x4 lhA[5], cpA[5], gtA[5], lhB[5], cpB[5], gtB[5];
        C5_LOAD(lhA, cpA, gtA, 0);
        for (int ch = tid; ch < 1280; ch += 512) {
            float pa[16], ha[16];
#pragma unroll
            for (int d = 0; d < 16; ++d) { pa[d] = AGG[((size_t)(T0 + d) * 2) * 1280 + ch]; ha[d] = AGG[((size_t)(T0 + d) * 2 + 1) * 1280 + ch]; }
            float c = 0.f;
#pragma unroll
            for (int d = 0; d < 15; ++d) c = (d < nd) ? pa[d] * c + ha[d] : c;
            if (nd == 15 && hf == 1 && out_hp) out_hp[(size_t)(T >> 4) * 1280 + ch] = pa[15] * c + ha[15];
            cr[ch] = c; }
        __syncthreads();
#define C5_ITEM(LHV, CPV, GTV, I) do { const int c8 = ((tid + 512 * (I)) % 160) * 8; const size_t o = ob + (size_t)(I) * 4096; \
            const f32x4 c0 = *(const LAS f32x4*)(cr + c8), c1 = *(const LAS f32x4*)(cr + c8 + 4); f32x4 r0, r1; \
            r0[0] = bflo(GTV.x) * (bflo(LHV.x) + bflo(CPV.x) * c0[0]); r0[1] = bfhi(GTV.x) * (bfhi(LHV.x) + bfhi(CPV.x) * c0[1]); \
            r0[2] = bflo(GTV.y) * (bflo(LHV.y) + bflo(CPV.y) * c0[2]); r0[3] = bfhi(GTV.y) * (bfhi(LHV.y) + bfhi(CPV.y) * c0[3]); \
            r1[0] = bflo(GTV.z) * (bflo(LHV.z) + bflo(CPV.z) * c1[0]); r1[1] = bfhi(GTV.z) * (bfhi(LHV.z) + bfhi(CPV.z) * c1[1]); \
            r1[2] = bflo(GTV.w) * (bflo(LHV.w) + bflo(CPV.w) * c1[2]); r1[3] = bfhi(GTV.w) * (bfhi(LHV.w) + bfhi(CPV.w) * c1[3]); \
            *(u32x4*)(GH + o) = pack8(r0, r1); } while (0)
        C5_LOAD(lhB, cpB, gtB, 1);
#pragma unroll
        for (int i = 0; i < 5; ++i) C5_ITEM(lhA[i], cpA[i], gtA[i], i);
        C5_LOAD(lhA, cpA, gtA, 2);
#pragma unroll
        for (int i = 0; i < 5; ++i) C5_ITEM(lhB[i], cpB[i], gtB[i], 5 + i);
        C5_LOAD(lhB, cpB, gtB, 3);
#pragma unroll
        for (int i = 0; i < 5; ++i) C5_ITEM(lhA[i], cpA[i], gtA[i], 10 + i);
#pragma unroll
        for (int i = 0; i < 5; ++i) C5_ITEM(lhB[i], cpB[i], gtB[i], 15 + i);
#undef C5_LOAD
#undef C5_ITEM
        __syncthreads();
    }
}
__device__ __forceinline__ void final_norm(const P& p, float* out_yp, float* out_ys) {
    const bf16* HB = p.w<bf16>(WS_HB); const long long* ssq = p.stat(ST_SSQ0 + 8); const float* g = p.in[8];
    const int gw = p.bid * NWAVES + p.wave, NGW = p.G * NWAVES, lane = p.lane;
    f32x4 gv[4];
#pragma unroll
    for (int jj = 0; jj < 4; ++jj) gv[jj] = *(const f32x4*)(g + 4 * lane + 256 * jj);
    u32x2 hw[4], hn[4]; long long sq = 0, sn = 0;
    if (gw < MT) { sq = ssq[gw];
#pragma unroll
        for (int jj = 0; jj < 4; ++jj) hw[jj] = *(const u32x2*)(HB + (size_t)gw * 1024 + 4 * lane + 256 * jj); }
    for (int m = gw; m < MT; m += NGW) { float* o = m < MP ? out_yp + (size_t)m * 1024 : out_ys + (size_t)(m - MP) * 1024;
        const int mn = (m + NGW < MT) ? m + NGW : m; sn = ssq[mn];
#pragma unroll
        for (int jj = 0; jj < 4; ++jj) hn[jj] = *(const u32x2*)(HB + (size_t)mn * 1024 + 4 * lane + 256 * jj);
        const float rs = rsqrtf((float)sq * ST_INV * (1.0f / 1024.0f) + RMS_EPS);
#pragma unroll
        for (int jj = 0; jj < 4; ++jj) *(f32x4*)(o + 4 * lane + 256 * jj) = (f32x4){bflo(hw[jj].x), bfhi(hw[jj].x), bflo(hw[jj].y), bfhi(hw[jj].y)} * rs * gv[jj];
#pragma unroll
        for (int jj = 0; jj < 4; ++jj) hw[jj] = hn[jj];
        sq = sn; }
}
}
namespace mk {
struct Args { const float* in[36]; float* out; unsigned char* ws; int ph_lo, ph_hi, li, mask; };
constexpr int NPHASE = 34;

#define MK_GEMM(EpiT, E, Aptr, LDA, Bptr, LDB, KD, NC) do { pg8::Gemm g_{(const pg8::bf16_t*)(Aptr), (const pg8::bf16_t*)(Bptr), (LDA), (LDB), (KD)}; pg8::StaticOrder S_; S_.init(MP, (NC), p.G, p.bid); \
        pg8::gemm_phase<EpiT, pg8::StaticOrder, MK_ALIGN_EPI, MK_SP2>(p.lds, g_, S_, E, p.tid); \
          \
        P q_ = p; { int t2_ = p0.tid; asm volatile("" : "+v"(t2_)); q_.tid = t2_; q_.lane = t2_ & 63; q_.wave = __builtin_amdgcn_readfirstlane(t2_ >> 6); } \
        if (MK_MINI_ON) mini_gemm<EpiT>(q_, (const bf16*)(Aptr), (LDA), (const bf16*)(Bptr), (LDB), (KD), (NC), E, (64 * ((NC) / 256)) % p.G); } while (0)

#ifndef MK_SP2
#define MK_SP2 true
#endif
#ifndef MK_ALIGN_EPI
#define MK_ALIGN_EPI true
#endif
#ifdef MK_DRYPROBE
#define MK_DRYARG , ((mask >> 10) & 1)
#define MK_MINI_ON ((mask >> 11) & 1)
#else
#define MK_DRYARG
#define MK_MINI_ON 1
#endif
#ifndef MK_REP_SEL
#define MK_REP_SEL(k) 0
#define MK_REP_N 1
#endif
#define REPF(k) for (int rep_ = 0; rep_ < (MK_REP_SEL(k) ? MK_REP_N : 1); ++rep_)
#define IN_(k) (lo <= (k) && (k) < hi)
#define PH_BEGIN() P p = p0; { int z_ = 0, t_ = p0.tid, g_ = p0.G, b_ = p0.bid; unsigned l_ = (unsigned)(size_t)p0.lds; asm volatile("" : "+s"(z_), "+v"(t_), "+s"(g_), "+s"(b_), "+s"(l_)); p.ws = p0.ws + z_; p.out = p0.out + z_; p.tid = t_; p.lane = t_ & 63; p.wave = __builtin_amdgcn_readfirstlane(t_ >> 6); p.G = g_; p.bid = b_; p.lds = (LAS unsigned char*)(size_t)l_; } float* const out = p.out; (void)out
#ifdef MK_PROF
#define STAMP(k) do { if (p0.bid == 0 && p0.tid == 0) ((unsigned long long*)(p0.ws + WS_PROF))[(k)] = (unsigned long long)wall_clock64(); } while (0)
#else
#define STAMP(k) do { } while (0)
#endif
#define ENDPH(k) do { if ((k) + 1 < hi) xcd_barrier(bar); STAMP((k) + 1); } while (0)
template <int LAYER> __device__ __forceinline__ void run_layer(const P& p0, const XcdBarrier& bar, const int lo, const int hi, const int mask) {
        constexpr int layer = LAYER, kind = layer % 3, j = layer / 3, pb = 1 + 8 * layer;
        constexpr size_t resA = kind == 0 ? WS_UM : kind == 1 ? WS_OB : WS_GH, resB = kind == 0 ? WS_WOUT + (size_t)j * 2 * MiB : kind == 1 ? WS_WOV : WS_WCO; constexpr int resK = kind == 0 ? 1024 : kind == 1 ? 2048 : 1280;
        if constexpr (kind == 0) {
            if (IN_(pb)) REPF(pb) { PH_BEGIN(); EpiA1 E{p.w<bf16>(WS_U), p.w<bf16>(WS_GV), p.stat(ST_SSQ0 + 2 * layer), p.stat(ST_LNS0 + 2 * j), p.stat(ST_LNQ0 + 2 * j) MK_DRYARG};
                MK_GEMM(EpiA1, E, p.w<bf16>(WS_HB), 1024, p.w<bf16>(WS_WIN + (size_t)j * 4 * MiB), 1024, 1024, 2048); ENDPH(pb); }
            if (IN_(pb + 1)) REPF(pb + 1) { PH_BEGIN(); a2_spatial(p, j, out + O_CV + (size_t)j * 131072); ENDPH(pb + 1); }
        } else if constexpr (kind == 1) {
            if (IN_(pb)) REPF(pb) { PH_BEGIN(); EpiB1 E{p.w<float>(WS_RAW), p.w<bf16>(WS_CQB), p.stat(ST_SSQ0 + 2 * layer), p.stat(ST_KV), p.stat(ST_Q) MK_DRYARG};
                MK_GEMM(EpiB1, E, p.w<bf16>(WS_HB), 1024, p.w<bf16>(WS_WDQKV), 1024, 1024, 768); ENDPH(pb); }
            if (IN_(pb + 1)) REPF(pb + 1) { PH_BEGIN(); b2_kvfinal(p, out + O_MP, out + O_MS);
                EpiB2 E{p.w<bf16>(WS_QF), p.stat(ST_Q), p.w<f32x2>(WS_ROPE)};
                MK_GEMM(EpiB2, E, p.w<bf16>(WS_CQB), 384, p.w<bf16>(WS_WQ), 384, 384, 2560); ENDPH(pb + 1); }
            if (IN_(pb + 2)) REPF(pb + 2) { PH_BEGIN();
                if (mask & 256) b3_attn_prompt(p); if (mask & 512) b3_attn_sample(p);
                ENDPH(pb + 2); }
            if (IN_(pb + 3)) REPF(pb + 3) { PH_BEGIN(); b3_combine(p); ENDPH(pb + 3); }
        } else {
            if (IN_(pb)) REPF(pb) { PH_BEGIN(); EpiC1 E{p.w<bf16>(WS_GATE), p.w<float>(WS_XW), p.stat(ST_SSQ0 + 2 * layer)};
                MK_GEMM(EpiC1, E, p.w<bf16>(WS_HB), 1024, p.w<bf16>(WS_WGX), 1024, 1024, 2560); ENDPH(pb); }
            if (IN_(pb + 1)) REPF(pb + 1) { PH_BEGIN(); c2_rglru(p, j, out + O_CP, out + O_CS, out + O_HS, mask); ENDPH(pb + 1); }
            if (IN_(pb + 3)) REPF(pb + 3) { PH_BEGIN(); c5_fixup(p, out + O_HP); ENDPH(pb + 3); }
        }
        if (IN_(pb + 5)) REPF(pb + 5) { PH_BEGIN(); EpiRes E{p.w<bf16>(WS_HB), p.stat(ST_SSQ0 + 2 * layer + 1) MK_DRYARG}; MK_GEMM(EpiRes, E, p.w<bf16>(resA), resK, p.w<bf16>(resB), resK, resK, 1024); ENDPH(pb + 5); }
        if (IN_(pb + 6)) REPF(pb + 6) { PH_BEGIN(); EpiF1 E{p.w<bf16>(WS_ACT), p.stat(ST_SSQ0 + 2 * layer + 1)}; MK_GEMM(EpiF1, E, p.w<bf16>(WS_HB), 1024, p.w<bf16>(WS_WGU + (size_t)layer * WGU_BYTES), 1024, 1024, 5632); ENDPH(pb + 6); }
        if (IN_(pb + 7)) REPF(pb + 7) { PH_BEGIN(); EpiRes E{p.w<bf16>(WS_HB), p.stat(ST_SSQ0 + 2 * layer + 2) MK_DRYARG}; MK_GEMM(EpiRes, E, p.w<bf16>(WS_ACT), DFF, p.w<bf16>(WS_WD + (size_t)layer * WD_BYTES), DFF, DFF, 1024); ENDPH(pb + 7); }
}
__global__ void __launch_bounds__(NWAVES * 64, 2) mk_fwd(Args a) {
    extern __shared__ __attribute__((aligned(16))) unsigned char lds_raw[];
    const int tid_ = threadIdx.x;
    const P p0{InTab{(const float* const __attribute__((address_space(4)))*)__builtin_amdgcn_kernarg_segment_ptr()}, a.out, a.ws, (LAS unsigned char*)lds_raw, tid_, tid_ & 63, __builtin_amdgcn_readfirstlane(tid_ >> 6), (int)gridDim.x, (int)blockIdx.x};
    volatile LAS unsigned* MISC = (volatile LAS unsigned*)(p0.lds + MISC_OFF);
    if (p0.tid < 64) MISC[p0.tid] = 0u;
    __syncthreads();
    XcdBarrier bar = xcd_barrier_post((unsigned*)(a.ws + WS_CTL) + CW_BAR + a.li * XCD_BAR_WORDS, MISC + 8);
    const int lo = a.ph_lo, hi = a.ph_hi, mask = a.mask;
    STAMP(0);
    if (IN_(0)) REPF(0) { PH_BEGIN(); p0_prologue(p, mask); if (mask & 128)
        { const int gt = p.bid * 512 + p.tid, NGT = p.G * 512; const u32x4 z = (u32x4){0u, 0u, 0u, 0u};
          for (int i = gt; i < 128 * 128; i += NGT) p.w<u32x4>(WS_UM + (size_t)MT * 2048)[i] = z;
          for (int i = gt; i < 128 * 256; i += NGT) p.w<u32x4>(WS_OB + (size_t)MT * 4096)[i] = z;
          for (int i = gt; i < 128 * 160; i += NGT) p.w<u32x4>(WS_GH + (size_t)MT * 2560)[i] = z; }
        ENDPH(0); }
    run_layer<0>(p0, bar, lo, hi, mask); run_layer<1>(p0, bar, lo, hi, mask); run_layer<2>(p0, bar, lo, hi, mask); run_layer<3>(p0, bar, lo, hi, mask);
    if (IN_(33)) REPF(33) { PH_BEGIN(); final_norm(p, out + O_YP, out + O_YS); VM_WAIT(); STAMP(34); }
#undef IN_
#undef ENDPH
}

inline void fill_args(Args& a, void* const* d_in, float* out, void* d_ws) { for (int i = 0; i < 36; ++i) a.in[i] = (const float*)d_in[i]; a.out = out; a.ws = (unsigned char*)d_ws; a.mask = -1; }
inline int setup_grid() {
    static int grid = 0;
    if (!grid) { int dev = 0, cus = 0; hipGetDevice(&dev); hipDeviceGetAttribute(&cus, hipDeviceAttributeMultiprocessorCount, dev);
        hipFuncSetAttribute((const void*)mk_fwd, hipFuncAttributeMaxDynamicSharedMemorySize, LDS_BYTES);
        int per_cu = 0; hipOccupancyMaxActiveBlocksPerMultiprocessor(&per_cu, (const void*)mk_fwd, NWAVES * 64, LDS_BYTES); (void)hipGetLastError();
        grid = cus > 0 ? cus : 256; }
    return grid;
}
inline void launch_range(void* const* d_in, float* out, void* d_ws, hipStream_t st, int lo, int hi, int li, int mask = -1) {
    Args a{}; fill_args(a, d_in, out, d_ws); a.ph_lo = lo; a.ph_hi = hi; a.li = li; a.mask = mask;
    hipLaunchKernelGGL(mk_fwd, dim3(setup_grid()), dim3(NWAVES * 64), LDS_BYTES, st, a);
}
}

extern "C" void kernel_launch(void* const* d_in, const int* in_sizes, int n_in, void* d_out, int out_size, void* d_ws, size_t ws_size, hipStream_t stream) {
    hipMemsetAsync(d_ws, 0, mk::CTL_BYTES, stream);
    mk::launch_range(d_in, (float*)d_out, d_ws, stream, 0, mk::NPHASE, 0);
}
```

```cpp
#include <hip/hip_runtime.h>
#include <math.h>
#define LAS __attribute__((address_space(3)))
#define GAS __attribute__((address_space(1)))
namespace pg8 {
#define PG8_LAS __attribute__((address_space(3)))
typedef unsigned short bf16_t;
typedef short bf16x8 __attribute__((ext_vector_type(8)));
typedef float f32x4 __attribute__((ext_vector_type(4)));
typedef unsigned u32x4 __attribute__((ext_vector_type(4)));
constexpr int BM = 256, BK = 64, HALF = 128, HTB = HALF * BK * 2  , STAGE_BYTES = 8 * HTB, NXCD = 8, WGM = 8;
__host__ __device__ __forceinline__ int lds_byte(int r, int c) { const int st = (r >> 4) * 2 + (c >> 5), rr = r & 15, cc = c & 31, ob = rr * 64 + cc * 2; return st * 1024 + (ob ^ (((ob >> 9) & 1) << 5)); }
__host__ __device__ __forceinline__ void stage_rc(int b, int& R, int& C) { const int st = b / 1024, sb = b % 1024, swz = sb ^ (((sb >> 9) & 1) << 5); R = (st >> 1) * 16 + swz / 64; C = (st & 1) * 32 + (swz % 64) / 2; }
__host__ __device__ __forceinline__ int perm32(int rho) { const int n = rho >> 4, i = rho & 15; return 8 * (i >> 2) + 4 * n + (i & 3); }
struct Unit { int pm, pn; };
struct Gemm { const bf16_t* A; const bf16_t* Bt; int lda, ldb, K; };
struct StaticOrder {
    int nM, nN, nwg, G, c;
    __host__ __device__ void init(int M, int N, int G_, int c_) { nM = M / BM; nN = N / BM; nwg = nM * nN; G = G_; c = c_; }
    __host__ __device__ bool next(int i, Unit& u) const {
        const long L = (long)i * G + c; if (L >= nwg) return false;
        int wgid = (int)L; { const int q = nwg / NXCD, r = nwg % NXCD, xcd = wgid % NXCD, off = wgid / NXCD; wgid = (xcd < r ? xcd * (q + 1) : r * (q + 1) + (xcd - r) * q) + off; }
        const int nig = WGM * nN, gid = wgid / nig, fm = gid * WGM, gsz = (nM - fm) < WGM ? (nM - fm) : WGM;
        u.pm = fm + ((wgid % nig) % gsz); u.pn = (wgid % nig) / gsz; return true;
    }
    __device__ __forceinline__ void a_ready(const Unit&) const {}
    __device__ __forceinline__ void done(const Unit&) const {}
};
__device__ __forceinline__ unsigned cvt_pk_bf16(float lo, float hi) { unsigned r; asm volatile("v_cvt_pk_bf16_f32 %0, %1, %2" : "=v"(r) : "v"(lo), "v"(hi)); return r; }
template <class Epi, class Sched, bool ALIGN_EPI = false, bool SP2 = false>
__device__ __forceinline__ void gemm_phase(PG8_LAS unsigned char* lds, const Gemm g, const Sched& S, const Epi& E, const int tid) {
    const int wid = __builtin_amdgcn_readfirstlane(tid >> 6), lane = tid & 63, wr = wid >> 2, wc = wid & 3, fr = lane & 15, fq = lane >> 4;
    const int K = g.K, nt = K / BK, lda = g.lda, ldb = g.ldb;
    unsigned voffA[2], voffB[2];
#pragma unroll
    for (int i = 0; i < 2; ++i) { int R, C; stage_rc(tid * 16 + i * 8192, R, C); const int Rb = Epi::PERM ? ((R & ~31) + perm32(R & 31)) : R;
        voffA[i] = (unsigned)(R * lda + C) * 2u; voffB[i] = (unsigned)(Rb * ldb + C) * 2u; }
    const size_t kstep = (size_t)(BK * 2);
    const size_t hstepA = (size_t)HALF * lda * 2, hstepB = (size_t)HALF * ldb * 2;
    const size_t tstepA = 2 * hstepA, tstepB = 2 * hstepB;
    const unsigned ldsw = (unsigned)wid * 1024u;
    const int aoff = lds_byte(wr * 64 + fr, fq * 8), boff = lds_byte(wc * 32 + fr, fq * 8);
#define PG8_SA(b, h) (((b) * 2 + (h)) * HTB)
#define PG8_SB(b, h) ((4 + (b) * 2 + (h)) * HTB)
#define PG8_STAGE(bufoff, gbase, voff) do { _Pragma("unroll") for (int _i = 0; _i < 2; ++_i) \
        __builtin_amdgcn_global_load_lds((const unsigned*)((const char*)(gbase) + (voff)[_i]), (PG8_LAS unsigned*)(lds + (bufoff) + ldsw + _i * 8192), 16, 0, 0); } while (0)
#define PG8_LDA(dst, b, h) do { _Pragma("unroll") for (int m = 0; m < 4; ++m) _Pragma("unroll") for (int k = 0; k < 2; ++k) dst[m][k] = *(const PG8_LAS bf16x8*)(lds + PG8_SA(b, h) + aoff + m * 2048 + k * 1024); } while (0)
#define PG8_LDB(dst, b, h) do { _Pragma("unroll") for (int n = 0; n < 2; ++n) _Pragma("unroll") for (int k = 0; k < 2; ++k) dst[n][k] = *(const PG8_LAS bf16x8*)(lds + PG8_SB(b, h) + boff + n * 2048 + k * 1024); } while (0)
#define PG8_MMA(ai, bj, At, Bt) do { __builtin_amdgcn_s_setprio(1); _Pragma("unroll") for (int m = 0; m < 4; ++m) _Pragma("unroll") for (int n = 0; n < 2; ++n) _Pragma("unroll") for (int k = 0; k < 2; ++k) \
        acc[ai][bj][m][n] = __builtin_amdgcn_mfma_f32_16x16x32_bf16(Bt[n][k], At[m][k], acc[ai][bj][m][n], 0, 0, 0); __builtin_amdgcn_s_setprio(0); } while (0)
#define PG8_WAIT_V(n) asm volatile("s_waitcnt vmcnt(" #n ")" ::: "memory")
#define PG8_WAIT_L(n) asm volatile("s_waitcnt lgkmcnt(" #n ")" ::: "memory")
#define PG8_BAR __builtin_amdgcn_s_barrier()
#define PG8_SCHED __builtin_amdgcn_sched_barrier(0)
    Unit cur, nxt; int ui = 0;
    if (!S.next(0, cur)) return;
    f32x4 acc[2][2][4][2];
    E.init(acc, cur, wr, wc, fr, fq);
    bf16x8 At[4][2], B0[2][2], B1[2][2];
    const char* cA = (const char*)g.A + (size_t)cur.pm * tstepA; const char* cB = (const char*)g.Bt + (size_t)cur.pn * tstepB;
    S.a_ready(cur);
    if constexpr (SP2) {
        PG8_STAGE(PG8_SB(0, 0), cB, voffB); PG8_STAGE(PG8_SB(0, 1), cB + hstepB, voffB); PG8_STAGE(PG8_SA(0, 0), cA, voffA); PG8_STAGE(PG8_SA(0, 1), cA + hstepA, voffA);
        if (wr == 1) PG8_BAR;
        PG8_WAIT_V(2); PG8_BAR;
        PG8_STAGE(PG8_SB(1, 0), cB + kstep, voffB); PG8_STAGE(PG8_SA(1, 0), cA + kstep, voffA); PG8_STAGE(PG8_SB(1, 1), cB + hstepB + kstep, voffB);
        PG8_WAIT_V(6); PG8_BAR;
    } else {
        PG8_STAGE(PG8_SB(0, 0), cB, voffB); PG8_STAGE(PG8_SA(0, 0), cA, voffA); PG8_STAGE(PG8_SB(0, 1), cB + hstepB, voffB); PG8_STAGE(PG8_SA(0, 1), cA + hstepA, voffA);
        if (wr == 1) PG8_BAR;
        PG8_WAIT_V(4); PG8_BAR;
        PG8_STAGE(PG8_SB(1, 0), cB + kstep, voffB); PG8_STAGE(PG8_SA(1, 0), cA + kstep, voffA); PG8_STAGE(PG8_SB(1, 1), cB + hstepB + kstep, voffB);
        PG8_WAIT_V(6); PG8_BAR;
    }
    for (;;) {
        const bool has_next = S.next(ui + 1, nxt);
        const char* nA = has_next ? (const char*)g.A + (size_t)nxt.pm * tstepA : cA; const char* nB = has_next ? (const char*)g.Bt + (size_t)nxt.pn * tstepB : cB;
        for (int t = 0; t < nt; t += 2) {
            const bool last = (t == nt - 2);
            const char* a1 = cA + (size_t)(t + 1) * kstep;
            const char* a2 = last ? nA : cA + (size_t)(t + 2) * kstep; const char* b2 = last ? nB : cB + (size_t)(t + 2) * kstep;
            const char* a3 = a2 + kstep; const char* b3 = b2 + kstep;
            if (last && has_next) S.a_ready(nxt);
            if constexpr (SP2) {
            PG8_LDB(B0, 0, 0); PG8_LDB(B1, 0, 1); PG8_SCHED; PG8_LDA(At, 0, 0); PG8_STAGE(PG8_SA(1, 1), a1 + hstepA, voffA);
            PG8_WAIT_V(8); PG8_WAIT_L(0); PG8_BAR; PG8_MMA(0, 0, At, B0); PG8_MMA(0, 1, At, B1); PG8_BAR; PG8_SCHED;
            PG8_LDA(At, 0, 1); PG8_STAGE(PG8_SB(0, 0), b2, voffB); PG8_STAGE(PG8_SB(0, 1), b2 + hstepB, voffB); PG8_STAGE(PG8_SA(0, 0), a2, voffA);
            PG8_WAIT_V(8); PG8_WAIT_L(0); PG8_BAR; PG8_MMA(1, 0, At, B0); PG8_MMA(1, 1, At, B1); PG8_BAR; PG8_SCHED;
            PG8_LDB(B0, 1, 0); PG8_LDB(B1, 1, 1); PG8_SCHED; PG8_LDA(At, 1, 0); PG8_STAGE(PG8_SA(0, 1), a2 + hstepA, voffA);
            PG8_WAIT_V(8); PG8_WAIT_L(0); PG8_BAR; PG8_MMA(0, 0, At, B0); PG8_MMA(0, 1, At, B1); PG8_BAR; PG8_SCHED;
            PG8_LDA(At, 1, 1); PG8_STAGE(PG8_SB(1, 0), b3, voffB); PG8_STAGE(PG8_SB(1, 1), b3 + hstepB, voffB); PG8_STAGE(PG8_SA(1, 0), a3, voffA);
            PG8_WAIT_V(8); PG8_WAIT_L(0); PG8_BAR; PG8_MMA(1, 0, At, B0); PG8_MMA(1, 1, At, B1); PG8_BAR; PG8_SCHED;
            } else {
            PG8_LDB(B0, 0, 0); PG8_SCHED; PG8_LDA(At, 0, 0); PG8_STAGE(PG8_SA(1, 1), a1 + hstepA, voffA);
            PG8_WAIT_L(8); PG8_BAR; PG8_WAIT_L(0); PG8_MMA(0, 0, At, B0); PG8_BAR; PG8_SCHED;
            PG8_LDB(B1, 0, 1); PG8_STAGE(PG8_SB(0, 0), b2, voffB);
            PG8_BAR; PG8_WAIT_L(0); PG8_MMA(0, 1, At, B1); PG8_BAR;
            PG8_LDA(At, 0, 1); PG8_STAGE(PG8_SA(0, 0), a2, voffA);
            PG8_BAR; PG8_WAIT_L(0); PG8_MMA(1, 0, At, B0); PG8_BAR; PG8_SCHED;
            PG8_STAGE(PG8_SB(0, 1), b2 + hstepB, voffB);
            PG8_WAIT_V(6); PG8_BAR; PG8_MMA(1, 1, At, B1); PG8_BAR;
            PG8_LDB(B0, 1, 0); PG8_SCHED; PG8_LDA(At, 1, 0); PG8_STAGE(PG8_SA(0, 1), a2 + hstepA, voffA);
            PG8_WAIT_L(8); PG8_BAR; PG8_WAIT_L(0); PG8_MMA(0, 0, At, B0); PG8_BAR; PG8_SCHED;
            PG8_LDB(B1, 1, 1); PG8_STAGE(PG8_SB(1, 0), b3, voffB);
            PG8_BAR; PG8_WAIT_L(0); PG8_MMA(0, 1, At, B1); PG8_BAR;
            PG8_LDA(At, 1, 1); PG8_STAGE(PG8_SA(1, 0), a3, voffA);
            PG8_BAR; PG8_WAIT_L(0); PG8_MMA(1, 0, At, B0); PG8_BAR; PG8_SCHED;
            PG8_STAGE(PG8_SB(1, 1), b3 + hstepB, voffB);
            PG8_WAIT_V(6); PG8_BAR; PG8_MMA(1, 1, At, B1); PG8_BAR;
            }
        }
        if constexpr (ALIGN_EPI) { if (wr == 0) PG8_BAR; }
        if constexpr (!Epi::AFTER_DRAIN) { E(acc, cur, wr, wc, fr, fq); S.done(cur); }
        if (!has_next) break;
        E.init(acc, nxt, wr, wc, fr, fq);
        cur = nxt; cA = nA; cB = nB; ++ui;
        if constexpr (ALIGN_EPI) { if (wr == 1) PG8_BAR; }
    }
    PG8_WAIT_V(0);
    if constexpr (!ALIGN_EPI) { if (wr == 0) PG8_BAR; }
    PG8_BAR;
    if constexpr (Epi::AFTER_DRAIN) { E.fused(acc, cur, wr, wc, fr, fq, lds, wid, lane); S.done(cur); }
#undef PG8_SA
#undef PG8_SB
#undef PG8_STAGE
#undef PG8_LDA
#undef PG8_LDB
#undef PG8_MMA
#undef PG8_WAIT_V
#undef PG8_WAIT_L
#undef PG8_BAR
#undef PG8_SCHED
}

}

namespace mk {
using pg8::f32x4; using pg8::bf16x8; using pg8::u32x4; using pg8::cvt_pk_bf16;
typedef unsigned short bf16;
typedef unsigned u32x2 __attribute__((ext_vector_type(2)));
typedef short s16x4 __attribute__((ext_vector_type(4)));
typedef float f32x2 __attribute__((ext_vector_type(2)));
typedef GAS unsigned gu32;
#define RLX_AGENT __ATOMIC_RELAXED, __HIP_MEMORY_SCOPE_AGENT
#define XB_TMO      128
#define XB_XCNT(j)  (256  + 64 * (j))
#define XB_XSUB(j)  (1280 + 64 * (j))
#define XB_XGEN(j)  (2304 + 64 * (j))
#define XB_TOP      3328
#define XB_TOPGEN   3392
#define XCD_BAR_WORDS 3456
#define XB_SPIN_CAP (1u << 18)

__device__ __forceinline__ unsigned xb_ld(unsigned* p)              { return __hip_atomic_load(p, __ATOMIC_RELAXED, __HIP_MEMORY_SCOPE_AGENT); }
__device__ __forceinline__ unsigned xb_add(unsigned* p, unsigned v) { return __hip_atomic_fetch_add(p, v, __ATOMIC_RELAXED, __HIP_MEMORY_SCOPE_AGENT); }
__device__ __forceinline__ unsigned xb_xcc_id() { return (unsigned)__builtin_amdgcn_s_getreg((3 << 11) | 20) & 0xFu; }
#define XB_SPIN(cond, bar) do { unsigned _sp = 0; while (cond) { __builtin_amdgcn_s_sleep(1); \
    if ((++_sp & 255u) == 0u) { if (xb_ld(&(bar)[XB_TMO])) break; if (_sp > XB_SPIN_CAP) { atomicAdd(&(bar)[XB_TMO], 1u); break; } } } } while (0)

struct XcdBarrier {
    unsigned* bar; unsigned x;
    volatile LAS unsigned* st;
};

__device__ __forceinline__ XcdBarrier xcd_barrier_post(unsigned* bar, volatile LAS unsigned* st) {
    XcdBarrier b; b.bar = bar; b.x = xb_xcc_id(); b.st = st;
    if (threadIdx.x == 0) (void)xb_add(&bar[XB_XCNT(b.x)], 1u);
    return b;
}
__device__ __forceinline__ void xcd_barrier_complete(unsigned* bar, unsigned x, unsigned& nloc, unsigned& nx) {
    const unsigned G = gridDim.x * gridDim.y * gridDim.z;
    unsigned sum, cnt, mine, sp = 0u;
    for (;;) {
        sum = 0u; cnt = 0u; mine = 0u;
#pragma unroll
        for (unsigned j = 0; j < 16; ++j) { const unsigned c = xb_ld(&bar[XB_XCNT(j)]); sum += c; cnt += (c > 0u) ? 1u : 0u; mine = (j == x) ? c : mine; }
        if (sum == G) break;
        __builtin_amdgcn_s_sleep(1);
        if ((++sp & 255u) == 0u) { if (xb_ld(&bar[XB_TMO])) break; if (sp > XB_SPIN_CAP) { atomicAdd(&bar[XB_TMO], 1u); break; } }
    }
    nloc = mine > 0u ? mine : 1u; nx = cnt > 0u ? cnt : 1u;
}

__device__ __forceinline__ void xcd_barrier(const XcdBarrier& b) {
    asm volatile("s_waitcnt vmcnt(0)" ::: "memory");
    __syncthreads();
    if (threadIdx.x == 0) {
        unsigned* bar = b.bar;
        __builtin_amdgcn_s_waitcnt(0);
        unsigned nloc = b.st[0], nx = b.st[1];
        if (nloc == 0u) { xcd_barrier_complete(bar, b.x, nloc, nx); b.st[0] = nloc; b.st[1] = nx; }
        const unsigned old = xb_add(&bar[XB_XSUB(b.x)], 1u);
        const unsigned gen = old / nloc;
        if (old + 1u == (gen + 1u) * nloc) {
            __builtin_amdgcn_fence(__ATOMIC_RELEASE, "agent");
            asm volatile("s_waitcnt vmcnt(0)" ::: "memory");
            const unsigned og = xb_add(&bar[XB_TOP], 1u);
            const unsigned tg = og / nx;
            if (og + 1u == (tg + 1u) * nx) xb_add(&bar[XB_TOPGEN], 1u);
            else XB_SPIN(xb_ld(&bar[XB_TOPGEN]) == tg, bar);
            __builtin_amdgcn_fence(__ATOMIC_ACQUIRE, "agent");
            xb_add(&bar[XB_XGEN(b.x)], 1u);
            asm volatile("s_waitcnt vmcnt(0)" ::: "memory");
        } else {
            XB_SPIN(xb_ld(&bar[XB_XGEN(b.x)]) == gen, bar);
            __builtin_amdgcn_fence(__ATOMIC_ACQUIRE, "agent");
            asm volatile("s_waitcnt vmcnt(0)" ::: "memory");
        }
    }
    __syncthreads();
}


constexpr int MP = 16384, MS = 128, MT = MP + MS, MR = 16640;
constexpr int D = 1024, DFF = 2816, NWAVES = 8;
constexpr float RMS_EPS = 1e-6f, LN_EPS = 1e-5f;
constexpr float MLA_SCALE = 0.07216878364870322f;
constexpr size_t MiB = 1u << 20;
constexpr size_t WS_CTL = 0, CTL_BYTES = 3 * MiB;
constexpr int CW_BAR = 4096;
constexpr size_t ST_OFF = 65536, ST_STRIDE = (size_t)MR * 8;
constexpr int ST_SSQ0 = 0  , ST_LNS0 = 9, ST_LNQ0 = 10  , ST_KV = 13, ST_Q = 14, NSTAT = 15;
static_assert(ST_OFF + NSTAT * ST_STRIDE <= CTL_BYTES, "stats inside CTL");
constexpr size_t WS_WGU = 3 * MiB, WGU_BYTES = 11 * MiB, WS_WD = 47 * MiB, WD_BYTES = 5767168, WS_WIN = 69 * MiB, WS_WOUT = 77 * MiB, WS_WS = 81 * MiB,
                 WS_WDQKV = 82 * MiB, WS_WQ = 84 * MiB, WS_WOV = 86 * MiB, WS_WGX = 90 * MiB, WS_WAT = 95 * MiB, WS_WIT = 95 * MiB + 512 * 1024, WS_WCO = 96 * MiB, WS_ROPE = 99 * MiB;
constexpr size_t WS_H = 100 * MiB, WS_HB = 165 * MiB, WS_U = 198 * MiB, WS_GV = 231 * MiB, WS_UM = 264 * MiB, WS_ACT = 297 * MiB, WS_RAW = 387 * MiB, WS_CQB = 436 * MiB,
                 WS_QF = 449 * MiB, WS_KVB = 531 * MiB, WS_OB = 542 * MiB, WS_PART = 607 * MiB, WS_PML = 623 * MiB, WS_GATE = 624 * MiB, WS_XW = 665 * MiB, WS_AA = 747 * MiB, WS_BB = 829 * MiB,
                 WS_AGG = 911 * MiB, WS_GH = 914 * MiB, WS_PROF = 955 * MiB, WS_MK_END = 956 * MiB;
constexpr int RING_BYTES = 131072, LDS_BYTES = 147456, MISC_OFF = LDS_BYTES - 256;
constexpr size_t O_YP = 0, O_YS = 16777216, O_CV = 16908288, O_MP = 17170432, O_MS = 22413312, O_HP = 22454272, O_HS = 22464512, O_CP = 22505472, O_CS = 22536192, O_END = 22659072;

__device__ __forceinline__ float fast_sigmoid_l2(float t) { return __builtin_amdgcn_rcpf(1.0f + __builtin_amdgcn_exp2f(-t)); }
__device__ __forceinline__ float gelu_tanh_f(float x) { return x * fast_sigmoid_l2(2.302208198f * (x + 0.044715f * x * x * x)); }
__device__ __forceinline__ float silu_f(float x) { return x * fast_sigmoid_l2(1.4426950409f * x); }
__device__ __forceinline__ unsigned f2bf(float f) { unsigned u = __builtin_bit_cast(unsigned, f); return (u + 0x7fffu + ((u >> 16) & 1u)) >> 16; }
__device__ __forceinline__ unsigned pk2(float lo, float hi) { return f2bf(lo) | (f2bf(hi) << 16); }
__device__ __forceinline__ float bf2f(unsigned short b) { return __builtin_bit_cast(float, (unsigned)b << 16); }
__device__ __forceinline__ float bflo(unsigned w) { return __builtin_bit_cast(float, w << 16); }
__device__ __forceinline__ float bfhi(unsigned w) { return __builtin_bit_cast(float, w & 0xffff0000u); }
constexpr float ST_SCALE = 16777216.0f, ST_INV = 1.0f / 16777216.0f;
__device__ __forceinline__ void stat_add(long long* p, float v) { atomicAdd((unsigned long long*)p, (unsigned long long)(long long)__float2ll_rn(v * ST_SCALE)); }
__device__ __forceinline__ void stat_set(long long* p, float v) { *p = (long long)__float2ll_rn(v * ST_SCALE); }
__device__ __forceinline__ float stat_get(const long long* p) { return (float)(*p) * ST_INV; }
#define LDS_WAIT() asm volatile("s_waitcnt lgkmcnt(0)" ::: "memory")
#define VM_WAIT() asm volatile("s_waitcnt vmcnt(0)" ::: "memory")

struct InTab { const float* const __attribute__((address_space(4)))* t; __device__ __forceinline__ const float* operator[](int i) const { return t[i]; } };
struct P {
    InTab in; float* out; unsigned char* ws;
    LAS unsigned char* lds; int tid, lane, wave, G, bid;
    __device__ __forceinline__ long long* stat(int a) const { return (long long*)(ws + ST_OFF + (size_t)a * ST_STRIDE); }
    template <class T> __device__ __forceinline__ T* w(size_t off) const { return (T*)(ws + off); }
};
}
namespace mk {
struct TrJob { const float* src; int ldsrc, K, N; bf16* dst; int lddst; const float* gain; int kind, off; };
__device__ __forceinline__ int tr_rowmap(int kind, int off, int n) { return kind == 1 ? ((n >> 7) * 256 + (n & 127) + off) : (off + n); }
__device__ __forceinline__ void tr_item(const TrJob& j, LAS float* scr, int item, int lane) {
    const int nblk = j.N / 32, kb = item / nblk, nb = item % nblk, k0 = 64 * kb, n0 = 32 * nb;
    const float* src = j.src + (size_t)(k0 + (lane >> 5)) * j.ldsrc + n0 + (lane & 31); const size_t rstep = (size_t)2 * j.ldsrc;
    float v[32];
#pragma unroll
    for (int i = 0; i < 32; ++i) v[i] = src[i * rstep];
    if (j.gain) { const float* gp = j.gain + k0 + (lane >> 5); float g[32];
#pragma unroll
        for (int i = 0; i < 32; ++i) g[i] = gp[2 * i];
#pragma unroll
        for (int i = 0; i < 32; ++i) v[i] *= g[i]; }
#pragma unroll
    for (int i = 0; i < 32; ++i) scr[(2 * i + (lane >> 5)) * 33 + (lane & 31)] = v[i];
    LDS_WAIT(); asm volatile("" ::: "memory");
    const int c = lane & 7;
#pragma unroll
    for (int jj = 0; jj < 4; ++jj) { const int n = (lane >> 3) + 8 * jj; const LAS float* s = scr + (8 * c) * 33 + n;
        u32x4 o; o.x = pk2(s[0], s[33]); o.y = pk2(s[66], s[99]); o.z = pk2(s[132], s[165]); o.w = pk2(s[198], s[231]);
        *(u32x4*)(j.dst + (size_t)tr_rowmap(j.kind, j.off, n0 + n) * j.lddst + k0 + 8 * c) = o; }
    LDS_WAIT(); asm volatile("" ::: "memory");
}
constexpr int NJOBS = 24;
__device__ __forceinline__ TrJob get_job(const P& p, int jid) {
    TrJob j; j.gain = nullptr; j.kind = 0; j.off = 0; j.src = nullptr; j.dst = nullptr; j.ldsrc = 0; j.K = 0; j.N = 0; j.lddst = 0;
    if (jid < 12) { const int l = jid / 3, t = jid % 3;
        if (t < 2) { j.src = p.in[33 + t] + (size_t)l * D * DFF; j.ldsrc = DFF; j.K = D; j.N = DFF; j.dst = p.w<bf16>(WS_WGU + l * WGU_BYTES); j.lddst = D; j.gain = p.in[7] + l * D; j.kind = 1; j.off = 128 * t; }
        else { j.src = p.in[35] + (size_t)l * DFF * D; j.ldsrc = D; j.K = DFF; j.N = D; j.dst = p.w<bf16>(WS_WD + l * WD_BYTES); j.lddst = DFF; }
    } else if (jid < 16) { const int a = (jid - 12) >> 1;
        if (((jid - 12) & 1) == 0) { j.src = p.in[9] + (size_t)a * D * 2048; j.ldsrc = 2048; j.K = D; j.N = 2048; j.dst = p.w<bf16>(WS_WIN + a * 4 * MiB); j.lddst = D; j.gain = p.in[6] + (3 * a) * D; }
        else { j.src = p.in[14] + (size_t)a * D * D; j.ldsrc = D; j.K = D; j.N = D; j.dst = p.w<bf16>(WS_WOUT + a * 2 * MiB); j.lddst = D; }
    } else if (jid == 16) { j.src = p.in[15]; j.ldsrc = 384; j.K = D; j.N = 384; j.dst = p.w<bf16>(WS_WDQKV); j.lddst = D; j.gain = p.in[6] + D; j.off = 256; }
    else if (jid == 17) { j.src = p.in[18]; j.ldsrc = 320; j.K = D; j.N = 256; j.dst = p.w<bf16>(WS_WDQKV); j.lddst = D; j.gain = p.in[6] + D; j.off = 0; }
    else if (jid == 18) { j.src = p.in[18] + 256; j.ldsrc = 320; j.K = D; j.N = 64; j.dst = p.w<bf16>(WS_WDQKV); j.lddst = D; j.gain = p.in[6] + D; j.off = 640; }
    else if (jid == 19) { j.src = p.in[24]; j.ldsrc = 1280; j.K = D; j.N = 1280; j.dst = p.w<bf16>(WS_WGX); j.lddst = D; j.gain = p.in[6] + 2 * D; j.off = 0; }
    else if (jid == 20) { j.src = p.in[23]; j.ldsrc = 1280; j.K = D; j.N = 1280; j.dst = p.w<bf16>(WS_WGX); j.lddst = D; j.gain = p.in[6] + 2 * D; j.off = 1280; }
    else if (jid == 21) { j.src = p.in[32]; j.ldsrc = D; j.K = 1280; j.N = D; j.dst = p.w<bf16>(WS_WCO); j.lddst = 1280; }
    else if (jid == 22) { j.src = p.in[27]; j.ldsrc = 128; j.K = 128; j.N = 128; j.dst = p.w<bf16>(WS_WAT); j.lddst = 128; j.kind = 2; }
    else { j.src = p.in[29]; j.ldsrc = 128; j.K = 128; j.N = 128; j.dst = p.w<bf16>(WS_WIT); j.lddst = 128; j.kind = 2; }
    return j;
}
__device__ __forceinline__ int job_items(const TrJob& j) { return j.kind == 2 ? 80 : (j.K / 64) * (j.N / 32); }

__device__ __forceinline__ void p0_prologue(const P& p, const int mask) {
    LAS float* scr = (LAS float*)(p.lds + p.wave * 16384);
    const int gw = p.bid * NWAVES + p.wave, NGW = p.G * NWAVES, lane = p.lane;
    const int gt = p.bid * (NWAVES * 64) + p.tid, NGT = p.G * NWAVES * 64;
    if (mask & 1) {
    {
        int base = 0;
        for (int jid = 0; jid < NJOBS; ++jid) {
            TrJob j = get_job(p, jid); const int nit = job_items(j);
            int first = (gw - base % NGW + NGW) % NGW;
            for (int it = first; it < nit; it += NGW) {
                if (j.kind == 2) { TrJob b = j; const int blk = it >> 3; b.src = j.src + (size_t)blk * 16384; b.dst = j.dst + (size_t)blk * 16384; b.kind = 0; tr_item(b, scr, it & 7, lane); }
                else tr_item(j, scr, it, lane);
            }
            base += nit;
        }
    }
    }
    if (mask & 2) {
    { u32x4* z = (u32x4*)(p.w<bf16>(WS_WDQKV) + (size_t)704 * D); for (int i = gt; i < 64 * D / 8; i += NGT) z[i] = (u32x4){0u, 0u, 0u, 0u}; }
    }
    if (mask & 4) {
    for (int i = gt; i < 2 * 8 * 128 * 16; i += NGT) {
        const int s0 = (i & 15) * 8, t = (i >> 4) & 127, jg = i >> 11; const float* src = p.in[12] + (size_t)jg * 16384 + t * 128 + s0;
        const f32x4 v0 = *(const f32x4*)src, v1 = *(const f32x4*)(src + 4); unsigned w[4];
#pragma unroll
        for (int e = 0; e < 2; ++e) { w[e] = pk2((s0 + 2 * e <= t) ? v0[2 * e] : 0.f, (s0 + 2 * e + 1 <= t) ? v0[2 * e + 1] : 0.f); w[2 + e] = pk2((s0 + 4 + 2 * e <= t) ? v1[2 * e] : 0.f, (s0 + 5 + 2 * e <= t) ? v1[2 * e + 1] : 0.f); }
        const int j = jg >> 3, g = jg & 7;
        *(u32x4*)(p.w<bf16>(WS_WS + (size_t)j * 262144) + ((size_t)g * 128 + t) * 128 + s0) = (u32x4){w[0], w[1], w[2], w[3]};
    }
    }
    if (mask & 8) {
    for (int i = gt; i < 2052 * 32; i += NGT) { const int tp = i >> 5, fi = i & 31, pos = tp < 2048 ? tp : 16384 + (tp - 2048);
        const float inv = 1.0f / powf(10000.0f, (float)(2 * fi) / 64.0f); const float ang = (float)pos * inv;
        p.w<f32x2>(WS_ROPE)[i] = (f32x2){cosf(ang), sinf(ang)}; }
    }
    if (mask & 16) {
    { bf16* HB = p.w<bf16>(WS_HB); long long* ssq = p.stat(ST_SSQ0);
      auto rowp = [&](int m) -> const float* { return m < MP ? p.in[0] + (size_t)m * D : p.in[1] + (size_t)((m < MT ? m : MT - 1) - MP) * D; };
      f32x4 v[4], vn[4];
      if (gw < MR) { const float* r = rowp(gw);
#pragma unroll
        for (int jj = 0; jj < 4; ++jj) v[jj] = *(const f32x4*)(r + 4 * lane + 256 * jj); }
      for (int m = gw; m < MR; m += NGW) {
        { const float* r = rowp(m + NGW < MR ? m + NGW : m);
#pragma unroll
          for (int jj = 0; jj < 4; ++jj) vn[jj] = *(const f32x4*)(r + 4 * lane + 256 * jj); }
        float s = 0.f;
#pragma unroll
        for (int jj = 0; jj < 4; ++jj) { if (m >= MT) v[jj] = (f32x4){0.f, 0.f, 0.f, 0.f};
            s += (v[jj].x * v[jj].x + v[jj].y * v[jj].y) + (v[jj].z * v[jj].z + v[jj].w * v[jj].w); }
#pragma unroll
        for (int o = 1; o < 64; o <<= 1) s += __shfl_xor(s, o);
#pragma unroll
        for (int jj = 0; jj < 4; ++jj) { const int c = 4 * lane + 256 * jj;
            *(u32x2*)(HB + (size_t)m * D + c) = (u32x2){pk2(v[jj].x, v[jj].y), pk2(v[jj].z, v[jj].w)}; }
        if (lane == 0) stat_set(ssq + m, s);
#pragma unroll
        for (int jj = 0; jj < 4; ++jj) v[jj] = vn[jj];
      } }
    }
    if (mask & 32) {
    { const float* wuq = p.in[17]; const float* wuk = p.in[20]; const float* qn = p.in[16]; bf16* Wq = p.w<bf16>(WS_WQ);
      LAS float* Qs = (LAS float*)p.lds; LAS float* Ks = (LAS float*)(p.lds + 64 * 132 * 4);
      for (int it = p.bid; it < 192; it += p.G) {
        const int h = it / 24, kb = (it >> 2) % 6, cq = it & 3, k0 = 64 * kb;
        __syncthreads();
#pragma unroll
        for (int q = 0; q < 4; ++q) { const int idx = p.tid + 512 * q, row = idx >> 5, c4 = idx & 31;
            *(LAS f32x4*)(Qs + row * 132 + c4 * 4) = *(const f32x4*)(wuq + (size_t)(k0 + row) * 1536 + h * 192 + c4 * 4);
            *(LAS f32x4*)(Ks + row * 132 + c4 * 4) = *(const f32x4*)(wuk + (size_t)(cq * 64 + row) * 1024 + h * 128 + c4 * 4); }
        __syncthreads();
        const int cl = p.wave * 8, c0 = cq * 64 + cl; float acc[8];
#pragma unroll
        for (int cc = 0; cc < 8; ++cc) acc[cc] = 0.f;
#pragma unroll 4
        for (int n4 = 0; n4 < 32; ++n4) { const f32x4 bv = *(const LAS f32x4*)(Qs + lane * 132 + n4 * 4);
#pragma unroll
            for (int cc = 0; cc < 8; ++cc) { const f32x4 av = *(const LAS f32x4*)(Ks + (cl + cc) * 132 + n4 * 4); acc[cc] += (av.x * bv.x + av.y * bv.y) + (av.z * bv.z + av.w * bv.w); } }
        const float g = qn[k0 + lane];
#pragma unroll
        for (int cc = 0; cc < 8; ++cc) Wq[(size_t)(320 * h + c0 + cc) * 384 + k0 + lane] = (bf16)f2bf(acc[cc] * g);
      }
      for (int r = gw; r < 512; r += NGW) { const int h = r >> 6, ie = r & 63, i = ie >> 1, e = ie & 1;
#pragma unroll
        for (int kk = 0; kk < 6; ++kk) { const int k = lane + 64 * kk; Wq[(size_t)(320 * h + 256 + ie) * 384 + k] = (bf16)f2bf(wuq[(size_t)k * 1536 + h * 192 + 128 + 32 * e + i] * qn[k]); } } }
    }
    if (mask & 64) {
    { const float* wuv = p.in[21]; const float* wo = p.in[22]; bf16* Wov = p.w<bf16>(WS_WOV);
      LAS float* Os = (LAS float*)p.lds;
      for (int it = p.bid; it < 256; it += p.G) { const int h = it >> 5, cg = (it >> 2) & 7, nb = it & 3, c0 = cg * 32 + p.wave * 4, n = nb * 256 + lane * 4;
        __syncthreads();
#pragma unroll
        for (int q = 0; q < 16; ++q) { const int idx = p.tid + 512 * q, v = idx >> 6, c4 = idx & 63; *(LAS f32x4*)(Os + v * 256 + c4 * 4) = *(const f32x4*)(wo + (size_t)(h * 128 + v) * D + nb * 256 + c4 * 4); }
        __syncthreads();
        f32x4 acc[4];
#pragma unroll
        for (int cc = 0; cc < 4; ++cc) acc[cc] = (f32x4){0.f, 0.f, 0.f, 0.f};
#pragma unroll 8
        for (int v = 0; v < 128; ++v) { const f32x4 b = *(const LAS f32x4*)(Os + v * 256 + lane * 4);
#pragma unroll
            for (int cc = 0; cc < 4; ++cc) { const float a = wuv[(size_t)(c0 + cc) * 1024 + h * 128 + v]; acc[cc] += b * a; } }
#pragma unroll
        for (int jn = 0; jn < 4; ++jn) *(u32x2*)(Wov + (size_t)(n + jn) * 2048 + h * 256 + c0) = (u32x2){pk2(acc[0][jn], acc[1][jn]), pk2(acc[2][jn], acc[3][jn])};
      }
      __syncthreads(); }
    }
}
}
namespace mk {
#ifdef MK_DRYPROBE
#define MK_DRY(E) ((E).dry)
#define MK_DRYFIELD int dry;
#else
#define MK_DRY(E) 0
#define MK_DRYFIELD
#endif
typedef const f32x4 (&AccRef)[2][2][4][2];
__device__ __forceinline__ float quad_red(float v) { v += __shfl_xor(v, 16); v += __shfl_xor(v, 32); return v; }
__device__ __forceinline__ u32x4 pack8(const f32x4 a, const f32x4 b) { u32x4 w; w.x = cvt_pk_bf16(a[0], a[1]); w.y = cvt_pk_bf16(a[2], a[3]); w.z = cvt_pk_bf16(b[0], b[1]); w.w = cvt_pk_bf16(b[2], b[3]); return w; }
__device__ __forceinline__ float sumsq8(const f32x4 a, const f32x4 b) { return ((a[0] * a[0] + a[1] * a[1]) + (a[2] * a[2] + a[3] * a[3])) + ((b[0] * b[0] + b[1] * b[1]) + (b[2] * b[2] + b[3] * b[3])); }
__device__ __forceinline__ float sum8(const f32x4 a, const f32x4 b) { return ((a[0] + a[1]) + (a[2] + a[3])) + ((b[0] + b[1]) + (b[2] + b[3])); }
#define MK_EPI_CALL() \
    __device__ __forceinline__ void operator()(AccRef acc, const pg8::Unit& u, int wr, int wc, int fr, int fq) const { \
        Pre pre_[2][4]; \
        _Pragma("unroll") for (int ai = 0; ai < 2; ++ai) _Pragma("unroll") for (int m = 0; m < 4; ++m) pre_[ai][m] = pre(u.pm * 256 + ai * 128 + wr * 64 + m * 16 + fr, u.pn, wc, fq); \
        _Pragma("unroll") for (int ai = 0; ai < 2; ++ai) _Pragma("unroll") for (int m = 0; m < 4; ++m) \
            rgp(u.pm * 256 + ai * 128 + wr * 64 + m * 16 + fr, u.pn, wc, fq, acc[ai][0][m][0], acc[ai][0][m][1], acc[ai][1][m][0], acc[ai][1][m][1], pre_[ai][m]); } \
    __device__ __forceinline__ void rgq(int r, int pn, int wc, int fq, f32x4 a0, f32x4 b0, f32x4 a1, f32x4 b1, const Pre pv) const { rgp(r, pn, wc, fq, a0, b0, a1, b1, pv); }
#define MK_EPI_CALL_DENSE() \
    __device__ __forceinline__ void operator()(AccRef acc, const pg8::Unit& u, int wr, int wc, int fr, int fq) const { \
        Pre pre_[2][4]; \
        _Pragma("unroll") for (int ai = 0; ai < 2; ++ai) _Pragma("unroll") for (int m = 0; m < 4; ++m) pre_[ai][m] = pre(u.pm * 256 + ai * 128 + wr * 64 + m * 16 + fr, u.pn, wc, fq); \
        _Pragma("unroll") for (int ai = 0; ai < 2; ++ai) { float s1 = 0.f, s2 = 0.f; \
            _Pragma("unroll") for (int m = 0; m < 4; ++m) { float t1, t2; \
                rgs(u.pm * 256 + ai * 128 + wr * 64 + m * 16 + fr, u.pn, wc, fq, acc[ai][0][m][0], acc[ai][0][m][1], acc[ai][1][m][0], acc[ai][1][m][1], pre_[ai][m], t1, t2); \
                s1 = (fq == m) ? t1 : s1; s2 = (fq == m) ? t2 : s2; } \
            stats(u.pm * 256 + ai * 128 + wr * 64 + fq * 16 + fr, u.pn, s1, s2); } } \
    __device__ __forceinline__ void rgq(int r, int pn, int wc, int fq, f32x4 a0, f32x4 b0, f32x4 a1, f32x4 b1, const Pre pv) const { float t1, t2; rgs(r, pn, wc, fq, a0, b0, a1, b1, pv, t1, t2); if (fq == 0) stats(r, pn, t1, t2); }
#define MK_INIT_ZERO() __device__ __forceinline__ void init(f32x4 (&acc)[2][2][4][2], const pg8::Unit&, int, int, int, int) const { \
        _Pragma("unroll") for (int a = 0; a < 2; ++a) _Pragma("unroll") for (int b = 0; b < 2; ++b) _Pragma("unroll") for (int m = 0; m < 4; ++m) _Pragma("unroll") for (int n = 0; n < 2; ++n) acc[a][b][m][n] = (f32x4){0.f, 0.f, 0.f, 0.f}; }
#define MK_PRE_STAT(PTR) MK_INIT_ZERO() typedef long long Pre; __device__ __forceinline__ Pre pre(int r, int, int, int) const { return (PTR)[r]; }
__device__ __forceinline__ float stat_f(long long v) { const int hi = (int)(v >> 32); const unsigned lo = (unsigned)v; return __builtin_fmaf((float)hi, 4294967296.0f * ST_INV, (float)lo * ST_INV); }
__device__ __forceinline__ float rsq_f(float x) { return __builtin_amdgcn_rsqf(x); }

struct EpiA1 {
    static constexpr bool PERM = true, AFTER_DRAIN = false;
    bf16* U; bf16* GV; const long long* ssq; long long* lns; long long* lnq; MK_DRYFIELD
    MK_PRE_STAT(ssq)
    __device__ __forceinline__ void rgs(int r, int pn, int wc, int fq, f32x4 a0, f32x4 b0, f32x4 a1, f32x4 b1, const Pre pv, float& s1, float& s2) const {
        const bool isv = pn >= 4; bf16* dst = (isv ? GV : U) + (size_t)r * 1024 + (pn & 3) * 256 + wc * 32 + 8 * fq; const float rs = rsq_f(stat_f(pv) * (1.0f / 1024.0f) + RMS_EPS);
        a0 *= rs; b0 *= rs; a1 *= rs; b1 *= rs;
#pragma unroll
        for (int e = 0; e < 4; ++e) { a0[e] = gelu_tanh_f(a0[e]); b0[e] = gelu_tanh_f(b0[e]); a1[e] = gelu_tanh_f(a1[e]); b1[e] = gelu_tanh_f(b1[e]); }
        *(u32x4*)dst = pack8(a0, b0); *(u32x4*)(dst + 128) = pack8(a1, b1);
        s1 = 0.f; s2 = 0.f;
        if (isv) { s1 = quad_red(sum8(a0, b0) + sum8(a1, b1)); s2 = quad_red(sumsq8(a0, b0) + sumsq8(a1, b1)); }
    }
    __device__ __forceinline__ void stats(int r, int pn, float s1, float s2) const { if (pn >= 4 && !MK_DRY(*this)) { stat_add(lns + r, s1); stat_add(lnq + r, s2); } }
    MK_EPI_CALL_DENSE()
};
struct EpiRes {
    static constexpr bool PERM = true, AFTER_DRAIN = false;
    bf16* HB; long long* ssq_out; MK_DRYFIELD
    struct Pre { u32x4 h0, h1; };
    static __device__ __forceinline__ f32x4 lo4(const u32x4 h) { return (f32x4){bflo(h.x), bfhi(h.x), bflo(h.y), bfhi(h.y)}; }
    static __device__ __forceinline__ f32x4 hi4(const u32x4 h) { return (f32x4){bflo(h.z), bfhi(h.z), bflo(h.w), bfhi(h.w)}; }
    __device__ __forceinline__ Pre pre(int r, int pn, int wc, int fq) const { const bf16* hp = HB + (size_t)r * 1024 + pn * 256 + wc * 32 + 8 * fq; Pre v; v.h0 = *(const u32x4*)hp; v.h1 = *(const u32x4*)(hp + 128); return v; }
    __device__ __forceinline__ void init(f32x4 (&acc)[2][2][4][2], const pg8::Unit& u, int wr, int wc, int fr, int fq) const {
        Pre v[2][4];
#pragma unroll
        for (int ai = 0; ai < 2; ++ai)
#pragma unroll
            for (int m = 0; m < 4; ++m) v[ai][m] = pre(u.pm * 256 + ai * 128 + wr * 64 + m * 16 + fr, u.pn, wc, fq);
#pragma unroll
        for (int ai = 0; ai < 2; ++ai)
#pragma unroll
            for (int m = 0; m < 4; ++m) { acc[ai][0][m][0] = lo4(v[ai][m].h0); acc[ai][0][m][1] = hi4(v[ai][m].h0); acc[ai][1][m][0] = lo4(v[ai][m].h1); acc[ai][1][m][1] = hi4(v[ai][m].h1); }
    }
    __device__ __forceinline__ void fin(int r, int pn, int wc, int fq, const f32x4 a0, const f32x4 b0, const f32x4 a1, const f32x4 b1, float& s1) const {
        bf16* hp = HB + (size_t)r * 1024 + pn * 256 + wc * 32 + 8 * fq;
        s1 = quad_red(sumsq8(a0, b0) + sumsq8(a1, b1));
        if (MK_DRY(*this)) { if (s1 == 12345.678f) *(u32x4*)hp = pack8(a0, b0); return; }
        *(u32x4*)hp = pack8(a0, b0); *(u32x4*)(hp + 128) = pack8(a1, b1);
    }
    __device__ __forceinline__ void stats(int r, int pn, float s1, float s2) const { if (!MK_DRY(*this)) stat_add(ssq_out + r, s1); }
    __device__ __forceinline__ void operator()(AccRef acc, const pg8::Unit& u, int wr, int wc, int fr, int fq) const {
#pragma unroll
        for (int ai = 0; ai < 2; ++ai) { float s1 = 0.f;
#pragma unroll
            for (int m = 0; m < 4; ++m) { float t1; fin(u.pm * 256 + ai * 128 + wr * 64 + m * 16 + fr, u.pn, wc, fq, acc[ai][0][m][0], acc[ai][0][m][1], acc[ai][1][m][0], acc[ai][1][m][1], t1); s1 = (fq == m) ? t1 : s1; }
            stats(u.pm * 256 + ai * 128 + wr * 64 + fq * 16 + fr, u.pn, s1, 0.f); } }
    __device__ __forceinline__ void rgq(int r, int pn, int wc, int fq, f32x4 a0, f32x4 b0, f32x4 a1, f32x4 b1, const Pre v) const { float t1;
        fin(r, pn, wc, fq, a0 + lo4(v.h0), b0 + hi4(v.h0), a1 + lo4(v.h1), b1 + hi4(v.h1), t1); if (fq == 0) stats(r, pn, t1, 0.f); }
};
struct EpiF1 {
    static constexpr bool PERM = true, AFTER_DRAIN = false;
    bf16* ACT; const long long* ssq;
    MK_PRE_STAT(ssq)
    __device__ __forceinline__ void rgp(int r, int pn, int wc, int fq, f32x4 a0, f32x4 b0, f32x4 a1, f32x4 b1, const Pre pv) const {
        const float rs = rsq_f(stat_f(pv) * (1.0f / 1024.0f) + RMS_EPS), kx = -1.4426950409f * rs, r2 = rs * rs; f32x4 a, b;
#pragma unroll
        for (int e = 0; e < 4; ++e) { a[e] = a0[e] * __builtin_amdgcn_rcpf(1.0f + __builtin_amdgcn_exp2f(a0[e] * kx)) * (a1[e] * r2); b[e] = b0[e] * __builtin_amdgcn_rcpf(1.0f + __builtin_amdgcn_exp2f(b0[e] * kx)) * (b1[e] * r2); }
        *(u32x4*)(ACT + (size_t)r * DFF + pn * 128 + wc * 32 + 8 * fq) = pack8(a, b);
    }
    MK_EPI_CALL()
};
struct EpiB1 {
    static constexpr bool PERM = true, AFTER_DRAIN = false;
    float* RAW; bf16* CQB; const long long* ssq; long long* ssq_kv; long long* ssq_q; MK_DRYFIELD
    __device__ __forceinline__ void half(int r, int c, f32x4 a, f32x4 b, float& qkv, float& qq) const {
        if (c < 256) { *(f32x4*)(RAW + (size_t)r * 768 + c) = a; *(f32x4*)(RAW + (size_t)r * 768 + c + 4) = b; qkv += sumsq8(a, b); }
        else if (c < 640) { *(u32x4*)(CQB + (size_t)r * 384 + (c - 256)) = pack8(a, b); qq += sumsq8(a, b); }
        else if (c < 704) { *(f32x4*)(RAW + (size_t)r * 768 + c) = a; *(f32x4*)(RAW + (size_t)r * 768 + c + 4) = b; } }
    MK_PRE_STAT(ssq)
    __device__ __forceinline__ void rgs(int r, int pn, int wc, int fq, f32x4 a0, f32x4 b0, f32x4 a1, f32x4 b1, const Pre pv, float& s1, float& s2) const {
        const float rs = rsq_f(stat_f(pv) * (1.0f / 1024.0f) + RMS_EPS); const int c = pn * 256 + wc * 32 + 8 * fq; float qkv = 0.f, qq = 0.f;
        half(r, c, a0 * rs, b0 * rs, qkv, qq); half(r, c + 128, a1 * rs, b1 * rs, qkv, qq);
        s1 = quad_red(qkv); s2 = quad_red(qq);
    }
    __device__ __forceinline__ void stats(int r, int pn, float s1, float s2) const { if (!MK_DRY(*this)) { if (pn == 0) stat_add(ssq_kv + r, s1); else stat_add(ssq_q + r, s2); } }
    MK_EPI_CALL_DENSE()
};
struct EpiB2 {
    static constexpr bool PERM = true, AFTER_DRAIN = false;
    bf16* QF; const long long* ssq_q; const f32x2* rope;
    __device__ __forceinline__ void half(int r, int c, int tp, const f32x4 a, const f32x4 b) const {
        const int h = c / 320, w = c - h * 320;
        if (w < 256) *(u32x4*)(QF + (size_t)r * 2560 + c) = pack8(a, b);
        else { const int i0 = (w - 256) >> 1;
            const f32x4 cs01 = *(const f32x4*)(rope + (size_t)tp * 32 + i0), cs23 = *(const f32x4*)(rope + (size_t)tp * 32 + i0 + 2);
            bf16* qh = QF + (size_t)r * 2560 + h * 320 + 256;
            *(u32x2*)(qh + i0) = (u32x2){cvt_pk_bf16(a[0] * cs01[0] - a[1] * cs01[1], a[2] * cs01[2] - a[3] * cs01[3]), cvt_pk_bf16(b[0] * cs23[0] - b[1] * cs23[1], b[2] * cs23[2] - b[3] * cs23[3])};
            *(u32x2*)(qh + 32 + i0) = (u32x2){cvt_pk_bf16(a[0] * cs01[1] + a[1] * cs01[0], a[2] * cs01[3] + a[3] * cs01[2]), cvt_pk_bf16(b[0] * cs23[1] + b[1] * cs23[0], b[2] * cs23[3] + b[3] * cs23[2])}; } }
    MK_PRE_STAT(ssq_q)
    __device__ __forceinline__ void rgp(int r, int pn, int wc, int fq, f32x4 a0, f32x4 b0, f32x4 a1, f32x4 b1, const Pre pv) const {
        const float rs = rsq_f(stat_f(pv) * (1.0f / 384.0f) + RMS_EPS) * (MLA_SCALE * 1.4426950408889634f)  ; const int tp = r < MP ? (r & 2047) : 2048 + ((r - MP) & 3), c = pn * 256 + wc * 32 + 8 * fq;
        half(r, c, tp, a0 * rs, b0 * rs); half(r, c + 128, tp, a1 * rs, b1 * rs);
    }
    MK_EPI_CALL()
};
struct EpiC1 {
    static constexpr bool PERM = true, AFTER_DRAIN = false;
    bf16* GATE; bf16* XW; const long long* ssq;
    MK_PRE_STAT(ssq)
    __device__ __forceinline__ void rgp(int r, int pn, int wc, int fq, f32x4 a0, f32x4 b0, f32x4 a1, f32x4 b1, const Pre pv) const {
        const bool isx = pn >= 5; const int c = (isx ? pn - 5 : pn) * 256 + wc * 32 + 8 * fq; const float rs = rsq_f(stat_f(pv) * (1.0f / 1024.0f) + RMS_EPS);
        a0 *= rs; b0 *= rs; a1 *= rs; b1 *= rs;
        if (isx) { bf16* x = XW + (size_t)r * 1280 + c; *(u32x4*)x = pack8(a0, b0); *(u32x4*)(x + 128) = pack8(a1, b1); }
        else {
#pragma unroll
            for (int e = 0; e < 4; ++e) { a0[e] = gelu_tanh_f(a0[e]); b0[e] = gelu_tanh_f(b0[e]); a1[e] = gelu_tanh_f(a1[e]); b1[e] = gelu_tanh_f(b1[e]); }
            bf16* g = GATE + (size_t)r * 1280 + c; *(u32x4*)g = pack8(a0, b0); *(u32x4*)(g + 128) = pack8(a1, b1); }
    }
    MK_EPI_CALL()
};

template <class Epi>
__device__ __forceinline__ void mini_gemm(const P& p, const bf16* A, int lda, const bf16* Bt, int ldb, int K, int N, const Epi& E, int first_wg) {
    constexpr int BP = 272, SLOT = 64 * BP;
    const int tid = p.tid, lane = p.lane, w = p.wave, kq = w & 3, rgp = w >> 2, l15 = lane & 15, g4 = lane >> 4, nmu = (N >> 8) * 16, nch = K >> 7, nst = (nch + 3) >> 2;
    const int t128 = (rgp << 6) | lane;
    const int nshare = first_wg ? p.G - first_wg : p.G, myi = (p.bid - first_wg + p.G) % p.G;
    for (int mu = myi < nshare ? myi : nmu; mu < nmu; mu += nshare) {
        const int pn = mu >> 4, wcq = (mu >> 2) & 3, rq = mu & 3, row = MP + 32 * rq + 16 * rgp + l15;
        const bf16* arow = A + (size_t)row * lda + 8 * g4;
        const int r0 = t128 >> 4, c16 = t128 & 15;
        const bf16* bbase = Bt + (size_t)(pn * 256 + wcq * 32 + 8 * (r0 >> 2) + (r0 & 3)) * ldb + c16 * 8; const int bo0 = r0 * BP + c16 * 16;
#define MG_BSRC(q) (bbase + (size_t)(128 * ((q) >> 2) + 4 * (((q) >> 1) & 1) + 16 * ((q) & 1)) * ldb)
#define MG_BOFF(q) (bo0 + 8 * (q) * BP)
        typename Epi::Pre pv_{}; if (kq == 0) pv_ = E.pre(row, pn, wcq, g4);
        f32x4 acc[4];
#pragma unroll
        for (int t = 0; t < 4; ++t) acc[t] = (f32x4){0.f, 0.f, 0.f, 0.f};
        u32x4 b0[8], a0[4], b1[8], a1[4], b2[8], a2[4];
#define MG_LOAD(BS, AS, ST) do { const int ch_ = 4 * (ST) + kq; if (ch_ < nch) { \
            _Pragma("unroll") for (int q = 0; q < 8; ++q) BS[q] = *(const u32x4*)(MG_BSRC(q) + (size_t)ch_ * 128); \
            _Pragma("unroll") for (int s = 0; s < 4; ++s) AS[s] = *(const u32x4*)(arow + (size_t)ch_ * 128 + 32 * s); } } while (0)
#define MG_STEP(BS, AS, ST) do { LAS unsigned char* slot = p.lds + (kq * 2 + ((ST) & 1)) * SLOT; const bool ok_ = 4 * (ST) + kq < nch; \
            if (ok_) { _Pragma("unroll") for (int q = 0; q < 8; ++q) *(LAS u32x4*)(slot + MG_BOFF(q)) = BS[q]; } \
            bf16x8 af[4]; _Pragma("unroll") for (int s = 0; s < 4; ++s) af[s] = __builtin_bit_cast(bf16x8, AS[s]); \
            __syncthreads(); \
            if ((ST) + 3 < nst) MG_LOAD(BS, AS, (ST) + 3); \
            if (ok_) { _Pragma("unroll") for (int s = 0; s < 4; ++s) _Pragma("unroll") for (int t = 0; t < 4; ++t) { \
                const bf16x8 bf = *(const LAS bf16x8*)(slot + (t * 16 + l15) * BP + (32 * s + 8 * g4) * 2); \
                acc[t] = __builtin_amdgcn_mfma_f32_16x16x32_bf16(bf, af[s], acc[t], 0, 0, 0); } } } while (0)
        MG_LOAD(b0, a0, 0); if (1 < nst) MG_LOAD(b1, a1, 1); if (2 < nst) MG_LOAD(b2, a2, 2);
        __syncthreads();
        for (int st = 0; st < nst; st += 3) {
            MG_STEP(b0, a0, st);
            if (st + 1 < nst) MG_STEP(b1, a1, st + 1);
            if (st + 2 < nst) MG_STEP(b2, a2, st + 2);
        }
#undef MG_LOAD
#undef MG_STEP
#undef MG_BSRC
#undef MG_BOFF
        __syncthreads();
        LAS f32x4* red = (LAS f32x4*)p.lds;
        if (kq > 0) {
#pragma unroll
            for (int t = 0; t < 4; ++t) red[((rgp * 3 + (kq - 1)) * 4 + t) * 64 + lane] = acc[t]; }
        __syncthreads();
        if (kq == 0) {
#pragma unroll
            for (int k2 = 0; k2 < 3; ++k2)
#pragma unroll
                for (int t = 0; t < 4; ++t) acc[t] += red[((rgp * 3 + k2) * 4 + t) * 64 + lane];
            E.rgq(row, pn, wcq, g4, acc[0], acc[1], acc[2], acc[3], pv_); }
    }
}
}
namespace mk {
__device__ __forceinline__ s16x4 tr16(const LAS unsigned char* a) { return __builtin_amdgcn_ds_read_tr16_b64_v4i16((LAS s16x4*)a); }
__device__ __forceinline__ bf16x8 cat8(const s16x4 a, const s16x4 b) { return (bf16x8){a[0], a[1], a[2], a[3], b[0], b[1], b[2], b[3]}; }
__device__ __forceinline__ bf16x8 as_bf16x8(const u32x4 w) { return __builtin_bit_cast(bf16x8, w); }
#define MFMA16(A, B, C) __builtin_amdgcn_mfma_f32_16x16x32_bf16((A), (B), (C), 0, 0, 0)
template <int OFF> __device__ __forceinline__ bf16x8 dsr128(unsigned a) { bf16x8 r; asm volatile("ds_read_b128 %0, %1 offset:%2" : "=&v"(r) : "v"(a), "i"(OFF) : "memory"); return r; }
template <int OFF> __device__ __forceinline__ s16x4 dstr64(unsigned a) { s16x4 r; asm volatile("ds_read_b64_tr_b16 %0, %1 offset:%2" : "=&v"(r) : "v"(a), "i"(OFF) : "memory"); return r; }
#define LDS_WAIT_PIN() do { asm volatile("s_waitcnt lgkmcnt(0)" ::: "memory"); __builtin_amdgcn_sched_barrier(0); } while (0)
constexpr int TP = 272;
constexpr int KP = 656;
constexpr float LOG2E = 1.4426950408889634f;

__device__ __forceinline__ void a2_spatial(const P& p, int j, float* out_cv  ) {
    const bf16* U = p.w<bf16>(WS_U); const bf16* GV = p.w<bf16>(WS_GV); bf16* UM = p.w<bf16>(WS_UM);
    const long long* lns = p.stat(ST_LNS0 + 2 * j); const long long* lnq = p.stat(ST_LNQ0 + 2 * j);
    const float* ln_g = p.in[10] + j * 1024; const float* ln_b = p.in[11] + j * 1024; const float* b_s = p.in[13] + j * 1024;
    LAS unsigned char* Wt = p.lds; LAS unsigned char* Vt = p.lds + 128 * TP;
    const int tid = p.tid, lane = p.lane, w = p.wave, l15 = lane & 15, g4 = lane >> 4, q4 = (lane & 15) >> 2, pp = lane & 3;
    { const float* aws = p.in[12] + (size_t)j * 8 * 16384;
      for (int idx = p.bid * 512 + tid; idx < 128 * 1024; idx += p.G * 512) {
        const int t = idx >> 10, d = idx & 1023, g = d >> 7, i = t & 3; const size_t r = (size_t)MP + t, rb = r - i;
        const float lg = ln_g[d], lb = ln_b[d]; float mixed = b_s[g * 128 + i], vi = 0.f;
#pragma unroll
        for (int s2 = 0; s2 < 4; ++s2) { const size_t rs = rb + s2;
            const float mu = stat_get(lns + rs) * (1.0f / 1024.0f), var = stat_get(lnq + rs) * (1.0f / 1024.0f) - mu * mu;
            const float v = (bf2f(GV[rs * 1024 + d]) - mu) * rsqrtf(var + LN_EPS) * lg + lb, wv = aws[(size_t)g * 16384 + i * 128 + s2];
            mixed += (s2 <= i) ? wv * v : 0.f; vi = (s2 == i) ? v : vi; }
        if (out_cv) out_cv[(size_t)t * 1024 + d] = vi;
        UM[r * 1024 + d] = (bf16)f2bf(bf2f(U[r * 1024 + d]) * mixed); } }
    u32x4 Wr[4], raw[4]; long long sl[4], sq[4]; f32x4 g0, g1, b0, b1;
#define A2_LOAD(U_) do { const int c_ = (U_) >> 3, g_ = (U_) & 7, row0_ = c_ * 128, c16_ = tid & 15, d0_ = g_ * 128 + c16_ * 8; \
        const bf16* Wsrc_ = p.w<bf16>(WS_WS + (size_t)j * 262144) + (size_t)g_ * 16384; \
        _Pragma("unroll") for (int q = 0; q < 4; ++q) { const int ch = tid + 512 * q, row = ch >> 4, c16 = ch & 15; Wr[q] = *(const u32x4*)(Wsrc_ + row * 128 + c16 * 8); } \
        g0 = *(const f32x4*)(ln_g + d0_); g1 = *(const f32x4*)(ln_g + d0_ + 4); b0 = *(const f32x4*)(ln_b + d0_); b1 = *(const f32x4*)(ln_b + d0_ + 4); \
        _Pragma("unroll") for (int q = 0; q < 4; ++q) { const int r = row0_ + (tid >> 4) + 32 * q; raw[q] = *(const u32x4*)(GV + (size_t)r * 1024 + d0_); sl[q] = lns[r]; sq[q] = lnq[r]; } } while (0)
    if (p.bid < 128 * 8) A2_LOAD(p.bid);
    for (int u = p.bid; u < 128 * 8; u += p.G) {
        int tl_ = p.tid; asm volatile("" : "+v"(tl_)); const int tid = tl_, lane = tl_ & 63, l15 = lane & 15, g4 = lane >> 4, q4 = (lane & 15) >> 2, pp = lane & 3;
        const int c = u >> 3, g = u & 7, row0 = c * 128;
#pragma unroll
        for (int q = 0; q < 4; ++q) { const int ch = tid + 512 * q, row = ch >> 4, c16 = ch & 15; *(LAS u32x4*)(Wt + row * TP + c16 * 16) = Wr[q]; }
        { const int c16 = tid & 15;
#pragma unroll
          for (int q = 0; q < 4; ++q) { const int s = (tid >> 4) + 32 * q;
            const float mu = (float)sl[q] * ST_INV * (1.0f / 1024.0f), var = (float)sq[q] * ST_INV * (1.0f / 1024.0f) - mu * mu, rstd = rsqrtf(var + LN_EPS);
            f32x4 v0, v1;
            v0[0] = bflo(raw[q].x); v0[1] = bfhi(raw[q].x); v0[2] = bflo(raw[q].y); v0[3] = bfhi(raw[q].y); v1[0] = bflo(raw[q].z); v1[1] = bfhi(raw[q].z); v1[2] = bflo(raw[q].w); v1[3] = bfhi(raw[q].w);
            v0 = (v0 - mu) * rstd * g0 + b0; v1 = (v1 - mu) * rstd * g1 + b1;
            *(LAS u32x4*)(Vt + s * TP + c16 * 16) = pack8(v0, v1); } }
        u32x2 uu[8]; float bsv[8];
#pragma unroll
        for (int tt = 0; tt < 8; ++tt) { uu[tt] = *(const u32x2*)(U + (size_t)(row0 + 16 * tt + l15) * 1024 + g * 128 + 16 * w + 4 * g4); bsv[tt] = b_s[g * 128 + 16 * tt + l15]; }
        __syncthreads();
        { const int un = u + p.G; if (un < 128 * 8) A2_LOAD(un); }
        f32x4 acc[8];
#pragma unroll
        for (int tt = 0; tt < 8; ++tt) acc[tt] = (f32x4){0.f, 0.f, 0.f, 0.f};
#pragma unroll
        for (int kk = 0; kk < 4; ++kk) {
            const bf16x8 X = cat8(tr16(Vt + (32 * kk + 8 * g4 + q4) * TP + (16 * w + 4 * pp) * 2), tr16(Vt + (32 * kk + 8 * g4 + 4 + q4) * TP + (16 * w + 4 * pp) * 2));
#pragma unroll
            for (int tt = 0; tt < 8; ++tt) if (32 * kk <= 16 * tt + 15) {
                const bf16x8 Y = *(const LAS bf16x8*)(Wt + (16 * tt + l15) * TP + (32 * kk + 8 * g4) * 2);
                acc[tt] = MFMA16(X, Y, acc[tt]); }
        }
#pragma unroll
        for (int tt = 0; tt < 8; ++tt) { const int t = 16 * tt + l15, r = row0 + t, col = g * 128 + 16 * w + 4 * g4; const float bias = bsv[tt];
            const float o0 = bflo(uu[tt].x) * (acc[tt][0] + bias), o1 = bfhi(uu[tt].x) * (acc[tt][1] + bias), o2 = bflo(uu[tt].y) * (acc[tt][2] + bias), o3 = bfhi(uu[tt].y) * (acc[tt][3] + bias);
            *(u32x2*)(UM + (size_t)r * 1024 + col) = (u32x2){cvt_pk_bf16(o0, o1), cvt_pk_bf16(o2, o3)}; }
        __syncthreads();
    }
#undef A2_LOAD
}

__device__ __forceinline__ void b2_kvfinal(const P& p, float* out_mp, float* out_ms) {
    const float* RAW = p.w<float>(WS_RAW); bf16* KVB = p.w<bf16>(WS_KVB); const long long* ssq_kv = p.stat(ST_KV); const float* kvn = p.in[19]; const f32x2* rope = p.w<f32x2>(WS_ROPE);
    const int gw = p.bid * NWAVES + p.wave, NGW = p.G * NWAVES, lane = p.lane, l31 = lane & 31;
    const f32x4 kn = *(const f32x4*)(kvn + 4 * lane);
    auto tpos = [&](int m) { return m < MP ? (m & 2047) : 2048 + ((m - MP) & 3); };
    long long sq = 0, sqn = 0; f32x4 rv = (f32x4){0.f, 0.f, 0.f, 0.f}, rvn = rv; f32x2 cs = (f32x2){0.f, 0.f}, csn = cs; float x1 = 0.f, x2 = 0.f, x1n = 0.f, x2n = 0.f;
    if (gw < MT) { const int m = gw; sq = ssq_kv[m]; rv = *(const f32x4*)(RAW + (size_t)m * 768 + 4 * lane); cs = rope[(size_t)tpos(m) * 32 + l31]; x1 = RAW[(size_t)m * 768 + 640 + l31]; x2 = RAW[(size_t)m * 768 + 672 + l31]; }
    for (int m = gw; m < MT; m += NGW) {
        { const int mn = (m + NGW < MT) ? m + NGW : m; sqn = ssq_kv[mn]; rvn = *(const f32x4*)(RAW + (size_t)mn * 768 + 4 * lane); csn = rope[(size_t)tpos(mn) * 32 + l31]; x1n = RAW[(size_t)mn * 768 + 640 + l31]; x2n = RAW[(size_t)mn * 768 + 672 + l31]; }
        float* o = m < MP ? (out_mp ? out_mp + (size_t)m * 320 : nullptr) : (out_ms ? out_ms + (size_t)(m - MP) * 320 : nullptr);
        const float rs = rsqrtf((float)sq * ST_INV * (1.0f / 256.0f) + RMS_EPS);
        const f32x4 v = rv * rs * kn;
        if (o) *(f32x4*)(o + 4 * lane) = v;
        *(u32x2*)(KVB + (size_t)m * 320 + 4 * lane) = (u32x2){cvt_pk_bf16(v[0], v[1]), cvt_pk_bf16(v[2], v[3])};
        if (lane < 32) {
            const float o1 = x1 * cs.x - x2 * cs.y, o2 = x1 * cs.y + x2 * cs.x;
            if (o) { o[256 + lane] = o1; o[288 + lane] = o2; }
            KVB[(size_t)m * 320 + 256 + lane] = (bf16)f2bf(o1); KVB[(size_t)m * 320 + 288 + lane] = (bf16)f2bf(o2); }
        sq = sqn; rv = rvn; cs = csn; x1 = x1n; x2 = x2n;
    }
}

__device__ __forceinline__ void b3_attn_prompt(const P& p) {
    const bf16* QF = p.w<bf16>(WS_QF); const bf16* KVB = p.w<bf16>(WS_KVB); bf16* OB = p.w<bf16>(WS_OB);
    const int lane = p.lane, h = p.wave, l15 = lane & 15, g4 = lane >> 4, q4 = (lane & 15) >> 2, pp = lane & 3;
    constexpr int TILE_B = 64 * 640;
    int soff[5];
#pragma unroll
    for (int i = 0; i < 5; ++i) { const int P_ = (h + 8 * i) * 64 + lane, row = P_ / 40, cph = P_ - 40 * row; soff[i] = row * 320 + ((cph ^ (row & 6)) << 3); }
    const int kb_ = l15 * 640 + ((g4 ^ (l15 & 2)) << 4), km_ = ((l15 >> 2) & 1) << 6, kbase0 = kb_ + km_, kbase1 = kb_ - km_;
    int taddr[4];
    { const int rl = 4 * g4 + q4, m_ = (rl & 6) >> 1;
#pragma unroll
      for (int v3 = 0; v3 < 4; ++v3) taddr[v3] = rl * 640 + (((v3 ^ m_) << 1 | (pp >> 1)) << 4) + 8 * (pp & 1); }
#define AT_DMA(BUF, SRC) do { _Pragma("unroll") for (int i = 0; i < 5; ++i) \
        __builtin_amdgcn_global_load_lds((const unsigned*)((SRC) + soff[i]), (LAS unsigned*)((BUF) + (h + 8 * i) * 1024), 16, 0, 0); } while (0)
    for (int pi = p.bid; pi < 512; pi += p.G) {
        const int b = (p.G % 8 == 0) ? (pi & 7) : (pi >> 6), x = (p.G % 8 == 0) ? ((pi >> 3) & 63) : (pi & 63);
        for (int half = 0; half < 2; ++half) {
            const int qt = half ? 127 - x : x, t0 = 16 * qt, nkt = (t0 + 15) / 64 + 1;
            const size_t rowq = (size_t)b * 2048 + t0 + l15; const bf16* kvb = KVB + (size_t)b * 2048 * 320;
            AT_DMA(p.lds, kvb);
            bf16x8 Q[10];
#pragma unroll
            for (int s = 0; s < 10; ++s) Q[s] = as_bf16x8(*(const u32x4*)(QF + rowq * 2560 + h * 320 + 32 * s + 8 * g4));
            f32x4 O[16];
#pragma unroll
            for (int vt = 0; vt < 16; ++vt) O[vt] = (f32x4){0.f, 0.f, 0.f, 0.f};
            float mrun = -1e30f, lrun = 0.f;
            asm volatile("s_waitcnt vmcnt(0)" ::: "memory"); __syncthreads();
#define AT_TILE(BUF, KT, MASKED) do { \
                const unsigned lb_ = (unsigned)(size_t)(BUF), kb0_ = lb_ + kbase0, kb1_ = lb_ + kbase1; \
                f32x4 S[4]; \
                _Pragma("unroll") for (int k4 = 0; k4 < 4; ++k4) S[k4] = (f32x4){0.f, 0.f, 0.f, 0.f}; \
                { const bf16x8 ka0 = dsr128<0>(kb0_), ka1 = dsr128<10240>(kb0_), ka2 = dsr128<20480>(kb0_), ka3 = dsr128<30720>(kb0_), kc0 = dsr128<64>(kb1_), kc1 = dsr128<10304>(kb1_), kc2 = dsr128<20544>(kb1_), kc3 = dsr128<30784>(kb1_); \
                  LDS_WAIT_PIN(); \
                  S[0] = MFMA16(ka0, Q[0], S[0]); S[1] = MFMA16(ka1, Q[0], S[1]); S[2] = MFMA16(ka2, Q[0], S[2]); S[3] = MFMA16(ka3, Q[0], S[3]); S[0] = MFMA16(kc0, Q[1], S[0]); S[1] = MFMA16(kc1, Q[1], S[1]); S[2] = MFMA16(kc2, Q[1], S[2]); S[3] = MFMA16(kc3, Q[1], S[3]); } \
                { const bf16x8 ka0 = dsr128<128>(kb0_), ka1 = dsr128<10368>(kb0_), ka2 = dsr128<20608>(kb0_), ka3 = dsr128<30848>(kb0_), kc0 = dsr128<192>(kb1_), kc1 = dsr128<10432>(kb1_), kc2 = dsr128<20672>(kb1_), kc3 = dsr128<30912>(kb1_); \
                  LDS_WAIT_PIN(); \
                  S[0] = MFMA16(ka0, Q[2], S[0]); S[1] = MFMA16(ka1, Q[2], S[1]); S[2] = MFMA16(ka2, Q[2], S[2]); S[3] = MFMA16(ka3, Q[2], S[3]); S[0] = MFMA16(kc0, Q[3], S[0]); S[1] = MFMA16(kc1, Q[3], S[1]); S[2] = MFMA16(kc2, Q[3], S[2]); S[3] = MFMA16(kc3, Q[3], S[3]); } \
                { const bf16x8 ka0 = dsr128<256>(kb0_), ka1 = dsr128<10496>(kb0_), ka2 = dsr128<20736>(kb0_), ka3 = dsr128<30976>(kb0_), kc0 = dsr128<320>(kb1_), kc1 = dsr128<10560>(kb1_), kc2 = dsr128<20800>(kb1_), kc3 = dsr128<31040>(kb1_); \
                  LDS_WAIT_PIN(); \
                  S[0] = MFMA16(ka0, Q[4], S[0]); S[1] = MFMA16(ka1, Q[4], S[1]); S[2] = MFMA16(ka2, Q[4], S[2]); S[3] = MFMA16(ka3, Q[4], S[3]); S[0] = MFMA16(kc0, Q[5], S[0]); S[1] = MFMA16(kc1, Q[5], S[1]); S[2] = MFMA16(kc2, Q[5], S[2]); S[3] = MFMA16(kc3, Q[5], S[3]); } \
                { const bf16x8 ka0 = dsr128<384>(kb0_), ka1 = dsr128<10624>(kb0_), ka2 = dsr128<20864>(kb0_), ka3 = dsr128<31104>(kb0_), kc0 = dsr128<448>(kb1_), kc1 = dsr128<10688>(kb1_), kc2 = dsr128<20928>(kb1_), kc3 = dsr128<31168>(kb1_); \
                  LDS_WAIT_PIN(); \
                  S[0] = MFMA16(ka0, Q[6], S[0]); S[1] = MFMA16(ka1, Q[6], S[1]); S[2] = MFMA16(ka2, Q[6], S[2]); S[3] = MFMA16(ka3, Q[6], S[3]); S[0] = MFMA16(kc0, Q[7], S[0]); S[1] = MFMA16(kc1, Q[7], S[1]); S[2] = MFMA16(kc2, Q[7], S[2]); S[3] = MFMA16(kc3, Q[7], S[3]); } \
                { const bf16x8 ka0 = dsr128<512>(kb0_), ka1 = dsr128<10752>(kb0_), ka2 = dsr128<20992>(kb0_), ka3 = dsr128<31232>(kb0_), kc0 = dsr128<576>(kb1_), kc1 = dsr128<10816>(kb1_), kc2 = dsr128<21056>(kb1_), kc3 = dsr128<31296>(kb1_); \
                  LDS_WAIT_PIN(); \
                  S[0] = MFMA16(ka0, Q[8], S[0]); S[1] = MFMA16(ka1, Q[8], S[1]); S[2] = MFMA16(ka2, Q[8], S[2]); S[3] = MFMA16(ka3, Q[8], S[3]); S[0] = MFMA16(kc0, Q[9], S[0]); S[1] = MFMA16(kc1, Q[9], S[1]); S[2] = MFMA16(kc2, Q[9], S[2]); S[3] = MFMA16(kc3, Q[9], S[3]); } \
                  \
                float mx = -1e30f; \
                _Pragma("unroll") for (int k4 = 0; k4 < 4; ++k4) _Pragma("unroll") for (int e = 0; e < 4; ++e) { float v = S[k4][e]; if ((MASKED) && 64 * (KT) + 16 * k4 + 4 * g4 + e > t0 + l15) v = -1e30f; S[k4][e] = v; mx = fmaxf(mx, v); } \
                mx = fmaxf(mx, __shfl_xor(mx, 16)); mx = fmaxf(mx, __shfl_xor(mx, 32)); \
                const float mnew = fmaxf(mrun, mx), alpha = __builtin_amdgcn_exp2f(mrun - mnew); mrun = mnew; \
                float ps = 0.f; \
                _Pragma("unroll") for (int k4 = 0; k4 < 4; ++k4) _Pragma("unroll") for (int e = 0; e < 4; ++e) { const float pv = __builtin_amdgcn_exp2f(S[k4][e] - mnew); S[k4][e] = pv; ps += pv; } \
                lrun = lrun * alpha + ps; \
                _Pragma("unroll") for (int vt = 0; vt < 16; ++vt) O[vt] *= alpha; \
                bf16x8 Pf[2]; \
                _Pragma("unroll") for (int ks = 0; ks < 2; ++ks) Pf[ks] = as_bf16x8((u32x4){cvt_pk_bf16(S[2 * ks][0], S[2 * ks][1]), cvt_pk_bf16(S[2 * ks][2], S[2 * ks][3]), cvt_pk_bf16(S[2 * ks + 1][0], S[2 * ks + 1][1]), cvt_pk_bf16(S[2 * ks + 1][2], S[2 * ks + 1][3])}); \
                  \
                { const unsigned tb0_ = lb_ + taddr[0], tb1_ = lb_ + taddr[1], tb2_ = lb_ + taddr[2], tb3_ = lb_ + taddr[3]; \
                  { const s16x4 v000 = dstr64<0>(tb0_), v001 = dstr64<10240>(tb0_), v010 = dstr64<20480>(tb0_), v011 = dstr64<30720>(tb0_), v100 = dstr64<0>(tb1_), v101 = dstr64<10240>(tb1_), v110 = dstr64<20480>(tb1_), v111 = dstr64<30720>(tb1_), v200 = dstr64<0>(tb2_), v201 = dstr64<10240>(tb2_), v210 = dstr64<20480>(tb2_), v211 = dstr64<30720>(tb2_), v300 = dstr64<0>(tb3_), v301 = dstr64<10240>(tb3_), v310 = dstr64<20480>(tb3_), v311 = dstr64<30720>(tb3_); \
                    LDS_WAIT_PIN(); \
                    O[0] = MFMA16(cat8(v000, v001), Pf[0], O[0]); O[0] = MFMA16(cat8(v010, v011), Pf[1], O[0]); O[1] = MFMA16(cat8(v100, v101), Pf[0], O[1]); O[1] = MFMA16(cat8(v110, v111), Pf[1], O[1]); O[2] = MFMA16(cat8(v200, v201), Pf[0], O[2]); O[2] = MFMA16(cat8(v210, v211), Pf[1], O[2]); O[3] = MFMA16(cat8(v300, v301), Pf[0], O[3]); O[3] = MFMA16(cat8(v310, v311), Pf[1], O[3]); } \
                  { const s16x4 v000 = dstr64<128>(tb0_), v001 = dstr64<10368>(tb0_), v010 = dstr64<20608>(tb0_), v011 = dstr64<30848>(tb0_), v100 = dstr64<128>(tb1_), v101 = dstr64<10368>(tb1_), v110 = dstr64<20608>(tb1_), v111 = dstr64<30848>(tb1_), v200 = dstr64<128>(tb2_), v201 = dstr64<10368>(tb2_), v210 = dstr64<20608>(tb2_), v211 = dstr64<30848>(tb2_), v300 = dstr64<128>(tb3_), v301 = dstr64<10368>(tb3_), v310 = dstr64<20608>(tb3_), v311 = dstr64<30848>(tb3_); \
                    LDS_WAIT_PIN(); \
                    O[4] = MFMA16(cat8(v000, v001), Pf[0], O[4]); O[4] = MFMA16(cat8(v010, v011), Pf[1], O[4]); O[5] = MFMA16(cat8(v100, v101), Pf[0], O[5]); O[5] = MFMA16(cat8(v110, v111), Pf[1], O[5]); O[6] = MFMA16(cat8(v200, v201), Pf[0], O[6]); O[6] = MFMA16(cat8(v210, v211), Pf[1], O[6]); O[7] = MFMA16(cat8(v300, v301), Pf[0], O[7]); O[7] = MFMA16(cat8(v310, v311), Pf[1], O[7]); } \
                  { const s16x4 v000 = dstr64<256>(tb0_), v001 = dstr64<10496>(tb0_), v010 = dstr64<20736>(tb0_), v011 = dstr64<30976>(tb0_), v100 = dstr64<256>(tb1_), v101 = dstr64<10496>(tb1_), v110 = dstr64<20736>(tb1_), v111 = dstr64<30976>(tb1_), v200 = dstr64<256>(tb2_), v201 = dstr64<10496>(tb2_), v210 = dstr64<20736>(tb2_), v211 = dstr64<30976>(tb2_), v300 = dstr64<256>(tb3_), v301 = dstr64<10496>(tb3_), v310 = dstr64<20736>(tb3_), v311 = dstr64<30976>(tb3_); \
                    LDS_WAIT_PIN(); \
                    O[8] = MFMA16(cat8(v000, v001), Pf[0], O[8]); O[8] = MFMA16(cat8(v010, v011), Pf[1], O[8]); O[9] = MFMA16(cat8(v100, v101), Pf[0], O[9]); O[9] = MFMA16(cat8(v110, v111), Pf[1], O[9]); O[10] = MFMA16(cat8(v200, v201), Pf[0], O[10]); O[10] = MFMA16(cat8(v210, v211), Pf[1], O[10]); O[11] = MFMA16(cat8(v300, v301), Pf[0], O[11]); O[11] = MFMA16(cat8(v310, v311), Pf[1], O[11]); } \
                  { const s16x4 v000 = dstr64<384>(tb0_), v001 = dstr64<10624>(tb0_), v010 = dstr64<20864>(tb0_), v011 = dstr64<31104>(tb0_), v100 = dstr64<384>(tb1_), v101 = dstr64<10624>(tb1_), v110 = dstr64<20864>(tb1_), v111 = dstr64<31104>(tb1_), v200 = dstr64<384>(tb2_), v201 = dstr64<10624>(tb2_), v210 = dstr64<20864>(tb2_), v211 = dstr64<31104>(tb2_), v300 = dstr64<384>(tb3_), v301 = dstr64<10624>(tb3_), v310 = dstr64<20864>(tb3_), v311 = dstr64<31104>(tb3_); \
                    LDS_WAIT_PIN(); \
                    O[12] = MFMA16(cat8(v000, v001), Pf[0], O[12]); O[12] = MFMA16(cat8(v010, v011), Pf[1], O[12]); O[13] = MFMA16(cat8(v100, v101), Pf[0], O[13]); O[13] = MFMA16(cat8(v110, v111), Pf[1], O[13]); O[14] = MFMA16(cat8(v200, v201), Pf[0], O[14]); O[14] = MFMA16(cat8(v210, v211), Pf[1], O[14]); O[15] = MFMA16(cat8(v300, v301), Pf[0], O[15]); O[15] = MFMA16(cat8(v310, v311), Pf[1], O[15]); } \
                } } while (0)
#define AT_V(BUF, VT, KS, T) tr16((BUF) + taddr[(VT) & 3] + ((VT) >> 2) * 128 + (32 * (KS) + 16 * (T)) * 640)
            for (int kt = 0; kt < nkt - 1; ++kt) {
                LAS unsigned char* buf = p.lds + (kt & 1) * TILE_B;
                AT_DMA(p.lds + ((kt + 1) & 1) * TILE_B, kvb + (size_t)64 * (kt + 1) * 320);
                AT_TILE(buf, kt, false);
                asm volatile("s_waitcnt vmcnt(0)" ::: "memory"); __syncthreads();
            }
            { const int kt = nkt - 1; LAS unsigned char* buf = p.lds + (kt & 1) * TILE_B;
              AT_TILE(buf, kt, true);
              __syncthreads(); }
#undef AT_TILE
#undef AT_V
            const float linv = 1.0f / quad_red(lrun);
#pragma unroll
            for (int vt = 0; vt < 16; ++vt) { const f32x4 o = O[vt] * linv;
                *(u32x2*)(OB + rowq * 2048 + h * 256 + 16 * vt + 4 * g4) = (u32x2){cvt_pk_bf16(o[0], o[1]), cvt_pk_bf16(o[2], o[3])}; }
        }
    }
#undef AT_DMA
}

__device__ __forceinline__ void b3_attn_sample(const P& p) {
    const bf16* QF = p.w<bf16>(WS_QF); float* PART = p.w<float>(WS_PART); float* PML = p.w<float>(WS_PML);
    const float* cache = p.in[2]; const int* ptab = (const int*)p.in[5];
    const int tid = p.tid, lane = p.lane, w = p.wave, qt = w & 1, dvq = w >> 1, l15 = lane & 15, g4 = lane >> 4, q4 = (lane & 15) >> 2, pp = lane & 3;
    constexpr int TILE_B = 64 * KP;
    for (int u = p.bid; u < 256; u += p.G) {
        const int b = u >> 3, sp = u & 7;
        const int hq = 4 * qt + (l15 >> 2), iq = l15 & 3; const size_t rowq = (size_t)MP + 4 * b + iq;
        bf16x8 Q[10];
#pragma unroll
        for (int s = 0; s < 10; ++s) Q[s] = as_bf16x8(*(const u32x4*)(QF + rowq * 2560 + hq * 320 + 32 * s + 8 * g4));
        f32x4 O[4];
#pragma unroll
        for (int v = 0; v < 4; ++v) O[v] = (f32x4){0.f, 0.f, 0.f, 0.f};
        float mrun = -1e30f, lrun = 0.f;
        f32x4 st[10];
        auto tile_src = [&](int ti) -> const float* { const int pg = 16 * sp + (ti >> 1); return cache + ((size_t)ptab[b * 128 + pg] * 128 + 64 * (ti & 1)) * 320; };
        { const float* src = tile_src(0);
#pragma unroll
          for (int q = 0; q < 10; ++q) st[q] = __builtin_nontemporal_load((const f32x4*)(src + (size_t)(tid + 512 * q) * 4));
          __syncthreads();
#pragma unroll
          for (int q = 0; q < 10; ++q) { const int ch = tid + 512 * q, row = ch / 80, c4 = ch % 80; *(LAS u32x2*)(p.lds + row * KP + c4 * 8) = (u32x2){cvt_pk_bf16(st[q][0], st[q][1]), cvt_pk_bf16(st[q][2], st[q][3])}; }
          __syncthreads(); }
        for (int ti = 0; ti < 32; ++ti) {
            LAS unsigned char* buf = p.lds + (ti & 1) * TILE_B;
            if (ti + 1 < 32) { const float* src = tile_src(ti + 1);
#pragma unroll
                for (int q = 0; q < 10; ++q) st[q] = __builtin_nontemporal_load((const f32x4*)(src + (size_t)(tid + 512 * q) * 4)); }
            f32x4 S[4];
#pragma unroll
            for (int k4 = 0; k4 < 4; ++k4) { S[k4] = (f32x4){0.f, 0.f, 0.f, 0.f};
#pragma unroll
                for (int s = 0; s < 10; ++s) { const bf16x8 Kf = *(const LAS bf16x8*)(buf + (16 * k4 + l15) * KP + (32 * s + 8 * g4) * 2); S[k4] = MFMA16(Kf, Q[s], S[k4]); } }
            float mx = -1e30f;
#pragma unroll
            for (int k4 = 0; k4 < 4; ++k4)
#pragma unroll
                for (int e = 0; e < 4; ++e) { const float v = S[k4][e]; mx = fmaxf(mx, v); }
            mx = fmaxf(mx, __shfl_xor(mx, 16)); mx = fmaxf(mx, __shfl_xor(mx, 32));
            const float mnew = fmaxf(mrun, mx), alpha = __builtin_amdgcn_exp2f(mrun - mnew); mrun = mnew;
            float ps = 0.f;
#pragma unroll
            for (int k4 = 0; k4 < 4; ++k4)
#pragma unroll
                for (int e = 0; e < 4; ++e) { const float pv = __builtin_amdgcn_exp2f(S[k4][e] - mnew); S[k4][e] = pv; ps += pv; }
            lrun = lrun * alpha + ps;
#pragma unroll
            for (int v = 0; v < 4; ++v) O[v] *= alpha;
            bf16x8 Pf[2];
#pragma unroll
            for (int ks = 0; ks < 2; ++ks) Pf[ks] = as_bf16x8((u32x4){cvt_pk_bf16(S[2 * ks][0], S[2 * ks][1]), cvt_pk_bf16(S[2 * ks][2], S[2 * ks][3]), cvt_pk_bf16(S[2 * ks + 1][0], S[2 * ks + 1][1]), cvt_pk_bf16(S[2 * ks + 1][2], S[2 * ks + 1][3])});
#pragma unroll
            for (int v = 0; v < 4; ++v) { const int vt = 4 * dvq + v;
#pragma unroll
                for (int ks = 0; ks < 2; ++ks) {
                    const bf16x8 Vf = cat8(tr16(buf + (32 * ks + 4 * g4 + q4) * KP + (16 * vt + 4 * pp) * 2), tr16(buf + (32 * ks + 16 + 4 * g4 + q4) * KP + (16 * vt + 4 * pp) * 2));
                    O[v] = MFMA16(Vf, Pf[ks], O[v]); } }
            if (ti + 1 < 32) { LAS unsigned char* nb = p.lds + ((ti + 1) & 1) * TILE_B;
#pragma unroll
                for (int q = 0; q < 10; ++q) { const int ch = tid + 512 * q, row = ch / 80, c4 = ch % 80; *(LAS u32x2*)(nb + row * KP + c4 * 8) = (u32x2){cvt_pk_bf16(st[q][0], st[q][1]), cvt_pk_bf16(st[q][2], st[q][3])}; } }
            __syncthreads();
        }
        const float lsum = quad_red(lrun); const int qrow = 16 * qt + l15; const size_t pb = ((size_t)(b * 8 + sp) * 32 + qrow);
#pragma unroll
        for (int v = 0; v < 4; ++v) *(f32x4*)(PART + pb * 256 + 16 * (4 * dvq + v) + 4 * g4) = O[v];
        if (dvq == 0 && g4 == 0) { PML[pb * 2] = mrun; PML[pb * 2 + 1] = lsum; }
    }
}
__device__ __forceinline__ void b3_combine(const P& p) {
    const bf16* QF = p.w<bf16>(WS_QF); const bf16* KVB = p.w<bf16>(WS_KVB); bf16* OB = p.w<bf16>(WS_OB); const float* PART = p.w<float>(WS_PART); const float* PML = p.w<float>(WS_PML);
    const int dv = p.tid & 255, sub = p.tid >> 8, lane = p.lane, w4 = p.wave & 3;
    LAS float* red = (LAS float*)p.lds;
    for (int base = 2 * p.bid; base < 1024; base += 2 * p.G) {
        const bool live = base + sub < 1024; const int it = live ? base + sub : 1023;
        const int b = it >> 5, i = (it >> 3) & 3, h = it & 7, qt = h >> 2, ql = ((h & 3) << 2) | i, qrow = 16 * qt + ql; const size_t row = (size_t)MP + 4 * b + i;
        { const int wd = dv < 160 ? dv : 159; const unsigned a = ((const unsigned*)(QF + row * 2560 + h * 320))[wd]; float pk[4];
#pragma unroll
          for (int kk = 0; kk < 4; ++kk) { const unsigned c = ((const unsigned*)(KVB + ((size_t)MP + 4 * b + kk) * 320))[wd]; pk[kk] = (dv < 160) ? bflo(a) * bflo(c) + bfhi(a) * bfhi(c) : 0.f; }
#pragma unroll
          for (int kk = 0; kk < 4; ++kk) {
#pragma unroll
              for (int o = 1; o < 64; o <<= 1) pk[kk] += __shfl_xor(pk[kk], o);
              if (lane == 0) red[(sub * 4 + w4) * 4 + kk] = pk[kk]; } }
        __syncthreads();
        float sn[4];
#pragma unroll
        for (int kk = 0; kk < 4; ++kk) { const float s = (red[(sub * 4 + 0) * 4 + kk] + red[(sub * 4 + 1) * 4 + kk]) + (red[(sub * 4 + 2) * 4 + kk] + red[(sub * 4 + 3) * 4 + kk]); sn[kk] = (kk <= i) ? s : -1e30f; }
        float M = fmaxf(fmaxf(sn[0], sn[1]), fmaxf(sn[2], sn[3])); float ms[8], ls[8];
#pragma unroll
        for (int sp = 0; sp < 8; ++sp) { const size_t pb = ((size_t)(b * 8 + sp) * 32 + qrow); ms[sp] = PML[pb * 2]; ls[sp] = PML[pb * 2 + 1]; M = fmaxf(M, ms[sp]); }
        float L = 0.f, Oa = 0.f;
#pragma unroll
        for (int sp = 0; sp < 8; ++sp) { const size_t pb = ((size_t)(b * 8 + sp) * 32 + qrow); const float wgt = __builtin_amdgcn_exp2f(ms[sp] - M); L += ls[sp] * wgt; Oa += PART[pb * 256 + dv] * wgt; }
#pragma unroll
        for (int kk = 0; kk < 4; ++kk) { const float pk = __builtin_amdgcn_exp2f(sn[kk] - M); L += pk; Oa += pk * bf2f(KVB[((size_t)MP + 4 * b + kk) * 320 + dv]); }
        if (live) OB[row * 2048 + h * 256 + dv] = (bf16)f2bf(Oa / L);
        __syncthreads();
    }
}

__device__ __forceinline__ f32x4 conv4s(const bf16* XW, const float* cbuf  , const float* cw, const float* cb, int m, int c) {
    f32x4 acc = *(const f32x4*)(cb + c);
    f32x4 v[4], wv[4];
    const int b = (m - MP) >> 2, t = (m - MP) & 3;
#pragma unroll
    for (int k = 0; k < 4; ++k) { wv[k] = *(const f32x4*)(cw + k * 1280 + c); const int r = t + k - 3;
        const u32x2 xw = *(const u32x2*)(XW + (size_t)(m + (r >= 0 ? k - 3 : 0)) * 1280 + c); const f32x4 st = *(const f32x4*)(cbuf + ((size_t)b * 3 + (r >= 0 ? 0 : 3 + r)) * 1280 + c);
        v[k] = (r >= 0) ? (f32x4){bflo(xw.x), bfhi(xw.x), bflo(xw.y), bfhi(xw.y)} : st; }
#pragma unroll
    for (int k = 0; k < 4; ++k) acc += wv[k] * v[k];
    return acc;
}
__device__ __forceinline__ void c2_sample_item(const P& p, int j, int item, float* out_hs) {
    const bf16* XW = p.w<bf16>(WS_XW); bf16* LH = p.w<bf16>(WS_AA);
    const float* cbuf = p.in[4] + (size_t)j * 32 * 3 * 1280; const float* cw = p.in[25] + (size_t)j * 4 * 1280; const float* cb = p.in[26] + j * 1280;
    const float* b_a = p.in[28] + j * 1280; const float* b_i = p.in[30] + j * 1280; const float* lam = p.in[31] + j * 1280; const float* h0s = p.in[3] + (size_t)j * 32 * 1280;
    const bf16* WaT = p.w<bf16>(WS_WAT); const bf16* WiT = p.w<bf16>(WS_WIT);
    LAS unsigned char* Xs = p.lds;
    const int tid = p.tid, lane = p.lane, w = p.wave, l15 = lane & 15, g4 = lane >> 4, rgq = item / 10, n = item % 10;
    const int chl = 16 * w + l15, chn = n * 128 + chl; u32x4 wa[4], wi[4];
#pragma unroll
    for (int kk = 0; kk < 4; ++kk) { wa[kk] = *(const u32x4*)(WaT + (size_t)n * 16384 + chl * 128 + 32 * kk + 8 * g4); wi[kk] = *(const u32x4*)(WiT + (size_t)n * 16384 + chl * 128 + 32 * kk + 8 * g4); }
    const int bb = 4 * rgq + g4; float h = h0s[(size_t)bb * 1280 + chn]; const float ba = b_a[chn], bi = b_i[chn], lm = lam[chn];
    { const int r16 = tid >> 5, c4 = (tid & 31) * 4; const f32x4 xc = conv4s(XW, cbuf, cw, cb, MP + 16 * rgq + r16, n * 128 + c4);
      __syncthreads();
      *(LAS u32x2*)(Xs + r16 * TP + c4 * 2) = (u32x2){cvt_pk_bf16(xc[0], xc[1]), cvt_pk_bf16(xc[2], xc[3])}; }
    __syncthreads();
    f32x4 ca = (f32x4){0.f, 0.f, 0.f, 0.f}, ci = ca;
#pragma unroll
    for (int kk = 0; kk < 4; ++kk) { const bf16x8 X = *(const LAS bf16x8*)(Xs + l15 * TP + (32 * kk + 8 * g4) * 2);
        ca = MFMA16(X, as_bf16x8(wa[kk]), ca); ci = MFMA16(X, as_bf16x8(wi[kk]), ci); }
    const float nl = -lm, sp = -8.0f * LOG2E * ((nl > 20.f) ? nl : log1pf(expf(nl)));
#pragma unroll
    for (int e = 0; e < 4; ++e) { const float xc = bf2f(*(const LAS bf16*)(Xs + (4 * g4 + e) * TP + chl * 2));
        const float r = fast_sigmoid_l2(LOG2E * (ca[e] + ba)), gi = fast_sigmoid_l2(LOG2E * (ci[e] + bi)), a = __builtin_amdgcn_exp2f(r * sp);
        const float bt = bf2f((bf16)f2bf(__builtin_amdgcn_sqrtf(fmaxf(__builtin_fmaf(-a, a, 1.0f), 0.f)) * gi * xc));
        h = a * h + bt;
        LH[(size_t)(MP + 4 * bb + e) * 1280 + chn] = (bf16)f2bf(h); }
    if (out_hs) out_hs[(size_t)bb * 1280 + chn] = h;
}
__device__ __forceinline__ void c2_rglru(const P& p, int j, float* out_cp, float* out_cs, float* out_hs, const int mask) {
    const bf16* XW = p.w<bf16>(WS_XW); bf16* LH = p.w<bf16>(WS_AA); bf16* CPB = p.w<bf16>(WS_BB); float* AGG = p.w<float>(WS_AGG);
    const float* cbuf = p.in[4] + (size_t)j * 32 * 3 * 1280; const float* cw = p.in[25] + (size_t)j * 4 * 1280; const float* cb = p.in[26] + j * 1280;
    const float* b_a = p.in[28] + j * 1280; const float* b_i = p.in[30] + j * 1280; const float* lam = p.in[31] + j * 1280; const float* h0s = p.in[3] + (size_t)j * 32 * 1280;
    const bf16* WaT = p.w<bf16>(WS_WAT); const bf16* WiT = p.w<bf16>(WS_WIT);
    LAS unsigned char* Xt = p.lds; LAS unsigned char* At = p.lds + 128 * TP; LAS unsigned char* It = p.lds + 256 * TP;
    LAS float* LA = (LAS float*)p.lds;
    LAS unsigned char* LB = p.lds + 128 * 528;
    LAS float* QT = (LAS float*)(p.lds + 128 * 528 + 128 * TP);
    const int tid = p.tid, lane = p.lane, w = p.wave, l15 = lane & 15, g4 = lane >> 4;
    { const int gt = p.bid * 512 + tid, NGT = p.G * 512;
      for (int i = gt; i < (8 + 32) * 3 * 320; i += NGT) { const int c = (i % 320) * 4, rr = i / 320, jj = rr % 3, bb = rr / 3;
          const u32x2 xw = *(const u32x2*)(XW + ((bb < 8) ? ((size_t)bb * 2048 + 2045 + jj) : ((size_t)MP + 4 * (bb - 8) + 1 + jj)) * 1280 + c); const f32x4 v = (f32x4){bflo(xw.x), bfhi(xw.x), bflo(xw.y), bfhi(xw.y)};
          if (bb < 8) { if (out_cp) *(f32x4*)(out_cp + ((size_t)bb * 3 + jj) * 1280 + c) = v; }
          else { const int b = bb - 8; if (out_cs) *(f32x4*)(out_cs + ((size_t)b * 3 + jj) * 1280 + c) = v; } } }
    const int c16 = tid & 15;
    f32x4 wv[4][2], bv[2]; u32x4 xv0[2][4], xv1[2][4], wa[4], wi[4];
#define C2_LOADW(U) do { const int n_ = (U) % 10, cch_ = n_ * 128 + c16 * 8; \
        _Pragma("unroll") for (int k = 0; k < 4; ++k) { wv[k][0] = *(const f32x4*)(cw + k * 1280 + cch_); wv[k][1] = *(const f32x4*)(cw + k * 1280 + cch_ + 4); } \
        bv[0] = *(const f32x4*)(cb + cch_); bv[1] = *(const f32x4*)(cb + cch_ + 4); } while (0)
#define C2_LOADG(U) do { const int n_ = (U) % 10; \
        _Pragma("unroll") for (int q = 0; q < 4; ++q) { const int row = (tid >> 4) + 32 * q; wa[q] = *(const u32x4*)(WaT + (size_t)n_ * 16384 + row * 128 + c16 * 8); wi[q] = *(const u32x4*)(WiT + (size_t)n_ * 16384 + row * 128 + c16 * 8); } } while (0)
#define C2_LOADX(U, QH, XV) do { const int T_ = (U) / 10, cch_ = ((U) % 10) * 128 + c16 * 8; \
        _Pragma("unroll") for (int qq = 0; qq < 2; ++qq) { const int m = T_ * 128 + (tid >> 4) + 32 * (2 * (QH) + qq); \
            _Pragma("unroll") for (int k = 0; k < 4; ++k) { const int t = m & 2047, r = t + k - 3; XV[qq][k] = *(const u32x4*)(XW + (size_t)(m + (r >= 0 ? k - 3 : -t)) * 1280 + cch_); } } } while (0)
#define C2_CONV(U, QH, XV) do { const int T_ = (U) / 10; \
        _Pragma("unroll") for (int qq = 0; qq < 2; ++qq) { const int row = (tid >> 4) + 32 * (2 * (QH) + qq), m = T_ * 128 + row; f32x4 v0 = bv[0], v1 = bv[1]; \
            _Pragma("unroll") for (int k = 0; k < 4; ++k) { const bool live = (((m & 2047) + k - 3) >= 0); const f32x4 z = (f32x4){0.f, 0.f, 0.f, 0.f}; const u32x4 x_ = XV[qq][k]; \
                v0 += (live ? wv[k][0] : z) * (f32x4){bflo(x_.x), bfhi(x_.x), bflo(x_.y), bfhi(x_.y)}; v1 += (live ? wv[k][1] : z) * (f32x4){bflo(x_.z), bfhi(x_.z), bflo(x_.w), bfhi(x_.w)}; } \
            *(LAS u32x4*)(Xt + row * TP + c16 * 16) = pack8(v0, v1); } } while (0)
    if (p.bid < 128 * 10) { C2_LOADX(p.bid, 0, xv0); C2_LOADX(p.bid, 1, xv1); }
    for (int u = p.bid; u < 128 * 10; u += p.G) {
        int tl_ = p.tid; asm volatile("" : "+v"(tl_)); const int tid = tl_, lane = tl_ & 63, l15 = lane & 15, g4 = lane >> 4, c16 = tl_ & 15;
        const int T = u / 10, n = u % 10, row0 = T * 128;
        {
            C2_LOADW(u); C2_LOADG(u);
            C2_CONV(u, 0, xv0); C2_CONV(u, 1, xv1);
#pragma unroll
            for (int q = 0; q < 4; ++q) { const int row = (tid >> 4) + 32 * q; *(LAS u32x4*)(At + row * TP + c16 * 16) = wa[q]; *(LAS u32x4*)(It + row * TP + c16 * 16) = wi[q]; }
        }
        __syncthreads();
        f32x4 ca[8], ci[8];
#pragma unroll
        for (int tt = 0; tt < 8; ++tt) { ca[tt] = (f32x4){0.f, 0.f, 0.f, 0.f}; ci[tt] = (f32x4){0.f, 0.f, 0.f, 0.f}; }
        {
#pragma unroll
        for (int kk = 0; kk < 4; ++kk) {
            const bf16x8 Xa = *(const LAS bf16x8*)(At + (16 * w + l15) * TP + (32 * kk + 8 * g4) * 2), Xi = *(const LAS bf16x8*)(It + (16 * w + l15) * TP + (32 * kk + 8 * g4) * 2);
#pragma unroll
            for (int tt = 0; tt < 8; ++tt) { const bf16x8 Y = *(const LAS bf16x8*)(Xt + (16 * tt + l15) * TP + (32 * kk + 8 * g4) * 2);
                ca[tt] = MFMA16(Xa, Y, ca[tt]); ci[tt] = MFMA16(Xi, Y, ci[tt]); }
        }
        const int chn = n * 128 + 16 * w + 4 * g4;
        { const f32x4 ba = *(const f32x4*)(b_a + chn), bi = *(const f32x4*)(b_i + chn), lm = *(const f32x4*)(lam + chn);
          f32x4 sp;
#pragma unroll
          for (int e = 0; e < 4; ++e) { const float nl = -lm[e]; sp[e] = -8.0f * LOG2E * ((nl > 20.f) ? nl : log1pf(expf(nl))); }
#pragma unroll
          for (int tt = 0; tt < 8; ++tt) { const u32x2 xb = *(const LAS u32x2*)(Xt + (16 * tt + l15) * TP + (16 * w + 4 * g4) * 2);
              const f32x4 xc = (f32x4){bflo(xb.x), bfhi(xb.x), bflo(xb.y), bfhi(xb.y)};
#pragma unroll
              for (int e = 0; e < 4; ++e) { const float r = fast_sigmoid_l2(LOG2E * (ca[tt][e] + ba[e])), gi = fast_sigmoid_l2(LOG2E * (ci[tt][e] + bi[e]));
                  const float a = __builtin_amdgcn_exp2f(r * sp[e]);
                  ca[tt][e] = a; ci[tt][e] = __builtin_amdgcn_sqrtf(fmaxf(__builtin_fmaf(-a, a, 1.0f), 0.f)) * gi * xc[e]; } } }
        }
        __syncthreads();
#pragma unroll
        for (int tt = 0; tt < 8; ++tt) { const int tok = 16 * tt + l15;
            *(LAS f32x4*)(LA + tok * 132 + 16 * w + 4 * g4) = ca[tt];
            *(LAS u32x2*)(LB + tok * TP + (16 * w + 4 * g4) * 2) = (u32x2){cvt_pk_bf16(ci[tt][0], ci[tt][1]), cvt_pk_bf16(ci[tt][2], ci[tt][3])}; }
        __syncthreads();
        { const int un = u + p.G; if (un < 128 * 10) { C2_LOADX(un, 0, xv0); C2_LOADX(un, 1, xv1); } }
        const int ch = tid & 127, q = tid >> 7, chg = n * 128 + ch;
        {
        if (T < 128) {
            float P_ = 1.f, H_ = 0.f;
#pragma unroll 4
            for (int t = 32 * q; t < 32 * q + 32; ++t) { const float a = LA[t * 132 + ch], b = bf2f(*(const LAS bf16*)(LB + t * TP + ch * 2)); H_ = a * H_ + b; P_ *= a; }
            QT[(q * 128 + ch) * 2] = P_; QT[(q * 128 + ch) * 2 + 1] = H_;
            __syncthreads();
            float h = 0.f, pc = 1.f;
#pragma unroll
            for (int qq = 0; qq < 3; ++qq) if (qq < q) { const float Pq = QT[(qq * 128 + ch) * 2], Hq = QT[(qq * 128 + ch) * 2 + 1]; h = Pq * h + Hq; pc *= Pq; }
#pragma unroll 4
            for (int t = 32 * q; t < 32 * q + 32; ++t) { const float a = LA[t * 132 + ch], b = bf2f(*(const LAS bf16*)(LB + t * TP + ch * 2)); h = a * h + b; pc *= a;
                LA[t * 132 + ch] = pc; *(LAS bf16*)(LB + t * TP + ch * 2) = (bf16)f2bf(h); }
            if (q == 3) { AGG[((size_t)T * 2) * 1280 + chg] = pc; AGG[((size_t)T * 2 + 1) * 1280 + chg] = h; }
        } else {
            for (int bb = 8 * q; bb < 8 * q + 8; ++bb) { float h = h0s[(size_t)bb * 1280 + chg];
#pragma unroll
                for (int i = 0; i < 4; ++i) { const int t = 4 * bb + i; const float a = LA[t * 132 + ch], b = bf2f(*(const LAS bf16*)(LB + t * TP + ch * 2)); h = a * h + b;
                    LA[t * 132 + ch] = 0.f; *(LAS bf16*)(LB + t * TP + ch * 2) = (bf16)f2bf(h); }
                if (out_hs) out_hs[(size_t)bb * 1280 + chg] = h; }
        }
        }
        __syncthreads();
#pragma unroll
        for (int i = 0; i < 4; ++i) { const int cidx = tid + 512 * i, tok = cidx >> 4, c8 = (cidx & 15) * 8; const size_t o = (size_t)(row0 + tok) * 1280 + n * 128 + c8;
            *(u32x4*)(LH + o) = *(const LAS u32x4*)(LB + tok * TP + c8 * 2);
            *(u32x4*)(CPB + o) = pack8(*(const LAS f32x4*)(LA + tok * 132 + c8), *(const LAS f32x4*)(LA + tok * 132 + c8 + 4)); }
        __syncthreads();
    }
#undef C2_LOADW
#undef C2_LOADG
#undef C2_LOADX
#undef C2_CONV
    for (int it = (p.bid + 80) % p.G; it < 80; it += p.G) c2_sample_item(p, j, it, out_hs);
}
__device__ __forceinline__ void c5_fixup(const P& p, float* out_hp) {
    const bf16* LH = p.w<bf16>(WS_AA); const bf16* CPB = p.w<bf16>(WS_BB); const float* AGG = p.w<float>(WS_AGG); const bf16* GATE = p.w<bf16>(WS_GATE); bf16* GH = p.w<bf16>(WS_GH);
    LAS float* cr = (LAS float*)p.lds;
    const int tid = p.tid;
    for (int ci = p.bid * 512 + tid; ci < 128 * 160; ci += p.G * 512) { const size_t o = (size_t)MP * 1280 + (size_t)ci * 8;
        const u32x4 lh = *(const u32x4*)(LH + o), gt = *(const u32x4*)(GATE + o); f32x4 r0, r1;
        r0[0] = bflo(gt.x) * bflo(lh.x); r0[1] = bfhi(gt.x) * bfhi(lh.x); r0[2] = bflo(gt.y) * bflo(lh.y); r0[3] = bfhi(gt.y) * bfhi(lh.y);
        r1[0] = bflo(gt.z) * bflo(lh.z); r1[1] = bfhi(gt.z) * bfhi(lh.z); r1[2] = bflo(gt.w) * bflo(lh.w); r1[3] = bfhi(gt.w) * bfhi(lh.w);
        *(u32x4*)(GH + o) = pack8(r0, r1); }
    for (int it = p.bid; it < 256; it += p.G) {
        const int T = it >> 1, hf = it & 1, row0 = T * 128 + 64 * hf, T0 = T & ~15, nd = T - T0;
        const size_t ob = (size_t)row0 * 1280 + (size_t)tid * 8;
#define C5_LOAD(LHV, CPV, GTV, K) do { _Pragma("unroll") for (int i = 0; i < 5; ++i) { const size_t o = ob + (size_t)(5 * (K) + i) * 4096; \
            LHV[i] = *(const u32x4*)(LH + o); CPV[i] = *(const u32x4*)(CPB + o); GTV[i] = *(const u32x4*)(GATE + o); } } while (0)
        u32x4 lhA[5], cpA[5], gtA[5], lhB[5], cpB[5], gtB[5];
        C5_LOAD(lhA, cpA, gtA, 0);
        for (int ch = tid; ch < 1280; ch += 512) {
            float pa[16], ha[16];
#pragma unroll
            for (int d = 0; d < 16; ++d) { pa[d] = AGG[((size_t)(T0 + d) * 2) * 1280 + ch]; ha[d] = AGG[((size_t)(T0 + d) * 2 + 1) * 1280 + ch]; }
            float c = 0.f;
#pragma unroll
            for (int d = 0; d < 15; ++d) c = (d < nd) ? pa[d] * c + ha[d] : c;
            if (nd == 15 && hf == 1 && out_hp) out_hp[(size_t)(T >> 4) * 1280 + ch] = pa[15] * c + ha[15];
            cr[ch] = c; }
        __syncthreads();
#define C5_ITEM(LHV, CPV, GTV, I) do { const int c8 = ((tid + 512 * (I)) % 160) * 8; const size_t o = ob + (size_t)(I) * 4096; \
            const f32x4 c0 = *(const LAS f32x4*)(cr + c8), c1 = *(const LAS f32x4*)(cr + c8 + 4); f32x4 r0, r1; \
            r0[0] = bflo(GTV.x) * (bflo(LHV.x) + bflo(CPV.x) * c0[0]); r0[1] = bfhi(GTV.x) * (bfhi(LHV.x) + bfhi(CPV.x) * c0[1]); \
            r0[2] = bflo(GTV.y) * (bflo(LHV.y) + bflo(CPV.y) * c0[2]); r0[3] = bfhi(GTV.y) * (bfhi(LHV.y) + bfhi(CPV.y) * c0[3]); \
            r1[0] = bflo(GTV.z) * (bflo(LHV.z) + bflo(CPV.z) * c1[0]); r1[1] = bfhi(GTV.z) * (bfhi(LHV.z) + bfhi(CPV.z) * c1[1]); \
            r1[2] = bflo(GTV.w) * (bflo(LHV.w) + bflo(CPV.w) * c1[2]); r1[3] = bfhi(GTV.w) * (bfhi(LHV.w) + bfhi(CPV.w) * c1[3]); \
            *(u32x4*)(GH + o) = pack8(r0, r1); } while (0)
        C5_LOAD(lhB, cpB, gtB, 1);
#pragma unroll
        for (int i = 0; i < 5; ++i) C5_ITEM(lhA[i], cpA[i], gtA[i], i);
        C5_LOAD(lhA, cpA, gtA, 2);
#pragma unroll
        for (int i = 0; i < 5; ++i) C5_ITEM(lhB[i], cpB[i], gtB[i], 5 + i);
        C5_LOAD(lhB, cpB, gtB, 3);
#pragma unroll
        for (int i = 0; i < 5; ++i) C5_ITEM(lhA[i], cpA[i], gtA[i], 10 + i);
#pragma unroll
        for (int i = 0; i < 5; ++i) C5_ITEM(lhB[i], cpB[i], gtB[i], 15 + i);
#undef C5_LOAD
#undef C5_ITEM
        __syncthreads();
    }
}
__device__ __forceinline__ void final_norm(const P& p, float* out_yp, float* out_ys) {
    const bf16* HB = p.w<bf16>(WS_HB); const long long* ssq = p.stat(ST_SSQ0 + 8); const float* g = p.in[8];
    const int gw = p.bid * NWAVES + p.wave, NGW = p.G * NWAVES, lane = p.lane;
    f32x4 gv[4];
#pragma unroll
    for (int jj = 0; jj < 4; ++jj) gv[jj] = *(const f32x4*)(g + 4 * lane + 256 * jj);
    u32x2 hw[4], hn[4]; long long sq = 0, sn = 0;
    if (gw < MT) { sq = ssq[gw];
#pragma unroll
        for (int jj = 0; jj < 4; ++jj) hw[jj] = *(const u32x2*)(HB + (size_t)gw * 1024 + 4 * lane + 256 * jj); }
    for (int m = gw; m < MT; m += NGW) { float* o = m < MP ? out_yp + (size_t)m * 1024 : out_ys + (size_t)(m - MP) * 1024;
        const int mn = (m + NGW < MT) ? m + NGW : m; sn = ssq[mn];
#pragma unroll
        for (int jj = 0; jj < 4; ++jj) hn[jj] = *(const u32x2*)(HB + (size_t)mn * 1024 + 4 * lane + 256 * jj);
        const float rs = rsqrtf((float)sq * ST_INV * (1.0f / 1024.0f) + RMS_EPS);
#pragma unroll
        for (int jj = 0; jj < 4; ++jj) *(f32x4*)(o + 4 * lane + 256 * jj) = (f32x4){bflo(hw[jj].x), bfhi(hw[jj].x), bflo(hw[jj].y), bfhi(hw[jj].y)} * rs * gv[jj];
#pragma unroll
        for (int jj = 0; jj < 4; ++jj) hw[jj] = hn[jj];
        sq = sn; }
}
}
namespace mk {
struct Args { const float* in[36]; float* out; unsigned char* ws; int ph_lo, ph_hi, li, mask; };
constexpr int NPHASE = 34;

#define MK_GEMM(EpiT, E, Aptr, LDA, Bptr, LDB, KD, NC) do { pg8::Gemm g_{(const pg8::bf16_t*)(Aptr), (const pg8::bf16_t*)(Bptr), (LDA), (LDB), (KD)}; pg8::StaticOrder S_; S_.init(MP, (NC), p.G, p.bid); \
        pg8::gemm_phase<EpiT, pg8::StaticOrder, MK_ALIGN_EPI, MK_SP2>(p.lds, g_, S_, E, p.tid); \
          \
        P q_ = p; { int t2_ = p0.tid; asm volatile("" : "+v"(t2_)); q_.tid = t2_; q_.lane = t2_ & 63; q_.wave = __builtin_amdgcn_readfirstlane(t2_ >> 6); } \
        if (MK_MINI_ON) mini_gemm<EpiT>(q_, (const bf16*)(Aptr), (LDA), (const bf16*)(Bptr), (LDB), (KD), (NC), E, (64 * ((NC) / 256)) % p.G); } while (0)

#ifndef MK_SP2
#define MK_SP2 true
#endif
#ifndef MK_ALIGN_EPI
#define MK_ALIGN_EPI true
#endif
#ifdef MK_DRYPROBE
#define MK_DRYARG , ((mask >> 10) & 1)
#define MK_MINI_ON ((mask >> 11) & 1)
#else
#define MK_DRYARG
#define MK_MINI_ON 1
#endif
#ifndef MK_REP_SEL
#define MK_REP_SEL(k) 0
#define MK_REP_N 1
#endif
#define REPF(k) for (int rep_ = 0; rep_ < (MK_REP_SEL(k) ? MK_REP_N : 1); ++rep_)
#define IN_(k) (lo <= (k) && (k) < hi)
#define PH_BEGIN() P p = p0; { int z_ = 0, t_ = p0.tid, g_ = p0.G, b_ = p0.bid; unsigned l_ = (unsigned)(size_t)p0.lds; asm volatile("" : "+s"(z_), "+v"(t_), "+s"(g_), "+s"(b_), "+s"(l_)); p.ws = p0.ws + z_; p.out = p0.out + z_; p.tid = t_; p.lane = t_ & 63; p.wave = __builtin_amdgcn_readfirstlane(t_ >> 6); p.G = g_; p.bid = b_; p.lds = (LAS unsigned char*)(size_t)l_; } float* const out = p.out; (void)out
#ifdef MK_PROF
#define STAMP(k) do { if (p0.bid == 0 && p0.tid == 0) ((unsigned long long*)(p0.ws + WS_PROF))[(k)] = (unsigned long long)wall_clock64(); } while (0)
#else
#define STAMP(k) do { } while (0)
#endif
#define ENDPH(k) do { if ((k) + 1 < hi) xcd_barrier(bar); STAMP((k) + 1); } while (0)
template <int LAYER> __device__ __forceinline__ void run_layer(const P& p0, const XcdBarrier& bar, const int lo, const int hi, const int mask) {
        constexpr int layer = LAYER, kind = layer % 3, j = layer / 3, pb = 1 + 8 * layer;
        constexpr size_t resA = kind == 0 ? WS_UM : kind == 1 ? WS_OB : WS_GH, resB = kind == 0 ? WS_WOUT + (size_t)j * 2 * MiB : kind == 1 ? WS_WOV : WS_WCO; constexpr int resK = kind == 0 ? 1024 : kind == 1 ? 2048 : 1280;
        if constexpr (kind == 0) {
            if (IN_(pb)) REPF(pb) { PH_BEGIN(); EpiA1 E{p.w<bf16>(WS_U), p.w<bf16>(WS_GV), p.stat(ST_SSQ0 + 2 * layer), p.stat(ST_LNS0 + 2 * j), p.stat(ST_LNQ0 + 2 * j) MK_DRYARG};
                MK_GEMM(EpiA1, E, p.w<bf16>(WS_HB), 1024, p.w<bf16>(WS_WIN + (size_t)j * 4 * MiB), 1024, 1024, 2048); ENDPH(pb); }
            if (IN_(pb + 1)) REPF(pb + 1) { PH_BEGIN(); a2_spatial(p, j, out + O_CV + (size_t)j * 131072); ENDPH(pb + 1); }
        } else if constexpr (kind == 1) {
            if (IN_(pb)) REPF(pb) { PH_BEGIN(); EpiB1 E{p.w<float>(WS_RAW), p.w<bf16>(WS_CQB), p.stat(ST_SSQ0 + 2 * layer), p.stat(ST_KV), p.stat(ST_Q) MK_DRYARG};
                MK_GEMM(EpiB1, E, p.w<bf16>(WS_HB), 1024, p.w<bf16>(WS_WDQKV), 1024, 1024, 768); ENDPH(pb); }
            if (IN_(pb + 1)) REPF(pb + 1) { PH_BEGIN(); b2_kvfinal(p, out + O_MP, out + O_MS);
                EpiB2 E{p.w<bf16>(WS_QF), p.stat(ST_Q), p.w<f32x2>(WS_ROPE)};
                MK_GEMM(EpiB2, E, p.w<bf16>(WS_CQB), 384, p.w<bf16>(WS_WQ), 384, 384, 2560); ENDPH(pb + 1); }
            if (IN_(pb + 2)) REPF(pb + 2) { PH_BEGIN();
                if (mask & 256) b3_attn_prompt(p); if (mask & 512) b3_attn_sample(p);
                ENDPH(pb + 2); }
            if (IN_(pb + 3)) REPF(pb + 3) { PH_BEGIN(); b3_combine(p); ENDPH(pb + 3); }
        } else {
            if (IN_(pb)) REPF(pb) { PH_BEGIN(); EpiC1 E{p.w<bf16>(WS_GATE), p.w<bf16>(WS_XW), p.stat(ST_SSQ0 + 2 * layer)};
                MK_GEMM(EpiC1, E, p.w<bf16>(WS_HB), 1024, p.w<bf16>(WS_WGX), 1024, 1024, 2560); ENDPH(pb); }
            if (IN_(pb + 1)) REPF(pb + 1) { PH_BEGIN(); c2_rglru(p, j, out + O_CP, out + O_CS, out + O_HS, mask); ENDPH(pb + 1); }
            if (IN_(pb + 3)) REPF(pb + 3) { PH_BEGIN(); c5_fixup(p, out + O_HP); ENDPH(pb + 3); }
        }
        if (IN_(pb + 5)) REPF(pb + 5) { PH_BEGIN(); EpiRes E{p.w<bf16>(WS_HB), p.stat(ST_SSQ0 + 2 * layer + 1) MK_DRYARG}; MK_GEMM(EpiRes, E, p.w<bf16>(resA), resK, p.w<bf16>(resB), resK, resK, 1024); ENDPH(pb + 5); }
        if (IN_(pb + 6)) REPF(pb + 6) { PH_BEGIN(); EpiF1 E{p.w<bf16>(WS_ACT), p.stat(ST_SSQ0 + 2 * layer + 1)}; MK_GEMM(EpiF1, E, p.w<bf16>(WS_HB), 1024, p.w<bf16>(WS_WGU + (size_t)layer * WGU_BYTES), 1024, 1024, 5632); ENDPH(pb + 6); }
        if (IN_(pb + 7)) REPF(pb + 7) { PH_BEGIN(); EpiRes E{p.w<bf16>(WS_HB), p.stat(ST_SSQ0 + 2 * layer + 2) MK_DRYARG}; MK_GEMM(EpiRes, E, p.w<bf16>(WS_ACT), DFF, p.w<bf16>(WS_WD + (size_t)layer * WD_BYTES), DFF, DFF, 1024); ENDPH(pb + 7); }
}
__global__ void __launch_bounds__(NWAVES * 64, 2) mk_fwd(Args a) {
    extern __shared__ __attribute__((aligned(16))) unsigned char lds_raw[];
    const int tid_ = threadIdx.x;
    const P p0{InTab{(const float* const __attribute__((address_space(4)))*)__builtin_amdgcn_kernarg_segment_ptr()}, a.out, a.ws, (LAS unsigned char*)lds_raw, tid_, tid_ & 63, __builtin_amdgcn_readfirstlane(tid_ >> 6), (int)gridDim.x, (int)blockIdx.x};
    volatile LAS unsigned* MISC = (volatile LAS unsigned*)(p0.lds + MISC_OFF);
    if (p0.tid < 64) MISC[p0.tid] = 0u;
    __syncthreads();
    XcdBarrier bar = xcd_barrier_post((unsigned*)(a.ws + WS_CTL) + CW_BAR + a.li * XCD_BAR_WORDS, MISC + 8);
    const int lo = a.ph_lo, hi = a.ph_hi, mask = a.mask;
    STAMP(0);
    if (IN_(0)) REPF(0) { PH_BEGIN(); p0_prologue(p, mask); if (mask & 128)
        { const int gt = p.bid * 512 + p.tid, NGT = p.G * 512; const u32x4 z = (u32x4){0u, 0u, 0u, 0u};
          for (int i = gt; i < 128 * 128; i += NGT) p.w<u32x4>(WS_UM + (size_t)MT * 2048)[i] = z;
          for (int i = gt; i < 128 * 256; i += NGT) p.w<u32x4>(WS_OB + (size_t)MT * 4096)[i] = z;
          for (int i = gt; i < 128 * 160; i += NGT) p.w<u32x4>(WS_GH + (size_t)MT * 2560)[i] = z; }
        ENDPH(0); }
    run_layer<0>(p0, bar, lo, hi, mask); run_layer<1>(p0, bar, lo, hi, mask); run_layer<2>(p0, bar, lo, hi, mask); run_layer<3>(p0, bar, lo, hi, mask);
    if (IN_(33)) REPF(33) { PH_BEGIN(); final_norm(p, out + O_YP, out + O_YS); VM_WAIT(); STAMP(34); }
#undef IN_
#undef ENDPH
}

inline void fill_args(Args& a, void* const* d_in, float* out, void* d_ws) { for (int i = 0; i < 36; ++i) a.in[i] = (const float*)d_in[i]; a.out = out; a.ws = (unsigned char*)d_ws; a.mask = -1; }
inline int setup_grid() {
    static int grid = 0;
    if (!grid) { int dev = 0, cus = 0; hipGetDevice(&dev); hipDeviceGetAttribute(&cus, hipDeviceAttributeMultiprocessorCount, dev);
        hipFuncSetAttribute((const void*)mk_fwd, hipFuncAttributeMaxDynamicSharedMemorySize, LDS_BYTES);
        int per_cu = 0; hipOccupancyMaxActiveBlocksPerMultiprocessor(&per_cu, (const void*)mk_fwd, NWAVES * 64, LDS_BYTES); (void)hipGetLastError();
        grid = cus > 0 ? cus : 256; }
    return grid;
}
inline void launch_range(void* const* d_in, float* out, void* d_ws, hipStream_t st, int lo, int hi, int li, int mask = -1) {
    Args a{}; fill_args(a, d_in, out, d_ws); a.ph_lo = lo; a.ph_hi = hi; a.li = li; a.mask = mask;
    hipLaunchKernelGGL(mk_fwd, dim3(setup_grid()), dim3(NWAVES * 64), LDS_BYTES, st, a);
}
}

extern "C" void kernel_launch(void* const* d_in, const int* in_sizes, int n_in, void* d_out, int out_size, void* d_ws, size_t ws_size, hipStream_t stream) {
    hipMemsetAsync(d_ws, 0, mk::CTL_BYTES, stream);
    mk::launch_range(d_in, (float*)d_out, d_ws, stream, 0, mk::NPHASE, 0);
}
```

```cpp
#include <hip/hip_runtime.h>
#include <math.h>
#define LAS __attribute__((address_space(3)))
#define GAS __attribute__((address_space(1)))
namespace pg8 {
#define PG8_LAS __attribute__((address_space(3)))
typedef unsigned short bf16_t;
typedef short bf16x8 __attribute__((ext_vector_type(8)));
typedef float f32x4 __attribute__((ext_vector_type(4)));
typedef unsigned u32x4 __attribute__((ext_vector_type(4)));
constexpr int BM = 256, BK = 64, HALF = 128, HTB = HALF * BK * 2  , STAGE_BYTES = 8 * HTB, NXCD = 8, WGM = 8;
__host__ __device__ __forceinline__ int lds_byte(int r, int c) { const int st = (r >> 4) * 2 + (c >> 5), rr = r & 15, cc = c & 31, ob = rr * 64 + cc * 2; return st * 1024 + (ob ^ (((ob >> 9) & 1) << 5)); }
__host__ __device__ __forceinline__ void stage_rc(int b, int& R, int& C) { const int st = b / 1024, sb = b % 1024, swz = sb ^ (((sb >> 9) & 1) << 5); R = (st >> 1) * 16 + swz / 64; C = (st & 1) * 32 + (swz % 64) / 2; }
__host__ __device__ __forceinline__ int perm32(int rho) { const int n = rho >> 4, i = rho & 15; return 8 * (i >> 2) + 4 * n + (i & 3); }
struct Unit { int pm, pn; };
struct Gemm { const bf16_t* A; const bf16_t* Bt; int lda, ldb, K; };
struct StaticOrder {
    int nM, nN, nwg, G, c;
    __host__ __device__ void init(int M, int N, int G_, int c_) { nM = M / BM; nN = N / BM; nwg = nM * nN; G = G_; c = c_; }
    __host__ __device__ bool next(int i, Unit& u) const {
        const long L = (long)i * G + c; if (L >= nwg) return false;
        int wgid = (int)L; { const int q = nwg / NXCD, r = nwg % NXCD, xcd = wgid % NXCD, off = wgid / NXCD; wgid = (xcd < r ? xcd * (q + 1) : r * (q + 1) + (xcd - r) * q) + off; }
        const int nig = WGM * nN, gid = wgid / nig, fm = gid * WGM, gsz = (nM - fm) < WGM ? (nM - fm) : WGM;
        u.pm = fm + ((wgid % nig) % gsz); u.pn = (wgid % nig) / gsz; return true;
    }
    __device__ __forceinline__ void a_ready(const Unit&) const {}
    __device__ __forceinline__ void done(const Unit&) const {}
};
__device__ __forceinline__ unsigned cvt_pk_bf16(float lo, float hi) { unsigned r; asm volatile("v_cvt_pk_bf16_f32 %0, %1, %2" : "=v"(r) : "v"(lo), "v"(hi)); return r; }
template <class Epi, class Sched, bool ALIGN_EPI = false, bool SP2 = false>
__device__ __forceinline__ void gemm_phase(PG8_LAS unsigned char* lds, const Gemm g, const Sched& S, const Epi& E, const int tid) {
    const int wid = __builtin_amdgcn_readfirstlane(tid >> 6), lane = tid & 63, wr = wid >> 2, wc = wid & 3, fr = lane & 15, fq = lane >> 4;
    const int K = g.K, nt = K / BK, lda = g.lda, ldb = g.ldb;
    unsigned voffA[2], voffB[2];
#pragma unroll
    for (int i = 0; i < 2; ++i) { int R, C; stage_rc(tid * 16 + i * 8192, R, C); const int Rb = Epi::PERM ? ((R & ~31) + perm32(R & 31)) : R;
        voffA[i] = (unsigned)(R * lda + C) * 2u; voffB[i] = (unsigned)(Rb * ldb + C) * 2u; }
    const size_t kstep = (size_t)(BK * 2);
    const size_t hstepA = (size_t)HALF * lda * 2, hstepB = (size_t)HALF * ldb * 2;
    const size_t tstepA = 2 * hstepA, tstepB = 2 * hstepB;
    const unsigned ldsw = (unsigned)wid * 1024u;
    const int aoff = lds_byte(wr * 64 + fr, fq * 8), boff = lds_byte(wc * 32 + fr, fq * 8);
#define PG8_SA(b, h) (((b) * 2 + (h)) * HTB)
#define PG8_SB(b, h) ((4 + (b) * 2 + (h)) * HTB)
#define PG8_STAGE(bufoff, gbase, voff) do { _Pragma("unroll") for (int _i = 0; _i < 2; ++_i) \
        __builtin_amdgcn_global_load_lds((const unsigned*)((const char*)(gbase) + (voff)[_i]), (PG8_LAS unsigned*)(lds + (bufoff) + ldsw + _i * 8192), 16, 0, 0); } while (0)
#define PG8_LDA(dst, b, h) do { _Pragma("unroll") for (int m = 0; m < 4; ++m) _Pragma("unroll") for (int k = 0; k < 2; ++k) dst[m][k] = *(const PG8_LAS bf16x8*)(lds + PG8_SA(b, h) + aoff + m * 2048 + k * 1024); } while (0)
#define PG8_LDB(dst, b, h) do { _Pragma("unroll") for (int n = 0; n < 2; ++n) _Pragma("unroll") for (int k = 0; k < 2; ++k) dst[n][k] = *(const PG8_LAS bf16x8*)(lds + PG8_SB(b, h) + boff + n * 2048 + k * 1024); } while (0)
#define PG8_MMA(ai, bj, At, Bt) do { __builtin_amdgcn_s_setprio(1); _Pragma("unroll") for (int m = 0; m < 4; ++m) _Pragma("unroll") for (int n = 0; n < 2; ++n) _Pragma("unroll") for (int k = 0; k < 2; ++k) \
        acc[ai][bj][m][n] = __builtin_amdgcn_mfma_f32_16x16x32_bf16(Bt[n][k], At[m][k], acc[ai][bj][m][n], 0, 0, 0); __builtin_amdgcn_s_setprio(0); } while (0)
#define PG8_WAIT_V(n) asm volatile("s_waitcnt vmcnt(" #n ")" ::: "memory")
#define PG8_WAIT_L(n) asm volatile("s_waitcnt lgkmcnt(" #n ")" ::: "memory")
#define PG8_BAR __builtin_amdgcn_s_barrier()
#define PG8_SCHED __builtin_amdgcn_sched_barrier(0)
    Unit cur, nxt; int ui = 0;
    if (!S.next(0, cur)) return;
    f32x4 acc[2][2][4][2];
    E.init(acc, cur, wr, wc, fr, fq);
    bf16x8 At[4][2], B0[2][2], B1[2][2];
    const char* cA = (const char*)g.A + (size_t)cur.pm * tstepA; const char* cB = (const char*)g.Bt + (size_t)cur.pn * tstepB;
    S.a_ready(cur);
    if constexpr (SP2) {
        PG8_STAGE(PG8_SB(0, 0), cB, voffB); PG8_STAGE(PG8_SB(0, 1), cB + hstepB, voffB); PG8_STAGE(PG8_SA(0, 0), cA, voffA); PG8_STAGE(PG8_SA(0, 1), cA + hstepA, voffA);
        if (wr == 1) PG8_BAR;
        PG8_WAIT_V(2); PG8_BAR;
        PG8_STAGE(PG8_SB(1, 0), cB + kstep, voffB); PG8_STAGE(PG8_SA(1, 0), cA + kstep, voffA); PG8_STAGE(PG8_SB(1, 1), cB + hstepB + kstep, voffB);
        PG8_WAIT_V(6); PG8_BAR;
    } else {
        PG8_STAGE(PG8_SB(0, 0), cB, voffB); PG8_STAGE(PG8_SA(0, 0), cA, voffA); PG8_STAGE(PG8_SB(0, 1), cB + hstepB, voffB); PG8_STAGE(PG8_SA(0, 1), cA + hstepA, voffA);
        if (wr == 1) PG8_BAR;
        PG8_WAIT_V(4); PG8_BAR;
        PG8_STAGE(PG8_SB(1, 0), cB + kstep, voffB); PG8_STAGE(PG8_SA(1, 0), cA + kstep, voffA); PG8_STAGE(PG8_SB(1, 1), cB + hstepB + kstep, voffB);
        PG8_WAIT_V(6); PG8_BAR;
    }
    for (;;) {
        const bool has_next = S.next(ui + 1, nxt);
        const char* nA = has_next ? (const char*)g.A + (size_t)nxt.pm * tstepA : cA; const char* nB = has_next ? (const char*)g.Bt + (size_t)nxt.pn * tstepB : cB;
        for (int t = 0; t < nt; t += 2) {
            const bool last = (t == nt - 2);
            const char* a1 = cA + (size_t)(t + 1) * kstep;
            const char* a2 = last ? nA : cA + (size_t)(t + 2) * kstep; const char* b2 = last ? nB : cB + (size_t)(t + 2) * kstep;
            const char* a3 = a2 + kstep; const char* b3 = b2 + kstep;
            if (last && has_next) S.a_ready(nxt);
            if constexpr (SP2) {
            PG8_LDB(B0, 0, 0); PG8_LDB(B1, 0, 1); PG8_SCHED; PG8_LDA(At, 0, 0); PG8_STAGE(PG8_SA(1, 1), a1 + hstepA, voffA);
            PG8_WAIT_V(8); PG8_WAIT_L(0); PG8_BAR; PG8_MMA(0, 0, At, B0); PG8_MMA(0, 1, At, B1); PG8_BAR; PG8_SCHED;
            PG8_LDA(At, 0, 1); PG8_STAGE(PG8_SB(0, 0), b2, voffB); PG8_STAGE(PG8_SB(0, 1), b2 + hstepB, voffB); PG8_STAGE(PG8_SA(0, 0), a2, voffA);
            PG8_WAIT_V(8); PG8_WAIT_L(0); PG8_BAR; PG8_MMA(1, 0, At, B0); PG8_MMA(1, 1, At, B1); PG8_BAR; PG8_SCHED;
            PG8_LDB(B0, 1, 0); PG8_LDB(B1, 1, 1); PG8_SCHED; PG8_LDA(At, 1, 0); PG8_STAGE(PG8_SA(0, 1), a2 + hstepA, voffA);
            PG8_WAIT_V(8); PG8_WAIT_L(0); PG8_BAR; PG8_MMA(0, 0, At, B0); PG8_MMA(0, 1, At, B1); PG8_BAR; PG8_SCHED;
            PG8_LDA(At, 1, 1); PG8_STAGE(PG8_SB(1, 0), b3, voffB); PG8_STAGE(PG8_SB(1, 1), b3 + hstepB, voffB); PG8_STAGE(PG8_SA(1, 0), a3, voffA);
            PG8_WAIT_V(8); PG8_WAIT_L(0); PG8_BAR; PG8_MMA(1, 0, At, B0); PG8_MMA(1, 1, At, B1); PG8_BAR; PG8_SCHED;
            } else {
            PG8_LDB(B0, 0, 0); PG8_SCHED; PG8_LDA(At, 0, 0); PG8_STAGE(PG8_SA(1, 1), a1 + hstepA, voffA);
            PG8_WAIT_L(8); PG8_BAR; PG8_WAIT_L(0); PG8_MMA(0, 0, At, B0); PG8_BAR; PG8_SCHED;
            PG8_LDB(B1, 0, 1); PG8_STAGE(PG8_SB(0, 0), b2, voffB);
            PG8_BAR; PG8_WAIT_L(0); PG8_MMA(0, 1, At, B1); PG8_BAR;
            PG8_LDA(At, 0, 1); PG8_STAGE(PG8_SA(0, 0), a2, voffA);
            PG8_BAR; PG8_WAIT_L(0); PG8_MMA(1, 0, At, B0); PG8_BAR; PG8_SCHED;
            PG8_STAGE(PG8_SB(0, 1), b2 + hstepB, voffB);
            PG8_WAIT_V(6); PG8_BAR; PG8_MMA(1, 1, At, B1); PG8_BAR;
            PG8_LDB(B0, 1, 0); PG8_SCHED; PG8_LDA(At, 1, 0); PG8_STAGE(PG8_SA(0, 1), a2 + hstepA, voffA);
            PG8_WAIT_L(8); PG8_BAR; PG8_WAIT_L(0); PG8_MMA(0, 0, At, B0); PG8_BAR; PG8_SCHED;
            PG8_LDB(B1, 1, 1); PG8_STAGE(PG8_SB(1, 0), b3, voffB);
            PG8_BAR; PG8_WAIT_L(0); PG8_MMA(0, 1, At, B1); PG8_BAR;
            PG8_LDA(At, 1, 1); PG8_STAGE(PG8_SA(1, 0), a3, voffA);
            PG8_BAR; PG8_WAIT_L(0); PG8_MMA(1, 0, At, B0); PG8_BAR; PG8_SCHED;
            PG8_STAGE(PG8_SB(1, 1), b3 + hstepB, voffB);
            PG8_WAIT_V(6); PG8_BAR; PG8_MMA(1, 1, At, B1); PG8_BAR;
            }
        }
        if constexpr (ALIGN_EPI) { if (wr == 0) PG8_BAR; }
        if constexpr (!Epi::AFTER_DRAIN) { E(acc, cur, wr, wc, fr, fq); S.done(cur); }
        if (!has_next) break;
        E.init(acc, nxt, wr, wc, fr, fq);
        cur = nxt; cA = nA; cB = nB; ++ui;
        if constexpr (ALIGN_EPI) { if (wr == 1) PG8_BAR; }
    }
    PG8_WAIT_V(0);
    if constexpr (!ALIGN_EPI) { if (wr == 0) PG8_BAR; }
    PG8_BAR;
    if constexpr (Epi::AFTER_DRAIN) { E.fused(acc, cur, wr, wc, fr, fq, lds, wid, lane); S.done(cur); }
#undef PG8_SA
#undef PG8_SB
#undef PG8_STAGE
#undef PG8_LDA
#undef PG8_LDB
#undef PG8_MMA
#undef PG8_WAIT_V
#undef PG8_WAIT_L
#undef PG8_BAR
#undef PG8_SCHED
}

}

namespace mk {
using pg8::f32x4; using pg8::bf16x8; using pg8::u32x4; using pg8::cvt_pk_bf16;
typedef unsigned short bf16;
typedef unsigned u32x2 __attribute__((ext_vector_type(2)));
typedef short s16x4 __attribute__((ext_vector_type(4)));
typedef float f32x2 __attribute__((ext_vector_type(2)));
typedef GAS unsigned gu32;
#define RLX_AGENT __ATOMIC_RELAXED, __HIP_MEMORY_SCOPE_AGENT
#define XB_TMO      128
#define XB_XCNT(j)  (256  + 64 * (j))
#define XB_XSUB(j)  (1280 + 64 * (j))
#define XB_XGEN(j)  (2304 + 64 * (j))
#define XB_TOP      3328
#define XB_TOPGEN   3392
#define XCD_BAR_WORDS 3456
#define XB_SPIN_CAP (1u << 18)

__device__ __forceinline__ unsigned xb_ld(unsigned* p)              { return __hip_atomic_load(p, __ATOMIC_RELAXED, __HIP_MEMORY_SCOPE_AGENT); }
__device__ __forceinline__ unsigned xb_add(unsigned* p, unsigned v) { return __hip_atomic_fetch_add(p, v, __ATOMIC_RELAXED, __HIP_MEMORY_SCOPE_AGENT); }
__device__ __forceinline__ unsigned xb_xcc_id() { return (unsigned)__builtin_amdgcn_s_getreg((3 << 11) | 20) & 0xFu; }
#define XB_SPIN(cond, bar) do { unsigned _sp = 0; while (cond) { __builtin_amdgcn_s_sleep(1); \
    if ((++_sp & 255u) == 0u) { if (xb_ld(&(bar)[XB_TMO])) break; if (_sp > XB_SPIN_CAP) { atomicAdd(&(bar)[XB_TMO], 1u); break; } } } } while (0)

struct XcdBarrier {
    unsigned* bar; unsigned x;
    volatile LAS unsigned* st;
};

__device__ __forceinline__ XcdBarrier xcd_barrier_post(unsigned* bar, volatile LAS unsigned* st) {
    XcdBarrier b; b.bar = bar; b.x = xb_xcc_id(); b.st = st;
    if (threadIdx.x == 0) (void)xb_add(&bar[XB_XCNT(b.x)], 1u);
    return b;
}
__device__ __forceinline__ void xcd_barrier_complete(unsigned* bar, unsigned x, unsigned& nloc, unsigned& nx) {
    const unsigned G = gridDim.x * gridDim.y * gridDim.z;
    unsigned sum, cnt, mine, sp = 0u;
    for (;;) {
        sum = 0u; cnt = 0u; mine = 0u;
#pragma unroll
        for (unsigned j = 0; j < 16; ++j) { const unsigned c = xb_ld(&bar[XB_XCNT(j)]); sum += c; cnt += (c > 0u) ? 1u : 0u; mine = (j == x) ? c : mine; }
        if (sum == G) break;
        __builtin_amdgcn_s_sleep(1);
        if ((++sp & 255u) == 0u) { if (xb_ld(&bar[XB_TMO])) break; if (sp > XB_SPIN_CAP) { atomicAdd(&bar[XB_TMO], 1u); break; } }
    }
    nloc = mine > 0u ? mine : 1u; nx = cnt > 0u ? cnt : 1u;
}

__device__ __forceinline__ void xcd_barrier(const XcdBarrier& b) {
    asm volatile("s_waitcnt vmcnt(0)" ::: "memory");
    __syncthreads();
    if (threadIdx.x == 0) {
        unsigned* bar = b.bar;
        __builtin_amdgcn_s_waitcnt(0);
        unsigned nloc = b.st[0], nx = b.st[1];
        if (nloc == 0u) { xcd_barrier_complete(bar, b.x, nloc, nx); b.st[0] = nloc; b.st[1] = nx; }
        const unsigned old = xb_add(&bar[XB_XSUB(b.x)], 1u);
        const unsigned gen = old / nloc;
        if (old + 1u == (gen + 1u) * nloc) {
            __builtin_amdgcn_fence(__ATOMIC_RELEASE, "agent");
            asm volatile("s_waitcnt vmcnt(0)" ::: "memory");
            const unsigned og = xb_add(&bar[XB_TOP], 1u);
            const unsigned tg = og / nx;
            if (og + 1u == (tg + 1u) * nx) xb_add(&bar[XB_TOPGEN], 1u);
            else XB_SPIN(xb_ld(&bar[XB_TOPGEN]) == tg, bar);
            __builtin_amdgcn_fence(__ATOMIC_ACQUIRE, "agent");
            xb_add(&bar[XB_XGEN(b.x)], 1u);
            asm volatile("s_waitcnt vmcnt(0)" ::: "memory");
        } else {
            XB_SPIN(xb_ld(&bar[XB_XGEN(b.x)]) == gen, bar);
            __builtin_amdgcn_fence(__ATOMIC_ACQUIRE, "agent");
            asm volatile("s_waitcnt vmcnt(0)" ::: "memory");
        }
    }
    __syncthreads();
}


constexpr int MP = 16384, MS = 128, MT = MP + MS, MR = 16640;
constexpr int D = 1024, DFF = 2816, NWAVES = 8;
constexpr float RMS_EPS = 1e-6f, LN_EPS = 1e-5f;
constexpr float MLA_SCALE = 0.07216878364870322f;
constexpr size_t MiB = 1u << 20;
constexpr size_t WS_CTL = 0, CTL_BYTES = 3 * MiB;
constexpr int CW_BAR = 4096;
constexpr size_t ST_OFF = 65536, ST_STRIDE = (size_t)MR * 8;
constexpr int ST_SSQ0 = 0  , ST_LNS0 = 9, ST_LNQ0 = 10  , ST_KV = 13, ST_Q = 14, NSTAT = 15;
static_assert(ST_OFF + NSTAT * ST_STRIDE <= CTL_BYTES, "stats inside CTL");
constexpr size_t WS_WGU = 3 * MiB, WGU_BYTES = 11 * MiB, WS_WD = 47 * MiB, WD_BYTES = 5767168, WS_WIN = 69 * MiB, WS_WOUT = 77 * MiB, WS_WS = 81 * MiB,
                 WS_WDQKV = 82 * MiB, WS_WQ = 84 * MiB, WS_WOV = 86 * MiB, WS_WGX = 90 * MiB, WS_WAT = 95 * MiB, WS_WIT = 95 * MiB + 512 * 1024, WS_WCO = 96 * MiB, WS_ROPE = 99 * MiB;
constexpr size_t WS_H = 100 * MiB, WS_HB = 165 * MiB, WS_U = 198 * MiB, WS_GV = 231 * MiB, WS_UM = 264 * MiB, WS_ACT = 297 * MiB, WS_RAW = 387 * MiB, WS_CQB = 436 * MiB,
                 WS_QF = 449 * MiB, WS_KVB = 531 * MiB, WS_OB = 542 * MiB, WS_PART = 607 * MiB, WS_PML = 623 * MiB, WS_GATE = 624 * MiB, WS_XW = 665 * MiB, WS_AA = 747 * MiB, WS_BB = 829 * MiB,
                 WS_AGG = 911 * MiB, WS_GH = 914 * MiB, WS_PROF = 955 * MiB, WS_MK_END = 956 * MiB;
constexpr int RING_BYTES = 131072, LDS_BYTES = 147456, MISC_OFF = LDS_BYTES - 256;
constexpr size_t O_YP = 0, O_YS = 16777216, O_CV = 16908288, O_MP = 17170432, O_MS = 22413312, O_HP = 22454272, O_HS = 22464512, O_CP = 22505472, O_CS = 22536192, O_END = 22659072;

__device__ __forceinline__ float fast_sigmoid_l2(float t) { return __builtin_amdgcn_rcpf(1.0f + __builtin_amdgcn_exp2f(-t)); }
__device__ __forceinline__ float gelu_tanh_f(float x) { return x * fast_sigmoid_l2(2.302208198f * (x + 0.044715f * x * x * x)); }
__device__ __forceinline__ float silu_f(float x) { return x * fast_sigmoid_l2(1.4426950409f * x); }
__device__ __forceinline__ unsigned f2bf(float f) { unsigned u = __builtin_bit_cast(unsigned, f); return (u + 0x7fffu + ((u >> 16) & 1u)) >> 16; }
__device__ __forceinline__ unsigned pk2(float lo, float hi) { return f2bf(lo) | (f2bf(hi) << 16); }
__device__ __forceinline__ float bf2f(unsigned short b) { return __builtin_bit_cast(float, (unsigned)b << 16); }
__device__ __forceinline__ float bflo(unsigned w) { return __builtin_bit_cast(float, w << 16); }
__device__ __forceinline__ float bfhi(unsigned w) { return __builtin_bit_cast(float, w & 0xffff0000u); }
constexpr float ST_SCALE = 16777216.0f, ST_INV = 1.0f / 16777216.0f;
__device__ __forceinline__ void stat_add(long long* p, float v) { atomicAdd((unsigned long long*)p, (unsigned long long)(long long)__float2ll_rn(v * ST_SCALE)); }
__device__ __forceinline__ void stat_set(long long* p, float v) { *p = (long long)__float2ll_rn(v * ST_SCALE); }
__device__ __forceinline__ float stat_get(const long long* p) { return (float)(*p) * ST_INV; }
#define LDS_WAIT() asm volatile("s_waitcnt lgkmcnt(0)" ::: "memory")
#define VM_WAIT() asm volatile("s_waitcnt vmcnt(0)" ::: "memory")

struct InTab { const float* const __attribute__((address_space(4)))* t; __device__ __forceinline__ const float* operator[](int i) const { return t[i]; } };
struct P {
    InTab in; float* out; unsigned char* ws;
    LAS unsigned char* lds; int tid, lane, wave, G, bid;
    __device__ __forceinline__ long long* stat(int a) const { return (long long*)(ws + ST_OFF + (size_t)a * ST_STRIDE); }
    template <class T> __device__ __forceinline__ T* w(size_t off) const { return (T*)(ws + off); }
};
}
namespace mk {
struct TrJob { const float* src; int ldsrc, K, N; bf16* dst; int lddst; const float* gain; int kind, off; };
__device__ __forceinline__ int tr_rowmap(int kind, int off, int n) { return kind == 1 ? ((n >> 7) * 256 + (n & 127) + off) : (off + n); }
__device__ __forceinline__ void tr_item(const TrJob& j, LAS float* scr, int item, int lane) {
    const int nblk = j.N / 32, kb = item / nblk, nb = item % nblk, k0 = 64 * kb, n0 = 32 * nb;
    const float* src = j.src + (size_t)(k0 + (lane >> 5)) * j.ldsrc + n0 + (lane & 31); const size_t rstep = (size_t)2 * j.ldsrc;
    float v[32];
#pragma unroll
    for (int i = 0; i < 32; ++i) v[i] = src[i * rstep];
    if (j.gain) { const float* gp = j.gain + k0 + (lane >> 5); float g[32];
#pragma unroll
        for (int i = 0; i < 32; ++i) g[i] = gp[2 * i];
#pragma unroll
        for (int i = 0; i < 32; ++i) v[i] *= g[i]; }
#pragma unroll
    for (int i = 0; i < 32; ++i) scr[(2 * i + (lane >> 5)) * 33 + (lane & 31)] = v[i];
    LDS_WAIT(); asm volatile("" ::: "memory");
    const int c = lane & 7;
#pragma unroll
    for (int jj = 0; jj < 4; ++jj) { const int n = (lane >> 3) + 8 * jj; const LAS float* s = scr + (8 * c) * 33 + n;
        u32x4 o; o.x = pk2(s[0], s[33]); o.y = pk2(s[66], s[99]); o.z = pk2(s[132], s[165]); o.w = pk2(s[198], s[231]);
        *(u32x4*)(j.dst + (size_t)tr_rowmap(j.kind, j.off, n0 + n) * j.lddst + k0 + 8 * c) = o; }
    LDS_WAIT(); asm volatile("" ::: "memory");
}
constexpr int NJOBS = 24;
__device__ __forceinline__ TrJob get_job(const P& p, int jid) {
    TrJob j; j.gain = nullptr; j.kind = 0; j.off = 0; j.src = nullptr; j.dst = nullptr; j.ldsrc = 0; j.K = 0; j.N = 0; j.lddst = 0;
    if (jid < 12) { const int l = jid / 3, t = jid % 3;
        if (t < 2) { j.src = p.in[33 + t] + (size_t)l * D * DFF; j.ldsrc = DFF; j.K = D; j.N = DFF; j.dst = p.w<bf16>(WS_WGU + l * WGU_BYTES); j.lddst = D; j.gain = p.in[7] + l * D; j.kind = 1; j.off = 128 * t; }
        else { j.src = p.in[35] + (size_t)l * DFF * D; j.ldsrc = D; j.K = DFF; j.N = D; j.dst = p.w<bf16>(WS_WD + l * WD_BYTES); j.lddst = DFF; }
    } else if (jid < 16) { const int a = (jid - 12) >> 1;
        if (((jid - 12) & 1) == 0) { j.src = p.in[9] + (size_t)a * D * 2048; j.ldsrc = 2048; j.K = D; j.N = 2048; j.dst = p.w<bf16>(WS_WIN + a * 4 * MiB); j.lddst = D; j.gain = p.in[6] + (3 * a) * D; }
        else { j.src = p.in[14] + (size_t)a * D * D; j.ldsrc = D; j.K = D; j.N = D; j.dst = p.w<bf16>(WS_WOUT + a * 2 * MiB); j.lddst = D; }
    } else if (jid == 16) { j.src = p.in[15]; j.ldsrc = 384; j.K = D; j.N = 384; j.dst = p.w<bf16>(WS_WDQKV); j.lddst = D; j.gain = p.in[6] + D; j.off = 256; }
    else if (jid == 17) { j.src = p.in[18]; j.ldsrc = 320; j.K = D; j.N = 256; j.dst = p.w<bf16>(WS_WDQKV); j.lddst = D; j.gain = p.in[6] + D; j.off = 0; }
    else if (jid == 18) { j.src = p.in[18] + 256; j.ldsrc = 320; j.K = D; j.N = 64; j.dst = p.w<bf16>(WS_WDQKV); j.lddst = D; j.gain = p.in[6] + D; j.off = 640; }
    else if (jid == 19) { j.src = p.in[24]; j.ldsrc = 1280; j.K = D; j.N = 1280; j.dst = p.w<bf16>(WS_WGX); j.lddst = D; j.gain = p.in[6] + 2 * D; j.off = 0; }
    else if (jid == 20) { j.src = p.in[23]; j.ldsrc = 1280; j.K = D; j.N = 1280; j.dst = p.w<bf16>(WS_WGX); j.lddst = D; j.gain = p.in[6] + 2 * D; j.off = 1280; }
    else if (jid == 21) { j.src = p.in[32]; j.ldsrc = D; j.K = 1280; j.N = D; j.dst = p.w<bf16>(WS_WCO); j.lddst = 1280; }
    else if (jid == 22) { j.src = p.in[27]; j.ldsrc = 128; j.K = 128; j.N = 128; j.dst = p.w<bf16>(WS_WAT); j.lddst = 128; j.kind = 2; }
    else { j.src = p.in[29]; j.ldsrc = 128; j.K = 128; j.N = 128; j.dst = p.w<bf16>(WS_WIT); j.lddst = 128; j.kind = 2; }
    return j;
}
__device__ __forceinline__ int job_items(const TrJob& j) { return j.kind == 2 ? 80 : (j.K / 64) * (j.N / 32); }

__device__ __forceinline__ void p0_prologue(const P& p, const int mask) {
    LAS float* scr = (LAS float*)(p.lds + p.wave * 16384);
    const int gw = p.bid * NWAVES + p.wave, NGW = p.G * NWAVES, lane = p.lane;
    const int gt = p.bid * (NWAVES * 64) + p.tid, NGT = p.G * NWAVES * 64;
    if (mask & 1) {
    {
        int base = 0;
        for (int jid = 0; jid < NJOBS; ++jid) {
            TrJob j = get_job(p, jid); const int nit = job_items(j);
            int first = (gw - base % NGW + NGW) % NGW;
            for (int it = first; it < nit; it += NGW) {
                if (j.kind == 2) { TrJob b = j; const int blk = it >> 3; b.src = j.src + (size_t)blk * 16384; b.dst = j.dst + (size_t)blk * 16384; b.kind = 0; tr_item(b, scr, it & 7, lane); }
                else tr_item(j, scr, it, lane);
            }
            base += nit;
        }
    }
    }
    if (mask & 2) {
    { u32x4* z = (u32x4*)(p.w<bf16>(WS_WDQKV) + (size_t)704 * D); for (int i = gt; i < 64 * D / 8; i += NGT) z[i] = (u32x4){0u, 0u, 0u, 0u}; }
    }
    if (mask & 4) {
    for (int i = gt; i < 2 * 8 * 128 * 16; i += NGT) {
        const int s0 = (i & 15) * 8, t = (i >> 4) & 127, jg = i >> 11; const float* src = p.in[12] + (size_t)jg * 16384 + t * 128 + s0;
        const f32x4 v0 = *(const f32x4*)src, v1 = *(const f32x4*)(src + 4); unsigned w[4];
#pragma unroll
        for (int e = 0; e < 2; ++e) { w[e] = pk2((s0 + 2 * e <= t) ? v0[2 * e] : 0.f, (s0 + 2 * e + 1 <= t) ? v0[2 * e + 1] : 0.f); w[2 + e] = pk2((s0 + 4 + 2 * e <= t) ? v1[2 * e] : 0.f, (s0 + 5 + 2 * e <= t) ? v1[2 * e + 1] : 0.f); }
        const int j = jg >> 3, g = jg & 7;
        *(u32x4*)(p.w<bf16>(WS_WS + (size_t)j * 262144) + ((size_t)g * 128 + t) * 128 + s0) = (u32x4){w[0], w[1], w[2], w[3]};
    }
    }
    if (mask & 8) {
    for (int i = gt; i < 2052 * 32; i += NGT) { const int tp = i >> 5, fi = i & 31, pos = tp < 2048 ? tp : 16384 + (tp - 2048);
        const float inv = 1.0f / powf(10000.0f, (float)(2 * fi) / 64.0f); const float ang = (float)pos * inv;
        p.w<f32x2>(WS_ROPE)[i] = (f32x2){cosf(ang), sinf(ang)}; }
    }
    if (mask & 16) {
    { bf16* HB = p.w<bf16>(WS_HB); long long* ssq = p.stat(ST_SSQ0);
      auto rowp = [&](int m) -> const float* { return m < MP ? p.in[0] + (size_t)m * D : p.in[1] + (size_t)((m < MT ? m : MT - 1) - MP) * D; };
      f32x4 v[4], vn[4];
      if (gw < MR) { const float* r = rowp(gw);
#pragma unroll
        for (int jj = 0; jj < 4; ++jj) v[jj] = *(const f32x4*)(r + 4 * lane + 256 * jj); }
      for (int m = gw; m < MR; m += NGW) {
        { const float* r = rowp(m + NGW < MR ? m + NGW : m);
#pragma unroll
          for (int jj = 0; jj < 4; ++jj) vn[jj] = *(const f32x4*)(r + 4 * lane + 256 * jj); }
        float s = 0.f;
#pragma unroll
        for (int jj = 0; jj < 4; ++jj) { if (m >= MT) v[jj] = (f32x4){0.f, 0.f, 0.f, 0.f};
            s += (v[jj].x * v[jj].x + v[jj].y * v[jj].y) + (v[jj].z * v[jj].z + v[jj].w * v[jj].w); }
#pragma unroll
        for (int o = 1; o < 64; o <<= 1) s += __shfl_xor(s, o);
#pragma unroll
        for (int jj = 0; jj < 4; ++jj) { const int c = 4 * lane + 256 * jj;
            *(u32x2*)(HB + (size_t)m * D + c) = (u32x2){pk2(v[jj].x, v[jj].y), pk2(v[jj].z, v[jj].w)}; }
        if (lane == 0) stat_set(ssq + m, s);
#pragma unroll
        for (int jj = 0; jj < 4; ++jj) v[jj] = vn[jj];
      } }
    }
    if (mask & 32) {
    { const float* wuq = p.in[17]; const float* wuk = p.in[20]; const float* qn = p.in[16]; bf16* Wq = p.w<bf16>(WS_WQ);
      LAS float* Qs = (LAS float*)p.lds; LAS float* Ks = (LAS float*)(p.lds + 64 * 132 * 4);
      for (int it = p.bid; it < 192; it += p.G) {
        const int h = it / 24, kb = (it >> 2) % 6, cq = it & 3, k0 = 64 * kb;
        __syncthreads();
#pragma unroll
        for (int q = 0; q < 4; ++q) { const int idx = p.tid + 512 * q, row = idx >> 5, c4 = idx & 31;
            *(LAS f32x4*)(Qs + row * 132 + c4 * 4) = *(const f32x4*)(wuq + (size_t)(k0 + row) * 1536 + h * 192 + c4 * 4);
            *(LAS f32x4*)(Ks + row * 132 + c4 * 4) = *(const f32x4*)(wuk + (size_t)(cq * 64 + row) * 1024 + h * 128 + c4 * 4); }
        __syncthreads();
        const int cl = p.wave * 8, c0 = cq * 64 + cl; float acc[8];
#pragma unroll
        for (int cc = 0; cc < 8; ++cc) acc[cc] = 0.f;
#pragma unroll 4
        for (int n4 = 0; n4 < 32; ++n4) { const f32x4 bv = *(const LAS f32x4*)(Qs + lane * 132 + n4 * 4);
#pragma unroll
            for (int cc = 0; cc < 8; ++cc) { const f32x4 av = *(const LAS f32x4*)(Ks + (cl + cc) * 132 + n4 * 4); acc[cc] += (av.x * bv.x + av.y * bv.y) + (av.z * bv.z + av.w * bv.w); } }
        const float g = qn[k0 + lane];
#pragma unroll
        for (int cc = 0; cc < 8; ++cc) Wq[(size_t)(320 * h + c0 + cc) * 384 + k0 + lane] = (bf16)f2bf(acc[cc] * g);
      }
      for (int r = gw; r < 512; r += NGW) { const int h = r >> 6, ie = r & 63, i = ie >> 1, e = ie & 1;
#pragma unroll
        for (int kk = 0; kk < 6; ++kk) { const int k = lane + 64 * kk; Wq[(size_t)(320 * h + 256 + ie) * 384 + k] = (bf16)f2bf(wuq[(size_t)k * 1536 + h * 192 + 128 + 32 * e + i] * qn[k]); } } }
    }
    if (mask & 64) {
    { const float* wuv = p.in[21]; const float* wo = p.in[22]; bf16* Wov = p.w<bf16>(WS_WOV);
      LAS float* Os = (LAS float*)p.lds;
      for (int it = p.bid; it < 256; it += p.G) { const int h = it >> 5, cg = (it >> 2) & 7, nb = it & 3, c0 = cg * 32 + p.wave * 4, n = nb * 256 + lane * 4;
        __syncthreads();
#pragma unroll
        for (int q = 0; q < 16; ++q) { const int idx = p.tid + 512 * q, v = idx >> 6, c4 = idx & 63; *(LAS f32x4*)(Os + v * 256 + c4 * 4) = *(const f32x4*)(wo + (size_t)(h * 128 + v) * D + nb * 256 + c4 * 4); }
        __syncthreads();
        f32x4 acc[4];
#pragma unroll
        for (int cc = 0; cc < 4; ++cc) acc[cc] = (f32x4){0.f, 0.f, 0.f, 0.f};
#pragma unroll 8
        for (int v = 0; v < 128; ++v) { const f32x4 b = *(const LAS f32x4*)(Os + v * 256 + lane * 4);
#pragma unroll
            for (int cc = 0; cc < 4; ++cc) { const float a = wuv[(size_t)(c0 + cc) * 1024 + h * 128 + v]; acc[cc] += b * a; } }
#pragma unroll
        for (int jn = 0; jn < 4; ++jn) *(u32x2*)(Wov + (size_t)(n + jn) * 2048 + h * 256 + c0) = (u32x2){pk2(acc[0][jn], acc[1][jn]), pk2(acc[2][jn], acc[3][jn])};
      }
      __syncthreads(); }
    }
}
}
namespace mk {
#ifdef MK_DRYPROBE
#define MK_DRY(E) ((E).dry)
#define MK_DRYFIELD int dry;
#else
#define MK_DRY(E) 0
#define MK_DRYFIELD
#endif
typedef const f32x4 (&AccRef)[2][2][4][2];
__device__ __forceinline__ float quad_red(float v) { v += __shfl_xor(v, 16); v += __shfl_xor(v, 32); return v; }
__device__ __forceinline__ u32x4 pack8(const f32x4 a, const f32x4 b) { u32x4 w; w.x = cvt_pk_bf16(a[0], a[1]); w.y = cvt_pk_bf16(a[2], a[3]); w.z = cvt_pk_bf16(b[0], b[1]); w.w = cvt_pk_bf16(b[2], b[3]); return w; }
__device__ __forceinline__ float sumsq8(const f32x4 a, const f32x4 b) { return ((a[0] * a[0] + a[1] * a[1]) + (a[2] * a[2] + a[3] * a[3])) + ((b[0] * b[0] + b[1] * b[1]) + (b[2] * b[2] + b[3] * b[3])); }
__device__ __forceinline__ float sum8(const f32x4 a, const f32x4 b) { return ((a[0] + a[1]) + (a[2] + a[3])) + ((b[0] + b[1]) + (b[2] + b[3])); }
#define MK_EPI_CALL() \
    __device__ __forceinline__ void operator()(AccRef acc, const pg8::Unit& u, int wr, int wc, int fr, int fq) const { \
        Pre pre_[2][4]; \
        _Pragma("unroll") for (int ai = 0; ai < 2; ++ai) _Pragma("unroll") for (int m = 0; m < 4; ++m) pre_[ai][m] = pre(u.pm * 256 + ai * 128 + wr * 64 + m * 16 + fr, u.pn, wc, fq); \
        _Pragma("unroll") for (int ai = 0; ai < 2; ++ai) _Pragma("unroll") for (int m = 0; m < 4; ++m) \
            rgp(u.pm * 256 + ai * 128 + wr * 64 + m * 16 + fr, u.pn, wc, fq, acc[ai][0][m][0], acc[ai][0][m][1], acc[ai][1][m][0], acc[ai][1][m][1], pre_[ai][m]); } \
    __device__ __forceinline__ void rgq(int r, int pn, int wc, int fq, f32x4 a0, f32x4 b0, f32x4 a1, f32x4 b1, const Pre pv) const { rgp(r, pn, wc, fq, a0, b0, a1, b1, pv); }
#define MK_EPI_CALL_DENSE() \
    __device__ __forceinline__ void operator()(AccRef acc, const pg8::Unit& u, int wr, int wc, int fr, int fq) const { \
        Pre pre_[2][4]; \
        _Pragma("unroll") for (int ai = 0; ai < 2; ++ai) _Pragma("unroll") for (int m = 0; m < 4; ++m) pre_[ai][m] = pre(u.pm * 256 + ai * 128 + wr * 64 + m * 16 + fr, u.pn, wc, fq); \
        _Pragma("unroll") for (int ai = 0; ai < 2; ++ai) { float s1 = 0.f, s2 = 0.f; \
            _Pragma("unroll") for (int m = 0; m < 4; ++m) { float t1, t2; \
                rgs(u.pm * 256 + ai * 128 + wr * 64 + m * 16 + fr, u.pn, wc, fq, acc[ai][0][m][0], acc[ai][0][m][1], acc[ai][1][m][0], acc[ai][1][m][1], pre_[ai][m], t1, t2); \
                s1 = (fq == m) ? t1 : s1; s2 = (fq == m) ? t2 : s2; } \
            stats(u.pm * 256 + ai * 128 + wr * 64 + fq * 16 + fr, u.pn, s1, s2); } } \
    __device__ __forceinline__ void rgq(int r, int pn, int wc, int fq, f32x4 a0, f32x4 b0, f32x4 a1, f32x4 b1, const Pre pv) const { float t1, t2; rgs(r, pn, wc, fq, a0, b0, a1, b1, pv, t1, t2); if (fq == 0) stats(r, pn, t1, t2); }
#define MK_INIT_ZERO() __device__ __forceinline__ void init(f32x4 (&acc)[2][2][4][2], const pg8::Unit&, int, int, int, int) const { \
        _Pragma("unroll") for (int a = 0; a < 2; ++a) _Pragma("unroll") for (int b = 0; b < 2; ++b) _Pragma("unroll") for (int m = 0; m < 4; ++m) _Pragma("unroll") for (int n = 0; n < 2; ++n) acc[a][b][m][n] = (f32x4){0.f, 0.f, 0.f, 0.f}; }
#define MK_PRE_STAT(PTR) MK_INIT_ZERO() typedef long long Pre; __device__ __forceinline__ Pre pre(int r, int, int, int) const { return (PTR)[r]; }
__device__ __forceinline__ float stat_f(long long v) { const int hi = (int)(v >> 32); const unsigned lo = (unsigned)v; return __builtin_fmaf((float)hi, 4294967296.0f * ST_INV, (float)lo * ST_INV); }
__device__ __forceinline__ float rsq_f(float x) { return __builtin_amdgcn_rsqf(x); }

struct EpiA1 {
    static constexpr bool PERM = true, AFTER_DRAIN = false;
    bf16* U; bf16* GV; const long long* ssq; long long* lns; long long* lnq; MK_DRYFIELD
    MK_PRE_STAT(ssq)
    __device__ __forceinline__ void rgs(int r, int pn, int wc, int fq, f32x4 a0, f32x4 b0, f32x4 a1, f32x4 b1, const Pre pv, float& s1, float& s2) const {
        const bool isv = pn >= 4; bf16* dst = (isv ? GV : U) + (size_t)r * 1024 + (pn & 3) * 256 + wc * 32 + 8 * fq; const float rs = rsq_f(stat_f(pv) * (1.0f / 1024.0f) + RMS_EPS);
        a0 *= rs; b0 *= rs; a1 *= rs; b1 *= rs;
#pragma unroll
        for (int e = 0; e < 4; ++e) { a0[e] = gelu_tanh_f(a0[e]); b0[e] = gelu_tanh_f(b0[e]); a1[e] = gelu_tanh_f(a1[e]); b1[e] = gelu_tanh_f(b1[e]); }
        *(u32x4*)dst = pack8(a0, b0); *(u32x4*)(dst + 128) = pack8(a1, b1);
        s1 = 0.f; s2 = 0.f;
        if (isv) { s1 = quad_red(sum8(a0, b0) + sum8(a1, b1)); s2 = quad_red(sumsq8(a0, b0) + sumsq8(a1, b1)); }
    }
    __device__ __forceinline__ void stats(int r, int pn, float s1, float s2) const { if (pn >= 4 && !MK_DRY(*this)) { stat_add(lns + r, s1); stat_add(lnq + r, s2); } }
    MK_EPI_CALL_DENSE()
};
struct EpiRes {
    static constexpr bool PERM = true, AFTER_DRAIN = false;
    bf16* HB; long long* ssq_out; MK_DRYFIELD
    struct Pre { u32x4 h0, h1; };
    static __device__ __forceinline__ f32x4 lo4(const u32x4 h) { return (f32x4){bflo(h.x), bfhi(h.x), bflo(h.y), bfhi(h.y)}; }
    static __device__ __forceinline__ f32x4 hi4(const u32x4 h) { return (f32x4){bflo(h.z), bfhi(h.z), bflo(h.w), bfhi(h.w)}; }
    __device__ __forceinline__ Pre pre(int r, int pn, int wc, int fq) const { const bf16* hp = HB + (size_t)r * 1024 + pn * 256 + wc * 32 + 8 * fq; Pre v; v.h0 = *(const u32x4*)hp; v.h1 = *(const u32x4*)(hp + 128); return v; }
    __device__ __forceinline__ void init(f32x4 (&acc)[2][2][4][2], const pg8::Unit& u, int wr, int wc, int fr, int fq) const {
        Pre v[2][4];
#pragma unroll
        for (int ai = 0; ai < 2; ++ai)
#pragma unroll
            for (int m = 0; m < 4; ++m) v[ai][m] = pre(u.pm * 256 + ai * 128 + wr * 64 + m * 16 + fr, u.pn, wc, fq);
#pragma unroll
        for (int ai = 0; ai < 2; ++ai)
#pragma unroll
            for (int m = 0; m < 4; ++m) { acc[ai][0][m][0] = lo4(v[ai][m].h0); acc[ai][0][m][1] = hi4(v[ai][m].h0); acc[ai][1][m][0] = lo4(v[ai][m].h1); acc[ai][1][m][1] = hi4(v[ai][m].h1); }
    }
    __device__ __forceinline__ void fin(int r, int pn, int wc, int fq, const f32x4 a0, const f32x4 b0, const f32x4 a1, const f32x4 b1, float& s1) const {
        bf16* hp = HB + (size_t)r * 1024 + pn * 256 + wc * 32 + 8 * fq;
        s1 = quad_red(sumsq8(a0, b0) + sumsq8(a1, b1));
        if (MK_DRY(*this)) { if (s1 == 12345.678f) *(u32x4*)hp = pack8(a0, b0); return; }
        *(u32x4*)hp = pack8(a0, b0); *(u32x4*)(hp + 128) = pack8(a1, b1);
    }
    __device__ __forceinline__ void stats(int r, int pn, float s1, float s2) const { if (!MK_DRY(*this)) stat_add(ssq_out + r, s1); }
    __device__ __forceinline__ void operator()(AccRef acc, const pg8::Unit& u, int wr, int wc, int fr, int fq) const {
#pragma unroll
        for (int ai = 0; ai < 2; ++ai) { float s1 = 0.f;
#pragma unroll
            for (int m = 0; m < 4; ++m) { float t1; fin(u.pm * 256 + ai * 128 + wr * 64 + m * 16 + fr, u.pn, wc, fq, acc[ai][0][m][0], acc[ai][0][m][1], acc[ai][1][m][0], acc[ai][1][m][1], t1); s1 = (fq == m) ? t1 : s1; }
            stats(u.pm * 256 + ai * 128 + wr * 64 + fq * 16 + fr, u.pn, s1, 0.f); } }
    __device__ __forceinline__ void rgq(int r, int pn, int wc, int fq, f32x4 a0, f32x4 b0, f32x4 a1, f32x4 b1, const Pre v) const { float t1;
        fin(r, pn, wc, fq, a0 + lo4(v.h0), b0 + hi4(v.h0), a1 + lo4(v.h1), b1 + hi4(v.h1), t1); if (fq == 0) stats(r, pn, t1, 0.f); }
};
struct EpiF1 {
    static constexpr bool PERM = true, AFTER_DRAIN = false;
    bf16* ACT; const long long* ssq;
    MK_PRE_STAT(ssq)
    __device__ __forceinline__ void rgp(int r, int pn, int wc, int fq, f32x4 a0, f32x4 b0, f32x4 a1, f32x4 b1, const Pre pv) const {
        const float rs = rsq_f(stat_f(pv) * (1.0f / 1024.0f) + RMS_EPS), kx = -1.4426950409f * rs, r2 = rs * rs; f32x4 a, b;
#pragma unroll
        for (int e = 0; e < 4; ++e) { a[e] = a0[e] * __builtin_amdgcn_rcpf(1.0f + __builtin_amdgcn_exp2f(a0[e] * kx)) * (a1[e] * r2); b[e] = b0[e] * __builtin_amdgcn_rcpf(1.0f + __builtin_amdgcn_exp2f(b0[e] * kx)) * (b1[e] * r2); }
        *(u32x4*)(ACT + (size_t)r * DFF + pn * 128 + wc * 32 + 8 * fq) = pack8(a, b);
    }
    MK_EPI_CALL()
};
struct EpiB1 {
    static constexpr bool PERM = true, AFTER_DRAIN = false;
    float* RAW; bf16* CQB; const long long* ssq; long long* ssq_kv; long long* ssq_q; MK_DRYFIELD
    __device__ __forceinline__ void half(int r, int c, f32x4 a, f32x4 b, float& qkv, float& qq) const {
        if (c < 256) { *(f32x4*)(RAW + (size_t)r * 768 + c) = a; *(f32x4*)(RAW + (size_t)r * 768 + c + 4) = b; qkv += sumsq8(a, b); }
        else if (c < 640) { *(u32x4*)(CQB + (size_t)r * 384 + (c - 256)) = pack8(a, b); qq += sumsq8(a, b); }
        else if (c < 704) { *(f32x4*)(RAW + (size_t)r * 768 + c) = a; *(f32x4*)(RAW + (size_t)r * 768 + c + 4) = b; } }
    MK_PRE_STAT(ssq)
    __device__ __forceinline__ void rgs(int r, int pn, int wc, int fq, f32x4 a0, f32x4 b0, f32x4 a1, f32x4 b1, const Pre pv, float& s1, float& s2) const {
        const float rs = rsq_f(stat_f(pv) * (1.0f / 1024.0f) + RMS_EPS); const int c = pn * 256 + wc * 32 + 8 * fq; float qkv = 0.f, qq = 0.f;
        half(r, c, a0 * rs, b0 * rs, qkv, qq); half(r, c + 128, a1 * rs, b1 * rs, qkv, qq);
        s1 = quad_red(qkv); s2 = quad_red(qq);
    }
    __device__ __forceinline__ void stats(int r, int pn, float s1, float s2) const { if (!MK_DRY(*this)) { if (pn == 0) stat_add(ssq_kv + r, s1); else stat_add(ssq_q + r, s2); } }
    MK_EPI_CALL_DENSE()
};
struct EpiB2 {
    static constexpr bool PERM = true, AFTER_DRAIN = false;
    bf16* QF; const long long* ssq_q; const f32x2* rope;
    __device__ __forceinline__ void half(int r, int c, int tp, const f32x4 a, const f32x4 b) const {
        const int h = c / 320, w = c - h * 320;
        if (w < 256) *(u32x4*)(QF + (size_t)r * 2560 + c) = pack8(a, b);
        else { const int i0 = (w - 256) >> 1;
            const f32x4 cs01 = *(const f32x4*)(rope + (size_t)tp * 32 + i0), cs23 = *(const f32x4*)(rope + (size_t)tp * 32 + i0 + 2);
            bf16* qh = QF + (size_t)r * 2560 + h * 320 + 256;
            *(u32x2*)(qh + i0) = (u32x2){cvt_pk_bf16(a[0] * cs01[0] - a[1] * cs01[1], a[2] * cs01[2] - a[3] * cs01[3]), cvt_pk_bf16(b[0] * cs23[0] - b[1] * cs23[1], b[2] * cs23[2] - b[3] * cs23[3])};
            *(u32x2*)(qh + 32 + i0) = (u32x2){cvt_pk_bf16(a[0] * cs01[1] + a[1] * cs01[0], a[2] * cs01[3] + a[3] * cs01[2]), cvt_pk_bf16(b[0] * cs23[1] + b[1] * cs23[0], b[2] * cs23[3] + b[3] * cs23[2])}; } }
    MK_PRE_STAT(ssq_q)
    __device__ __forceinline__ void rgp(int r, int pn, int wc, int fq, f32x4 a0, f32x4 b0, f32x4 a1, f32x4 b1, const Pre pv) const {
        const float rs = rsq_f(stat_f(pv) * (1.0f / 384.0f) + RMS_EPS) * (MLA_SCALE * 1.4426950408889634f)  ; const int tp = r < MP ? (r & 2047) : 2048 + ((r - MP) & 3), c = pn * 256 + wc * 32 + 8 * fq;
        half(r, c, tp, a0 * rs, b0 * rs); half(r, c + 128, tp, a1 * rs, b1 * rs);
    }
    MK_EPI_CALL()
};
struct EpiC1 {
    static constexpr bool PERM = true, AFTER_DRAIN = false;
    bf16* GATE; bf16* XW; const long long* ssq;
    MK_PRE_STAT(ssq)
    __device__ __forceinline__ void rgp(int r, int pn, int wc, int fq, f32x4 a0, f32x4 b0, f32x4 a1, f32x4 b1, const Pre pv) const {
        const bool isx = pn >= 5; const int c = (isx ? pn - 5 : pn) * 256 + wc * 32 + 8 * fq; const float rs = rsq_f(stat_f(pv) * (1.0f / 1024.0f) + RMS_EPS);
        a0 *= rs; b0 *= rs; a1 *= rs; b1 *= rs;
        if (isx) { bf16* x = XW + (size_t)r * 1280 + c; *(u32x4*)x = pack8(a0, b0); *(u32x4*)(x + 128) = pack8(a1, b1); }
        else {
#pragma unroll
            for (int e = 0; e < 4; ++e) { a0[e] = gelu_tanh_f(a0[e]); b0[e] = gelu_tanh_f(b0[e]); a1[e] = gelu_tanh_f(a1[e]); b1[e] = gelu_tanh_f(b1[e]); }
            bf16* g = GATE + (size_t)r * 1280 + c; *(u32x4*)g = pack8(a0, b0); *(u32x4*)(g + 128) = pack8(a1, b1); }
    }
    MK_EPI_CALL()
};

template <class Epi>
__device__ __forceinline__ void mini_gemm(const P& p, const bf16* A, int lda, const bf16* Bt, int ldb, int K, int N, const Epi& E, int first_wg) {
    constexpr int BP = 272, SLOT = 64 * BP;
    const int tid = p.tid, lane = p.lane, w = p.wave, kq = w & 3, rgp = w >> 2, l15 = lane & 15, g4 = lane >> 4, nmu = (N >> 8) * 16, nch = K >> 7, nst = (nch + 3) >> 2;
    const int t128 = (rgp << 6) | lane;
    const int nshare = first_wg ? p.G - first_wg : p.G, myi = (p.bid - first_wg + p.G) % p.G;
    for (int mu = myi < nshare ? myi : nmu; mu < nmu; mu += nshare) {
        const int pn = mu >> 4, wcq = (mu >> 2) & 3, rq = mu & 3, row = MP + 32 * rq + 16 * rgp + l15;
        const bf16* arow = A + (size_t)row * lda + 8 * g4;
        const int r0 = t128 >> 4, c16 = t128 & 15;
        const bf16* bbase = Bt + (size_t)(pn * 256 + wcq * 32 + 8 * (r0 >> 2) + (r0 & 3)) * ldb + c16 * 8; const int bo0 = r0 * BP + c16 * 16;
#define MG_BSRC(q) (bbase + (size_t)(128 * ((q) >> 2) + 4 * (((q) >> 1) & 1) + 16 * ((q) & 1)) * ldb)
#define MG_BOFF(q) (bo0 + 8 * (q) * BP)
        typename Epi::Pre pv_{}; if (kq == 0) pv_ = E.pre(row, pn, wcq, g4);
        f32x4 acc[4];
#pragma unroll
        for (int t = 0; t < 4; ++t) acc[t] = (f32x4){0.f, 0.f, 0.f, 0.f};
        u32x4 b0[8], a0[4], b1[8], a1[4], b2[8], a2[4];
#define MG_LOAD(BS, AS, ST) do { const int ch_ = 4 * (ST) + kq; if (ch_ < nch) { \
            _Pragma("unroll") for (int q = 0; q < 8; ++q) BS[q] = *(const u32x4*)(MG_BSRC(q) + (size_t)ch_ * 128); \
            _Pragma("unroll") for (int s = 0; s < 4; ++s) AS[s] = *(const u32x4*)(arow + (size_t)ch_ * 128 + 32 * s); } } while (0)
#define MG_STEP(BS, AS, ST) do { LAS unsigned char* slot = p.lds + (kq * 2 + ((ST) & 1)) * SLOT; const bool ok_ = 4 * (ST) + kq < nch; \
            if (ok_) { _Pragma("unroll") for (int q = 0; q < 8; ++q) *(LAS u32x4*)(slot + MG_BOFF(q)) = BS[q]; } \
            bf16x8 af[4]; _Pragma("unroll") for (int s = 0; s < 4; ++s) af[s] = __builtin_bit_cast(bf16x8, AS[s]); \
            __syncthreads(); \
            if ((ST) + 3 < nst) MG_LOAD(BS, AS, (ST) + 3); \
            if (ok_) { _Pragma("unroll") for (int s = 0; s < 4; ++s) _Pragma("unroll") for (int t = 0; t < 4; ++t) { \
                const bf16x8 bf = *(const LAS bf16x8*)(slot + (t * 16 + l15) * BP + (32 * s + 8 * g4) * 2); \
                acc[t] = __builtin_amdgcn_mfma_f32_16x16x32_bf16(bf, af[s], acc[t], 0, 0, 0); } } } while (0)
        MG_LOAD(b0, a0, 0); if (1 < nst) MG_LOAD(b1, a1, 1); if (2 < nst) MG_LOAD(b2, a2, 2);
        __syncthreads();
        for (int st = 0; st < nst; st += 3) {
            MG_STEP(b0, a0, st);
            if (st + 1 < nst) MG_STEP(b1, a1, st + 1);
            if (st + 2 < nst) MG_STEP(b2, a2, st + 2);
        }
#undef MG_LOAD
#undef MG_STEP
#undef MG_BSRC
#undef MG_BOFF
        __syncthreads();
        LAS f32x4* red = (LAS f32x4*)p.lds;
        if (kq > 0) {
#pragma unroll
            for (int t = 0; t < 4; ++t) red[((rgp * 3 + (kq - 1)) * 4 + t) * 64 + lane] = acc[t]; }
        __syncthreads();
        if (kq == 0) {
#pragma unroll
            for (int k2 = 0; k2 < 3; ++k2)
#pragma unroll
                for (int t = 0; t < 4; ++t) acc[t] += red[((rgp * 3 + k2) * 4 + t) * 64 + lane];
            E.rgq(row, pn, wcq, g4, acc[0], acc[1], acc[2], acc[3], pv_); }
    }
}
}
namespace mk {
__device__ __forceinline__ s16x4 tr16(const LAS unsigned char* a) { return __builtin_amdgcn_ds_read_tr16_b64_v4i16((LAS s16x4*)a); }
__device__ __forceinline__ bf16x8 cat8(const s16x4 a, const s16x4 b) { return (bf16x8){a[0], a[1], a[2], a[3], b[0], b[1], b[2], b[3]}; }
__device__ __forceinline__ bf16x8 as_bf16x8(const u32x4 w) { return __builtin_bit_cast(bf16x8, w); }
#define MFMA16(A, B, C) __builtin_amdgcn_mfma_f32_16x16x32_bf16((A), (B), (C), 0, 0, 0)
template <int OFF> __device__ __forceinline__ bf16x8 dsr128(unsigned a) { bf16x8 r; asm volatile("ds_read_b128 %0, %1 offset:%2" : "=&v"(r) : "v"(a), "i"(OFF) : "memory"); return r; }
template <int OFF> __device__ __forceinline__ s16x4 dstr64(unsigned a) { s16x4 r; asm volatile("ds_read_b64_tr_b16 %0, %1 offset:%2" : "=&v"(r) : "v"(a), "i"(OFF) : "memory"); return r; }
#define LDS_WAIT_PIN() do { asm volatile("s_waitcnt lgkmcnt(0)" ::: "memory"); __builtin_amdgcn_sched_barrier(0); } while (0)
constexpr int TP = 272;
constexpr int KP = 656;
constexpr float LOG2E = 1.4426950408889634f;

__device__ __forceinline__ void a2_spatial(const P& p, int j, float* out_cv  ) {
    const bf16* U = p.w<bf16>(WS_U); const bf16* GV = p.w<bf16>(WS_GV); bf16* UM = p.w<bf16>(WS_UM);
    const long long* lns = p.stat(ST_LNS0 + 2 * j); const long long* lnq = p.stat(ST_LNQ0 + 2 * j);
    const float* ln_g = p.in[10] + j * 1024; const float* ln_b = p.in[11] + j * 1024; const float* b_s = p.in[13] + j * 1024;
    LAS unsigned char* Wt = p.lds; LAS unsigned char* Vt = p.lds + 128 * TP;
    const int tid = p.tid, lane = p.lane, w = p.wave, l15 = lane & 15, g4 = lane >> 4, q4 = (lane & 15) >> 2, pp = lane & 3;
    { const float* aws = p.in[12] + (size_t)j * 8 * 16384;
      for (int idx = p.bid * 512 + tid; idx < 128 * 1024; idx += p.G * 512) {
        const int t = idx >> 10, d = idx & 1023, g = d >> 7, i = t & 3; const size_t r = (size_t)MP + t, rb = r - i;
        const float lg = ln_g[d], lb = ln_b[d]; float mixed = b_s[g * 128 + i], vi = 0.f;
#pragma unroll
        for (int s2 = 0; s2 < 4; ++s2) { const size_t rs = rb + s2;
            const float mu = stat_get(lns + rs) * (1.0f / 1024.0f), var = stat_get(lnq + rs) * (1.0f / 1024.0f) - mu * mu;
            const float v = (bf2f(GV[rs * 1024 + d]) - mu) * rsqrtf(var + LN_EPS) * lg + lb, wv = aws[(size_t)g * 16384 + i * 128 + s2];
            mixed += (s2 <= i) ? wv * v : 0.f; vi = (s2 == i) ? v : vi; }
        if (out_cv) out_cv[(size_t)t * 1024 + d] = vi;
        UM[r * 1024 + d] = (bf16)f2bf(bf2f(U[r * 1024 + d]) * mixed); } }
    u32x4 Wr[4], raw[4]; long long sl[4], sq[4]; f32x4 g0, g1, b0, b1;
#define A2_LOAD(U_) do { const int c_ = (U_) >> 3, g_ = (U_) & 7, row0_ = c_ * 128, c16_ = tid & 15, d0_ = g_ * 128 + c16_ * 8; \
        const bf16* Wsrc_ = p.w<bf16>(WS_WS + (size_t)j * 262144) + (size_t)g_ * 16384; \
        _Pragma("unroll") for (int q = 0; q < 4; ++q) { const int ch = tid + 512 * q, row = ch >> 4, c16 = ch & 15; Wr[q] = *(const u32x4*)(Wsrc_ + row * 128 + c16 * 8); } \
        g0 = *(const f32x4*)(ln_g + d0_); g1 = *(const f32x4*)(ln_g + d0_ + 4); b0 = *(const f32x4*)(ln_b + d0_); b1 = *(const f32x4*)(ln_b + d0_ + 4); \
        _Pragma("unroll") for (int q = 0; q < 4; ++q) { const int r = row0_ + (tid >> 4) + 32 * q; raw[q] = *(const u32x4*)(GV + (size_t)r * 1024 + d0_); sl[q] = lns[r]; sq[q] = lnq[r]; } } while (0)
    if (p.bid < 128 * 8) A2_LOAD(p.bid);
    for (int u = p.bid; u < 128 * 8; u += p.G) {
        int tl_ = p.tid; asm volatile("" : "+v"(tl_)); const int tid = tl_, lane = tl_ & 63, l15 = lane & 15, g4 = lane >> 4, q4 = (lane & 15) >> 2, pp = lane & 3;
        const int c = u >> 3, g = u & 7, row0 = c * 128;
#pragma unroll
        for (int q = 0; q < 4; ++q) { const int ch = tid + 512 * q, row = ch >> 4, c16 = ch & 15; *(LAS u32x4*)(Wt + row * TP + c16 * 16) = Wr[q]; }
        { const int c16 = tid & 15;
#pragma unroll
          for (int q = 0; q < 4; ++q) { const int s = (tid >> 4) + 32 * q;
            const float mu = (float)sl[q] * ST_INV * (1.0f / 1024.0f), var = (float)sq[q] * ST_INV * (1.0f / 1024.0f) - mu * mu, rstd = rsqrtf(var + LN_EPS);
            f32x4 v0, v1;
            v0[0] = bflo(raw[q].x); v0[1] = bfhi(raw[q].x); v0[2] = bflo(raw[q].y); v0[3] = bfhi(raw[q].y); v1[0] = bflo(raw[q].z); v1[1] = bfhi(raw[q].z); v1[2] = bflo(raw[q].w); v1[3] = bfhi(raw[q].w);
            v0 = (v0 - mu) * rstd * g0 + b0; v1 = (v1 - mu) * rstd * g1 + b1;
            *(LAS u32x4*)(Vt + s * TP + c16 * 16) = pack8(v0, v1); } }
        u32x2 uu[8]; float bsv[8];
#pragma unroll
        for (int tt = 0; tt < 8; ++tt) { uu[tt] = *(const u32x2*)(U + (size_t)(row0 + 16 * tt + l15) * 1024 + g * 128 + 16 * w + 4 * g4); bsv[tt] = b_s[g * 128 + 16 * tt + l15]; }
        __syncthreads();
        { const int un = u + p.G; if (un < 128 * 8) A2_LOAD(un); }
        f32x4 acc[8];
#pragma unroll
        for (int tt = 0; tt < 8; ++tt) acc[tt] = (f32x4){0.f, 0.f, 0.f, 0.f};
#pragma unroll
        for (int kk = 0; kk < 4; ++kk) {
            const bf16x8 X = cat8(tr16(Vt + (32 * kk + 8 * g4 + q4) * TP + (16 * w + 4 * pp) * 2), tr16(Vt + (32 * kk + 8 * g4 + 4 + q4) * TP + (16 * w + 4 * pp) * 2));
#pragma unroll
            for (int tt = 0; tt < 8; ++tt) if (32 * kk <= 16 * tt + 15) {
                const bf16x8 Y = *(const LAS bf16x8*)(Wt + (16 * tt + l15) * TP + (32 * kk + 8 * g4) * 2);
                acc[tt] = MFMA16(X, Y, acc[tt]); }
        }
#pragma unroll
        for (int tt = 0; tt < 8; ++tt) { const int t = 16 * tt + l15, r = row0 + t, col = g * 128 + 16 * w + 4 * g4; const float bias = bsv[tt];
            const float o0 = bflo(uu[tt].x) * (acc[tt][0] + bias), o1 = bfhi(uu[tt].x) * (acc[tt][1] + bias), o2 = bflo(uu[tt].y) * (acc[tt][2] + bias), o3 = bfhi(uu[tt].y) * (acc[tt][3] + bias);
            *(u32x2*)(UM + (size_t)r * 1024 + col) = (u32x2){cvt_pk_bf16(o0, o1), cvt_pk_bf16(o2, o3)}; }
        __syncthreads();
    }
#undef A2_LOAD
}

__device__ __forceinline__ void b2_kvfinal(const P& p, float* out_mp, float* out_ms) {
    const float* RAW = p.w<float>(WS_RAW); bf16* KVB = p.w<bf16>(WS_KVB); const long long* ssq_kv = p.stat(ST_KV); const float* kvn = p.in[19]; const f32x2* rope = p.w<f32x2>(WS_ROPE);
    const int gw = p.bid * NWAVES + p.wave, NGW = p.G * NWAVES, lane = p.lane, l31 = lane & 31;
    const f32x4 kn = *(const f32x4*)(kvn + 4 * lane);
    auto tpos = [&](int m) { return m < MP ? (m & 2047) : 2048 + ((m - MP) & 3); };
    long long sq = 0, sqn = 0; f32x4 rv = (f32x4){0.f, 0.f, 0.f, 0.f}, rvn = rv; f32x2 cs = (f32x2){0.f, 0.f}, csn = cs; float x1 = 0.f, x2 = 0.f, x1n = 0.f, x2n = 0.f;
    if (gw < MT) { const int m = gw; sq = ssq_kv[m]; rv = *(const f32x4*)(RAW + (size_t)m * 768 + 4 * lane); cs = rope[(size_t)tpos(m) * 32 + l31]; x1 = RAW[(size_t)m * 768 + 640 + l31]; x2 = RAW[(size_t)m * 768 + 672 + l31]; }
    for (int m = gw; m < MT; m += NGW) {
        { const int mn = (m + NGW < MT) ? m + NGW : m; sqn = ssq_kv[mn]; rvn = *(const f32x4*)(RAW + (size_t)mn * 768 + 4 * lane); csn = rope[(size_t)tpos(mn) * 32 + l31]; x1n = RAW[(size_t)mn * 768 + 640 + l31]; x2n = RAW[(size_t)mn * 768 + 672 + l31]; }
        float* o = m < MP ? (out_mp ? out_mp + (size_t)m * 320 : nullptr) : (out_ms ? out_ms + (size_t)(m - MP) * 320 : nullptr);
        const float rs = rsqrtf((float)sq * ST_INV * (1.0f / 256.0f) + RMS_EPS);
        const f32x4 v = rv * rs * kn;
        if (o) *(f32x4*)(o + 4 * lane) = v;
        *(u32x2*)(KVB + (size_t)m * 320 + 4 * lane) = (u32x2){cvt_pk_bf16(v[0], v[1]), cvt_pk_bf16(v[2], v[3])};
        if (lane < 32) {
            const float o1 = x1 * cs.x - x2 * cs.y, o2 = x1 * cs.y + x2 * cs.x;
            if (o) { o[256 + lane] = o1; o[288 + lane] = o2; }
            KVB[(size_t)m * 320 + 256 + lane] = (bf16)f2bf(o1); KVB[(size_t)m * 320 + 288 + lane] = (bf16)f2bf(o2); }
        sq = sqn; rv = rvn; cs = csn; x1 = x1n; x2 = x2n;
    }
}

__device__ __forceinline__ void b3_attn_prompt(const P& p) {
    const bf16* QF = p.w<bf16>(WS_QF); const bf16* KVB = p.w<bf16>(WS_KVB); bf16* OB = p.w<bf16>(WS_OB);
    const int lane = p.lane, h = p.wave, l15 = lane & 15, g4 = lane >> 4, q4 = (lane & 15) >> 2, pp = lane & 3;
    constexpr int TILE_B = 64 * 640;
    int soff[5];
#pragma unroll
    for (int i = 0; i < 5; ++i) { const int P_ = (h + 8 * i) * 64 + lane, row = P_ / 40, cph = P_ - 40 * row; soff[i] = row * 320 + ((cph ^ (row & 6)) << 3); }
    const int kb_ = l15 * 640 + ((g4 ^ (l15 & 2)) << 4), km_ = ((l15 >> 2) & 1) << 6, kbase0 = kb_ + km_, kbase1 = kb_ - km_;
    int taddr[4];
    { const int rl = 4 * g4 + q4, m_ = (rl & 6) >> 1;
#pragma unroll
      for (int v3 = 0; v3 < 4; ++v3) taddr[v3] = rl * 640 + (((v3 ^ m_) << 1 | (pp >> 1)) << 4) + 8 * (pp & 1); }
#define AT_DMA(BUF, SRC) do { _Pragma("unroll") for (int i = 0; i < 5; ++i) \
        __builtin_amdgcn_global_load_lds((const unsigned*)((SRC) + soff[i]), (LAS unsigned*)((BUF) + (h + 8 * i) * 1024), 16, 0, 0); } while (0)
    for (int pi = p.bid; pi < 512; pi += p.G) {
        const int b = (p.G % 8 == 0) ? (pi & 7) : (pi >> 6), x = (p.G % 8 == 0) ? ((pi >> 3) & 63) : (pi & 63);
        for (int half = 0; half < 2; ++half) {
            const int qt = half ? 127 - x : x, t0 = 16 * qt, nkt = (t0 + 15) / 64 + 1;
            const size_t rowq = (size_t)b * 2048 + t0 + l15; const bf16* kvb = KVB + (size_t)b * 2048 * 320;
            AT_DMA(p.lds, kvb);
            bf16x8 Q[10];
#pragma unroll
            for (int s = 0; s < 10; ++s) Q[s] = as_bf16x8(*(const u32x4*)(QF + rowq * 2560 + h * 320 + 32 * s + 8 * g4));
            f32x4 O[16];
#pragma unroll
            for (int vt = 0; vt < 16; ++vt) O[vt] = (f32x4){0.f, 0.f, 0.f, 0.f};
            float mrun = -1e30f, lrun = 0.f;
            asm volatile("s_waitcnt vmcnt(0)" ::: "memory"); __syncthreads();
#define AT_TILE(BUF, KT, MASKED) do { \
                const unsigned lb_ = (unsigned)(size_t)(BUF), kb0_ = lb_ + kbase0, kb1_ = lb_ + kbase1; \
                f32x4 S[4]; \
                _Pragma("unroll") for (int k4 = 0; k4 < 4; ++k4) S[k4] = (f32x4){0.f, 0.f, 0.f, 0.f}; \
                { const bf16x8 ka0 = dsr128<0>(kb0_), ka1 = dsr128<10240>(kb0_), ka2 = dsr128<20480>(kb0_), ka3 = dsr128<30720>(kb0_), kc0 = dsr128<64>(kb1_), kc1 = dsr128<10304>(kb1_), kc2 = dsr128<20544>(kb1_), kc3 = dsr128<30784>(kb1_); \
                  LDS_WAIT_PIN(); \
                  S[0] = MFMA16(ka0, Q[0], S[0]); S[1] = MFMA16(ka1, Q[0], S[1]); S[2] = MFMA16(ka2, Q[0], S[2]); S[3] = MFMA16(ka3, Q[0], S[3]); S[0] = MFMA16(kc0, Q[1], S[0]); S[1] = MFMA16(kc1, Q[1], S[1]); S[2] = MFMA16(kc2, Q[1], S[2]); S[3] = MFMA16(kc3, Q[1], S[3]); } \
                { const bf16x8 ka0 = dsr128<128>(kb0_), ka1 = dsr128<10368>(kb0_), ka2 = dsr128<20608>(kb0_), ka3 = dsr128<30848>(kb0_), kc0 = dsr128<192>(kb1_), kc1 = dsr128<10432>(kb1_), kc2 = dsr128<20672>(kb1_), kc3 = dsr128<30912>(kb1_); \
                  LDS_WAIT_PIN(); \
                  S[0] = MFMA16(ka0, Q[2], S[0]); S[1] = MFMA16(ka1, Q[2], S[1]); S[2] = MFMA16(ka2, Q[2], S[2]); S[3] = MFMA16(ka3, Q[2], S[3]); S[0] = MFMA16(kc0, Q[3], S[0]); S[1] = MFMA16(kc1, Q[3], S[1]); S[2] = MFMA16(kc2, Q[3], S[2]); S[3] = MFMA16(kc3, Q[3], S[3]); } \
                { const bf16x8 ka0 = dsr128<256>(kb0_), ka1 = dsr128<10496>(kb0_), ka2 = dsr128<20736>(kb0_), ka3 = dsr128<30976>(kb0_), kc0 = dsr128<320>(kb1_), kc1 = dsr128<10560>(kb1_), kc2 = dsr128<20800>(kb1_), kc3 = dsr128<31040>(kb1_); \
                  LDS_WAIT_PIN(); \
                  S[0] = MFMA16(ka0, Q[4], S[0]); S[1] = MFMA16(ka1, Q[4], S[1]); S[2] = MFMA16(ka2, Q[4], S[2]); S[3] = MFMA16(ka3, Q[4], S[3]); S[0] = MFMA16(kc0, Q[5], S[0]); S[1] = MFMA16(kc1, Q[5], S[1]); S[2] = MFMA16(kc2, Q[5], S[2]); S[3] = MFMA16(kc3, Q[5], S[3]); } \
                { const bf16x8 ka0 = dsr128<384>(kb0_), ka1 = dsr128<10624>(kb0_), ka2 = dsr128<20864>(kb0_), ka3 = dsr128<31104>(kb0_), kc0 = dsr128<448>(kb1_), kc1 = dsr128<10688>(kb1_), kc2 = dsr128<20928>(kb1_), kc3 = dsr128<31168>(kb1_); \
                  LDS_WAIT_PIN(); \
                  S[0] = MFMA16(ka0, Q[6], S[0]); S[1] = MFMA16(ka1, Q[6], S[1]); S[2] = MFMA16(ka2, Q[6], S[2]); S[3] = MFMA16(ka3, Q[6], S[3]); S[0] = MFMA16(kc0, Q[7], S[0]); S[1] = MFMA16(kc1, Q[7], S[1]); S[2] = MFMA16(kc2, Q[7], S[2]); S[3] = MFMA16(kc3, Q[7], S[3]); } \
                { const bf16x8 ka0 = dsr128<512>(kb0_), ka1 = dsr128<10752>(kb0_), ka2 = dsr128<20992>(kb0_), ka3 = dsr128<31232>(kb0_), kc0 = dsr128<576>(kb1_), kc1 = dsr128<10816>(kb1_), kc2 = dsr128<21056>(kb1_), kc3 = dsr128<31296>(kb1_); \
                  LDS_WAIT_PIN(); \
                  S[0] = MFMA16(ka0, Q[8], S[0]); S[1] = MFMA16(ka1, Q[8], S[1]); S[2] = MFMA16(ka2, Q[8], S[2]); S[3] = MFMA16(ka3, Q[8], S[3]); S[0] = MFMA16(kc0, Q[9], S[0]); S[1] = MFMA16(kc1, Q[9], S[1]); S[2] = MFMA16(kc2, Q[9], S[2]); S[3] = MFMA16(kc3, Q[9], S[3]); } \
                  \
                float mx = -1e30f; \
                _Pragma("unroll") for (int k4 = 0; k4 < 4; ++k4) _Pragma("unroll") for (int e = 0; e < 4; ++e) { float v = S[k4][e]; if ((MASKED) && 64 * (KT) + 16 * k4 + 4 * g4 + e > t0 + l15) v = -1e30f; S[k4][e] = v; mx = fmaxf(mx, v); } \
                mx = fmaxf(mx, __shfl_xor(mx, 16)); mx = fmaxf(mx, __shfl_xor(mx, 32)); \
                const float mnew = fmaxf(mrun, mx), alpha = __builtin_amdgcn_exp2f(mrun - mnew); mrun = mnew; \
                float ps = 0.f; \
                _Pragma("unroll") for (int k4 = 0; k4 < 4; ++k4) _Pragma("unroll") for (int e = 0; e < 4; ++e) { const float pv = __builtin_amdgcn_exp2f(S[k4][e] - mnew); S[k4][e] = pv; ps += pv; } \
                lrun = lrun * alpha + ps; \
                _Pragma("unroll") for (int vt = 0; vt < 16; ++vt) O[vt] *= alpha; \
                bf16x8 Pf[2]; \
                _Pragma("unroll") for (int ks = 0; ks < 2; ++ks) Pf[ks] = as_bf16x8((u32x4){cvt_pk_bf16(S[2 * ks][0], S[2 * ks][1]), cvt_pk_bf16(S[2 * ks][2], S[2 * ks][3]), cvt_pk_bf16(S[2 * ks + 1][0], S[2 * ks + 1][1]), cvt_pk_bf16(S[2 * ks + 1][2], S[2 * ks + 1][3])}); \
                  \
                { const unsigned tb0_ = lb_ + taddr[0], tb1_ = lb_ + taddr[1], tb2_ = lb_ + taddr[2], tb3_ = lb_ + taddr[3]; \
                  { const s16x4 v000 = dstr64<0>(tb0_), v001 = dstr64<10240>(tb0_), v010 = dstr64<20480>(tb0_), v011 = dstr64<30720>(tb0_), v100 = dstr64<0>(tb1_), v101 = dstr64<10240>(tb1_), v110 = dstr64<20480>(tb1_), v111 = dstr64<30720>(tb1_), v200 = dstr64<0>(tb2_), v201 = dstr64<10240>(tb2_), v210 = dstr64<20480>(tb2_), v211 = dstr64<30720>(tb2_), v300 = dstr64<0>(tb3_), v301 = dstr64<10240>(tb3_), v310 = dstr64<20480>(tb3_), v311 = dstr64<30720>(tb3_); \
                    LDS_WAIT_PIN(); \
                    O[0] = MFMA16(cat8(v000, v001), Pf[0], O[0]); O[0] = MFMA16(cat8(v010, v011), Pf[1], O[0]); O[1] = MFMA16(cat8(v100, v101), Pf[0], O[1]); O[1] = MFMA16(cat8(v110, v111), Pf[1], O[1]); O[2] = MFMA16(cat8(v200, v201), Pf[0], O[2]); O[2] = MFMA16(cat8(v210, v211), Pf[1], O[2]); O[3] = MFMA16(cat8(v300, v301), Pf[0], O[3]); O[3] = MFMA16(cat8(v310, v311), Pf[1], O[3]); } \
                  { const s16x4 v000 = dstr64<128>(tb0_), v001 = dstr64<10368>(tb0_), v010 = dstr64<20608>(tb0_), v011 = dstr64<30848>(tb0_), v100 = dstr64<128>(tb1_), v101 = dstr64<10368>(tb1_), v110 = dstr64<20608>(tb1_), v111 = dstr64<30848>(tb1_), v200 = dstr64<128>(tb2_), v201 = dstr64<10368>(tb2_), v210 = dstr64<20608>(tb2_), v211 = dstr64<30848>(tb2_), v300 = dstr64<128>(tb3_), v301 = dstr64<10368>(tb3_), v310 = dstr64<20608>(tb3_), v311 = dstr64<30848>(tb3_); \
                    LDS_WAIT_PIN(); \
                    O[4] = MFMA16(cat8(v000, v001), Pf[0], O[4]); O[4] = MFMA16(cat8(v010, v011), Pf[1], O[4]); O[5] = MFMA16(cat8(v100, v101), Pf[0], O[5]); O[5] = MFMA16(cat8(v110, v111), Pf[1], O[5]); O[6] = MFMA16(cat8(v200, v201), Pf[0], O[6]); O[6] = MFMA16(cat8(v210, v211), Pf[1], O[6]); O[7] = MFMA16(cat8(v300, v301), Pf[0], O[7]); O[7] = MFMA16(cat8(v310, v311), Pf[1], O[7]); } \
                  { const s16x4 v000 = dstr64<256>(tb0_), v001 = dstr64<10496>(tb0_), v010 = dstr64<20736>(tb0_), v011 = dstr64<30976>(tb0_), v100 = dstr64<256>(tb1_), v101 = dstr64<10496>(tb1_), v110 = dstr64<20736>(tb1_), v111 = dstr64<30976>(tb1_), v200 = dstr64<256>(tb2_), v201 = dstr64<10496>(tb2_), v210 = dstr64<20736>(tb2_), v211 = dstr64<30976>(tb2_), v300 = dstr64<256>(tb3_), v301 = dstr64<10496>(tb3_), v310 = dstr64<20736>(tb3_), v311 = dstr64<30976>(tb3_); \
                    LDS_WAIT_PIN(); \
                    O[8] = MFMA16(cat8(v000, v001), Pf[0], O[8]); O[8] = MFMA16(cat8(v010, v011), Pf[1], O[8]); O[9] = MFMA16(cat8(v100, v101), Pf[0], O[9]); O[9] = MFMA16(cat8(v110, v111), Pf[1], O[9]); O[10] = MFMA16(cat8(v200, v201), Pf[0], O[10]); O[10] = MFMA16(cat8(v210, v211), Pf[1], O[10]); O[11] = MFMA16(cat8(v300, v301), Pf[0], O[11]); O[11] = MFMA16(cat8(v310, v311), Pf[1], O[11]); } \
                  { const s16x4 v000 = dstr64<384>(tb0_), v001 = dstr64<10624>(tb0_), v010 = dstr64<20864>(tb0_), v011 = dstr64<31104>(tb0_), v100 = dstr64<384>(tb1_), v101 = dstr64<10624>(tb1_), v110 = dstr64<20864>(tb1_), v111 = dstr64<31104>(tb1_), v200 = dstr64<384>(tb2_), v201 = dstr64<10624>(tb2_), v210 = dstr64<20864>(tb2_), v211 = dstr64<31104>(tb2_), v300 = dstr64<384>(tb3_), v301 = dstr64<10624>(tb3_), v310 = dstr64<20864>(tb3_), v311 = dstr64<31104>(tb3_); \
                    LDS_WAIT_PIN(); \
                    O[12] = MFMA16(cat8(v000, v001), Pf[0], O[12]); O[12] = MFMA16(cat8(v010, v011), Pf[1], O[12]); O[13] = MFMA16(cat8(v100, v101), Pf[0], O[13]); O[13] = MFMA16(cat8(v110, v111), Pf[1], O[13]); O[14] = MFMA16(cat8(v200, v201), Pf[0], O[14]); O[14] = MFMA16(cat8(v210, v211), Pf[1], O[14]); O[15] = MFMA16(cat8(v300, v301), Pf[0], O[15]); O[15] = MFMA16(cat8(v310, v311), Pf[1], O[15]); } \
                } } while (0)
#define AT_V(BUF, VT, KS, T) tr16((BUF) + taddr[(VT) & 3] + ((VT) >> 2) * 128 + (32 * (KS) + 16 * (T)) * 640)
            for (int kt = 0; kt < nkt - 1; ++kt) {
                LAS unsigned char* buf = p.lds + (kt & 1) * TILE_B;
                AT_DMA(p.lds + ((kt + 1) & 1) * TILE_B, kvb + (size_t)64 * (kt + 1) * 320);
                AT_TILE(buf, kt, false);
                asm volatile("s_waitcnt vmcnt(0)" ::: "memory"); __syncthreads();
            }
            { const int kt = nkt - 1; LAS unsigned char* buf = p.lds + (kt & 1) * TILE_B;
              AT_TILE(buf, kt, true);
              __syncthreads(); }
#undef AT_TILE
#undef AT_V
            const float linv = 1.0f / quad_red(lrun);
#pragma unroll
            for (int vt = 0; vt < 16; ++vt) { const f32x4 o = O[vt] * linv;
                *(u32x2*)(OB + rowq * 2048 + h * 256 + 16 * vt + 4 * g4) = (u32x2){cvt_pk_bf16(o[0], o[1]), cvt_pk_bf16(o[2], o[3])}; }
        }
    }
#undef AT_DMA
}

__device__ __forceinline__ void b3_attn_sample_unit(const P& p, const int u) {
    const bf16* QF = p.w<bf16>(WS_QF); float* PART = p.w<float>(WS_PART); float* PML = p.w<float>(WS_PML);
    const float* cache = p.in[2]; const int* ptab = (const int*)p.in[5];
    const int tid = p.tid, lane = p.lane, w = p.wave, qt = w & 1, dvq = w >> 1, l15 = lane & 15, g4 = lane >> 4, q4 = (lane & 15) >> 2, pp = lane & 3;
    constexpr int TILE_B = 64 * KP;
    {
        const int b = u >> 3, sp = u & 7;
        const int hq = 4 * qt + (l15 >> 2), iq = l15 & 3; const size_t rowq = (size_t)MP + 4 * b + iq;
        bf16x8 Q[10];
#pragma unroll
        for (int s = 0; s < 10; ++s) Q[s] = as_bf16x8(*(const u32x4*)(QF + rowq * 2560 + hq * 320 + 32 * s + 8 * g4));
        f32x4 O[4];
#pragma unroll
        for (int v = 0; v < 4; ++v) O[v] = (f32x4){0.f, 0.f, 0.f, 0.f};
        float mrun = -1e30f, lrun = 0.f;
        f32x4 stA[10], stB[10];
        auto tile_src = [&](int ti) -> const float* { const int pg = 16 * sp + (ti >> 1); return cache + ((size_t)ptab[b * 128 + pg] * 128 + 64 * (ti & 1)) * 320; };
#define SA_LOAD(ST, TI) do { const float* src_ = tile_src(TI); _Pragma("unroll") for (int q = 0; q < 10; ++q) ST[q] = __builtin_nontemporal_load((const f32x4*)(src_ + (size_t)(tid + 512 * q) * 4)); } while (0)
#define SA_CVT(ST, BUF) do { _Pragma("unroll") for (int q = 0; q < 10; ++q) { const int ch = tid + 512 * q, row = ch / 80, c4 = ch % 80; \
            *(LAS u32x2*)((BUF) + row * KP + c4 * 8) = (u32x2){cvt_pk_bf16(ST[q][0], ST[q][1]), cvt_pk_bf16(ST[q][2], ST[q][3])}; } } while (0)
#define SA_COMPUTE(BUF) do { f32x4 S[4]; \
            _Pragma("unroll") for (int k4 = 0; k4 < 4; ++k4) { S[k4] = (f32x4){0.f, 0.f, 0.f, 0.f}; \
                _Pragma("unroll") for (int s = 0; s < 10; ++s) { const bf16x8 Kf = *(const LAS bf16x8*)((BUF) + (16 * k4 + l15) * KP + (32 * s + 8 * g4) * 2); S[k4] = MFMA16(Kf, Q[s], S[k4]); } } \
            float mx = -1e30f; \
            _Pragma("unroll") for (int k4 = 0; k4 < 4; ++k4) _Pragma("unroll") for (int e = 0; e < 4; ++e) { const float v = S[k4][e]; mx = fmaxf(mx, v); } \
            mx = fmaxf(mx, __shfl_xor(mx, 16)); mx = fmaxf(mx, __shfl_xor(mx, 32)); \
            const float mnew = fmaxf(mrun, mx), alpha = __builtin_amdgcn_exp2f(mrun - mnew); mrun = mnew; \
            float ps = 0.f; \
            _Pragma("unroll") for (int k4 = 0; k4 < 4; ++k4) _Pragma("unroll") for (int e = 0; e < 4; ++e) { const float pv = __builtin_amdgcn_exp2f(S[k4][e] - mnew); S[k4][e] = pv; ps += pv; } \
            lrun = lrun * alpha + ps; \
            _Pragma("unroll") for (int v = 0; v < 4; ++v) O[v] *= alpha; \
            bf16x8 Pf[2]; \
            _Pragma("unroll") for (int ks = 0; ks < 2; ++ks) Pf[ks] = as_bf16x8((u32x4){cvt_pk_bf16(S[2 * ks][0], S[2 * ks][1]), cvt_pk_bf16(S[2 * ks][2], S[2 * ks][3]), cvt_pk_bf16(S[2 * ks + 1][0], S[2 * ks + 1][1]), cvt_pk_bf16(S[2 * ks + 1][2], S[2 * ks + 1][3])}); \
            _Pragma("unroll") for (int v = 0; v < 4; ++v) { const int vt = 4 * dvq + v; \
                _Pragma("unroll") for (int ks = 0; ks < 2; ++ks) { \
                    const bf16x8 Vf = cat8(tr16((BUF) + (32 * ks + 4 * g4 + q4) * KP + (16 * vt + 4 * pp) * 2), tr16((BUF) + (32 * ks + 16 + 4 * g4 + q4) * KP + (16 * vt + 4 * pp) * 2)); \
                    O[v] = MFMA16(Vf, Pf[ks], O[v]); } } } while (0)
        LAS unsigned char* const buf0 = p.lds; LAS unsigned char* const buf1 = p.lds + TILE_B;
        SA_LOAD(stA, 0); SA_LOAD(stB, 1);
        __syncthreads();
        SA_CVT(stA, buf0);
        __syncthreads();
        for (int ti = 0; ti < 32; ti += 2) {
            if (ti + 2 < 32) SA_LOAD(stA, ti + 2);
            SA_COMPUTE(buf0);
            SA_CVT(stB, buf1);
            __syncthreads();
            if (ti + 3 < 32) SA_LOAD(stB, ti + 3);
            SA_COMPUTE(buf1);
            if (ti + 2 < 32) SA_CVT(stA, buf0);
            __syncthreads();
        }
#undef SA_LOAD
#undef SA_CVT
#undef SA_COMPUTE
        const float lsum = quad_red(lrun); const int qrow = 16 * qt + l15; const size_t pb = ((size_t)(b * 8 + sp) * 32 + qrow);
#pragma unroll
        for (int v = 0; v < 4; ++v) *(f32x4*)(PART + pb * 256 + 16 * (4 * dvq + v) + 4 * g4) = O[v];
        if (dvq == 0 && g4 == 0) { PML[pb * 2] = mrun; PML[pb * 2 + 1] = lsum; }
    }
}
__device__ __forceinline__ void b3_attn_sample(const P& p) {
#ifdef MK_SAMPLE_HALF
    if ((p.bid >> 3) & 1) for (int u = (p.bid & 7) | ((p.bid >> 4) << 3); u < 256; u += p.G / 2) b3_attn_sample_unit(p, u);
#else
    for (int u = p.bid; u < 256; u += p.G) b3_attn_sample_unit(p, u);
#endif
}
__device__ __forceinline__ void b3_combine(const P& p) {
    const bf16* QF = p.w<bf16>(WS_QF); const bf16* KVB = p.w<bf16>(WS_KVB); bf16* OB = p.w<bf16>(WS_OB); const float* PART = p.w<float>(WS_PART); const float* PML = p.w<float>(WS_PML);
    const int dv = p.tid & 255, sub = p.tid >> 8, lane = p.lane, w4 = p.wave & 3;
    LAS float* red = (LAS float*)p.lds;
    for (int base = 2 * p.bid; base < 1024; base += 2 * p.G) {
        const bool live = base + sub < 1024; const int it = live ? base + sub : 1023;
        const int b = it >> 5, i = (it >> 3) & 3, h = it & 7, qt = h >> 2, ql = ((h & 3) << 2) | i, qrow = 16 * qt + ql; const size_t row = (size_t)MP + 4 * b + i;
        { const int wd = dv < 160 ? dv : 159; const unsigned a = ((const unsigned*)(QF + row * 2560 + h * 320))[wd]; float pk[4];
#pragma unroll
          for (int kk = 0; kk < 4; ++kk) { const unsigned c = ((const unsigned*)(KVB + ((size_t)MP + 4 * b + kk) * 320))[wd]; pk[kk] = (dv < 160) ? bflo(a) * bflo(c) + bfhi(a) * bfhi(c) : 0.f; }
#pragma unroll
          for (int kk = 0; kk < 4; ++kk) {
#pragma unroll
              for (int o = 1; o < 64; o <<= 1) pk[kk] += __shfl_xor(pk[kk], o);
              if (lane == 0) red[(sub * 4 + w4) * 4 + kk] = pk[kk]; } }
        __syncthreads();
        float sn[4];
#pragma unroll
        for (int kk = 0; kk < 4; ++kk) { const float s = (red[(sub * 4 + 0) * 4 + kk] + red[(sub * 4 + 1) * 4 + kk]) + (red[(sub * 4 + 2) * 4 + kk] + red[(sub * 4 + 3) * 4 + kk]); sn[kk] = (kk <= i) ? s : -1e30f; }
        float M = fmaxf(fmaxf(sn[0], sn[1]), fmaxf(sn[2], sn[3])); float ms[8], ls[8];
#pragma unroll
        for (int sp = 0; sp < 8; ++sp) { const size_t pb = ((size_t)(b * 8 + sp) * 32 + qrow); ms[sp] = PML[pb * 2]; ls[sp] = PML[pb * 2 + 1]; M = fmaxf(M, ms[sp]); }
        float L = 0.f, Oa = 0.f;
#pragma unroll
        for (int sp = 0; sp < 8; ++sp) { const size_t pb = ((size_t)(b * 8 + sp) * 32 + qrow); const float wgt = __builtin_amdgcn_exp2f(ms[sp] - M); L += ls[sp] * wgt; Oa += PART[pb * 256 + dv] * wgt; }
#pragma unroll
        for (int kk = 0; kk < 4; ++kk) { const float pk = __builtin_amdgcn_exp2f(sn[kk] - M); L += pk; Oa += pk * bf2f(KVB[((size_t)MP + 4 * b + kk) * 320 + dv]); }
        if (live) OB[row * 2048 + h * 256 + dv] = (bf16)f2bf(Oa / L);
        __syncthreads();
    }
}

__device__ __forceinline__ f32x4 conv4s(const bf16* XW, const float* cbuf  , const float* cw, const float* cb, int m, int c) {
    f32x4 acc = *(const f32x4*)(cb + c);
    f32x4 v[4], wv[4];
    const int b = (m - MP) >> 2, t = (m - MP) & 3;
#pragma unroll
    for (int k = 0; k < 4; ++k) { wv[k] = *(const f32x4*)(cw + k * 1280 + c); const int r = t + k - 3;
        const u32x2 xw = *(const u32x2*)(XW + (size_t)(m + (r >= 0 ? k - 3 : 0)) * 1280 + c); const f32x4 st = *(const f32x4*)(cbuf + ((size_t)b * 3 + (r >= 0 ? 0 : 3 + r)) * 1280 + c);
        v[k] = (r >= 0) ? (f32x4){bflo(xw.x), bfhi(xw.x), bflo(xw.y), bfhi(xw.y)} : st; }
#pragma unroll
    for (int k = 0; k < 4; ++k) acc += wv[k] * v[k];
    return acc;
}
__device__ __forceinline__ void c2_sample_item(const P& p, int j, int item, float* out_hs) {
    const bf16* XW = p.w<bf16>(WS_XW); bf16* LH = p.w<bf16>(WS_AA);
    const float* cbuf = p.in[4] + (size_t)j * 32 * 3 * 1280; const float* cw = p.in[25] + (size_t)j * 4 * 1280; const float* cb = p.in[26] + j * 1280;
    const float* b_a = p.in[28] + j * 1280; const float* b_i = p.in[30] + j * 1280; const float* lam = p.in[31] + j * 1280; const float* h0s = p.in[3] + (size_t)j * 32 * 1280;
    const bf16* WaT = p.w<bf16>(WS_WAT); const bf16* WiT = p.w<bf16>(WS_WIT);
    LAS unsigned char* Xs = p.lds;
    const int tid = p.tid, lane = p.lane, w = p.wave, l15 = lane & 15, g4 = lane >> 4, rgq = item / 10, n = item % 10;
    const int chl = 16 * w + l15, chn = n * 128 + chl; u32x4 wa[4], wi[4];
#pragma unroll
    for (int kk = 0; kk < 4; ++kk) { wa[kk] = *(const u32x4*)(WaT + (size_t)n * 16384 + chl * 128 + 32 * kk + 8 * g4); wi[kk] = *(const u32x4*)(WiT + (size_t)n * 16384 + chl * 128 + 32 * kk + 8 * g4); }
    const int bb = 4 * rgq + g4; float h = h0s[(size_t)bb * 1280 + chn]; const float ba = b_a[chn], bi = b_i[chn], lm = lam[chn];
    { const int r16 = tid >> 5, c4 = (tid & 31) * 4; const f32x4 xc = conv4s(XW, cbuf, cw, cb, MP + 16 * rgq + r16, n * 128 + c4);
      __syncthreads();
      *(LAS u32x2*)(Xs + r16 * TP + c4 * 2) = (u32x2){cvt_pk_bf16(xc[0], xc[1]), cvt_pk_bf16(xc[2], xc[3])}; }
    __syncthreads();
    f32x4 ca = (f32x4){0.f, 0.f, 0.f, 0.f}, ci = ca;
#pragma unroll
    for (int kk = 0; kk < 4; ++kk) { const bf16x8 X = *(const LAS bf16x8*)(Xs + l15 * TP + (32 * kk + 8 * g4) * 2);
        ca = MFMA16(X, as_bf16x8(wa[kk]), ca); ci = MFMA16(X, as_bf16x8(wi[kk]), ci); }
    const float nl = -lm, sp = -8.0f * LOG2E * ((nl > 20.f) ? nl : log1pf(expf(nl)));
#pragma unroll
    for (int e = 0; e < 4; ++e) { const float xc = bf2f(*(const LAS bf16*)(Xs + (4 * g4 + e) * TP + chl * 2));
        const float r = fast_sigmoid_l2(LOG2E * (ca[e] + ba)), gi = fast_sigmoid_l2(LOG2E * (ci[e] + bi)), a = __builtin_amdgcn_exp2f(r * sp);
        const float bt = bf2f((bf16)f2bf(__builtin_amdgcn_sqrtf(fmaxf(__builtin_fmaf(-a, a, 1.0f), 0.f)) * gi * xc));
        h = a * h + bt;
        LH[(size_t)(MP + 4 * bb + e) * 1280 + chn] = (bf16)f2bf(h); }
    if (out_hs) out_hs[(size_t)bb * 1280 + chn] = h;
}
__device__ __forceinline__ void c2_rglru(const P& p, int j, float* out_cp, float* out_cs, float* out_hs, const int mask) {
    const bf16* XW = p.w<bf16>(WS_XW); bf16* LH = p.w<bf16>(WS_AA); bf16* CPB = p.w<bf16>(WS_BB); float* AGG = p.w<float>(WS_AGG);
    const float* cbuf = p.in[4] + (size_t)j * 32 * 3 * 1280; const float* cw = p.in[25] + (size_t)j * 4 * 1280; const float* cb = p.in[26] + j * 1280;
    const float* b_a = p.in[28] + j * 1280; const float* b_i = p.in[30] + j * 1280; const float* lam = p.in[31] + j * 1280; const float* h0s = p.in[3] + (size_t)j * 32 * 1280;
    const bf16* WaT = p.w<bf16>(WS_WAT); const bf16* WiT = p.w<bf16>(WS_WIT);
    LAS unsigned char* Xt = p.lds; LAS unsigned char* At = p.lds + 128 * TP; LAS unsigned char* It = p.lds + 256 * TP;
    LAS float* LA = (LAS float*)p.lds;
    LAS unsigned char* LB = p.lds + 128 * 528;
    LAS float* QT = (LAS float*)(p.lds + 128 * 528 + 128 * TP);
    const int tid = p.tid, lane = p.lane, w = p.wave, l15 = lane & 15, g4 = lane >> 4;
    { const int gt = p.bid * 512 + tid, NGT = p.G * 512;
      for (int i = gt; i < (8 + 32) * 3 * 320; i += NGT) { const int c = (i % 320) * 4, rr = i / 320, jj = rr % 3, bb = rr / 3;
          const u32x2 xw = *(const u32x2*)(XW + ((bb < 8) ? ((size_t)bb * 2048 + 2045 + jj) : ((size_t)MP + 4 * (bb - 8) + 1 + jj)) * 1280 + c); const f32x4 v = (f32x4){bflo(xw.x), bfhi(xw.x), bflo(xw.y), bfhi(xw.y)};
          if (bb < 8) { if (out_cp) *(f32x4*)(out_cp + ((size_t)bb * 3 + jj) * 1280 + c) = v; }
          else { const int b = bb - 8; if (out_cs) *(f32x4*)(out_cs + ((size_t)b * 3 + jj) * 1280 + c) = v; } } }
    const int c16 = tid & 15;
    f32x4 wv[4][2], bv[2]; u32x4 xv0[2][4], xv1[2][4], wa[4], wi[4];
#define C2_LOADW(U) do { const int n_ = (U) % 10, cch_ = n_ * 128 + c16 * 8; \
        _Pragma("unroll") for (int k = 0; k < 4; ++k) { wv[k][0] = *(const f32x4*)(cw + k * 1280 + cch_); wv[k][1] = *(const f32x4*)(cw + k * 1280 + cch_ + 4); } \
        bv[0] = *(const f32x4*)(cb + cch_); bv[1] = *(const f32x4*)(cb + cch_ + 4); } while (0)
#define C2_LOADG(U) do { const int n_ = (U) % 10; \
        _Pragma("unroll") for (int q = 0; q < 4; ++q) { const int row = (tid >> 4) + 32 * q; wa[q] = *(const u32x4*)(WaT + (size_t)n_ * 16384 + row * 128 + c16 * 8); wi[q] = *(const u32x4*)(WiT + (size_t)n_ * 16384 + row * 128 + c16 * 8); } } while (0)
#define C2_LOADX(U, QH, XV) do { const int T_ = (U) / 10, cch_ = ((U) % 10) * 128 + c16 * 8; \
        _Pragma("unroll") for (int qq = 0; qq < 2; ++qq) { const int m = T_ * 128 + (tid >> 4) + 32 * (2 * (QH) + qq); \
            _Pragma("unroll") for (int k = 0; k < 4; ++k) { const int t = m & 2047, r = t + k - 3; XV[qq][k] = *(const u32x4*)(XW + (size_t)(m + (r >= 0 ? k - 3 : -t)) * 1280 + cch_); } } } while (0)
#define C2_CONV(U, QH, XV) do { const int T_ = (U) / 10; \
        _Pragma("unroll") for (int qq = 0; qq < 2; ++qq) { const int row = (tid >> 4) + 32 * (2 * (QH) + qq), m = T_ * 128 + row; f32x4 v0 = bv[0], v1 = bv[1]; \
            _Pragma("unroll") for (int k = 0; k < 4; ++k) { const bool live = (((m & 2047) + k - 3) >= 0); const f32x4 z = (f32x4){0.f, 0.f, 0.f, 0.f}; const u32x4 x_ = XV[qq][k]; \
                v0 += (live ? wv[k][0] : z) * (f32x4){bflo(x_.x), bfhi(x_.x), bflo(x_.y), bfhi(x_.y)}; v1 += (live ? wv[k][1] : z) * (f32x4){bflo(x_.z), bfhi(x_.z), bflo(x_.w), bfhi(x_.w)}; } \
            *(LAS u32x4*)(Xt + row * TP + c16 * 16) = pack8(v0, v1); } } while (0)
    if (p.bid < 128 * 10) { C2_LOADX(p.bid, 0, xv0); C2_LOADX(p.bid, 1, xv1); }
    for (int u = p.bid; u < 128 * 10; u += p.G) {
        int tl_ = p.tid; asm volatile("" : "+v"(tl_)); const int tid = tl_, lane = tl_ & 63, l15 = lane & 15, g4 = lane >> 4, c16 = tl_ & 15;
        const int T = u / 10, n = u % 10, row0 = T * 128;
        {
            C2_LOADW(u); C2_LOADG(u);
            C2_CONV(u, 0, xv0); C2_CONV(u, 1, xv1);
#pragma unroll
            for (int q = 0; q < 4; ++q) { const int row = (tid >> 4) + 32 * q; *(LAS u32x4*)(At + row * TP + c16 * 16) = wa[q]; *(LAS u32x4*)(It + row * TP + c16 * 16) = wi[q]; }
        }
        __syncthreads();
        f32x4 ca[8], ci[8];
#pragma unroll
        for (int tt = 0; tt < 8; ++tt) { ca[tt] = (f32x4){0.f, 0.f, 0.f, 0.f}; ci[tt] = (f32x4){0.f, 0.f, 0.f, 0.f}; }
        {
#pragma unroll
        for (int kk = 0; kk < 4; ++kk) {
            const bf16x8 Xa = *(const LAS bf16x8*)(At + (16 * w + l15) * TP + (32 * kk + 8 * g4) * 2), Xi = *(const LAS bf16x8*)(It + (16 * w + l15) * TP + (32 * kk + 8 * g4) * 2);
#pragma unroll
            for (int tt = 0; tt < 8; ++tt) { const bf16x8 Y = *(const LAS bf16x8*)(Xt + (16 * tt + l15) * TP + (32 * kk + 8 * g4) * 2);
                ca[tt] = MFMA16(Xa, Y, ca[tt]); ci[tt] = MFMA16(Xi, Y, ci[tt]); }
        }
        const int chn = n * 128 + 16 * w + 4 * g4;
        { const f32x4 ba = *(const f32x4*)(b_a + chn), bi = *(const f32x4*)(b_i + chn), lm = *(const f32x4*)(lam + chn);
          f32x4 sp;
#pragma unroll
          for (int e = 0; e < 4; ++e) { const float nl = -lm[e]; sp[e] = -8.0f * LOG2E * ((nl > 20.f) ? nl : log1pf(expf(nl))); }
#pragma unroll
          for (int tt = 0; tt < 8; ++tt) { const u32x2 xb = *(const LAS u32x2*)(Xt + (16 * tt + l15) * TP + (16 * w + 4 * g4) * 2);
              const f32x4 xc = (f32x4){bflo(xb.x), bfhi(xb.x), bflo(xb.y), bfhi(xb.y)};
#pragma unroll
              for (int e = 0; e < 4; ++e) { const float r = fast_sigmoid_l2(LOG2E * (ca[tt][e] + ba[e])), gi = fast_sigmoid_l2(LOG2E * (ci[tt][e] + bi[e]));
                  const float a = __builtin_amdgcn_exp2f(r * sp[e]);
                  ca[tt][e] = a; ci[tt][e] = __builtin_amdgcn_sqrtf(fmaxf(__builtin_fmaf(-a, a, 1.0f), 0.f)) * gi * xc[e]; } } }
        }
        __syncthreads();
#pragma unroll
        for (int tt = 0; tt < 8; ++tt) { const int tok = 16 * tt + l15;
            *(LAS f32x4*)(LA + tok * 132 + 16 * w + 4 * g4) = ca[tt];
            *(LAS u32x2*)(LB + tok * TP + (16 * w + 4 * g4) * 2) = (u32x2){cvt_pk_bf16(ci[tt][0], ci[tt][1]), cvt_pk_bf16(ci[tt][2], ci[tt][3])}; }
        __syncthreads();
        { const int un = u + p.G; if (un < 128 * 10) { C2_LOADX(un, 0, xv0); C2_LOADX(un, 1, xv1); } }
        const int ch = tid & 127, q = tid >> 7, chg = n * 128 + ch;
        {
        if (T < 128) {
            float P_ = 1.f, H_ = 0.f;
#pragma unroll 4
            for (int t = 32 * q; t < 32 * q + 32; ++t) { const float a = LA[t * 132 + ch], b = bf2f(*(const LAS bf16*)(LB + t * TP + ch * 2)); H_ = a * H_ + b; P_ *= a; }
            QT[(q * 128 + ch) * 2] = P_; QT[(q * 128 + ch) * 2 + 1] = H_;
            __syncthreads();
            float h = 0.f, pc = 1.f;
#pragma unroll
            for (int qq = 0; qq < 3; ++qq) if (qq < q) { const float Pq = QT[(qq * 128 + ch) * 2], Hq = QT[(qq * 128 + ch) * 2 + 1]; h = Pq * h + Hq; pc *= Pq; }
#pragma unroll 4
            for (int t = 32 * q; t < 32 * q + 32; ++t) { const float a = LA[t * 132 + ch], b = bf2f(*(const LAS bf16*)(LB + t * TP + ch * 2)); h = a * h + b; pc *= a;
                LA[t * 132 + ch] = pc; *(LAS bf16*)(LB + t * TP + ch * 2) = (bf16)f2bf(h); }
            if (q == 3) { AGG[((size_t)T * 2) * 1280 + chg] = pc; AGG[((size_t)T * 2 + 1) * 1280 + chg] = h; }
        } else {
            for (int bb = 8 * q; bb < 8 * q + 8; ++bb) { float h = h0s[(size_t)bb * 1280 + chg];
#pragma unroll
                for (int i = 0; i < 4; ++i) { const int t = 4 * bb + i; const float a = LA[t * 132 + ch], b = bf2f(*(const LAS bf16*)(LB + t * TP + ch * 2)); h = a * h + b;
                    LA[t * 132 + ch] = 0.f; *(LAS bf16*)(LB + t * TP + ch * 2) = (bf16)f2bf(h); }
                if (out_hs) out_hs[(size_t)bb * 1280 + chg] = h; }
        }
        }
        __syncthreads();
#pragma unroll
        for (int i = 0; i < 4; ++i) { const int cidx = tid + 512 * i, tok = cidx >> 4, c8 = (cidx & 15) * 8; const size_t o = (size_t)(row0 + tok) * 1280 + n * 128 + c8;
            *(u32x4*)(LH + o) = *(const LAS u32x4*)(LB + tok * TP + c8 * 2);
            *(u32x4*)(CPB + o) = pack8(*(const LAS f32x4*)(LA + tok * 132 + c8), *(const LAS f32x4*)(LA + tok * 132 + c8 + 4)); }
        __syncthreads();
    }
#undef C2_LOADW
#undef C2_LOADG
#undef C2_LOADX
#undef C2_CONV
    for (int it = (p.bid + 80) % p.G; it < 80; it += p.G) c2_sample_item(p, j, it, out_hs);
}
__device__ __forceinline__ void c5_fixup(const P& p, float* out_hp) {
    const bf16* LH = p.w<bf16>(WS_AA); const bf16* CPB = p.w<bf16>(WS_BB); const float* AGG = p.w<float>(WS_AGG); const bf16* GATE = p.w<bf16>(WS_GATE); bf16* GH = p.w<bf16>(WS_GH);
    LAS float* cr = (LAS float*)p.lds;
    const int tid = p.tid;
    for (int ci = p.bid * 512 + tid; ci < 128 * 160; ci += p.G * 512) { const size_t o = (size_t)MP * 1280 + (size_t)ci * 8;
        const u32x4 lh = *(const u32x4*)(LH + o), gt = *(const u32x4*)(GATE + o); f32x4 r0, r1;
        r0[0] = bflo(gt.x) * bflo(lh.x); r0[1] = bfhi(gt.x) * bfhi(lh.x); r0[2] = bflo(gt.y) * bflo(lh.y); r0[3] = bfhi(gt.y) * bfhi(lh.y);
        r1[0] = bflo(gt.z) * bflo(lh.z); r1[1] = bfhi(gt.z) * bfhi(lh.z); r1[2] = bflo(gt.w) * bflo(lh.w); r1[3] = bfhi(gt.w) * bfhi(lh.w);
        *(u32x4*)(GH + o) = pack8(r0, r1); }
    for (int it = p.bid; it < 256; it += p.G) {
        const int T = it >> 1, hf = it & 1, row0 = T * 128 + 64 * hf, T0 = T & ~15, nd = T - T0;
        const size_t ob = (size_t)row0 * 1280 + (size_t)tid * 8;
#define C5_LOAD(LHV, CPV, GTV, K) do { _Pragma("unroll") for (int i = 0; i < 5; ++i) { const size_t o = ob + (size_t)(5 * (K) + i) * 4096; \
            LHV[i] = *(const u32x4*)(LH + o); CPV[i] = *(const u32x4*)(CPB + o); GTV[i] = *(const u32x4*)(GATE + o); } } while (0)
        u32x4 lhA[5], cpA[5], gtA[5], lhB[5], cpB[5], gtB[5];
        C5_LOAD(lhA, cpA, gtA, 0);
        for (int ch = tid; ch < 1280; ch += 512) {
            float pa[16], ha[16];
#pragma unroll
            for (int d = 0; d < 16; ++d) { pa[d] = AGG[((size_t)(T0 + d) * 2) * 1280 + ch]; ha[d] = AGG[((size_t)(T0 + d) * 2 + 1) * 1280 + ch]; }
            float c = 0.f;
#pragma unroll
            for (int d = 0; d < 15; ++d) c = (d < nd) ? pa[d] * c + ha[d] : c;
            if (nd == 15 && hf == 1 && out_hp) out_hp[(size_t)(T >> 4) * 1280 + ch] = pa[15] * c + ha[15];
            cr[ch] = c; }
        __syncthreads();
#define C5_ITEM(LHV, CPV, GTV, I) do { const int c8 = ((tid + 512 * (I)) % 160) * 8; const size_t o = ob + (size_t)(I) * 4096; \
            const f32x4 c0 = *(const LAS f32x4*)(cr + c8), c1 = *(const LAS f32x4*)(cr + c8 + 4); f32x4 r0, r1; \
            r0[0] = bflo(GTV.x) * (bflo(LHV.x) + bflo(CPV.x) * c0[0]); r0[1] = bfhi(GTV.x) * (bfhi(LHV.x) + bfhi(CPV.x) * c0[1]); \
            r0[2] = bflo(GTV.y) * (bflo(LHV.y) + bflo(CPV.y) * c0[2]); r0[3] = bfhi(GTV.y) * (bfhi(LHV.y) + bfhi(CPV.y) * c0[3]); \
            r1[0] = bflo(GTV.z) * (bflo(LHV.z) + bflo(CPV.z) * c1[0]); r1[1] = bfhi(GTV.z) * (bfhi(LHV.z) + bfhi(CPV.z) * c1[1]); \
            r1[2] = bflo(GTV.w) * (bflo(LHV.w) + bflo(CPV.w) * c1[2]); r1[3] = bfhi(GTV.w) * (bfhi(LHV.w) + bfhi(CPV.w) * c1[3]); \
            *(u32x4*)(GH + o) = pack8(r0, r1); } while (0)
        C5_LOAD(lhB, cpB, gtB, 1);
#pragma unroll
        for (int i = 0; i < 5; ++i) C5_ITEM(lhA[i], cpA[i], gtA[i], i);
        C5_LOAD(lhA, cpA, gtA, 2);
#pragma unroll
        for (int i = 0; i < 5; ++i) C5_ITEM(lhB[i], cpB[i], gtB[i], 5 + i);
        C5_LOAD(lhB, cpB, gtB, 3);
#pragma unroll
        for (int i = 0; i < 5; ++i) C5_ITEM(lhA[i], cpA[i], gtA[i], 10 + i);
#pragma unroll
        for (int i = 0; i < 5; ++i) C5_ITEM(lhB[i], cpB[i], gtB[i], 15 + i);
#undef C5_LOAD
#undef C5_ITEM
        __syncthreads();
    }
}
__device__ __forceinline__ void final_norm(const P& p, float* out_yp, float* out_ys) {
    const bf16* HB = p.w<bf16>(WS_HB); const long long* ssq = p.stat(ST_SSQ0 + 8); const float* g = p.in[8];
    const int gw = p.bid * NWAVES + p.wave, NGW = p.G * NWAVES, lane = p.lane;
    f32x4 gv[4];
#pragma unroll
    for (int jj = 0; jj < 4; ++jj) gv[jj] = *(const f32x4*)(g + 4 * lane + 256 * jj);
    u32x2 hw[4], hn[4]; long long sq = 0, sn = 0;
    if (gw < MT) { sq = ssq[gw];
#pragma unroll
        for (int jj = 0; jj < 4; ++jj) hw[jj] = *(const u32x2*)(HB + (size_t)gw * 1024 + 4 * lane + 256 * jj); }
    for (int m = gw; m < MT; m += NGW) { float* o = m < MP ? out_yp + (size_t)m * 1024 : out_ys + (size_t)(m - MP) * 1024;
        const int mn = (m + NGW < MT) ? m + NGW : m; sn = ssq[mn];
#pragma unroll
        for (int jj = 0; jj < 4; ++jj) hn[jj] = *(const u32x2*)(HB + (size_t)mn * 1024 + 4 * lane + 256 * jj);
        const float rs = rsqrtf((float)sq * ST_INV * (1.0f / 1024.0f) + RMS_EPS);
#pragma unroll
        for (int jj = 0; jj < 4; ++jj) *(f32x4*)(o + 4 * lane + 256 * jj) = (f32x4){bflo(hw[jj].x), bfhi(hw[jj].x), bflo(hw[jj].y), bfhi(hw[jj].y)} * rs * gv[jj];
#pragma unroll
        for (int jj = 0; jj < 4; ++jj) hw[jj] = hn[jj];
        sq = sn; }
}
}
namespace mk {
struct Args { const float* in[36]; float* out; unsigned char* ws; int ph_lo, ph_hi, li, mask; };
constexpr int NPHASE = 34;

#define MK_GEMM(EpiT, E, Aptr, LDA, Bptr, LDB, KD, NC) do { pg8::Gemm g_{(const pg8::bf16_t*)(Aptr), (const pg8::bf16_t*)(Bptr), (LDA), (LDB), (KD)}; pg8::StaticOrder S_; S_.init(MP, (NC), p.G, p.bid); \
        pg8::gemm_phase<EpiT, pg8::StaticOrder, MK_ALIGN_EPI, MK_SP2>(p.lds, g_, S_, E, p.tid); \
          \
        P q_ = p; { int t2_ = p0.tid; asm volatile("" : "+v"(t2_)); q_.tid = t2_; q_.lane = t2_ & 63; q_.wave = __builtin_amdgcn_readfirstlane(t2_ >> 6); } \
        if (MK_MINI_ON) mini_gemm<EpiT>(q_, (const bf16*)(Aptr), (LDA), (const bf16*)(Bptr), (LDB), (KD), (NC), E, (64 * ((NC) / 256)) % p.G); } while (0)

#ifndef MK_SP2
#define MK_SP2 true
#endif
#ifndef MK_ALIGN_EPI
#define MK_ALIGN_EPI true
#endif
#ifdef MK_DRYPROBE
#define MK_DRYARG , ((mask >> 10) & 1)
#define MK_MINI_ON ((mask >> 11) & 1)
#else
#define MK_DRYARG
#define MK_MINI_ON 1
#endif
#ifndef MK_REP_SEL
#define MK_REP_SEL(k) 0
#define MK_REP_N 1
#endif
#define REPF(k) for (int rep_ = 0; rep_ < (MK_REP_SEL(k) ? MK_REP_N : 1); ++rep_)
#define IN_(k) (lo <= (k) && (k) < hi)
#define PH_BEGIN() P p = p0; { int z_ = 0, t_ = p0.tid, g_ = p0.G, b_ = p0.bid; unsigned l_ = (unsigned)(size_t)p0.lds; asm volatile("" : "+s"(z_), "+v"(t_), "+s"(g_), "+s"(b_), "+s"(l_)); p.ws = p0.ws + z_; p.out = p0.out + z_; p.tid = t_; p.lane = t_ & 63; p.wave = __builtin_amdgcn_readfirstlane(t_ >> 6); p.G = g_; p.bid = b_; p.lds = (LAS unsigned char*)(size_t)l_; } float* const out = p.out; (void)out
#ifdef MK_PROF
#define STAMP(k) do { if (p0.bid == 0 && p0.tid == 0) ((unsigned long long*)(p0.ws + WS_PROF))[(k)] = (unsigned long long)wall_clock64(); } while (0)
#else
#define STAMP(k) do { } while (0)
#endif
#define ENDPH(k) do { if ((k) + 1 < hi) xcd_barrier(bar); STAMP((k) + 1); } while (0)
template <int LAYER> __device__ __forceinline__ void run_layer(const P& p0, const XcdBarrier& bar, const int lo, const int hi, const int mask) {
        constexpr int layer = LAYER, kind = layer % 3, j = layer / 3, pb = 1 + 8 * layer;
        constexpr size_t resA = kind == 0 ? WS_UM : kind == 1 ? WS_OB : WS_GH, resB = kind == 0 ? WS_WOUT + (size_t)j * 2 * MiB : kind == 1 ? WS_WOV : WS_WCO; constexpr int resK = kind == 0 ? 1024 : kind == 1 ? 2048 : 1280;
        if constexpr (kind == 0) {
            if (IN_(pb)) REPF(pb) { PH_BEGIN(); EpiA1 E{p.w<bf16>(WS_U), p.w<bf16>(WS_GV), p.stat(ST_SSQ0 + 2 * layer), p.stat(ST_LNS0 + 2 * j), p.stat(ST_LNQ0 + 2 * j) MK_DRYARG};
                MK_GEMM(EpiA1, E, p.w<bf16>(WS_HB), 1024, p.w<bf16>(WS_WIN + (size_t)j * 4 * MiB), 1024, 1024, 2048); ENDPH(pb); }
            if (IN_(pb + 1)) REPF(pb + 1) { PH_BEGIN(); a2_spatial(p, j, out + O_CV + (size_t)j * 131072); ENDPH(pb + 1); }
        } else if constexpr (kind == 1) {
            if (IN_(pb)) REPF(pb) { PH_BEGIN(); EpiB1 E{p.w<float>(WS_RAW), p.w<bf16>(WS_CQB), p.stat(ST_SSQ0 + 2 * layer), p.stat(ST_KV), p.stat(ST_Q) MK_DRYARG};
                MK_GEMM(EpiB1, E, p.w<bf16>(WS_HB), 1024, p.w<bf16>(WS_WDQKV), 1024, 1024, 768); ENDPH(pb); }
            if (IN_(pb + 1)) REPF(pb + 1) { PH_BEGIN(); b2_kvfinal(p, out + O_MP, out + O_MS);
                EpiB2 E{p.w<bf16>(WS_QF), p.stat(ST_Q), p.w<f32x2>(WS_ROPE)};
                MK_GEMM(EpiB2, E, p.w<bf16>(WS_CQB), 384, p.w<bf16>(WS_WQ), 384, 384, 2560); ENDPH(pb + 1); }
            if (IN_(pb + 2)) REPF(pb + 2) { PH_BEGIN();
                if ((p.bid >> 3) & 1) { if (mask & 512) b3_attn_sample(p); if (mask & 256) b3_attn_prompt(p); } else { if (mask & 256) b3_attn_prompt(p); if (mask & 512) b3_attn_sample(p); }
                ENDPH(pb + 2); }
            if (IN_(pb + 3)) REPF(pb + 3) { PH_BEGIN(); b3_combine(p); ENDPH(pb + 3); }
        } else {
            if (IN_(pb)) REPF(pb) { PH_BEGIN(); EpiC1 E{p.w<bf16>(WS_GATE), p.w<bf16>(WS_XW), p.stat(ST_SSQ0 + 2 * layer)};
                MK_GEMM(EpiC1, E, p.w<bf16>(WS_HB), 1024, p.w<bf16>(WS_WGX), 1024, 1024, 2560); ENDPH(pb); }
            if (IN_(pb + 1)) REPF(pb + 1) { PH_BEGIN(); c2_rglru(p, j, out + O_CP, out + O_CS, out + O_HS, mask); ENDPH(pb + 1); }
            if (IN_(pb + 3)) REPF(pb + 3) { PH_BEGIN(); c5_fixup(p, out + O_HP); ENDPH(pb + 3); }
        }
        if (IN_(pb + 5)) REPF(pb + 5) { PH_BEGIN(); EpiRes E{p.w<bf16>(WS_HB), p.stat(ST_SSQ0 + 2 * layer + 1) MK_DRYARG}; MK_GEMM(EpiRes, E, p.w<bf16>(resA), resK, p.w<bf16>(resB), resK, resK, 1024); ENDPH(pb + 5); }
        if (IN_(pb + 6)) REPF(pb + 6) { PH_BEGIN(); EpiF1 E{p.w<bf16>(WS_ACT), p.stat(ST_SSQ0 + 2 * layer + 1)}; MK_GEMM(EpiF1, E, p.w<bf16>(WS_HB), 1024, p.w<bf16>(WS_WGU + (size_t)layer * WGU_BYTES), 1024, 1024, 5632); ENDPH(pb + 6); }
        if (IN_(pb + 7)) REPF(pb + 7) { PH_BEGIN(); EpiRes E{p.w<bf16>(WS_HB), p.stat(ST_SSQ0 + 2 * layer + 2) MK_DRYARG}; MK_GEMM(EpiRes, E, p.w<bf16>(WS_ACT), DFF, p.w<bf16>(WS_WD + (size_t)layer * WD_BYTES), DFF, DFF, 1024); ENDPH(pb + 7); }
}
__global__ void __launch_bounds__(NWAVES * 64, 2) mk_fwd(Args a) {
    extern __shared__ __attribute__((aligned(16))) unsigned char lds_raw[];
    const int tid_ = threadIdx.x;
    const P p0{InTab{(const float* const __attribute__((address_space(4)))*)__builtin_amdgcn_kernarg_segment_ptr()}, a.out, a.ws, (LAS unsigned char*)lds_raw, tid_, tid_ & 63, __builtin_amdgcn_readfirstlane(tid_ >> 6), (int)gridDim.x, (int)blockIdx.x};
    volatile LAS unsigned* MISC = (volatile LAS unsigned*)(p0.lds + MISC_OFF);
    if (p0.tid < 64) MISC[p0.tid] = 0u;
    __syncthreads();
    XcdBarrier bar = xcd_barrier_post((unsigned*)(a.ws + WS_CTL) + CW_BAR + a.li * XCD_BAR_WORDS, MISC + 8);
    const int lo = a.ph_lo, hi = a.ph_hi, mask = a.mask;
    STAMP(0);
    if (IN_(0)) REPF(0) { PH_BEGIN(); p0_prologue(p, mask); if (mask & 128)
        { const int gt = p.bid * 512 + p.tid, NGT = p.G * 512; const u32x4 z = (u32x4){0u, 0u, 0u, 0u};
          for (int i = gt; i < 128 * 128; i += NGT) p.w<u32x4>(WS_UM + (size_t)MT * 2048)[i] = z;
          for (int i = gt; i < 128 * 256; i += NGT) p.w<u32x4>(WS_OB + (size_t)MT * 4096)[i] = z;
          for (int i = gt; i < 128 * 160; i += NGT) p.w<u32x4>(WS_GH + (size_t)MT * 2560)[i] = z; }
        ENDPH(0); }
    run_layer<0>(p0, bar, lo, hi, mask); run_layer<1>(p0, bar, lo, hi, mask); run_layer<2>(p0, bar, lo, hi, mask); run_layer<3>(p0, bar, lo, hi, mask);
    if (IN_(33)) REPF(33) { PH_BEGIN(); final_norm(p, out + O_YP, out + O_YS); VM_WAIT(); STAMP(34); }
#undef IN_
#undef ENDPH
}

inline void fill_args(Args& a, void* const* d_in, float* out, void* d_ws) { for (int i = 0; i < 36; ++i) a.in[i] = (const float*)d_in[i]; a.out = out; a.ws = (unsigned char*)d_ws; a.mask = -1; }
inline int setup_grid() {
    static int grid = 0;
    if (!grid) { int dev = 0, cus = 0; hipGetDevice(&dev); hipDeviceGetAttribute(&cus, hipDeviceAttributeMultiprocessorCount, dev);
        hipFuncSetAttribute((const void*)mk_fwd, hipFuncAttributeMaxDynamicSharedMemorySize, LDS_BYTES);
        int per_cu = 0; hipOccupancyMaxActiveBlocksPerMultiprocessor(&per_cu, (const void*)mk_fwd, NWAVES * 64, LDS_BYTES); (void)hipGetLastError();
        grid = cus > 0 ? cus : 256; }
    return grid;
}
inline void launch_range(void* const* d_in, float* out, void* d_ws, hipStream_t st, int lo, int hi, int li, int mask = -1) {
    Args a{}; fill_args(a, d_in, out, d_ws); a.ph_lo = lo; a.ph_hi = hi; a.li = li; a.mask = mask;
    hipLaunchKernelGGL(mk_fwd, dim3(setup_grid()), dim3(NWAVES * 64), LDS_BYTES, st, a);
}
}

extern "C" void kernel_launch(void* const* d_in, const int* in_sizes, int n_in, void* d_out, int out_size, void* d_ws, size_t ws_size, hipStream_t stream) {
    hipMemsetAsync(d_ws, 0, mk::CTL_BYTES, stream);
    mk::launch_range(d_in, (float*)d_out, d_ws, stream, 0, mk::NPHASE, 0);
}
```
